# Optimizing an MI355X kernel written in HIP

```python
import math
import jax, jax.numpy as jnp
from jax import lax
import numpy as np

D_MODEL = 1024
BATCH = 8
SEQ = 2048
DEPTH = 1

D_FF = 2816
HEAD_DIM = 64
NSA_HEADS = 8
NSA_KV_GROUPS = 2
NSA_HPG = NSA_HEADS // NSA_KV_GROUPS
CMP_BLOCK = 32
CMP_STRIDE = 16
CMP_HIDDEN = 256
SEL_BLOCK = 64
SEL_TOP_N = 16
SEL_Q_BLOCK = 64
WINDOW = 512
WIN_Q_BLOCK = 128
FOX_HEADS = 8
FOX_Q_BLOCK = 128
MEM_LEN = 256
MEM_HEADS = 4
MEM_HEAD_DIM = D_MODEL // MEM_HEADS
NUM_BUCKETS = 32
MAX_DISTANCE = 128
RMS_EPS = 1e-6
NEG_INF = -1e30
FORCE_BONUS = 1e4

NSA_Q = NSA_HEADS * HEAD_DIM
NSA_KV = NSA_KV_GROUPS * HEAD_DIM
FOX_W = FOX_HEADS * HEAD_DIM
IN_SPLITS = (NSA_Q, NSA_KV, NSA_KV, NSA_KV, NSA_KV, NSA_KV, NSA_KV, 3 * NSA_HEADS,
             FOX_W, FOX_W, FOX_W, FOX_HEADS, D_MODEL, D_MODEL)
IN_WIDTH = NSA_Q + 6 * NSA_KV + 3 * NSA_HEADS + 3 * FOX_W + FOX_HEADS + 2 * D_MODEL

kernel_name = 'hybrid_nsa_fox_macaron'


def rmsnorm(x, g):
    x32 = x.astype(jnp.float32)
    y = x32 * lax.rsqrt(jnp.mean(x32 * x32, axis=-1, keepdims=True) + RMS_EPS)
    return (y * g.astype(jnp.float32)).astype(x.dtype)


def swiglu(h, w_gate, w_up, w_down):
    return (jax.nn.silu(h @ w_gate) * (h @ w_up)) @ w_down


def split_cols(z, sizes):
    return jnp.split(z, np.cumsum(sizes)[:-1].tolist(), axis=-1)


def t5_bucket(dist):
    n = jnp.maximum(dist, 0)
    exact = NUM_BUCKETS // 2
    nf = jnp.maximum(n, 1).astype(jnp.float32)
    large = exact + (jnp.log(nf / exact) / math.log(MAX_DISTANCE / exact)
                     * (NUM_BUCKETS - exact)).astype(jnp.int32)
    large = jnp.minimum(large, NUM_BUCKETS - 1)
    return jnp.where(n < exact, n, large)


def masked_softmax(s, mask):
    s = jnp.where(mask, s.astype(jnp.float32), NEG_INF)
    p = jax.nn.softmax(s, axis=-1)
    return jnp.where(mask, p, 0.0)


def cmp_sel_overlap(n_cmp, n_sel):
    c0 = np.arange(n_cmp)[:, None] * CMP_STRIDE
    s0 = np.arange(n_sel)[None, :] * SEL_BLOCK
    ov = np.clip(np.minimum(c0 + CMP_BLOCK, s0 + SEL_BLOCK) - np.maximum(c0, s0), 0, None)
    return jnp.asarray(ov / CMP_STRIDE, dtype=jnp.float32)


def compress(kv, pos, w1, w2):
    b, s, g, d = kv.shape
    n_chunks = s // CMP_STRIDE
    r = CMP_BLOCK // CMP_STRIDE
    nc = n_chunks - r + 1
    chunks = kv.reshape(b, n_chunks, CMP_STRIDE, g, d)
    blocks = jnp.concatenate([chunks[:, i:i + nc] for i in range(r)], axis=2)
    blocks = blocks + pos[None, None, :, None, :]
    flat = blocks.transpose(0, 1, 3, 2, 4).reshape(b, nc, g, CMP_BLOCK * d)
    return jax.nn.gelu(flat @ w1) @ w2


def nsa_attention(q, k_c, v_c, k_s, v_s, k_w, v_w, g_nsa, rel_bias_table,
                  cmp_pos_k, cmp_pos_v, cmp_k_w1, cmp_k_w2, cmp_v_w1, cmp_v_w2):
    b, s = q.shape[:2]
    G, J, D = NSA_KV_GROUPS, NSA_HPG, HEAD_DIM
    qg = q.reshape(b, s, G, J, D) * (D ** -0.5)
    t = jnp.arange(s)
    tbl = rel_bias_table.reshape(NUM_BUCKETS, G, J)

    kc = compress(k_c, cmp_pos_k, cmp_k_w1, cmp_k_w2)
    vc = compress(v_c, cmp_pos_v, cmp_v_w1, cmp_v_w2)
    nc = kc.shape[1]
    c_end = jnp.arange(nc) * CMP_STRIDE + CMP_BLOCK - 1
    dist_c = t[:, None] - c_end[None, :]
    bias_c = tbl[t5_bucket(dist_c)].transpose(2, 3, 0, 1)
    s_c = jnp.einsum('bsgjd,bcgd->bgjsc', qg, kc) + bias_c
    p_c = masked_softmax(s_c, dist_c >= 0)
    o_c = jnp.einsum('bgjsc,bcgd->bsgjd', p_c.astype(vc.dtype), vc)

    n_sel = s // SEL_BLOCK
    top_n = min(SEL_TOP_N, n_sel)
    imp = jnp.einsum('bgjsc,cn->bgsn', p_c, cmp_sel_overlap(nc, n_sel))
    blk = jnp.arange(n_sel)[None, :]
    cur = (t // SEL_BLOCK)[:, None]
    forced = (blk == 0) | (blk == cur) | (blk == cur - 1)
    imp = jnp.where(blk * SEL_BLOCK <= t[:, None],
                    imp + jnp.where(forced, FORCE_BONUS, 0.0), NEG_INF)
    _, sel_idx = lax.top_k(imp, top_n)

    kb = k_s.reshape(b, n_sel, SEL_BLOCK, G, D).transpose(0, 3, 1, 2, 4)
    vb = v_s.reshape(b, n_sel, SEL_BLOCK, G, D).transpose(0, 3, 1, 2, 4)
    nq = s // SEL_Q_BLOCK
    q_blocks = qg.reshape(b, nq, SEL_Q_BLOCK, G, J, D).transpose(1, 0, 3, 4, 2, 5)
    idx_blocks = sel_idx.reshape(b, G, nq, SEL_Q_BLOCK, top_n).transpose(2, 0, 1, 3, 4)
    bi = jnp.arange(b)[:, None, None, None]
    gi = jnp.arange(G)[None, :, None, None]
    gi5 = jnp.arange(G)[None, :, None, None, None]
    r = jnp.arange(SEL_BLOCK)

    def sel_block(args):
        qb, ib, start = args
        kg = kb[bi, gi, ib]
        vg = vb[bi, gi, ib]
        tq = start + jnp.arange(SEL_Q_BLOCK)
        pos = ib[..., None] * SEL_BLOCK + r
        dist = tq[None, None, :, None, None] - pos
        bias = tbl[t5_bucket(dist), gi5].transpose(0, 1, 5, 2, 3, 4)
        sc = jnp.einsum('bgjqd,bgqnrd->bgjqnr', qb, kg) + bias
        flat = top_n * SEL_BLOCK
        p = masked_softmax(sc.reshape(b, G, J, SEL_Q_BLOCK, flat),
                           (dist >= 0).reshape(b, G, 1, SEL_Q_BLOCK, flat))
        p = p.reshape(b, G, J, SEL_Q_BLOCK, top_n, SEL_BLOCK).astype(vg.dtype)
        return jnp.einsum('bgjqnr,bgqnrd->bqgjd', p, vg)

    o_s = lax.map(sel_block, (q_blocks, idx_blocks, jnp.arange(nq) * SEL_Q_BLOCK))
    o_s = o_s.transpose(1, 0, 2, 3, 4, 5).reshape(b, s, G, J, D)

    nw = s // WIN_Q_BLOCK
    span = WINDOW + WIN_Q_BLOCK
    kpad = jnp.pad(k_w, ((0, 0), (WINDOW, 0), (0, 0), (0, 0)))
    vpad = jnp.pad(v_w, ((0, 0), (WINDOW, 0), (0, 0), (0, 0)))
    win_idx = (jnp.arange(nw) * WIN_Q_BLOCK)[:, None] + jnp.arange(span)[None, :]
    kwin = kpad[:, win_idx]
    vwin = vpad[:, win_idx]
    qw = qg.reshape(b, nw, WIN_Q_BLOCK, G, J, D)
    dist_w = jnp.arange(WIN_Q_BLOCK)[:, None] + WINDOW - jnp.arange(span)[None, :]
    bias_w = tbl[t5_bucket(dist_w)].transpose(2, 3, 0, 1)[:, :, None]
    mask_w = ((dist_w >= 0) & (dist_w < WINDOW))[None] & (win_idx >= WINDOW)[:, None, :]
    s_w = jnp.einsum('bnqgjd,bnkgd->bgjnqk', qw, kwin) + bias_w
    p_w = masked_softmax(s_w, mask_w)
    o_w = jnp.einsum('bgjnqk,bnkgd->bnqgjd', p_w.astype(vwin.dtype), vwin).reshape(b, s, G, J, D)

    g = jax.nn.sigmoid(g_nsa).reshape(b, s, 3, G, J)[..., None]
    o = g[:, :, 0] * o_c + g[:, :, 1] * o_s + g[:, :, 2] * o_w
    return o.reshape(b, s, NSA_Q)


def forgetting_attention(q, k, v, f_logit):
    b, s, h, d = q.shape
    c = jnp.cumsum(jax.nn.log_sigmoid(f_logit.astype(jnp.float32)), axis=1).transpose(0, 2, 1)
    nb = s // FOX_Q_BLOCK
    qb = (q * (d ** -0.5)).reshape(b, nb, FOX_Q_BLOCK, h, d).transpose(1, 0, 3, 2, 4)
    cb = c.reshape(b, h, nb, FOX_Q_BLOCK).transpose(2, 0, 1, 3)
    kpos = jnp.arange(s)

    def block(args):
        qi, ci, start = args
        sc = jnp.einsum('bhqd,bkhd->bhqk', qi, k).astype(jnp.float32) + ci[..., None] - c[:, :, None, :]
        mask = (start + jnp.arange(FOX_Q_BLOCK))[:, None] >= kpos[None, :]
        p = masked_softmax(sc, mask)
        return jnp.einsum('bhqk,bkhd->bqhd', p.astype(v.dtype), v)

    o = lax.map(block, (qb, cb, jnp.arange(nb) * FOX_Q_BLOCK))
    return o.transpose(1, 0, 2, 3, 4).reshape(b, s, h * d)


def hybrid_mixer(h, w_in, b_forget, rel_bias_table, cmp_pos_k, cmp_pos_v, cmp_k_w1, cmp_k_w2,
                 cmp_v_w1, cmp_v_w2, w_up_nsa, w_up_fox, w_out):
    b, s, _ = h.shape
    (q_n, k_c, v_c, k_s, v_s, k_w, v_w, g_nsa, q_f, k_f, v_f, f_logit,
     gate_a, gate_b) = split_cols(h @ w_in, IN_SPLITS)
    kvh = lambda z: z.reshape(b, s, NSA_KV_GROUPS, HEAD_DIM)
    o_nsa = nsa_attention(q_n, kvh(k_c), kvh(v_c), kvh(k_s), kvh(v_s), kvh(k_w), kvh(v_w), g_nsa,
                          rel_bias_table, cmp_pos_k, cmp_pos_v, cmp_k_w1, cmp_k_w2, cmp_v_w1, cmp_v_w2)
    fh = lambda z: z.reshape(b, s, FOX_HEADS, HEAD_DIM)
    o_fox = forgetting_attention(fh(q_f), fh(k_f), fh(v_f), f_logit + b_forget)
    y = jax.nn.sigmoid(gate_a) * (o_nsa @ w_up_nsa) + jax.nn.sigmoid(gate_b) * (o_fox @ w_up_fox)
    return y @ w_out


def memory_cross_attention(h, mem_n, w_q, w_kv, w_o):
    b, s, _ = h.shape
    q = (h @ w_q).reshape(b, s, MEM_HEADS, MEM_HEAD_DIM) * (MEM_HEAD_DIM ** -0.5)
    k, v = jnp.split(mem_n @ w_kv, 2, axis=-1)
    k = k.reshape(b, -1, MEM_HEADS, MEM_HEAD_DIM)
    v = v.reshape(b, -1, MEM_HEADS, MEM_HEAD_DIM)
    p = jax.nn.softmax(jnp.einsum('bshd,bmhd->bhsm', q, k).astype(jnp.float32), axis=-1)
    o = jnp.einsum('bhsm,bmhd->bshd', p.astype(v.dtype), v).reshape(b, s, D_MODEL)
    return o @ w_o


def setup_inputs(seed: int = 0) -> dict:
    key = jax.random.key(seed)
    ks = iter(jax.random.split(key, 40))
    nrm = lambda shape, scale: jax.random.normal(next(ks), shape, jnp.float32) * scale
    gain = lambda shape: 1.0 + nrm(shape, 0.02)
    L = DEPTH
    return {
        'x': nrm((BATCH, SEQ, D_MODEL), 1.0),
        'mem': nrm((BATCH, MEM_LEN, D_MODEL), 1.0),
        'rel_bias_table': nrm((NUM_BUCKETS, NSA_HEADS), 0.5),
        'ffn1_norm': gain((L, D_MODEL)),
        'ffn1_w_gate': nrm((L, D_MODEL, D_FF), D_MODEL ** -0.5),
        'ffn1_w_up': nrm((L, D_MODEL, D_FF), D_MODEL ** -0.5),
        'ffn1_w_down': nrm((L, D_FF, D_MODEL), D_FF ** -0.5),
        'mix_norm': gain((L, D_MODEL)),
        'mix_w_in': nrm((L, D_MODEL, IN_WIDTH), D_MODEL ** -0.5),
        'mix_b_forget': 2.0 + nrm((L, FOX_HEADS), 0.5),
        'cmp_pos_k': nrm((L, CMP_BLOCK, HEAD_DIM), 0.1),
        'cmp_pos_v': nrm((L, CMP_BLOCK, HEAD_DIM), 0.1),
        'cmp_k_w1': nrm((L, CMP_BLOCK * HEAD_DIM, CMP_HIDDEN), (CMP_BLOCK * HEAD_DIM) ** -0.5),
        'cmp_k_w2': nrm((L, CMP_HIDDEN, HEAD_DIM), 2.0 * CMP_HIDDEN ** -0.5),
        'cmp_v_w1': nrm((L, CMP_BLOCK * HEAD_DIM, CMP_HIDDEN), (CMP_BLOCK * HEAD_DIM) ** -0.5),
        'cmp_v_w2': nrm((L, CMP_HIDDEN, HEAD_DIM), 2.0 * CMP_HIDDEN ** -0.5),
        'w_up_nsa': nrm((L, NSA_Q, D_MODEL), NSA_Q ** -0.5),
        'w_up_fox': nrm((L, FOX_W, D_MODEL), FOX_W ** -0.5),
        'mix_w_out': nrm((L, D_MODEL, D_MODEL), D_MODEL ** -0.5),
        'mem_q_norm': gain((L, D_MODEL)),
        'mem_kv_norm': gain((L, D_MODEL)),
        'mem_w_q': nrm((L, D_MODEL, D_MODEL), D_MODEL ** -0.5),
        'mem_w_kv': nrm((L, D_MODEL, 2 * D_MODEL), D_MODEL ** -0.5),
        'mem_w_o': nrm((L, D_MODEL, D_MODEL), D_MODEL ** -0.5),
        'ffn2_norm': gain((L, D_MODEL)),
        'ffn2_w_gate': nrm((L, D_MODEL, D_FF), D_MODEL ** -0.5),
        'ffn2_w_up': nrm((L, D_MODEL, D_FF), D_MODEL ** -0.5),
        'ffn2_w_down': nrm((L, D_FF, D_MODEL), D_FF ** -0.5),
        'final_norm': gain((D_MODEL,)),
    }


def reference(x, mem, rel_bias_table, ffn1_norm, ffn1_w_gate, ffn1_w_up, ffn1_w_down,
              mix_norm, mix_w_in, mix_b_forget, cmp_pos_k, cmp_pos_v, cmp_k_w1, cmp_k_w2,
              cmp_v_w1, cmp_v_w2, w_up_nsa, w_up_fox, mix_w_out, mem_q_norm, mem_kv_norm,
              mem_w_q, mem_w_kv, mem_w_o, ffn2_norm, ffn2_w_gate, ffn2_w_up, ffn2_w_down,
              final_norm):
    for l in range(DEPTH):
        x = x + 0.5 * swiglu(rmsnorm(x, ffn1_norm[l]), ffn1_w_gate[l], ffn1_w_up[l], ffn1_w_down[l])
        x = x + hybrid_mixer(rmsnorm(x, mix_norm[l]), mix_w_in[l], mix_b_forget[l], rel_bias_table,
                             cmp_pos_k[l], cmp_pos_v[l], cmp_k_w1[l], cmp_k_w2[l], cmp_v_w1[l],
                             cmp_v_w2[l], w_up_nsa[l], w_up_fox[l], mix_w_out[l])
        x = x + memory_cross_attention(rmsnorm(x, mem_q_norm[l]), rmsnorm(mem, mem_kv_norm[l]),
                                       mem_w_q[l], mem_w_kv[l], mem_w_o[l])
        x = x + 0.5 * swiglu(rmsnorm(x, ffn2_norm[l]), ffn2_w_gate[l], ffn2_w_up[l], ffn2_w_down[l])
    return rmsnorm(x, final_norm)
```

```cpp
#define STAGE_LIMIT 4
#include <hip/hip_runtime.h>
#include <hip/hip_cooperative_groups.h>
#include <cstdio>
#include <cstdint>
namespace cg = cooperative_groups;

#define LAS __attribute__((address_space(3)))
typedef unsigned short bf16_t;
typedef short bf16x8 __attribute__((ext_vector_type(8)));
typedef short s16x4 __attribute__((ext_vector_type(4)));
typedef float f32x2 __attribute__((ext_vector_type(2)));
typedef float f32x4 __attribute__((ext_vector_type(4)));
typedef float f32x16 __attribute__((ext_vector_type(16)));
typedef unsigned u32x2 __attribute__((ext_vector_type(2)));
typedef unsigned u32x4 __attribute__((ext_vector_type(4)));
typedef __bf16 bf16x2_t __attribute__((ext_vector_type(2)));

constexpr int NB = 8, SEQ = 2048, DM = 1024, FF = 2816, M = NB * SEQ;
constexpr int MEMLEN = 256, MROWS = NB * MEMLEN;
constexpr float RMS_EPS = 1e-6f;
constexpr float LOG2E = 1.4426950408889634f;
constexpr float QS64 = 0.125f * LOG2E;
constexpr float QS256 = 0.0625f * LOG2E;

__device__ __forceinline__ int fresh_tid() { int t = threadIdx.x; asm volatile("" : "+v"(t)); return t; }
__device__ __forceinline__ unsigned cvtpk(float lo, float hi) { f32x2 v = {lo, hi}; bf16x2_t b = __builtin_convertvector(v, bf16x2_t); return __builtin_bit_cast(unsigned, b); }
__device__ __forceinline__ float bflo(unsigned w) { return __uint_as_float(w << 16); }
__device__ __forceinline__ float bfhi(unsigned w) { return __uint_as_float(w & 0xffff0000u); }
__device__ __forceinline__ u32x4 pack8(f32x4 a, f32x4 b) { u32x4 w; w.x = cvtpk(a[0], a[1]); w.y = cvtpk(a[2], a[3]); w.z = cvtpk(b[0], b[1]); w.w = cvtpk(b[2], b[3]); return w; }
__device__ __forceinline__ float fexp2(float x) { return __builtin_amdgcn_exp2f(x); }
__device__ __forceinline__ float frcp(float x) { return __builtin_amdgcn_rcpf(x); }
__device__ __forceinline__ float sigmoidf_(float x) { return frcp(1.0f + fexp2(-x * LOG2E)); }
__device__ __forceinline__ float rstd_of(float ss) { return __builtin_amdgcn_rsqf(ss * (1.0f / DM) + RMS_EPS); }

namespace pg8 {
constexpr int BM = 256, BK = 64, HALF = 128, HTB = HALF * BK * 2, STAGE_BYTES = 8 * HTB, NXCD = 8, WGM = 8;
__host__ __device__ __forceinline__ int lds_byte(int r, int c) { const int st = (r >> 4) * 2 + (c >> 5), rr = r & 15, cc = c & 31, ob = rr * 64 + cc * 2; return st * 1024 + (ob ^ (((ob >> 9) & 1) << 5)); }
__host__ __device__ __forceinline__ void stage_rc(int b, int& R, int& C) { const int st = b / 1024, sb = b % 1024, swz = sb ^ (((sb >> 9) & 1) << 5); R = (st >> 1) * 16 + swz / 64; C = (st & 1) * 32 + (swz % 64) / 2; }
__host__ __device__ __forceinline__ int perm32(int rho) { const int n = rho >> 4, i = rho & 15; return 8 * (i >> 2) + 4 * n + (i & 3); }

struct Unit { int pm, pn, pb; };
struct Gemm { const bf16_t* A; const bf16_t* Bt; int lda, ldb, K; long sAb, sAh, sBb, sBh; };

struct Order {
    int nM, nN, nwg, G, c;
    __device__ __forceinline__ void init(int nM_, int nN_, int nB_, int G_, int c_) { nM = nM_; nN = nN_; nwg = nM_ * nN_ * nB_; G = G_; c = c_; }
    __device__ __forceinline__ bool next(int i, Unit& u) const {
        if (c < 0) return false;
        const long L = (long)i * G + c; if (L >= nwg) return false;
        int wgid = (int)L; { const int q = nwg / NXCD, r = nwg % NXCD, xcd = wgid % NXCD, off = wgid / NXCD; wgid = (xcd < r ? xcd * (q + 1) : r * (q + 1) + (xcd - r) * q) + off; }
        const int per = nM * nN; u.pb = wgid / per; const int w = wgid % per;
        const int nig = WGM * nN, gid = w / nig, fm = gid * WGM, gsz = (nM - fm) < WGM ? (nM - fm) : WGM;
        u.pm = fm + ((w % nig) % gsz); u.pn = (w % nig) / gsz; return true;
    }
};

typedef f32x4 Acc[2][2][4][2];

template <class Epi, bool ALIGN_EPI>
__device__ __forceinline__ void gemm_phase(LAS unsigned char* lds, const Gemm g, const Order& S, const Epi& E) {
    const int tid = fresh_tid(), wid = __builtin_amdgcn_readfirstlane(tid >> 6), lane = tid & 63, wr = wid >> 2, wc = wid & 3, fr = lane & 15, fq = lane >> 4;
    const int K = g.K, nt = K / BK;
    unsigned voffA[2], voffB[2];
#pragma unroll
    for (int i = 0; i < 2; ++i) { int R, C; stage_rc(tid * 16 + i * 8192, R, C); const int Rb = (R & ~31) + perm32(R & 31);
        voffA[i] = (unsigned)(R * g.lda + C) * 2u; voffB[i] = (unsigned)(Rb * g.ldb + C) * 2u; }
    const size_t kstep = (size_t)(BK * 2);
    const size_t hstepA = (size_t)HALF * g.lda * 2, hstepB = (size_t)HALF * g.ldb * 2;
    const size_t tstepA = 2 * hstepA, tstepB = 2 * hstepB;
    const unsigned ldsw = (unsigned)wid * 1024u;
    const int aoff = lds_byte(wr * 64 + fr, fq * 8), boff = lds_byte(wc * 32 + fr, fq * 8);
#define PG8_SA(b, h) (((b) * 2 + (h)) * HTB)
#define PG8_SB(b, h) ((4 + (b) * 2 + (h)) * HTB)
#define PG8_STAGE(bufoff, gbase, voff) do { _Pragma("unroll") for (int _i = 0; _i < 2; ++_i) \
        __builtin_amdgcn_global_load_lds((const unsigned*)((const char*)(gbase) + (voff)[_i]), (LAS unsigned*)(lds + (bufoff) + ldsw + _i * 8192), 16, 0, 0); } while (0)
#define PG8_LDA(dst, b, h) do { _Pragma("unroll") for (int m = 0; m < 4; ++m) _Pragma("unroll") for (int k = 0; k < 2; ++k) dst[m][k] = *(const LAS bf16x8*)(lds + PG8_SA(b, h) + aoff + m * 2048 + k * 1024); } while (0)
#define PG8_LDB(dst, b, h) do { _Pragma("unroll") for (int n = 0; n < 2; ++n) _Pragma("unroll") for (int k = 0; k < 2; ++k) dst[n][k] = *(const LAS bf16x8*)(lds + PG8_SB(b, h) + boff + n * 2048 + k * 1024); } while (0)
#define PG8_MMA(ai, bj, At, Bt) do { __builtin_amdgcn_s_setprio(1); _Pragma("unroll") for (int m = 0; m < 4; ++m) _Pragma("unroll") for (int n = 0; n < 2; ++n) _Pragma("unroll") for (int k = 0; k < 2; ++k) \
        acc[ai][bj][m][n] = __builtin_amdgcn_mfma_f32_16x16x32_bf16(Bt[n][k], At[m][k], acc[ai][bj][m][n], 0, 0, 0); __builtin_amdgcn_s_setprio(0); } while (0)
#define PG8_WAIT_V(n) asm volatile("s_waitcnt vmcnt(" #n ")" ::: "memory")
#define PG8_WAIT_L(n) asm volatile("s_waitcnt lgkmcnt(" #n ")" ::: "memory")
#define PG8_BAR __builtin_amdgcn_s_barrier()
#define PG8_SCHED __builtin_amdgcn_sched_barrier(0)
#define PG8_OFFA(u) ((size_t)(((u).pb >> 2) * g.sAb + ((u).pb & 3) * g.sAh) * 2 + (size_t)(u).pm * tstepA)
#define PG8_OFFB(u) ((size_t)(((u).pb >> 2) * g.sBb + ((u).pb & 3) * g.sBh) * 2 + (size_t)(u).pn * tstepB)
    Unit cur, nxt; int ui = 0;
    if (!S.next(0, cur)) return;
    Acc acc;
#pragma unroll
    for (int a = 0; a < 2; ++a)
#pragma unroll
        for (int b = 0; b < 2; ++b)
#pragma unroll
            for (int m = 0; m < 4; ++m)
#pragma unroll
                for (int n = 0; n < 2; ++n) acc[a][b][m][n] = (f32x4){0.f, 0.f, 0.f, 0.f};
    bf16x8 At[4][2], B0[2][2], B1[2][2];
    const char* cA = (const char*)g.A + PG8_OFFA(cur); const char* cB = (const char*)g.Bt + PG8_OFFB(cur);
    {
        PG8_STAGE(PG8_SB(0, 0), cB, voffB); PG8_STAGE(PG8_SB(0, 1), cB + hstepB, voffB); PG8_STAGE(PG8_SA(0, 0), cA, voffA); PG8_STAGE(PG8_SA(0, 1), cA + hstepA, voffA);
        if (wr == 1) PG8_BAR;
        PG8_WAIT_V(2); PG8_BAR;
        PG8_STAGE(PG8_SB(1, 0), cB + kstep, voffB); PG8_STAGE(PG8_SA(1, 0), cA + kstep, voffA); PG8_STAGE(PG8_SB(1, 1), cB + hstepB + kstep, voffB);
        PG8_WAIT_V(6); PG8_BAR;
    }
    for (;;) {
        const bool has_next = S.next(ui + 1, nxt);
        const char* nA = has_next ? (const char*)g.A + PG8_OFFA(nxt) : cA; const char* nB = has_next ? (const char*)g.Bt + PG8_OFFB(nxt) : cB;
        for (int t = 0; t < nt; t += 2) {
            const bool last = (t == nt - 2);
            const char* a1 = cA + (size_t)(t + 1) * kstep;
            const char* a2 = last ? nA : cA + (size_t)(t + 2) * kstep; const char* b2 = last ? nB : cB + (size_t)(t + 2) * kstep;
            const char* a3 = a2 + kstep; const char* b3 = b2 + kstep;
            PG8_LDB(B0, 0, 0); PG8_LDB(B1, 0, 1); PG8_SCHED; PG8_LDA(At, 0, 0); PG8_STAGE(PG8_SA(1, 1), a1 + hstepA, voffA);
            PG8_WAIT_V(8); PG8_WAIT_L(0); PG8_BAR; PG8_MMA(0, 0, At, B0); PG8_MMA(0, 1, At, B1); PG8_BAR; PG8_SCHED;
            PG8_LDA(At, 0, 1); PG8_STAGE(PG8_SB(0, 0), b2, voffB); PG8_STAGE(PG8_SB(0, 1), b2 + hstepB, voffB); PG8_STAGE(PG8_SA(0, 0), a2, voffA);
            PG8_WAIT_V(8); PG8_WAIT_L(0); PG8_BAR; PG8_MMA(1, 0, At, B0); PG8_MMA(1, 1, At, B1); PG8_BAR; PG8_SCHED;
            PG8_LDB(B0, 1, 0); PG8_LDB(B1, 1, 1); PG8_SCHED; PG8_LDA(At, 1, 0); PG8_STAGE(PG8_SA(0, 1), a2 + hstepA, voffA);
            PG8_WAIT_V(8); PG8_WAIT_L(0); PG8_BAR; PG8_MMA(0, 0, At, B0); PG8_MMA(0, 1, At, B1); PG8_BAR; PG8_SCHED;
            PG8_LDA(At, 1, 1); PG8_STAGE(PG8_SB(1, 0), b3, voffB); PG8_STAGE(PG8_SB(1, 1), b3 + hstepB, voffB); PG8_STAGE(PG8_SA(1, 0), a3, voffA);
            PG8_WAIT_V(8); PG8_WAIT_L(0); PG8_BAR; PG8_MMA(1, 0, At, B0); PG8_MMA(1, 1, At, B1); PG8_BAR; PG8_SCHED;
        }
        if constexpr (ALIGN_EPI) { if (wr == 0) PG8_BAR; }
        if constexpr (!Epi::AFTER_DRAIN) { E(acc, cur, wr, wc, fr, fq); }
        if (!has_next) break;
#pragma unroll
        for (int a = 0; a < 2; ++a)
#pragma unroll
            for (int b = 0; b < 2; ++b)
#pragma unroll
                for (int m = 0; m < 4; ++m)
#pragma unroll
                    for (int n = 0; n < 2; ++n) acc[a][b][m][n] = (f32x4){0.f, 0.f, 0.f, 0.f};
        cur = nxt; cA = nA; cB = nB; ++ui;
        if constexpr (ALIGN_EPI) { if (wr == 1) PG8_BAR; }
    }
    PG8_WAIT_V(0);
    if constexpr (!ALIGN_EPI) { if (wr == 0) PG8_BAR; }
    PG8_BAR;
    if constexpr (Epi::AFTER_DRAIN) { E.fused(acc, cur, wr, wc, fr, fq, lds, wid, lane); }
#undef PG8_SA
#undef PG8_SB
#undef PG8_STAGE
#undef PG8_LDA
#undef PG8_LDB
#undef PG8_MMA
#undef PG8_WAIT_V
#undef PG8_WAIT_L
#undef PG8_BAR
#undef PG8_SCHED
#undef PG8_OFFA
#undef PG8_OFFB
}

struct EpiGU {
    static constexpr bool AFTER_DRAIN = false;
    bf16_t* H; const float* ss;
    __device__ __forceinline__ void operator()(const Acc& acc, const Unit& u, int wr, int wc, int fr, int fq) const {
        const int row0 = u.pm * BM + wr * 64 + fr, col0 = u.pn * 128 + wc * 32 + fq * 8;
#pragma unroll
        for (int ai = 0; ai < 2; ++ai)
#pragma unroll
            for (int m = 0; m < 4; ++m) {
                const int row = row0 + ai * HALF + m * 16; const float rs = rstd_of(ss[row]);
                f32x4 h[2];
#pragma unroll
                for (int n = 0; n < 2; ++n) { const f32x4 gg = acc[ai][0][m][n] * rs, uu = acc[ai][1][m][n] * rs;
#pragma unroll
                    for (int j = 0; j < 4; ++j) h[n][j] = gg[j] * sigmoidf_(gg[j]) * uu[j]; }
                *(u32x4*)(H + (size_t)row * FF + col0) = pack8(h[0], h[1]);
            }
    }
};
template <bool WRITE_XB, bool WRITE_SS> struct EpiRes {
    static constexpr bool AFTER_DRAIN = false;
    const float* base; float* out; bf16_t* xb; float* ss; float scale;
    __device__ __forceinline__ void operator()(const Acc& acc, const Unit& u, int wr, int wc, int fr, int fq) const {
        const int row0 = u.pm * BM + wr * 64 + fr, col0 = u.pn * BM + wc * 32 + fq * 8;
#pragma unroll
        for (int ai = 0; ai < 2; ++ai)
#pragma unroll
            for (int m = 0; m < 4; ++m) {
                const int row = row0 + ai * HALF + m * 16; float sq = 0.f;
#pragma unroll
                for (int bj = 0; bj < 2; ++bj) { const size_t p = (size_t)row * DM + col0 + bj * HALF;
                    const f32x4 o0 = *(const f32x4*)(base + p), o1 = *(const f32x4*)(base + p + 4);
                    const f32x4 n0 = o0 + acc[ai][bj][m][0] * scale, n1 = o1 + acc[ai][bj][m][1] * scale;
                    *(f32x4*)(out + p) = n0; *(f32x4*)(out + p + 4) = n1;
                    if (WRITE_XB) *(u32x4*)(xb + p) = pack8(n0, n1);
                    if (WRITE_SS) sq += (n0[0] * n0[0] + n0[1] * n0[1]) + (n0[2] * n0[2] + n0[3] * n0[3]) + (n1[0] * n1[0] + n1[1] * n1[1]) + (n1[2] * n1[2] + n1[3] * n1[3]); }
                if (WRITE_SS) { sq += __shfl_xor(sq, 16); sq += __shfl_xor(sq, 32); if (fq == 0) unsafeAtomicAdd(ss + row, sq); }
                asm volatile("" ::: "memory");
            }
    }
};
struct EpiQKV {
    static constexpr bool AFTER_DRAIN = false;
    bf16_t *QN, *KVN, *QF, *KVF, *GAB; float* F32S; const float* ss;
    __device__ __forceinline__ void operator()(const Acc& acc, const Unit& u, int wr, int wc, int fr, int fq) const {
        const int row0 = u.pm * BM + wr * 64 + fr, pn = u.pn;
        if (pn == 19) {
            if (wc == 0) {
#pragma unroll
                for (int ai = 0; ai < 2; ++ai)
#pragma unroll
                    for (int m = 0; m < 4; ++m) { const int row = row0 + ai * HALF + m * 16; const float rs = rstd_of(ss[row]);
                        *(f32x4*)(F32S + (size_t)row * 32 + fq * 8) = acc[ai][0][m][0] * rs; *(f32x4*)(F32S + (size_t)row * 32 + fq * 8 + 4) = acc[ai][0][m][1] * rs; }
            }
            return;
        }
        bf16_t* dst; int pitch, coff;
        if (pn < 2) { dst = QN; pitch = 512; coff = pn * 256; }
        else if (pn < 5) { dst = KVN; pitch = 768; coff = (pn - 2) * 256; }
        else if (pn < 7) { dst = QF; pitch = 512; coff = (pn - 5) * 256; }
        else if (pn < 11) { dst = KVF; pitch = 1024; coff = (pn - 7) * 256; }
        else { dst = GAB; pitch = 2048; coff = (pn - 11) * 256; }
        coff += wc * 32 + fq * 8;
#pragma unroll
        for (int ai = 0; ai < 2; ++ai)
#pragma unroll
            for (int m = 0; m < 4; ++m) { const int row = row0 + ai * HALF + m * 16; const float rs = rstd_of(ss[row]);
#pragma unroll
                for (int bj = 0; bj < 2; ++bj) *(u32x4*)(dst + (size_t)row * pitch + coff + bj * HALF) = pack8(acc[ai][bj][m][0] * rs, acc[ai][bj][m][1] * rs); }
    }
};
template <int STEP> struct EpiUp {
    static constexpr bool AFTER_DRAIN = false;
    const bf16_t* GAB; bf16_t* Y;
    __device__ __forceinline__ void operator()(const Acc& acc, const Unit& u, int wr, int wc, int fr, int fq) const {
        const int row0 = u.pm * BM + wr * 64 + fr, col0 = u.pn * BM + wc * 32 + fq * 8;
#pragma unroll
        for (int ai = 0; ai < 2; ++ai)
#pragma unroll
            for (int m = 0; m < 4; ++m) { const int row = row0 + ai * HALF + m * 16;
#pragma unroll
                for (int bj = 0; bj < 2; ++bj) { const int c = col0 + bj * HALF;
                    const u32x4 gw = *(const u32x4*)(GAB + (size_t)row * 2048 + STEP * 1024 + c);
                    f32x4 v0, v1; const f32x4 a0 = acc[ai][bj][m][0], a1 = acc[ai][bj][m][1];
                    v0[0] = sigmoidf_(bflo(gw.x)) * a0[0]; v0[1] = sigmoidf_(bfhi(gw.x)) * a0[1]; v0[2] = sigmoidf_(bflo(gw.y)) * a0[2]; v0[3] = sigmoidf_(bfhi(gw.y)) * a0[3];
                    v1[0] = sigmoidf_(bflo(gw.z)) * a1[0]; v1[1] = sigmoidf_(bfhi(gw.z)) * a1[1]; v1[2] = sigmoidf_(bflo(gw.w)) * a1[2]; v1[3] = sigmoidf_(bfhi(gw.w)) * a1[3];
                    bf16_t* yp = Y + (size_t)row * DM + c;
                    if (STEP == 1) { const u32x4 y = *(const u32x4*)yp;
                        v0[0] += bflo(y.x); v0[1] += bfhi(y.x); v0[2] += bflo(y.y); v0[3] += bfhi(y.y); v1[0] += bflo(y.z); v1[1] += bfhi(y.z); v1[2] += bflo(y.w); v1[3] += bfhi(y.w); }
                    *(u32x4*)yp = pack8(v0, v1); }
                asm volatile("" ::: "memory"); }
    }
};
struct EpiRowScale {
    static constexpr bool AFTER_DRAIN = false;
    bf16_t* O; int ldo; const float* ss;
    __device__ __forceinline__ void operator()(const Acc& acc, const Unit& u, int wr, int wc, int fr, int fq) const {
        const int row0 = u.pm * BM + wr * 64 + fr, col0 = u.pn * BM + wc * 32 + fq * 8;
#pragma unroll
        for (int ai = 0; ai < 2; ++ai)
#pragma unroll
            for (int m = 0; m < 4; ++m) { const int row = row0 + ai * HALF + m * 16; const float rs = rstd_of(ss[row]);
#pragma unroll
                for (int bj = 0; bj < 2; ++bj) *(u32x4*)(O + (size_t)row * ldo + col0 + bj * HALF) = pack8(acc[ai][bj][m][0] * rs, acc[ai][bj][m][1] * rs); }
    }
};
struct EpiColScale {
    static constexpr bool AFTER_DRAIN = false;
    bf16_t* O; int ldo; const float* ss;
    __device__ __forceinline__ void operator()(const Acc& acc, const Unit& u, int wr, int wc, int fr, int fq) const {
        const int row0 = u.pm * BM + wr * 64 + fr, col0 = u.pn * BM + wc * 32 + fq * 8;
#pragma unroll
        for (int bj = 0; bj < 2; ++bj) { const int c = col0 + bj * HALF;
            f32x4 s0 = *(const f32x4*)(ss + c), s1 = *(const f32x4*)(ss + c + 4);
#pragma unroll
            for (int j = 0; j < 4; ++j) { s0[j] = rstd_of(s0[j]); s1[j] = rstd_of(s1[j]); }
#pragma unroll
            for (int ai = 0; ai < 2; ++ai)
#pragma unroll
                for (int m = 0; m < 4; ++m) { const int row = row0 + ai * HALF + m * 16;
                    *(u32x4*)(O + (size_t)row * ldo + c) = pack8(acc[ai][bj][m][0] * s0, acc[ai][bj][m][1] * s1); } }
    }
};
struct EpiBatchBf16 {
    static constexpr bool AFTER_DRAIN = false;
    bf16_t* O; int ldo; long sOb, sOh;
    __device__ __forceinline__ void operator()(const Acc& acc, const Unit& u, int wr, int wc, int fr, int fq) const {
        const int row0 = u.pm * BM + wr * 64 + fr, col0 = u.pn * BM + wc * 32 + fq * 8;
        bf16_t* Ob = O + (size_t)((u.pb >> 2) * sOb + (u.pb & 3) * sOh);
#pragma unroll
        for (int ai = 0; ai < 2; ++ai)
#pragma unroll
            for (int m = 0; m < 4; ++m) { const int row = row0 + ai * HALF + m * 16;
#pragma unroll
                for (int bj = 0; bj < 2; ++bj) *(u32x4*)(Ob + (size_t)row * ldo + col0 + bj * HALF) = pack8(acc[ai][bj][m][0], acc[ai][bj][m][1]); }
    }
};
struct EpiSoftmax {
    static constexpr bool AFTER_DRAIN = true;
    bf16_t* P;
    __device__ __forceinline__ void fused(Acc& acc, const Unit& u, int wr, int wc, int fr, int fq, LAS unsigned char* lds, int wid, int lane) const {
        LAS float* Pm = (LAS float*)lds;
        LAS float* Ps = (LAS float*)(lds + 8192);
#pragma unroll
        for (int ai = 0; ai < 2; ++ai)
#pragma unroll
            for (int m = 0; m < 4; ++m) { float mx = -3.0e38f;
#pragma unroll
                for (int bj = 0; bj < 2; ++bj)
#pragma unroll
                    for (int n = 0; n < 2; ++n) { const f32x4 x = acc[ai][bj][m][n]; mx = fmaxf(mx, fmaxf(fmaxf(x[0], x[1]), fmaxf(x[2], x[3]))); }
                mx = fmaxf(mx, __shfl_xor(mx, 16)); mx = fmaxf(mx, __shfl_xor(mx, 32));
                if (fq == 0) Pm[(ai * HALF + wr * 64 + m * 16 + fr) * 4 + wc] = mx; }
        __syncthreads();
#pragma unroll
        for (int ai = 0; ai < 2; ++ai)
#pragma unroll
            for (int m = 0; m < 4; ++m) { const int r = ai * HALF + wr * 64 + m * 16 + fr; const f32x4 t = *(const LAS f32x4*)(Pm + r * 4);
                const float mx = fmaxf(fmaxf(t[0], t[1]), fmaxf(t[2], t[3])); float s = 0.f;
#pragma unroll
                for (int bj = 0; bj < 2; ++bj)
#pragma unroll
                    for (int n = 0; n < 2; ++n) { f32x4 x = acc[ai][bj][m][n];
#pragma unroll
                        for (int j = 0; j < 4; ++j) { x[j] = fexp2(x[j] - mx); s += x[j]; }
                        acc[ai][bj][m][n] = x; }
                s += __shfl_xor(s, 16); s += __shfl_xor(s, 32);
                if (fq == 0) Ps[r * 4 + wc] = s; }
        __syncthreads();
        bf16_t* Pb = P + (size_t)u.pb * SEQ * 256;
        const int col0 = wc * 32 + fq * 8;
#pragma unroll
        for (int ai = 0; ai < 2; ++ai)
#pragma unroll
            for (int m = 0; m < 4; ++m) { const int r = ai * HALF + wr * 64 + m * 16 + fr; const f32x4 t = *(const LAS f32x4*)(Ps + r * 4);
                const float inv = 1.0f / ((t[0] + t[1]) + (t[2] + t[3])); const int row = u.pm * BM + r;
#pragma unroll
                for (int bj = 0; bj < 2; ++bj) *(u32x4*)(Pb + (size_t)row * 256 + col0 + bj * HALF) = pack8(acc[ai][bj][m][0] * inv, acc[ai][bj][m][1] * inv); }
        __syncthreads();
    }
};
}
namespace att {
__device__ __forceinline__ int crow(int r, int hi) { return (r & 3) + 8 * (r >> 2) + 4 * hi; }
#define SBAR() __builtin_amdgcn_sched_barrier(0)
constexpr float NEG = -INFINITY;
constexpr int L_SLOT = 0;
constexpr int L_WSF = 32768;
constexpr int L_OST = L_WSF + 2048;
constexpr int L_TBL = L_OST + 32768;
constexpr int L_CB = L_TBL + 4096;
constexpr int L_PS = L_CB + 8192;
constexpr int L_IMP = L_PS + 64 * 129 * 4;
constexpr int L_MISC = L_IMP + 64 * 33 * 4;
constexpr int L_END = L_MISC + 64;
static_assert(L_END <= 131072, "attention LDS map");

__device__ __forceinline__ void qkt(f32x16& p0, f32x16& p1, const LAS unsigned char* Kslot, const bf16x8 (&qr)[4], int r32, int hi) {
    const LAS unsigned char* kb = Kslot + hi * 1024 + r32 * 16;
    p0 = f32x16{}; p1 = f32x16{};
#pragma unroll
    for (int d0 = 0; d0 < 4; ++d0) {
        const bf16x8 b0 = *(const LAS bf16x8*)(kb + d0 * 2048);
        const bf16x8 b1 = *(const LAS bf16x8*)(kb + d0 * 2048 + 512);
        p0 = __builtin_amdgcn_mfma_f32_32x32x16_bf16(b0, qr[d0], p0, 0, 0, 0);
        p1 = __builtin_amdgcn_mfma_f32_32x32x16_bf16(b1, qr[d0], p1, 0, 0, 0);
    }
}
__device__ __forceinline__ void pv(f32x16 (&o)[2], int vb, bf16x8 pa0, bf16x8 pa1, bf16x8 pa2, bf16x8 pa3) {
#pragma unroll
    for (int d0 = 0; d0 < 2; ++d0) { s16x4 lo[4], hi[4];
#pragma unroll
        for (int ks = 0; ks < 4; ++ks) {
            asm volatile("ds_read_b64_tr_b16 %0,%1 offset:%c2" : "=&v"(lo[ks]) : "v"(vb), "i"(d0 * 4096 + ks * 1024) : "memory");
            asm volatile("ds_read_b64_tr_b16 %0,%1 offset:%c2" : "=&v"(hi[ks]) : "v"(vb), "i"(d0 * 4096 + ks * 1024 + 512) : "memory"); }
        asm volatile("s_waitcnt lgkmcnt(0)" ::: "memory"); SBAR();
#define PK(k) (bf16x8){lo[k][0], lo[k][1], lo[k][2], lo[k][3], hi[k][0], hi[k][1], hi[k][2], hi[k][3]}
        o[d0] = __builtin_amdgcn_mfma_f32_32x32x16_bf16(pa0, PK(0), o[d0], 0, 0, 0);
        o[d0] = __builtin_amdgcn_mfma_f32_32x32x16_bf16(pa1, PK(1), o[d0], 0, 0, 0);
        o[d0] = __builtin_amdgcn_mfma_f32_32x32x16_bf16(pa2, PK(2), o[d0], 0, 0, 0);
        o[d0] = __builtin_amdgcn_mfma_f32_32x32x16_bf16(pa3, PK(3), o[d0], 0, 0, 0);
#undef PK
    }
}
__device__ __forceinline__ float rowmax32(const f32x16& p0, const f32x16& p1) {
    float a = fmaxf(p0[0], p1[0]);
#pragma unroll
    for (int r = 1; r < 16; ++r) a = fmaxf(a, fmaxf(p0[r], p1[r]));
    auto rr = __builtin_amdgcn_permlane32_swap(__float_as_uint(a), __float_as_uint(a), false, false);
    return fmaxf(__uint_as_float(rr[0]), __uint_as_float(rr[1]));
}
__device__ __forceinline__ float halfsum(float v) {
    auto rr = __builtin_amdgcn_permlane32_swap(__float_as_uint(v), __float_as_uint(v), false, false);
    return __uint_as_float(rr[0]) + __uint_as_float(rr[1]);
}
#define PKW(P, B) cvtpk(P[B], P[B + 1])
__device__ __forceinline__ void pack_p(const f32x16& p0, const f32x16& p1, bf16x8& a0, bf16x8& a1, bf16x8& a2, bf16x8& a3) {
    const u32x4 w0 = {PKW(p0, 0), PKW(p0, 2), PKW(p0, 4), PKW(p0, 6)}, w1 = {PKW(p0, 8), PKW(p0, 10), PKW(p0, 12), PKW(p0, 14)};
    const u32x4 w2 = {PKW(p1, 0), PKW(p1, 2), PKW(p1, 4), PKW(p1, 6)}, w3 = {PKW(p1, 8), PKW(p1, 10), PKW(p1, 12), PKW(p1, 14)};
    a0 = __builtin_bit_cast(bf16x8, w0); a1 = __builtin_bit_cast(bf16x8, w1); a2 = __builtin_bit_cast(bf16x8, w2); a3 = __builtin_bit_cast(bf16x8, w3);
}
#undef PKW
__device__ __forceinline__ void scale_rows(f32x16 (&o)[2], LAS float* wsf, float v, int r32, int hi) {
    if (hi == 0) wsf[r32] = v;
    asm volatile("s_waitcnt lgkmcnt(0)" ::: "memory");
#pragma unroll
    for (int i = 0; i < 4; ++i) { const f32x4 f = *(const LAS f32x4*)(wsf + 8 * i + 4 * hi);
#pragma unroll
        for (int j = 0; j < 4; ++j) { o[0][4 * i + j] *= f[j]; o[1][4 * i + j] *= f[j]; } }
    asm volatile("s_waitcnt lgkmcnt(0)" ::: "memory");
}
struct StageGeo { int krow, kcol, koff, vrow, vcol, voff; };
__device__ __forceinline__ StageGeo stage_geo(int tid) {
    StageGeo s; const int w = tid >> 6, ln = tid & 63;
    s.krow = ln; s.kcol = w * 8; s.koff = w * 1024 + ln * 16;
    s.vrow = 16 * (w & 3) + (ln >> 2); s.vcol = (w >> 2) * 32 + (ln & 3) * 8; s.voff = 8192 + w * 1024 + ln * 16;
    return s;
}
template <class Mod>
__device__ __forceinline__ void tile_step(const LAS unsigned char* slot, const bf16x8 (&qr)[4], f32x16 (&o)[2], float& m, float& l, LAS float* wsf, const Mod& mod, int r32, int hi, int vb) {
    f32x16 p0, p1;
    qkt(p0, p1, slot, qr, r32, hi);
    mod(p0, p1);
    const float rm = rowmax32(p0, p1);
    const float mn = fmaxf(m, rm);
    const float alpha = fexp2(m - mn);
    const bool need = __any(mn > m);
    m = mn;
    float s = 0.f;
#pragma unroll
    for (int r = 0; r < 16; ++r) { p0[r] = fexp2(p0[r] - mn); p1[r] = fexp2(p1[r] - mn); s += p0[r] + p1[r]; }
    l = l * alpha + s;
    if (need) scale_rows(o, wsf, alpha, r32, hi);
    bf16x8 a0, a1, a2, a3; pack_p(p0, p1, a0, a1, a2, a3);
    pv(o, vb, a0, a1, a2, a3);
}
template <class ModF>
__device__ __forceinline__ void attn_loop(unsigned tmask, const bf16_t* Kg, int pitchK, const bf16_t* Vg, int pitchV, LAS unsigned char* lds, const bf16x8 (&qr)[4],
                                          f32x16 (&o)[2], float& m, float& l, const ModF& modf, int wave_last_row) {
    const int tid = fresh_tid(), lane = tid & 63, r32 = lane & 31, hi = lane >> 5, wid = tid >> 6;
    const StageGeo sg = stage_geo(tid);
    LAS float* wsf = (LAS float*)(lds + L_WSF) + wid * 64;
    const int vb0 = (int)(unsigned)(size_t)(lds + L_SLOT + 8192) + ((lane >> 4) & 1) * 32 + (lane & 3) * 8 + (4 * hi + ((lane & 15) >> 2)) * 64;
    int kt = 31 - __clz((int)tmask);
    u32x4 kreg = *(const u32x4*)(Kg + (size_t)(kt * 64 + sg.krow) * pitchK + sg.kcol);
    u32x4 vreg = *(const u32x4*)(Vg + (size_t)(kt * 64 + sg.vrow) * pitchV + sg.vcol);
    *(LAS u32x4*)(lds + L_SLOT + sg.koff) = kreg; *(LAS u32x4*)(lds + L_SLOT + sg.voff) = vreg;
    __syncthreads();
    int s = 0;
    for (;;) {
        tmask &= ~(1u << kt);
        const int nk = tmask ? 31 - __clz((int)tmask) : -1;
        if (nk >= 0) { kreg = *(const u32x4*)(Kg + (size_t)(nk * 64 + sg.krow) * pitchK + sg.kcol); vreg = *(const u32x4*)(Vg + (size_t)(nk * 64 + sg.vrow) * pitchV + sg.vcol); }
        if (kt * 64 <= wave_last_row) tile_step(lds + L_SLOT + s * 16384, qr, o, m, l, wsf, modf(kt), r32, hi, vb0 + s * 16384);
        if (nk >= 0) { *(LAS u32x4*)(lds + L_SLOT + (s ^ 1) * 16384 + sg.koff) = kreg; *(LAS u32x4*)(lds + L_SLOT + (s ^ 1) * 16384 + sg.voff) = vreg; }
        __syncthreads();
        if (nk < 0) break;
        kt = nk; s ^= 1;
    }
}
template <bool ADD>
__device__ __forceinline__ void store_o(const f32x16 (&o)[2], LAS unsigned char* lds, bf16_t* dst, int pitch, const bf16_t* addsrc, int addpitch) {
    const int tid = fresh_tid(), lane = tid & 63, r32 = lane & 31, hi = lane >> 5, wid = tid >> 6;
    LAS bf16_t* stg = (LAS bf16_t*)(lds + L_OST) + wid * 2048;
#pragma unroll
    for (int r = 0; r < 16; ++r) { const int orow = crow(r, hi);
#pragma unroll
        for (int d0 = 0; d0 < 2; ++d0) stg[orow * 64 + d0 * 32 + r32] = (bf16_t)(cvtpk(o[d0][r], 0.f) & 0xffffu); }
    asm volatile("s_waitcnt lgkmcnt(0)" ::: "memory");
#pragma unroll
    for (int i = 0; i < 4; ++i) { const int row = i * 8 + (lane >> 3), ch = lane & 7;
        u32x4 v = *(const LAS u32x4*)(stg + row * 64 + ch * 8);
        if (ADD) { const u32x4 a = *(const u32x4*)(addsrc + (size_t)row * addpitch + ch * 8);
            v.x = cvtpk(bflo(v.x) + bflo(a.x), bfhi(v.x) + bfhi(a.x)); v.y = cvtpk(bflo(v.y) + bflo(a.y), bfhi(v.y) + bfhi(a.y));
            v.z = cvtpk(bflo(v.z) + bflo(a.z), bfhi(v.z) + bfhi(a.z)); v.w = cvtpk(bflo(v.w) + bflo(a.w), bfhi(v.w) + bfhi(a.w)); }
        *(u32x4*)(dst + (size_t)row * pitch + ch * 8) = v; }
    asm volatile("s_waitcnt lgkmcnt(0)" ::: "memory");
}
__device__ __forceinline__ void load_q(bf16x8 (&qr)[4], const bf16_t* Qw, int pitch, int r32, int hi) {
#pragma unroll
    for (int d0 = 0; d0 < 4; ++d0) qr[d0] = *(const bf16x8*)(Qw + (size_t)r32 * pitch + d0 * 16 + hi * 8);
}

struct ModFox { const LAS float* cb; int kbase, qpos, hi; bool diag;
    __device__ __forceinline__ void operator()(f32x16& p0, f32x16& p1) const {
#pragma unroll
        for (int i = 0; i < 4; ++i) { const f32x4 c0 = *(const LAS f32x4*)(cb + kbase + 8 * i + 4 * hi), c1 = *(const LAS f32x4*)(cb + kbase + 32 + 8 * i + 4 * hi);
#pragma unroll
            for (int j = 0; j < 4; ++j) { p0[4 * i + j] += c0[j]; p1[4 * i + j] += c1[j]; } }
        if (diag) {
#pragma unroll
            for (int r = 0; r < 16; ++r) { const int kv = kbase + crow(r, hi); if (kv > qpos) p0[r] = NEG; if (kv + 32 > qpos) p1[r] = NEG; } }
    } };
struct ModFoxF { const LAS float* cb; int qpos, hi, q0w;
    __device__ __forceinline__ ModFox operator()(int kt) const { return ModFox{cb, kt * 64, qpos, hi, kt * 64 + 63 > q0w}; } };
struct ModT5 { const LAS float* tb; int kbase, qpos, hi, window; bool enabled;
    __device__ __forceinline__ void operator()(f32x16& p0, f32x16& p1) const {
#pragma unroll
        for (int r = 0; r < 16; ++r) { const int d0 = qpos - (kbase + crow(r, hi)), d1 = d0 - 32;
            const float b0 = tb[min(max(d0, 0), 127)], b1 = tb[min(max(d1, 0), 127)];
            p0[r] = (enabled && d0 >= 0 && d0 < window) ? p0[r] + b0 : NEG;
            p1[r] = (enabled && d1 >= 0 && d1 < window) ? p1[r] + b1 : NEG; }
    } };
struct ModWinF { const LAS float* tb; int qpos, hi;
    __device__ __forceinline__ ModT5 operator()(int kt) const { return ModT5{tb, kt * 64, qpos, hi, 512, true}; } };
struct ModSelF { const LAS float* tb; int qpos, hi; unsigned mask;
    __device__ __forceinline__ ModT5 operator()(int kt) const { return ModT5{tb, kt * 64, qpos, hi, 1 << 30, ((mask >> kt) & 1u) != 0u}; } };
}
#ifndef STAGE_LIMIT
#define STAGE_LIMIT 4
#endif
constexpr size_t MiB = 1u << 20;
constexpr size_t WS_CTL = 0, CTL_ZERO_BYTES = 2 * MiB;
constexpr size_t WS_SS = 256 * 1024;
constexpr size_t WS_SSM = 640 * 1024;
constexpr size_t WS_F32S = 2 * MiB;
constexpr size_t WS_CUM = 4 * MiB;
constexpr size_t WS_MASK = 4 * MiB + 512 * 1024;
constexpr size_t WS_UMASK = WS_MASK + 128 * 1024;
constexpr size_t WS_KC = 5 * MiB, WS_VC = 5 * MiB + 256 * 1024;
constexpr size_t WS_POSC = 5 * MiB + 512 * 1024;
constexpr size_t WS_WGU1 = 8 * MiB, WS_WD1 = 19 * MiB, WS_WIN = 25 * MiB, WS_WUPN = 35 * MiB, WS_WUPF = 36 * MiB, WS_WOUT = 37 * MiB, WS_WMQ = 39 * MiB,
                 WS_WMKV = 41 * MiB, WS_WMO = 45 * MiB, WS_WGU2 = 47 * MiB, WS_WD2 = 58 * MiB, WS_CW1K = 64 * MiB, WS_CW1V = 65 * MiB, WS_CW2K = 66 * MiB, WS_CW2V = 66 * MiB + 256 * 1024;
constexpr size_t WS_KM = 8 * MiB, WS_VT = 12 * MiB;
constexpr size_t WS_XB = 68 * MiB;
constexpr size_t WS_QN = 100 * MiB, WS_KVN = 116 * MiB, WS_QF = 140 * MiB, WS_KVF = 156 * MiB, WS_GAB = 188 * MiB;
constexpr size_t WS_H = 100 * MiB;
constexpr size_t WS_Y = WS_KVF;
constexpr size_t WS_QM = 108 * MiB, WS_PM = 188 * MiB, WS_OM = 140 * MiB;
constexpr size_t WS_MEMB = 252 * MiB, WS_END = 256 * MiB;
static_assert(WS_WD2 + (size_t)DM * FF * 2 <= WS_CW1K && WS_GAB + (size_t)M * 2048 * 2 <= WS_MEMB && WS_H + (size_t)M * FF * 2 <= WS_GAB, "ws map");
constexpr int CW_BAR = 4096;
constexpr int RING_BYTES = 131072, LDS_BYTES = 147456;

__device__ const unsigned char T5B[128] = {0, 1, 2, 3, 4, 5, 6, 7, 8, 9, 10, 11, 12, 13, 14, 15, 16, 16, 16, 17, 17, 18, 18, 18, 19, 19, 19, 20, 20, 20, 20, 21, 21, 21, 21, 22, 22, 22, 22, 22, 23, 23, 23, 23, 23, 23, 24, 24, 24, 24, 24, 24, 25, 25, 25, 25, 25, 25, 25, 26, 26, 26, 26, 26, 26, 26, 26, 27, 27, 27, 27, 27, 27, 27, 27, 27, 27, 28, 28, 28, 28, 28, 28, 28, 28, 28, 28, 29, 29, 29, 29, 29, 29, 29, 29, 29, 29, 29, 29, 30, 30, 30, 30, 30, 30, 30, 30, 30, 30, 30, 30, 30, 30, 31, 31, 31, 31, 31, 31, 31, 31, 31, 31, 31, 31, 31, 31, 31};

struct Args { const float* in[29]; float* out; unsigned char* ws; int lo, hi; };
enum { I_X = 0, I_MEM, I_RELB, I_F1N, I_F1G, I_F1U, I_F1D, I_MIXN, I_WIN, I_BF, I_POSK, I_POSV, I_CK1, I_CK2, I_CV1, I_CV2, I_UPN, I_UPF, I_WOUT, I_MQN, I_MKVN, I_MWQ, I_MWKV, I_MWO, I_F2N, I_F2G, I_F2U, I_F2D, I_FINN };

__device__ __forceinline__ float wave_sum(float v) {
#pragma unroll
    for (int o = 1; o < 64; o <<= 1) v += __shfl_xor(v, o);
    return v;
}
template <class CM>
__device__ __forceinline__ void tr_item(const float* W, int ldsrc, int K, bf16_t* WT, int k0, int dstrow0, const float* gain, LAS float* scr, int lane, const CM& cm) {
    const int n = lane & 31; int sc; float scl; cm(dstrow0 + n, sc, scl);
#pragma unroll 8
    for (int i = 0; i < 32; ++i) { const int kk = 2 * i + (lane >> 5); float v = 0.f;
        if (sc >= 0) { v = W[(size_t)(k0 + kk) * ldsrc + sc] * scl; if (gain) v *= gain[k0 + kk]; }
        scr[kk * 33 + n] = v; }
    asm volatile("s_waitcnt lgkmcnt(0)" ::: "memory");
    const int c = lane & 7;
#pragma unroll
    for (int j = 0; j < 4; ++j) { const int nn = (lane >> 3) + 8 * j; const LAS float* s = scr + (8 * c) * 33 + nn;
        u32x4 o; o.x = cvtpk(s[0 * 33], s[1 * 33]); o.y = cvtpk(s[2 * 33], s[3 * 33]); o.z = cvtpk(s[4 * 33], s[5 * 33]); o.w = cvtpk(s[6 * 33], s[7 * 33]);
        *(u32x4*)(WT + (size_t)(dstrow0 + nn) * K + k0 + 8 * c) = o; }
    asm volatile("s_waitcnt lgkmcnt(0)" ::: "memory");
}
struct CmPlain { int off; float s; __device__ __forceinline__ void operator()(int n, int& sc, float& scl) const { sc = n + off; scl = s; } };
struct CmWin { __device__ __forceinline__ void operator()(int n, int& sc, float& scl) const {
    scl = 1.f;
    if (n < 512) { sc = n; scl = QS64; }
    else if (n < 1280) sc = n;
    else if (n < 1792) { sc = 1304 + (n - 1280); scl = QS64; }
    else if (n < 2816) sc = 1816 + (n - 1792);
    else if (n < 4864) sc = 2848 + (n - 2816);
    else if (n < 4888) sc = 1280 + (n - 4864);
    else if (n < 4896) sc = 2840 + (n - 4888);
    else sc = -1; } };

__device__ __forceinline__ void p0_prologue(const Args& a, LAS unsigned char* lds, int gw, int NGW, int wave, int lane) {
    unsigned char* ws = a.ws;
    LAS float* scr = (LAS float*)(lds + wave * 16384);
    constexpr int N_GU = 16 * 176, N_D = 44 * 32, N_WIN = 16 * 160, N_UP = 8 * 32, N_SQ = 16 * 32, N_MKV = 16 * 64, N_C1 = 32 * 8, N_C2 = 4 * 2;
    constexpr int NITEMS = 2 * N_GU + 2 * N_D + N_WIN + 2 * N_UP + 3 * N_SQ + N_MKV + 2 * N_C1 + 2 * N_C2;
    for (int it = gw; it < NITEMS; it += NGW) {
        int r = it;
        if (r < 2 * N_GU) { const int f = r >= N_GU; r -= f * N_GU; const int kb = r / 176, gi = r % 176, dr = gi * 32, tile = dr >> 8, within = dr & 255;
            const float* W = a.in[within < 128 ? (f ? I_F2G : I_F1G) : (f ? I_F2U : I_F1U)];
            tr_item(W, FF, DM, (bf16_t*)(ws + (f ? WS_WGU2 : WS_WGU1)), kb * 64, dr, a.in[f ? I_F2N : I_F1N], scr, lane, CmPlain{tile * 128 + (within & 127) - dr, 1.f}); continue; }
        r -= 2 * N_GU;
        if (r < 2 * N_D) { const int f = r >= N_D; r -= f * N_D; const int kb = r / 32, gi = r % 32;
            tr_item(a.in[f ? I_F2D : I_F1D], DM, FF, (bf16_t*)(ws + (f ? WS_WD2 : WS_WD1)), kb * 64, gi * 32, nullptr, scr, lane, CmPlain{0, 1.f}); continue; }
        r -= 2 * N_D;
        if (r < N_WIN) { const int kb = r / 160, gi = r % 160; tr_item(a.in[I_WIN], 4896, DM, (bf16_t*)(ws + WS_WIN), kb * 64, gi * 32, a.in[I_MIXN], scr, lane, CmWin{}); continue; }
        r -= N_WIN;
        if (r < 2 * N_UP) { const int f = r >= N_UP; r -= f * N_UP; const int kb = r / 32, gi = r % 32;
            tr_item(a.in[f ? I_UPF : I_UPN], DM, 512, (bf16_t*)(ws + (f ? WS_WUPF : WS_WUPN)), kb * 64, gi * 32, nullptr, scr, lane, CmPlain{0, 1.f}); continue; }
        r -= 2 * N_UP;
        if (r < 3 * N_SQ) { const int f = r / N_SQ; r -= f * N_SQ; const int kb = r / 32, gi = r % 32;
            tr_item(a.in[f == 0 ? I_WOUT : (f == 1 ? I_MWQ : I_MWO)], DM, DM, (bf16_t*)(ws + (f == 0 ? WS_WOUT : (f == 1 ? WS_WMQ : WS_WMO))), kb * 64, gi * 32, f == 1 ? a.in[I_MQN] : nullptr, scr, lane,
                    CmPlain{0, f == 1 ? QS256 : 1.f}); continue; }
        r -= 3 * N_SQ;
        if (r < N_MKV) { const int kb = r / 64, gi = r % 64; tr_item(a.in[I_MWKV], 2048, DM, (bf16_t*)(ws + WS_WMKV), kb * 64, gi * 32, a.in[I_MKVN], scr, lane, CmPlain{0, 1.f}); continue; }
        r -= N_MKV;
        if (r < 2 * N_C1) { const int f = r >= N_C1; r -= f * N_C1; const int kb = r / 8, gi = r % 8;
            tr_item(a.in[f ? I_CV1 : I_CK1], 256, 2048, (bf16_t*)(ws + (f ? WS_CW1V : WS_CW1K)), kb * 64, gi * 32, nullptr, scr, lane, CmPlain{0, 1.f}); continue; }
        r -= 2 * N_C1;
        { const int f = r >= N_C2; r -= f * N_C2; const int kb = r / 2, gi = r % 2;
            tr_item(a.in[f ? I_CV2 : I_CK2], 64, 256, (bf16_t*)(ws + (f ? WS_CW2V : WS_CW2K)), kb * 64, gi * 32, nullptr, scr, lane, CmPlain{0, 1.f}); }
    }
    for (int mrow = gw; mrow < M + MROWS; mrow += NGW) {
        const bool ismem = mrow >= M; const int rr = ismem ? mrow - M : mrow;
        const f32x4* xr = (const f32x4*)((ismem ? a.in[I_MEM] : a.in[I_X]) + (size_t)rr * DM) + lane;
        unsigned long long* o8 = (unsigned long long*)((bf16_t*)(ws + (ismem ? WS_MEMB : WS_XB)) + (size_t)rr * DM) + lane;
        float s = 0.f;
#pragma unroll
        for (int j = 0; j < 4; ++j) { const f32x4 v = xr[64 * j]; s += (v[0] * v[0] + v[1] * v[1]) + (v[2] * v[2] + v[3] * v[3]);
            o8[64 * j] = (unsigned long long)cvtpk(v[0], v[1]) | ((unsigned long long)cvtpk(v[2], v[3]) << 32); }
        s = wave_sum(s);
        if (lane == 0) ((float*)(ws + (ismem ? WS_SSM : WS_SS)))[rr] = s;
    }
    for (int t = gw; t < 512; t += NGW) { const int kv = t >> 8, n = t & 255; const float* pos = a.in[kv ? I_POSV : I_POSK]; const float* w1 = a.in[kv ? I_CV1 : I_CK1];
        float s = 0.f;
        for (int k = lane; k < 2048; k += 64) s += pos[k] * w1[(size_t)k * 256 + n];
        s = wave_sum(s);
        if (lane == 0) ((float*)(ws + WS_POSC))[t] = s; }
}

__device__ __forceinline__ void compress_unit(const Args& a, LAS unsigned char* lds, int uidx) {
    unsigned char* ws = a.ws;
    const int tid = fresh_tid(), lane = tid & 63, r32 = lane & 31, hi = lane >> 5, wid = __builtin_amdgcn_readfirstlane(tid >> 6);
    const int kv = uidx >> 6, b = (uidx >> 3) & 7, g = (uidx >> 2) & 1, chunk = uidx & 3, n0 = chunk * 32;
    const bf16_t* W1 = (const bf16_t*)(ws + (kv ? WS_CW1V : WS_CW1K)); const bf16_t* W2 = (const bf16_t*)(ws + (kv ? WS_CW2V : WS_CW2K));
    const float* posc = (const float*)(ws + WS_POSC) + kv * 256;
    const bf16_t* arow = (const bf16_t*)(ws + WS_KVN) + (size_t)(b * SEQ) * 768 + kv * 128 + g * 64 + hi * 8;
    const bf16_t* brow = W1 + (size_t)(32 * wid + r32) * 2048 + hi * 8;
    const int tok = 16 * (n0 + r32);
    f32x16 acc = f32x16{};
#pragma unroll 8
    for (int kk = 0; kk < 128; ++kk) { const int l = kk >> 2, d = (kk & 3) * 16; const int t = min(tok + l, SEQ - 1);
        const bf16x8 av = *(const bf16x8*)(arow + (size_t)t * 768 + d); const bf16x8 bv = *(const bf16x8*)(brow + kk * 16);
        acc = __builtin_amdgcn_mfma_f32_32x32x16_bf16(av, bv, acc, 0, 0, 0); }
    LAS bf16_t* Hs = (LAS bf16_t*)lds;
    const float pc = posc[32 * wid + r32];
#pragma unroll
    for (int r = 0; r < 16; ++r) { const float x = acc[r] + pc; const float u = 0.7978845608028654f * (x + 0.044715f * x * x * x);
        const float ge = x * frcp(1.0f + fexp2(-2.0f * LOG2E * u)); Hs[att::crow(r, hi) * 264 + 32 * wid + r32] = (bf16_t)(cvtpk(ge, 0.f) & 0xffffu); }
    __syncthreads();
    if (wid < 2) { f32x16 acc2 = f32x16{};
#pragma unroll
        for (int kk = 0; kk < 16; ++kk) { const bf16x8 av = *(const LAS bf16x8*)(Hs + r32 * 264 + kk * 16 + hi * 8); const bf16x8 bv = *(const bf16x8*)(W2 + (size_t)(32 * wid + r32) * 256 + kk * 16 + hi * 8);
            acc2 = __builtin_amdgcn_mfma_f32_32x32x16_bf16(av, bv, acc2, 0, 0, 0); }
        bf16_t* outp = (bf16_t*)(ws + (kv ? WS_VC : WS_KC)) + (size_t)((b * 2 + g) * 128) * 64;
#pragma unroll
        for (int r = 0; r < 16; ++r) { const int n = n0 + att::crow(r, hi); const float v = n < 127 ? acc2[r] : 0.f; outp[(size_t)n * 64 + 32 * wid + r32] = (bf16_t)(cvtpk(v, 0.f) & 0xffffu); } }
    __syncthreads();
}
__device__ __forceinline__ void cumsum_task(const Args& a, int task, int lane) {
    const int b = task >> 3, h = task & 7; const float bf = a.in[I_BF][h];
    const float* fl = (const float*)(a.ws + WS_F32S) + (size_t)(b * SEQ) * 32 + 24 + h; float* out = (float*)(a.ws + WS_CUM) + (size_t)task * SEQ;
    float tot = 0.f;
    for (int i = 0; i < 32; ++i) { const float v = fl[(size_t)(32 * lane + i) * 32] + bf; tot += fminf(v, 0.f) - log1pf(expf(-fabsf(v))); }
    float inc = tot;
#pragma unroll
    for (int o = 1; o < 64; o <<= 1) { const float t = __shfl_up(inc, o); if (lane >= o) inc += t; }
    float run = inc - tot;
    for (int i = 0; i < 32; ++i) { const float v = fl[(size_t)(32 * lane + i) * 32] + bf; run += fminf(v, 0.f) - log1pf(expf(-fabsf(v))); out[32 * lane + i] = -run * LOG2E; }
}

__device__ __forceinline__ void init_t5_table(const Args& a, LAS unsigned char* lds) {
    LAS float* T = (LAS float*)(lds + att::L_TBL);
    for (int i = fresh_tid(); i < 1024; i += 512) { const int h = i >> 7, d = i & 127; T[i] = a.in[I_RELB][T5B[d] * 8 + h] * LOG2E; }
}
__device__ __forceinline__ void fox_unit(const Args& a, LAS unsigned char* lds, int b, int h, int qb) {
    using namespace att;
    unsigned char* ws = a.ws;
    const int tid = fresh_tid(), lane = tid & 63, r32 = lane & 31, hi = lane >> 5, wid = __builtin_amdgcn_readfirstlane(tid >> 6);
    const int q0 = qb * 256, q0w = q0 + wid * 32, qpos = q0w + r32;
    LAS float* cb = (LAS float*)(lds + L_CB); LAS float* wsf = (LAS float*)(lds + L_WSF) + wid * 64;
    const float* cum = (const float*)(ws + WS_CUM) + (size_t)(b * 8 + h) * SEQ;
    for (int i = tid; i < q0 + 256; i += 512) cb[i] = cum[i];
    bf16_t* Qw = (bf16_t*)(ws + WS_QF) + (size_t)(b * SEQ + q0w) * 512 + h * 64;
    bf16x8 qr[4]; load_q(qr, Qw, 512, r32, hi);
    f32x16 o[2]; o[0] = f32x16{}; o[1] = f32x16{}; float m = -1e30f, l = 0.f;
    const int nt = 4 * qb + 4; const unsigned tmask = nt >= 32 ? 0xffffffffu : ((1u << nt) - 1u);
    const bf16_t* Kg = (const bf16_t*)(ws + WS_KVF) + (size_t)(b * SEQ) * 1024 + h * 64;
    attn_loop(tmask, Kg, 1024, Kg + 512, 1024, lds, qr, o, m, l, ModFoxF{cb, qpos, hi, q0w}, q0w + 31);
    l = halfsum(l);
    scale_rows(o, wsf, 1.0f / l, r32, hi);
    store_o<false>(o, lds, Qw, 512, nullptr, 0);
}
__device__ __forceinline__ void cmpwin_unit(const Args& a, LAS unsigned char* lds, int b, int g, int qb) {
    using namespace att;
    unsigned char* ws = a.ws;
    const int tid = fresh_tid(), lane = tid & 63, r32 = lane & 31, hi = lane >> 5, wid = __builtin_amdgcn_readfirstlane(tid >> 6);
    const int j = wid >> 1, sub = wid & 1, hg = g * 4 + j, q0w = qb * 64 + sub * 32, qpos = q0w + r32; const size_t qrow = (size_t)b * SEQ + qpos;
    const LAS float* tb = (const LAS float*)(lds + L_TBL) + hg * 128;
    LAS float* wsf = (LAS float*)(lds + L_WSF) + wid * 64; LAS float* PS = (LAS float*)(lds + L_PS); LAS float* IMP = (LAS float*)(lds + L_IMP); LAS unsigned* MW = (LAS unsigned*)(lds + L_MISC);
    const float* gates = (const float*)(ws + WS_F32S) + qrow * 32;
    for (int i = tid; i < 64 * 129; i += 512) PS[i] = 0.f;
    if (tid == 0) MW[0] = 0u;
    bf16x8 qr[4]; load_q(qr, (const bf16_t*)(ws + WS_QN) + (size_t)(b * SEQ + q0w) * 512 + hg * 64, 512, r32, hi);
    const StageGeo sg = stage_geo(tid);
    { const bf16_t* Kc = (const bf16_t*)(ws + WS_KC) + (size_t)((b * 2 + g) * 128) * 64; const bf16_t* Vc = (const bf16_t*)(ws + WS_VC) + (size_t)((b * 2 + g) * 128) * 64;
#pragma unroll
        for (int t = 0; t < 2; ++t) { *(LAS u32x4*)(lds + L_SLOT + t * 16384 + sg.koff) = *(const u32x4*)(Kc + (size_t)(t * 64 + sg.krow) * 64 + sg.kcol);
            *(LAS u32x4*)(lds + L_SLOT + t * 16384 + sg.voff) = *(const u32x4*)(Vc + (size_t)(t * 64 + sg.vrow) * 64 + sg.vcol); } }
    __syncthreads();
    f32x16 oc[2]; oc[0] = f32x16{}; oc[1] = f32x16{};
    {
        f32x16 a0, a1, b0, b1; qkt(a0, a1, lds + L_SLOT, qr, r32, hi); qkt(b0, b1, lds + L_SLOT + 16384, qr, r32, hi);
        float mx = NEG;
#pragma unroll
        for (int r = 0; r < 16; ++r) { const int d = qpos - 16 * crow(r, hi) - 31;
            a0[r] = d >= 0 ? a0[r] + tb[min(d, 127)] : NEG; a1[r] = d - 512 >= 0 ? a1[r] + tb[min(d - 512, 127)] : NEG;
            b0[r] = d - 1024 >= 0 ? b0[r] + tb[min(d - 1024, 127)] : NEG; b1[r] = d - 1536 >= 0 ? b1[r] + tb[min(d - 1536, 127)] : NEG;
            mx = fmaxf(fmaxf(mx, fmaxf(a0[r], a1[r])), fmaxf(b0[r], b1[r])); }
        { auto rr = __builtin_amdgcn_permlane32_swap(__float_as_uint(mx), __float_as_uint(mx), false, false); mx = fmaxf(__uint_as_float(rr[0]), __uint_as_float(rr[1])); }
        const float mxs = mx == NEG ? 0.f : mx; float s = 0.f;
#pragma unroll
        for (int r = 0; r < 16; ++r) { a0[r] = fexp2(a0[r] - mxs); a1[r] = fexp2(a1[r] - mxs); b0[r] = fexp2(b0[r] - mxs); b1[r] = fexp2(b1[r] - mxs); s += (a0[r] + a1[r]) + (b0[r] + b1[r]); }
        s = halfsum(s); const float inv = s > 0.f ? 1.0f / s : 0.f;
        LAS float* psr = PS + (sub * 32 + r32) * 129;
#pragma unroll
        for (int r = 0; r < 16; ++r) { a0[r] *= inv; a1[r] *= inv; b0[r] *= inv; b1[r] *= inv; const int c = crow(r, hi);
            __hip_atomic_fetch_add(psr + c, a0[r], __ATOMIC_RELAXED, __HIP_MEMORY_SCOPE_WORKGROUP); __hip_atomic_fetch_add(psr + c + 32, a1[r], __ATOMIC_RELAXED, __HIP_MEMORY_SCOPE_WORKGROUP); __hip_atomic_fetch_add(psr + c + 64, b0[r], __ATOMIC_RELAXED, __HIP_MEMORY_SCOPE_WORKGROUP); __hip_atomic_fetch_add(psr + c + 96, b1[r], __ATOMIC_RELAXED, __HIP_MEMORY_SCOPE_WORKGROUP); }
        const int vb0 = (int)(unsigned)(size_t)(lds + L_SLOT + 8192) + ((lane >> 4) & 1) * 32 + (lane & 3) * 8 + (4 * hi + ((lane & 15) >> 2)) * 64;
        bf16x8 x0, x1, x2, x3; pack_p(a0, a1, x0, x1, x2, x3); pv(oc, vb0, x0, x1, x2, x3);
        pack_p(b0, b1, x0, x1, x2, x3); pv(oc, vb0 + 16384, x0, x1, x2, x3);
        scale_rows(oc, wsf, sigmoidf_(gates[hg]), r32, hi);
    }
    __syncthreads();
    {
        const int q = tid >> 3, jb = (tid & 7) * 4; const LAS float* ps = PS + q * 129; LAS float* im = IMP + q * 33;
#pragma unroll
        for (int jj = 0; jj < 4; ++jj) { const int jx = jb + jj, c0 = 4 * jx - 1;
            const float v = (c0 >= 0 ? ps[c0] : 0.f) + 2.0f * (ps[c0 + 1] + ps[c0 + 2] + ps[c0 + 3]) + ps[c0 + 4];
            const bool valid = jx <= qb, forced = (jx == 0) || (jx == qb) || (jx == qb - 1);
            im[jx] = valid ? v + (forced ? 1e4f : 0.f) : -1e30f; }
        __syncthreads();
        unsigned bits = 0u;
#pragma unroll
        for (int jj = 0; jj < 4; ++jj) { const int jx = jb + jj; const float v = im[jx]; int cnt = 0;
            for (int j2 = 0; j2 < 32; ++j2) { const float v2 = im[j2]; cnt += (v2 > v || (v2 == v && j2 < jx)) ? 1 : 0; }
            if (cnt < 16 && jx <= qb) bits |= 1u << jx; }
        bits |= __shfl_xor(bits, 1); bits |= __shfl_xor(bits, 2); bits |= __shfl_xor(bits, 4);
        if ((tid & 7) == 0) { ((unsigned*)(ws + WS_MASK))[(size_t)(b * 2 + g) * SEQ + qb * 64 + q] = bits; __hip_atomic_fetch_or(MW, bits, __ATOMIC_RELAXED, __HIP_MEMORY_SCOPE_WORKGROUP); }
        __syncthreads();
        if (tid == 0) ((unsigned*)(ws + WS_UMASK))[(b * 2 + g) * 32 + qb] = MW[0];
    }
    f32x16 o[2]; o[0] = f32x16{}; o[1] = f32x16{}; float m = -1e30f, l = 0.f;
    const int lo = qb > 8 ? qb - 8 : 0; const unsigned tmask = (qb >= 31 ? 0xffffffffu : ((2u << qb) - 1u)) & ~((1u << lo) - 1u);
    const bf16_t* Kg = (const bf16_t*)(ws + WS_KVN) + (size_t)(b * SEQ) * 768 + 512 + g * 64;
    attn_loop(tmask, Kg, 768, Kg + 128, 768, lds, qr, o, m, l, ModWinF{tb, qpos, hi}, q0w + 31);
    l = halfsum(l);
    scale_rows(o, wsf, sigmoidf_(gates[16 + hg]) / l, r32, hi);
    o[0] += oc[0]; o[1] += oc[1];
    store_o<false>(o, lds, (bf16_t*)(ws + WS_XB) + (size_t)(b * SEQ + q0w) * 512 + hg * 64, 512, nullptr, 0);
}
__device__ __forceinline__ void sel_unit(const Args& a, LAS unsigned char* lds, int b, int g, int qb) {
    using namespace att;
    unsigned char* ws = a.ws;
    const int tid = fresh_tid(), lane = tid & 63, r32 = lane & 31, hi = lane >> 5, wid = __builtin_amdgcn_readfirstlane(tid >> 6);
    const int j = wid >> 1, sub = wid & 1, hg = g * 4 + j, q0w = qb * 64 + sub * 32, qpos = q0w + r32; const size_t qrow = (size_t)b * SEQ + qpos;
    const LAS float* tb = (const LAS float*)(lds + L_TBL) + hg * 128; LAS float* wsf = (LAS float*)(lds + L_WSF) + wid * 64;
    bf16_t* Qw = (bf16_t*)(ws + WS_QN) + (size_t)(b * SEQ + q0w) * 512 + hg * 64;
    bf16x8 qr[4]; load_q(qr, Qw, 512, r32, hi);
    const unsigned mask = ((const unsigned*)(ws + WS_MASK))[(size_t)(b * 2 + g) * SEQ + qpos];
    const unsigned um = ((const unsigned*)(ws + WS_UMASK))[(b * 2 + g) * 32 + qb] & (qb >= 31 ? 0xffffffffu : ((2u << qb) - 1u));
    f32x16 o[2]; o[0] = f32x16{}; o[1] = f32x16{}; float m = -1e30f, l = 0.f;
    const bf16_t* Kg = (const bf16_t*)(ws + WS_KVN) + (size_t)(b * SEQ) * 768 + 256 + g * 64;
    attn_loop(um, Kg, 768, Kg + 128, 768, lds, qr, o, m, l, ModSelF{tb, qpos, hi, mask}, q0w + 31);
    l = halfsum(l);
    const float g1 = sigmoidf_(((const float*)(ws + WS_F32S))[qrow * 32 + 8 + hg]);
    scale_rows(o, wsf, g1 / l, r32, hi);
    store_o<true>(o, lds, Qw, 512, (const bf16_t*)(ws + WS_XB) + (size_t)(b * SEQ + q0w) * 512 + hg * 64, 512);
}
#ifndef PHMASK
#define PHMASK 0xffffffffu
#endif
#define PH(n) (((PHMASK) >> (n)) & 1u)
__global__ void __launch_bounds__(512, 2) hybrid_fwd(Args a) {
    extern __shared__ __attribute__((aligned(16))) unsigned char lds_raw[];
    LAS unsigned char* lds = (LAS unsigned char*)lds_raw;
    cg::grid_group grid = cg::this_grid();
    unsigned char* ws = a.ws;
    const int tid = fresh_tid(), lane = tid & 63, wave = __builtin_amdgcn_readfirstlane(tid >> 6);
    const int G = gridDim.x, bx = blockIdx.x, vcu = (G % 8 == 0) ? (bx % 8) * (G / 8) + bx / 8 : bx;
    const int gw = vcu * 8 + wave, NGW = G * 8;
    float* X = a.out;
    bf16_t* XB = (bf16_t*)(ws + WS_XB);
    float* SS = (float*)(ws + WS_SS);
#define GSYNC() grid.sync()
    const float* fin_src = a.in[I_X];

#if STAGE_LIMIT >= 1
    p0_prologue(a, lds, gw, NGW, wave, lane);
    GSYNC();
    { pg8::Gemm g{XB, (const bf16_t*)(ws + WS_WGU1), DM, DM, DM, 0, 0, 0, 0}; pg8::Order S; S.init(64, 22, 1, G, bx);
      pg8::EpiGU E{(bf16_t*)(ws + WS_H), SS}; pg8::gemm_phase<pg8::EpiGU, true>(lds, g, S, E); }
    GSYNC();
    { pg8::Gemm g{(const bf16_t*)(ws + WS_H), (const bf16_t*)(ws + WS_WD1), FF, FF, FF, 0, 0, 0, 0}; pg8::Order S; S.init(64, 4, 1, G, bx);
      pg8::EpiRes<true, true> E{a.in[I_X], X, XB, SS + M, 0.5f}; pg8::gemm_phase<pg8::EpiRes<true, true>, false>(lds, g, S, E); }
    GSYNC();
    fin_src = X;
#endif
#if STAGE_LIMIT >= 2
#if PH(3)
    { pg8::Gemm g{XB, (const bf16_t*)(ws + WS_WIN), DM, DM, DM, 0, 0, 0, 0}; pg8::Order S; S.init(64, 20, 1, G, bx);
      pg8::EpiQKV E{(bf16_t*)(ws + WS_QN), (bf16_t*)(ws + WS_KVN), (bf16_t*)(ws + WS_QF), (bf16_t*)(ws + WS_KVF), (bf16_t*)(ws + WS_GAB), (float*)(ws + WS_F32S), SS + M};
      pg8::gemm_phase<pg8::EpiQKV, true>(lds, g, S, E); }
#endif
    GSYNC();
#if PH(4)
    if (bx < 128) { compress_unit(a, lds, bx); }
    else if (bx < 192) {
        if (bx < 160) { pg8::Gemm g{(const bf16_t*)(ws + WS_MEMB), (const bf16_t*)(ws + WS_WMKV), DM, DM, DM, 0, 0, 0, 0}; pg8::Order S; S.init(8, 4, 1, 32, bx - 128);
            pg8::EpiRowScale E{(bf16_t*)(ws + WS_KM), DM, (const float*)(ws + WS_SSM)}; pg8::gemm_phase<pg8::EpiRowScale, false>(lds, g, S, E); }
        else { pg8::Gemm g{(const bf16_t*)(ws + WS_WMKV) + (size_t)DM * DM, (const bf16_t*)(ws + WS_MEMB), DM, DM, DM, 0, 0, 0, 0}; pg8::Order S; S.init(4, 8, 1, 32, bx - 160);
            pg8::EpiColScale E{(bf16_t*)(ws + WS_VT), MROWS, (const float*)(ws + WS_SSM)}; pg8::gemm_phase<pg8::EpiColScale, false>(lds, g, S, E); }
    } else { if (wave == 0) cumsum_task(a, bx - 192, lane); }
#endif
    GSYNC();
#if PH(5)
    init_t5_table(a, lds);
    { const int bh = vcu >> 2, s = vcu & 3; fox_unit(a, lds, bh >> 3, bh & 7, 7 - s); fox_unit(a, lds, bh >> 3, bh & 7, s); }
    { const int bg = vcu >> 4, s = vcu & 15; cmpwin_unit(a, lds, bg >> 1, bg & 1, 31 - s); cmpwin_unit(a, lds, bg >> 1, bg & 1, s); }
#endif
    GSYNC();
#if PH(6)
    { const int bg = vcu >> 4, s = vcu & 15; sel_unit(a, lds, bg >> 1, bg & 1, 31 - s); sel_unit(a, lds, bg >> 1, bg & 1, s); }
#endif
    GSYNC();
#if PH(7)
    { pg8::Order S; S.init(64, 4, 1, G, bx);
      { pg8::Gemm g{(const bf16_t*)(ws + WS_QN), (const bf16_t*)(ws + WS_WUPN), 512, 512, 512, 0, 0, 0, 0}; pg8::EpiUp<0> E{(const bf16_t*)(ws + WS_GAB), (bf16_t*)(ws + WS_Y)}; pg8::gemm_phase<pg8::EpiUp<0>, false>(lds, g, S, E); }
      { pg8::Gemm g{(const bf16_t*)(ws + WS_QF), (const bf16_t*)(ws + WS_WUPF), 512, 512, 512, 0, 0, 0, 0}; pg8::EpiUp<1> E{(const bf16_t*)(ws + WS_GAB), (bf16_t*)(ws + WS_Y)}; pg8::gemm_phase<pg8::EpiUp<1>, false>(lds, g, S, E); } }
#endif
    GSYNC();
#if PH(8)
    { pg8::Gemm g{(const bf16_t*)(ws + WS_Y), (const bf16_t*)(ws + WS_WOUT), DM, DM, DM, 0, 0, 0, 0}; pg8::Order S; S.init(64, 4, 1, G, bx);
      pg8::EpiRes<true, true> E{X, X, XB, SS + 2 * M, 1.0f}; pg8::gemm_phase<pg8::EpiRes<true, true>, false>(lds, g, S, E); }
#endif
    GSYNC();
#endif
#if STAGE_LIMIT >= 3
    { pg8::Gemm g{XB, (const bf16_t*)(ws + WS_WMQ), DM, DM, DM, 0, 0, 0, 0}; pg8::Order S; S.init(64, 4, 1, G, bx);
      pg8::EpiRowScale E{(bf16_t*)(ws + WS_QM), DM, SS + 2 * M}; pg8::gemm_phase<pg8::EpiRowScale, false>(lds, g, S, E); }
    GSYNC();
    { pg8::Gemm g{(const bf16_t*)(ws + WS_QM), (const bf16_t*)(ws + WS_KM), DM, DM, 256, (long)SEQ * DM, 256, (long)MEMLEN * DM, 256}; pg8::Order S; S.init(8, 1, 32, G, bx);
      pg8::EpiSoftmax E{(bf16_t*)(ws + WS_PM)}; pg8::gemm_phase<pg8::EpiSoftmax, false>(lds, g, S, E); }
    GSYNC();
    { pg8::Gemm g{(const bf16_t*)(ws + WS_PM), (const bf16_t*)(ws + WS_VT), 256, MROWS, 256, (long)4 * SEQ * 256, (long)SEQ * 256, 256, (long)256 * MROWS}; pg8::Order S; S.init(8, 1, 32, G, bx);
      pg8::EpiBatchBf16 E{(bf16_t*)(ws + WS_OM), DM, (long)SEQ * DM, 256}; pg8::gemm_phase<pg8::EpiBatchBf16, false>(lds, g, S, E); }
    GSYNC();
    { pg8::Gemm g{(const bf16_t*)(ws + WS_OM), (const bf16_t*)(ws + WS_WMO), DM, DM, DM, 0, 0, 0, 0}; pg8::Order S; S.init(64, 4, 1, G, bx);
      pg8::EpiRes<true, true> E{X, X, XB, SS + 3 * M, 1.0f}; pg8::gemm_phase<pg8::EpiRes<true, true>, false>(lds, g, S, E); }
    GSYNC();
#endif
#if STAGE_LIMIT >= 4
    { pg8::Gemm g{XB, (const bf16_t*)(ws + WS_WGU2), DM, DM, DM, 0, 0, 0, 0}; pg8::Order S; S.init(64, 22, 1, G, bx);
      pg8::EpiGU E{(bf16_t*)(ws + WS_H), SS + 3 * M}; pg8::gemm_phase<pg8::EpiGU, true>(lds, g, S, E); }
    GSYNC();
    { pg8::Gemm g{(const bf16_t*)(ws + WS_H), (const bf16_t*)(ws + WS_WD2), FF, FF, FF, 0, 0, 0, 0}; pg8::Order S; S.init(64, 4, 1, G, bx);
      pg8::EpiRes<false, false> E{X, X, nullptr, nullptr, 0.5f}; pg8::gemm_phase<pg8::EpiRes<false, false>, false>(lds, g, S, E); }
    GSYNC();
#endif
    { const float* gn = a.in[I_FINN]; const int tid2 = fresh_tid(), lane = tid2 & 63, gw = vcu * 8 + (tid2 >> 6);
      for (int mrow = gw; mrow < M; mrow += NGW) {
          const f32x4* xr = (const f32x4*)(fin_src + (size_t)mrow * DM) + lane; f32x4* orow = (f32x4*)(X + (size_t)mrow * DM) + lane;
          f32x4 v[4]; float s = 0.f;
#pragma unroll
          for (int j = 0; j < 4; ++j) { v[j] = xr[64 * j]; s += (v[j][0] * v[j][0] + v[j][1] * v[j][1]) + (v[j][2] * v[j][2] + v[j][3] * v[j][3]); }
          const float rs = rstd_of(wave_sum(s));
#pragma unroll
          for (int j = 0; j < 4; ++j) orow[64 * j] = v[j] * rs * ((const f32x4*)gn)[lane + 64 * j];
      } }
}

extern "C" void kernel_launch(void* const* d_in, const int* in_sizes, int n_in, void* d_out, int out_size, void* d_ws, size_t ws_size, hipStream_t stream) {
    static int grid = 0;
    if (grid == 0) {
        if (n_in != 29 || out_size != M * DM || ws_size < WS_END) { fprintf(stderr, "kernel_launch: unexpected shapes (n_in %d out %d ws %zu)\n", n_in, out_size, ws_size); grid = -1; return; }
        int dev = 0, cus = 0, per_cu = 0;
        hipGetDevice(&dev); hipDeviceGetAttribute(&cus, hipDeviceAttributeMultiprocessorCount, dev);
        if (hipFuncSetAttribute((const void*)hybrid_fwd, hipFuncAttributeMaxDynamicSharedMemorySize, LDS_BYTES) != hipSuccess) { fprintf(stderr, "kernel_launch: hipFuncSetAttribute failed\n"); grid = -1; return; }
        if (hipOccupancyMaxActiveBlocksPerMultiprocessor(&per_cu, (const void*)hybrid_fwd, 512, LDS_BYTES) != hipSuccess || per_cu < 1) { fprintf(stderr, "kernel_launch: occupancy query failed (%d)\n", per_cu); per_cu = 1; }
        (void)hipGetLastError();
        grid = cus * (per_cu < 1 ? 1 : 1);
        if (grid != 256) fprintf(stderr, "kernel_launch: grid %d != 256: this kernel's phase maps assume 256 workgroups\n", grid);
    }
    if (grid < 0) return;
    hipMemsetAsync((char*)d_ws + WS_CTL, 0, CTL_ZERO_BYTES, stream);
    Args a{};
    for (int i = 0; i < 29; ++i) a.in[i] = (const float*)d_in[i];
    a.out = (float*)d_out; a.ws = (unsigned char*)d_ws; a.lo = 0; a.hi = 0;
    void* args[] = {&a};
    hipError_t e = hipLaunchCooperativeKernel((const void*)hybrid_fwd, dim3(grid), dim3(512), args, LDS_BYTES, stream);
    if (e != hipSuccess) fprintf(stderr, "kernel_launch: cooperative launch failed: %s (grid %d)\n", hipGetErrorString(e), grid);
}
```

```cpp
#include <hip/hip_runtime.h>
#include <hip/hip_cooperative_groups.h>
#include <cstdio>
#include <cstdint>
namespace cg = cooperative_groups;

#define LAS __attribute__((address_space(3)))
typedef unsigned short bf16_t;
typedef short bf16x8 __attribute__((ext_vector_type(8)));
typedef short s16x4 __attribute__((ext_vector_type(4)));
typedef float f32x2 __attribute__((ext_vector_type(2)));
typedef float f32x4 __attribute__((ext_vector_type(4)));
typedef float f32x16 __attribute__((ext_vector_type(16)));
typedef unsigned u32x2 __attribute__((ext_vector_type(2)));
typedef unsigned u32x4 __attribute__((ext_vector_type(4)));
typedef __bf16 bf16x2_t __attribute__((ext_vector_type(2)));

constexpr int NB = 8, SEQ = 2048, DM = 1024, FF = 2816, M = NB * SEQ;
constexpr int MEMLEN = 256, MROWS = NB * MEMLEN;
constexpr float RMS_EPS = 1e-6f;
constexpr float LOG2E = 1.4426950408889634f;
constexpr float QS64 = 0.125f * LOG2E;
constexpr float QS256 = 0.0625f * LOG2E;

__device__ __forceinline__ int fresh_tid() { int t = threadIdx.x; asm volatile("" : "+v"(t)); return t; }
__device__ __forceinline__ unsigned cvtpk(float lo, float hi) { f32x2 v = {lo, hi}; bf16x2_t b = __builtin_convertvector(v, bf16x2_t); return __builtin_bit_cast(unsigned, b); }
__device__ __forceinline__ float bflo(unsigned w) { return __uint_as_float(w << 16); }
__device__ __forceinline__ float bfhi(unsigned w) { return __uint_as_float(w & 0xffff0000u); }
__device__ __forceinline__ u32x4 pack8(f32x4 a, f32x4 b) { u32x4 w; w.x = cvtpk(a[0], a[1]); w.y = cvtpk(a[2], a[3]); w.z = cvtpk(b[0], b[1]); w.w = cvtpk(b[2], b[3]); return w; }
__device__ __forceinline__ float fexp2(float x) { return __builtin_amdgcn_exp2f(x); }
__device__ __forceinline__ float frcp(float x) { return __builtin_amdgcn_rcpf(x); }
__device__ __forceinline__ float sigmoidf_(float x) { return frcp(1.0f + fexp2(-x * LOG2E)); }
__device__ __forceinline__ float rstd_of(float ss) { return __builtin_amdgcn_rsqf(ss * (1.0f / DM) + RMS_EPS); }

namespace pg8 {
constexpr int BM = 256, BK = 64, HALF = 128, HTB = HALF * BK * 2, STAGE_BYTES = 8 * HTB, NXCD = 8, WGM = 8;
__host__ __device__ __forceinline__ int lds_byte(int r, int c) { const int st = (r >> 4) * 2 + (c >> 5), rr = r & 15, cc = c & 31, ob = rr * 64 + cc * 2; return st * 1024 + (ob ^ (((ob >> 9) & 1) << 5)); }
__host__ __device__ __forceinline__ void stage_rc(int b, int& R, int& C) { const int st = b / 1024, sb = b % 1024, swz = sb ^ (((sb >> 9) & 1) << 5); R = (st >> 1) * 16 + swz / 64; C = (st & 1) * 32 + (swz % 64) / 2; }
__host__ __device__ __forceinline__ int perm32(int rho) { const int n = rho >> 4, i = rho & 15; return 8 * (i >> 2) + 4 * n + (i & 3); }

struct Unit { int pm, pn, pb; };
struct Gemm { const bf16_t* A; const bf16_t* Bt; int lda, ldb, K; long sAb, sAh, sBb, sBh; };

struct Order {
    int nM, nN, nwg, G, c;
    __device__ __forceinline__ void init(int nM_, int nN_, int nB_, int G_, int c_) { nM = nM_; nN = nN_; nwg = nM_ * nN_ * nB_; G = G_; c = c_; }
    __device__ __forceinline__ bool next(int i, Unit& u) const {
        if (c < 0) return false;
        const long L = (long)i * G + c; if (L >= nwg) return false;
        int wgid = (int)L; { const int q = nwg / NXCD, r = nwg % NXCD, xcd = wgid % NXCD, off = wgid / NXCD; wgid = (xcd < r ? xcd * (q + 1) : r * (q + 1) + (xcd - r) * q) + off; }
        const int per = nM * nN; u.pb = wgid / per; const int w = wgid % per;
        const int nig = WGM * nN, gid = w / nig, fm = gid * WGM, gsz = (nM - fm) < WGM ? (nM - fm) : WGM;
        u.pm = fm + ((w % nig) % gsz); u.pn = (w % nig) / gsz; return true;
    }
};

typedef f32x4 Acc[2][2][4][2];

template <class Epi, bool ALIGN_EPI>
__device__ __forceinline__ void gemm_phase(LAS unsigned char* lds, const Gemm g, const Order& S, const Epi& E) {
    const int tid = fresh_tid(), wid = __builtin_amdgcn_readfirstlane(tid >> 6), lane = tid & 63, wr = wid >> 2, wc = wid & 3, fr = lane & 15, fq = lane >> 4;
    const int K = g.K, nt = K / BK;
    unsigned voffA[2], voffB[2];
#pragma unroll
    for (int i = 0; i < 2; ++i) { int R, C; stage_rc(tid * 16 + i * 8192, R, C); const int Rb = (R & ~31) + perm32(R & 31);
        voffA[i] = (unsigned)(R * g.lda + C) * 2u; voffB[i] = (unsigned)(Rb * g.ldb + C) * 2u; }
    const size_t kstep = (size_t)(BK * 2);
    const size_t hstepA = (size_t)HALF * g.lda * 2, hstepB = (size_t)HALF * g.ldb * 2;
    const size_t tstepA = 2 * hstepA, tstepB = 2 * hstepB;
    const unsigned ldsw = (unsigned)wid * 1024u;
    const int aoff = lds_byte(wr * 64 + fr, fq * 8), boff = lds_byte(wc * 32 + fr, fq * 8);
#define PG8_SA(b, h) (((b) * 2 + (h)) * HTB)
#define PG8_SB(b, h) ((4 + (b) * 2 + (h)) * HTB)
#define PG8_STAGE(bufoff, gbase, voff) do { _Pragma("unroll") for (int _i = 0; _i < 2; ++_i) \
        __builtin_amdgcn_global_load_lds((const unsigned*)((const char*)(gbase) + (voff)[_i]), (LAS unsigned*)(lds + (bufoff) + ldsw + _i * 8192), 16, 0, 0); } while (0)
#define PG8_LDA(dst, b, h) do { _Pragma("unroll") for (int m = 0; m < 4; ++m) _Pragma("unroll") for (int k = 0; k < 2; ++k) dst[m][k] = *(const LAS bf16x8*)(lds + PG8_SA(b, h) + aoff + m * 2048 + k * 1024); } while (0)
#define PG8_LDB(dst, b, h) do { _Pragma("unroll") for (int n = 0; n < 2; ++n) _Pragma("unroll") for (int k = 0; k < 2; ++k) dst[n][k] = *(const LAS bf16x8*)(lds + PG8_SB(b, h) + boff + n * 2048 + k * 1024); } while (0)
#define PG8_MMA(ai, bj, At, Bt) do { __builtin_amdgcn_s_setprio(1); _Pragma("unroll") for (int m = 0; m < 4; ++m) _Pragma("unroll") for (int n = 0; n < 2; ++n) _Pragma("unroll") for (int k = 0; k < 2; ++k) \
        acc[ai][bj][m][n] = __builtin_amdgcn_mfma_f32_16x16x32_bf16(Bt[n][k], At[m][k], acc[ai][bj][m][n], 0, 0, 0); __builtin_amdgcn_s_setprio(0); } while (0)
#define PG8_WAIT_V(n) asm volatile("s_waitcnt vmcnt(" #n ")" ::: "memory")
#define PG8_WAIT_L(n) asm volatile("s_waitcnt lgkmcnt(" #n ")" ::: "memory")
#define PG8_BAR __builtin_amdgcn_s_barrier()
#define PG8_SCHED __builtin_amdgcn_sched_barrier(0)
#define PG8_OFFA(u) ((size_t)(((u).pb >> 2) * g.sAb + ((u).pb & 3) * g.sAh) * 2 + (size_t)(u).pm * tstepA)
#define PG8_OFFB(u) ((size_t)(((u).pb >> 2) * g.sBb + ((u).pb & 3) * g.sBh) * 2 + (size_t)(u).pn * tstepB)
    Unit cur, nxt; int ui = 0;
    if (!S.next(0, cur)) return;
    Acc acc;
#pragma unroll
    for (int a = 0; a < 2; ++a)
#pragma unroll
        for (int b = 0; b < 2; ++b)
#pragma unroll
            for (int m = 0; m < 4; ++m)
#pragma unroll
                for (int n = 0; n < 2; ++n) acc[a][b][m][n] = (f32x4){0.f, 0.f, 0.f, 0.f};
    bf16x8 At[4][2], B0[2][2], B1[2][2];
    const char* cA = (const char*)g.A + PG8_OFFA(cur); const char* cB = (const char*)g.Bt + PG8_OFFB(cur);
    {
        PG8_STAGE(PG8_SB(0, 0), cB, voffB); PG8_STAGE(PG8_SB(0, 1), cB + hstepB, voffB); PG8_STAGE(PG8_SA(0, 0), cA, voffA); PG8_STAGE(PG8_SA(0, 1), cA + hstepA, voffA);
        if (wr == 1) PG8_BAR;
        PG8_WAIT_V(2); PG8_BAR;
        PG8_STAGE(PG8_SB(1, 0), cB + kstep, voffB); PG8_STAGE(PG8_SA(1, 0), cA + kstep, voffA); PG8_STAGE(PG8_SB(1, 1), cB + hstepB + kstep, voffB);
        PG8_WAIT_V(6); PG8_BAR;
    }
    for (;;) {
        const bool has_next = S.next(ui + 1, nxt);
        const char* nA = has_next ? (const char*)g.A + PG8_OFFA(nxt) : cA; const char* nB = has_next ? (const char*)g.Bt + PG8_OFFB(nxt) : cB;
        for (int t = 0; t < nt; t += 2) {
            const bool last = (t == nt - 2);
            const char* a1 = cA + (size_t)(t + 1) * kstep;
            const char* a2 = last ? nA : cA + (size_t)(t + 2) * kstep; const char* b2 = last ? nB : cB + (size_t)(t + 2) * kstep;
            const char* a3 = a2 + kstep; const char* b3 = b2 + kstep;
            PG8_LDB(B0, 0, 0); PG8_LDB(B1, 0, 1); PG8_SCHED; PG8_LDA(At, 0, 0); PG8_STAGE(PG8_SA(1, 1), a1 + hstepA, voffA);
            PG8_WAIT_V(8); PG8_WAIT_L(0); PG8_BAR; PG8_MMA(0, 0, At, B0); PG8_MMA(0, 1, At, B1); PG8_BAR; PG8_SCHED;
            PG8_LDA(At, 0, 1); PG8_STAGE(PG8_SB(0, 0), b2, voffB); PG8_STAGE(PG8_SB(0, 1), b2 + hstepB, voffB); PG8_STAGE(PG8_SA(0, 0), a2, voffA);
            PG8_WAIT_V(8); PG8_WAIT_L(0); PG8_BAR; PG8_MMA(1, 0, At, B0); PG8_MMA(1, 1, At, B1); PG8_BAR; PG8_SCHED;
            PG8_LDB(B0, 1, 0); PG8_LDB(B1, 1, 1); PG8_SCHED; PG8_LDA(At, 1, 0); PG8_STAGE(PG8_SA(0, 1), a2 + hstepA, voffA);
            PG8_WAIT_V(8); PG8_WAIT_L(0); PG8_BAR; PG8_MMA(0, 0, At, B0); PG8_MMA(0, 1, At, B1); PG8_BAR; PG8_SCHED;
            PG8_LDA(At, 1, 1); PG8_STAGE(PG8_SB(1, 0), b3, voffB); PG8_STAGE(PG8_SB(1, 1), b3 + hstepB, voffB); PG8_STAGE(PG8_SA(1, 0), a3, voffA);
            PG8_WAIT_V(8); PG8_WAIT_L(0); PG8_BAR; PG8_MMA(1, 0, At, B0); PG8_MMA(1, 1, At, B1); PG8_BAR; PG8_SCHED;
        }
        if constexpr (ALIGN_EPI) { if (wr == 0) PG8_BAR; }
        if constexpr (!Epi::AFTER_DRAIN) { E(acc, cur, wr, wc, fr, fq); }
        if (!has_next) break;
#pragma unroll
        for (int a = 0; a < 2; ++a)
#pragma unroll
            for (int b = 0; b < 2; ++b)
#pragma unroll
                for (int m = 0; m < 4; ++m)
#pragma unroll
                    for (int n = 0; n < 2; ++n) acc[a][b][m][n] = (f32x4){0.f, 0.f, 0.f, 0.f};
        cur = nxt; cA = nA; cB = nB; ++ui;
        if constexpr (ALIGN_EPI) { if (wr == 1) PG8_BAR; }
    }
    PG8_WAIT_V(0);
    if constexpr (!ALIGN_EPI) { if (wr == 0) PG8_BAR; }
    PG8_BAR;
    if constexpr (Epi::AFTER_DRAIN) { E.fused(acc, cur, wr, wc, fr, fq, lds, wid, lane); }
#undef PG8_SA
#undef PG8_SB
#undef PG8_STAGE
#undef PG8_LDA
#undef PG8_LDB
#undef PG8_MMA
#undef PG8_WAIT_V
#undef PG8_WAIT_L
#undef PG8_BAR
#undef PG8_SCHED
#undef PG8_OFFA
#undef PG8_OFFB
}

struct EpiGU {
    static constexpr bool AFTER_DRAIN = false;
    bf16_t* H; const float* ss;
    __device__ __forceinline__ void operator()(const Acc& acc, const Unit& u, int wr, int wc, int fr, int fq) const {
        const int row0 = u.pm * BM + wr * 64 + fr, col0 = u.pn * 128 + wc * 32 + fq * 8;
#pragma unroll
        for (int ai = 0; ai < 2; ++ai)
#pragma unroll
            for (int m = 0; m < 4; ++m) {
                const int row = row0 + ai * HALF + m * 16; const float rs = rstd_of(ss[row]);
                f32x4 h[2];
#pragma unroll
                for (int n = 0; n < 2; ++n) { const f32x4 gg = acc[ai][0][m][n] * rs, uu = acc[ai][1][m][n] * rs;
#pragma unroll
                    for (int j = 0; j < 4; ++j) h[n][j] = gg[j] * sigmoidf_(gg[j]) * uu[j]; }
                *(u32x4*)(H + (size_t)row * FF + col0) = pack8(h[0], h[1]);
            }
    }
};
template <bool WRITE_XB, bool WRITE_SS> struct EpiRes {
    static constexpr bool AFTER_DRAIN = false;
    const float* base; float* out; bf16_t* xb; float* ss; float scale;
    __device__ __forceinline__ void operator()(const Acc& acc, const Unit& u, int wr, int wc, int fr, int fq) const {
        const int row0 = u.pm * BM + wr * 64 + fr, col0 = u.pn * BM + wc * 32 + fq * 8;
#pragma unroll
        for (int ai = 0; ai < 2; ++ai)
#pragma unroll
            for (int m = 0; m < 4; ++m) {
                const int row = row0 + ai * HALF + m * 16; float sq = 0.f;
#pragma unroll
                for (int bj = 0; bj < 2; ++bj) { const size_t p = (size_t)row * DM + col0 + bj * HALF;
                    const f32x4 o0 = *(const f32x4*)(base + p), o1 = *(const f32x4*)(base + p + 4);
                    const f32x4 n0 = o0 + acc[ai][bj][m][0] * scale, n1 = o1 + acc[ai][bj][m][1] * scale;
                    *(f32x4*)(out + p) = n0; *(f32x4*)(out + p + 4) = n1;
                    if (WRITE_XB) *(u32x4*)(xb + p) = pack8(n0, n1);
                    if (WRITE_SS) sq += (n0[0] * n0[0] + n0[1] * n0[1]) + (n0[2] * n0[2] + n0[3] * n0[3]) + (n1[0] * n1[0] + n1[1] * n1[1]) + (n1[2] * n1[2] + n1[3] * n1[3]); }
                if (WRITE_SS) { sq += __shfl_xor(sq, 16); sq += __shfl_xor(sq, 32); if (fq == 0) unsafeAtomicAdd(ss + row, sq); }
                asm volatile("" ::: "memory");
            }
    }
};
struct EpiQKV {
    static constexpr bool AFTER_DRAIN = false;
    bf16_t *QN, *KVN, *QF, *KVF, *GAB; float* F32S; const float* ss;
    __device__ __forceinline__ void operator()(const Acc& acc, const Unit& u, int wr, int wc, int fr, int fq) const {
        const int row0 = u.pm * BM + wr * 64 + fr, pn = u.pn;
        if (pn == 19) {
            if (wc == 0) {
#pragma unroll
                for (int ai = 0; ai < 2; ++ai)
#pragma unroll
                    for (int m = 0; m < 4; ++m) { const int row = row0 + ai * HALF + m * 16; const float rs = rstd_of(ss[row]);
                        *(f32x4*)(F32S + (size_t)row * 32 + fq * 8) = acc[ai][0][m][0] * rs; *(f32x4*)(F32S + (size_t)row * 32 + fq * 8 + 4) = acc[ai][0][m][1] * rs; }
            }
            return;
        }
        bf16_t* dst; int pitch, coff;
        if (pn < 2) { dst = QN; pitch = 512; coff = pn * 256; }
        else if (pn < 5) { dst = KVN; pitch = 768; coff = (pn - 2) * 256; }
        else if (pn < 7) { dst = QF; pitch = 512; coff = (pn - 5) * 256; }
        else if (pn < 11) { dst = KVF; pitch = 1024; coff = (pn - 7) * 256; }
        else { dst = GAB; pitch = 2048; coff = (pn - 11) * 256; }
        coff += wc * 32 + fq * 8;
#pragma unroll
        for (int ai = 0; ai < 2; ++ai)
#pragma unroll
            for (int m = 0; m < 4; ++m) { const int row = row0 + ai * HALF + m * 16; const float rs = rstd_of(ss[row]);
#pragma unroll
                for (int bj = 0; bj < 2; ++bj) *(u32x4*)(dst + (size_t)row * pitch + coff + bj * HALF) = pack8(acc[ai][bj][m][0] * rs, acc[ai][bj][m][1] * rs); }
    }
};
template <int STEP> struct EpiUp {
    static constexpr bool AFTER_DRAIN = false;
    const bf16_t* GAB; bf16_t* Y;
    __device__ __forceinline__ void operator()(const Acc& acc, const Unit& u, int wr, int wc, int fr, int fq) const {
        const int row0 = u.pm * BM + wr * 64 + fr, col0 = u.pn * BM + wc * 32 + fq * 8;
#pragma unroll
        for (int ai = 0; ai < 2; ++ai)
#pragma unroll
            for (int m = 0; m < 4; ++m) { const int row = row0 + ai * HALF + m * 16;
#pragma unroll
                for (int bj = 0; bj < 2; ++bj) { const int c = col0 + bj * HALF;
                    const u32x4 gw = *(const u32x4*)(GAB + (size_t)row * 2048 + STEP * 1024 + c);
                    f32x4 v0, v1; const f32x4 a0 = acc[ai][bj][m][0], a1 = acc[ai][bj][m][1];
                    v0[0] = sigmoidf_(bflo(gw.x)) * a0[0]; v0[1] = sigmoidf_(bfhi(gw.x)) * a0[1]; v0[2] = sigmoidf_(bflo(gw.y)) * a0[2]; v0[3] = sigmoidf_(bfhi(gw.y)) * a0[3];
                    v1[0] = sigmoidf_(bflo(gw.z)) * a1[0]; v1[1] = sigmoidf_(bfhi(gw.z)) * a1[1]; v1[2] = sigmoidf_(bflo(gw.w)) * a1[2]; v1[3] = sigmoidf_(bfhi(gw.w)) * a1[3];
                    bf16_t* yp = Y + (size_t)row * DM + c;
                    if (STEP == 1) { const u32x4 y = *(const u32x4*)yp;
                        v0[0] += bflo(y.x); v0[1] += bfhi(y.x); v0[2] += bflo(y.y); v0[3] += bfhi(y.y); v1[0] += bflo(y.z); v1[1] += bfhi(y.z); v1[2] += bflo(y.w); v1[3] += bfhi(y.w); }
                    *(u32x4*)yp = pack8(v0, v1); }
                asm volatile("" ::: "memory"); }
    }
};
struct EpiRowScale {
    static constexpr bool AFTER_DRAIN = false;
    bf16_t* O; int ldo; const float* ss;
    __device__ __forceinline__ void operator()(const Acc& acc, const Unit& u, int wr, int wc, int fr, int fq) const {
        const int row0 = u.pm * BM + wr * 64 + fr, col0 = u.pn * BM + wc * 32 + fq * 8;
#pragma unroll
        for (int ai = 0; ai < 2; ++ai)
#pragma unroll
            for (int m = 0; m < 4; ++m) { const int row = row0 + ai * HALF + m * 16; const float rs = rstd_of(ss[row]);
#pragma unroll
                for (int bj = 0; bj < 2; ++bj) *(u32x4*)(O + (size_t)row * ldo + col0 + bj * HALF) = pack8(acc[ai][bj][m][0] * rs, acc[ai][bj][m][1] * rs); }
    }
};
struct EpiColScale {
    static constexpr bool AFTER_DRAIN = false;
    bf16_t* O; int ldo; const float* ss;
    __device__ __forceinline__ void operator()(const Acc& acc, const Unit& u, int wr, int wc, int fr, int fq) const {
        const int row0 = u.pm * BM + wr * 64 + fr, col0 = u.pn * BM + wc * 32 + fq * 8;
#pragma unroll
        for (int bj = 0; bj < 2; ++bj) { const int c = col0 + bj * HALF;
            f32x4 s0 = *(const f32x4*)(ss + c), s1 = *(const f32x4*)(ss + c + 4);
#pragma unroll
            for (int j = 0; j < 4; ++j) { s0[j] = rstd_of(s0[j]); s1[j] = rstd_of(s1[j]); }
#pragma unroll
            for (int ai = 0; ai < 2; ++ai)
#pragma unroll
                for (int m = 0; m < 4; ++m) { const int row = row0 + ai * HALF + m * 16;
                    *(u32x4*)(O + (size_t)row * ldo + c) = pack8(acc[ai][bj][m][0] * s0, acc[ai][bj][m][1] * s1); } }
    }
};
struct EpiBatchBf16 {
    static constexpr bool AFTER_DRAIN = false;
    bf16_t* O; int ldo; long sOb, sOh;
    __device__ __forceinline__ void operator()(const Acc& acc, const Unit& u, int wr, int wc, int fr, int fq) const {
        const int row0 = u.pm * BM + wr * 64 + fr, col0 = u.pn * BM + wc * 32 + fq * 8;
        bf16_t* Ob = O + (size_t)((u.pb >> 2) * sOb + (u.pb & 3) * sOh);
#pragma unroll
        for (int ai = 0; ai < 2; ++ai)
#pragma unroll
            for (int m = 0; m < 4; ++m) { const int row = row0 + ai * HALF + m * 16;
#pragma unroll
                for (int bj = 0; bj < 2; ++bj) *(u32x4*)(Ob + (size_t)row * ldo + col0 + bj * HALF) = pack8(acc[ai][bj][m][0], acc[ai][bj][m][1]); }
    }
};
struct EpiSoftmax {
    static constexpr bool AFTER_DRAIN = true;
    bf16_t* P;
    __device__ __forceinline__ void fused(Acc& acc, const Unit& u, int wr, int wc, int fr, int fq, LAS unsigned char* lds, int wid, int lane) const {
        LAS float* Pm = (LAS float*)lds;
        LAS float* Ps = (LAS float*)(lds + 8192);
#pragma unroll
        for (int ai = 0; ai < 2; ++ai)
#pragma unroll
            for (int m = 0; m < 4; ++m) { float mx = -3.0e38f;
#pragma unroll
                for (int bj = 0; bj < 2; ++bj)
#pragma unroll
                    for (int n = 0; n < 2; ++n) { const f32x4 x = acc[ai][bj][m][n]; mx = fmaxf(mx, fmaxf(fmaxf(x[0], x[1]), fmaxf(x[2], x[3]))); }
                mx = fmaxf(mx, __shfl_xor(mx, 16)); mx = fmaxf(mx, __shfl_xor(mx, 32));
                if (fq == 0) Pm[(ai * HALF + wr * 64 + m * 16 + fr) * 4 + wc] = mx; }
        __syncthreads();
#pragma unroll
        for (int ai = 0; ai < 2; ++ai)
#pragma unroll
            for (int m = 0; m < 4; ++m) { const int r = ai * HALF + wr * 64 + m * 16 + fr; const f32x4 t = *(const LAS f32x4*)(Pm + r * 4);
                const float mx = fmaxf(fmaxf(t[0], t[1]), fmaxf(t[2], t[3])); float s = 0.f;
#pragma unroll
                for (int bj = 0; bj < 2; ++bj)
#pragma unroll
                    for (int n = 0; n < 2; ++n) { f32x4 x = acc[ai][bj][m][n];
#pragma unroll
                        for (int j = 0; j < 4; ++j) { x[j] = fexp2(x[j] - mx); s += x[j]; }
                        acc[ai][bj][m][n] = x; }
                s += __shfl_xor(s, 16); s += __shfl_xor(s, 32);
                if (fq == 0) Ps[r * 4 + wc] = s; }
        __syncthreads();
        bf16_t* Pb = P + (size_t)u.pb * SEQ * 256;
        const int col0 = wc * 32 + fq * 8;
#pragma unroll
        for (int ai = 0; ai < 2; ++ai)
#pragma unroll
            for (int m = 0; m < 4; ++m) { const int r = ai * HALF + wr * 64 + m * 16 + fr; const f32x4 t = *(const LAS f32x4*)(Ps + r * 4);
                const float inv = 1.0f / ((t[0] + t[1]) + (t[2] + t[3])); const int row = u.pm * BM + r;
#pragma unroll
                for (int bj = 0; bj < 2; ++bj) *(u32x4*)(Pb + (size_t)row * 256 + col0 + bj * HALF) = pack8(acc[ai][bj][m][0] * inv, acc[ai][bj][m][1] * inv); }
        __syncthreads();
    }
};
}
namespace att {
__device__ __forceinline__ int crow(int r, int hi) { return (r & 3) + 8 * (r >> 2) + 4 * hi; }
#define SBAR() __builtin_amdgcn_sched_barrier(0)
constexpr float NEG = -INFINITY;
constexpr int L_SLOT = 0;
constexpr int L_WSF = 32768;
constexpr int L_OST = L_WSF + 2048;
constexpr int L_TBL = L_OST + 32768;
constexpr int L_CB = L_TBL + 4096;
constexpr int L_PS = L_CB + 8192;
constexpr int L_IMP = L_PS + 64 * 129 * 4;
constexpr int L_MISC = L_IMP + 64 * 33 * 4;
constexpr int L_END = L_MISC + 64;
static_assert(L_END <= 131072, "attention LDS map");

__device__ __forceinline__ void qkt(f32x16& p0, f32x16& p1, const LAS unsigned char* Kslot, const bf16x8 (&qr)[4], int r32, int hi) {
    const LAS unsigned char* kb = Kslot + hi * 1024 + r32 * 16;
    p0 = f32x16{}; p1 = f32x16{};
#pragma unroll
    for (int d0 = 0; d0 < 4; ++d0) {
        const bf16x8 b0 = *(const LAS bf16x8*)(kb + d0 * 2048);
        const bf16x8 b1 = *(const LAS bf16x8*)(kb + d0 * 2048 + 512);
        p0 = __builtin_amdgcn_mfma_f32_32x32x16_bf16(b0, qr[d0], p0, 0, 0, 0);
        p1 = __builtin_amdgcn_mfma_f32_32x32x16_bf16(b1, qr[d0], p1, 0, 0, 0);
    }
}
__device__ __forceinline__ void pv(f32x16 (&o)[2], int vb, bf16x8 pa0, bf16x8 pa1, bf16x8 pa2, bf16x8 pa3) {
#pragma unroll
    for (int d0 = 0; d0 < 2; ++d0) { s16x4 lo[4], hi[4];
#pragma unroll
        for (int ks = 0; ks < 4; ++ks) {
            asm volatile("ds_read_b64_tr_b16 %0,%1 offset:%c2" : "=&v"(lo[ks]) : "v"(vb), "i"(d0 * 4096 + ks * 1024) : "memory");
            asm volatile("ds_read_b64_tr_b16 %0,%1 offset:%c2" : "=&v"(hi[ks]) : "v"(vb), "i"(d0 * 4096 + ks * 1024 + 512) : "memory"); }
        asm volatile("s_waitcnt lgkmcnt(0)" ::: "memory"); SBAR();
#define PK(k) (bf16x8){lo[k][0], lo[k][1], lo[k][2], lo[k][3], hi[k][0], hi[k][1], hi[k][2], hi[k][3]}
        o[d0] = __builtin_amdgcn_mfma_f32_32x32x16_bf16(pa0, PK(0), o[d0], 0, 0, 0);
        o[d0] = __builtin_amdgcn_mfma_f32_32x32x16_bf16(pa1, PK(1), o[d0], 0, 0, 0);
        o[d0] = __builtin_amdgcn_mfma_f32_32x32x16_bf16(pa2, PK(2), o[d0], 0, 0, 0);
        o[d0] = __builtin_amdgcn_mfma_f32_32x32x16_bf16(pa3, PK(3), o[d0], 0, 0, 0);
#undef PK
    }
}
__device__ __forceinline__ float rowmax32(const f32x16& p0, const f32x16& p1) {
    float a = fmaxf(p0[0], p1[0]);
#pragma unroll
    for (int r = 1; r < 16; ++r) a = fmaxf(a, fmaxf(p0[r], p1[r]));
    auto rr = __builtin_amdgcn_permlane32_swap(__float_as_uint(a), __float_as_uint(a), false, false);
    return fmaxf(__uint_as_float(rr[0]), __uint_as_float(rr[1]));
}
__device__ __forceinline__ float halfsum(float v) {
    auto rr = __builtin_amdgcn_permlane32_swap(__float_as_uint(v), __float_as_uint(v), false, false);
    return __uint_as_float(rr[0]) + __uint_as_float(rr[1]);
}
#define PKW(P, B) cvtpk(P[B], P[B + 1])
__device__ __forceinline__ void pack_p(const f32x16& p0, const f32x16& p1, bf16x8& a0, bf16x8& a1, bf16x8& a2, bf16x8& a3) {
    const u32x4 w0 = {PKW(p0, 0), PKW(p0, 2), PKW(p0, 4), PKW(p0, 6)}, w1 = {PKW(p0, 8), PKW(p0, 10), PKW(p0, 12), PKW(p0, 14)};
    const u32x4 w2 = {PKW(p1, 0), PKW(p1, 2), PKW(p1, 4), PKW(p1, 6)}, w3 = {PKW(p1, 8), PKW(p1, 10), PKW(p1, 12), PKW(p1, 14)};
    a0 = __builtin_bit_cast(bf16x8, w0); a1 = __builtin_bit_cast(bf16x8, w1); a2 = __builtin_bit_cast(bf16x8, w2); a3 = __builtin_bit_cast(bf16x8, w3);
}
#undef PKW
__device__ __forceinline__ void scale_rows(f32x16 (&o)[2], LAS float* wsf, float v, int r32, int hi) {
    if (hi == 0) wsf[r32] = v;
    asm volatile("s_waitcnt lgkmcnt(0)" ::: "memory");
#pragma unroll
    for (int i = 0; i < 4; ++i) { const f32x4 f = *(const LAS f32x4*)(wsf + 8 * i + 4 * hi);
#pragma unroll
        for (int j = 0; j < 4; ++j) { o[0][4 * i + j] *= f[j]; o[1][4 * i + j] *= f[j]; } }
    asm volatile("s_waitcnt lgkmcnt(0)" ::: "memory");
}
struct StageGeo { int krow, kcol, koff, vrow, vcol, voff; };
__device__ __forceinline__ StageGeo stage_geo(int tid) {
    StageGeo s; const int w = tid >> 6, ln = tid & 63;
    s.krow = ln; s.kcol = w * 8; s.koff = w * 1024 + ln * 16;
    s.vrow = 16 * (w & 3) + (ln >> 2); s.vcol = (w >> 2) * 32 + (ln & 3) * 8; s.voff = 8192 + w * 1024 + ln * 16;
    return s;
}
template <class Mod>
__device__ __forceinline__ void tile_step(const LAS unsigned char* slot, const bf16x8 (&qr)[4], f32x16 (&o)[2], float& m, float& l, LAS float* wsf, const Mod& mod, int r32, int hi, int vb) {
    f32x16 p0, p1;
    qkt(p0, p1, slot, qr, r32, hi);
    mod(p0, p1);
    const float rm = rowmax32(p0, p1);
    const float mn = fmaxf(m, rm);
    const float alpha = fexp2(m - mn);
    const bool need = __any(mn > m);
    m = mn;
    float s = 0.f;
#pragma unroll
    for (int r = 0; r < 16; ++r) { p0[r] = fexp2(p0[r] - mn); p1[r] = fexp2(p1[r] - mn); s += p0[r] + p1[r]; }
    l = l * alpha + s;
    if (need) scale_rows(o, wsf, alpha, r32, hi);
    bf16x8 a0, a1, a2, a3; pack_p(p0, p1, a0, a1, a2, a3);
    pv(o, vb, a0, a1, a2, a3);
}
template <class ModF>
__device__ __forceinline__ void attn_loop(unsigned tmask, const bf16_t* Kg, int pitchK, const bf16_t* Vg, int pitchV, LAS unsigned char* lds, const bf16x8 (&qr)[4],
                                          f32x16 (&o)[2], float& m, float& l, const ModF& modf, int wave_last_row) {
    const int tid = fresh_tid(), lane = tid & 63, r32 = lane & 31, hi = lane >> 5, wid = tid >> 6;
    const StageGeo sg = stage_geo(tid);
    LAS float* wsf = (LAS float*)(lds + L_WSF) + wid * 64;
    const int vb0 = (int)(unsigned)(size_t)(lds + L_SLOT + 8192) + ((lane >> 4) & 1) * 32 + (lane & 3) * 8 + (4 * hi + ((lane & 15) >> 2)) * 64;
    int kt = 31 - __clz((int)tmask);
    u32x4 kreg = *(const u32x4*)(Kg + (size_t)(kt * 64 + sg.krow) * pitchK + sg.kcol);
    u32x4 vreg = *(const u32x4*)(Vg + (size_t)(kt * 64 + sg.vrow) * pitchV + sg.vcol);
    *(LAS u32x4*)(lds + L_SLOT + sg.koff) = kreg; *(LAS u32x4*)(lds + L_SLOT + sg.voff) = vreg;
    __syncthreads();
    int s = 0;
    for (;;) {
        tmask &= ~(1u << kt);
        const int nk = tmask ? 31 - __clz((int)tmask) : -1;
        if (nk >= 0) { kreg = *(const u32x4*)(Kg + (size_t)(nk * 64 + sg.krow) * pitchK + sg.kcol); vreg = *(const u32x4*)(Vg + (size_t)(nk * 64 + sg.vrow) * pitchV + sg.vcol); }
        if (kt * 64 <= wave_last_row) tile_step(lds + L_SLOT + s * 16384, qr, o, m, l, wsf, modf(kt), r32, hi, vb0 + s * 16384);
        if (nk >= 0) { *(LAS u32x4*)(lds + L_SLOT + (s ^ 1) * 16384 + sg.koff) = kreg; *(LAS u32x4*)(lds + L_SLOT + (s ^ 1) * 16384 + sg.voff) = vreg; }
        __syncthreads();
        if (nk < 0) break;
        kt = nk; s ^= 1;
    }
}
template <bool ADD>
__device__ __forceinline__ void store_o(const f32x16 (&o)[2], LAS unsigned char* lds, bf16_t* dst, int pitch, const bf16_t* addsrc, int addpitch) {
    const int tid = fresh_tid(), lane = tid & 63, r32 = lane & 31, hi = lane >> 5, wid = tid >> 6;
    LAS bf16_t* stg = (LAS bf16_t*)(lds + L_OST) + wid * 2048;
#pragma unroll
    for (int r = 0; r < 16; ++r) { const int orow = crow(r, hi);
#pragma unroll
        for (int d0 = 0; d0 < 2; ++d0) stg[orow * 64 + d0 * 32 + r32] = (bf16_t)(cvtpk(o[d0][r], 0.f) & 0xffffu); }
    asm volatile("s_waitcnt lgkmcnt(0)" ::: "memory");
#pragma unroll
    for (int i = 0; i < 4; ++i) { const int row = i * 8 + (lane >> 3), ch = lane & 7;
        u32x4 v = *(const LAS u32x4*)(stg + row * 64 + ch * 8);
        if (ADD) { const u32x4 a = *(const u32x4*)(addsrc + (size_t)row * addpitch + ch * 8);
            v.x = cvtpk(bflo(v.x) + bflo(a.x), bfhi(v.x) + bfhi(a.x)); v.y = cvtpk(bflo(v.y) + bflo(a.y), bfhi(v.y) + bfhi(a.y));
            v.z = cvtpk(bflo(v.z) + bflo(a.z), bfhi(v.z) + bfhi(a.z)); v.w = cvtpk(bflo(v.w) + bflo(a.w), bfhi(v.w) + bfhi(a.w)); }
        *(u32x4*)(dst + (size_t)row * pitch + ch * 8) = v; }
    asm volatile("s_waitcnt lgkmcnt(0)" ::: "memory");
}
__device__ __forceinline__ void load_q(bf16x8 (&qr)[4], const bf16_t* Qw, int pitch, int r32, int hi) {
#pragma unroll
    for (int d0 = 0; d0 < 4; ++d0) qr[d0] = *(const bf16x8*)(Qw + (size_t)r32 * pitch + d0 * 16 + hi * 8);
}

struct ModFox { const LAS float* cb; int kbase, qpos, hi; bool diag;
    __device__ __forceinline__ void operator()(f32x16& p0, f32x16& p1) const {
#pragma unroll
        for (int i = 0; i < 4; ++i) { const f32x4 c0 = *(const LAS f32x4*)(cb + kbase + 8 * i + 4 * hi), c1 = *(const LAS f32x4*)(cb + kbase + 32 + 8 * i + 4 * hi);
#pragma unroll
            for (int j = 0; j < 4; ++j) { p0[4 * i + j] += c0[j]; p1[4 * i + j] += c1[j]; } }
        if (diag) {
#pragma unroll
            for (int r = 0; r < 16; ++r) { const int kv = kbase + crow(r, hi); if (kv > qpos) p0[r] = NEG; if (kv + 32 > qpos) p1[r] = NEG; } }
    } };
struct ModFoxF { const LAS float* cb; int qpos, hi, q0w;
    __device__ __forceinline__ ModFox operator()(int kt) const { return ModFox{cb, kt * 64, qpos, hi, kt * 64 + 63 > q0w}; } };
struct ModT5 { const LAS float* tb; int kbase, qpos, hi, window; bool enabled;
    __device__ __forceinline__ void operator()(f32x16& p0, f32x16& p1) const {
#pragma unroll
        for (int r = 0; r < 16; ++r) { const int d0 = qpos - (kbase + crow(r, hi)), d1 = d0 - 32;
            const float b0 = tb[min(max(d0, 0), 127)], b1 = tb[min(max(d1, 0), 127)];
            p0[r] = (enabled && d0 >= 0 && d0 < window) ? p0[r] + b0 : NEG;
            p1[r] = (enabled && d1 >= 0 && d1 < window) ? p1[r] + b1 : NEG; }
    } };
struct ModWinF { const LAS float* tb; int qpos, hi;
    __device__ __forceinline__ ModT5 operator()(int kt) const { return ModT5{tb, kt * 64, qpos, hi, 512, true}; } };
struct ModSelF { const LAS float* tb; int qpos, hi; unsigned mask;
    __device__ __forceinline__ ModT5 operator()(int kt) const { return ModT5{tb, kt * 64, qpos, hi, 1 << 30, ((mask >> kt) & 1u) != 0u}; } };
}
#ifndef STAGE_LIMIT
#define STAGE_LIMIT 4
#endif
constexpr size_t MiB = 1u << 20;
constexpr size_t WS_CTL = 0, CTL_ZERO_BYTES = 2 * MiB;
constexpr size_t WS_SS = 256 * 1024;
constexpr size_t WS_SSM = 640 * 1024;
constexpr size_t WS_F32S = 2 * MiB;
constexpr size_t WS_CUM = 4 * MiB;
constexpr size_t WS_MASK = 4 * MiB + 512 * 1024;
constexpr size_t WS_UMASK = WS_MASK + 128 * 1024;
constexpr size_t WS_KC = 5 * MiB, WS_VC = 5 * MiB + 256 * 1024;
constexpr size_t WS_POSC = 5 * MiB + 512 * 1024;
constexpr size_t WS_WGU1 = 8 * MiB, WS_WD1 = 19 * MiB, WS_WIN = 25 * MiB, WS_WUPN = 35 * MiB, WS_WUPF = 36 * MiB, WS_WOUT = 37 * MiB, WS_WMQ = 39 * MiB,
                 WS_WMKV = 41 * MiB, WS_WMO = 45 * MiB, WS_WGU2 = 47 * MiB, WS_WD2 = 58 * MiB, WS_CW1K = 64 * MiB, WS_CW1V = 65 * MiB, WS_CW2K = 66 * MiB, WS_CW2V = 66 * MiB + 256 * 1024;
constexpr size_t WS_KM = 8 * MiB, WS_VT = 12 * MiB;
constexpr size_t WS_XB = 68 * MiB;
constexpr size_t WS_QN = 100 * MiB, WS_KVN = 116 * MiB, WS_QF = 140 * MiB, WS_KVF = 156 * MiB, WS_GAB = 188 * MiB;
constexpr size_t WS_H = 100 * MiB;
constexpr size_t WS_Y = WS_KVF;
constexpr size_t WS_QM = 108 * MiB, WS_PM = 188 * MiB, WS_OM = 140 * MiB;
constexpr size_t WS_MEMB = 252 * MiB, WS_END = 256 * MiB;
static_assert(WS_WD2 + (size_t)DM * FF * 2 <= WS_CW1K && WS_GAB + (size_t)M * 2048 * 2 <= WS_MEMB && WS_H + (size_t)M * FF * 2 <= WS_GAB, "ws map");
constexpr int CW_BAR = 4096;
constexpr int RING_BYTES = 131072, LDS_BYTES = 147456;

__device__ const unsigned char T5B[128] = {0, 1, 2, 3, 4, 5, 6, 7, 8, 9, 10, 11, 12, 13, 14, 15, 16, 16, 16, 17, 17, 18, 18, 18, 19, 19, 19, 20, 20, 20, 20, 21, 21, 21, 21, 22, 22, 22, 22, 22, 23, 23, 23, 23, 23, 23, 24, 24, 24, 24, 24, 24, 25, 25, 25, 25, 25, 25, 25, 26, 26, 26, 26, 26, 26, 26, 26, 27, 27, 27, 27, 27, 27, 27, 27, 27, 27, 28, 28, 28, 28, 28, 28, 28, 28, 28, 28, 29, 29, 29, 29, 29, 29, 29, 29, 29, 29, 29, 29, 30, 30, 30, 30, 30, 30, 30, 30, 30, 30, 30, 30, 30, 30, 31, 31, 31, 31, 31, 31, 31, 31, 31, 31, 31, 31, 31, 31, 31};


#define XB_TMO      128
#define XB_XCNT(j)  (256  + 64 * (j))
#define XB_XSUB(j)  (1280 + 64 * (j))
#define XB_XGEN(j)  (2304 + 64 * (j))
#define XB_TOP      3328
#define XB_TOPGEN   3392
#define XCD_BAR_WORDS 3456
#define XB_SPIN_CAP (1u << 18)
__device__ __forceinline__ unsigned xb_ld(unsigned* p)              { return __hip_atomic_load(p, __ATOMIC_RELAXED, __HIP_MEMORY_SCOPE_AGENT); }
__device__ __forceinline__ unsigned xb_add(unsigned* p, unsigned v) { return __hip_atomic_fetch_add(p, v, __ATOMIC_RELAXED, __HIP_MEMORY_SCOPE_AGENT); }
__device__ __forceinline__ unsigned xb_xcc_id() { return (unsigned)__builtin_amdgcn_s_getreg((3 << 11) | 20) & 0xFu; }
#define XB_SPIN(cond, bar) do { unsigned _sp = 0; while (cond) { __builtin_amdgcn_s_sleep(1); \
    if ((++_sp & 255u) == 0u) { if (xb_ld(&(bar)[XB_TMO])) break; if (_sp > XB_SPIN_CAP) { atomicAdd(&(bar)[XB_TMO], 1u); break; } } } } while (0)
struct XcdBarrier { unsigned* bar; unsigned x; volatile LAS unsigned* st; };
__device__ __forceinline__ XcdBarrier xcd_barrier_post(unsigned* bar, volatile LAS unsigned* st) {
    XcdBarrier b; b.bar = bar; b.x = xb_xcc_id(); b.st = st;
    if (threadIdx.x == 0) (void)xb_add(&bar[XB_XCNT(b.x)], 1u);
    return b;
}
__device__ __forceinline__ void xcd_barrier_complete(unsigned* bar, unsigned x, unsigned& nloc, unsigned& nx) {
    const unsigned G = gridDim.x * gridDim.y * gridDim.z;
    unsigned sum, cnt, mine, sp = 0u;
    for (;;) {
        sum = 0u; cnt = 0u; mine = 0u;
#pragma unroll
        for (unsigned j = 0; j < 16; ++j) { const unsigned c = xb_ld(&bar[XB_XCNT(j)]); sum += c; cnt += (c > 0u) ? 1u : 0u; mine = (j == x) ? c : mine; }
        if (sum == G) break;
        __builtin_amdgcn_s_sleep(1);
        if ((++sp & 255u) == 0u) { if (xb_ld(&bar[XB_TMO])) break; if (sp > XB_SPIN_CAP) { atomicAdd(&bar[XB_TMO], 1u); break; } }
    }
    nloc = mine > 0u ? mine : 1u; nx = cnt > 0u ? cnt : 1u;
}
__device__ __forceinline__ void xcd_barrier(const XcdBarrier& b) {
    asm volatile("s_waitcnt vmcnt(0)" ::: "memory");
    __syncthreads();
    if (threadIdx.x == 0) {
        unsigned* bar = b.bar;
        __builtin_amdgcn_s_waitcnt(0);
        unsigned nloc = b.st[0], nx = b.st[1];
        if (nloc == 0u) { xcd_barrier_complete(bar, b.x, nloc, nx); b.st[0] = nloc; b.st[1] = nx; }
        const unsigned old = xb_add(&bar[XB_XSUB(b.x)], 1u);
        const unsigned gen = old / nloc;
        if (old + 1u == (gen + 1u) * nloc) {
            __builtin_amdgcn_fence(__ATOMIC_RELEASE, "agent");
            asm volatile("s_waitcnt vmcnt(0)" ::: "memory");
            const unsigned og = xb_add(&bar[XB_TOP], 1u);
            const unsigned tg = og / nx;
            if (og + 1u == (tg + 1u) * nx) xb_add(&bar[XB_TOPGEN], 1u);
            else XB_SPIN(xb_ld(&bar[XB_TOPGEN]) == tg, bar);
            __builtin_amdgcn_fence(__ATOMIC_ACQUIRE, "agent");
            xb_add(&bar[XB_XGEN(b.x)], 1u);
            asm volatile("s_waitcnt vmcnt(0)" ::: "memory");
        } else {
            XB_SPIN(xb_ld(&bar[XB_XGEN(b.x)]) == gen, bar);
            __builtin_amdgcn_fence(__ATOMIC_ACQUIRE, "agent");
            asm volatile("s_waitcnt vmcnt(0)" ::: "memory");
        }
    }
    __syncthreads();
}

struct Args { const float* in[29]; float* out; unsigned char* ws; int lo, hi; };
enum { I_X = 0, I_MEM, I_RELB, I_F1N, I_F1G, I_F1U, I_F1D, I_MIXN, I_WIN, I_BF, I_POSK, I_POSV, I_CK1, I_CK2, I_CV1, I_CV2, I_UPN, I_UPF, I_WOUT, I_MQN, I_MKVN, I_MWQ, I_MWKV, I_MWO, I_F2N, I_F2G, I_F2U, I_F2D, I_FINN };

__device__ __forceinline__ float wave_sum(float v) {
#pragma unroll
    for (int o = 1; o < 64; o <<= 1) v += __shfl_xor(v, o);
    return v;
}
template <class CM>
__device__ __forceinline__ void tr_item(const float* W, int ldsrc, int K, bf16_t* WT, int k0, int dstrow0, const float* gain, LAS float* scr, int lane, const CM& cm) {
    const int n = lane & 31; int sc; float scl; cm(dstrow0 + n, sc, scl);
#pragma unroll 8
    for (int i = 0; i < 32; ++i) { const int kk = 2 * i + (lane >> 5); float v = 0.f;
        if (sc >= 0) { v = W[(size_t)(k0 + kk) * ldsrc + sc] * scl; if (gain) v *= gain[k0 + kk]; }
        scr[kk * 33 + n] = v; }
    asm volatile("s_waitcnt lgkmcnt(0)" ::: "memory");
    const int c = lane & 7;
#pragma unroll
    for (int j = 0; j < 4; ++j) { const int nn = (lane >> 3) + 8 * j; const LAS float* s = scr + (8 * c) * 33 + nn;
        u32x4 o; o.x = cvtpk(s[0 * 33], s[1 * 33]); o.y = cvtpk(s[2 * 33], s[3 * 33]); o.z = cvtpk(s[4 * 33], s[5 * 33]); o.w = cvtpk(s[6 * 33], s[7 * 33]);
        *(u32x4*)(WT + (size_t)(dstrow0 + nn) * K + k0 + 8 * c) = o; }
    asm volatile("s_waitcnt lgkmcnt(0)" ::: "memory");
}
struct CmPlain { int off; float s; __device__ __forceinline__ void operator()(int n, int& sc, float& scl) const { sc = n + off; scl = s; } };
struct CmWin { __device__ __forceinline__ void operator()(int n, int& sc, float& scl) const {
    scl = 1.f;
    if (n < 512) { sc = n; scl = QS64; }
    else if (n < 1280) sc = n;
    else if (n < 1792) { sc = 1304 + (n - 1280); scl = QS64; }
    else if (n < 2816) sc = 1816 + (n - 1792);
    else if (n < 4864) sc = 2848 + (n - 2816);
    else if (n < 4888) sc = 1280 + (n - 4864);
    else if (n < 4896) sc = 2840 + (n - 4888);
    else sc = -1; } };

__device__ __forceinline__ void p0_prologue(const Args& a, LAS unsigned char* lds, int gw, int NGW, int wave, int lane) {
    unsigned char* ws = a.ws;
    LAS float* scr = (LAS float*)(lds + wave * 16384);
    constexpr int N_GU = 16 * 176, N_D = 44 * 32, N_WIN = 16 * 160, N_UP = 8 * 32, N_SQ = 16 * 32, N_MKV = 16 * 64, N_C1 = 32 * 8, N_C2 = 4 * 2;
    constexpr int NITEMS = 2 * N_GU + 2 * N_D + N_WIN + 2 * N_UP + 3 * N_SQ + N_MKV + 2 * N_C1 + 2 * N_C2;
    for (int it = gw; it < NITEMS; it += NGW) {
        int r = it;
        if (r < 2 * N_GU) { const int f = r >= N_GU; r -= f * N_GU; const int kb = r / 176, gi = r % 176, dr = gi * 32, tile = dr >> 8, within = dr & 255;
            const float* W = a.in[within < 128 ? (f ? I_F2G : I_F1G) : (f ? I_F2U : I_F1U)];
            tr_item(W, FF, DM, (bf16_t*)(ws + (f ? WS_WGU2 : WS_WGU1)), kb * 64, dr, a.in[f ? I_F2N : I_F1N], scr, lane, CmPlain{tile * 128 + (within & 127) - dr, 1.f}); continue; }
        r -= 2 * N_GU;
        if (r < 2 * N_D) { const int f = r >= N_D; r -= f * N_D; const int kb = r / 32, gi = r % 32;
            tr_item(a.in[f ? I_F2D : I_F1D], DM, FF, (bf16_t*)(ws + (f ? WS_WD2 : WS_WD1)), kb * 64, gi * 32, nullptr, scr, lane, CmPlain{0, 1.f}); continue; }
        r -= 2 * N_D;
        if (r < N_WIN) { const int kb = r / 160, gi = r % 160; tr_item(a.in[I_WIN], 4896, DM, (bf16_t*)(ws + WS_WIN), kb * 64, gi * 32, a.in[I_MIXN], scr, lane, CmWin{}); continue; }
        r -= N_WIN;
        if (r < 2 * N_UP) { const int f = r >= N_UP; r -= f * N_UP; const int kb = r / 32, gi = r % 32;
            tr_item(a.in[f ? I_UPF : I_UPN], DM, 512, (bf16_t*)(ws + (f ? WS_WUPF : WS_WUPN)), kb * 64, gi * 32, nullptr, scr, lane, CmPlain{0, 1.f}); continue; }
        r -= 2 * N_UP;
        if (r < 3 * N_SQ) { const int f = r / N_SQ; r -= f * N_SQ; const int kb = r / 32, gi = r % 32;
            tr_item(a.in[f == 0 ? I_WOUT : (f == 1 ? I_MWQ : I_MWO)], DM, DM, (bf16_t*)(ws + (f == 0 ? WS_WOUT : (f == 1 ? WS_WMQ : WS_WMO))), kb * 64, gi * 32, f == 1 ? a.in[I_MQN] : nullptr, scr, lane,
                    CmPlain{0, f == 1 ? QS256 : 1.f}); continue; }
        r -= 3 * N_SQ;
        if (r < N_MKV) { const int kb = r / 64, gi = r % 64; tr_item(a.in[I_MWKV], 2048, DM, (bf16_t*)(ws + WS_WMKV), kb * 64, gi * 32, a.in[I_MKVN], scr, lane, CmPlain{0, 1.f}); continue; }
        r -= N_MKV;
        if (r < 2 * N_C1) { const int f = r >= N_C1; r -= f * N_C1; const int kb = r / 8, gi = r % 8;
            tr_item(a.in[f ? I_CV1 : I_CK1], 256, 2048, (bf16_t*)(ws + (f ? WS_CW1V : WS_CW1K)), kb * 64, gi * 32, nullptr, scr, lane, CmPlain{0, 1.f}); continue; }
        r -= 2 * N_C1;
        { const int f = r >= N_C2; r -= f * N_C2; const int kb = r / 2, gi = r % 2;
            tr_item(a.in[f ? I_CV2 : I_CK2], 64, 256, (bf16_t*)(ws + (f ? WS_CW2V : WS_CW2K)), kb * 64, gi * 32, nullptr, scr, lane, CmPlain{0, 1.f}); }
    }
    for (int mrow = gw; mrow < M + MROWS; mrow += NGW) {
        const bool ismem = mrow >= M; const int rr = ismem ? mrow - M : mrow;
        const f32x4* xr = (const f32x4*)((ismem ? a.in[I_MEM] : a.in[I_X]) + (size_t)rr * DM) + lane;
        unsigned long long* o8 = (unsigned long long*)((bf16_t*)(ws + (ismem ? WS_MEMB : WS_XB)) + (size_t)rr * DM) + lane;
        float s = 0.f;
#pragma unroll
        for (int j = 0; j < 4; ++j) { const f32x4 v = xr[64 * j]; s += (v[0] * v[0] + v[1] * v[1]) + (v[2] * v[2] + v[3] * v[3]);
            o8[64 * j] = (unsigned long long)cvtpk(v[0], v[1]) | ((unsigned long long)cvtpk(v[2], v[3]) << 32); }
        s = wave_sum(s);
        if (lane == 0) ((float*)(ws + (ismem ? WS_SSM : WS_SS)))[rr] = s;
    }
    for (int t = gw; t < 512; t += NGW) { const int kv = t >> 8, n = t & 255; const float* pos = a.in[kv ? I_POSV : I_POSK]; const float* w1 = a.in[kv ? I_CV1 : I_CK1];
        float s = 0.f;
        for (int k = lane; k < 2048; k += 64) s += pos[k] * w1[(size_t)k * 256 + n];
        s = wave_sum(s);
        if (lane == 0) ((float*)(ws + WS_POSC))[t] = s; }
}

__device__ __forceinline__ void compress_unit(const Args& a, LAS unsigned char* lds, int uidx) {
    unsigned char* ws = a.ws;
    const int tid = fresh_tid(), lane = tid & 63, r32 = lane & 31, hi = lane >> 5, wid = __builtin_amdgcn_readfirstlane(tid >> 6);
    const int kv = uidx >> 6, b = (uidx >> 3) & 7, g = (uidx >> 2) & 1, chunk = uidx & 3, n0 = chunk * 32;
    const bf16_t* W1 = (const bf16_t*)(ws + (kv ? WS_CW1V : WS_CW1K)); const bf16_t* W2 = (const bf16_t*)(ws + (kv ? WS_CW2V : WS_CW2K));
    const float* posc = (const float*)(ws + WS_POSC) + kv * 256;
    const bf16_t* arow = (const bf16_t*)(ws + WS_KVN) + (size_t)(b * SEQ) * 768 + kv * 128 + g * 64 + hi * 8;
    const bf16_t* brow = W1 + (size_t)(32 * wid + r32) * 2048 + hi * 8;
    const int tok = 16 * (n0 + r32);
    f32x16 acc = f32x16{};
#pragma unroll 8
    for (int kk = 0; kk < 128; ++kk) { const int l = kk >> 2, d = (kk & 3) * 16; const int t = min(tok + l, SEQ - 1);
        const bf16x8 av = *(const bf16x8*)(arow + (size_t)t * 768 + d); const bf16x8 bv = *(const bf16x8*)(brow + kk * 16);
        acc = __builtin_amdgcn_mfma_f32_32x32x16_bf16(av, bv, acc, 0, 0, 0); }
    LAS bf16_t* Hs = (LAS bf16_t*)lds;
    const float pc = posc[32 * wid + r32];
#pragma unroll
    for (int r = 0; r < 16; ++r) { const float x = acc[r] + pc; const float u = 0.7978845608028654f * (x + 0.044715f * x * x * x);
        const float ge = x * frcp(1.0f + fexp2(-2.0f * LOG2E * u)); Hs[att::crow(r, hi) * 264 + 32 * wid + r32] = (bf16_t)(cvtpk(ge, 0.f) & 0xffffu); }
    __syncthreads();
    if (wid < 2) { f32x16 acc2 = f32x16{};
#pragma unroll
        for (int kk = 0; kk < 16; ++kk) { const bf16x8 av = *(const LAS bf16x8*)(Hs + r32 * 264 + kk * 16 + hi * 8); const bf16x8 bv = *(const bf16x8*)(W2 + (size_t)(32 * wid + r32) * 256 + kk * 16 + hi * 8);
            acc2 = __builtin_amdgcn_mfma_f32_32x32x16_bf16(av, bv, acc2, 0, 0, 0); }
        bf16_t* outp = (bf16_t*)(ws + (kv ? WS_VC : WS_KC)) + (size_t)((b * 2 + g) * 128) * 64;
#pragma unroll
        for (int r = 0; r < 16; ++r) { const int n = n0 + att::crow(r, hi); const float v = n < 127 ? acc2[r] : 0.f; outp[(size_t)n * 64 + 32 * wid + r32] = (bf16_t)(cvtpk(v, 0.f) & 0xffffu); } }
    __syncthreads();
}
__device__ __forceinline__ void cumsum_task(const Args& a, int task, int lane) {
    const int b = task >> 3, h = task & 7; const float bf = a.in[I_BF][h];
    const float* fl = (const float*)(a.ws + WS_F32S) + (size_t)(b * SEQ) * 32 + 24 + h; float* out = (float*)(a.ws + WS_CUM) + (size_t)task * SEQ;
    float tot = 0.f;
    for (int i = 0; i < 32; ++i) { const float v = fl[(size_t)(32 * lane + i) * 32] + bf; tot += fminf(v, 0.f) - log1pf(expf(-fabsf(v))); }
    float inc = tot;
#pragma unroll
    for (int o = 1; o < 64; o <<= 1) { const float t = __shfl_up(inc, o); if (lane >= o) inc += t; }
    float run = inc - tot;
    for (int i = 0; i < 32; ++i) { const float v = fl[(size_t)(32 * lane + i) * 32] + bf; run += fminf(v, 0.f) - log1pf(expf(-fabsf(v))); out[32 * lane + i] = -run * LOG2E; }
}

__device__ __forceinline__ void init_t5_table(const Args& a, LAS unsigned char* lds) {
    LAS float* T = (LAS float*)(lds + att::L_TBL);
    for (int i = fresh_tid(); i < 1024; i += 512) { const int h = i >> 7, d = i & 127; T[i] = a.in[I_RELB][T5B[d] * 8 + h] * LOG2E; }
}
__device__ __forceinline__ void fox_unit(const Args& a, LAS unsigned char* lds, int b, int h, int qb) {
    using namespace att;
    unsigned char* ws = a.ws;
    const int tid = fresh_tid(), lane = tid & 63, r32 = lane & 31, hi = lane >> 5, wid = __builtin_amdgcn_readfirstlane(tid >> 6);
    const int q0 = qb * 256, q0w = q0 + wid * 32, qpos = q0w + r32;
    LAS float* cb = (LAS float*)(lds + L_CB); LAS float* wsf = (LAS float*)(lds + L_WSF) + wid * 64;
    const float* cum = (const float*)(ws + WS_CUM) + (size_t)(b * 8 + h) * SEQ;
    for (int i = tid; i < q0 + 256; i += 512) cb[i] = cum[i];
    bf16_t* Qw = (bf16_t*)(ws + WS_QF) + (size_t)(b * SEQ + q0w) * 512 + h * 64;
    bf16x8 qr[4]; load_q(qr, Qw, 512, r32, hi);
    f32x16 o[2]; o[0] = f32x16{}; o[1] = f32x16{}; float m = -1e30f, l = 0.f;
    const int nt = 4 * qb + 4; const unsigned tmask = nt >= 32 ? 0xffffffffu : ((1u << nt) - 1u);
    const bf16_t* Kg = (const bf16_t*)(ws + WS_KVF) + (size_t)(b * SEQ) * 1024 + h * 64;
    attn_loop(tmask, Kg, 1024, Kg + 512, 1024, lds, qr, o, m, l, ModFoxF{cb, qpos, hi, q0w}, q0w + 31);
    l = halfsum(l);
    scale_rows(o, wsf, 1.0f / l, r32, hi);
    store_o<false>(o, lds, Qw, 512, nullptr, 0);
}
__device__ __forceinline__ void cmpwin_unit(const Args& a, LAS unsigned char* lds, int b, int g, int qb) {
    using namespace att;
    unsigned char* ws = a.ws;
    const int tid = fresh_tid(), lane = tid & 63, r32 = lane & 31, hi = lane >> 5, wid = __builtin_amdgcn_readfirstlane(tid >> 6);
    const int j = wid >> 1, sub = wid & 1, hg = g * 4 + j, q0w = qb * 64 + sub * 32, qpos = q0w + r32; const size_t qrow = (size_t)b * SEQ + qpos;
    const LAS float* tb = (const LAS float*)(lds + L_TBL) + hg * 128;
    LAS float* wsf = (LAS float*)(lds + L_WSF) + wid * 64; LAS float* PS = (LAS float*)(lds + L_PS); LAS float* IMP = (LAS float*)(lds + L_IMP); LAS unsigned* MW = (LAS unsigned*)(lds + L_MISC);
    const float* gates = (const float*)(ws + WS_F32S) + qrow * 32;
    for (int i = tid; i < 64 * 129; i += 512) PS[i] = 0.f;
    if (tid == 0) MW[0] = 0u;
    bf16x8 qr[4]; load_q(qr, (const bf16_t*)(ws + WS_QN) + (size_t)(b * SEQ + q0w) * 512 + hg * 64, 512, r32, hi);
    const StageGeo sg = stage_geo(tid);
    { const bf16_t* Kc = (const bf16_t*)(ws + WS_KC) + (size_t)((b * 2 + g) * 128) * 64; const bf16_t* Vc = (const bf16_t*)(ws + WS_VC) + (size_t)((b * 2 + g) * 128) * 64;
#pragma unroll
        for (int t = 0; t < 2; ++t) { *(LAS u32x4*)(lds + L_SLOT + t * 16384 + sg.koff) = *(const u32x4*)(Kc + (size_t)(t * 64 + sg.krow) * 64 + sg.kcol);
            *(LAS u32x4*)(lds + L_SLOT + t * 16384 + sg.voff) = *(const u32x4*)(Vc + (size_t)(t * 64 + sg.vrow) * 64 + sg.vcol); } }
    __syncthreads();
    f32x16 oc[2]; oc[0] = f32x16{}; oc[1] = f32x16{};
    {
        f32x16 a0, a1, b0, b1; qkt(a0, a1, lds + L_SLOT, qr, r32, hi); qkt(b0, b1, lds + L_SLOT + 16384, qr, r32, hi);
        float mx = NEG;
#pragma unroll
        for (int r = 0; r < 16; ++r) { const int d = qpos - 16 * crow(r, hi) - 31;
            a0[r] = d >= 0 ? a0[r] + tb[min(d, 127)] : NEG; a1[r] = d - 512 >= 0 ? a1[r] + tb[min(d - 512, 127)] : NEG;
            b0[r] = d - 1024 >= 0 ? b0[r] + tb[min(d - 1024, 127)] : NEG; b1[r] = d - 1536 >= 0 ? b1[r] + tb[min(d - 1536, 127)] : NEG;
            mx = fmaxf(fmaxf(mx, fmaxf(a0[r], a1[r])), fmaxf(b0[r], b1[r])); }
        { auto rr = __builtin_amdgcn_permlane32_swap(__float_as_uint(mx), __float_as_uint(mx), false, false); mx = fmaxf(__uint_as_float(rr[0]), __uint_as_float(rr[1])); }
        const float mxs = mx == NEG ? 0.f : mx; float s = 0.f;
#pragma unroll
        for (int r = 0; r < 16; ++r) { a0[r] = fexp2(a0[r] - mxs); a1[r] = fexp2(a1[r] - mxs); b0[r] = fexp2(b0[r] - mxs); b1[r] = fexp2(b1[r] - mxs); s += (a0[r] + a1[r]) + (b0[r] + b1[r]); }
        s = halfsum(s); const float inv = s > 0.f ? 1.0f / s : 0.f;
        LAS float* psr = PS + (sub * 32 + r32) * 129;
#pragma unroll
        for (int r = 0; r < 16; ++r) { a0[r] *= inv; a1[r] *= inv; b0[r] *= inv; b1[r] *= inv; const int c = crow(r, hi);
            __hip_atomic_fetch_add(psr + c, a0[r], __ATOMIC_RELAXED, __HIP_MEMORY_SCOPE_WORKGROUP); __hip_atomic_fetch_add(psr + c + 32, a1[r], __ATOMIC_RELAXED, __HIP_MEMORY_SCOPE_WORKGROUP); __hip_atomic_fetch_add(psr + c + 64, b0[r], __ATOMIC_RELAXED, __HIP_MEMORY_SCOPE_WORKGROUP); __hip_atomic_fetch_add(psr + c + 96, b1[r], __ATOMIC_RELAXED, __HIP_MEMORY_SCOPE_WORKGROUP); }
        const int vb0 = (int)(unsigned)(size_t)(lds + L_SLOT + 8192) + ((lane >> 4) & 1) * 32 + (lane & 3) * 8 + (4 * hi + ((lane & 15) >> 2)) * 64;
        bf16x8 x0, x1, x2, x3; pack_p(a0, a1, x0, x1, x2, x3); pv(oc, vb0, x0, x1, x2, x3);
        pack_p(b0, b1, x0, x1, x2, x3); pv(oc, vb0 + 16384, x0, x1, x2, x3);
        scale_rows(oc, wsf, sigmoidf_(gates[hg]), r32, hi);
    }
    __syncthreads();
    {
        const int q = tid >> 3, jb = (tid & 7) * 4; const LAS float* ps = PS + q * 129; LAS float* im = IMP + q * 33;
#pragma unroll
        for (int jj = 0; jj < 4; ++jj) { const int jx = jb + jj, c0 = 4 * jx - 1;
            const float v = (c0 >= 0 ? ps[c0] : 0.f) + 2.0f * (ps[c0 + 1] + ps[c0 + 2] + ps[c0 + 3]) + ps[c0 + 4];
            const bool valid = jx <= qb, forced = (jx == 0) || (jx == qb) || (jx == qb - 1);
            im[jx] = valid ? v + (forced ? 1e4f : 0.f) : -1e30f; }
        __syncthreads();
        unsigned bits = 0u;
#pragma unroll
        for (int jj = 0; jj < 4; ++jj) { const int jx = jb + jj; const float v = im[jx]; int cnt = 0;
            for (int j2 = 0; j2 < 32; ++j2) { const float v2 = im[j2]; cnt += (v2 > v || (v2 == v && j2 < jx)) ? 1 : 0; }
            if (cnt < 16 && jx <= qb) bits |= 1u << jx; }
        bits |= __shfl_xor(bits, 1); bits |= __shfl_xor(bits, 2); bits |= __shfl_xor(bits, 4);
        if ((tid & 7) == 0) { ((unsigned*)(ws + WS_MASK))[(size_t)(b * 2 + g) * SEQ + qb * 64 + q] = bits; __hip_atomic_fetch_or(MW, bits, __ATOMIC_RELAXED, __HIP_MEMORY_SCOPE_WORKGROUP); }
        __syncthreads();
        if (tid == 0) ((unsigned*)(ws + WS_UMASK))[(b * 2 + g) * 32 + qb] = MW[0];
    }
    f32x16 o[2]; o[0] = f32x16{}; o[1] = f32x16{}; float m = -1e30f, l = 0.f;
    const int lo = qb > 8 ? qb - 8 : 0; const unsigned tmask = (qb >= 31 ? 0xffffffffu : ((2u << qb) - 1u)) & ~((1u << lo) - 1u);
    const bf16_t* Kg = (const bf16_t*)(ws + WS_KVN) + (size_t)(b * SEQ) * 768 + 512 + g * 64;
    attn_loop(tmask, Kg, 768, Kg + 128, 768, lds, qr, o, m, l, ModWinF{tb, qpos, hi}, q0w + 31);
    l = halfsum(l);
    scale_rows(o, wsf, sigmoidf_(gates[16 + hg]) / l, r32, hi);
    o[0] += oc[0]; o[1] += oc[1];
    store_o<false>(o, lds, (bf16_t*)(ws + WS_XB) + (size_t)(b * SEQ + q0w) * 512 + hg * 64, 512, nullptr, 0);
}
__device__ __forceinline__ void sel_unit(const Args& a, LAS unsigned char* lds, int b, int g, int qb) {
    using namespace att;
    unsigned char* ws = a.ws;
    const int tid = fresh_tid(), lane = tid & 63, r32 = lane & 31, hi = lane >> 5, wid = __builtin_amdgcn_readfirstlane(tid >> 6);
    const int j = wid >> 1, sub = wid & 1, hg = g * 4 + j, q0w = qb * 64 + sub * 32, qpos = q0w + r32; const size_t qrow = (size_t)b * SEQ + qpos;
    const LAS float* tb = (const LAS float*)(lds + L_TBL) + hg * 128; LAS float* wsf = (LAS float*)(lds + L_WSF) + wid * 64;
    bf16_t* Qw = (bf16_t*)(ws + WS_QN) + (size_t)(b * SEQ + q0w) * 512 + hg * 64;
    bf16x8 qr[4]; load_q(qr, Qw, 512, r32, hi);
    const unsigned mask = ((const unsigned*)(ws + WS_MASK))[(size_t)(b * 2 + g) * SEQ + qpos];
    const unsigned um = ((const unsigned*)(ws + WS_UMASK))[(b * 2 + g) * 32 + qb] & (qb >= 31 ? 0xffffffffu : ((2u << qb) - 1u));
    f32x16 o[2]; o[0] = f32x16{}; o[1] = f32x16{}; float m = -1e30f, l = 0.f;
    const bf16_t* Kg = (const bf16_t*)(ws + WS_KVN) + (size_t)(b * SEQ) * 768 + 256 + g * 64;
    attn_loop(um, Kg, 768, Kg + 128, 768, lds, qr, o, m, l, ModSelF{tb, qpos, hi, mask}, q0w + 31);
    l = halfsum(l);
    const float g1 = sigmoidf_(((const float*)(ws + WS_F32S))[qrow * 32 + 8 + hg]);
    scale_rows(o, wsf, g1 / l, r32, hi);
    store_o<true>(o, lds, Qw, 512, (const bf16_t*)(ws + WS_XB) + (size_t)(b * SEQ + q0w) * 512 + hg * 64, 512);
}
#ifndef PHMASK
#define PHMASK 0xffffffffu
#endif
#define PH(n) (((PHMASK) >> (n)) & 1u)
__global__ void __launch_bounds__(512, 2) hybrid_fwd(Args a) {
    extern __shared__ __attribute__((aligned(16))) unsigned char lds_raw[];
    LAS unsigned char* lds = (LAS unsigned char*)lds_raw;
    cg::grid_group grid = cg::this_grid();
    unsigned char* ws = a.ws;
    const int tid = fresh_tid(), lane = tid & 63, wave = __builtin_amdgcn_readfirstlane(tid >> 6);
    const int G = gridDim.x, bx = blockIdx.x, vcu = (G % 8 == 0) ? (bx % 8) * (G / 8) + bx / 8 : bx;
    const int gw = vcu * 8 + wave, NGW = G * 8;
    float* X = a.out;
    bf16_t* XB = (bf16_t*)(ws + WS_XB);
    float* SS = (float*)(ws + WS_SS);
    { volatile LAS unsigned* st0 = (volatile LAS unsigned*)(lds + RING_BYTES + 320); if (tid < 32) st0[tid] = 0u; }
    __syncthreads();
    XcdBarrier xbar = xcd_barrier_post((unsigned*)(ws + WS_CTL) + CW_BAR, (volatile LAS unsigned*)(lds + RING_BYTES + 320 + 32));
#ifdef USE_CG_SYNC
#define GSYNC() grid.sync()
#else
    if (a.lo == 0x7e57) grid.sync();
#define GSYNC() xcd_barrier(xbar)
#endif
    const float* fin_src = a.in[I_X];

#if STAGE_LIMIT >= 1
    p0_prologue(a, lds, gw, NGW, wave, lane);
    GSYNC();
    { pg8::Gemm g{XB, (const bf16_t*)(ws + WS_WGU1), DM, DM, DM, 0, 0, 0, 0}; pg8::Order S; S.init(64, 22, 1, G, bx);
      pg8::EpiGU E{(bf16_t*)(ws + WS_H), SS}; pg8::gemm_phase<pg8::EpiGU, true>(lds, g, S, E); }
    GSYNC();
    { pg8::Gemm g{(const bf16_t*)(ws + WS_H), (const bf16_t*)(ws + WS_WD1), FF, FF, FF, 0, 0, 0, 0}; pg8::Order S; S.init(64, 4, 1, G, bx);
      pg8::EpiRes<true, true> E{a.in[I_X], X, XB, SS + M, 0.5f}; pg8::gemm_phase<pg8::EpiRes<true, true>, false>(lds, g, S, E); }
    GSYNC();
    fin_src = X;
#endif
#if STAGE_LIMIT >= 2
#if PH(3)
    { pg8::Gemm g{XB, (const bf16_t*)(ws + WS_WIN), DM, DM, DM, 0, 0, 0, 0}; pg8::Order S; S.init(64, 20, 1, G, bx);
      pg8::EpiQKV E{(bf16_t*)(ws + WS_QN), (bf16_t*)(ws + WS_KVN), (bf16_t*)(ws + WS_QF), (bf16_t*)(ws + WS_KVF), (bf16_t*)(ws + WS_GAB), (float*)(ws + WS_F32S), SS + M};
      pg8::gemm_phase<pg8::EpiQKV, true>(lds, g, S, E); }
#endif
    GSYNC();
#if PH(4)
    if (bx < 128) { compress_unit(a, lds, bx); }
    else if (bx < 192) {
        if (bx < 160) { pg8::Gemm g{(const bf16_t*)(ws + WS_MEMB), (const bf16_t*)(ws + WS_WMKV), DM, DM, DM, 0, 0, 0, 0}; pg8::Order S; S.init(8, 4, 1, 32, bx - 128);
            pg8::EpiRowScale E{(bf16_t*)(ws + WS_KM), DM, (const float*)(ws + WS_SSM)}; pg8::gemm_phase<pg8::EpiRowScale, false>(lds, g, S, E); }
        else { pg8::Gemm g{(const bf16_t*)(ws + WS_WMKV) + (size_t)DM * DM, (const bf16_t*)(ws + WS_MEMB), DM, DM, DM, 0, 0, 0, 0}; pg8::Order S; S.init(4, 8, 1, 32, bx - 160);
            pg8::EpiColScale E{(bf16_t*)(ws + WS_VT), MROWS, (const float*)(ws + WS_SSM)}; pg8::gemm_phase<pg8::EpiColScale, false>(lds, g, S, E); }
    } else { if (wave == 0) cumsum_task(a, bx - 192, lane); }
#endif
    GSYNC();
#if PH(5)
    init_t5_table(a, lds);
    { const int bh = vcu >> 2, s = vcu & 3; fox_unit(a, lds, bh >> 3, bh & 7, 7 - s); fox_unit(a, lds, bh >> 3, bh & 7, s); }
    { const int bg = vcu >> 4, s = vcu & 15; cmpwin_unit(a, lds, bg >> 1, bg & 1, 31 - s); cmpwin_unit(a, lds, bg >> 1, bg & 1, s); }
#endif
    GSYNC();
#if PH(6)
    { const int bg = vcu >> 4, s = vcu & 15; sel_unit(a, lds, bg >> 1, bg & 1, 31 - s); sel_unit(a, lds, bg >> 1, bg & 1, s); }
#endif
    GSYNC();
#if PH(7)
    { pg8::Order S; S.init(64, 4, 1, G, bx);
      { pg8::Gemm g{(const bf16_t*)(ws + WS_QN), (const bf16_t*)(ws + WS_WUPN), 512, 512, 512, 0, 0, 0, 0}; pg8::EpiUp<0> E{(const bf16_t*)(ws + WS_GAB), (bf16_t*)(ws + WS_Y)}; pg8::gemm_phase<pg8::EpiUp<0>, false>(lds, g, S, E); }
      { pg8::Gemm g{(const bf16_t*)(ws + WS_QF), (const bf16_t*)(ws + WS_WUPF), 512, 512, 512, 0, 0, 0, 0}; pg8::EpiUp<1> E{(const bf16_t*)(ws + WS_GAB), (bf16_t*)(ws + WS_Y)}; pg8::gemm_phase<pg8::EpiUp<1>, false>(lds, g, S, E); } }
#endif
    GSYNC();
#if PH(8)
    { pg8::Gemm g{(const bf16_t*)(ws + WS_Y), (const bf16_t*)(ws + WS_WOUT), DM, DM, DM, 0, 0, 0, 0}; pg8::Order S; S.init(64, 4, 1, G, bx);
      pg8::EpiRes<true, true> E{X, X, XB, SS + 2 * M, 1.0f}; pg8::gemm_phase<pg8::EpiRes<true, true>, false>(lds, g, S, E); }
#endif
    GSYNC();
#endif
#if STAGE_LIMIT >= 3
    { pg8::Gemm g{XB, (const bf16_t*)(ws + WS_WMQ), DM, DM, DM, 0, 0, 0, 0}; pg8::Order S; S.init(64, 4, 1, G, bx);
      pg8::EpiRowScale E{(bf16_t*)(ws + WS_QM), DM, SS + 2 * M}; pg8::gemm_phase<pg8::EpiRowScale, false>(lds, g, S, E); }
    GSYNC();
    { pg8::Gemm g{(const bf16_t*)(ws + WS_QM), (const bf16_t*)(ws + WS_KM), DM, DM, 256, (long)SEQ * DM, 256, (long)MEMLEN * DM, 256}; pg8::Order S; S.init(8, 1, 32, G, bx);
      pg8::EpiSoftmax E{(bf16_t*)(ws + WS_PM)}; pg8::gemm_phase<pg8::EpiSoftmax, false>(lds, g, S, E); }
    GSYNC();
    { pg8::Gemm g{(const bf16_t*)(ws + WS_PM), (const bf16_t*)(ws + WS_VT), 256, MROWS, 256, (long)4 * SEQ * 256, (long)SEQ * 256, 256, (long)256 * MROWS}; pg8::Order S; S.init(8, 1, 32, G, bx);
      pg8::EpiBatchBf16 E{(bf16_t*)(ws + WS_OM), DM, (long)SEQ * DM, 256}; pg8::gemm_phase<pg8::EpiBatchBf16, false>(lds, g, S, E); }
    GSYNC();
    { pg8::Gemm g{(const bf16_t*)(ws + WS_OM), (const bf16_t*)(ws + WS_WMO), DM, DM, DM, 0, 0, 0, 0}; pg8::Order S; S.init(64, 4, 1, G, bx);
      pg8::EpiRes<true, true> E{X, X, XB, SS + 3 * M, 1.0f}; pg8::gemm_phase<pg8::EpiRes<true, true>, false>(lds, g, S, E); }
    GSYNC();
#endif
#if STAGE_LIMIT >= 4
    { pg8::Gemm g{XB, (const bf16_t*)(ws + WS_WGU2), DM, DM, DM, 0, 0, 0, 0}; pg8::Order S; S.init(64, 22, 1, G, bx);
      pg8::EpiGU E{(bf16_t*)(ws + WS_H), SS + 3 * M}; pg8::gemm_phase<pg8::EpiGU, true>(lds, g, S, E); }
    GSYNC();
    { pg8::Gemm g{(const bf16_t*)(ws + WS_H), (const bf16_t*)(ws + WS_WD2), FF, FF, FF, 0, 0, 0, 0}; pg8::Order S; S.init(64, 4, 1, G, bx);
      pg8::EpiRes<false, false> E{X, X, nullptr, nullptr, 0.5f}; pg8::gemm_phase<pg8::EpiRes<false, false>, false>(lds, g, S, E); }
    GSYNC();
#endif
    { const float* gn = a.in[I_FINN]; const int tid2 = fresh_tid(), lane = tid2 & 63, gw = vcu * 8 + (tid2 >> 6);
      for (int mrow = gw; mrow < M; mrow += NGW) {
          const f32x4* xr = (const f32x4*)(fin_src + (size_t)mrow * DM) + lane; f32x4* orow = (f32x4*)(X + (size_t)mrow * DM) + lane;
          f32x4 v[4]; float s = 0.f;
#pragma unroll
          for (int j = 0; j < 4; ++j) { v[j] = xr[64 * j]; s += (v[j][0] * v[j][0] + v[j][1] * v[j][1]) + (v[j][2] * v[j][2] + v[j][3] * v[j][3]); }
          const float rs = rstd_of(wave_sum(s));
#pragma unroll
          for (int j = 0; j < 4; ++j) orow[64 * j] = v[j] * rs * ((const f32x4*)gn)[lane + 64 * j];
      } }
}

extern "C" void kernel_launch(void* const* d_in, const int* in_sizes, int n_in, void* d_out, int out_size, void* d_ws, size_t ws_size, hipStream_t stream) {
    static int grid = 0;
    if (grid == 0) {
        if (n_in != 29 || out_size != M * DM || ws_size < WS_END) { fprintf(stderr, "kernel_launch: unexpected shapes (n_in %d out %d ws %zu)\n", n_in, out_size, ws_size); grid = -1; return; }
        int dev = 0, cus = 0, per_cu = 0;
        hipGetDevice(&dev); hipDeviceGetAttribute(&cus, hipDeviceAttributeMultiprocessorCount, dev);
        if (hipFuncSetAttribute((const void*)hybrid_fwd, hipFuncAttributeMaxDynamicSharedMemorySize, LDS_BYTES) != hipSuccess) { fprintf(stderr, "kernel_launch: hipFuncSetAttribute failed\n"); grid = -1; return; }
        if (hipOccupancyMaxActiveBlocksPerMultiprocessor(&per_cu, (const void*)hybrid_fwd, 512, LDS_BYTES) != hipSuccess || per_cu < 1) { fprintf(stderr, "kernel_launch: occupancy query failed (%d)\n", per_cu); per_cu = 1; }
        (void)hipGetLastError();
        grid = cus * (per_cu < 1 ? 1 : 1);
        if (grid != 256) fprintf(stderr, "kernel_launch: grid %d != 256: this kernel's phase maps assume 256 workgroups\n", grid);
    }
    if (grid < 0) return;
    hipMemsetAsync((char*)d_ws + WS_CTL, 0, CTL_ZERO_BYTES, stream);
    Args a{};
    for (int i = 0; i < 29; ++i) a.in[i] = (const float*)d_in[i];
    a.out = (float*)d_out; a.ws = (unsigned char*)d_ws; a.lo = 0; a.hi = 0;
    void* args[] = {&a};
    hipError_t e = hipLaunchCooperativeKernel((const void*)hybrid_fwd, dim3(grid), dim3(512), args, LDS_BYTES, stream);
    if (e != hipSuccess) fprintf(stderr, "kernel_launch: cooperative launch failed: %s (grid %d)\n", hipGetErrorString(e), grid);
}
```

```cpp
#include <hip/hip_runtime.h>
#include <hip/hip_cooperative_groups.h>
#include <cstdio>
#include <cstdint>
namespace cg = cooperative_groups;

#define LAS __attribute__((address_space(3)))
typedef unsigned short bf16_t;
typedef short bf16x8 __attribute__((ext_vector_type(8)));
typedef short s16x4 __attribute__((ext_vector_type(4)));
typedef float f32x2 __attribute__((ext_vector_type(2)));
typedef float f32x4 __attribute__((ext_vector_type(4)));
typedef float f32x16 __attribute__((ext_vector_type(16)));
typedef unsigned u32x2 __attribute__((ext_vector_type(2)));
typedef unsigned u32x4 __attribute__((ext_vector_type(4)));
typedef __bf16 bf16x2_t __attribute__((ext_vector_type(2)));

constexpr int NB = 8, SEQ = 2048, DM = 1024, FF = 2816, M = NB * SEQ;
constexpr int MEMLEN = 256, MROWS = NB * MEMLEN;
constexpr float RMS_EPS = 1e-6f;
constexpr float LOG2E = 1.4426950408889634f;
constexpr float QS64 = 0.125f * LOG2E;
constexpr float QS256 = 0.0625f * LOG2E;

__device__ __forceinline__ int fresh_tid() { int t = threadIdx.x; asm volatile("" : "+v"(t)); return t; }
__device__ __forceinline__ unsigned cvtpk(float lo, float hi) { f32x2 v = {lo, hi}; bf16x2_t b = __builtin_convertvector(v, bf16x2_t); return __builtin_bit_cast(unsigned, b); }
__device__ __forceinline__ float bflo(unsigned w) { return __uint_as_float(w << 16); }
__device__ __forceinline__ float bfhi(unsigned w) { return __uint_as_float(w & 0xffff0000u); }
__device__ __forceinline__ u32x4 pack8(f32x4 a, f32x4 b) { u32x4 w; w.x = cvtpk(a[0], a[1]); w.y = cvtpk(a[2], a[3]); w.z = cvtpk(b[0], b[1]); w.w = cvtpk(b[2], b[3]); return w; }
__device__ __forceinline__ float fexp2(float x) { return __builtin_amdgcn_exp2f(x); }
__device__ __forceinline__ float frcp(float x) { return __builtin_amdgcn_rcpf(x); }
__device__ __forceinline__ float sigmoidf_(float x) { return frcp(1.0f + fexp2(-x * LOG2E)); }
__device__ __forceinline__ float rstd_of(float ss) { return __builtin_amdgcn_rsqf(ss * (1.0f / DM) + RMS_EPS); }

namespace pg8 {
constexpr int BM = 256, BK = 64, HALF = 128, HTB = HALF * BK * 2, STAGE_BYTES = 8 * HTB, NXCD = 8, WGM = 8;
__host__ __device__ __forceinline__ int lds_byte(int r, int c) { const int st = (r >> 4) * 2 + (c >> 5), rr = r & 15, cc = c & 31, ob = rr * 64 + cc * 2; return st * 1024 + (ob ^ (((ob >> 9) & 1) << 5)); }
__host__ __device__ __forceinline__ void stage_rc(int b, int& R, int& C) { const int st = b / 1024, sb = b % 1024, swz = sb ^ (((sb >> 9) & 1) << 5); R = (st >> 1) * 16 + swz / 64; C = (st & 1) * 32 + (swz % 64) / 2; }
__host__ __device__ __forceinline__ int perm32(int rho) { const int n = rho >> 4, i = rho & 15; return 8 * (i >> 2) + 4 * n + (i & 3); }

struct Unit { int pm, pn, pb; };
struct Gemm { const bf16_t* A; const bf16_t* Bt; int lda, ldb, K; long sAb, sAh, sBb, sBh; };

struct Order {
    int nM, nN, nwg, G, c;
    __device__ __forceinline__ void init(int nM_, int nN_, int nB_, int G_, int c_) { nM = nM_; nN = nN_; nwg = nM_ * nN_ * nB_; G = G_; c = c_; }
    __device__ __forceinline__ bool next(int i, Unit& u) const {
        if (c < 0) return false;
        const long L = (long)i * G + c; if (L >= nwg) return false;
        int wgid = (int)L; { const int q = nwg / NXCD, r = nwg % NXCD, xcd = wgid % NXCD, off = wgid / NXCD; wgid = (xcd < r ? xcd * (q + 1) : r * (q + 1) + (xcd - r) * q) + off; }
        const int per = nM * nN; u.pb = wgid / per; const int w = wgid % per;
        const int nig = WGM * nN, gid = w / nig, fm = gid * WGM, gsz = (nM - fm) < WGM ? (nM - fm) : WGM;
        u.pm = fm + ((w % nig) % gsz); u.pn = (w % nig) / gsz; return true;
    }
};

typedef f32x4 Acc[2][2][4][2];

template <class Epi, bool ALIGN_EPI>
__device__ __forceinline__ void gemm_phase(LAS unsigned char* lds, const Gemm g, const Order& S, const Epi& E) {
    const int tid = fresh_tid(), wid = __builtin_amdgcn_readfirstlane(tid >> 6), lane = tid & 63, wr = wid >> 2, wc = wid & 3, fr = lane & 15, fq = lane >> 4;
    const int K = g.K, nt = K / BK;
    unsigned voffA[2], voffB[2];
#pragma unroll
    for (int i = 0; i < 2; ++i) { int R, C; stage_rc(tid * 16 + i * 8192, R, C); const int Rb = (R & ~31) + perm32(R & 31);
        voffA[i] = (unsigned)(R * g.lda + C) * 2u; voffB[i] = (unsigned)(Rb * g.ldb + C) * 2u; }
    const size_t kstep = (size_t)(BK * 2);
    const size_t hstepA = (size_t)HALF * g.lda * 2, hstepB = (size_t)HALF * g.ldb * 2;
    const size_t tstepA = 2 * hstepA, tstepB = 2 * hstepB;
    const unsigned ldsw = (unsigned)wid * 1024u;
    const int aoff = lds_byte(wr * 64 + fr, fq * 8), boff = lds_byte(wc * 32 + fr, fq * 8);
#define PG8_SA(b, h) (((b) * 2 + (h)) * HTB)
#define PG8_SB(b, h) ((4 + (b) * 2 + (h)) * HTB)
#define PG8_STAGE(bufoff, gbase, voff) do { _Pragma("unroll") for (int _i = 0; _i < 2; ++_i) \
        __builtin_amdgcn_global_load_lds((const unsigned*)((const char*)(gbase) + (voff)[_i]), (LAS unsigned*)(lds + (bufoff) + ldsw + _i * 8192), 16, 0, 0); } while (0)
#define PG8_LDA(dst, b, h) do { _Pragma("unroll") for (int m = 0; m < 4; ++m) _Pragma("unroll") for (int k = 0; k < 2; ++k) dst[m][k] = *(const LAS bf16x8*)(lds + PG8_SA(b, h) + aoff + m * 2048 + k * 1024); } while (0)
#define PG8_LDB(dst, b, h) do { _Pragma("unroll") for (int n = 0; n < 2; ++n) _Pragma("unroll") for (int k = 0; k < 2; ++k) dst[n][k] = *(const LAS bf16x8*)(lds + PG8_SB(b, h) + boff + n * 2048 + k * 1024); } while (0)
#define PG8_MMA(ai, bj, At, Bt) do { __builtin_amdgcn_s_setprio(1); _Pragma("unroll") for (int m = 0; m < 4; ++m) _Pragma("unroll") for (int n = 0; n < 2; ++n) _Pragma("unroll") for (int k = 0; k < 2; ++k) \
        acc[ai][bj][m][n] = __builtin_amdgcn_mfma_f32_16x16x32_bf16(Bt[n][k], At[m][k], acc[ai][bj][m][n], 0, 0, 0); __builtin_amdgcn_s_setprio(0); } while (0)
#define PG8_WAIT_V(n) asm volatile("s_waitcnt vmcnt(" #n ")" ::: "memory")
#define PG8_WAIT_L(n) asm volatile("s_waitcnt lgkmcnt(" #n ")" ::: "memory")
#define PG8_BAR __builtin_amdgcn_s_barrier()
#define PG8_SCHED __builtin_amdgcn_sched_barrier(0)
#define PG8_OFFA(u) ((size_t)(((u).pb >> 2) * g.sAb + ((u).pb & 3) * g.sAh) * 2 + (size_t)(u).pm * tstepA)
#define PG8_OFFB(u) ((size_t)(((u).pb >> 2) * g.sBb + ((u).pb & 3) * g.sBh) * 2 + (size_t)(u).pn * tstepB)
    Unit cur, nxt; int ui = 0;
    if (!S.next(0, cur)) return;
    Acc acc;
#pragma unroll
    for (int a = 0; a < 2; ++a)
#pragma unroll
        for (int b = 0; b < 2; ++b)
#pragma unroll
            for (int m = 0; m < 4; ++m)
#pragma unroll
                for (int n = 0; n < 2; ++n) acc[a][b][m][n] = (f32x4){0.f, 0.f, 0.f, 0.f};
    bf16x8 At[4][2], B0[2][2], B1[2][2];
    const char* cA = (const char*)g.A + PG8_OFFA(cur); const char* cB = (const char*)g.Bt + PG8_OFFB(cur);
    {
        PG8_STAGE(PG8_SB(0, 0), cB, voffB); PG8_STAGE(PG8_SB(0, 1), cB + hstepB, voffB); PG8_STAGE(PG8_SA(0, 0), cA, voffA); PG8_STAGE(PG8_SA(0, 1), cA + hstepA, voffA);
        if (wr == 1) PG8_BAR;
        PG8_WAIT_V(2); PG8_BAR;
        PG8_STAGE(PG8_SB(1, 0), cB + kstep, voffB); PG8_STAGE(PG8_SA(1, 0), cA + kstep, voffA); PG8_STAGE(PG8_SB(1, 1), cB + hstepB + kstep, voffB);
        PG8_WAIT_V(6); PG8_BAR;
    }
    for (;;) {
        const bool has_next = S.next(ui + 1, nxt);
        const char* nA = has_next ? (const char*)g.A + PG8_OFFA(nxt) : cA; const char* nB = has_next ? (const char*)g.Bt + PG8_OFFB(nxt) : cB;
        for (int t = 0; t < nt; t += 2) {
            const bool last = (t == nt - 2);
            const char* a1 = cA + (size_t)(t + 1) * kstep;
            const char* a2 = last ? nA : cA + (size_t)(t + 2) * kstep; const char* b2 = last ? nB : cB + (size_t)(t + 2) * kstep;
            const char* a3 = a2 + kstep; const char* b3 = b2 + kstep;
            PG8_LDB(B0, 0, 0); PG8_LDB(B1, 0, 1); PG8_SCHED; PG8_LDA(At, 0, 0); PG8_STAGE(PG8_SA(1, 1), a1 + hstepA, voffA);
            PG8_WAIT_V(8); PG8_WAIT_L(0); PG8_BAR; PG8_MMA(0, 0, At, B0); PG8_MMA(0, 1, At, B1); PG8_BAR; PG8_SCHED;
            PG8_LDA(At, 0, 1); PG8_STAGE(PG8_SB(0, 0), b2, voffB); PG8_STAGE(PG8_SB(0, 1), b2 + hstepB, voffB); PG8_STAGE(PG8_SA(0, 0), a2, voffA);
            PG8_WAIT_V(8); PG8_WAIT_L(0); PG8_BAR; PG8_MMA(1, 0, At, B0); PG8_MMA(1, 1, At, B1); PG8_BAR; PG8_SCHED;
            PG8_LDB(B0, 1, 0); PG8_LDB(B1, 1, 1); PG8_SCHED; PG8_LDA(At, 1, 0); PG8_STAGE(PG8_SA(0, 1), a2 + hstepA, voffA);
            PG8_WAIT_V(8); PG8_WAIT_L(0); PG8_BAR; PG8_MMA(0, 0, At, B0); PG8_MMA(0, 1, At, B1); PG8_BAR; PG8_SCHED;
            PG8_LDA(At, 1, 1); PG8_STAGE(PG8_SB(1, 0), b3, voffB); PG8_STAGE(PG8_SB(1, 1), b3 + hstepB, voffB); PG8_STAGE(PG8_SA(1, 0), a3, voffA);
            PG8_WAIT_V(8); PG8_WAIT_L(0); PG8_BAR; PG8_MMA(1, 0, At, B0); PG8_MMA(1, 1, At, B1); PG8_BAR; PG8_SCHED;
        }
        if constexpr (ALIGN_EPI) { if (wr == 0) PG8_BAR; }
        if constexpr (!Epi::AFTER_DRAIN) { E(acc, cur, wr, wc, fr, fq); }
        if (!has_next) break;
#pragma unroll
        for (int a = 0; a < 2; ++a)
#pragma unroll
            for (int b = 0; b < 2; ++b)
#pragma unroll
                for (int m = 0; m < 4; ++m)
#pragma unroll
                    for (int n = 0; n < 2; ++n) acc[a][b][m][n] = (f32x4){0.f, 0.f, 0.f, 0.f};
        cur = nxt; cA = nA; cB = nB; ++ui;
        if constexpr (ALIGN_EPI) { if (wr == 1) PG8_BAR; }
    }
    PG8_WAIT_V(0);
    if constexpr (!ALIGN_EPI) { if (wr == 0) PG8_BAR; }
    PG8_BAR;
    if constexpr (Epi::AFTER_DRAIN) { E.fused(acc, cur, wr, wc, fr, fq, lds, wid, lane); }
#undef PG8_SA
#undef PG8_SB
#undef PG8_STAGE
#undef PG8_LDA
#undef PG8_LDB
#undef PG8_MMA
#undef PG8_WAIT_V
#undef PG8_WAIT_L
#undef PG8_BAR
#undef PG8_SCHED
#undef PG8_OFFA
#undef PG8_OFFB
}

struct EpiNull { static constexpr bool AFTER_DRAIN = false; float* sink; __device__ __forceinline__ void operator()(const Acc& acc, const Unit& u, int wr, int wc, int fr, int fq) const { f32x4 s = {0.f, 0.f, 0.f, 0.f};
_Pragma("unroll") for (int a = 0; a < 2; ++a) _Pragma("unroll") for (int b = 0; b < 2; ++b) _Pragma("unroll") for (int m = 0; m < 4; ++m) _Pragma("unroll") for (int n = 0; n < 2; ++n) s += acc[a][b][m][n];
 if (s[0] + s[1] + s[2] + s[3] == 1234567.25f) sink[0] = 1.f; } };
struct EpiGU {
    static constexpr bool AFTER_DRAIN = false;
    bf16_t* H; const float* ss;
    __device__ __forceinline__ void operator()(const Acc& acc, const Unit& u, int wr, int wc, int fr, int fq) const {
        const int row0 = u.pm * BM + wr * 64 + fr, col0 = u.pn * 128 + wc * 32 + fq * 8;
#pragma unroll
        for (int ai = 0; ai < 2; ++ai)
#pragma unroll
            for (int m = 0; m < 4; ++m) {
                const int row = row0 + ai * HALF + m * 16; const float rs = rstd_of(ss[row]);
                f32x4 h[2];
#pragma unroll
                for (int n = 0; n < 2; ++n) { const f32x4 gg = acc[ai][0][m][n] * rs, uu = acc[ai][1][m][n] * rs;
#pragma unroll
                    for (int j = 0; j < 4; ++j) h[n][j] = gg[j] * sigmoidf_(gg[j]) * uu[j]; }
                *(u32x4*)(H + (size_t)row * FF + col0) = pack8(h[0], h[1]);
            }
    }
};
template <bool WRITE_XB, bool WRITE_SS> struct EpiRes {
    static constexpr bool AFTER_DRAIN = false;
    const float* base; float* out; bf16_t* xb; float* ss; float scale;
    __device__ __forceinline__ void operator()(const Acc& acc, const Unit& u, int wr, int wc, int fr, int fq) const {
        const int row0 = u.pm * BM + wr * 64 + fr, col0 = u.pn * BM + wc * 32 + fq * 8;
#pragma unroll
        for (int ai = 0; ai < 2; ++ai)
#pragma unroll
            for (int m = 0; m < 4; ++m) {
                const int row = row0 + ai * HALF + m * 16; float sq = 0.f;
#pragma unroll
                for (int bj = 0; bj < 2; ++bj) { const size_t p = (size_t)row * DM + col0 + bj * HALF;
                    const f32x4 o0 = *(const f32x4*)(base + p), o1 = *(const f32x4*)(base + p + 4);
                    const f32x4 n0 = o0 + acc[ai][bj][m][0] * scale, n1 = o1 + acc[ai][bj][m][1] * scale;
                    *(f32x4*)(out + p) = n0; *(f32x4*)(out + p + 4) = n1;
                    if (WRITE_XB) *(u32x4*)(xb + p) = pack8(n0, n1);
                    if (WRITE_SS) sq += (n0[0] * n0[0] + n0[1] * n0[1]) + (n0[2] * n0[2] + n0[3] * n0[3]) + (n1[0] * n1[0] + n1[1] * n1[1]) + (n1[2] * n1[2] + n1[3] * n1[3]); }
                if (WRITE_SS) { sq += __shfl_xor(sq, 16); sq += __shfl_xor(sq, 32); if (fq == 0) unsafeAtomicAdd(ss + row, sq); }
                asm volatile("" ::: "memory");
            }
    }
};
struct EpiQKV {
    static constexpr bool AFTER_DRAIN = false;
    bf16_t *QN, *KVN, *QF, *KVF, *GAB; float* F32S; const float* ss;
    __device__ __forceinline__ void operator()(const Acc& acc, const Unit& u, int wr, int wc, int fr, int fq) const {
        const int row0 = u.pm * BM + wr * 64 + fr, pn = u.pn;
        if (pn == 19) {
            if (wc == 0) {
#pragma unroll
                for (int ai = 0; ai < 2; ++ai)
#pragma unroll
                    for (int m = 0; m < 4; ++m) { const int row = row0 + ai * HALF + m * 16; const float rs = rstd_of(ss[row]);
                        *(f32x4*)(F32S + (size_t)row * 32 + fq * 8) = acc[ai][0][m][0] * rs; *(f32x4*)(F32S + (size_t)row * 32 + fq * 8 + 4) = acc[ai][0][m][1] * rs; }
            }
            return;
        }
        bf16_t* dst; int pitch, coff;
        if (pn < 2) { dst = QN; pitch = 512; coff = pn * 256; }
        else if (pn < 5) { dst = KVN; pitch = 768; coff = (pn - 2) * 256; }
        else if (pn < 7) { dst = QF; pitch = 512; coff = (pn - 5) * 256; }
        else if (pn < 11) { dst = KVF; pitch = 1024; coff = (pn - 7) * 256; }
        else { dst = GAB; pitch = 2048; coff = (pn - 11) * 256; }
        coff += wc * 32 + fq * 8;
#pragma unroll
        for (int ai = 0; ai < 2; ++ai)
#pragma unroll
            for (int m = 0; m < 4; ++m) { const int row = row0 + ai * HALF + m * 16; const float rs = rstd_of(ss[row]);
#pragma unroll
                for (int bj = 0; bj < 2; ++bj) *(u32x4*)(dst + (size_t)row * pitch + coff + bj * HALF) = pack8(acc[ai][bj][m][0] * rs, acc[ai][bj][m][1] * rs); }
    }
};
template <int STEP> struct EpiUp {
    static constexpr bool AFTER_DRAIN = false;
    const bf16_t* GAB; bf16_t* Y;
    __device__ __forceinline__ void operator()(const Acc& acc, const Unit& u, int wr, int wc, int fr, int fq) const {
        const int row0 = u.pm * BM + wr * 64 + fr, col0 = u.pn * BM + wc * 32 + fq * 8;
#pragma unroll
        for (int ai = 0; ai < 2; ++ai)
#pragma unroll
            for (int m = 0; m < 4; ++m) { const int row = row0 + ai * HALF + m * 16;
#pragma unroll
                for (int bj = 0; bj < 2; ++bj) { const int c = col0 + bj * HALF;
                    const u32x4 gw = *(const u32x4*)(GAB + (size_t)row * 2048 + STEP * 1024 + c);
                    f32x4 v0, v1; const f32x4 a0 = acc[ai][bj][m][0], a1 = acc[ai][bj][m][1];
                    v0[0] = sigmoidf_(bflo(gw.x)) * a0[0]; v0[1] = sigmoidf_(bfhi(gw.x)) * a0[1]; v0[2] = sigmoidf_(bflo(gw.y)) * a0[2]; v0[3] = sigmoidf_(bfhi(gw.y)) * a0[3];
                    v1[0] = sigmoidf_(bflo(gw.z)) * a1[0]; v1[1] = sigmoidf_(bfhi(gw.z)) * a1[1]; v1[2] = sigmoidf_(bflo(gw.w)) * a1[2]; v1[3] = sigmoidf_(bfhi(gw.w)) * a1[3];
                    bf16_t* yp = Y + (size_t)row * DM + c;
                    if (STEP == 1) { const u32x4 y = *(const u32x4*)yp;
                        v0[0] += bflo(y.x); v0[1] += bfhi(y.x); v0[2] += bflo(y.y); v0[3] += bfhi(y.y); v1[0] += bflo(y.z); v1[1] += bfhi(y.z); v1[2] += bflo(y.w); v1[3] += bfhi(y.w); }
                    *(u32x4*)yp = pack8(v0, v1); }
                asm volatile("" ::: "memory"); }
    }
};
struct EpiRowScale {
    static constexpr bool AFTER_DRAIN = false;
    bf16_t* O; int ldo; const float* ss;
    __device__ __forceinline__ void operator()(const Acc& acc, const Unit& u, int wr, int wc, int fr, int fq) const {
        const int row0 = u.pm * BM + wr * 64 + fr, col0 = u.pn * BM + wc * 32 + fq * 8;
#pragma unroll
        for (int ai = 0; ai < 2; ++ai)
#pragma unroll
            for (int m = 0; m < 4; ++m) { const int row = row0 + ai * HALF + m * 16; const float rs = rstd_of(ss[row]);
#pragma unroll
                for (int bj = 0; bj < 2; ++bj) *(u32x4*)(O + (size_t)row * ldo + col0 + bj * HALF) = pack8(acc[ai][bj][m][0] * rs, acc[ai][bj][m][1] * rs); }
    }
};
struct EpiColScale {
    static constexpr bool AFTER_DRAIN = false;
    bf16_t* O; int ldo; const float* ss;
    __device__ __forceinline__ void operator()(const Acc& acc, const Unit& u, int wr, int wc, int fr, int fq) const {
        const int row0 = u.pm * BM + wr * 64 + fr, col0 = u.pn * BM + wc * 32 + fq * 8;
#pragma unroll
        for (int bj = 0; bj < 2; ++bj) { const int c = col0 + bj * HALF;
            f32x4 s0 = *(const f32x4*)(ss + c), s1 = *(const f32x4*)(ss + c + 4);
#pragma unroll
            for (int j = 0; j < 4; ++j) { s0[j] = rstd_of(s0[j]); s1[j] = rstd_of(s1[j]); }
#pragma unroll
            for (int ai = 0; ai < 2; ++ai)
#pragma unroll
                for (int m = 0; m < 4; ++m) { const int row = row0 + ai * HALF + m * 16;
                    *(u32x4*)(O + (size_t)row * ldo + c) = pack8(acc[ai][bj][m][0] * s0, acc[ai][bj][m][1] * s1); } }
    }
};
struct EpiBatchBf16 {
    static constexpr bool AFTER_DRAIN = false;
    bf16_t* O; int ldo; long sOb, sOh;
    __device__ __forceinline__ void operator()(const Acc& acc, const Unit& u, int wr, int wc, int fr, int fq) const {
        const int row0 = u.pm * BM + wr * 64 + fr, col0 = u.pn * BM + wc * 32 + fq * 8;
        bf16_t* Ob = O + (size_t)((u.pb >> 2) * sOb + (u.pb & 3) * sOh);
#pragma unroll
        for (int ai = 0; ai < 2; ++ai)
#pragma unroll
            for (int m = 0; m < 4; ++m) { const int row = row0 + ai * HALF + m * 16;
#pragma unroll
                for (int bj = 0; bj < 2; ++bj) *(u32x4*)(Ob + (size_t)row * ldo + col0 + bj * HALF) = pack8(acc[ai][bj][m][0], acc[ai][bj][m][1]); }
    }
};
struct EpiSoftmax {
    static constexpr bool AFTER_DRAIN = true;
    bf16_t* P;
    __device__ __forceinline__ void fused(Acc& acc, const Unit& u, int wr, int wc, int fr, int fq, LAS unsigned char* lds, int wid, int lane) const {
        LAS float* Pm = (LAS float*)lds;
        LAS float* Ps = (LAS float*)(lds + 8192);
#pragma unroll
        for (int ai = 0; ai < 2; ++ai)
#pragma unroll
            for (int m = 0; m < 4; ++m) { float mx = -3.0e38f;
#pragma unroll
                for (int bj = 0; bj < 2; ++bj)
#pragma unroll
                    for (int n = 0; n < 2; ++n) { const f32x4 x = acc[ai][bj][m][n]; mx = fmaxf(mx, fmaxf(fmaxf(x[0], x[1]), fmaxf(x[2], x[3]))); }
                mx = fmaxf(mx, __shfl_xor(mx, 16)); mx = fmaxf(mx, __shfl_xor(mx, 32));
                if (fq == 0) Pm[(ai * HALF + wr * 64 + m * 16 + fr) * 4 + wc] = mx; }
        __syncthreads();
#pragma unroll
        for (int ai = 0; ai < 2; ++ai)
#pragma unroll
            for (int m = 0; m < 4; ++m) { const int r = ai * HALF + wr * 64 + m * 16 + fr; const f32x4 t = *(const LAS f32x4*)(Pm + r * 4);
                const float mx = fmaxf(fmaxf(t[0], t[1]), fmaxf(t[2], t[3])); float s = 0.f;
#pragma unroll
                for (int bj = 0; bj < 2; ++bj)
#pragma unroll
                    for (int n = 0; n < 2; ++n) { f32x4 x = acc[ai][bj][m][n];
#pragma unroll
                        for (int j = 0; j < 4; ++j) { x[j] = fexp2(x[j] - mx); s += x[j]; }
                        acc[ai][bj][m][n] = x; }
                s += __shfl_xor(s, 16); s += __shfl_xor(s, 32);
                if (fq == 0) Ps[r * 4 + wc] = s; }
        __syncthreads();
        bf16_t* Pb = P + (size_t)u.pb * SEQ * 256;
        const int col0 = wc * 32 + fq * 8;
#pragma unroll
        for (int ai = 0; ai < 2; ++ai)
#pragma unroll
            for (int m = 0; m < 4; ++m) { const int r = ai * HALF + wr * 64 + m * 16 + fr; const f32x4 t = *(const LAS f32x4*)(Ps + r * 4);
                const float inv = 1.0f / ((t[0] + t[1]) + (t[2] + t[3])); const int row = u.pm * BM + r;
#pragma unroll
                for (int bj = 0; bj < 2; ++bj) *(u32x4*)(Pb + (size_t)row * 256 + col0 + bj * HALF) = pack8(acc[ai][bj][m][0] * inv, acc[ai][bj][m][1] * inv); }
        __syncthreads();
    }
};
}
namespace att {
__device__ __forceinline__ int crow(int r, int hi) { return (r & 3) + 8 * (r >> 2) + 4 * hi; }
#define SBAR() __builtin_amdgcn_sched_barrier(0)
constexpr float NEG = -INFINITY;
constexpr int L_SLOT = 0;
constexpr int L_WSF = 32768;
constexpr int L_OST = L_WSF + 2048;
constexpr int L_TBL = L_OST + 32768;
constexpr int L_CB = L_TBL + 4096;
constexpr int L_PS = L_CB + 8192;
constexpr int L_IMP = L_PS + 64 * 129 * 4;
constexpr int L_MISC = L_IMP + 64 * 33 * 4;
constexpr int L_END = L_MISC + 64;
static_assert(L_END <= 131072, "attention LDS map");

__device__ __forceinline__ void qkt(f32x16& p0, f32x16& p1, const LAS unsigned char* Kslot, const bf16x8 (&qr)[4], int r32, int hi) {
    const LAS unsigned char* kb = Kslot + hi * 1024 + r32 * 16;
    p0 = f32x16{}; p1 = f32x16{};
#pragma unroll
    for (int d0 = 0; d0 < 4; ++d0) {
        const bf16x8 b0 = *(const LAS bf16x8*)(kb + d0 * 2048);
        const bf16x8 b1 = *(const LAS bf16x8*)(kb + d0 * 2048 + 512);
        p0 = __builtin_amdgcn_mfma_f32_32x32x16_bf16(b0, qr[d0], p0, 0, 0, 0);
        p1 = __builtin_amdgcn_mfma_f32_32x32x16_bf16(b1, qr[d0], p1, 0, 0, 0);
    }
}
__device__ __forceinline__ void pv(f32x16 (&o)[2], int vb, bf16x8 pa0, bf16x8 pa1, bf16x8 pa2, bf16x8 pa3) {
#pragma unroll
    for (int d0 = 0; d0 < 2; ++d0) { s16x4 lo[4], hi[4];
#pragma unroll
        for (int ks = 0; ks < 4; ++ks) {
            asm volatile("ds_read_b64_tr_b16 %0,%1 offset:%c2" : "=&v"(lo[ks]) : "v"(vb), "i"(d0 * 4096 + ks * 1024) : "memory");
            asm volatile("ds_read_b64_tr_b16 %0,%1 offset:%c2" : "=&v"(hi[ks]) : "v"(vb), "i"(d0 * 4096 + ks * 1024 + 512) : "memory"); }
        asm volatile("s_waitcnt lgkmcnt(0)" ::: "memory"); SBAR();
#define PK(k) (bf16x8){lo[k][0], lo[k][1], lo[k][2], lo[k][3], hi[k][0], hi[k][1], hi[k][2], hi[k][3]}
        o[d0] = __builtin_amdgcn_mfma_f32_32x32x16_bf16(pa0, PK(0), o[d0], 0, 0, 0);
        o[d0] = __builtin_amdgcn_mfma_f32_32x32x16_bf16(pa1, PK(1), o[d0], 0, 0, 0);
        o[d0] = __builtin_amdgcn_mfma_f32_32x32x16_bf16(pa2, PK(2), o[d0], 0, 0, 0);
        o[d0] = __builtin_amdgcn_mfma_f32_32x32x16_bf16(pa3, PK(3), o[d0], 0, 0, 0);
#undef PK
    }
}
__device__ __forceinline__ float rowmax32(const f32x16& p0, const f32x16& p1) {
    float a = fmaxf(p0[0], p1[0]);
#pragma unroll
    for (int r = 1; r < 16; ++r) a = fmaxf(a, fmaxf(p0[r], p1[r]));
    auto rr = __builtin_amdgcn_permlane32_swap(__float_as_uint(a), __float_as_uint(a), false, false);
    return fmaxf(__uint_as_float(rr[0]), __uint_as_float(rr[1]));
}
__device__ __forceinline__ float halfsum(float v) {
    auto rr = __builtin_amdgcn_permlane32_swap(__float_as_uint(v), __float_as_uint(v), false, false);
    return __uint_as_float(rr[0]) + __uint_as_float(rr[1]);
}
#define PKW(P, B) cvtpk(P[B], P[B + 1])
__device__ __forceinline__ void pack_p(const f32x16& p0, const f32x16& p1, bf16x8& a0, bf16x8& a1, bf16x8& a2, bf16x8& a3) {
    const u32x4 w0 = {PKW(p0, 0), PKW(p0, 2), PKW(p0, 4), PKW(p0, 6)}, w1 = {PKW(p0, 8), PKW(p0, 10), PKW(p0, 12), PKW(p0, 14)};
    const u32x4 w2 = {PKW(p1, 0), PKW(p1, 2), PKW(p1, 4), PKW(p1, 6)}, w3 = {PKW(p1, 8), PKW(p1, 10), PKW(p1, 12), PKW(p1, 14)};
    a0 = __builtin_bit_cast(bf16x8, w0); a1 = __builtin_bit_cast(bf16x8, w1); a2 = __builtin_bit_cast(bf16x8, w2); a3 = __builtin_bit_cast(bf16x8, w3);
}
#undef PKW
__device__ __forceinline__ void scale_rows(f32x16 (&o)[2], LAS float* wsf, float v, int r32, int hi) {
    if (hi == 0) wsf[r32] = v;
    asm volatile("s_waitcnt lgkmcnt(0)" ::: "memory");
#pragma unroll
    for (int i = 0; i < 4; ++i) { const f32x4 f = *(const LAS f32x4*)(wsf + 8 * i + 4 * hi);
#pragma unroll
        for (int j = 0; j < 4; ++j) { o[0][4 * i + j] *= f[j]; o[1][4 * i + j] *= f[j]; } }
    asm volatile("s_waitcnt lgkmcnt(0)" ::: "memory");
}
struct StageGeo { int krow, kcol, koff, vrow, vcol, voff; };
__device__ __forceinline__ StageGeo stage_geo(int tid) {
    StageGeo s; const int w = tid >> 6, ln = tid & 63;
    s.krow = ln; s.kcol = w * 8; s.koff = w * 1024 + ln * 16;
    s.vrow = 16 * (w & 3) + (ln >> 2); s.vcol = (w >> 2) * 32 + (ln & 3) * 8; s.voff = 8192 + w * 1024 + ln * 16;
    return s;
}
template <class Mod>
__device__ __forceinline__ void tile_step(const LAS unsigned char* slot, const bf16x8 (&qr)[4], f32x16 (&o)[2], float& m, float& l, LAS float* wsf, const Mod& mod, int r32, int hi, int vb) {
    f32x16 p0, p1;
    qkt(p0, p1, slot, qr, r32, hi);
    mod(p0, p1);
    const float rm = rowmax32(p0, p1);
    const float mn = fmaxf(m, rm);
    const float alpha = fexp2(m - mn);
    const bool need = __any(mn > m);
    m = mn;
    float s = 0.f;
#pragma unroll
    for (int r = 0; r < 16; ++r) { p0[r] = fexp2(p0[r] - mn); p1[r] = fexp2(p1[r] - mn); s += p0[r] + p1[r]; }
    l = l * alpha + s;
    if (need) scale_rows(o, wsf, alpha, r32, hi);
    bf16x8 a0, a1, a2, a3; pack_p(p0, p1, a0, a1, a2, a3);
    pv(o, vb, a0, a1, a2, a3);
}
template <class ModF>
__device__ __forceinline__ void attn_loop(unsigned tmask, const bf16_t* Kg, int pitchK, const bf16_t* Vg, int pitchV, LAS unsigned char* lds, const bf16x8 (&qr)[4],
                                          f32x16 (&o)[2], float& m, float& l, const ModF& modf, int wave_last_row) {
    const int tid = fresh_tid(), lane = tid & 63, r32 = lane & 31, hi = lane >> 5, wid = tid >> 6;
    const StageGeo sg = stage_geo(tid);
    LAS float* wsf = (LAS float*)(lds + L_WSF) + wid * 64;
    const int vb0 = (int)(unsigned)(size_t)(lds + L_SLOT + 8192) + ((lane >> 4) & 1) * 32 + (lane & 3) * 8 + (4 * hi + ((lane & 15) >> 2)) * 64;
    int kt = 31 - __clz((int)tmask);
    u32x4 kreg = *(const u32x4*)(Kg + (size_t)(kt * 64 + sg.krow) * pitchK + sg.kcol);
    u32x4 vreg = *(const u32x4*)(Vg + (size_t)(kt * 64 + sg.vrow) * pitchV + sg.vcol);
    *(LAS u32x4*)(lds + L_SLOT + sg.koff) = kreg; *(LAS u32x4*)(lds + L_SLOT + sg.voff) = vreg;
    __syncthreads();
    int s = 0;
    for (;;) {
        tmask &= ~(1u << kt);
        const int nk = tmask ? 31 - __clz((int)tmask) : -1;
        if (nk >= 0) { kreg = *(const u32x4*)(Kg + (size_t)(nk * 64 + sg.krow) * pitchK + sg.kcol); vreg = *(const u32x4*)(Vg + (size_t)(nk * 64 + sg.vrow) * pitchV + sg.vcol); }
        if (kt * 64 <= wave_last_row) tile_step(lds + L_SLOT + s * 16384, qr, o, m, l, wsf, modf(kt), r32, hi, vb0 + s * 16384);
        if (nk >= 0) { *(LAS u32x4*)(lds + L_SLOT + (s ^ 1) * 16384 + sg.koff) = kreg; *(LAS u32x4*)(lds + L_SLOT + (s ^ 1) * 16384 + sg.voff) = vreg; }
        __syncthreads();
        if (nk < 0) break;
        kt = nk; s ^= 1;
    }
}
template <bool ADD>
__device__ __forceinline__ void store_o(const f32x16 (&o)[2], LAS unsigned char* lds, bf16_t* dst, int pitch, const bf16_t* addsrc, int addpitch) {
    const int tid = fresh_tid(), lane = tid & 63, r32 = lane & 31, hi = lane >> 5, wid = tid >> 6;
    LAS bf16_t* stg = (LAS bf16_t*)(lds + L_OST) + wid * 2048;
#pragma unroll
    for (int r = 0; r < 16; ++r) { const int orow = crow(r, hi);
#pragma unroll
        for (int d0 = 0; d0 < 2; ++d0) stg[orow * 64 + d0 * 32 + r32] = (bf16_t)(cvtpk(o[d0][r], 0.f) & 0xffffu); }
    asm volatile("s_waitcnt lgkmcnt(0)" ::: "memory");
#pragma unroll
    for (int i = 0; i < 4; ++i) { const int row = i * 8 + (lane >> 3), ch = lane & 7;
        u32x4 v = *(const LAS u32x4*)(stg + row * 64 + ch * 8);
        if (ADD) { const u32x4 a = *(const u32x4*)(addsrc + (size_t)row * addpitch + ch * 8);
            v.x = cvtpk(bflo(v.x) + bflo(a.x), bfhi(v.x) + bfhi(a.x)); v.y = cvtpk(bflo(v.y) + bflo(a.y), bfhi(v.y) + bfhi(a.y));
            v.z = cvtpk(bflo(v.z) + bflo(a.z), bfhi(v.z) + bfhi(a.z)); v.w = cvtpk(bflo(v.w) + bflo(a.w), bfhi(v.w) + bfhi(a.w)); }
        *(u32x4*)(dst + (size_t)row * pitch + ch * 8) = v; }
    asm volatile("s_waitcnt lgkmcnt(0)" ::: "memory");
}
__device__ __forceinline__ void load_q(bf16x8 (&qr)[4], const bf16_t* Qw, int pitch, int r32, int hi) {
#pragma unroll
    for (int d0 = 0; d0 < 4; ++d0) qr[d0] = *(const bf16x8*)(Qw + (size_t)r32 * pitch + d0 * 16 + hi * 8);
}

struct ModFox { const LAS float* cb; int kbase, qpos, hi; bool diag;
    __device__ __forceinline__ void operator()(f32x16& p0, f32x16& p1) const {
#pragma unroll
        for (int i = 0; i < 4; ++i) { const f32x4 c0 = *(const LAS f32x4*)(cb + kbase + 8 * i + 4 * hi), c1 = *(const LAS f32x4*)(cb + kbase + 32 + 8 * i + 4 * hi);
#pragma unroll
            for (int j = 0; j < 4; ++j) { p0[4 * i + j] += c0[j]; p1[4 * i + j] += c1[j]; } }
        if (diag) {
#pragma unroll
            for (int r = 0; r < 16; ++r) { const int kv = kbase + crow(r, hi); if (kv > qpos) p0[r] = NEG; if (kv + 32 > qpos) p1[r] = NEG; } }
    } };
struct ModFoxF { const LAS float* cb; int qpos, hi, q0w;
    __device__ __forceinline__ ModFox operator()(int kt) const { return ModFox{cb, kt * 64, qpos, hi, kt * 64 + 63 > q0w}; } };
struct ModT5 { const LAS float* tb; int kbase, qpos, hi, window; bool enabled;
    __device__ __forceinline__ void operator()(f32x16& p0, f32x16& p1) const {
#pragma unroll
        for (int r = 0; r < 16; ++r) { const int d0 = qpos - (kbase + crow(r, hi)), d1 = d0 - 32;
            const float b0 = tb[min(max(d0, 0), 127)], b1 = tb[min(max(d1, 0), 127)];
            p0[r] = (enabled && d0 >= 0 && d0 < window) ? p0[r] + b0 : NEG;
            p1[r] = (enabled && d1 >= 0 && d1 < window) ? p1[r] + b1 : NEG; }
    } };
struct ModWinF { const LAS float* tb; int qpos, hi;
    __device__ __forceinline__ ModT5 operator()(int kt) const { return ModT5{tb, kt * 64, qpos, hi, 512, true}; } };
struct ModSelF { const LAS float* tb; int qpos, hi; unsigned mask;
    __device__ __forceinline__ ModT5 operator()(int kt) const { return ModT5{tb, kt * 64, qpos, hi, 1 << 30, ((mask >> kt) & 1u) != 0u}; } };
}
#ifndef STAGE_LIMIT
#define STAGE_LIMIT 4
#endif
constexpr size_t MiB = 1u << 20;
constexpr size_t WS_CTL = 0, CTL_ZERO_BYTES = 2 * MiB;
constexpr size_t WS_SS = 256 * 1024;
constexpr size_t WS_SSM = 640 * 1024;
constexpr size_t WS_F32S = 2 * MiB;
constexpr size_t WS_CUM = 4 * MiB;
constexpr size_t WS_MASK = 4 * MiB + 512 * 1024;
constexpr size_t WS_UMASK = WS_MASK + 128 * 1024;
constexpr size_t WS_KC = 5 * MiB, WS_VC = 5 * MiB + 256 * 1024;
constexpr size_t WS_POSC = 704 * 1024;
constexpr size_t WS_WGU1 = 8 * MiB, WS_WD1 = 19 * MiB, WS_WIN = 25 * MiB, WS_WUPN = 35 * MiB, WS_WUPF = 36 * MiB, WS_WOUT = 37 * MiB, WS_WMQ = 39 * MiB,
                 WS_WMKV = 41 * MiB, WS_WMO = 45 * MiB, WS_WGU2 = 47 * MiB, WS_WD2 = 58 * MiB, WS_CW1K = 64 * MiB, WS_CW1V = 65 * MiB, WS_CW2K = 66 * MiB, WS_CW2V = 66 * MiB + 256 * 1024;
constexpr size_t WS_KM = 8 * MiB, WS_VT = 12 * MiB;
constexpr size_t WS_XB = 68 * MiB;
constexpr size_t WS_QN = 100 * MiB, WS_KVN = 116 * MiB, WS_QF = 140 * MiB, WS_KVF = 156 * MiB, WS_GAB = 188 * MiB;
constexpr size_t WS_H = 100 * MiB;
constexpr size_t WS_Y = WS_KVF;
constexpr size_t WS_QM = 108 * MiB, WS_PM = 188 * MiB, WS_OM = 140 * MiB;
constexpr size_t WS_MEMB = 252 * MiB, WS_END = 256 * MiB;
static_assert(WS_WD2 + (size_t)DM * FF * 2 <= WS_CW1K && WS_GAB + (size_t)M * 2048 * 2 <= WS_MEMB && WS_H + (size_t)M * FF * 2 <= WS_GAB, "ws map");
constexpr int CW_BAR = 4096;
constexpr int RING_BYTES = 131072, LDS_BYTES = 147456;

__device__ const unsigned char T5B[128] = {0, 1, 2, 3, 4, 5, 6, 7, 8, 9, 10, 11, 12, 13, 14, 15, 16, 16, 16, 17, 17, 18, 18, 18, 19, 19, 19, 20, 20, 20, 20, 21, 21, 21, 21, 22, 22, 22, 22, 22, 23, 23, 23, 23, 23, 23, 24, 24, 24, 24, 24, 24, 25, 25, 25, 25, 25, 25, 25, 26, 26, 26, 26, 26, 26, 26, 26, 27, 27, 27, 27, 27, 27, 27, 27, 27, 27, 28, 28, 28, 28, 28, 28, 28, 28, 28, 28, 29, 29, 29, 29, 29, 29, 29, 29, 29, 29, 29, 29, 30, 30, 30, 30, 30, 30, 30, 30, 30, 30, 30, 30, 30, 30, 31, 31, 31, 31, 31, 31, 31, 31, 31, 31, 31, 31, 31, 31, 31};


#define XB_TMO      128
#define XB_XCNT(j)  (256  + 64 * (j))
#define XB_XSUB(j)  (1280 + 64 * (j))
#define XB_XGEN(j)  (2304 + 64 * (j))
#define XB_TOP      3328
#define XB_TOPGEN   3392
#define XCD_BAR_WORDS 3456
#define XB_SPIN_CAP (1u << 18)
__device__ __forceinline__ unsigned xb_ld(unsigned* p)              { return __hip_atomic_load(p, __ATOMIC_RELAXED, __HIP_MEMORY_SCOPE_AGENT); }
__device__ __forceinline__ unsigned xb_add(unsigned* p, unsigned v) { return __hip_atomic_fetch_add(p, v, __ATOMIC_RELAXED, __HIP_MEMORY_SCOPE_AGENT); }
__device__ __forceinline__ unsigned xb_xcc_id() { return (unsigned)__builtin_amdgcn_s_getreg((3 << 11) | 20) & 0xFu; }
#define XB_SPIN(cond, bar) do { unsigned _sp = 0; while (cond) { __builtin_amdgcn_s_sleep(1); \
    if ((++_sp & 255u) == 0u) { if (xb_ld(&(bar)[XB_TMO])) break; if (_sp > XB_SPIN_CAP) { atomicAdd(&(bar)[XB_TMO], 1u); break; } } } } while (0)
struct XcdBarrier { unsigned* bar; unsigned x; volatile LAS unsigned* st; };
__device__ __forceinline__ XcdBarrier xcd_barrier_post(unsigned* bar, volatile LAS unsigned* st) {
    XcdBarrier b; b.bar = bar; b.x = xb_xcc_id(); b.st = st;
    if (threadIdx.x == 0) (void)xb_add(&bar[XB_XCNT(b.x)], 1u);
    return b;
}
__device__ __forceinline__ void xcd_barrier_complete(unsigned* bar, unsigned x, unsigned& nloc, unsigned& nx) {
    const unsigned G = gridDim.x * gridDim.y * gridDim.z;
    unsigned sum, cnt, mine, sp = 0u;
    for (;;) {
        sum = 0u; cnt = 0u; mine = 0u;
#pragma unroll
        for (unsigned j = 0; j < 16; ++j) { const unsigned c = xb_ld(&bar[XB_XCNT(j)]); sum += c; cnt += (c > 0u) ? 1u : 0u; mine = (j == x) ? c : mine; }
        if (sum == G) break;
        __builtin_amdgcn_s_sleep(1);
        if ((++sp & 255u) == 0u) { if (xb_ld(&bar[XB_TMO])) break; if (sp > XB_SPIN_CAP) { atomicAdd(&bar[XB_TMO], 1u); break; } }
    }
    nloc = mine > 0u ? mine : 1u; nx = cnt > 0u ? cnt : 1u;
}
__device__ __forceinline__ void xcd_barrier(const XcdBarrier& b) {
    asm volatile("s_waitcnt vmcnt(0)" ::: "memory");
    __syncthreads();
    if (threadIdx.x == 0) {
        unsigned* bar = b.bar;
        __builtin_amdgcn_s_waitcnt(0);
        unsigned nloc = b.st[0], nx = b.st[1];
        if (nloc == 0u) { xcd_barrier_complete(bar, b.x, nloc, nx); b.st[0] = nloc; b.st[1] = nx; }
        const unsigned old = xb_add(&bar[XB_XSUB(b.x)], 1u);
        const unsigned gen = old / nloc;
        if (old + 1u == (gen + 1u) * nloc) {
            __builtin_amdgcn_fence(__ATOMIC_RELEASE, "agent");
            asm volatile("s_waitcnt vmcnt(0)" ::: "memory");
            const unsigned og = xb_add(&bar[XB_TOP], 1u);
            const unsigned tg = og / nx;
            if (og + 1u == (tg + 1u) * nx) xb_add(&bar[XB_TOPGEN], 1u);
            else XB_SPIN(xb_ld(&bar[XB_TOPGEN]) == tg, bar);
            __builtin_amdgcn_fence(__ATOMIC_ACQUIRE, "agent");
            xb_add(&bar[XB_XGEN(b.x)], 1u);
            asm volatile("s_waitcnt vmcnt(0)" ::: "memory");
        } else {
            XB_SPIN(xb_ld(&bar[XB_XGEN(b.x)]) == gen, bar);
            __builtin_amdgcn_fence(__ATOMIC_ACQUIRE, "agent");
            asm volatile("s_waitcnt vmcnt(0)" ::: "memory");
        }
    }
    __syncthreads();
}

struct Args { const float* in[29]; float* out; unsigned char* ws; int lo, hi; };
enum { I_X = 0, I_MEM, I_RELB, I_F1N, I_F1G, I_F1U, I_F1D, I_MIXN, I_WIN, I_BF, I_POSK, I_POSV, I_CK1, I_CK2, I_CV1, I_CV2, I_UPN, I_UPF, I_WOUT, I_MQN, I_MKVN, I_MWQ, I_MWKV, I_MWO, I_F2N, I_F2G, I_F2U, I_F2D, I_FINN };

__device__ __forceinline__ float wave_sum(float v) {
#pragma unroll
    for (int o = 1; o < 64; o <<= 1) v += __shfl_xor(v, o);
    return v;
}
template <class CM>
__device__ __forceinline__ void tr_item(const float* W, int ldsrc, int K, bf16_t* WT, int k0, int dstrow0, const float* gain, LAS float* scr, int lane, const CM& cm) {
    const int kr = lane >> 3, c4 = lane & 7; int sc; float scl; cm(dstrow0 + 4 * c4, sc, scl);
    f32x4 v[8]; float gk[8];
#pragma unroll
    for (int i = 0; i < 8; ++i) { const int kk = 8 * i + kr; v[i] = sc >= 0 ? *(const f32x4*)(W + (size_t)(k0 + kk) * ldsrc + sc) : (f32x4){0.f, 0.f, 0.f, 0.f}; gk[i] = gain ? gain[k0 + kk] : 1.f; }
#pragma unroll
    for (int i = 0; i < 8; ++i) { const int kk = 8 * i + kr; const float s = gk[i] * scl; LAS float* p = scr + kk * 33 + 4 * c4; p[0] = v[i][0] * s; p[1] = v[i][1] * s; p[2] = v[i][2] * s; p[3] = v[i][3] * s; }
    asm volatile("s_waitcnt lgkmcnt(0)" ::: "memory");
    const int c = lane & 7;
#pragma unroll
    for (int j = 0; j < 4; ++j) { const int nn = (lane >> 3) + 8 * j; const LAS float* s = scr + (8 * c) * 33 + nn;
        u32x4 o; o.x = cvtpk(s[0 * 33], s[1 * 33]); o.y = cvtpk(s[2 * 33], s[3 * 33]); o.z = cvtpk(s[4 * 33], s[5 * 33]); o.w = cvtpk(s[6 * 33], s[7 * 33]);
        *(u32x4*)(WT + (size_t)(dstrow0 + nn) * K + k0 + 8 * c) = o; }
    asm volatile("s_waitcnt lgkmcnt(0)" ::: "memory");
}
struct CmPlain { int off; float s; __device__ __forceinline__ void operator()(int n, int& sc, float& scl) const { sc = n + off; scl = s; } };
struct CmWin { __device__ __forceinline__ void operator()(int n, int& sc, float& scl) const {
    scl = 1.f;
    if (n < 512) { sc = n; scl = QS64; }
    else if (n < 1280) sc = n;
    else if (n < 1792) { sc = 1304 + (n - 1280); scl = QS64; }
    else if (n < 2816) sc = 1816 + (n - 1792);
    else if (n < 4864) sc = 2848 + (n - 2816);
    else if (n < 4888) sc = 1280 + (n - 4864);
    else if (n < 4896) sc = 2840 + (n - 4888);
    else sc = -1; } };
constexpr int N_GU = 16 * 176, N_D = 44 * 32, N_WIN = 16 * 160, N_UP = 8 * 32, N_SQ = 16 * 32, N_MKV = 16 * 64, N_C1 = 32 * 8, N_C2 = 4 * 2;
constexpr int CONV_NA = N_GU + N_D + N_WIN + N_MKV + 2 * N_C1 + 2 * N_C2, CONV_NB = N_GU + N_D + 2 * N_UP + 3 * N_SQ;
__device__ __forceinline__ void conv_item(const Args& a, int it, LAS float* scr, int lane) {
    unsigned char* ws = a.ws; int r = it;
    const int f = r >= CONV_NA; if (f) r -= CONV_NA;
    if (r < N_GU) { const int kb = r / 176, gi = r % 176, dr = gi * 32, tile = dr >> 8, within = dr & 255;
        const float* W = a.in[within < 128 ? (f ? I_F2G : I_F1G) : (f ? I_F2U : I_F1U)];
        tr_item(W, FF, DM, (bf16_t*)(ws + (f ? WS_WGU2 : WS_WGU1)), kb * 64, dr, a.in[f ? I_F2N : I_F1N], scr, lane, CmPlain{tile * 128 + (within & 127) - dr, 1.f}); return; }
    r -= N_GU;
    if (r < N_D) { const int kb = r / 32, gi = r % 32; tr_item(a.in[f ? I_F2D : I_F1D], DM, FF, (bf16_t*)(ws + (f ? WS_WD2 : WS_WD1)), kb * 64, gi * 32, nullptr, scr, lane, CmPlain{0, 1.f}); return; }
    r -= N_D;
    if (!f) {
        if (r < N_WIN) { const int kb = r / 160, gi = r % 160; tr_item(a.in[I_WIN], 4896, DM, (bf16_t*)(ws + WS_WIN), kb * 64, gi * 32, a.in[I_MIXN], scr, lane, CmWin{}); return; }
        r -= N_WIN;
        if (r < N_MKV) { const int kb = r / 64, gi = r % 64; tr_item(a.in[I_MWKV], 2048, DM, (bf16_t*)(ws + WS_WMKV), kb * 64, gi * 32, a.in[I_MKVN], scr, lane, CmPlain{0, 1.f}); return; }
        r -= N_MKV;
        if (r < 2 * N_C1) { const int g = r >= N_C1; r -= g * N_C1; const int kb = r / 8, gi = r % 8;
            tr_item(a.in[g ? I_CV1 : I_CK1], 256, 2048, (bf16_t*)(ws + (g ? WS_CW1V : WS_CW1K)), kb * 64, gi * 32, nullptr, scr, lane, CmPlain{0, 1.f}); return; }
        r -= 2 * N_C1;
        { const int g = r >= N_C2; r -= g * N_C2; const int kb = r / 2, gi = r % 2;
            tr_item(a.in[g ? I_CV2 : I_CK2], 64, 256, (bf16_t*)(ws + (g ? WS_CW2V : WS_CW2K)), kb * 64, gi * 32, nullptr, scr, lane, CmPlain{0, 1.f}); }
    } else {
        if (r < 2 * N_UP) { const int g = r >= N_UP; r -= g * N_UP; const int kb = r / 32, gi = r % 32;
            tr_item(a.in[g ? I_UPF : I_UPN], DM, 512, (bf16_t*)(ws + (g ? WS_WUPF : WS_WUPN)), kb * 64, gi * 32, nullptr, scr, lane, CmPlain{0, 1.f}); return; }
        r -= 2 * N_UP;
        { const int g = r / N_SQ; r -= g * N_SQ; const int kb = r / 32, gi = r % 32;
            tr_item(a.in[g == 0 ? I_WOUT : (g == 1 ? I_MWQ : I_MWO)], DM, DM, (bf16_t*)(ws + (g == 0 ? WS_WOUT : (g == 1 ? WS_WMQ : WS_WMO))), kb * 64, gi * 32, g == 1 ? a.in[I_MQN] : nullptr, scr, lane,
                    CmPlain{0, g == 1 ? QS256 : 1.f}); }
    }
}

__device__ __forceinline__ void p0_prologue(const Args& a, LAS unsigned char* lds, int gw, int NGW, int wave, int lane) {
    unsigned char* ws = a.ws;
    LAS float* scr = (LAS float*)(lds + wave * 16384);
    for (int it = gw; it < CONV_NA; it += NGW) conv_item(a, it, scr, lane);
    for (int mrow = gw; mrow < M + MROWS; mrow += NGW) {
        const bool ismem = mrow >= M; const int rr = ismem ? mrow - M : mrow;
        const f32x4* xr = (const f32x4*)((ismem ? a.in[I_MEM] : a.in[I_X]) + (size_t)rr * DM) + lane;
        unsigned long long* o8 = (unsigned long long*)((bf16_t*)(ws + (ismem ? WS_MEMB : WS_XB)) + (size_t)rr * DM) + lane;
        float s = 0.f; f32x4 v[4];
#pragma unroll
        for (int j = 0; j < 4; ++j) v[j] = xr[64 * j];
#pragma unroll
        for (int j = 0; j < 4; ++j) { s += (v[j][0] * v[j][0] + v[j][1] * v[j][1]) + (v[j][2] * v[j][2] + v[j][3] * v[j][3]);
            o8[64 * j] = (unsigned long long)cvtpk(v[j][0], v[j][1]) | ((unsigned long long)cvtpk(v[j][2], v[j][3]) << 32); }
        s = wave_sum(s);
        if (lane == 0) ((float*)(ws + (ismem ? WS_SSM : WS_SS)))[rr] = s;
    }
    for (int t = gw; t < 64; t += NGW) { const int kv = t >> 5, kc = (t & 31) * 64; const float* pos = a.in[kv ? I_POSV : I_POSK] + kc; const f32x4* w1 = (const f32x4*)(a.in[kv ? I_CV1 : I_CK1] + (size_t)kc * 256) + lane;
        f32x4 s = {0.f, 0.f, 0.f, 0.f};
#pragma unroll 8
        for (int k = 0; k < 64; ++k) s += w1[(size_t)k * 64] * pos[k];
        float* o = (float*)(ws + WS_POSC) + kv * 256 + 4 * lane;
        unsafeAtomicAdd(o, s[0]); unsafeAtomicAdd(o + 1, s[1]); unsafeAtomicAdd(o + 2, s[2]); unsafeAtomicAdd(o + 3, s[3]); }
}

__device__ __forceinline__ void compress_unit(const Args& a, LAS unsigned char* lds, int uidx) {
    unsigned char* ws = a.ws;
    const int tid = fresh_tid(), lane = tid & 63, r32 = lane & 31, hi = lane >> 5, wid = __builtin_amdgcn_readfirstlane(tid >> 6);
    const int kv = uidx >> 6, b = (uidx >> 3) & 7, g = (uidx >> 2) & 1, chunk = uidx & 3, n0 = chunk * 32;
    const bf16_t* W1 = (const bf16_t*)(ws + (kv ? WS_CW1V : WS_CW1K)); const bf16_t* W2 = (const bf16_t*)(ws + (kv ? WS_CW2V : WS_CW2K));
    const float* posc = (const float*)(ws + WS_POSC) + kv * 256;
    const bf16_t* asrc = (const bf16_t*)(ws + WS_KVN) + (size_t)(b * SEQ) * 768 + kv * 128 + g * 64;
    LAS bf16_t* As = (LAS bf16_t*)lds;
    for (int i = tid; i < 528 * 8; i += 512) { const int row = i >> 3, ch = i & 7; const int t = min(16 * n0 + row, SEQ - 1);
        *(LAS u32x4*)(As + row * 64 + ((ch ^ ((row >> 4) & 7)) * 8)) = *(const u32x4*)(asrc + (size_t)t * 768 + ch * 8); }
    __syncthreads();
    const bf16_t* brow = W1 + (size_t)(32 * wid + r32) * 2048 + hi * 8;
    f32x16 acc = f32x16{};
#pragma unroll 16
    for (int kk = 0; kk < 128; ++kk) { const int l = kk >> 2, dch = (kk & 3) * 2 + hi, row = 16 * r32 + l;
        const bf16x8 av = *(const LAS bf16x8*)(As + row * 64 + ((dch ^ ((row >> 4) & 7)) * 8)); const bf16x8 bv = *(const bf16x8*)(brow + kk * 16);
        acc = __builtin_amdgcn_mfma_f32_32x32x16_bf16(av, bv, acc, 0, 0, 0); }
    LAS bf16_t* Hs = (LAS bf16_t*)(lds + 81920);
    const float pc = posc[32 * wid + r32];
#pragma unroll
    for (int r = 0; r < 16; ++r) { const float x = acc[r] + pc; const float u = 0.7978845608028654f * (x + 0.044715f * x * x * x);
        const float ge = x * frcp(1.0f + fexp2(-2.0f * LOG2E * u)); Hs[att::crow(r, hi) * 264 + 32 * wid + r32] = (bf16_t)(cvtpk(ge, 0.f) & 0xffffu); }
    __syncthreads();
    if (wid < 2) { f32x16 acc2 = f32x16{};
#pragma unroll
        for (int kk = 0; kk < 16; ++kk) { const bf16x8 av = *(const LAS bf16x8*)(Hs + r32 * 264 + kk * 16 + hi * 8); const bf16x8 bv = *(const bf16x8*)(W2 + (size_t)(32 * wid + r32) * 256 + kk * 16 + hi * 8);
            acc2 = __builtin_amdgcn_mfma_f32_32x32x16_bf16(av, bv, acc2, 0, 0, 0); }
        bf16_t* outp = (bf16_t*)(ws + (kv ? WS_VC : WS_KC)) + (size_t)((b * 2 + g) * 128) * 64;
#pragma unroll
        for (int r = 0; r < 16; ++r) { const int n = n0 + att::crow(r, hi); const float v = n < 127 ? acc2[r] : 0.f; outp[(size_t)n * 64 + 32 * wid + r32] = (bf16_t)(cvtpk(v, 0.f) & 0xffffu); } }
    __syncthreads();
}
__device__ __forceinline__ void cumsum_task(const Args& a, int task, int lane) {
    const int b = task >> 3, h = task & 7; const float bf = a.in[I_BF][h];
    const float* fl = (const float*)(a.ws + WS_F32S) + (size_t)(b * SEQ) * 32 + 24 + h; float* out = (float*)(a.ws + WS_CUM) + (size_t)task * SEQ;
    float tot = 0.f;
    for (int i = 0; i < 32; ++i) { const float v = fl[(size_t)(32 * lane + i) * 32] + bf; tot += fminf(v, 0.f) - log1pf(expf(-fabsf(v))); }
    float inc = tot;
#pragma unroll
    for (int o = 1; o < 64; o <<= 1) { const float t = __shfl_up(inc, o); if (lane >= o) inc += t; }
    float run = inc - tot;
    for (int i = 0; i < 32; ++i) { const float v = fl[(size_t)(32 * lane + i) * 32] + bf; run += fminf(v, 0.f) - log1pf(expf(-fabsf(v))); out[32 * lane + i] = -run * LOG2E; }
}

__device__ __forceinline__ void init_t5_table(const Args& a, LAS unsigned char* lds) {
    LAS float* T = (LAS float*)(lds + att::L_TBL);
    for (int i = fresh_tid(); i < 1024; i += 512) { const int h = i >> 7, d = i & 127; T[i] = a.in[I_RELB][T5B[d] * 8 + h] * LOG2E; }
}
template <bool DRY> __device__ __forceinline__ void fox_unit(const Args& a, LAS unsigned char* lds, int b, int h, int qb) {
    using namespace att;
    unsigned char* ws = a.ws;
    const int tid = fresh_tid(), lane = tid & 63, r32 = lane & 31, hi = lane >> 5, wid = __builtin_amdgcn_readfirstlane(tid >> 6);
    const int q0 = qb * 256, q0w = q0 + wid * 32, qpos = q0w + r32;
    LAS float* cb = (LAS float*)(lds + L_CB); LAS float* wsf = (LAS float*)(lds + L_WSF) + wid * 64;
    const float* cum = (const float*)(ws + WS_CUM) + (size_t)(b * 8 + h) * SEQ;
    for (int i = tid; i < q0 + 256; i += 512) cb[i] = cum[i];
    bf16_t* Qw = (bf16_t*)(ws + WS_QF) + (size_t)(b * SEQ + q0w) * 512 + h * 64;
    bf16x8 qr[4]; load_q(qr, Qw, 512, r32, hi);
    f32x16 o[2]; o[0] = f32x16{}; o[1] = f32x16{}; float m = -1e30f, l = 0.f;
    const int nt = 4 * qb + 4; const unsigned tmask = nt >= 32 ? 0xffffffffu : ((1u << nt) - 1u);
    const bf16_t* Kg = (const bf16_t*)(ws + WS_KVF) + (size_t)(b * SEQ) * 1024 + h * 64;
    attn_loop(tmask, Kg, 1024, Kg + 512, 1024, lds, qr, o, m, l, ModFoxF{cb, qpos, hi, q0w}, q0w + 31);
    l = halfsum(l);
    scale_rows(o, wsf, 1.0f / l, r32, hi);
    store_o<false>(o, lds, DRY ? (bf16_t*)(ws + WS_XB + 16 * MiB) + (size_t)(b * SEQ + q0w) * 512 + h * 64 : Qw, 512, nullptr, 0);
}
__device__ __forceinline__ void cmpwin_unit(const Args& a, LAS unsigned char* lds, int b, int g, int qb) {
    using namespace att;
    unsigned char* ws = a.ws;
    const int tid = fresh_tid(), lane = tid & 63, r32 = lane & 31, hi = lane >> 5, wid = __builtin_amdgcn_readfirstlane(tid >> 6);
    const int j = wid >> 1, sub = wid & 1, hg = g * 4 + j, q0w = qb * 64 + sub * 32, qpos = q0w + r32; const size_t qrow = (size_t)b * SEQ + qpos;
    const LAS float* tb = (const LAS float*)(lds + L_TBL) + hg * 128;
    LAS float* wsf = (LAS float*)(lds + L_WSF) + wid * 64; LAS float* PS = (LAS float*)(lds + L_PS); LAS float* IMP = (LAS float*)(lds + L_IMP); LAS unsigned* MW = (LAS unsigned*)(lds + L_MISC);
    const float* gates = (const float*)(ws + WS_F32S) + qrow * 32;
    for (int i = tid; i < 64 * 129; i += 512) PS[i] = 0.f;
    if (tid == 0) MW[0] = 0u;
    bf16x8 qr[4]; load_q(qr, (const bf16_t*)(ws + WS_QN) + (size_t)(b * SEQ + q0w) * 512 + hg * 64, 512, r32, hi);
    const StageGeo sg = stage_geo(tid);
    { const bf16_t* Kc = (const bf16_t*)(ws + WS_KC) + (size_t)((b * 2 + g) * 128) * 64; const bf16_t* Vc = (const bf16_t*)(ws + WS_VC) + (size_t)((b * 2 + g) * 128) * 64;
#pragma unroll
        for (int t = 0; t < 2; ++t) { *(LAS u32x4*)(lds + L_SLOT + t * 16384 + sg.koff) = *(const u32x4*)(Kc + (size_t)(t * 64 + sg.krow) * 64 + sg.kcol);
            *(LAS u32x4*)(lds + L_SLOT + t * 16384 + sg.voff) = *(const u32x4*)(Vc + (size_t)(t * 64 + sg.vrow) * 64 + sg.vcol); } }
    __syncthreads();
    f32x16 oc[2]; oc[0] = f32x16{}; oc[1] = f32x16{};
    {
        f32x16 a0, a1, b0, b1; qkt(a0, a1, lds + L_SLOT, qr, r32, hi); qkt(b0, b1, lds + L_SLOT + 16384, qr, r32, hi);
        float mx = NEG;
#pragma unroll
        for (int r = 0; r < 16; ++r) { const int d = qpos - 16 * crow(r, hi) - 31;
            a0[r] = d >= 0 ? a0[r] + tb[min(d, 127)] : NEG; a1[r] = d - 512 >= 0 ? a1[r] + tb[min(d - 512, 127)] : NEG;
            b0[r] = d - 1024 >= 0 ? b0[r] + tb[min(d - 1024, 127)] : NEG; b1[r] = d - 1536 >= 0 ? b1[r] + tb[min(d - 1536, 127)] : NEG;
            mx = fmaxf(fmaxf(mx, fmaxf(a0[r], a1[r])), fmaxf(b0[r], b1[r])); }
        { auto rr = __builtin_amdgcn_permlane32_swap(__float_as_uint(mx), __float_as_uint(mx), false, false); mx = fmaxf(__uint_as_float(rr[0]), __uint_as_float(rr[1])); }
        const float mxs = mx == NEG ? 0.f : mx; float s = 0.f;
#pragma unroll
        for (int r = 0; r < 16; ++r) { a0[r] = fexp2(a0[r] - mxs); a1[r] = fexp2(a1[r] - mxs); b0[r] = fexp2(b0[r] - mxs); b1[r] = fexp2(b1[r] - mxs); s += (a0[r] + a1[r]) + (b0[r] + b1[r]); }
        s = halfsum(s); const float inv = s > 0.f ? 1.0f / s : 0.f;
        LAS float* psr = PS + (sub * 32 + r32) * 129;
#pragma unroll
        for (int r = 0; r < 16; ++r) { a0[r] *= inv; a1[r] *= inv; b0[r] *= inv; b1[r] *= inv; const int c = crow(r, hi);
            __hip_atomic_fetch_add(psr + c, a0[r], __ATOMIC_RELAXED, __HIP_MEMORY_SCOPE_WORKGROUP); __hip_atomic_fetch_add(psr + c + 32, a1[r], __ATOMIC_RELAXED, __HIP_MEMORY_SCOPE_WORKGROUP); __hip_atomic_fetch_add(psr + c + 64, b0[r], __ATOMIC_RELAXED, __HIP_MEMORY_SCOPE_WORKGROUP); __hip_atomic_fetch_add(psr + c + 96, b1[r], __ATOMIC_RELAXED, __HIP_MEMORY_SCOPE_WORKGROUP); }
        const int vb0 = (int)(unsigned)(size_t)(lds + L_SLOT + 8192) + ((lane >> 4) & 1) * 32 + (lane & 3) * 8 + (4 * hi + ((lane & 15) >> 2)) * 64;
        bf16x8 x0, x1, x2, x3; pack_p(a0, a1, x0, x1, x2, x3); pv(oc, vb0, x0, x1, x2, x3);
        pack_p(b0, b1, x0, x1, x2, x3); pv(oc, vb0 + 16384, x0, x1, x2, x3);
        scale_rows(oc, wsf, sigmoidf_(gates[hg]), r32, hi);
    }
    __syncthreads();
    {
        const int q = tid >> 3, jb = (tid & 7) * 4; const LAS float* ps = PS + q * 129; LAS float* im = IMP + q * 33;
#pragma unroll
        for (int jj = 0; jj < 4; ++jj) { const int jx = jb + jj, c0 = 4 * jx - 1;
            const float v = (c0 >= 0 ? ps[c0] : 0.f) + 2.0f * (ps[c0 + 1] + ps[c0 + 2] + ps[c0 + 3]) + ps[c0 + 4];
            const bool valid = jx <= qb, forced = (jx == 0) || (jx == qb) || (jx == qb - 1);
            im[jx] = valid ? v + (forced ? 1e4f : 0.f) : -1e30f; }
        __syncthreads();
        unsigned bits = 0u;
#pragma unroll
        for (int jj = 0; jj < 4; ++jj) { const int jx = jb + jj; const float v = im[jx]; int cnt = 0;
            for (int j2 = 0; j2 < 32; ++j2) { const float v2 = im[j2]; cnt += (v2 > v || (v2 == v && j2 < jx)) ? 1 : 0; }
            if (cnt < 16 && jx <= qb) bits |= 1u << jx; }
        bits |= __shfl_xor(bits, 1); bits |= __shfl_xor(bits, 2); bits |= __shfl_xor(bits, 4);
        if ((tid & 7) == 0) { ((unsigned*)(ws + WS_MASK))[(size_t)(b * 2 + g) * SEQ + qb * 64 + q] = bits; __hip_atomic_fetch_or(MW, bits, __ATOMIC_RELAXED, __HIP_MEMORY_SCOPE_WORKGROUP); }
        __syncthreads();
        if (tid == 0) ((unsigned*)(ws + WS_UMASK))[(b * 2 + g) * 32 + qb] = MW[0];
    }
    f32x16 o[2]; o[0] = f32x16{}; o[1] = f32x16{}; float m = -1e30f, l = 0.f;
    const int lo = qb > 8 ? qb - 8 : 0; const unsigned tmask = (qb >= 31 ? 0xffffffffu : ((2u << qb) - 1u)) & ~((1u << lo) - 1u);
    const bf16_t* Kg = (const bf16_t*)(ws + WS_KVN) + (size_t)(b * SEQ) * 768 + 512 + g * 64;
    attn_loop(tmask, Kg, 768, Kg + 128, 768, lds, qr, o, m, l, ModWinF{tb, qpos, hi}, q0w + 31);
    l = halfsum(l);
    scale_rows(o, wsf, sigmoidf_(gates[16 + hg]) / l, r32, hi);
    o[0] += oc[0]; o[1] += oc[1];
    store_o<false>(o, lds, (bf16_t*)(ws + WS_XB) + (size_t)(b * SEQ + q0w) * 512 + hg * 64, 512, nullptr, 0);
}
template <bool DRY> __device__ __forceinline__ void sel_unit(const Args& a, LAS unsigned char* lds, int b, int g, int qb) {
    using namespace att;
    unsigned char* ws = a.ws;
    const int tid = fresh_tid(), lane = tid & 63, r32 = lane & 31, hi = lane >> 5, wid = __builtin_amdgcn_readfirstlane(tid >> 6);
    const int j = wid >> 1, sub = wid & 1, hg = g * 4 + j, q0w = qb * 64 + sub * 32, qpos = q0w + r32; const size_t qrow = (size_t)b * SEQ + qpos;
    const LAS float* tb = (const LAS float*)(lds + L_TBL) + hg * 128; LAS float* wsf = (LAS float*)(lds + L_WSF) + wid * 64;
    bf16_t* Qw = (bf16_t*)(ws + WS_QN) + (size_t)(b * SEQ + q0w) * 512 + hg * 64;
    bf16x8 qr[4]; load_q(qr, Qw, 512, r32, hi);
    const unsigned mask = ((const unsigned*)(ws + WS_MASK))[(size_t)(b * 2 + g) * SEQ + qpos];
    const unsigned um = ((const unsigned*)(ws + WS_UMASK))[(b * 2 + g) * 32 + qb] & (qb >= 31 ? 0xffffffffu : ((2u << qb) - 1u));
    f32x16 o[2]; o[0] = f32x16{}; o[1] = f32x16{}; float m = -1e30f, l = 0.f;
    const bf16_t* Kg = (const bf16_t*)(ws + WS_KVN) + (size_t)(b * SEQ) * 768 + 256 + g * 64;
    attn_loop(um, Kg, 768, Kg + 128, 768, lds, qr, o, m, l, ModSelF{tb, qpos, hi, mask}, q0w + 31);
    l = halfsum(l);
    const float g1 = sigmoidf_(((const float*)(ws + WS_F32S))[qrow * 32 + 8 + hg]);
    scale_rows(o, wsf, g1 / l, r32, hi);
    store_o<true>(o, lds, DRY ? (bf16_t*)(ws + WS_XB + 16 * MiB) + (size_t)(b * SEQ + q0w) * 512 + hg * 64 : Qw, 512, (const bf16_t*)(ws + WS_XB) + (size_t)(b * SEQ + q0w) * 512 + hg * 64, 512);
}
#ifndef PHMASK
#define PHMASK 0xffffffffu
#endif
#define PH(n) (((PHMASK) >> (n)) & 1u)
#ifndef DUPMASK
#define DUPMASK 0u
#endif
#define DUP(n) (((DUPMASK) >> (n)) & 1u)
#define REP(n) for (int rep_ = 0; rep_ < 1 + (int)DUP(n); ++rep_)
__global__ void __launch_bounds__(512, 2) hybrid_fwd(Args a) {
    extern __shared__ __attribute__((aligned(16))) unsigned char lds_raw[];
    LAS unsigned char* lds = (LAS unsigned char*)lds_raw;
    cg::grid_group grid = cg::this_grid();
    unsigned char* ws = a.ws;
    const int tid = fresh_tid(), lane = tid & 63, wave = __builtin_amdgcn_readfirstlane(tid >> 6);
    const int G = gridDim.x, bx = blockIdx.x, vcu = (G % 8 == 0) ? (bx % 8) * (G / 8) + bx / 8 : bx;
    const int gw = vcu * 8 + wave, NGW = G * 8;
    float* X = a.out;
    bf16_t* XB = (bf16_t*)(ws + WS_XB);
    float* SS = (float*)(ws + WS_SS);
    { volatile LAS unsigned* st0 = (volatile LAS unsigned*)(lds + RING_BYTES + 320); if (tid < 32) st0[tid] = 0u; }
    __syncthreads();
    XcdBarrier xbar = xcd_barrier_post((unsigned*)(ws + WS_CTL) + CW_BAR, (volatile LAS unsigned*)(lds + RING_BYTES + 320 + 32));
#ifdef USE_CG_SYNC
#define GSYNC() grid.sync()
#else
    if (a.lo == 0x7e57) grid.sync();
#define GSYNC() xcd_barrier(xbar)
#endif
    const float* fin_src = a.in[I_X];

#if STAGE_LIMIT >= 1
    REP(0) p0_prologue(a, lds, gw, NGW, wave, lane);
    GSYNC();
    { pg8::Gemm g{XB, (const bf16_t*)(ws + WS_WGU1), DM, DM, DM, 0, 0, 0, 0}; pg8::Order S; S.init(64, 22, 1, G, bx);
      pg8::EpiGU E{(bf16_t*)(ws + WS_H), SS}; REP(1) pg8::gemm_phase<pg8::EpiGU, true>(lds, g, S, E); }
    GSYNC();
    { pg8::Gemm g{(const bf16_t*)(ws + WS_H), (const bf16_t*)(ws + WS_WD1), FF, FF, FF, 0, 0, 0, 0}; pg8::Order S; S.init(64, 4, 1, G, bx);
      if (DUP(2)) { pg8::EpiNull E0{(float*)(ws + WS_POSC + 4096)}; pg8::gemm_phase<pg8::EpiNull, false>(lds, g, S, E0); }
      pg8::EpiRes<true, true> E{a.in[I_X], X, XB, SS + M, 0.5f}; pg8::gemm_phase<pg8::EpiRes<true, true>, false>(lds, g, S, E); }
    GSYNC();
    fin_src = X;
#endif
#if STAGE_LIMIT >= 2
#if PH(3)
    { pg8::Gemm g{XB, (const bf16_t*)(ws + WS_WIN), DM, DM, DM, 0, 0, 0, 0}; pg8::Order S; S.init(64, 20, 1, G, bx);
      pg8::EpiQKV E{(bf16_t*)(ws + WS_QN), (bf16_t*)(ws + WS_KVN), (bf16_t*)(ws + WS_QF), (bf16_t*)(ws + WS_KVF), (bf16_t*)(ws + WS_GAB), (float*)(ws + WS_F32S), SS + M};
      REP(3) pg8::gemm_phase<pg8::EpiQKV, true>(lds, g, S, E); }
#endif
    GSYNC();
#if PH(4)
    REP(4) if (bx < 128) { compress_unit(a, lds, bx); }
    else if (bx < 192) {
        if (bx < 160) { pg8::Gemm g{(const bf16_t*)(ws + WS_MEMB), (const bf16_t*)(ws + WS_WMKV), DM, DM, DM, 0, 0, 0, 0}; pg8::Order S; S.init(8, 4, 1, 32, bx - 128);
            pg8::EpiRowScale E{(bf16_t*)(ws + WS_KM), DM, (const float*)(ws + WS_SSM)}; pg8::gemm_phase<pg8::EpiRowScale, false>(lds, g, S, E); }
        else { pg8::Gemm g{(const bf16_t*)(ws + WS_WMKV) + (size_t)DM * DM, (const bf16_t*)(ws + WS_MEMB), DM, DM, DM, 0, 0, 0, 0}; pg8::Order S; S.init(4, 8, 1, 32, bx - 160);
            pg8::EpiColScale E{(bf16_t*)(ws + WS_VT), MROWS, (const float*)(ws + WS_SSM)}; pg8::gemm_phase<pg8::EpiColScale, false>(lds, g, S, E); }
    } else { if (wave == 0) cumsum_task(a, bx - 192, lane); }
    if (bx >= 128) { LAS float* scr = (LAS float*)(lds + wave * 16384); for (int it = CONV_NA + (bx - 128) * 8 + wave; it < CONV_NA + CONV_NB; it += 1024) conv_item(a, it, scr, lane); }
#endif
    GSYNC();
#if PH(5)
    init_t5_table(a, lds);
    { const int bh = vcu >> 2, s = vcu & 3; if (DUP(5)) { fox_unit<true>(a, lds, bh >> 3, bh & 7, 7 - s); fox_unit<true>(a, lds, bh >> 3, bh & 7, s); }
      fox_unit<false>(a, lds, bh >> 3, bh & 7, 7 - s); fox_unit<false>(a, lds, bh >> 3, bh & 7, s); }
    REP(15) { const int bg = vcu >> 4, s = vcu & 15; cmpwin_unit(a, lds, bg >> 1, bg & 1, 31 - s); cmpwin_unit(a, lds, bg >> 1, bg & 1, s); }
#endif
    GSYNC();
#if PH(6)
    { const int bg = vcu >> 4, s = vcu & 15; if (DUP(6)) { sel_unit<true>(a, lds, bg >> 1, bg & 1, 31 - s); sel_unit<true>(a, lds, bg >> 1, bg & 1, s); }
      sel_unit<false>(a, lds, bg >> 1, bg & 1, 31 - s); sel_unit<false>(a, lds, bg >> 1, bg & 1, s); }
#endif
    GSYNC();
#if PH(7)
    REP(7) { pg8::Order S; S.init(64, 4, 1, G, bx);
      { pg8::Gemm g{(const bf16_t*)(ws + WS_QN), (const bf16_t*)(ws + WS_WUPN), 512, 512, 512, 0, 0, 0, 0}; pg8::EpiUp<0> E{(const bf16_t*)(ws + WS_GAB), (bf16_t*)(ws + WS_Y)}; pg8::gemm_phase<pg8::EpiUp<0>, false>(lds, g, S, E); }
      { pg8::Gemm g{(const bf16_t*)(ws + WS_QF), (const bf16_t*)(ws + WS_WUPF), 512, 512, 512, 0, 0, 0, 0}; pg8::EpiUp<1> E{(const bf16_t*)(ws + WS_GAB), (bf16_t*)(ws + WS_Y)}; pg8::gemm_phase<pg8::EpiUp<1>, false>(lds, g, S, E); } }
#endif
    GSYNC();
#if PH(8)
    { pg8::Gemm g{(const bf16_t*)(ws + WS_Y), (const bf16_t*)(ws + WS_WOUT), DM, DM, DM, 0, 0, 0, 0}; pg8::Order S; S.init(64, 4, 1, G, bx);
      if (DUP(8)) { pg8::EpiNull E0{(float*)(ws + WS_POSC + 4096)}; pg8::gemm_phase<pg8::EpiNull, false>(lds, g, S, E0); }
      pg8::EpiRes<true, true> E{X, X, XB, SS + 2 * M, 1.0f}; pg8::gemm_phase<pg8::EpiRes<true, true>, false>(lds, g, S, E); }
#endif
    GSYNC();
#endif
#if STAGE_LIMIT >= 3
    { pg8::Gemm g{XB, (const bf16_t*)(ws + WS_WMQ), DM, DM, DM, 0, 0, 0, 0}; pg8::Order S; S.init(64, 4, 1, G, bx);
      pg8::EpiRowScale E{(bf16_t*)(ws + WS_QM), DM, SS + 2 * M}; REP(9) pg8::gemm_phase<pg8::EpiRowScale, false>(lds, g, S, E); }
    GSYNC();
    { pg8::Gemm g{(const bf16_t*)(ws + WS_QM), (const bf16_t*)(ws + WS_KM), DM, DM, 256, (long)SEQ * DM, 256, (long)MEMLEN * DM, 256}; pg8::Order S; S.init(8, 1, 32, G, bx);
      pg8::EpiSoftmax E{(bf16_t*)(ws + WS_PM)}; REP(10) pg8::gemm_phase<pg8::EpiSoftmax, false>(lds, g, S, E); }
    GSYNC();
    { pg8::Gemm g{(const bf16_t*)(ws + WS_PM), (const bf16_t*)(ws + WS_VT), 256, MROWS, 256, (long)4 * SEQ * 256, (long)SEQ * 256, 256, (long)256 * MROWS}; pg8::Order S; S.init(8, 1, 32, G, bx);
      pg8::EpiBatchBf16 E{(bf16_t*)(ws + WS_OM), DM, (long)SEQ * DM, 256}; REP(11) pg8::gemm_phase<pg8::EpiBatchBf16, false>(lds, g, S, E); }
    GSYNC();
    { pg8::Gemm g{(const bf16_t*)(ws + WS_OM), (const bf16_t*)(ws + WS_WMO), DM, DM, DM, 0, 0, 0, 0}; pg8::Order S; S.init(64, 4, 1, G, bx);
      pg8::EpiRes<true, true> E{X, X, XB, SS + 3 * M, 1.0f}; pg8::gemm_phase<pg8::EpiRes<true, true>, false>(lds, g, S, E); }
    GSYNC();
#endif
#if STAGE_LIMIT >= 4
    { pg8::Gemm g{XB, (const bf16_t*)(ws + WS_WGU2), DM, DM, DM, 0, 0, 0, 0}; pg8::Order S; S.init(64, 22, 1, G, bx);
      pg8::EpiGU E{(bf16_t*)(ws + WS_H), SS + 3 * M}; pg8::gemm_phase<pg8::EpiGU, true>(lds, g, S, E); }
    GSYNC();
    { pg8::Gemm g{(const bf16_t*)(ws + WS_H), (const bf16_t*)(ws + WS_WD2), FF, FF, FF, 0, 0, 0, 0}; pg8::Order S; S.init(64, 4, 1, G, bx);
      pg8::EpiRes<false, false> E{X, X, nullptr, nullptr, 0.5f}; pg8::gemm_phase<pg8::EpiRes<false, false>, false>(lds, g, S, E); }
    GSYNC();
#endif
    { const float* gn = a.in[I_FINN]; const int tid2 = fresh_tid(), lane = tid2 & 63, gw = vcu * 8 + (tid2 >> 6);
      for (int mrow = gw; mrow < M; mrow += NGW) {
          const f32x4* xr = (const f32x4*)(fin_src + (size_t)mrow * DM) + lane; f32x4* orow = (f32x4*)(X + (size_t)mrow * DM) + lane;
          f32x4 v[4]; float s = 0.f;
#pragma unroll
          for (int j = 0; j < 4; ++j) { v[j] = xr[64 * j]; s += (v[j][0] * v[j][0] + v[j][1] * v[j][1]) + (v[j][2] * v[j][2] + v[j][3] * v[j][3]); }
          const float rs = rstd_of(wave_sum(s));
#pragma unroll
          for (int j = 0; j < 4; ++j) orow[64 * j] = v[j] * rs * ((const f32x4*)gn)[lane + 64 * j];
      } }
}

extern "C" void kernel_launch(void* const* d_in, const int* in_sizes, int n_in, void* d_out, int out_size, void* d_ws, size_t ws_size, hipStream_t stream) {
    static int grid = 0;
    if (grid == 0) {
        if (n_in != 29 || out_size != M * DM || ws_size < WS_END) { fprintf(stderr, "kernel_launch: unexpected shapes (n_in %d out %d ws %zu)\n", n_in, out_size, ws_size); grid = -1; return; }
        int dev = 0, cus = 0, per_cu = 0;
        hipGetDevice(&dev); hipDeviceGetAttribute(&cus, hipDeviceAttributeMultiprocessorCount, dev);
        if (hipFuncSetAttribute((const void*)hybrid_fwd, hipFuncAttributeMaxDynamicSharedMemorySize, LDS_BYTES) != hipSuccess) { fprintf(stderr, "kernel_launch: hipFuncSetAttribute failed\n"); grid = -1; return; }
        if (hipOccupancyMaxActiveBlocksPerMultiprocessor(&per_cu, (const void*)hybrid_fwd, 512, LDS_BYTES) != hipSuccess || per_cu < 1) { fprintf(stderr, "kernel_launch: occupancy query failed (%d)\n", per_cu); per_cu = 1; }
        (void)hipGetLastError();
        grid = cus * (per_cu < 1 ? 1 : 1);
        if (grid != 256) fprintf(stderr, "kernel_launch: grid %d != 256: this kernel's phase maps assume 256 workgroups\n", grid);
    }
    if (grid < 0) return;
    hipMemsetAsync((char*)d_ws + WS_CTL, 0, CTL_ZERO_BYTES, stream);
    Args a{};
    for (int i = 0; i < 29; ++i) a.in[i] = (const float*)d_in[i];
    a.out = (float*)d_out; a.ws = (unsigned char*)d_ws; a.lo = 0; a.hi = 0;
    void* args[] = {&a};
    hipError_t e = hipLaunchCooperativeKernel((const void*)hybrid_fwd, dim3(grid), dim3(512), args, LDS_BYTES, stream);
    if (e != hipSuccess) fprintf(stderr, "kernel_launch: cooperative launch failed: %s (grid %d)\n", hipGetErrorString(e), grid);
}
```

```cpp
#include <hip/hip_runtime.h>
#include <hip/hip_cooperative_groups.h>
#include <cstdio>
#include <cstdint>
namespace cg = cooperative_groups;

#define LAS __attribute__((address_space(3)))
typedef unsigned short bf16_t;
typedef short bf16x8 __attribute__((ext_vector_type(8)));
typedef short s16x4 __attribute__((ext_vector_type(4)));
typedef float f32x2 __attribute__((ext_vector_type(2)));
typedef float f32x4 __attribute__((ext_vector_type(4)));
typedef float f32x16 __attribute__((ext_vector_type(16)));
typedef unsigned u32x2 __attribute__((ext_vector_type(2)));
typedef unsigned u32x4 __attribute__((ext_vector_type(4)));
typedef __bf16 bf16x2_t __attribute__((ext_vector_type(2)));

constexpr int NB = 8, SEQ = 2048, DM = 1024, FF = 2816, M = NB * SEQ;
constexpr int MEMLEN = 256, MROWS = NB * MEMLEN;
constexpr float RMS_EPS = 1e-6f;
constexpr float LOG2E = 1.4426950408889634f;
constexpr float QS64 = 0.125f * LOG2E;
constexpr float QS256 = 0.0625f * LOG2E;

__device__ __forceinline__ int fresh_tid() { int t = threadIdx.x; asm volatile("" : "+v"(t)); return t; }
__device__ __forceinline__ unsigned cvtpk(float lo, float hi) { f32x2 v = {lo, hi}; bf16x2_t b = __builtin_convertvector(v, bf16x2_t); return __builtin_bit_cast(unsigned, b); }
__device__ __forceinline__ float bflo(unsigned w) { return __uint_as_float(w << 16); }
__device__ __forceinline__ float bfhi(unsigned w) { return __uint_as_float(w & 0xffff0000u); }
__device__ __forceinline__ u32x4 pack8(f32x4 a, f32x4 b) { u32x4 w; w.x = cvtpk(a[0], a[1]); w.y = cvtpk(a[2], a[3]); w.z = cvtpk(b[0], b[1]); w.w = cvtpk(b[2], b[3]); return w; }
__device__ __forceinline__ float fexp2(float x) { return __builtin_amdgcn_exp2f(x); }
__device__ __forceinline__ float frcp(float x) { return __builtin_amdgcn_rcpf(x); }
__device__ __forceinline__ float sigmoidf_(float x) { return frcp(1.0f + fexp2(-x * LOG2E)); }
__device__ __forceinline__ float rstd_of(float ss) { return __builtin_amdgcn_rsqf(ss * (1.0f / DM) + RMS_EPS); }

namespace pg8 {
constexpr int BM = 256, BK = 64, HALF = 128, HTB = HALF * BK * 2, STAGE_BYTES = 8 * HTB, NXCD = 8, WGM = 8;
__host__ __device__ __forceinline__ int lds_byte(int r, int c) { const int st = (r >> 4) * 2 + (c >> 5), rr = r & 15, cc = c & 31, ob = rr * 64 + cc * 2; return st * 1024 + (ob ^ (((ob >> 9) & 1) << 5)); }
__host__ __device__ __forceinline__ void stage_rc(int b, int& R, int& C) { const int st = b / 1024, sb = b % 1024, swz = sb ^ (((sb >> 9) & 1) << 5); R = (st >> 1) * 16 + swz / 64; C = (st & 1) * 32 + (swz % 64) / 2; }
__host__ __device__ __forceinline__ int perm32(int rho) { const int n = rho >> 4, i = rho & 15; return 8 * (i >> 2) + 4 * n + (i & 3); }

struct Unit { int pm, pn, pb; };
struct Gemm { const bf16_t* A; const bf16_t* Bt; int lda, ldb, K; long sAb, sAh, sBb, sBh; };

struct Order {
    int nM, nN, nwg, G, c;
    __device__ __forceinline__ void init(int nM_, int nN_, int nB_, int G_, int c_) { nM = nM_; nN = nN_; nwg = nM_ * nN_ * nB_; G = G_; c = c_; }
    __device__ __forceinline__ bool next(int i, Unit& u) const {
        if (c < 0) return false;
        const long L = (long)i * G + c; if (L >= nwg) return false;
        int wgid = (int)L; { const int q = nwg / NXCD, r = nwg % NXCD, xcd = wgid % NXCD, off = wgid / NXCD; wgid = (xcd < r ? xcd * (q + 1) : r * (q + 1) + (xcd - r) * q) + off; }
        const int per = nM * nN; u.pb = wgid / per; const int w = wgid % per;
        const int nig = WGM * nN, gid = w / nig, fm = gid * WGM, gsz = (nM - fm) < WGM ? (nM - fm) : WGM;
        u.pm = fm + ((w % nig) % gsz); u.pn = (w % nig) / gsz; return true;
    }
};

typedef f32x4 Acc[2][2][4][2];

template <class Epi, bool ALIGN_EPI>
__device__ __forceinline__ void gemm_phase(LAS unsigned char* lds, const Gemm g, const Order& S, const Epi& E) {
    const int tid = fresh_tid(), wid = __builtin_amdgcn_readfirstlane(tid >> 6), lane = tid & 63, wr = wid >> 2, wc = wid & 3, fr = lane & 15, fq = lane >> 4;
    const int K = g.K, nt = K / BK;
    unsigned voffA[2], voffB[2];
#pragma unroll
    for (int i = 0; i < 2; ++i) { int R, C; stage_rc(tid * 16 + i * 8192, R, C); const int Rb = (R & ~31) + perm32(R & 31);
        voffA[i] = (unsigned)(R * g.lda + C) * 2u; voffB[i] = (unsigned)(Rb * g.ldb + C) * 2u; }
    const size_t kstep = (size_t)(BK * 2);
    const size_t hstepA = (size_t)HALF * g.lda * 2, hstepB = (size_t)HALF * g.ldb * 2;
    const size_t tstepA = 2 * hstepA, tstepB = 2 * hstepB;
    const unsigned ldsw = (unsigned)wid * 1024u;
    const int aoff = lds_byte(wr * 64 + fr, fq * 8), boff = lds_byte(wc * 32 + fr, fq * 8);
#define PG8_SA(b, h) (((b) * 2 + (h)) * HTB)
#define PG8_SB(b, h) ((4 + (b) * 2 + (h)) * HTB)
#define PG8_STAGE(bufoff, gbase, voff) do { _Pragma("unroll") for (int _i = 0; _i < 2; ++_i) \
        __builtin_amdgcn_global_load_lds((const unsigned*)((const char*)(gbase) + (voff)[_i]), (LAS unsigned*)(lds + (bufoff) + ldsw + _i * 8192), 16, 0, 0); } while (0)
#define PG8_LDA(dst, b, h) do { _Pragma("unroll") for (int m = 0; m < 4; ++m) _Pragma("unroll") for (int k = 0; k < 2; ++k) dst[m][k] = *(const LAS bf16x8*)(lds + PG8_SA(b, h) + aoff + m * 2048 + k * 1024); } while (0)
#define PG8_LDB(dst, b, h) do { _Pragma("unroll") for (int n = 0; n < 2; ++n) _Pragma("unroll") for (int k = 0; k < 2; ++k) dst[n][k] = *(const LAS bf16x8*)(lds + PG8_SB(b, h) + boff + n * 2048 + k * 1024); } while (0)
#define PG8_MMA(ai, bj, At, Bt) do { __builtin_amdgcn_s_setprio(1); _Pragma("unroll") for (int m = 0; m < 4; ++m) _Pragma("unroll") for (int n = 0; n < 2; ++n) _Pragma("unroll") for (int k = 0; k < 2; ++k) \
        acc[ai][bj][m][n] = __builtin_amdgcn_mfma_f32_16x16x32_bf16(Bt[n][k], At[m][k], acc[ai][bj][m][n], 0, 0, 0); __builtin_amdgcn_s_setprio(0); } while (0)
#define PG8_WAIT_V(n) asm volatile("s_waitcnt vmcnt(" #n ")" ::: "memory")
#define PG8_WAIT_L(n) asm volatile("s_waitcnt lgkmcnt(" #n ")" ::: "memory")
#define PG8_BAR __builtin_amdgcn_s_barrier()
#define PG8_SCHED __builtin_amdgcn_sched_barrier(0)
#define PG8_OFFA(u) ((size_t)(((u).pb >> 2) * g.sAb + ((u).pb & 3) * g.sAh) * 2 + (size_t)(u).pm * tstepA)
#define PG8_OFFB(u) ((size_t)(((u).pb >> 2) * g.sBb + ((u).pb & 3) * g.sBh) * 2 + (size_t)(u).pn * tstepB)
    Unit cur, nxt; int ui = 0;
    if (!S.next(0, cur)) return;
    Acc acc;
#pragma unroll
    for (int a = 0; a < 2; ++a)
#pragma unroll
        for (int b = 0; b < 2; ++b)
#pragma unroll
            for (int m = 0; m < 4; ++m)
#pragma unroll
                for (int n = 0; n < 2; ++n) acc[a][b][m][n] = (f32x4){0.f, 0.f, 0.f, 0.f};
    bf16x8 At[4][2], B0[2][2], B1[2][2];
    const char* cA = (const char*)g.A + PG8_OFFA(cur); const char* cB = (const char*)g.Bt + PG8_OFFB(cur);
    {
        PG8_STAGE(PG8_SB(0, 0), cB, voffB); PG8_STAGE(PG8_SB(0, 1), cB + hstepB, voffB); PG8_STAGE(PG8_SA(0, 0), cA, voffA); PG8_STAGE(PG8_SA(0, 1), cA + hstepA, voffA);
        if (wr == 1) PG8_BAR;
        PG8_WAIT_V(2); PG8_BAR;
        PG8_STAGE(PG8_SB(1, 0), cB + kstep, voffB); PG8_STAGE(PG8_SA(1, 0), cA + kstep, voffA); PG8_STAGE(PG8_SB(1, 1), cB + hstepB + kstep, voffB);
        PG8_WAIT_V(6); PG8_BAR;
    }
    for (;;) {
        const bool has_next = S.next(ui + 1, nxt);
        const char* nA = has_next ? (const char*)g.A + PG8_OFFA(nxt) : cA; const char* nB = has_next ? (const char*)g.Bt + PG8_OFFB(nxt) : cB;
        for (int t = 0; t < nt; t += 2) {
            const bool last = (t == nt - 2);
            const char* a1 = cA + (size_t)(t + 1) * kstep;
            const char* a2 = last ? nA : cA + (size_t)(t + 2) * kstep; const char* b2 = last ? nB : cB + (size_t)(t + 2) * kstep;
            const char* a3 = a2 + kstep; const char* b3 = b2 + kstep;
            PG8_LDB(B0, 0, 0); PG8_LDB(B1, 0, 1); PG8_SCHED; PG8_LDA(At, 0, 0); PG8_STAGE(PG8_SA(1, 1), a1 + hstepA, voffA);
            PG8_WAIT_V(8); PG8_WAIT_L(0); PG8_BAR; PG8_MMA(0, 0, At, B0); PG8_MMA(0, 1, At, B1); PG8_BAR; PG8_SCHED;
            PG8_LDA(At, 0, 1); PG8_STAGE(PG8_SB(0, 0), b2, voffB); PG8_STAGE(PG8_SB(0, 1), b2 + hstepB, voffB); PG8_STAGE(PG8_SA(0, 0), a2, voffA);
            PG8_WAIT_V(8); PG8_WAIT_L(0); PG8_BAR; PG8_MMA(1, 0, At, B0); PG8_MMA(1, 1, At, B1); PG8_BAR; PG8_SCHED;
            PG8_LDB(B0, 1, 0); PG8_LDB(B1, 1, 1); PG8_SCHED; PG8_LDA(At, 1, 0); PG8_STAGE(PG8_SA(0, 1), a2 + hstepA, voffA);
            PG8_WAIT_V(8); PG8_WAIT_L(0); PG8_BAR; PG8_MMA(0, 0, At, B0); PG8_MMA(0, 1, At, B1); PG8_BAR; PG8_SCHED;
            PG8_LDA(At, 1, 1); PG8_STAGE(PG8_SB(1, 0), b3, voffB); PG8_STAGE(PG8_SB(1, 1), b3 + hstepB, voffB); PG8_STAGE(PG8_SA(1, 0), a3, voffA);
            PG8_WAIT_V(8); PG8_WAIT_L(0); PG8_BAR; PG8_MMA(1, 0, At, B0); PG8_MMA(1, 1, At, B1); PG8_BAR; PG8_SCHED;
        }
        if constexpr (ALIGN_EPI) { if (wr == 0) PG8_BAR; }
        if constexpr (!Epi::AFTER_DRAIN) { E(acc, cur, wr, wc, fr, fq); }
        if (!has_next) break;
#pragma unroll
        for (int a = 0; a < 2; ++a)
#pragma unroll
            for (int b = 0; b < 2; ++b)
#pragma unroll
                for (int m = 0; m < 4; ++m)
#pragma unroll
                    for (int n = 0; n < 2; ++n) acc[a][b][m][n] = (f32x4){0.f, 0.f, 0.f, 0.f};
        cur = nxt; cA = nA; cB = nB; ++ui;
        if constexpr (ALIGN_EPI) { if (wr == 1) PG8_BAR; }
    }
    PG8_WAIT_V(0);
    if constexpr (!ALIGN_EPI) { if (wr == 0) PG8_BAR; }
    PG8_BAR;
    if constexpr (Epi::AFTER_DRAIN) { E.fused(acc, cur, wr, wc, fr, fq, lds, wid, lane); }
#undef PG8_SA
#undef PG8_SB
#undef PG8_STAGE
#undef PG8_LDA
#undef PG8_LDB
#undef PG8_MMA
#undef PG8_WAIT_V
#undef PG8_WAIT_L
#undef PG8_BAR
#undef PG8_SCHED
#undef PG8_OFFA
#undef PG8_OFFB
}

struct EpiNull { static constexpr bool AFTER_DRAIN = false; float* sink; __device__ __forceinline__ void operator()(const Acc& acc, const Unit& u, int wr, int wc, int fr, int fq) const { f32x4 s = {0.f, 0.f, 0.f, 0.f};
_Pragma("unroll") for (int a = 0; a < 2; ++a) _Pragma("unroll") for (int b = 0; b < 2; ++b) _Pragma("unroll") for (int m = 0; m < 4; ++m) _Pragma("unroll") for (int n = 0; n < 2; ++n) s += acc[a][b][m][n];
 if (s[0] + s[1] + s[2] + s[3] == 1234567.25f) sink[0] = 1.f; } };
struct EpiGU {
    static constexpr bool AFTER_DRAIN = false;
    bf16_t* H; const float* ss;
    __device__ __forceinline__ void operator()(const Acc& acc, const Unit& u, int wr, int wc, int fr, int fq) const {
        const int row0 = u.pm * BM + wr * 64 + fr, col0 = u.pn * 128 + wc * 32 + fq * 8;
#pragma unroll
        for (int ai = 0; ai < 2; ++ai)
#pragma unroll
            for (int m = 0; m < 4; ++m) {
                const int row = row0 + ai * HALF + m * 16; const float rs = rstd_of(ss[row]);
                f32x4 h[2];
#pragma unroll
                for (int n = 0; n < 2; ++n) { const f32x4 gg = acc[ai][0][m][n] * rs, uu = acc[ai][1][m][n] * rs;
#pragma unroll
                    for (int j = 0; j < 4; ++j) h[n][j] = gg[j] * sigmoidf_(gg[j]) * uu[j]; }
                *(u32x4*)(H + (size_t)row * FF + col0) = pack8(h[0], h[1]);
            }
    }
};
template <bool WRITE_XB, bool WRITE_SS> struct EpiRes {
    static constexpr bool AFTER_DRAIN = false;
    const float* base; float* out; bf16_t* xb; float* ss; float scale;
    __device__ __forceinline__ void operator()(const Acc& acc, const Unit& u, int wr, int wc, int fr, int fq) const {
        const int row0 = u.pm * BM + wr * 64 + fr, col0 = u.pn * BM + wc * 32 + fq * 8;
#pragma unroll
        for (int ai = 0; ai < 2; ++ai)
#pragma unroll
            for (int m = 0; m < 4; ++m) {
                const int row = row0 + ai * HALF + m * 16; float sq = 0.f;
#pragma unroll
                for (int bj = 0; bj < 2; ++bj) { const size_t p = (size_t)row * DM + col0 + bj * HALF;
                    const f32x4 o0 = *(const f32x4*)(base + p), o1 = *(const f32x4*)(base + p + 4);
                    const f32x4 n0 = o0 + acc[ai][bj][m][0] * scale, n1 = o1 + acc[ai][bj][m][1] * scale;
                    *(f32x4*)(out + p) = n0; *(f32x4*)(out + p + 4) = n1;
                    if (WRITE_XB) *(u32x4*)(xb + p) = pack8(n0, n1);
                    if (WRITE_SS) sq += (n0[0] * n0[0] + n0[1] * n0[1]) + (n0[2] * n0[2] + n0[3] * n0[3]) + (n1[0] * n1[0] + n1[1] * n1[1]) + (n1[2] * n1[2] + n1[3] * n1[3]); }
                if (WRITE_SS) { sq += __shfl_xor(sq, 16); sq += __shfl_xor(sq, 32); if (fq == 0) unsafeAtomicAdd(ss + row, sq); }
                asm volatile("" ::: "memory");
            }
    }
};
struct EpiQKV {
    static constexpr bool AFTER_DRAIN = false;
    bf16_t *QN, *KVN, *QF, *KVF, *GAB; float* F32S; const float* ss;
    __device__ __forceinline__ void operator()(const Acc& acc, const Unit& u, int wr, int wc, int fr, int fq) const {
        const int row0 = u.pm * BM + wr * 64 + fr, pn = u.pn;
        if (pn == 19) {
            if (wc == 0) {
#pragma unroll
                for (int ai = 0; ai < 2; ++ai)
#pragma unroll
                    for (int m = 0; m < 4; ++m) { const int row = row0 + ai * HALF + m * 16; const float rs = rstd_of(ss[row]);
                        *(f32x4*)(F32S + (size_t)row * 32 + fq * 8) = acc[ai][0][m][0] * rs; *(f32x4*)(F32S + (size_t)row * 32 + fq * 8 + 4) = acc[ai][0][m][1] * rs; }
            }
            return;
        }
        bf16_t* dst; int pitch, coff;
        if (pn < 2) { dst = QN; pitch = 512; coff = pn * 256; }
        else if (pn < 5) { dst = KVN; pitch = 768; coff = (pn - 2) * 256; }
        else if (pn < 7) { dst = QF; pitch = 512; coff = (pn - 5) * 256; }
        else if (pn < 11) { dst = KVF; pitch = 1024; coff = (pn - 7) * 256; }
        else { dst = GAB; pitch = 2048; coff = (pn - 11) * 256; }
        coff += wc * 32 + fq * 8;
#pragma unroll
        for (int ai = 0; ai < 2; ++ai)
#pragma unroll
            for (int m = 0; m < 4; ++m) { const int row = row0 + ai * HALF + m * 16; const float rs = rstd_of(ss[row]);
#pragma unroll
                for (int bj = 0; bj < 2; ++bj) *(u32x4*)(dst + (size_t)row * pitch + coff + bj * HALF) = pack8(acc[ai][bj][m][0] * rs, acc[ai][bj][m][1] * rs); }
    }
};
template <int STEP> struct EpiUp {
    static constexpr bool AFTER_DRAIN = false;
    const bf16_t* GAB; bf16_t* Y;
    __device__ __forceinline__ void operator()(const Acc& acc, const Unit& u, int wr, int wc, int fr, int fq) const {
        const int row0 = u.pm * BM + wr * 64 + fr, col0 = u.pn * BM + wc * 32 + fq * 8;
#pragma unroll
        for (int ai = 0; ai < 2; ++ai)
#pragma unroll
            for (int m = 0; m < 4; ++m) { const int row = row0 + ai * HALF + m * 16;
#pragma unroll
                for (int bj = 0; bj < 2; ++bj) { const int c = col0 + bj * HALF;
                    const u32x4 gw = *(const u32x4*)(GAB + (size_t)row * 2048 + STEP * 1024 + c);
                    f32x4 v0, v1; const f32x4 a0 = acc[ai][bj][m][0], a1 = acc[ai][bj][m][1];
                    v0[0] = sigmoidf_(bflo(gw.x)) * a0[0]; v0[1] = sigmoidf_(bfhi(gw.x)) * a0[1]; v0[2] = sigmoidf_(bflo(gw.y)) * a0[2]; v0[3] = sigmoidf_(bfhi(gw.y)) * a0[3];
                    v1[0] = sigmoidf_(bflo(gw.z)) * a1[0]; v1[1] = sigmoidf_(bfhi(gw.z)) * a1[1]; v1[2] = sigmoidf_(bflo(gw.w)) * a1[2]; v1[3] = sigmoidf_(bfhi(gw.w)) * a1[3];
                    bf16_t* yp = Y + (size_t)row * DM + c;
                    if (STEP == 1) { const u32x4 y = *(const u32x4*)yp;
                        v0[0] += bflo(y.x); v0[1] += bfhi(y.x); v0[2] += bflo(y.y); v0[3] += bfhi(y.y); v1[0] += bflo(y.z); v1[1] += bfhi(y.z); v1[2] += bflo(y.w); v1[3] += bfhi(y.w); }
                    *(u32x4*)yp = pack8(v0, v1); }
                asm volatile("" ::: "memory"); }
    }
};
struct EpiRowScale {
    static constexpr bool AFTER_DRAIN = false;
    bf16_t* O; int ldo; const float* ss;
    __device__ __forceinline__ void operator()(const Acc& acc, const Unit& u, int wr, int wc, int fr, int fq) const {
        const int row0 = u.pm * BM + wr * 64 + fr, col0 = u.pn * BM + wc * 32 + fq * 8;
#pragma unroll
        for (int ai = 0; ai < 2; ++ai)
#pragma unroll
            for (int m = 0; m < 4; ++m) { const int row = row0 + ai * HALF + m * 16; const float rs = rstd_of(ss[row]);
#pragma unroll
                for (int bj = 0; bj < 2; ++bj) *(u32x4*)(O + (size_t)row * ldo + col0 + bj * HALF) = pack8(acc[ai][bj][m][0] * rs, acc[ai][bj][m][1] * rs); }
    }
};
struct EpiColScale {
    static constexpr bool AFTER_DRAIN = false;
    bf16_t* O; int ldo; const float* ss;
    __device__ __forceinline__ void operator()(const Acc& acc, const Unit& u, int wr, int wc, int fr, int fq) const {
        const int row0 = u.pm * BM + wr * 64 + fr, col0 = u.pn * BM + wc * 32 + fq * 8;
#pragma unroll
        for (int bj = 0; bj < 2; ++bj) { const int c = col0 + bj * HALF;
            f32x4 s0 = *(const f32x4*)(ss + c), s1 = *(const f32x4*)(ss + c + 4);
#pragma unroll
            for (int j = 0; j < 4; ++j) { s0[j] = rstd_of(s0[j]); s1[j] = rstd_of(s1[j]); }
#pragma unroll
            for (int ai = 0; ai < 2; ++ai)
#pragma unroll
                for (int m = 0; m < 4; ++m) { const int row = row0 + ai * HALF + m * 16;
                    *(u32x4*)(O + (size_t)row * ldo + c) = pack8(acc[ai][bj][m][0] * s0, acc[ai][bj][m][1] * s1); } }
    }
};
struct EpiBatchBf16 {
    static constexpr bool AFTER_DRAIN = false;
    bf16_t* O; int ldo; long sOb, sOh;
    __device__ __forceinline__ void operator()(const Acc& acc, const Unit& u, int wr, int wc, int fr, int fq) const {
        const int row0 = u.pm * BM + wr * 64 + fr, col0 = u.pn * BM + wc * 32 + fq * 8;
        bf16_t* Ob = O + (size_t)((u.pb >> 2) * sOb + (u.pb & 3) * sOh);
#pragma unroll
        for (int ai = 0; ai < 2; ++ai)
#pragma unroll
            for (int m = 0; m < 4; ++m) { const int row = row0 + ai * HALF + m * 16;
#pragma unroll
                for (int bj = 0; bj < 2; ++bj) *(u32x4*)(Ob + (size_t)row * ldo + col0 + bj * HALF) = pack8(acc[ai][bj][m][0], acc[ai][bj][m][1]); }
    }
};
struct EpiSoftmax {
    static constexpr bool AFTER_DRAIN = true;
    bf16_t* P;
    __device__ __forceinline__ void fused(Acc& acc, const Unit& u, int wr, int wc, int fr, int fq, LAS unsigned char* lds, int wid, int lane) const {
        LAS float* Pm = (LAS float*)lds;
        LAS float* Ps = (LAS float*)(lds + 8192);
#pragma unroll
        for (int ai = 0; ai < 2; ++ai)
#pragma unroll
            for (int m = 0; m < 4; ++m) { float mx = -3.0e38f;
#pragma unroll
                for (int bj = 0; bj < 2; ++bj)
#pragma unroll
                    for (int n = 0; n < 2; ++n) { const f32x4 x = acc[ai][bj][m][n]; mx = fmaxf(mx, fmaxf(fmaxf(x[0], x[1]), fmaxf(x[2], x[3]))); }
                mx = fmaxf(mx, __shfl_xor(mx, 16)); mx = fmaxf(mx, __shfl_xor(mx, 32));
                if (fq == 0) Pm[(ai * HALF + wr * 64 + m * 16 + fr) * 4 + wc] = mx; }
        __syncthreads();
#pragma unroll
        for (int ai = 0; ai < 2; ++ai)
#pragma unroll
            for (int m = 0; m < 4; ++m) { const int r = ai * HALF + wr * 64 + m * 16 + fr; const f32x4 t = *(const LAS f32x4*)(Pm + r * 4);
                const float mx = fmaxf(fmaxf(t[0], t[1]), fmaxf(t[2], t[3])); float s = 0.f;
#pragma unroll
                for (int bj = 0; bj < 2; ++bj)
#pragma unroll
                    for (int n = 0; n < 2; ++n) { f32x4 x = acc[ai][bj][m][n];
#pragma unroll
                        for (int j = 0; j < 4; ++j) { x[j] = fexp2(x[j] - mx); s += x[j]; }
                        acc[ai][bj][m][n] = x; }
                s += __shfl_xor(s, 16); s += __shfl_xor(s, 32);
                if (fq == 0) Ps[r * 4 + wc] = s; }
        __syncthreads();
        bf16_t* Pb = P + (size_t)u.pb * SEQ * 256;
        const int col0 = wc * 32 + fq * 8;
#pragma unroll
        for (int ai = 0; ai < 2; ++ai)
#pragma unroll
            for (int m = 0; m < 4; ++m) { const int r = ai * HALF + wr * 64 + m * 16 + fr; const f32x4 t = *(const LAS f32x4*)(Ps + r * 4);
                const float inv = 1.0f / ((t[0] + t[1]) + (t[2] + t[3])); const int row = u.pm * BM + r;
#pragma unroll
                for (int bj = 0; bj < 2; ++bj) *(u32x4*)(Pb + (size_t)row * 256 + col0 + bj * HALF) = pack8(acc[ai][bj][m][0] * inv, acc[ai][bj][m][1] * inv); }
        __syncthreads();
    }
};
}
namespace att {
__device__ __forceinline__ int crow(int r, int hi) { return (r & 3) + 8 * (r >> 2) + 4 * hi; }
#define SBAR() __builtin_amdgcn_sched_barrier(0)
constexpr float NEG = -INFINITY;
constexpr int L_SLOT = 0;
constexpr int L_WSF = 32768;
constexpr int L_OST = L_WSF + 2048;
constexpr int L_TBL = L_OST + 32768;
constexpr int L_CB = L_TBL + 4096;
constexpr int L_PS = L_CB + 8192;
constexpr int L_IMP = L_PS + 4 * 64 * 33 * 4;
constexpr int L_MISC = L_IMP + 64 * 33 * 4;
constexpr int L_END = L_MISC + 64;
static_assert(L_END <= 131072, "attention LDS map");

__device__ __forceinline__ void qkt(f32x16& p0, f32x16& p1, const LAS unsigned char* Kslot, const bf16x8 (&qr)[4], int r32, int hi) {
    const LAS unsigned char* kb = Kslot + hi * 1024 + r32 * 16;
    p0 = f32x16{}; p1 = f32x16{};
#pragma unroll
    for (int d0 = 0; d0 < 4; ++d0) {
        const bf16x8 b0 = *(const LAS bf16x8*)(kb + d0 * 2048);
        const bf16x8 b1 = *(const LAS bf16x8*)(kb + d0 * 2048 + 512);
        p0 = __builtin_amdgcn_mfma_f32_32x32x16_bf16(b0, qr[d0], p0, 0, 0, 0);
        p1 = __builtin_amdgcn_mfma_f32_32x32x16_bf16(b1, qr[d0], p1, 0, 0, 0);
    }
}
__device__ __forceinline__ void pv(f32x16 (&o)[2], int vb, bf16x8 pa0, bf16x8 pa1, bf16x8 pa2, bf16x8 pa3) {
#pragma unroll
    for (int d0 = 0; d0 < 2; ++d0) { s16x4 lo[4], hi[4];
#pragma unroll
        for (int ks = 0; ks < 4; ++ks) {
            asm volatile("ds_read_b64_tr_b16 %0,%1 offset:%c2" : "=&v"(lo[ks]) : "v"(vb), "i"(d0 * 4096 + ks * 1024) : "memory");
            asm volatile("ds_read_b64_tr_b16 %0,%1 offset:%c2" : "=&v"(hi[ks]) : "v"(vb), "i"(d0 * 4096 + ks * 1024 + 512) : "memory"); }
        asm volatile("s_waitcnt lgkmcnt(0)" ::: "memory"); SBAR();
#define PK(k) (bf16x8){lo[k][0], lo[k][1], lo[k][2], lo[k][3], hi[k][0], hi[k][1], hi[k][2], hi[k][3]}
        o[d0] = __builtin_amdgcn_mfma_f32_32x32x16_bf16(pa0, PK(0), o[d0], 0, 0, 0);
        o[d0] = __builtin_amdgcn_mfma_f32_32x32x16_bf16(pa1, PK(1), o[d0], 0, 0, 0);
        o[d0] = __builtin_amdgcn_mfma_f32_32x32x16_bf16(pa2, PK(2), o[d0], 0, 0, 0);
        o[d0] = __builtin_amdgcn_mfma_f32_32x32x16_bf16(pa3, PK(3), o[d0], 0, 0, 0);
#undef PK
    }
}
__device__ __forceinline__ float rowmax32(const f32x16& p0, const f32x16& p1) {
    float a = fmaxf(p0[0], p1[0]);
#pragma unroll
    for (int r = 1; r < 16; ++r) a = fmaxf(a, fmaxf(p0[r], p1[r]));
    auto rr = __builtin_amdgcn_permlane32_swap(__float_as_uint(a), __float_as_uint(a), false, false);
    return fmaxf(__uint_as_float(rr[0]), __uint_as_float(rr[1]));
}
__device__ __forceinline__ float halfsum(float v) {
    auto rr = __builtin_amdgcn_permlane32_swap(__float_as_uint(v), __float_as_uint(v), false, false);
    return __uint_as_float(rr[0]) + __uint_as_float(rr[1]);
}
#define PKW(P, B) cvtpk(P[B], P[B + 1])
__device__ __forceinline__ void pack_p(const f32x16& p0, const f32x16& p1, bf16x8& a0, bf16x8& a1, bf16x8& a2, bf16x8& a3) {
    const u32x4 w0 = {PKW(p0, 0), PKW(p0, 2), PKW(p0, 4), PKW(p0, 6)}, w1 = {PKW(p0, 8), PKW(p0, 10), PKW(p0, 12), PKW(p0, 14)};
    const u32x4 w2 = {PKW(p1, 0), PKW(p1, 2), PKW(p1, 4), PKW(p1, 6)}, w3 = {PKW(p1, 8), PKW(p1, 10), PKW(p1, 12), PKW(p1, 14)};
    a0 = __builtin_bit_cast(bf16x8, w0); a1 = __builtin_bit_cast(bf16x8, w1); a2 = __builtin_bit_cast(bf16x8, w2); a3 = __builtin_bit_cast(bf16x8, w3);
}
#undef PKW
__device__ __forceinline__ void scale_rows(f32x16 (&o)[2], LAS float* wsf, float v, int r32, int hi) {
    if (hi == 0) wsf[r32] = v;
    asm volatile("s_waitcnt lgkmcnt(0)" ::: "memory");
#pragma unroll
    for (int i = 0; i < 4; ++i) { const f32x4 f = *(const LAS f32x4*)(wsf + 8 * i + 4 * hi);
#pragma unroll
        for (int j = 0; j < 4; ++j) { o[0][4 * i + j] *= f[j]; o[1][4 * i + j] *= f[j]; } }
    asm volatile("s_waitcnt lgkmcnt(0)" ::: "memory");
}
struct StageGeo { int krow, kcol, koff, vrow, vcol, voff; };
__device__ __forceinline__ StageGeo stage_geo(int tid) {
    StageGeo s; const int w = tid >> 6, ln = tid & 63;
    s.krow = ln; s.kcol = w * 8; s.koff = w * 1024 + ln * 16;
    s.vrow = 16 * (w & 3) + (ln >> 2); s.vcol = (w >> 2) * 32 + (ln & 3) * 8; s.voff = 8192 + w * 1024 + ln * 16;
    return s;
}
template <class Mod>
__device__ __forceinline__ void tile_step(const LAS unsigned char* slot, const bf16x8 (&qr)[4], f32x16 (&o)[2], float& m, float& l, LAS float* wsf, const Mod& mod, int r32, int hi, int vb) {
    f32x16 p0, p1;
    qkt(p0, p1, slot, qr, r32, hi);
    mod(p0, p1);
    const float rm = rowmax32(p0, p1);
    const float mn = fmaxf(m, rm);
    const float alpha = fexp2(m - mn);
    const bool need = __any(mn > m);
    m = mn;
    float s = 0.f;
#pragma unroll
    for (int r = 0; r < 16; ++r) { p0[r] = fexp2(p0[r] - mn); p1[r] = fexp2(p1[r] - mn); s += p0[r] + p1[r]; }
    l = l * alpha + s;
    if (need) scale_rows(o, wsf, alpha, r32, hi);
    bf16x8 a0, a1, a2, a3; pack_p(p0, p1, a0, a1, a2, a3);
    pv(o, vb, a0, a1, a2, a3);
}
template <class ModF>
__device__ __forceinline__ void attn_loop(unsigned tmask, const bf16_t* Kg, int pitchK, const bf16_t* Vg, int pitchV, LAS unsigned char* lds, const bf16x8 (&qr)[4],
                                          f32x16 (&o)[2], float& m, float& l, const ModF& modf, int wave_last_row) {
    const int tid = fresh_tid(), lane = tid & 63, r32 = lane & 31, hi = lane >> 5, wid = tid >> 6;
    const StageGeo sg = stage_geo(tid);
    LAS float* wsf = (LAS float*)(lds + L_WSF) + wid * 64;
    const int vb0 = (int)(unsigned)(size_t)(lds + L_SLOT + 8192) + ((lane >> 4) & 1) * 32 + (lane & 3) * 8 + (4 * hi + ((lane & 15) >> 2)) * 64;
    int kt = 31 - __clz((int)tmask);
    u32x4 kreg = *(const u32x4*)(Kg + (size_t)(kt * 64 + sg.krow) * pitchK + sg.kcol);
    u32x4 vreg = *(const u32x4*)(Vg + (size_t)(kt * 64 + sg.vrow) * pitchV + sg.vcol);
    *(LAS u32x4*)(lds + L_SLOT + sg.koff) = kreg; *(LAS u32x4*)(lds + L_SLOT + sg.voff) = vreg;
    __syncthreads();
    int s = 0;
    for (;;) {
        tmask &= ~(1u << kt);
        const int nk = tmask ? 31 - __clz((int)tmask) : -1;
        if (nk >= 0) { kreg = *(const u32x4*)(Kg + (size_t)(nk * 64 + sg.krow) * pitchK + sg.kcol); vreg = *(const u32x4*)(Vg + (size_t)(nk * 64 + sg.vrow) * pitchV + sg.vcol); }
        if (kt * 64 <= wave_last_row) tile_step(lds + L_SLOT + s * 16384, qr, o, m, l, wsf, modf(kt), r32, hi, vb0 + s * 16384);
        if (nk >= 0) { *(LAS u32x4*)(lds + L_SLOT + (s ^ 1) * 16384 + sg.koff) = kreg; *(LAS u32x4*)(lds + L_SLOT + (s ^ 1) * 16384 + sg.voff) = vreg; }
        __syncthreads();
        if (nk < 0) break;
        kt = nk; s ^= 1;
    }
}
template <bool ADD>
__device__ __forceinline__ void store_o(const f32x16 (&o)[2], LAS unsigned char* lds, bf16_t* dst, int pitch, const bf16_t* addsrc, int addpitch) {
    const int tid = fresh_tid(), lane = tid & 63, r32 = lane & 31, hi = lane >> 5, wid = tid >> 6;
    LAS bf16_t* stg = (LAS bf16_t*)(lds + L_OST) + wid * 2048;
#pragma unroll
    for (int r = 0; r < 16; ++r) { const int orow = crow(r, hi);
#pragma unroll
        for (int d0 = 0; d0 < 2; ++d0) stg[orow * 64 + d0 * 32 + r32] = (bf16_t)(cvtpk(o[d0][r], 0.f) & 0xffffu); }
    asm volatile("s_waitcnt lgkmcnt(0)" ::: "memory");
#pragma unroll
    for (int i = 0; i < 4; ++i) { const int row = i * 8 + (lane >> 3), ch = lane & 7;
        u32x4 v = *(const LAS u32x4*)(stg + row * 64 + ch * 8);
        if (ADD) { const u32x4 a = *(const u32x4*)(addsrc + (size_t)row * addpitch + ch * 8);
            v.x = cvtpk(bflo(v.x) + bflo(a.x), bfhi(v.x) + bfhi(a.x)); v.y = cvtpk(bflo(v.y) + bflo(a.y), bfhi(v.y) + bfhi(a.y));
            v.z = cvtpk(bflo(v.z) + bflo(a.z), bfhi(v.z) + bfhi(a.z)); v.w = cvtpk(bflo(v.w) + bflo(a.w), bfhi(v.w) + bfhi(a.w)); }
        *(u32x4*)(dst + (size_t)row * pitch + ch * 8) = v; }
    asm volatile("s_waitcnt lgkmcnt(0)" ::: "memory");
}
__device__ __forceinline__ void load_q(bf16x8 (&qr)[4], const bf16_t* Qw, int pitch, int r32, int hi) {
#pragma unroll
    for (int d0 = 0; d0 < 4; ++d0) qr[d0] = *(const bf16x8*)(Qw + (size_t)r32 * pitch + d0 * 16 + hi * 8);
}

struct ModFox { const LAS float* cb; int kbase, qpos, hi; bool diag;
    __device__ __forceinline__ void operator()(f32x16& p0, f32x16& p1) const {
#pragma unroll
        for (int i = 0; i < 4; ++i) { const f32x4 c0 = *(const LAS f32x4*)(cb + kbase + 8 * i + 4 * hi), c1 = *(const LAS f32x4*)(cb + kbase + 32 + 8 * i + 4 * hi);
#pragma unroll
            for (int j = 0; j < 4; ++j) { p0[4 * i + j] += c0[j]; p1[4 * i + j] += c1[j]; } }
        if (diag) {
#pragma unroll
            for (int r = 0; r < 16; ++r) { const int kv = kbase + crow(r, hi); if (kv > qpos) p0[r] = NEG; if (kv + 32 > qpos) p1[r] = NEG; } }
    } };
struct ModFoxF { const LAS float* cb; int qpos, hi, q0w;
    __device__ __forceinline__ ModFox operator()(int kt) const { return ModFox{cb, kt * 64, qpos, hi, kt * 64 + 63 > q0w}; } };
struct ModT5 { const LAS float* tb; int kbase, qpos, hi, window; bool enabled;
    __device__ __forceinline__ void operator()(f32x16& p0, f32x16& p1) const {
#pragma unroll
        for (int r = 0; r < 16; ++r) { const int d0 = qpos - (kbase + crow(r, hi)), d1 = d0 - 32;
            const float b0 = tb[min(max(d0, 0), 127)], b1 = tb[min(max(d1, 0), 127)];
            p0[r] = (enabled && d0 >= 0 && d0 < window) ? p0[r] + b0 : NEG;
            p1[r] = (enabled && d1 >= 0 && d1 < window) ? p1[r] + b1 : NEG; }
    } };
struct ModWinF { const LAS float* tb; int qpos, hi;
    __device__ __forceinline__ ModT5 operator()(int kt) const { return ModT5{tb, kt * 64, qpos, hi, 512, true}; } };
struct ModSelF { const LAS float* tb; int qpos, hi; unsigned mask;
    __device__ __forceinline__ ModT5 operator()(int kt) const { return ModT5{tb, kt * 64, qpos, hi, 1 << 30, ((mask >> kt) & 1u) != 0u}; } };

typedef short v4i16_t __attribute__((ext_vector_type(4)));
__device__ __forceinline__ s16x4 vtr(const LAS unsigned char* p) { return __builtin_bit_cast(s16x4, __builtin_amdgcn_ds_read_tr16_b64_v4i16((LAS v4i16_t*)p)); }
__device__ __forceinline__ void qkt_c(f32x16& p0, f32x16& p1, const LAS unsigned char* Kslot, const bf16x8 (&qr)[4], const f32x16& c0, const f32x16& c1, int r32, int hi) {
    const LAS unsigned char* kb = Kslot + hi * 1024 + r32 * 16;
    { const bf16x8 b0 = *(const LAS bf16x8*)(kb); const bf16x8 b1 = *(const LAS bf16x8*)(kb + 512);
      p0 = __builtin_amdgcn_mfma_f32_32x32x16_bf16(b0, qr[0], c0, 0, 0, 0); p1 = __builtin_amdgcn_mfma_f32_32x32x16_bf16(b1, qr[0], c1, 0, 0, 0); }
#pragma unroll
    for (int d0 = 1; d0 < 4; ++d0) {
        const bf16x8 b0 = *(const LAS bf16x8*)(kb + d0 * 2048); const bf16x8 b1 = *(const LAS bf16x8*)(kb + d0 * 2048 + 512);
        p0 = __builtin_amdgcn_mfma_f32_32x32x16_bf16(b0, qr[d0], p0, 0, 0, 0); p1 = __builtin_amdgcn_mfma_f32_32x32x16_bf16(b1, qr[d0], p1, 0, 0, 0); }
}
__device__ __forceinline__ void pv2(f32x16 (&o)[2], const LAS unsigned char* vp, bf16x8 pa0, bf16x8 pa1, bf16x8 pa2, bf16x8 pa3) {
#pragma unroll
    for (int d0 = 0; d0 < 2; ++d0) { s16x4 lo[4], hi[4];
#pragma unroll
        for (int ks = 0; ks < 4; ++ks) { lo[ks] = vtr(vp + d0 * 4096 + ks * 1024); hi[ks] = vtr(vp + d0 * 4096 + ks * 1024 + 512); }
#define PK(k) (bf16x8){lo[k][0], lo[k][1], lo[k][2], lo[k][3], hi[k][0], hi[k][1], hi[k][2], hi[k][3]}
        o[d0] = __builtin_amdgcn_mfma_f32_32x32x16_bf16(pa0, PK(0), o[d0], 0, 0, 0);
        o[d0] = __builtin_amdgcn_mfma_f32_32x32x16_bf16(pa1, PK(1), o[d0], 0, 0, 0);
        o[d0] = __builtin_amdgcn_mfma_f32_32x32x16_bf16(pa2, PK(2), o[d0], 0, 0, 0);
        o[d0] = __builtin_amdgcn_mfma_f32_32x32x16_bf16(pa3, PK(3), o[d0], 0, 0, 0);
#undef PK
    }
}
__device__ __forceinline__ float rowmax32b(const f32x16& p0, const f32x16& p1) {
    float a = __builtin_fmaxf(__builtin_fmaxf(p0[0], p0[1]), p1[0]), b = __builtin_fmaxf(__builtin_fmaxf(p0[2], p0[3]), p1[1]); a = __builtin_fmaxf(__builtin_fmaxf(a, p1[2]), p1[3]);
#pragma unroll
    for (int r = 4; r < 16; r += 4) { a = __builtin_fmaxf(__builtin_fmaxf(a, p0[r]), p0[r + 1]); b = __builtin_fmaxf(__builtin_fmaxf(b, p0[r + 2]), p0[r + 3]);
        a = __builtin_fmaxf(__builtin_fmaxf(a, p1[r]), p1[r + 1]); b = __builtin_fmaxf(__builtin_fmaxf(b, p1[r + 2]), p1[r + 3]); }
    const float m = __builtin_fmaxf(a, b);
    auto rr = __builtin_amdgcn_permlane32_swap(__float_as_uint(m), __float_as_uint(m), false, false);
    return __builtin_fmaxf(__uint_as_float(rr[0]), __uint_as_float(rr[1]));
}
constexpr float DEFER_THR = 6.0f;
template <class TF>
__device__ __forceinline__ bool attn_step(f32x16& sc0, f32x16& sc1, f32x16& sn0, f32x16& sn1, int& kt, int& kt1, unsigned& tmask, int par, bool& first, bool& act_cur,
                                          float& mref, float& l, f32x16 (&o)[2], const bf16x8 (&qr)[4], const bf16_t* Kg, int pitchK, const bf16_t* Vg, int pitchV,
                                          LAS unsigned char* lds, const StageGeo& sg, LAS float* wsf, const LAS unsigned char* vp0, const TF& tf, int wave_last_row, int r32, int hi) {
    const int kt2 = tmask ? 31 - __clz((int)tmask) : -1;
    u32x4 kreg, vreg;
    if (kt2 >= 0) kreg = *(const u32x4*)(Kg + (size_t)(kt2 * 64 + sg.krow) * pitchK + sg.kcol);
    if (kt1 >= 0) vreg = *(const u32x4*)(Vg + (size_t)(kt1 * 64 + sg.vrow) * pitchV + sg.vcol);
    const bool act_next = kt1 >= 0 && kt1 * 64 <= wave_last_row;
    if (act_next) { f32x16 c0, c1; tf.cinit(kt1, mref, c0, c1); qkt_c(sn0, sn1, lds + L_SLOT + (par ^ 1) * 16384, qr, c0, c1, r32, hi); }
    if (act_cur) {
        tf.post(kt, sc0, sc1);
        const float rm = rowmax32b(sc0, sc1);
        if (__any(first || rm > DEFER_THR)) {
            const float delta = first ? (rm == NEG ? 0.f : rm) : __builtin_fmaxf(rm, 0.f);
            mref += delta;
#pragma unroll
            for (int r = 0; r < 16; ++r) { sc0[r] -= delta; sc1[r] -= delta; }
            if (act_next) {
#pragma unroll
                for (int r = 0; r < 16; ++r) { sn0[r] -= delta; sn1[r] -= delta; } }
            const float f = fexp2(-delta); l *= f;
            if (!first) scale_rows(o, wsf, f, r32, hi);
            first = false;
        }
        float s = 0.f;
#pragma unroll
        for (int r = 0; r < 16; ++r) { sc0[r] = fexp2(sc0[r]); sc1[r] = fexp2(sc1[r]); s += sc0[r] + sc1[r]; }
        l += s;
        bf16x8 a0, a1, a2, a3; pack_p(sc0, sc1, a0, a1, a2, a3);
        pv2(o, vp0 + par * 16384, a0, a1, a2, a3);
    }
    if (kt2 >= 0) *(LAS u32x4*)(lds + L_SLOT + par * 16384 + sg.koff) = kreg;
    if (kt1 >= 0) *(LAS u32x4*)(lds + L_SLOT + (par ^ 1) * 16384 + sg.voff) = vreg;
    __syncthreads();
    if (kt1 < 0) return true;
    kt = kt1; kt1 = kt2; if (kt2 >= 0) tmask &= ~(1u << kt2); act_cur = act_next;
    return false;
}
template <class TF>
__device__ __forceinline__ void attn_loop2(unsigned tmask, const bf16_t* Kg, int pitchK, const bf16_t* Vg, int pitchV, LAS unsigned char* lds, const bf16x8 (&qr)[4],
                                           f32x16 (&o)[2], float& mref, float& l, const TF& tf, int wave_last_row) {
    const int tid = fresh_tid(), lane = tid & 63, r32 = lane & 31, hi = lane >> 5, wid = tid >> 6;
    const StageGeo sg = stage_geo(tid);
    LAS float* wsf = (LAS float*)(lds + L_WSF) + wid * 64;
    const LAS unsigned char* vp0 = lds + L_SLOT + 8192 + ((lane >> 4) & 1) * 32 + (lane & 3) * 8 + (4 * hi + ((lane & 15) >> 2)) * 64;
    int kt = 31 - __clz((int)tmask); tmask &= ~(1u << kt);
    int kt1 = tmask ? 31 - __clz((int)tmask) : -1; if (kt1 >= 0) tmask &= ~(1u << kt1);
    { const u32x4 k0 = *(const u32x4*)(Kg + (size_t)(kt * 64 + sg.krow) * pitchK + sg.kcol), v0 = *(const u32x4*)(Vg + (size_t)(kt * 64 + sg.vrow) * pitchV + sg.vcol);
      *(LAS u32x4*)(lds + L_SLOT + sg.koff) = k0; *(LAS u32x4*)(lds + L_SLOT + sg.voff) = v0;
      if (kt1 >= 0) { const u32x4 k1 = *(const u32x4*)(Kg + (size_t)(kt1 * 64 + sg.krow) * pitchK + sg.kcol); *(LAS u32x4*)(lds + L_SLOT + 16384 + sg.koff) = k1; } }
    __syncthreads();
    f32x16 sa0, sa1, sb0, sb1;
    bool first = true, act_cur = kt * 64 <= wave_last_row;
    mref = 0.f; l = 0.f;
    if (act_cur) { f32x16 c0, c1; tf.cinit(kt, 0.f, c0, c1); qkt_c(sa0, sa1, lds + L_SLOT, qr, c0, c1, r32, hi); }
    for (;;) {
        if (attn_step(sa0, sa1, sb0, sb1, kt, kt1, tmask, 0, first, act_cur, mref, l, o, qr, Kg, pitchK, Vg, pitchV, lds, sg, wsf, vp0, tf, wave_last_row, r32, hi)) break;
        if (attn_step(sb0, sb1, sa0, sa1, kt, kt1, tmask, 1, first, act_cur, mref, l, o, qr, Kg, pitchK, Vg, pitchV, lds, sg, wsf, vp0, tf, wave_last_row, r32, hi)) break;
    }
}
struct TfFox { const LAS float* cb; int qpos, hi, q0w;
    __device__ __forceinline__ void cinit(int kt, float mref, f32x16& c0, f32x16& c1) const {
#pragma unroll
        for (int i = 0; i < 4; ++i) { const f32x4 a = *(const LAS f32x4*)(cb + kt * 64 + 8 * i + 4 * hi), b = *(const LAS f32x4*)(cb + kt * 64 + 32 + 8 * i + 4 * hi);
#pragma unroll
            for (int j = 0; j < 4; ++j) { c0[4 * i + j] = a[j] - mref; c1[4 * i + j] = b[j] - mref; } } }
    __device__ __forceinline__ void post(int kt, f32x16& p0, f32x16& p1) const {
        if (kt * 64 + 63 > q0w) {
#pragma unroll
            for (int r = 0; r < 16; ++r) { const int kv = kt * 64 + crow(r, hi); if (kv > qpos) p0[r] = NEG; if (kv + 32 > qpos) p1[r] = NEG; } } } };
struct TfT5 { const LAS float* tb; int qpos, hi, q0w, window; unsigned mask; bool use_mask;
    __device__ __forceinline__ void cinit(int kt, float mref, f32x16& c0, f32x16& c1) const {
        if (q0w - (kt * 64 + 63) >= 113) { const float c = tb[127] - mref;
#pragma unroll
            for (int r = 0; r < 16; ++r) { c0[r] = c; c1[r] = c; } }
        else {
#pragma unroll
            for (int r = 0; r < 16; ++r) { const int d0 = qpos - kt * 64 - crow(r, hi); c0[r] = tb[min(max(d0, 0), 127)] - mref; c1[r] = tb[min(max(d0 - 32, 0), 127)] - mref; } } }
    __device__ __forceinline__ void post(int kt, f32x16& p0, f32x16& p1) const {
        if (q0w - (kt * 64 + 63) < 0 || q0w + 31 - kt * 64 >= window) {
#pragma unroll
            for (int r = 0; r < 16; ++r) { const int d0 = qpos - kt * 64 - crow(r, hi), d1 = d0 - 32; if (d0 < 0 || d0 >= window) p0[r] = NEG; if (d1 < 0 || d1 >= window) p1[r] = NEG; } }
        if (use_mask) { const bool en = ((mask >> kt) & 1u) != 0u;
            if (!__all(en)) {
#pragma unroll
                for (int r = 0; r < 16; ++r) { p0[r] = en ? p0[r] : NEG; p1[r] = en ? p1[r] : NEG; } } } } };
}
#ifndef STAGE_LIMIT
#define STAGE_LIMIT 4
#endif
constexpr size_t MiB = 1u << 20;
constexpr size_t WS_CTL = 0, CTL_ZERO_BYTES = 2 * MiB;
constexpr size_t WS_SS = 256 * 1024;
constexpr size_t WS_SSM = 640 * 1024;
constexpr size_t WS_F32S = 2 * MiB;
constexpr size_t WS_CUM = 4 * MiB;
constexpr size_t WS_MASK = 4 * MiB + 512 * 1024;
constexpr size_t WS_UMASK = WS_MASK + 128 * 1024;
constexpr size_t WS_KC = 5 * MiB, WS_VC = 5 * MiB + 256 * 1024;
constexpr size_t WS_POSC = 704 * 1024;
constexpr size_t WS_WGU1 = 8 * MiB, WS_WD1 = 19 * MiB, WS_WIN = 25 * MiB, WS_WUPN = 35 * MiB, WS_WUPF = 36 * MiB, WS_WOUT = 37 * MiB, WS_WMQ = 39 * MiB,
                 WS_WMKV = 41 * MiB, WS_WMO = 45 * MiB, WS_WGU2 = 47 * MiB, WS_WD2 = 58 * MiB, WS_CW1K = 64 * MiB, WS_CW1V = 65 * MiB, WS_CW2K = 66 * MiB, WS_CW2V = 66 * MiB + 256 * 1024;
constexpr size_t WS_KM = 8 * MiB, WS_VT = 12 * MiB;
constexpr size_t WS_XB = 68 * MiB;
constexpr size_t WS_QN = 100 * MiB, WS_KVN = 116 * MiB, WS_QF = 140 * MiB, WS_KVF = 156 * MiB, WS_GAB = 188 * MiB;
constexpr size_t WS_H = 100 * MiB;
constexpr size_t WS_Y = WS_KVF;
constexpr size_t WS_QM = 108 * MiB, WS_PM = 188 * MiB, WS_OM = 140 * MiB;
constexpr size_t WS_MEMB = 252 * MiB, WS_END = 256 * MiB;
static_assert(WS_WD2 + (size_t)DM * FF * 2 <= WS_CW1K && WS_GAB + (size_t)M * 2048 * 2 <= WS_MEMB && WS_H + (size_t)M * FF * 2 <= WS_GAB, "ws map");
constexpr int CW_BAR = 4096;
constexpr int RING_BYTES = 131072, LDS_BYTES = 147456;

__device__ const unsigned char T5B[128] = {0, 1, 2, 3, 4, 5, 6, 7, 8, 9, 10, 11, 12, 13, 14, 15, 16, 16, 16, 17, 17, 18, 18, 18, 19, 19, 19, 20, 20, 20, 20, 21, 21, 21, 21, 22, 22, 22, 22, 22, 23, 23, 23, 23, 23, 23, 24, 24, 24, 24, 24, 24, 25, 25, 25, 25, 25, 25, 25, 26, 26, 26, 26, 26, 26, 26, 26, 27, 27, 27, 27, 27, 27, 27, 27, 27, 27, 28, 28, 28, 28, 28, 28, 28, 28, 28, 28, 29, 29, 29, 29, 29, 29, 29, 29, 29, 29, 29, 29, 30, 30, 30, 30, 30, 30, 30, 30, 30, 30, 30, 30, 30, 30, 31, 31, 31, 31, 31, 31, 31, 31, 31, 31, 31, 31, 31, 31, 31};


#define XB_TMO      128
#define XB_XCNT(j)  (256  + 64 * (j))
#define XB_XSUB(j)  (1280 + 64 * (j))
#define XB_XGEN(j)  (2304 + 64 * (j))
#define XB_TOP      3328
#define XB_TOPGEN   3392
#define XCD_BAR_WORDS 3456
#define XB_SPIN_CAP (1u << 18)
__device__ __forceinline__ unsigned xb_ld(unsigned* p)              { return __hip_atomic_load(p, __ATOMIC_RELAXED, __HIP_MEMORY_SCOPE_AGENT); }
__device__ __forceinline__ unsigned xb_add(unsigned* p, unsigned v) { return __hip_atomic_fetch_add(p, v, __ATOMIC_RELAXED, __HIP_MEMORY_SCOPE_AGENT); }
__device__ __forceinline__ unsigned xb_xcc_id() { return (unsigned)__builtin_amdgcn_s_getreg((3 << 11) | 20) & 0xFu; }
#define XB_SPIN(cond, bar) do { unsigned _sp = 0; while (cond) { __builtin_amdgcn_s_sleep(1); \
    if ((++_sp & 255u) == 0u) { if (xb_ld(&(bar)[XB_TMO])) break; if (_sp > XB_SPIN_CAP) { atomicAdd(&(bar)[XB_TMO], 1u); break; } } } } while (0)
struct XcdBarrier { unsigned* bar; unsigned x; volatile LAS unsigned* st; };
__device__ __forceinline__ XcdBarrier xcd_barrier_post(unsigned* bar, volatile LAS unsigned* st) {
    XcdBarrier b; b.bar = bar; b.x = xb_xcc_id(); b.st = st;
    if (threadIdx.x == 0) (void)xb_add(&bar[XB_XCNT(b.x)], 1u);
    return b;
}
__device__ __forceinline__ void xcd_barrier_complete(unsigned* bar, unsigned x, unsigned& nloc, unsigned& nx) {
    const unsigned G = gridDim.x * gridDim.y * gridDim.z;
    unsigned sum, cnt, mine, sp = 0u;
    for (;;) {
        sum = 0u; cnt = 0u; mine = 0u;
#pragma unroll
        for (unsigned j = 0; j < 16; ++j) { const unsigned c = xb_ld(&bar[XB_XCNT(j)]); sum += c; cnt += (c > 0u) ? 1u : 0u; mine = (j == x) ? c : mine; }
        if (sum == G) break;
        __builtin_amdgcn_s_sleep(1);
        if ((++sp & 255u) == 0u) { if (xb_ld(&bar[XB_TMO])) break; if (sp > XB_SPIN_CAP) { atomicAdd(&bar[XB_TMO], 1u); break; } }
    }
    nloc = mine > 0u ? mine : 1u; nx = cnt > 0u ? cnt : 1u;
}
__device__ __forceinline__ void xcd_barrier(const XcdBarrier& b) {
    asm volatile("s_waitcnt vmcnt(0)" ::: "memory");
    __syncthreads();
    if (threadIdx.x == 0) {
        unsigned* bar = b.bar;
        __builtin_amdgcn_s_waitcnt(0);
        unsigned nloc = b.st[0], nx = b.st[1];
        if (nloc == 0u) { xcd_barrier_complete(bar, b.x, nloc, nx); b.st[0] = nloc; b.st[1] = nx; }
        const unsigned old = xb_add(&bar[XB_XSUB(b.x)], 1u);
        const unsigned gen = old / nloc;
        if (old + 1u == (gen + 1u) * nloc) {
            __builtin_amdgcn_fence(__ATOMIC_RELEASE, "agent");
            asm volatile("s_waitcnt vmcnt(0)" ::: "memory");
            const unsigned og = xb_add(&bar[XB_TOP], 1u);
            const unsigned tg = og / nx;
            if (og + 1u == (tg + 1u) * nx) xb_add(&bar[XB_TOPGEN], 1u);
            else XB_SPIN(xb_ld(&bar[XB_TOPGEN]) == tg, bar);
            __builtin_amdgcn_fence(__ATOMIC_ACQUIRE, "agent");
            xb_add(&bar[XB_XGEN(b.x)], 1u);
            asm volatile("s_waitcnt vmcnt(0)" ::: "memory");
        } else {
            XB_SPIN(xb_ld(&bar[XB_XGEN(b.x)]) == gen, bar);
            __builtin_amdgcn_fence(__ATOMIC_ACQUIRE, "agent");
            asm volatile("s_waitcnt vmcnt(0)" ::: "memory");
        }
    }
    __syncthreads();
}

struct Args { const float* in[29]; float* out; unsigned char* ws; int lo, hi; };
enum { I_X = 0, I_MEM, I_RELB, I_F1N, I_F1G, I_F1U, I_F1D, I_MIXN, I_WIN, I_BF, I_POSK, I_POSV, I_CK1, I_CK2, I_CV1, I_CV2, I_UPN, I_UPF, I_WOUT, I_MQN, I_MKVN, I_MWQ, I_MWKV, I_MWO, I_F2N, I_F2G, I_F2U, I_F2D, I_FINN };

__device__ __forceinline__ float wave_sum(float v) {
#pragma unroll
    for (int o = 1; o < 64; o <<= 1) v += __shfl_xor(v, o);
    return v;
}
template <class CM>
__device__ __forceinline__ void tr_item(const float* W, int ldsrc, int K, bf16_t* WT, int k0, int dstrow0, const float* gain, LAS float* scr, int lane, const CM& cm) {
    const int kr = lane >> 3, c4 = lane & 7; int sc; float scl; cm(dstrow0 + 4 * c4, sc, scl);
    f32x4 v[8]; float gk[8];
#pragma unroll
    for (int i = 0; i < 8; ++i) { const int kk = 8 * i + kr; v[i] = sc >= 0 ? *(const f32x4*)(W + (size_t)(k0 + kk) * ldsrc + sc) : (f32x4){0.f, 0.f, 0.f, 0.f}; gk[i] = gain ? gain[k0 + kk] : 1.f; }
#pragma unroll
    for (int i = 0; i < 8; ++i) { const int kk = 8 * i + kr; const float s = gk[i] * scl; LAS float* p = scr + kk * 33 + 4 * c4; p[0] = v[i][0] * s; p[1] = v[i][1] * s; p[2] = v[i][2] * s; p[3] = v[i][3] * s; }
    asm volatile("s_waitcnt lgkmcnt(0)" ::: "memory");
    const int c = lane & 7;
#pragma unroll
    for (int j = 0; j < 4; ++j) { const int nn = (lane >> 3) + 8 * j; const LAS float* s = scr + (8 * c) * 33 + nn;
        u32x4 o; o.x = cvtpk(s[0 * 33], s[1 * 33]); o.y = cvtpk(s[2 * 33], s[3 * 33]); o.z = cvtpk(s[4 * 33], s[5 * 33]); o.w = cvtpk(s[6 * 33], s[7 * 33]);
        *(u32x4*)(WT + (size_t)(dstrow0 + nn) * K + k0 + 8 * c) = o; }
    asm volatile("s_waitcnt lgkmcnt(0)" ::: "memory");
}
struct CmPlain { int off; float s; __device__ __forceinline__ void operator()(int n, int& sc, float& scl) const { sc = n + off; scl = s; } };
struct CmWin { __device__ __forceinline__ void operator()(int n, int& sc, float& scl) const {
    scl = 1.f;
    if (n < 512) { sc = n; scl = QS64; }
    else if (n < 1280) sc = n;
    else if (n < 1792) { sc = 1304 + (n - 1280); scl = QS64; }
    else if (n < 2816) sc = 1816 + (n - 1792);
    else if (n < 4864) sc = 2848 + (n - 2816);
    else if (n < 4888) sc = 1280 + (n - 4864);
    else if (n < 4896) sc = 2840 + (n - 4888);
    else sc = -1; } };
constexpr int N_GU = 16 * 176, N_D = 44 * 32, N_WIN = 16 * 160, N_UP = 8 * 32, N_SQ = 16 * 32, N_MKV = 16 * 64, N_C1 = 32 * 8, N_C2 = 4 * 2;
constexpr int CONV_NA = N_GU + N_D + N_WIN + N_MKV + 2 * N_C1 + 2 * N_C2, CONV_NB = N_GU + N_D + 2 * N_UP + 3 * N_SQ;
__device__ __forceinline__ void conv_item(const Args& a, int it, LAS float* scr, int lane) {
    unsigned char* ws = a.ws; int r = it;
    const int f = r >= CONV_NA; if (f) r -= CONV_NA;
    if (r < N_GU) { const int kb = r / 176, gi = r % 176, dr = gi * 32, tile = dr >> 8, within = dr & 255;
        const float* W = a.in[within < 128 ? (f ? I_F2G : I_F1G) : (f ? I_F2U : I_F1U)];
        tr_item(W, FF, DM, (bf16_t*)(ws + (f ? WS_WGU2 : WS_WGU1)), kb * 64, dr, a.in[f ? I_F2N : I_F1N], scr, lane, CmPlain{tile * 128 + (within & 127) - dr, 1.f}); return; }
    r -= N_GU;
    if (r < N_D) { const int kb = r / 32, gi = r % 32; tr_item(a.in[f ? I_F2D : I_F1D], DM, FF, (bf16_t*)(ws + (f ? WS_WD2 : WS_WD1)), kb * 64, gi * 32, nullptr, scr, lane, CmPlain{0, 1.f}); return; }
    r -= N_D;
    if (!f) {
        if (r < N_WIN) { const int kb = r / 160, gi = r % 160; tr_item(a.in[I_WIN], 4896, DM, (bf16_t*)(ws + WS_WIN), kb * 64, gi * 32, a.in[I_MIXN], scr, lane, CmWin{}); return; }
        r -= N_WIN;
        if (r < N_MKV) { const int kb = r / 64, gi = r % 64; tr_item(a.in[I_MWKV], 2048, DM, (bf16_t*)(ws + WS_WMKV), kb * 64, gi * 32, a.in[I_MKVN], scr, lane, CmPlain{0, 1.f}); return; }
        r -= N_MKV;
        if (r < 2 * N_C1) { const int g = r >= N_C1; r -= g * N_C1; const int kb = r / 8, gi = r % 8;
            tr_item(a.in[g ? I_CV1 : I_CK1], 256, 2048, (bf16_t*)(ws + (g ? WS_CW1V : WS_CW1K)), kb * 64, gi * 32, nullptr, scr, lane, CmPlain{0, 1.f}); return; }
        r -= 2 * N_C1;
        { const int g = r >= N_C2; r -= g * N_C2; const int kb = r / 2, gi = r % 2;
            tr_item(a.in[g ? I_CV2 : I_CK2], 64, 256, (bf16_t*)(ws + (g ? WS_CW2V : WS_CW2K)), kb * 64, gi * 32, nullptr, scr, lane, CmPlain{0, 1.f}); }
    } else {
        if (r < 2 * N_UP) { const int g = r >= N_UP; r -= g * N_UP; const int kb = r / 32, gi = r % 32;
            tr_item(a.in[g ? I_UPF : I_UPN], DM, 512, (bf16_t*)(ws + (g ? WS_WUPF : WS_WUPN)), kb * 64, gi * 32, nullptr, scr, lane, CmPlain{0, 1.f}); return; }
        r -= 2 * N_UP;
        { const int g = r / N_SQ; r -= g * N_SQ; const int kb = r / 32, gi = r % 32;
            tr_item(a.in[g == 0 ? I_WOUT : (g == 1 ? I_MWQ : I_MWO)], DM, DM, (bf16_t*)(ws + (g == 0 ? WS_WOUT : (g == 1 ? WS_WMQ : WS_WMO))), kb * 64, gi * 32, g == 1 ? a.in[I_MQN] : nullptr, scr, lane,
                    CmPlain{0, g == 1 ? QS256 : 1.f}); }
    }
}

__device__ __forceinline__ void p0_prologue(const Args& a, LAS unsigned char* lds, int gw, int NGW, int wave, int lane) {
    unsigned char* ws = a.ws;
    LAS float* scr = (LAS float*)(lds + wave * 16384);
    for (int it = gw; it < CONV_NA; it += NGW) conv_item(a, it, scr, lane);
    for (int mrow = gw; mrow < M + MROWS; mrow += NGW) {
        const bool ismem = mrow >= M; const int rr = ismem ? mrow - M : mrow;
        const f32x4* xr = (const f32x4*)((ismem ? a.in[I_MEM] : a.in[I_X]) + (size_t)rr * DM) + lane;
        unsigned long long* o8 = (unsigned long long*)((bf16_t*)(ws + (ismem ? WS_MEMB : WS_XB)) + (size_t)rr * DM) + lane;
        float s = 0.f; f32x4 v[4];
#pragma unroll
        for (int j = 0; j < 4; ++j) v[j] = xr[64 * j];
#pragma unroll
        for (int j = 0; j < 4; ++j) { s += (v[j][0] * v[j][0] + v[j][1] * v[j][1]) + (v[j][2] * v[j][2] + v[j][3] * v[j][3]);
            o8[64 * j] = (unsigned long long)cvtpk(v[j][0], v[j][1]) | ((unsigned long long)cvtpk(v[j][2], v[j][3]) << 32); }
        s = wave_sum(s);
        if (lane == 0) ((float*)(ws + (ismem ? WS_SSM : WS_SS)))[rr] = s;
    }
    for (int t = gw; t < 64; t += NGW) { const int kv = t >> 5, kc = (t & 31) * 64; const float* pos = a.in[kv ? I_POSV : I_POSK] + kc; const f32x4* w1 = (const f32x4*)(a.in[kv ? I_CV1 : I_CK1] + (size_t)kc * 256) + lane;
        f32x4 s = {0.f, 0.f, 0.f, 0.f};
#pragma unroll 8
        for (int k = 0; k < 64; ++k) s += w1[(size_t)k * 64] * pos[k];
        float* o = (float*)(ws + WS_POSC) + kv * 256 + 4 * lane;
        unsafeAtomicAdd(o, s[0]); unsafeAtomicAdd(o + 1, s[1]); unsafeAtomicAdd(o + 2, s[2]); unsafeAtomicAdd(o + 3, s[3]); }
}

__device__ __forceinline__ void compress_unit(const Args& a, LAS unsigned char* lds, int uidx) {
    unsigned char* ws = a.ws;
    const int tid = fresh_tid(), lane = tid & 63, r32 = lane & 31, hi = lane >> 5, wid = __builtin_amdgcn_readfirstlane(tid >> 6);
    const int kv = uidx >> 6, b = (uidx >> 3) & 7, g = (uidx >> 2) & 1, chunk = uidx & 3, n0 = chunk * 32;
    const bf16_t* W1 = (const bf16_t*)(ws + (kv ? WS_CW1V : WS_CW1K)); const bf16_t* W2 = (const bf16_t*)(ws + (kv ? WS_CW2V : WS_CW2K));
    const float* posc = (const float*)(ws + WS_POSC) + kv * 256;
    const bf16_t* asrc = (const bf16_t*)(ws + WS_KVN) + (size_t)(b * SEQ) * 768 + kv * 128 + g * 64;
    LAS bf16_t* As = (LAS bf16_t*)lds;
    for (int i = tid; i < 528 * 8; i += 512) { const int row = i >> 3, ch = i & 7; const int t = min(16 * n0 + row, SEQ - 1);
        *(LAS u32x4*)(As + row * 64 + ((ch ^ ((row >> 4) & 7)) * 8)) = *(const u32x4*)(asrc + (size_t)t * 768 + ch * 8); }
    __syncthreads();
    const bf16_t* brow = W1 + (size_t)(32 * wid + r32) * 2048 + hi * 8;
    f32x16 acc = f32x16{};
#pragma unroll 16
    for (int kk = 0; kk < 128; ++kk) { const int l = kk >> 2, dch = (kk & 3) * 2 + hi, row = 16 * r32 + l;
        const bf16x8 av = *(const LAS bf16x8*)(As + row * 64 + ((dch ^ ((row >> 4) & 7)) * 8)); const bf16x8 bv = *(const bf16x8*)(brow + kk * 16);
        acc = __builtin_amdgcn_mfma_f32_32x32x16_bf16(av, bv, acc, 0, 0, 0); }
    LAS bf16_t* Hs = (LAS bf16_t*)(lds + 81920);
    const float pc = posc[32 * wid + r32];
#pragma unroll
    for (int r = 0; r < 16; ++r) { const float x = acc[r] + pc; const float u = 0.7978845608028654f * (x + 0.044715f * x * x * x);
        const float ge = x * frcp(1.0f + fexp2(-2.0f * LOG2E * u)); Hs[att::crow(r, hi) * 264 + 32 * wid + r32] = (bf16_t)(cvtpk(ge, 0.f) & 0xffffu); }
    __syncthreads();
    if (wid < 2) { f32x16 acc2 = f32x16{};
#pragma unroll
        for (int kk = 0; kk < 16; ++kk) { const bf16x8 av = *(const LAS bf16x8*)(Hs + r32 * 264 + kk * 16 + hi * 8); const bf16x8 bv = *(const bf16x8*)(W2 + (size_t)(32 * wid + r32) * 256 + kk * 16 + hi * 8);
            acc2 = __builtin_amdgcn_mfma_f32_32x32x16_bf16(av, bv, acc2, 0, 0, 0); }
        bf16_t* outp = (bf16_t*)(ws + (kv ? WS_VC : WS_KC)) + (size_t)((b * 2 + g) * 128) * 64;
#pragma unroll
        for (int r = 0; r < 16; ++r) { const int n = n0 + att::crow(r, hi); const float v = n < 127 ? acc2[r] : 0.f; outp[(size_t)n * 64 + 32 * wid + r32] = (bf16_t)(cvtpk(v, 0.f) & 0xffffu); } }
    __syncthreads();
}
__device__ __forceinline__ void cumsum_task(const Args& a, int task, int lane) {
    const int b = task >> 3, h = task & 7; const float bf = a.in[I_BF][h];
    const float* fl = (const float*)(a.ws + WS_F32S) + (size_t)(b * SEQ) * 32 + 24 + h; float* out = (float*)(a.ws + WS_CUM) + (size_t)task * SEQ;
    float tot = 0.f;
    for (int i = 0; i < 32; ++i) { const float v = fl[(size_t)(32 * lane + i) * 32] + bf; tot += fminf(v, 0.f) - log1pf(expf(-fabsf(v))); }
    float inc = tot;
#pragma unroll
    for (int o = 1; o < 64; o <<= 1) { const float t = __shfl_up(inc, o); if (lane >= o) inc += t; }
    float run = inc - tot;
    for (int i = 0; i < 32; ++i) { const float v = fl[(size_t)(32 * lane + i) * 32] + bf; run += fminf(v, 0.f) - log1pf(expf(-fabsf(v))); out[32 * lane + i] = -run * LOG2E; }
}

__device__ __forceinline__ void init_t5_table(const Args& a, LAS unsigned char* lds) {
    LAS float* T = (LAS float*)(lds + att::L_TBL);
    for (int i = fresh_tid(); i < 1024; i += 512) { const int h = i >> 7, d = i & 127; T[i] = a.in[I_RELB][T5B[d] * 8 + h] * LOG2E; }
}
template <bool DRY> __device__ __forceinline__ void fox_unit(const Args& a, LAS unsigned char* lds, int b, int h, int qb) {
    using namespace att;
    unsigned char* ws = a.ws;
    const int tid = fresh_tid(), lane = tid & 63, r32 = lane & 31, hi = lane >> 5, wid = __builtin_amdgcn_readfirstlane(tid >> 6);
    const int q0 = qb * 256, q0w = q0 + wid * 32, qpos = q0w + r32;
    LAS float* cb = (LAS float*)(lds + L_CB); LAS float* wsf = (LAS float*)(lds + L_WSF) + wid * 64;
    const float* cum = (const float*)(ws + WS_CUM) + (size_t)(b * 8 + h) * SEQ;
    for (int i = tid; i < q0 + 256; i += 512) cb[i] = cum[i];
    bf16_t* Qw = (bf16_t*)(ws + WS_QF) + (size_t)(b * SEQ + q0w) * 512 + h * 64;
    bf16x8 qr[4]; load_q(qr, Qw, 512, r32, hi);
    f32x16 o[2]; o[0] = f32x16{}; o[1] = f32x16{}; float m = 0.f, l = 0.f;
    const int nt = 4 * qb + 4; const unsigned tmask = nt >= 32 ? 0xffffffffu : ((1u << nt) - 1u);
    const bf16_t* Kg = (const bf16_t*)(ws + WS_KVF) + (size_t)(b * SEQ) * 1024 + h * 64;
    attn_loop2(tmask, Kg, 1024, Kg + 512, 1024, lds, qr, o, m, l, TfFox{cb, qpos, hi, q0w}, q0w + 31);
    l = halfsum(l);
    scale_rows(o, wsf, 1.0f / l, r32, hi);
    store_o<false>(o, lds, DRY ? (bf16_t*)(ws + WS_XB + 16 * MiB) + (size_t)(b * SEQ + q0w) * 512 + h * 64 : Qw, 512, nullptr, 0);
}
template <int PARTS> __device__ __forceinline__ void cmpwin_unit(const Args& a, LAS unsigned char* lds, int b, int g, int qb) {
    using namespace att;
    unsigned char* ws = a.ws;
    const int tid = fresh_tid(), lane = tid & 63, r32 = lane & 31, hi = lane >> 5, wid = __builtin_amdgcn_readfirstlane(tid >> 6);
    const int j = wid >> 1, sub = wid & 1, hg = g * 4 + j, q0w = qb * 64 + sub * 32, qpos = q0w + r32; const size_t qrow = (size_t)b * SEQ + qpos;
    const LAS float* tb = (const LAS float*)(lds + L_TBL) + hg * 128;
    LAS float* wsf = (LAS float*)(lds + L_WSF) + wid * 64; LAS float* PS = (LAS float*)(lds + L_PS); LAS float* IMP = (LAS float*)(lds + L_IMP); LAS unsigned* MW = (LAS unsigned*)(lds + L_MISC);
    const float* gates = (const float*)(ws + WS_F32S) + qrow * 32;
    if (tid == 0) MW[0] = 0u;
    bf16x8 qr[4]; load_q(qr, (const bf16_t*)(ws + WS_QN) + (size_t)(b * SEQ + q0w) * 512 + hg * 64, 512, r32, hi);
    const StageGeo sg = stage_geo(tid);
    { const bf16_t* Kc = (const bf16_t*)(ws + WS_KC) + (size_t)((b * 2 + g) * 128) * 64; const bf16_t* Vc = (const bf16_t*)(ws + WS_VC) + (size_t)((b * 2 + g) * 128) * 64;
#pragma unroll
        for (int t = 0; t < 2; ++t) { *(LAS u32x4*)(lds + L_SLOT + t * 16384 + sg.koff) = *(const u32x4*)(Kc + (size_t)(t * 64 + sg.krow) * 64 + sg.kcol);
            *(LAS u32x4*)(lds + L_SLOT + t * 16384 + sg.voff) = *(const u32x4*)(Vc + (size_t)(t * 64 + sg.vrow) * 64 + sg.vcol); } }
    __syncthreads();
    if (PARTS & 1) {
        f32x16 oc[2]; oc[0] = f32x16{}; oc[1] = f32x16{};
        f32x16 a0, a1, b0, b1; qkt(a0, a1, lds + L_SLOT, qr, r32, hi); qkt(b0, b1, lds + L_SLOT + 16384, qr, r32, hi);
        float mx = NEG;
#pragma unroll
        for (int r = 0; r < 16; ++r) { const int d = qpos - 16 * crow(r, hi) - 31;
            a0[r] = d >= 0 ? a0[r] + tb[min(d, 127)] : NEG; a1[r] = d - 512 >= 0 ? a1[r] + tb[min(d - 512, 127)] : NEG;
            b0[r] = d - 1024 >= 0 ? b0[r] + tb[min(d - 1024, 127)] : NEG; b1[r] = d - 1536 >= 0 ? b1[r] + tb[min(d - 1536, 127)] : NEG;
            mx = fmaxf(fmaxf(mx, fmaxf(a0[r], a1[r])), fmaxf(b0[r], b1[r])); }
        { auto rr = __builtin_amdgcn_permlane32_swap(__float_as_uint(mx), __float_as_uint(mx), false, false); mx = fmaxf(__uint_as_float(rr[0]), __uint_as_float(rr[1])); }
        const float mxs = mx == NEG ? 0.f : mx; float s = 0.f;
#pragma unroll
        for (int r = 0; r < 16; ++r) { a0[r] = fexp2(a0[r] - mxs); a1[r] = fexp2(a1[r] - mxs); b0[r] = fexp2(b0[r] - mxs); b1[r] = fexp2(b1[r] - mxs); s += (a0[r] + a1[r]) + (b0[r] + b1[r]); }
        s = halfsum(s); const float inv = s > 0.f ? 1.0f / s : 0.f;
#pragma unroll
        for (int r = 0; r < 16; ++r) { a0[r] *= inv; a1[r] *= inv; b0[r] *= inv; b1[r] *= inv; }
        {
            float own[4][4], x3[4][4], rcv[4][4];
#pragma unroll
            for (int i = 0; i < 4; ++i) {
                own[0][i] = 2.0f * (a0[4 * i] + a0[4 * i + 1] + a0[4 * i + 2]) + a0[4 * i + 3]; x3[0][i] = a0[4 * i + 3];
                own[1][i] = 2.0f * (a1[4 * i] + a1[4 * i + 1] + a1[4 * i + 2]) + a1[4 * i + 3]; x3[1][i] = a1[4 * i + 3];
                own[2][i] = 2.0f * (b0[4 * i] + b0[4 * i + 1] + b0[4 * i + 2]) + b0[4 * i + 3]; x3[2][i] = b0[4 * i + 3];
                own[3][i] = 2.0f * (b1[4 * i] + b1[4 * i + 1] + b1[4 * i + 2]) + b1[4 * i + 3]; x3[3][i] = b1[4 * i + 3]; }
#pragma unroll
            for (int k = 0; k < 4; ++k)
#pragma unroll
                for (int i = 0; i < 4; ++i) { auto rr = __builtin_amdgcn_permlane32_swap(__float_as_uint(x3[k][i]), __float_as_uint(x3[k][i]), false, false); rcv[k][i] = __uint_as_float(hi ? rr[0] : rr[1]); }
            LAS float* imh = PS + j * (64 * 33) + (sub * 32 + r32) * 33 + hi;
#pragma unroll
            for (int k = 0; k < 4; ++k)
#pragma unroll
                for (int i = 0; i < 4; ++i) { const float prev = i > 0 ? rcv[k][i - 1] : (k > 0 ? rcv[k - 1][3] : 0.f);
                    imh[8 * k + 2 * i] = own[k][i] + (hi ? rcv[k][i] : prev); }
        }
        const int vb0 = (int)(unsigned)(size_t)(lds + L_SLOT + 8192) + ((lane >> 4) & 1) * 32 + (lane & 3) * 8 + (4 * hi + ((lane & 15) >> 2)) * 64;
        bf16x8 x0, x1, x2, x3; pack_p(a0, a1, x0, x1, x2, x3); pv(oc, vb0, x0, x1, x2, x3);
        pack_p(b0, b1, x0, x1, x2, x3); pv(oc, vb0 + 16384, x0, x1, x2, x3);
        scale_rows(oc, wsf, sigmoidf_(gates[hg]), r32, hi);
        store_o<false>(oc, lds, (bf16_t*)(ws + WS_XB) + (size_t)(b * SEQ + q0w) * 512 + hg * 64, 512, nullptr, 0);
    }
    __syncthreads();
    if (PARTS & 2) {
        const int q = tid >> 3, jb = (tid & 7) * 4; const LAS float* ps = PS + q * 33; LAS float* im = IMP + q * 33;
#pragma unroll
        for (int jj = 0; jj < 4; ++jj) { const int jx = jb + jj;
            const float v = (ps[jx] + ps[64 * 33 + jx]) + (ps[2 * 64 * 33 + jx] + ps[3 * 64 * 33 + jx]);
            const bool valid = jx <= qb, forced = (jx == 0) || (jx == qb) || (jx == qb - 1);
            im[jx] = valid ? v + (forced ? 1e4f : 0.f) : -1e30f; }
        __syncthreads();
        unsigned bits = 0u;
#pragma unroll
        for (int jj = 0; jj < 4; ++jj) { const int jx = jb + jj; const float v = im[jx]; int cnt = 0;
#pragma unroll
            for (int j2 = 0; j2 < 32; ++j2) { const float v2 = im[j2]; cnt += (v2 > v || (v2 == v && j2 < jx)) ? 1 : 0; }
            if (cnt < 16 && jx <= qb) bits |= 1u << jx; }
        bits |= __shfl_xor(bits, 1); bits |= __shfl_xor(bits, 2); bits |= __shfl_xor(bits, 4);
        if ((tid & 7) == 0) { ((unsigned*)(ws + WS_MASK))[(size_t)(b * 2 + g) * SEQ + qb * 64 + q] = bits; __hip_atomic_fetch_or(MW, bits, __ATOMIC_RELAXED, __HIP_MEMORY_SCOPE_WORKGROUP); }
        __syncthreads();
        if (tid == 0) ((unsigned*)(ws + WS_UMASK))[(b * 2 + g) * 32 + qb] = MW[0];
    }
    if (PARTS & 4) {
    f32x16 o[2]; o[0] = f32x16{}; o[1] = f32x16{}; float m = -1e30f, l = 0.f;
    const int lo = qb > 8 ? qb - 8 : 0; const unsigned tmask = (qb >= 31 ? 0xffffffffu : ((2u << qb) - 1u)) & ~((1u << lo) - 1u);
    const bf16_t* Kg = (const bf16_t*)(ws + WS_KVN) + (size_t)(b * SEQ) * 768 + 512 + g * 64;
    attn_loop2(tmask, Kg, 768, Kg + 128, 768, lds, qr, o, m, l, TfT5{tb, qpos, hi, q0w, 512, 0u, false}, q0w + 31);
    l = halfsum(l);
    scale_rows(o, wsf, sigmoidf_(gates[16 + hg]) / l, r32, hi);
    { bf16_t* ocw = (bf16_t*)(ws + WS_XB) + (size_t)(b * SEQ + q0w) * 512 + hg * 64; store_o<true>(o, lds, ocw, 512, ocw, 512); }
    }
}
template <bool DRY> __device__ __forceinline__ void sel_unit(const Args& a, LAS unsigned char* lds, int b, int g, int qb) {
    using namespace att;
    unsigned char* ws = a.ws;
    const int tid = fresh_tid(), lane = tid & 63, r32 = lane & 31, hi = lane >> 5, wid = __builtin_amdgcn_readfirstlane(tid >> 6);
    const int j = wid >> 1, sub = wid & 1, hg = g * 4 + j, q0w = qb * 64 + sub * 32, qpos = q0w + r32; const size_t qrow = (size_t)b * SEQ + qpos;
    const LAS float* tb = (const LAS float*)(lds + L_TBL) + hg * 128; LAS float* wsf = (LAS float*)(lds + L_WSF) + wid * 64;
    bf16_t* Qw = (bf16_t*)(ws + WS_QN) + (size_t)(b * SEQ + q0w) * 512 + hg * 64;
    bf16x8 qr[4]; load_q(qr, Qw, 512, r32, hi);
    const unsigned mask = ((const unsigned*)(ws + WS_MASK))[(size_t)(b * 2 + g) * SEQ + qpos];
    const unsigned um = ((const unsigned*)(ws + WS_UMASK))[(b * 2 + g) * 32 + qb] & (qb >= 31 ? 0xffffffffu : ((2u << qb) - 1u));
    f32x16 o[2]; o[0] = f32x16{}; o[1] = f32x16{}; float m = -1e30f, l = 0.f;
    const bf16_t* Kg = (const bf16_t*)(ws + WS_KVN) + (size_t)(b * SEQ) * 768 + 256 + g * 64;
    attn_loop2(um, Kg, 768, Kg + 128, 768, lds, qr, o, m, l, TfT5{tb, qpos, hi, q0w, 1 << 30, mask, true}, q0w + 31);
    l = halfsum(l);
    const float g1 = sigmoidf_(((const float*)(ws + WS_F32S))[qrow * 32 + 8 + hg]);
    scale_rows(o, wsf, g1 / l, r32, hi);
    store_o<true>(o, lds, DRY ? (bf16_t*)(ws + WS_XB + 16 * MiB) + (size_t)(b * SEQ + q0w) * 512 + hg * 64 : Qw, 512, (const bf16_t*)(ws + WS_XB) + (size_t)(b * SEQ + q0w) * 512 + hg * 64, 512);
}
#ifndef PHMASK
#define PHMASK 0xffffffffu
#endif
#define PH(n) (((PHMASK) >> (n)) & 1u)
#ifndef DUPMASK
#define DUPMASK 0u
#endif
#define DUP(n) (((DUPMASK) >> (n)) & 1u)
#define REP(n) for (int rep_ = 0; rep_ < 1 + (int)DUP(n); ++rep_)
__global__ void __launch_bounds__(512, 2) hybrid_fwd(Args a) {
    extern __shared__ __attribute__((aligned(16))) unsigned char lds_raw[];
    LAS unsigned char* lds = (LAS unsigned char*)lds_raw;
    cg::grid_group grid = cg::this_grid();
    unsigned char* ws = a.ws;
    const int tid = fresh_tid(), lane = tid & 63, wave = __builtin_amdgcn_readfirstlane(tid >> 6);
    const int G = gridDim.x, bx = blockIdx.x, vcu = (G % 8 == 0) ? (bx % 8) * (G / 8) + bx / 8 : bx;
    const int gw = vcu * 8 + wave, NGW = G * 8;
    float* X = a.out;
    bf16_t* XB = (bf16_t*)(ws + WS_XB);
    float* SS = (float*)(ws + WS_SS);
    { volatile LAS unsigned* st0 = (volatile LAS unsigned*)(lds + RING_BYTES + 320); if (tid < 32) st0[tid] = 0u; }
    __syncthreads();
    XcdBarrier xbar = xcd_barrier_post((unsigned*)(ws + WS_CTL) + CW_BAR, (volatile LAS unsigned*)(lds + RING_BYTES + 320 + 32));
#ifdef USE_CG_SYNC
#define GSYNC() grid.sync()
#else
    if (a.lo == 0x7e57) grid.sync();
#define GSYNC() xcd_barrier(xbar)
#endif
    const float* fin_src = a.in[I_X];

#if STAGE_LIMIT >= 1
    REP(0) p0_prologue(a, lds, gw, NGW, wave, lane);
    GSYNC();
    { pg8::Gemm g{XB, (const bf16_t*)(ws + WS_WGU1), DM, DM, DM, 0, 0, 0, 0}; pg8::Order S; S.init(64, 22, 1, G, bx);
      pg8::EpiGU E{(bf16_t*)(ws + WS_H), SS}; REP(1) pg8::gemm_phase<pg8::EpiGU, true>(lds, g, S, E); }
    GSYNC();
    { pg8::Gemm g{(const bf16_t*)(ws + WS_H), (const bf16_t*)(ws + WS_WD1), FF, FF, FF, 0, 0, 0, 0}; pg8::Order S; S.init(64, 4, 1, G, bx);
      if (DUP(2)) { pg8::EpiNull E0{(float*)(ws + WS_POSC + 4096)}; pg8::gemm_phase<pg8::EpiNull, false>(lds, g, S, E0); }
      pg8::EpiRes<true, true> E{a.in[I_X], X, XB, SS + M, 0.5f}; pg8::gemm_phase<pg8::EpiRes<true, true>, false>(lds, g, S, E); }
    GSYNC();
    fin_src = X;
#endif
#if STAGE_LIMIT >= 2
#if PH(3)
    { pg8::Gemm g{XB, (const bf16_t*)(ws + WS_WIN), DM, DM, DM, 0, 0, 0, 0}; pg8::Order S; S.init(64, 20, 1, G, bx);
      pg8::EpiQKV E{(bf16_t*)(ws + WS_QN), (bf16_t*)(ws + WS_KVN), (bf16_t*)(ws + WS_QF), (bf16_t*)(ws + WS_KVF), (bf16_t*)(ws + WS_GAB), (float*)(ws + WS_F32S), SS + M};
      REP(3) pg8::gemm_phase<pg8::EpiQKV, true>(lds, g, S, E); }
#endif
    GSYNC();
#if PH(4)
    REP(4) if (bx < 128) { compress_unit(a, lds, bx); }
    else if (bx < 192) {
        if (bx < 160) { pg8::Gemm g{(const bf16_t*)(ws + WS_MEMB), (const bf16_t*)(ws + WS_WMKV), DM, DM, DM, 0, 0, 0, 0}; pg8::Order S; S.init(8, 4, 1, 32, bx - 128);
            pg8::EpiRowScale E{(bf16_t*)(ws + WS_KM), DM, (const float*)(ws + WS_SSM)}; pg8::gemm_phase<pg8::EpiRowScale, false>(lds, g, S, E); }
        else { pg8::Gemm g{(const bf16_t*)(ws + WS_WMKV) + (size_t)DM * DM, (const bf16_t*)(ws + WS_MEMB), DM, DM, DM, 0, 0, 0, 0}; pg8::Order S; S.init(4, 8, 1, 32, bx - 160);
            pg8::EpiColScale E{(bf16_t*)(ws + WS_VT), MROWS, (const float*)(ws + WS_SSM)}; pg8::gemm_phase<pg8::EpiColScale, false>(lds, g, S, E); }
    } else { if (wave == 0) cumsum_task(a, bx - 192, lane); }
    if (bx >= 128) { LAS float* scr = (LAS float*)(lds + wave * 16384); for (int it = CONV_NA + (bx - 128) * 8 + wave; it < CONV_NA + CONV_NB; it += 1024) conv_item(a, it, scr, lane); }
#endif
    GSYNC();
#if PH(5)
    init_t5_table(a, lds);
    { const int bh = vcu >> 2, s = vcu & 3; if (DUP(5)) { fox_unit<true>(a, lds, bh >> 3, bh & 7, 7 - s); fox_unit<true>(a, lds, bh >> 3, bh & 7, s); }
      fox_unit<false>(a, lds, bh >> 3, bh & 7, 7 - s); fox_unit<false>(a, lds, bh >> 3, bh & 7, s); }
#ifdef DUPPART
    { const int bg = vcu >> 4, s = vcu & 15; cmpwin_unit<DUPPART>(a, lds, bg >> 1, bg & 1, 31 - s); cmpwin_unit<DUPPART>(a, lds, bg >> 1, bg & 1, s); }
#endif
#ifndef NO_CMPWIN
    REP(15) { const int bg = vcu >> 4, s = vcu & 15; cmpwin_unit<7>(a, lds, bg >> 1, bg & 1, 31 - s); cmpwin_unit<7>(a, lds, bg >> 1, bg & 1, s); }
#endif
#endif
    GSYNC();
#if PH(6)
    { const int bg = vcu >> 4, s = vcu & 15; if (DUP(6)) { sel_unit<true>(a, lds, bg >> 1, bg & 1, 31 - s); sel_unit<true>(a, lds, bg >> 1, bg & 1, s); }
      sel_unit<false>(a, lds, bg >> 1, bg & 1, 31 - s); sel_unit<false>(a, lds, bg >> 1, bg & 1, s); }
#endif
    GSYNC();
#if PH(7)
    REP(7) { pg8::Order S; S.init(64, 4, 1, G, bx);
      { pg8::Gemm g{(const bf16_t*)(ws + WS_QN), (const bf16_t*)(ws + WS_WUPN), 512, 512, 512, 0, 0, 0, 0}; pg8::EpiUp<0> E{(const bf16_t*)(ws + WS_GAB), (bf16_t*)(ws + WS_Y)}; pg8::gemm_phase<pg8::EpiUp<0>, false>(lds, g, S, E); }
      { pg8::Gemm g{(const bf16_t*)(ws + WS_QF), (const bf16_t*)(ws + WS_WUPF), 512, 512, 512, 0, 0, 0, 0}; pg8::EpiUp<1> E{(const bf16_t*)(ws + WS_GAB), (bf16_t*)(ws + WS_Y)}; pg8::gemm_phase<pg8::EpiUp<1>, false>(lds, g, S, E); } }
#endif
    GSYNC();
#if PH(8)
    { pg8::Gemm g{(const bf16_t*)(ws + WS_Y), (const bf16_t*)(ws + WS_WOUT), DM, DM, DM, 0, 0, 0, 0}; pg8::Order S; S.init(64, 4, 1, G, bx);
      if (DUP(8)) { pg8::EpiNull E0{(float*)(ws + WS_POSC + 4096)}; pg8::gemm_phase<pg8::EpiNull, false>(lds, g, S, E0); }
      pg8::EpiRes<true, true> E{X, X, XB, SS + 2 * M, 1.0f}; pg8::gemm_phase<pg8::EpiRes<true, true>, false>(lds, g, S, E); }
#endif
    GSYNC();
#endif
#if STAGE_LIMIT >= 3
    { pg8::Gemm g{XB, (const bf16_t*)(ws + WS_WMQ), DM, DM, DM, 0, 0, 0, 0}; pg8::Order S; S.init(64, 4, 1, G, bx);
      pg8::EpiRowScale E{(bf16_t*)(ws + WS_QM), DM, SS + 2 * M}; REP(9) pg8::gemm_phase<pg8::EpiRowScale, false>(lds, g, S, E); }
    GSYNC();
    { pg8::Gemm g{(const bf16_t*)(ws + WS_QM), (const bf16_t*)(ws + WS_KM), DM, DM, 256, (long)SEQ * DM, 256, (long)MEMLEN * DM, 256}; pg8::Order S; S.init(8, 1, 32, G, bx);
      pg8::EpiSoftmax E{(bf16_t*)(ws + WS_PM)}; REP(10) pg8::gemm_phase<pg8::EpiSoftmax, false>(lds, g, S, E); }
    GSYNC();
    { pg8::Gemm g{(const bf16_t*)(ws + WS_PM), (const bf16_t*)(ws + WS_VT), 256, MROWS, 256, (long)4 * SEQ * 256, (long)SEQ * 256, 256, (long)256 * MROWS}; pg8::Order S; S.init(8, 1, 32, G, bx);
      pg8::EpiBatchBf16 E{(bf16_t*)(ws + WS_OM), DM, (long)SEQ * DM, 256}; REP(11) pg8::gemm_phase<pg8::EpiBatchBf16, false>(lds, g, S, E); }
    GSYNC();
    { pg8::Gemm g{(const bf16_t*)(ws + WS_OM), (const bf16_t*)(ws + WS_WMO), DM, DM, DM, 0, 0, 0, 0}; pg8::Order S; S.init(64, 4, 1, G, bx);
      pg8::EpiRes<true, true> E{X, X, XB, SS + 3 * M, 1.0f}; pg8::gemm_phase<pg8::EpiRes<true, true>, false>(lds, g, S, E); }
    GSYNC();
#endif
#if STAGE_LIMIT >= 4
    { pg8::Gemm g{XB, (const bf16_t*)(ws + WS_WGU2), DM, DM, DM, 0, 0, 0, 0}; pg8::Order S; S.init(64, 22, 1, G, bx);
      pg8::EpiGU E{(bf16_t*)(ws + WS_H), SS + 3 * M}; pg8::gemm_phase<pg8::EpiGU, true>(lds, g, S, E); }
    GSYNC();
    { pg8::Gemm g{(const bf16_t*)(ws + WS_H), (const bf16_t*)(ws + WS_WD2), FF, FF, FF, 0, 0, 0, 0}; pg8::Order S; S.init(64, 4, 1, G, bx);
      pg8::EpiRes<false, false> E{X, X, nullptr, nullptr, 0.5f}; pg8::gemm_phase<pg8::EpiRes<false, false>, false>(lds, g, S, E); }
    GSYNC();
#endif
#ifdef EXTRA_BARS
    for (int eb = 0; eb < EXTRA_BARS; ++eb) GSYNC();
#endif
    { const float* gn = a.in[I_FINN]; const int tid2 = fresh_tid(), lane = tid2 & 63, gw = vcu * 8 + (tid2 >> 6);
      for (int mrow = gw; mrow < M; mrow += NGW) {
          const f32x4* xr = (const f32x4*)(fin_src + (size_t)mrow * DM) + lane; f32x4* orow = (f32x4*)(X + (size_t)mrow * DM) + lane;
          f32x4 v[4]; float s = 0.f;
#pragma unroll
          for (int j = 0; j < 4; ++j) { v[j] = xr[64 * j]; s += (v[j][0] * v[j][0] + v[j][1] * v[j][1]) + (v[j][2] * v[j][2] + v[j][3] * v[j][3]); }
          const float rs = rstd_of(wave_sum(s));
#pragma unroll
          for (int j = 0; j < 4; ++j) orow[64 * j] = v[j] * rs * ((const f32x4*)gn)[lane + 64 * j];
      } }
}

extern "C" void kernel_launch(void* const* d_in, const int* in_sizes, int n_in, void* d_out, int out_size, void* d_ws, size_t ws_size, hipStream_t stream) {
    static int grid = 0;
    if (grid == 0) {
        if (n_in != 29 || out_size != M * DM || ws_size < WS_END) { fprintf(stderr, "kernel_launch: unexpected shapes (n_in %d out %d ws %zu)\n", n_in, out_size, ws_size); grid = -1; return; }
        int dev = 0, cus = 0, per_cu = 0;
        hipGetDevice(&dev); hipDeviceGetAttribute(&cus, hipDeviceAttributeMultiprocessorCount, dev);
        if (hipFuncSetAttribute((const void*)hybrid_fwd, hipFuncAttributeMaxDynamicSharedMemorySize, LDS_BYTES) != hipSuccess) { fprintf(stderr, "kernel_launch: hipFuncSetAttribute failed\n"); grid = -1; return; }
        if (hipOccupancyMaxActiveBlocksPerMultiprocessor(&per_cu, (const void*)hybrid_fwd, 512, LDS_BYTES) != hipSuccess || per_cu < 1) { fprintf(stderr, "kernel_launch: occupancy query failed (%d)\n", per_cu); per_cu = 1; }
        (void)hipGetLastError();
        grid = cus * (per_cu < 1 ? 1 : 1);
        if (grid != 256) fprintf(stderr, "kernel_launch: grid %d != 256: this kernel's phase maps assume 256 workgroups\n", grid);
    }
    if (grid < 0) return;
    hipMemsetAsync((char*)d_ws + WS_CTL, 0, CTL_ZERO_BYTES, stream);
    Args a{};
    for (int i = 0; i < 29; ++i) a.in[i] = (const float*)d_in[i];
    a.out = (float*)d_out; a.ws = (unsigned char*)d_ws; a.lo = 0; a.hi = 0;
    void* args[] = {&a};
    hipError_t e = hipLaunchCooperativeKernel((const void*)hybrid_fwd, dim3(grid), dim3(512), args, LDS_BYTES, stream);
    if (e != hipSuccess) fprintf(stderr, "kernel_launch: cooperative launch failed: %s (grid %d)\n", hipGetErrorString(e), grid);
}
```

```cpp
#define ATT_GRP(w) 0
#include <hip/hip_runtime.h>
#include <hip/hip_cooperative_groups.h>
#include <cstdio>
#include <cstdint>
namespace cg = cooperative_groups;

#define LAS __attribute__((address_space(3)))
typedef unsigned short bf16_t;
typedef short bf16x8 __attribute__((ext_vector_type(8)));
typedef short s16x4 __attribute__((ext_vector_type(4)));
typedef float f32x2 __attribute__((ext_vector_type(2)));
typedef float f32x4 __attribute__((ext_vector_type(4)));
typedef float f32x16 __attribute__((ext_vector_type(16)));
typedef unsigned u32x2 __attribute__((ext_vector_type(2)));
typedef unsigned u32x4 __attribute__((ext_vector_type(4)));
typedef __bf16 bf16x2_t __attribute__((ext_vector_type(2)));

constexpr int NB = 8, SEQ = 2048, DM = 1024, FF = 2816, M = NB * SEQ;
constexpr int MEMLEN = 256, MROWS = NB * MEMLEN;
constexpr float RMS_EPS = 1e-6f;
constexpr float LOG2E = 1.4426950408889634f;
constexpr float QS64 = 0.125f * LOG2E;
constexpr float QS256 = 0.0625f * LOG2E;

__device__ __forceinline__ int fresh_tid() { int t = threadIdx.x; asm volatile("" : "+v"(t)); return t; }
__device__ __forceinline__ unsigned cvtpk(float lo, float hi) { f32x2 v = {lo, hi}; bf16x2_t b = __builtin_convertvector(v, bf16x2_t); return __builtin_bit_cast(unsigned, b); }
__device__ __forceinline__ float bflo(unsigned w) { return __uint_as_float(w << 16); }
__device__ __forceinline__ float bfhi(unsigned w) { return __uint_as_float(w & 0xffff0000u); }
__device__ __forceinline__ u32x4 pack8(f32x4 a, f32x4 b) { u32x4 w; w.x = cvtpk(a[0], a[1]); w.y = cvtpk(a[2], a[3]); w.z = cvtpk(b[0], b[1]); w.w = cvtpk(b[2], b[3]); return w; }
__device__ __forceinline__ float fexp2(float x) { return __builtin_amdgcn_exp2f(x); }
__device__ __forceinline__ float frcp(float x) { return __builtin_amdgcn_rcpf(x); }
__device__ __forceinline__ float sigmoidf_(float x) { return frcp(1.0f + fexp2(-x * LOG2E)); }
__device__ __forceinline__ float rstd_of(float ss) { return __builtin_amdgcn_rsqf(ss * (1.0f / DM) + RMS_EPS); }

namespace pg8 {
constexpr int BM = 256, BK = 64, HALF = 128, HTB = HALF * BK * 2, STAGE_BYTES = 8 * HTB, NXCD = 8, WGM = 8;
__host__ __device__ __forceinline__ int lds_byte(int r, int c) { const int st = (r >> 4) * 2 + (c >> 5), rr = r & 15, cc = c & 31, ob = rr * 64 + cc * 2; return st * 1024 + (ob ^ (((ob >> 9) & 1) << 5)); }
__host__ __device__ __forceinline__ void stage_rc(int b, int& R, int& C) { const int st = b / 1024, sb = b % 1024, swz = sb ^ (((sb >> 9) & 1) << 5); R = (st >> 1) * 16 + swz / 64; C = (st & 1) * 32 + (swz % 64) / 2; }
__host__ __device__ __forceinline__ int perm32(int rho) { const int n = rho >> 4, i = rho & 15; return 8 * (i >> 2) + 4 * n + (i & 3); }

struct Unit { int pm, pn, pb; };
struct Gemm { const bf16_t* A; const bf16_t* Bt; int lda, ldb, K; long sAb, sAh, sBb, sBh; };

struct Order {
    int nM, nN, nwg, G, c;
    __device__ __forceinline__ void init(int nM_, int nN_, int nB_, int G_, int c_) { nM = nM_; nN = nN_; nwg = nM_ * nN_ * nB_; G = G_; c = c_; }
    __device__ __forceinline__ bool next(int i, Unit& u) const {
        if (c < 0) return false;
        const long L = (long)i * G + c; if (L >= nwg) return false;
        int wgid = (int)L; { const int q = nwg / NXCD, r = nwg % NXCD, xcd = wgid % NXCD, off = wgid / NXCD; wgid = (xcd < r ? xcd * (q + 1) : r * (q + 1) + (xcd - r) * q) + off; }
        const int per = nM * nN; u.pb = wgid / per; const int w = wgid % per;
        const int nig = WGM * nN, gid = w / nig, fm = gid * WGM, gsz = (nM - fm) < WGM ? (nM - fm) : WGM;
        u.pm = fm + ((w % nig) % gsz); u.pn = (w % nig) / gsz; return true;
    }
};

typedef f32x4 Acc[2][2][4][2];

template <class Epi, bool ALIGN_EPI>
__device__ __forceinline__ void gemm_phase(LAS unsigned char* lds, const Gemm g, const Order& S, const Epi& E) {
    const int tid = fresh_tid(), wid = __builtin_amdgcn_readfirstlane(tid >> 6), lane = tid & 63, wr = wid >> 2, wc = wid & 3, fr = lane & 15, fq = lane >> 4;
    const int K = g.K, nt = K / BK;
    unsigned voffA[2], voffB[2];
#pragma unroll
    for (int i = 0; i < 2; ++i) { int R, C; stage_rc(tid * 16 + i * 8192, R, C); const int Rb = (R & ~31) + perm32(R & 31);
        voffA[i] = (unsigned)(R * g.lda + C) * 2u; voffB[i] = (unsigned)(Rb * g.ldb + C) * 2u; }
    const size_t kstep = (size_t)(BK * 2);
    const size_t hstepA = (size_t)HALF * g.lda * 2, hstepB = (size_t)HALF * g.ldb * 2;
    const size_t tstepA = 2 * hstepA, tstepB = 2 * hstepB;
    const unsigned ldsw = (unsigned)wid * 1024u;
    const int aoff = lds_byte(wr * 64 + fr, fq * 8), boff = lds_byte(wc * 32 + fr, fq * 8);
#define PG8_SA(b, h) (((b) * 2 + (h)) * HTB)
#define PG8_SB(b, h) ((4 + (b) * 2 + (h)) * HTB)
#define PG8_STAGE(bufoff, gbase, voff) do { _Pragma("unroll") for (int _i = 0; _i < 2; ++_i) \
        __builtin_amdgcn_global_load_lds((const unsigned*)((const char*)(gbase) + (voff)[_i]), (LAS unsigned*)(lds + (bufoff) + ldsw + _i * 8192), 16, 0, 0); } while (0)
#define PG8_LDA(dst, b, h) do { _Pragma("unroll") for (int m = 0; m < 4; ++m) _Pragma("unroll") for (int k = 0; k < 2; ++k) dst[m][k] = *(const LAS bf16x8*)(lds + PG8_SA(b, h) + aoff + m * 2048 + k * 1024); } while (0)
#define PG8_LDB(dst, b, h) do { _Pragma("unroll") for (int n = 0; n < 2; ++n) _Pragma("unroll") for (int k = 0; k < 2; ++k) dst[n][k] = *(const LAS bf16x8*)(lds + PG8_SB(b, h) + boff + n * 2048 + k * 1024); } while (0)
#define PG8_MMA(ai, bj, At, Bt) do { __builtin_amdgcn_s_setprio(1); _Pragma("unroll") for (int m = 0; m < 4; ++m) _Pragma("unroll") for (int n = 0; n < 2; ++n) _Pragma("unroll") for (int k = 0; k < 2; ++k) \
        acc[ai][bj][m][n] = __builtin_amdgcn_mfma_f32_16x16x32_bf16(Bt[n][k], At[m][k], acc[ai][bj][m][n], 0, 0, 0); __builtin_amdgcn_s_setprio(0); } while (0)
#define PG8_WAIT_V(n) asm volatile("s_waitcnt vmcnt(" #n ")" ::: "memory")
#define PG8_WAIT_L(n) asm volatile("s_waitcnt lgkmcnt(" #n ")" ::: "memory")
#define PG8_BAR __builtin_amdgcn_s_barrier()
#define PG8_SCHED __builtin_amdgcn_sched_barrier(0)
#define PG8_OFFA(u) ((size_t)(((u).pb >> 2) * g.sAb + ((u).pb & 3) * g.sAh) * 2 + (size_t)(u).pm * tstepA)
#define PG8_OFFB(u) ((size_t)(((u).pb >> 2) * g.sBb + ((u).pb & 3) * g.sBh) * 2 + (size_t)(u).pn * tstepB)
    Unit cur, nxt; int ui = 0;
    if (!S.next(0, cur)) return;
    Acc acc;
#pragma unroll
    for (int a = 0; a < 2; ++a)
#pragma unroll
        for (int b = 0; b < 2; ++b)
#pragma unroll
            for (int m = 0; m < 4; ++m)
#pragma unroll
                for (int n = 0; n < 2; ++n) acc[a][b][m][n] = (f32x4){0.f, 0.f, 0.f, 0.f};
    bf16x8 At[4][2], B0[2][2], B1[2][2];
    const char* cA = (const char*)g.A + PG8_OFFA(cur); const char* cB = (const char*)g.Bt + PG8_OFFB(cur);
    {
        PG8_STAGE(PG8_SB(0, 0), cB, voffB); PG8_STAGE(PG8_SB(0, 1), cB + hstepB, voffB); PG8_STAGE(PG8_SA(0, 0), cA, voffA); PG8_STAGE(PG8_SA(0, 1), cA + hstepA, voffA);
        if (wr == 1) PG8_BAR;
        PG8_WAIT_V(2); PG8_BAR;
        PG8_STAGE(PG8_SB(1, 0), cB + kstep, voffB); PG8_STAGE(PG8_SA(1, 0), cA + kstep, voffA); PG8_STAGE(PG8_SB(1, 1), cB + hstepB + kstep, voffB);
        PG8_WAIT_V(6); PG8_BAR;
    }
    for (;;) {
        const bool has_next = S.next(ui + 1, nxt);
        const char* nA = has_next ? (const char*)g.A + PG8_OFFA(nxt) : cA; const char* nB = has_next ? (const char*)g.Bt + PG8_OFFB(nxt) : cB;
        for (int t = 0; t < nt; t += 2) {
            const bool last = (t == nt - 2);
            const char* a1 = cA + (size_t)(t + 1) * kstep;
            const char* a2 = last ? nA : cA + (size_t)(t + 2) * kstep; const char* b2 = last ? nB : cB + (size_t)(t + 2) * kstep;
            const char* a3 = a2 + kstep; const char* b3 = b2 + kstep;
            PG8_LDB(B0, 0, 0); PG8_LDB(B1, 0, 1); PG8_SCHED; PG8_LDA(At, 0, 0); PG8_STAGE(PG8_SA(1, 1), a1 + hstepA, voffA);
            PG8_WAIT_V(8); PG8_WAIT_L(0); PG8_BAR; PG8_MMA(0, 0, At, B0); PG8_MMA(0, 1, At, B1); PG8_BAR; PG8_SCHED;
            PG8_LDA(At, 0, 1); PG8_STAGE(PG8_SB(0, 0), b2, voffB); PG8_STAGE(PG8_SB(0, 1), b2 + hstepB, voffB); PG8_STAGE(PG8_SA(0, 0), a2, voffA);
            PG8_WAIT_V(8); PG8_WAIT_L(0); PG8_BAR; PG8_MMA(1, 0, At, B0); PG8_MMA(1, 1, At, B1); PG8_BAR; PG8_SCHED;
            PG8_LDB(B0, 1, 0); PG8_LDB(B1, 1, 1); PG8_SCHED; PG8_LDA(At, 1, 0); PG8_STAGE(PG8_SA(0, 1), a2 + hstepA, voffA);
            PG8_WAIT_V(8); PG8_WAIT_L(0); PG8_BAR; PG8_MMA(0, 0, At, B0); PG8_MMA(0, 1, At, B1); PG8_BAR; PG8_SCHED;
            PG8_LDA(At, 1, 1); PG8_STAGE(PG8_SB(1, 0), b3, voffB); PG8_STAGE(PG8_SB(1, 1), b3 + hstepB, voffB); PG8_STAGE(PG8_SA(1, 0), a3, voffA);
            PG8_WAIT_V(8); PG8_WAIT_L(0); PG8_BAR; PG8_MMA(1, 0, At, B0); PG8_MMA(1, 1, At, B1); PG8_BAR; PG8_SCHED;
        }
        if constexpr (ALIGN_EPI) { if (wr == 0) PG8_BAR; }
        if constexpr (!Epi::AFTER_DRAIN) { E(acc, cur, wr, wc, fr, fq); }
        if (!has_next) break;
#pragma unroll
        for (int a = 0; a < 2; ++a)
#pragma unroll
            for (int b = 0; b < 2; ++b)
#pragma unroll
                for (int m = 0; m < 4; ++m)
#pragma unroll
                    for (int n = 0; n < 2; ++n) acc[a][b][m][n] = (f32x4){0.f, 0.f, 0.f, 0.f};
        cur = nxt; cA = nA; cB = nB; ++ui;
        if constexpr (ALIGN_EPI) { if (wr == 1) PG8_BAR; }
    }
    PG8_WAIT_V(0);
    if constexpr (!ALIGN_EPI) { if (wr == 0) PG8_BAR; }
    PG8_BAR;
    if constexpr (Epi::AFTER_DRAIN) { E.fused(acc, cur, wr, wc, fr, fq, lds, wid, lane); }
#undef PG8_SA
#undef PG8_SB
#undef PG8_STAGE
#undef PG8_LDA
#undef PG8_LDB
#undef PG8_MMA
#undef PG8_WAIT_V
#undef PG8_WAIT_L
#undef PG8_BAR
#undef PG8_SCHED
#undef PG8_OFFA
#undef PG8_OFFB
}

struct EpiNull { static constexpr bool AFTER_DRAIN = false; float* sink; __device__ __forceinline__ void operator()(const Acc& acc, const Unit& u, int wr, int wc, int fr, int fq) const { f32x4 s = {0.f, 0.f, 0.f, 0.f};
_Pragma("unroll") for (int a = 0; a < 2; ++a) _Pragma("unroll") for (int b = 0; b < 2; ++b) _Pragma("unroll") for (int m = 0; m < 4; ++m) _Pragma("unroll") for (int n = 0; n < 2; ++n) s += acc[a][b][m][n];
 if (s[0] + s[1] + s[2] + s[3] == 1234567.25f) sink[0] = 1.f; } };
struct EpiGU {
    static constexpr bool AFTER_DRAIN = false;
    bf16_t* H; const float* ss;
    __device__ __forceinline__ void operator()(const Acc& acc, const Unit& u, int wr, int wc, int fr, int fq) const {
        const int row0 = u.pm * BM + wr * 64 + fr, col0 = u.pn * 128 + wc * 32 + fq * 8;
#pragma unroll
        for (int ai = 0; ai < 2; ++ai)
#pragma unroll
            for (int m = 0; m < 4; ++m) {
                const int row = row0 + ai * HALF + m * 16; const float rs = rstd_of(ss[row]);
                f32x4 h[2];
#pragma unroll
                for (int n = 0; n < 2; ++n) { const f32x4 gg = acc[ai][0][m][n] * rs, uu = acc[ai][1][m][n] * rs;
#pragma unroll
                    for (int j = 0; j < 4; ++j) h[n][j] = gg[j] * sigmoidf_(gg[j]) * uu[j]; }
                *(u32x4*)(H + (size_t)row * FF + col0) = pack8(h[0], h[1]);
            }
    }
};
template <bool WRITE_XB, bool WRITE_SS> struct EpiRes {
    static constexpr bool AFTER_DRAIN = false;
    const float* base; float* out; bf16_t* xb; float* ss; float scale;
    __device__ __forceinline__ void operator()(const Acc& acc, const Unit& u, int wr, int wc, int fr, int fq) const {
        const int row0 = u.pm * BM + wr * 64 + fr, col0 = u.pn * BM + wc * 32 + fq * 8;
#pragma unroll
        for (int ai = 0; ai < 2; ++ai)
#pragma unroll
            for (int m = 0; m < 4; ++m) {
                const int row = row0 + ai * HALF + m * 16; float sq = 0.f;
#pragma unroll
                for (int bj = 0; bj < 2; ++bj) { const size_t p = (size_t)row * DM + col0 + bj * HALF;
                    const f32x4 o0 = *(const f32x4*)(base + p), o1 = *(const f32x4*)(base + p + 4);
                    const f32x4 n0 = o0 + acc[ai][bj][m][0] * scale, n1 = o1 + acc[ai][bj][m][1] * scale;
                    *(f32x4*)(out + p) = n0; *(f32x4*)(out + p + 4) = n1;
                    if (WRITE_XB) *(u32x4*)(xb + p) = pack8(n0, n1);
                    if (WRITE_SS) sq += (n0[0] * n0[0] + n0[1] * n0[1]) + (n0[2] * n0[2] + n0[3] * n0[3]) + (n1[0] * n1[0] + n1[1] * n1[1]) + (n1[2] * n1[2] + n1[3] * n1[3]); }
                if (WRITE_SS) { sq += __shfl_xor(sq, 16); sq += __shfl_xor(sq, 32); if (fq == 0) unsafeAtomicAdd(ss + row, sq); }
                asm volatile("" ::: "memory");
            }
    }
};
struct EpiQKV {
    static constexpr bool AFTER_DRAIN = false;
    bf16_t *QN, *KVN, *QF, *KVF, *GAB; float* F32S; const float* ss;
    __device__ __forceinline__ void operator()(const Acc& acc, const Unit& u, int wr, int wc, int fr, int fq) const {
        const int row0 = u.pm * BM + wr * 64 + fr, pn = u.pn;
        if (pn == 19) {
            if (wc == 0) {
#pragma unroll
                for (int ai = 0; ai < 2; ++ai)
#pragma unroll
                    for (int m = 0; m < 4; ++m) { const int row = row0 + ai * HALF + m * 16; const float rs = rstd_of(ss[row]);
                        *(f32x4*)(F32S + (size_t)row * 32 + fq * 8) = acc[ai][0][m][0] * rs; *(f32x4*)(F32S + (size_t)row * 32 + fq * 8 + 4) = acc[ai][0][m][1] * rs; }
            }
            return;
        }
        bf16_t* dst; int pitch, coff;
        if (pn < 2) { dst = QN; pitch = 512; coff = pn * 256; }
        else if (pn < 5) { dst = KVN; pitch = 768; coff = (pn - 2) * 256; }
        else if (pn < 7) { dst = QF; pitch = 512; coff = (pn - 5) * 256; }
        else if (pn < 11) { dst = KVF; pitch = 1024; coff = (pn - 7) * 256; }
        else { dst = GAB; pitch = 2048; coff = (pn - 11) * 256; }
        coff += wc * 32 + fq * 8;
#pragma unroll
        for (int ai = 0; ai < 2; ++ai)
#pragma unroll
            for (int m = 0; m < 4; ++m) { const int row = row0 + ai * HALF + m * 16; const float rs = rstd_of(ss[row]);
#pragma unroll
                for (int bj = 0; bj < 2; ++bj) *(u32x4*)(dst + (size_t)row * pitch + coff + bj * HALF) = pack8(acc[ai][bj][m][0] * rs, acc[ai][bj][m][1] * rs); }
    }
};
template <int STEP> struct EpiUp {
    static constexpr bool AFTER_DRAIN = false;
    const bf16_t* GAB; bf16_t* Y;
    __device__ __forceinline__ void operator()(const Acc& acc, const Unit& u, int wr, int wc, int fr, int fq) const {
        const int row0 = u.pm * BM + wr * 64 + fr, col0 = u.pn * BM + wc * 32 + fq * 8;
#pragma unroll
        for (int ai = 0; ai < 2; ++ai)
#pragma unroll
            for (int m = 0; m < 4; ++m) { const int row = row0 + ai * HALF + m * 16;
#pragma unroll
                for (int bj = 0; bj < 2; ++bj) { const int c = col0 + bj * HALF;
                    const u32x4 gw = *(const u32x4*)(GAB + (size_t)row * 2048 + STEP * 1024 + c);
                    f32x4 v0, v1; const f32x4 a0 = acc[ai][bj][m][0], a1 = acc[ai][bj][m][1];
                    v0[0] = sigmoidf_(bflo(gw.x)) * a0[0]; v0[1] = sigmoidf_(bfhi(gw.x)) * a0[1]; v0[2] = sigmoidf_(bflo(gw.y)) * a0[2]; v0[3] = sigmoidf_(bfhi(gw.y)) * a0[3];
                    v1[0] = sigmoidf_(bflo(gw.z)) * a1[0]; v1[1] = sigmoidf_(bfhi(gw.z)) * a1[1]; v1[2] = sigmoidf_(bflo(gw.w)) * a1[2]; v1[3] = sigmoidf_(bfhi(gw.w)) * a1[3];
                    bf16_t* yp = Y + (size_t)row * DM + c;
                    if (STEP == 1) { const u32x4 y = *(const u32x4*)yp;
                        v0[0] += bflo(y.x); v0[1] += bfhi(y.x); v0[2] += bflo(y.y); v0[3] += bfhi(y.y); v1[0] += bflo(y.z); v1[1] += bfhi(y.z); v1[2] += bflo(y.w); v1[3] += bfhi(y.w); }
                    *(u32x4*)yp = pack8(v0, v1); }
                asm volatile("" ::: "memory"); }
    }
};
struct EpiRowScale {
    static constexpr bool AFTER_DRAIN = false;
    bf16_t* O; int ldo; const float* ss;
    __device__ __forceinline__ void operator()(const Acc& acc, const Unit& u, int wr, int wc, int fr, int fq) const {
        const int row0 = u.pm * BM + wr * 64 + fr, col0 = u.pn * BM + wc * 32 + fq * 8;
#pragma unroll
        for (int ai = 0; ai < 2; ++ai)
#pragma unroll
            for (int m = 0; m < 4; ++m) { const int row = row0 + ai * HALF + m * 16; const float rs = rstd_of(ss[row]);
#pragma unroll
                for (int bj = 0; bj < 2; ++bj) *(u32x4*)(O + (size_t)row * ldo + col0 + bj * HALF) = pack8(acc[ai][bj][m][0] * rs, acc[ai][bj][m][1] * rs); }
    }
};
struct EpiColScale {
    static constexpr bool AFTER_DRAIN = false;
    bf16_t* O; int ldo; const float* ss;
    __device__ __forceinline__ void operator()(const Acc& acc, const Unit& u, int wr, int wc, int fr, int fq) const {
        const int row0 = u.pm * BM + wr * 64 + fr, col0 = u.pn * BM + wc * 32 + fq * 8;
#pragma unroll
        for (int bj = 0; bj < 2; ++bj) { const int c = col0 + bj * HALF;
            f32x4 s0 = *(const f32x4*)(ss + c), s1 = *(const f32x4*)(ss + c + 4);
#pragma unroll
            for (int j = 0; j < 4; ++j) { s0[j] = rstd_of(s0[j]); s1[j] = rstd_of(s1[j]); }
#pragma unroll
            for (int ai = 0; ai < 2; ++ai)
#pragma unroll
                for (int m = 0; m < 4; ++m) { const int row = row0 + ai * HALF + m * 16;
                    *(u32x4*)(O + (size_t)row * ldo + c) = pack8(acc[ai][bj][m][0] * s0, acc[ai][bj][m][1] * s1); } }
    }
};
struct EpiBatchBf16 {
    static constexpr bool AFTER_DRAIN = false;
    bf16_t* O; int ldo; long sOb, sOh;
    __device__ __forceinline__ void operator()(const Acc& acc, const Unit& u, int wr, int wc, int fr, int fq) const {
        const int row0 = u.pm * BM + wr * 64 + fr, col0 = u.pn * BM + wc * 32 + fq * 8;
        bf16_t* Ob = O + (size_t)((u.pb >> 2) * sOb + (u.pb & 3) * sOh);
#pragma unroll
        for (int ai = 0; ai < 2; ++ai)
#pragma unroll
            for (int m = 0; m < 4; ++m) { const int row = row0 + ai * HALF + m * 16;
#pragma unroll
                for (int bj = 0; bj < 2; ++bj) *(u32x4*)(Ob + (size_t)row * ldo + col0 + bj * HALF) = pack8(acc[ai][bj][m][0], acc[ai][bj][m][1]); }
    }
};
struct EpiSoftmax {
    static constexpr bool AFTER_DRAIN = true;
    bf16_t* P;
    __device__ __forceinline__ void fused(Acc& acc, const Unit& u, int wr, int wc, int fr, int fq, LAS unsigned char* lds, int wid, int lane) const {
        LAS float* Pm = (LAS float*)lds;
        LAS float* Ps = (LAS float*)(lds + 8192);
#pragma unroll
        for (int ai = 0; ai < 2; ++ai)
#pragma unroll
            for (int m = 0; m < 4; ++m) { float mx = -3.0e38f;
#pragma unroll
                for (int bj = 0; bj < 2; ++bj)
#pragma unroll
                    for (int n = 0; n < 2; ++n) { const f32x4 x = acc[ai][bj][m][n]; mx = fmaxf(mx, fmaxf(fmaxf(x[0], x[1]), fmaxf(x[2], x[3]))); }
                mx = fmaxf(mx, __shfl_xor(mx, 16)); mx = fmaxf(mx, __shfl_xor(mx, 32));
                if (fq == 0) Pm[(ai * HALF + wr * 64 + m * 16 + fr) * 4 + wc] = mx; }
        __syncthreads();
#pragma unroll
        for (int ai = 0; ai < 2; ++ai)
#pragma unroll
            for (int m = 0; m < 4; ++m) { const int r = ai * HALF + wr * 64 + m * 16 + fr; const f32x4 t = *(const LAS f32x4*)(Pm + r * 4);
                const float mx = fmaxf(fmaxf(t[0], t[1]), fmaxf(t[2], t[3])); float s = 0.f;
#pragma unroll
                for (int bj = 0; bj < 2; ++bj)
#pragma unroll
                    for (int n = 0; n < 2; ++n) { f32x4 x = acc[ai][bj][m][n];
#pragma unroll
                        for (int j = 0; j < 4; ++j) { x[j] = fexp2(x[j] - mx); s += x[j]; }
                        acc[ai][bj][m][n] = x; }
                s += __shfl_xor(s, 16); s += __shfl_xor(s, 32);
                if (fq == 0) Ps[r * 4 + wc] = s; }
        __syncthreads();
        bf16_t* Pb = P + (size_t)u.pb * SEQ * 256;
        const int col0 = wc * 32 + fq * 8;
#pragma unroll
        for (int ai = 0; ai < 2; ++ai)
#pragma unroll
            for (int m = 0; m < 4; ++m) { const int r = ai * HALF + wr * 64 + m * 16 + fr; const f32x4 t = *(const LAS f32x4*)(Ps + r * 4);
                const float inv = 1.0f / ((t[0] + t[1]) + (t[2] + t[3])); const int row = u.pm * BM + r;
#pragma unroll
                for (int bj = 0; bj < 2; ++bj) *(u32x4*)(Pb + (size_t)row * 256 + col0 + bj * HALF) = pack8(acc[ai][bj][m][0] * inv, acc[ai][bj][m][1] * inv); }
        __syncthreads();
    }
};
}
namespace att {
__device__ __forceinline__ int crow(int r, int hi) { return (r & 3) + 8 * (r >> 2) + 4 * hi; }
#define SBAR() __builtin_amdgcn_sched_barrier(0)
constexpr float NEG = -INFINITY;
constexpr int L_SLOT = 0;
constexpr int L_VR = 24576;
constexpr int L_WSF = 49152;
constexpr int L_OST = L_WSF + 2048;
constexpr int L_TBL = L_OST + 32768;
constexpr int L_CB = L_TBL + 4096;
constexpr int L_PS = L_CB + 8192;
constexpr int L_IMP = L_PS + 4 * 64 * 33 * 4;
constexpr int L_MISC = L_IMP + 64 * 33 * 4;
constexpr int L_END = L_MISC + 64;
static_assert(L_END <= 147456 - 256, "attention LDS map");

__device__ __forceinline__ void qkt(f32x16& p0, f32x16& p1, const LAS unsigned char* Kslot, const bf16x8 (&qr)[4], int r32, int hi) {
    const LAS unsigned char* kb = Kslot + hi * 1024 + r32 * 16;
    p0 = f32x16{}; p1 = f32x16{};
#pragma unroll
    for (int d0 = 0; d0 < 4; ++d0) {
        const bf16x8 b0 = *(const LAS bf16x8*)(kb + d0 * 2048);
        const bf16x8 b1 = *(const LAS bf16x8*)(kb + d0 * 2048 + 512);
        p0 = __builtin_amdgcn_mfma_f32_32x32x16_bf16(b0, qr[d0], p0, 0, 0, 0);
        p1 = __builtin_amdgcn_mfma_f32_32x32x16_bf16(b1, qr[d0], p1, 0, 0, 0);
    }
}
__device__ __forceinline__ void pv(f32x16 (&o)[2], int vb, bf16x8 pa0, bf16x8 pa1, bf16x8 pa2, bf16x8 pa3) {
#pragma unroll
    for (int d0 = 0; d0 < 2; ++d0) { s16x4 lo[4], hi[4];
#pragma unroll
        for (int ks = 0; ks < 4; ++ks) {
            asm volatile("ds_read_b64_tr_b16 %0,%1 offset:%c2" : "=&v"(lo[ks]) : "v"(vb), "i"(d0 * 4096 + ks * 1024) : "memory");
            asm volatile("ds_read_b64_tr_b16 %0,%1 offset:%c2" : "=&v"(hi[ks]) : "v"(vb), "i"(d0 * 4096 + ks * 1024 + 512) : "memory"); }
        asm volatile("s_waitcnt lgkmcnt(0)" ::: "memory"); SBAR();
#define PK(k) (bf16x8){lo[k][0], lo[k][1], lo[k][2], lo[k][3], hi[k][0], hi[k][1], hi[k][2], hi[k][3]}
        o[d0] = __builtin_amdgcn_mfma_f32_32x32x16_bf16(pa0, PK(0), o[d0], 0, 0, 0);
        o[d0] = __builtin_amdgcn_mfma_f32_32x32x16_bf16(pa1, PK(1), o[d0], 0, 0, 0);
        o[d0] = __builtin_amdgcn_mfma_f32_32x32x16_bf16(pa2, PK(2), o[d0], 0, 0, 0);
        o[d0] = __builtin_amdgcn_mfma_f32_32x32x16_bf16(pa3, PK(3), o[d0], 0, 0, 0);
#undef PK
    }
}
__device__ __forceinline__ float rowmax32(const f32x16& p0, const f32x16& p1) {
    float a = fmaxf(p0[0], p1[0]);
#pragma unroll
    for (int r = 1; r < 16; ++r) a = fmaxf(a, fmaxf(p0[r], p1[r]));
    auto rr = __builtin_amdgcn_permlane32_swap(__float_as_uint(a), __float_as_uint(a), false, false);
    return fmaxf(__uint_as_float(rr[0]), __uint_as_float(rr[1]));
}
__device__ __forceinline__ float halfsum(float v) {
    auto rr = __builtin_amdgcn_permlane32_swap(__float_as_uint(v), __float_as_uint(v), false, false);
    return __uint_as_float(rr[0]) + __uint_as_float(rr[1]);
}
#define PKW(P, B) cvtpk(P[B], P[B + 1])
__device__ __forceinline__ void pack_p(const f32x16& p0, const f32x16& p1, bf16x8& a0, bf16x8& a1, bf16x8& a2, bf16x8& a3) {
    const u32x4 w0 = {PKW(p0, 0), PKW(p0, 2), PKW(p0, 4), PKW(p0, 6)}, w1 = {PKW(p0, 8), PKW(p0, 10), PKW(p0, 12), PKW(p0, 14)};
    const u32x4 w2 = {PKW(p1, 0), PKW(p1, 2), PKW(p1, 4), PKW(p1, 6)}, w3 = {PKW(p1, 8), PKW(p1, 10), PKW(p1, 12), PKW(p1, 14)};
    a0 = __builtin_bit_cast(bf16x8, w0); a1 = __builtin_bit_cast(bf16x8, w1); a2 = __builtin_bit_cast(bf16x8, w2); a3 = __builtin_bit_cast(bf16x8, w3);
}
#undef PKW
__device__ __forceinline__ void scale_rows(f32x16 (&o)[2], LAS float* wsf, float v, int r32, int hi) {
    if (hi == 0) wsf[r32] = v;
    asm volatile("s_waitcnt lgkmcnt(0)" ::: "memory");
#pragma unroll
    for (int i = 0; i < 4; ++i) { const f32x4 f = *(const LAS f32x4*)(wsf + 8 * i + 4 * hi);
#pragma unroll
        for (int j = 0; j < 4; ++j) { o[0][4 * i + j] *= f[j]; o[1][4 * i + j] *= f[j]; } }
    asm volatile("s_waitcnt lgkmcnt(0)" ::: "memory");
}
struct StageGeo { int krow, kcol, koff, vrow, vcol, voff; };
__device__ __forceinline__ StageGeo stage_geo(int tid) {
    StageGeo s; const int w = tid >> 6, ln = tid & 63;
    s.krow = ln; s.kcol = w * 8; s.koff = w * 1024 + ln * 16;
    s.vrow = 16 * (w & 3) + (ln >> 2); s.vcol = (w >> 2) * 32 + (ln & 3) * 8; s.voff = 8192 + w * 1024 + ln * 16;
    return s;
}
template <class Mod>
__device__ __forceinline__ void tile_step(const LAS unsigned char* slot, const bf16x8 (&qr)[4], f32x16 (&o)[2], float& m, float& l, LAS float* wsf, const Mod& mod, int r32, int hi, int vb) {
    f32x16 p0, p1;
    qkt(p0, p1, slot, qr, r32, hi);
    mod(p0, p1);
    const float rm = rowmax32(p0, p1);
    const float mn = fmaxf(m, rm);
    const float alpha = fexp2(m - mn);
    const bool need = __any(mn > m);
    m = mn;
    float s = 0.f;
#pragma unroll
    for (int r = 0; r < 16; ++r) { p0[r] = fexp2(p0[r] - mn); p1[r] = fexp2(p1[r] - mn); s += p0[r] + p1[r]; }
    l = l * alpha + s;
    if (need) scale_rows(o, wsf, alpha, r32, hi);
    bf16x8 a0, a1, a2, a3; pack_p(p0, p1, a0, a1, a2, a3);
    pv(o, vb, a0, a1, a2, a3);
}
template <class ModF>
__device__ __forceinline__ void attn_loop(unsigned tmask, const bf16_t* Kg, int pitchK, const bf16_t* Vg, int pitchV, LAS unsigned char* lds, const bf16x8 (&qr)[4],
                                          f32x16 (&o)[2], float& m, float& l, const ModF& modf, int wave_last_row) {
    const int tid = fresh_tid(), lane = tid & 63, r32 = lane & 31, hi = lane >> 5, wid = tid >> 6;
    const StageGeo sg = stage_geo(tid);
    LAS float* wsf = (LAS float*)(lds + L_WSF) + wid * 64;
    const int vb0 = (int)(unsigned)(size_t)(lds + L_SLOT + 8192) + ((lane >> 4) & 1) * 32 + (lane & 3) * 8 + (4 * hi + ((lane & 15) >> 2)) * 64;
    int kt = 31 - __clz((int)tmask);
    u32x4 kreg = *(const u32x4*)(Kg + (size_t)(kt * 64 + sg.krow) * pitchK + sg.kcol);
    u32x4 vreg = *(const u32x4*)(Vg + (size_t)(kt * 64 + sg.vrow) * pitchV + sg.vcol);
    *(LAS u32x4*)(lds + L_SLOT + sg.koff) = kreg; *(LAS u32x4*)(lds + L_SLOT + sg.voff) = vreg;
    __syncthreads();
    int s = 0;
    for (;;) {
        tmask &= ~(1u << kt);
        const int nk = tmask ? 31 - __clz((int)tmask) : -1;
        if (nk >= 0) { kreg = *(const u32x4*)(Kg + (size_t)(nk * 64 + sg.krow) * pitchK + sg.kcol); vreg = *(const u32x4*)(Vg + (size_t)(nk * 64 + sg.vrow) * pitchV + sg.vcol); }
        if (kt * 64 <= wave_last_row) tile_step(lds + L_SLOT + s * 16384, qr, o, m, l, wsf, modf(kt), r32, hi, vb0 + s * 16384);
        if (nk >= 0) { *(LAS u32x4*)(lds + L_SLOT + (s ^ 1) * 16384 + sg.koff) = kreg; *(LAS u32x4*)(lds + L_SLOT + (s ^ 1) * 16384 + sg.voff) = vreg; }
        __syncthreads();
        if (nk < 0) break;
        kt = nk; s ^= 1;
    }
}
template <bool ADD>
__device__ __forceinline__ void store_o(const f32x16 (&o)[2], LAS unsigned char* lds, bf16_t* dst, int pitch, const bf16_t* addsrc, int addpitch) {
    const int tid = fresh_tid(), lane = tid & 63, r32 = lane & 31, hi = lane >> 5, wid = tid >> 6;
    LAS bf16_t* stg = (LAS bf16_t*)(lds + L_OST) + wid * 2048;
#pragma unroll
    for (int r = 0; r < 16; ++r) { const int orow = crow(r, hi);
#pragma unroll
        for (int d0 = 0; d0 < 2; ++d0) stg[orow * 64 + d0 * 32 + r32] = (bf16_t)(cvtpk(o[d0][r], 0.f) & 0xffffu); }
    asm volatile("s_waitcnt lgkmcnt(0)" ::: "memory");
#pragma unroll
    for (int i = 0; i < 4; ++i) { const int row = i * 8 + (lane >> 3), ch = lane & 7;
        u32x4 v = *(const LAS u32x4*)(stg + row * 64 + ch * 8);
        if (ADD) { const u32x4 a = *(const u32x4*)(addsrc + (size_t)row * addpitch + ch * 8);
            v.x = cvtpk(bflo(v.x) + bflo(a.x), bfhi(v.x) + bfhi(a.x)); v.y = cvtpk(bflo(v.y) + bflo(a.y), bfhi(v.y) + bfhi(a.y));
            v.z = cvtpk(bflo(v.z) + bflo(a.z), bfhi(v.z) + bfhi(a.z)); v.w = cvtpk(bflo(v.w) + bflo(a.w), bfhi(v.w) + bfhi(a.w)); }
        *(u32x4*)(dst + (size_t)row * pitch + ch * 8) = v; }
    asm volatile("s_waitcnt lgkmcnt(0)" ::: "memory");
}
__device__ __forceinline__ void load_q(bf16x8 (&qr)[4], const bf16_t* Qw, int pitch, int r32, int hi) {
#pragma unroll
    for (int d0 = 0; d0 < 4; ++d0) qr[d0] = *(const bf16x8*)(Qw + (size_t)r32 * pitch + d0 * 16 + hi * 8);
}

struct ModFox { const LAS float* cb; int kbase, qpos, hi; bool diag;
    __device__ __forceinline__ void operator()(f32x16& p0, f32x16& p1) const {
#pragma unroll
        for (int i = 0; i < 4; ++i) { const f32x4 c0 = *(const LAS f32x4*)(cb + kbase + 8 * i + 4 * hi), c1 = *(const LAS f32x4*)(cb + kbase + 32 + 8 * i + 4 * hi);
#pragma unroll
            for (int j = 0; j < 4; ++j) { p0[4 * i + j] += c0[j]; p1[4 * i + j] += c1[j]; } }
        if (diag) {
#pragma unroll
            for (int r = 0; r < 16; ++r) { const int kv = kbase + crow(r, hi); if (kv > qpos) p0[r] = NEG; if (kv + 32 > qpos) p1[r] = NEG; } }
    } };
struct ModFoxF { const LAS float* cb; int qpos, hi, q0w;
    __device__ __forceinline__ ModFox operator()(int kt) const { return ModFox{cb, kt * 64, qpos, hi, kt * 64 + 63 > q0w}; } };
struct ModT5 { const LAS float* tb; int kbase, qpos, hi, window; bool enabled;
    __device__ __forceinline__ void operator()(f32x16& p0, f32x16& p1) const {
#pragma unroll
        for (int r = 0; r < 16; ++r) { const int d0 = qpos - (kbase + crow(r, hi)), d1 = d0 - 32;
            const float b0 = tb[min(max(d0, 0), 127)], b1 = tb[min(max(d1, 0), 127)];
            p0[r] = (enabled && d0 >= 0 && d0 < window) ? p0[r] + b0 : NEG;
            p1[r] = (enabled && d1 >= 0 && d1 < window) ? p1[r] + b1 : NEG; }
    } };
struct ModWinF { const LAS float* tb; int qpos, hi;
    __device__ __forceinline__ ModT5 operator()(int kt) const { return ModT5{tb, kt * 64, qpos, hi, 512, true}; } };
struct ModSelF { const LAS float* tb; int qpos, hi; unsigned mask;
    __device__ __forceinline__ ModT5 operator()(int kt) const { return ModT5{tb, kt * 64, qpos, hi, 1 << 30, ((mask >> kt) & 1u) != 0u}; } };

typedef short v4i16_t __attribute__((ext_vector_type(4)));
__device__ __forceinline__ s16x4 vtr(const LAS unsigned char* p) { return __builtin_bit_cast(s16x4, __builtin_amdgcn_ds_read_tr16_b64_v4i16((LAS v4i16_t*)p)); }
__device__ __forceinline__ void qkt_c(f32x16& p0, f32x16& p1, const LAS unsigned char* Kslot, const bf16x8 (&qr)[4], const f32x16& c0, const f32x16& c1, int r32, int hi) {
    const LAS unsigned char* kb = Kslot + hi * 1024 + r32 * 16;
    { const bf16x8 b0 = *(const LAS bf16x8*)(kb); const bf16x8 b1 = *(const LAS bf16x8*)(kb + 512);
      p0 = __builtin_amdgcn_mfma_f32_32x32x16_bf16(b0, qr[0], c0, 0, 0, 0); p1 = __builtin_amdgcn_mfma_f32_32x32x16_bf16(b1, qr[0], c1, 0, 0, 0); }
#pragma unroll
    for (int d0 = 1; d0 < 4; ++d0) {
        const bf16x8 b0 = *(const LAS bf16x8*)(kb + d0 * 2048); const bf16x8 b1 = *(const LAS bf16x8*)(kb + d0 * 2048 + 512);
        p0 = __builtin_amdgcn_mfma_f32_32x32x16_bf16(b0, qr[d0], p0, 0, 0, 0); p1 = __builtin_amdgcn_mfma_f32_32x32x16_bf16(b1, qr[d0], p1, 0, 0, 0); }
}
__device__ __forceinline__ void pv2(f32x16 (&o)[2], const LAS unsigned char* vp, bf16x8 pa0, bf16x8 pa1, bf16x8 pa2, bf16x8 pa3) {
#pragma unroll
    for (int d0 = 0; d0 < 2; ++d0) { s16x4 lo[4], hi[4];
#pragma unroll
        for (int ks = 0; ks < 4; ++ks) { lo[ks] = vtr(vp + d0 * 4096 + ks * 1024); hi[ks] = vtr(vp + d0 * 4096 + ks * 1024 + 512); }
#define PK(k) (bf16x8){lo[k][0], lo[k][1], lo[k][2], lo[k][3], hi[k][0], hi[k][1], hi[k][2], hi[k][3]}
        o[d0] = __builtin_amdgcn_mfma_f32_32x32x16_bf16(pa0, PK(0), o[d0], 0, 0, 0);
        o[d0] = __builtin_amdgcn_mfma_f32_32x32x16_bf16(pa1, PK(1), o[d0], 0, 0, 0);
        o[d0] = __builtin_amdgcn_mfma_f32_32x32x16_bf16(pa2, PK(2), o[d0], 0, 0, 0);
        o[d0] = __builtin_amdgcn_mfma_f32_32x32x16_bf16(pa3, PK(3), o[d0], 0, 0, 0);
#undef PK
    }
}
__device__ __forceinline__ float rowmax32b(const f32x16& p0, const f32x16& p1) {
    float a = __builtin_fmaxf(__builtin_fmaxf(p0[0], p0[1]), p1[0]), b = __builtin_fmaxf(__builtin_fmaxf(p0[2], p0[3]), p1[1]); a = __builtin_fmaxf(__builtin_fmaxf(a, p1[2]), p1[3]);
#pragma unroll
    for (int r = 4; r < 16; r += 4) { a = __builtin_fmaxf(__builtin_fmaxf(a, p0[r]), p0[r + 1]); b = __builtin_fmaxf(__builtin_fmaxf(b, p0[r + 2]), p0[r + 3]);
        a = __builtin_fmaxf(__builtin_fmaxf(a, p1[r]), p1[r + 1]); b = __builtin_fmaxf(__builtin_fmaxf(b, p1[r + 2]), p1[r + 3]); }
    const float m = __builtin_fmaxf(a, b);
    auto rr = __builtin_amdgcn_permlane32_swap(__float_as_uint(m), __float_as_uint(m), false, false);
    return __builtin_fmaxf(__uint_as_float(rr[0]), __uint_as_float(rr[1]));
}
constexpr float DEFER_THR = 6.0f;
#ifndef ATT_GRP
#define ATT_GRP(w) ((w) >> 2)
#endif
template <int ABL, class TF>
__device__ __forceinline__ void sm_pv(f32x16& sc0, f32x16& sc1, f32x16& sn0, f32x16& sn1, bool adjust_next, int kt, int par, bool& first, float& mref, float& l, f32x16 (&o)[2],
                                      LAS float* wsf, const LAS unsigned char* vp0, const TF& tf, int r32, int hi) {
    if (ABL & 16) { o[0][1] += sc0[3] + sc1[5]; return; }
    tf.post(kt, sc0, sc1);
    const float rm = rowmax32b(sc0, sc1);
    if (__any(first || rm > DEFER_THR)) {
        const float delta = first ? (rm == NEG ? 0.f : rm) : __builtin_fmaxf(rm, 0.f);
        mref += delta;
#pragma unroll
        for (int r = 0; r < 16; ++r) { sc0[r] -= delta; sc1[r] -= delta; }
        if (adjust_next) {
#pragma unroll
            for (int r = 0; r < 16; ++r) { sn0[r] -= delta; sn1[r] -= delta; } }
        const float f = fexp2(-delta); l *= f;
        if (!first) scale_rows(o, wsf, f, r32, hi);
        first = false;
    }
    float s = 0.f;
#pragma unroll
    for (int r = 0; r < 16; ++r) { if (!(ABL & 1)) { sc0[r] = fexp2(sc0[r]); sc1[r] = fexp2(sc1[r]); } s += sc0[r] + sc1[r]; }
    l += s;
    bf16x8 a0, a1, a2, a3; pack_p(sc0, sc1, a0, a1, a2, a3);
    if (!(ABL & 2)) pv2(o, vp0 + par * 8192, a0, a1, a2, a3); else { o[0][0] += __builtin_bit_cast(f32x4, a0)[0] + __builtin_bit_cast(f32x4, a3)[3]; }
}
__device__ __forceinline__ void glds16(const void* gsrc, unsigned lds_dst) { unsigned keep;
    asm volatile("s_mov_b32 %0, m0\n\ts_mov_b32 m0, %2\n\ts_nop 0\n\tglobal_load_lds_dwordx4 %1, off\n\ts_mov_b32 m0, %0" : "=&s"(keep) : "v"(gsrc), "s"(lds_dst) : "memory"); }
#define ATT_WAIT_BAR(N) asm volatile("s_waitcnt vmcnt(" #N ") lgkmcnt(0)\n\ts_barrier" ::: "memory")
template <int ABL = 0, class TF>
__device__ __forceinline__ void attn_loop2(unsigned tmask, const bf16_t* Kg, int pitchK, const bf16_t* Vg, int pitchV, LAS unsigned char* lds, const bf16x8 (&qr)[4],
                                           f32x16 (&o)[2], float& mref, float& l, const TF& tf, int wave_last_row) {
    const int tid = fresh_tid(), lane = tid & 63, r32 = lane & 31, hi = lane >> 5, wid = __builtin_amdgcn_readfirstlane(tid >> 6), grp = ATT_GRP(wid);
    LAS float* wsf = (LAS float*)(lds + L_WSF) + wid * 64;
    const LAS unsigned char* vp0 = lds + L_SLOT + L_VR + ((lane >> 4) & 1) * 32 + (lane & 3) * 8 + (4 * hi + ((lane & 15) >> 2)) * 64;
    const bf16_t* ksrc = Kg + (size_t)lane * pitchK + wid * 8;
    const bf16_t* vsrc = Vg + (size_t)(16 * (wid & 3) + (lane >> 2)) * pitchV + (wid >> 2) * 32 + (lane & 3) * 8;
    const unsigned ldsb = (unsigned)(size_t)(lds + L_SLOT) + (unsigned)wid * 1024u;
#define DMA_K(t, slot) glds16(ksrc + (size_t)(t) * 64 * pitchK, (unsigned)__builtin_amdgcn_readfirstlane(ldsb + (unsigned)(slot) * 8192u))
#define DMA_V(t, slot) glds16(vsrc + (size_t)(t) * 64 * pitchV, (unsigned)__builtin_amdgcn_readfirstlane(ldsb + (unsigned)L_VR + (unsigned)(slot) * 8192u))
#define NEXT_TILE(dst) do { if (tmask) { dst = 31 - __clz((int)tmask); tmask &= ~(1u << dst); } else dst = -1; } while (0)
    int t0, t1, t2, t3;
    NEXT_TILE(t0); NEXT_TILE(t1); NEXT_TILE(t2);
    const int tz = t0;
    DMA_K(t0, 0); DMA_V(t0, 0); DMA_K(t1 < 0 ? tz : t1, 1); DMA_V(t1 < 0 ? tz : t1, 1); DMA_K(t2 < 0 ? tz : t2, 2);
    ATT_WAIT_BAR(2);
    f32x16 sa0, sa1, sb0, sb1;
    bool first = true;
    mref = 0.f; l = 0.f;
    { f32x16 c0, c1; tf.cinit(t0, 0.f, c0, c1); qkt_c(sa0, sa1, lds + L_SLOT, qr, c0, c1, r32, hi); }
    asm volatile("s_waitcnt lgkmcnt(0)\n\ts_barrier" ::: "memory");
    int s0 = 0, s1 = 1, s2 = 2;
#define ATT_STEP(SC0, SC1, SN0, SN1) do { \
        NEXT_TILE(t3); \
        DMA_K(t3 < 0 ? tz : t3, s0); DMA_V(t2 < 0 ? tz : t2, s2); \
        const int t1c = t1 < 0 ? tz : t1; \
        if (grp == 0) { \
            { f32x16 c0, c1; if (ABL & 32) { c0 = f32x16{}; c1 = f32x16{}; c0[0] = mref; } else tf.cinit(t1c, mref, c0, c1); if (!(ABL & 4)) qkt_c(SN0, SN1, lds + L_SLOT + s1 * 8192, qr, c0, c1, r32, hi); else { SN0 = c0; SN1 = c1; } } \
            sm_pv<ABL>(SC0, SC1, SN0, SN1, true, t0, s0, first, mref, l, o, wsf, vp0, tf, r32, hi); \
        } else { \
            sm_pv<ABL>(SC0, SC1, SN0, SN1, false, t0, s0, first, mref, l, o, wsf, vp0, tf, r32, hi); \
            { f32x16 c0, c1; if (ABL & 32) { c0 = f32x16{}; c1 = f32x16{}; c0[0] = mref; } else tf.cinit(t1c, mref, c0, c1); if (!(ABL & 4)) qkt_c(SN0, SN1, lds + L_SLOT + s1 * 8192, qr, c0, c1, r32, hi); else { SN0 = c0; SN1 = c1; } } \
        } \
        ATT_WAIT_BAR(2); \
        t0 = t1; t1 = t2; t2 = t3; { const int s_ = s0; s0 = s1; s1 = s2; s2 = s_; } \
    } while (0)
    for (;;) {
        ATT_STEP(sa0, sa1, sb0, sb1); if (t0 < 0) break;
        ATT_STEP(sb0, sb1, sa0, sa1); if (t0 < 0) break;
    }
    asm volatile("s_waitcnt vmcnt(0)" ::: "memory");
    __syncthreads();
#undef ATT_STEP
#undef NEXT_TILE
#undef DMA_K
#undef DMA_V
}
struct TfFox { const LAS float* cb; int qpos, hi, q0w;
    __device__ __forceinline__ void cinit(int kt, float mref, f32x16& c0, f32x16& c1) const {
#pragma unroll
        for (int i = 0; i < 4; ++i) { const f32x4 a = *(const LAS f32x4*)(cb + kt * 64 + 8 * i + 4 * hi), b = *(const LAS f32x4*)(cb + kt * 64 + 32 + 8 * i + 4 * hi);
#pragma unroll
            for (int j = 0; j < 4; ++j) { c0[4 * i + j] = a[j] - mref; c1[4 * i + j] = b[j] - mref; } } }
    __device__ __forceinline__ void post(int kt, f32x16& p0, f32x16& p1) const {
        if (kt * 64 + 63 > q0w) {
#pragma unroll
            for (int r = 0; r < 16; ++r) { const int kv = kt * 64 + crow(r, hi); if (kv > qpos) p0[r] = NEG; if (kv + 32 > qpos) p1[r] = NEG; } } } };
struct TfT5 { const LAS float* tb; int qpos, hi, q0w, window; unsigned mask; bool use_mask;
    __device__ __forceinline__ void cinit(int kt, float mref, f32x16& c0, f32x16& c1) const {
        if (q0w - (kt * 64 + 63) >= 113) { const float c = tb[127] - mref;
#pragma unroll
            for (int r = 0; r < 16; ++r) { c0[r] = c; c1[r] = c; } }
        else {
#pragma unroll
            for (int r = 0; r < 16; ++r) { const int d0 = qpos - kt * 64 - crow(r, hi); c0[r] = tb[min(max(d0, 0), 127)] - mref; c1[r] = tb[min(max(d0 - 32, 0), 127)] - mref; } } }
    __device__ __forceinline__ void post(int kt, f32x16& p0, f32x16& p1) const {
        if (q0w - (kt * 64 + 63) < 0 || q0w + 31 - kt * 64 >= window) {
#pragma unroll
            for (int r = 0; r < 16; ++r) { const int d0 = qpos - kt * 64 - crow(r, hi), d1 = d0 - 32; if (d0 < 0 || d0 >= window) p0[r] = NEG; if (d1 < 0 || d1 >= window) p1[r] = NEG; } }
        if (use_mask) { const bool en = ((mask >> kt) & 1u) != 0u;
            if (!__all(en)) {
#pragma unroll
                for (int r = 0; r < 16; ++r) { p0[r] = en ? p0[r] : NEG; p1[r] = en ? p1[r] : NEG; } } } } };
}
#ifndef STAGE_LIMIT
#define STAGE_LIMIT 4
#endif
constexpr size_t MiB = 1u << 20;
constexpr size_t WS_CTL = 0, CTL_ZERO_BYTES = 2 * MiB;
constexpr size_t WS_SS = 256 * 1024;
constexpr size_t WS_SSM = 640 * 1024;
constexpr size_t WS_F32S = 2 * MiB;
constexpr size_t WS_CUM = 4 * MiB;
constexpr size_t WS_MASK = 4 * MiB + 512 * 1024;
constexpr size_t WS_UMASK = WS_MASK + 128 * 1024;
constexpr size_t WS_KC = 5 * MiB, WS_VC = 5 * MiB + 256 * 1024;
constexpr size_t WS_POSC = 704 * 1024;
constexpr size_t WS_WGU1 = 8 * MiB, WS_WD1 = 19 * MiB, WS_WIN = 25 * MiB, WS_WUPN = 35 * MiB, WS_WUPF = 36 * MiB, WS_WOUT = 37 * MiB, WS_WMQ = 39 * MiB,
                 WS_WMKV = 41 * MiB, WS_WMO = 45 * MiB, WS_WGU2 = 47 * MiB, WS_WD2 = 58 * MiB, WS_CW1K = 64 * MiB, WS_CW1V = 65 * MiB, WS_CW2K = 66 * MiB, WS_CW2V = 66 * MiB + 256 * 1024;
constexpr size_t WS_KM = 8 * MiB, WS_VT = 12 * MiB;
constexpr size_t WS_XB = 68 * MiB;
constexpr size_t WS_QN = 100 * MiB, WS_KVN = 116 * MiB, WS_QF = 140 * MiB, WS_KVF = 156 * MiB, WS_GAB = 188 * MiB;
constexpr size_t WS_H = 100 * MiB;
constexpr size_t WS_Y = WS_KVF;
constexpr size_t WS_QM = 108 * MiB, WS_PM = 188 * MiB, WS_OM = 140 * MiB;
constexpr size_t WS_MEMB = 252 * MiB, WS_END = 256 * MiB;
static_assert(WS_WD2 + (size_t)DM * FF * 2 <= WS_CW1K && WS_GAB + (size_t)M * 2048 * 2 <= WS_MEMB && WS_H + (size_t)M * FF * 2 <= WS_GAB, "ws map");
constexpr int CW_BAR = 4096;
constexpr int RING_BYTES = 131072, LDS_BYTES = 147456;

__device__ const unsigned char T5B[128] = {0, 1, 2, 3, 4, 5, 6, 7, 8, 9, 10, 11, 12, 13, 14, 15, 16, 16, 16, 17, 17, 18, 18, 18, 19, 19, 19, 20, 20, 20, 20, 21, 21, 21, 21, 22, 22, 22, 22, 22, 23, 23, 23, 23, 23, 23, 24, 24, 24, 24, 24, 24, 25, 25, 25, 25, 25, 25, 25, 26, 26, 26, 26, 26, 26, 26, 26, 27, 27, 27, 27, 27, 27, 27, 27, 27, 27, 28, 28, 28, 28, 28, 28, 28, 28, 28, 28, 29, 29, 29, 29, 29, 29, 29, 29, 29, 29, 29, 29, 30, 30, 30, 30, 30, 30, 30, 30, 30, 30, 30, 30, 30, 30, 31, 31, 31, 31, 31, 31, 31, 31, 31, 31, 31, 31, 31, 31, 31};


#define XB_TMO      128
#define XB_XCNT(j)  (256  + 64 * (j))
#define XB_XSUB(j)  (1280 + 64 * (j))
#define XB_XGEN(j)  (2304 + 64 * (j))
#define XB_TOP      3328
#define XB_TOPGEN   3392
#define XCD_BAR_WORDS 3456
#define XB_SPIN_CAP (1u << 18)
__device__ __forceinline__ unsigned xb_ld(unsigned* p)              { return __hip_atomic_load(p, __ATOMIC_RELAXED, __HIP_MEMORY_SCOPE_AGENT); }
__device__ __forceinline__ unsigned xb_add(unsigned* p, unsigned v) { return __hip_atomic_fetch_add(p, v, __ATOMIC_RELAXED, __HIP_MEMORY_SCOPE_AGENT); }
__device__ __forceinline__ unsigned xb_xcc_id() { return (unsigned)__builtin_amdgcn_s_getreg((3 << 11) | 20) & 0xFu; }
#define XB_SPIN(cond, bar) do { unsigned _sp = 0; while (cond) { __builtin_amdgcn_s_sleep(1); \
    if ((++_sp & 255u) == 0u) { if (xb_ld(&(bar)[XB_TMO])) break; if (_sp > XB_SPIN_CAP) { atomicAdd(&(bar)[XB_TMO], 1u); break; } } } } while (0)
struct XcdBarrier { unsigned* bar; unsigned x; volatile LAS unsigned* st; };
__device__ __forceinline__ XcdBarrier xcd_barrier_post(unsigned* bar, volatile LAS unsigned* st) {
    XcdBarrier b; b.bar = bar; b.x = xb_xcc_id(); b.st = st;
    if (threadIdx.x == 0) (void)xb_add(&bar[XB_XCNT(b.x)], 1u);
    return b;
}
__device__ __forceinline__ void xcd_barrier_complete(unsigned* bar, unsigned x, unsigned& nloc, unsigned& nx) {
    const unsigned G = gridDim.x * gridDim.y * gridDim.z;
    unsigned sum, cnt, mine, sp = 0u;
    for (;;) {
        sum = 0u; cnt = 0u; mine = 0u;
#pragma unroll
        for (unsigned j = 0; j < 16; ++j) { const unsigned c = xb_ld(&bar[XB_XCNT(j)]); sum += c; cnt += (c > 0u) ? 1u : 0u; mine = (j == x) ? c : mine; }
        if (sum == G) break;
        __builtin_amdgcn_s_sleep(1);
        if ((++sp & 255u) == 0u) { if (xb_ld(&bar[XB_TMO])) break; if (sp > XB_SPIN_CAP) { atomicAdd(&bar[XB_TMO], 1u); break; } }
    }
    nloc = mine > 0u ? mine : 1u; nx = cnt > 0u ? cnt : 1u;
}
__device__ __forceinline__ void xcd_barrier(const XcdBarrier& b) {
    asm volatile("s_waitcnt vmcnt(0)" ::: "memory");
    __syncthreads();
    if (threadIdx.x == 0) {
        unsigned* bar = b.bar;
        __builtin_amdgcn_s_waitcnt(0);
        unsigned nloc = b.st[0], nx = b.st[1];
        if (nloc == 0u) { xcd_barrier_complete(bar, b.x, nloc, nx); b.st[0] = nloc; b.st[1] = nx; }
        const unsigned old = xb_add(&bar[XB_XSUB(b.x)], 1u);
        const unsigned gen = old / nloc;
        if (old + 1u == (gen + 1u) * nloc) {
            __builtin_amdgcn_fence(__ATOMIC_RELEASE, "agent");
            asm volatile("s_waitcnt vmcnt(0)" ::: "memory");
            const unsigned og = xb_add(&bar[XB_TOP], 1u);
            const unsigned tg = og / nx;
            if (og + 1u == (tg + 1u) * nx) xb_add(&bar[XB_TOPGEN], 1u);
            else XB_SPIN(xb_ld(&bar[XB_TOPGEN]) == tg, bar);
            __builtin_amdgcn_fence(__ATOMIC_ACQUIRE, "agent");
            xb_add(&bar[XB_XGEN(b.x)], 1u);
            asm volatile("s_waitcnt vmcnt(0)" ::: "memory");
        } else {
            XB_SPIN(xb_ld(&bar[XB_XGEN(b.x)]) == gen, bar);
            __builtin_amdgcn_fence(__ATOMIC_ACQUIRE, "agent");
            asm volatile("s_waitcnt vmcnt(0)" ::: "memory");
        }
    }
    __syncthreads();
}

struct Args { const float* in[29]; float* out; unsigned char* ws; int lo, hi; };
enum { I_X = 0, I_MEM, I_RELB, I_F1N, I_F1G, I_F1U, I_F1D, I_MIXN, I_WIN, I_BF, I_POSK, I_POSV, I_CK1, I_CK2, I_CV1, I_CV2, I_UPN, I_UPF, I_WOUT, I_MQN, I_MKVN, I_MWQ, I_MWKV, I_MWO, I_F2N, I_F2G, I_F2U, I_F2D, I_FINN };

__device__ __forceinline__ float wave_sum(float v) {
#pragma unroll
    for (int o = 1; o < 64; o <<= 1) v += __shfl_xor(v, o);
    return v;
}
template <class CM>
__device__ __forceinline__ void tr_item(const float* W, int ldsrc, int K, bf16_t* WT, int k0, int dstrow0, const float* gain, LAS float* scr, int lane, const CM& cm) {
    const int kr = lane >> 3, c4 = lane & 7; int sc; float scl; cm(dstrow0 + 4 * c4, sc, scl);
    f32x4 v[8]; float gk[8];
#pragma unroll
    for (int i = 0; i < 8; ++i) { const int kk = 8 * i + kr; v[i] = sc >= 0 ? *(const f32x4*)(W + (size_t)(k0 + kk) * ldsrc + sc) : (f32x4){0.f, 0.f, 0.f, 0.f}; gk[i] = gain ? gain[k0 + kk] : 1.f; }
#pragma unroll
    for (int i = 0; i < 8; ++i) { const int kk = 8 * i + kr; const float s = gk[i] * scl; LAS float* p = scr + kk * 33 + 4 * c4; p[0] = v[i][0] * s; p[1] = v[i][1] * s; p[2] = v[i][2] * s; p[3] = v[i][3] * s; }
    asm volatile("s_waitcnt lgkmcnt(0)" ::: "memory");
    const int c = lane & 7;
#pragma unroll
    for (int j = 0; j < 4; ++j) { const int nn = (lane >> 3) + 8 * j; const LAS float* s = scr + (8 * c) * 33 + nn;
        u32x4 o; o.x = cvtpk(s[0 * 33], s[1 * 33]); o.y = cvtpk(s[2 * 33], s[3 * 33]); o.z = cvtpk(s[4 * 33], s[5 * 33]); o.w = cvtpk(s[6 * 33], s[7 * 33]);
        *(u32x4*)(WT + (size_t)(dstrow0 + nn) * K + k0 + 8 * c) = o; }
    asm volatile("s_waitcnt lgkmcnt(0)" ::: "memory");
}
struct CmPlain { int off; float s; __device__ __forceinline__ void operator()(int n, int& sc, float& scl) const { sc = n + off; scl = s; } };
struct CmWin { __device__ __forceinline__ void operator()(int n, int& sc, float& scl) const {
    scl = 1.f;
    if (n < 512) { sc = n; scl = QS64; }
    else if (n < 1280) sc = n;
    else if (n < 1792) { sc = 1304 + (n - 1280); scl = QS64; }
    else if (n < 2816) sc = 1816 + (n - 1792);
    else if (n < 4864) sc = 2848 + (n - 2816);
    else if (n < 4888) sc = 1280 + (n - 4864);
    else if (n < 4896) sc = 2840 + (n - 4888);
    else sc = -1; } };
constexpr int N_GU = 16 * 176, N_D = 44 * 32, N_WIN = 16 * 160, N_UP = 8 * 32, N_SQ = 16 * 32, N_MKV = 16 * 64, N_C1 = 32 * 8, N_C2 = 4 * 2;
constexpr int CONV_NA = N_GU + N_D + N_WIN + N_MKV + 2 * N_C1 + 2 * N_C2, CONV_NB = N_GU + N_D + 2 * N_UP + 3 * N_SQ;
__device__ __forceinline__ void conv_item(const Args& a, int it, LAS float* scr, int lane) {
    unsigned char* ws = a.ws; int r = it;
    const int f = r >= CONV_NA; if (f) r -= CONV_NA;
    if (r < N_GU) { const int kb = r / 176, gi = r % 176, dr = gi * 32, tile = dr >> 8, within = dr & 255;
        const float* W = a.in[within < 128 ? (f ? I_F2G : I_F1G) : (f ? I_F2U : I_F1U)];
        tr_item(W, FF, DM, (bf16_t*)(ws + (f ? WS_WGU2 : WS_WGU1)), kb * 64, dr, a.in[f ? I_F2N : I_F1N], scr, lane, CmPlain{tile * 128 + (within & 127) - dr, 1.f}); return; }
    r -= N_GU;
    if (r < N_D) { const int kb = r / 32, gi = r % 32; tr_item(a.in[f ? I_F2D : I_F1D], DM, FF, (bf16_t*)(ws + (f ? WS_WD2 : WS_WD1)), kb * 64, gi * 32, nullptr, scr, lane, CmPlain{0, 1.f}); return; }
    r -= N_D;
    if (!f) {
        if (r < N_WIN) { const int kb = r / 160, gi = r % 160; tr_item(a.in[I_WIN], 4896, DM, (bf16_t*)(ws + WS_WIN), kb * 64, gi * 32, a.in[I_MIXN], scr, lane, CmWin{}); return; }
        r -= N_WIN;
        if (r < N_MKV) { const int kb = r / 64, gi = r % 64; tr_item(a.in[I_MWKV], 2048, DM, (bf16_t*)(ws + WS_WMKV), kb * 64, gi * 32, a.in[I_MKVN], scr, lane, CmPlain{0, 1.f}); return; }
        r -= N_MKV;
        if (r < 2 * N_C1) { const int g = r >= N_C1; r -= g * N_C1; const int kb = r / 8, gi = r % 8;
            tr_item(a.in[g ? I_CV1 : I_CK1], 256, 2048, (bf16_t*)(ws + (g ? WS_CW1V : WS_CW1K)), kb * 64, gi * 32, nullptr, scr, lane, CmPlain{0, 1.f}); return; }
        r -= 2 * N_C1;
        { const int g = r >= N_C2; r -= g * N_C2; const int kb = r / 2, gi = r % 2;
            tr_item(a.in[g ? I_CV2 : I_CK2], 64, 256, (bf16_t*)(ws + (g ? WS_CW2V : WS_CW2K)), kb * 64, gi * 32, nullptr, scr, lane, CmPlain{0, 1.f}); }
    } else {
        if (r < 2 * N_UP) { const int g = r >= N_UP; r -= g * N_UP; const int kb = r / 32, gi = r % 32;
            tr_item(a.in[g ? I_UPF : I_UPN], DM, 512, (bf16_t*)(ws + (g ? WS_WUPF : WS_WUPN)), kb * 64, gi * 32, nullptr, scr, lane, CmPlain{0, 1.f}); return; }
        r -= 2 * N_UP;
        { const int g = r / N_SQ; r -= g * N_SQ; const int kb = r / 32, gi = r % 32;
            tr_item(a.in[g == 0 ? I_WOUT : (g == 1 ? I_MWQ : I_MWO)], DM, DM, (bf16_t*)(ws + (g == 0 ? WS_WOUT : (g == 1 ? WS_WMQ : WS_WMO))), kb * 64, gi * 32, g == 1 ? a.in[I_MQN] : nullptr, scr, lane,
                    CmPlain{0, g == 1 ? QS256 : 1.f}); }
    }
}

__device__ __forceinline__ void p0_prologue(const Args& a, LAS unsigned char* lds, int gw, int NGW, int wave, int lane) {
    unsigned char* ws = a.ws;
    LAS float* scr = (LAS float*)(lds + wave * 16384);
    for (int it = gw; it < N_GU; it += NGW) conv_item(a, it, scr, lane);
    for (int mrow = gw; mrow < M + MROWS; mrow += NGW) {
        const bool ismem = mrow >= M; const int rr = ismem ? mrow - M : mrow;
        const f32x4* xr = (const f32x4*)((ismem ? a.in[I_MEM] : a.in[I_X]) + (size_t)rr * DM) + lane;
        unsigned long long* o8 = (unsigned long long*)((bf16_t*)(ws + (ismem ? WS_MEMB : WS_XB)) + (size_t)rr * DM) + lane;
        float s = 0.f; f32x4 v[4];
#pragma unroll
        for (int j = 0; j < 4; ++j) v[j] = xr[64 * j];
#pragma unroll
        for (int j = 0; j < 4; ++j) { s += (v[j][0] * v[j][0] + v[j][1] * v[j][1]) + (v[j][2] * v[j][2] + v[j][3] * v[j][3]);
            o8[64 * j] = (unsigned long long)cvtpk(v[j][0], v[j][1]) | ((unsigned long long)cvtpk(v[j][2], v[j][3]) << 32); }
        s = wave_sum(s);
        if (lane == 0) ((float*)(ws + (ismem ? WS_SSM : WS_SS)))[rr] = s;
    }
    for (int t = gw; t < 64; t += NGW) { const int kv = t >> 5, kc = (t & 31) * 64; const float* pos = a.in[kv ? I_POSV : I_POSK] + kc; const f32x4* w1 = (const f32x4*)(a.in[kv ? I_CV1 : I_CK1] + (size_t)kc * 256) + lane;
        f32x4 s = {0.f, 0.f, 0.f, 0.f};
#pragma unroll 8
        for (int k = 0; k < 64; ++k) s += w1[(size_t)k * 64] * pos[k];
        float* o = (float*)(ws + WS_POSC) + kv * 256 + 4 * lane;
        unsafeAtomicAdd(o, s[0]); unsafeAtomicAdd(o + 1, s[1]); unsafeAtomicAdd(o + 2, s[2]); unsafeAtomicAdd(o + 3, s[3]); }
}

__device__ __forceinline__ void compress_unit(const Args& a, LAS unsigned char* lds, int uidx) {
    unsigned char* ws = a.ws;
    const int tid = fresh_tid(), lane = tid & 63, r32 = lane & 31, hi = lane >> 5, wid = __builtin_amdgcn_readfirstlane(tid >> 6);
    const int kv = uidx >> 6, b = (uidx >> 3) & 7, g = (uidx >> 2) & 1, chunk = uidx & 3, n0 = chunk * 32;
    const bf16_t* W1 = (const bf16_t*)(ws + (kv ? WS_CW1V : WS_CW1K)); const bf16_t* W2 = (const bf16_t*)(ws + (kv ? WS_CW2V : WS_CW2K));
    const float* posc = (const float*)(ws + WS_POSC) + kv * 256;
    const bf16_t* asrc = (const bf16_t*)(ws + WS_KVN) + (size_t)(b * SEQ) * 768 + kv * 128 + g * 64;
    LAS bf16_t* As = (LAS bf16_t*)lds;
    for (int i = tid; i < 528 * 8; i += 512) { const int row = i >> 3, ch = i & 7; const int t = min(16 * n0 + row, SEQ - 1);
        *(LAS u32x4*)(As + row * 64 + ((ch ^ ((row >> 4) & 7)) * 8)) = *(const u32x4*)(asrc + (size_t)t * 768 + ch * 8); }
    __syncthreads();
    const bf16_t* brow = W1 + (size_t)(32 * wid + r32) * 2048 + hi * 8;
    f32x16 acc = f32x16{};
#pragma unroll 16
    for (int kk = 0; kk < 128; ++kk) { const int l = kk >> 2, dch = (kk & 3) * 2 + hi, row = 16 * r32 + l;
        const bf16x8 av = *(const LAS bf16x8*)(As + row * 64 + ((dch ^ ((row >> 4) & 7)) * 8)); const bf16x8 bv = *(const bf16x8*)(brow + kk * 16);
        acc = __builtin_amdgcn_mfma_f32_32x32x16_bf16(av, bv, acc, 0, 0, 0); }
    LAS bf16_t* Hs = (LAS bf16_t*)(lds + 81920);
    const float pc = posc[32 * wid + r32];
#pragma unroll
    for (int r = 0; r < 16; ++r) { const float x = acc[r] + pc; const float u = 0.7978845608028654f * (x + 0.044715f * x * x * x);
        const float ge = x * frcp(1.0f + fexp2(-2.0f * LOG2E * u)); Hs[att::crow(r, hi) * 264 + 32 * wid + r32] = (bf16_t)(cvtpk(ge, 0.f) & 0xffffu); }
    __syncthreads();
    if (wid < 2) { f32x16 acc2 = f32x16{};
#pragma unroll
        for (int kk = 0; kk < 16; ++kk) { const bf16x8 av = *(const LAS bf16x8*)(Hs + r32 * 264 + kk * 16 + hi * 8); const bf16x8 bv = *(const bf16x8*)(W2 + (size_t)(32 * wid + r32) * 256 + kk * 16 + hi * 8);
            acc2 = __builtin_amdgcn_mfma_f32_32x32x16_bf16(av, bv, acc2, 0, 0, 0); }
        bf16_t* outp = (bf16_t*)(ws + (kv ? WS_VC : WS_KC)) + (size_t)((b * 2 + g) * 128) * 64;
#pragma unroll
        for (int r = 0; r < 16; ++r) { const int n = n0 + att::crow(r, hi); const float v = n < 127 ? acc2[r] : 0.f; outp[(size_t)n * 64 + 32 * wid + r32] = (bf16_t)(cvtpk(v, 0.f) & 0xffffu); } }
    __syncthreads();
}
__device__ __forceinline__ void cumsum_task(const Args& a, int task, int lane) {
    const int b = task >> 3, h = task & 7; const float bf = a.in[I_BF][h];
    const float* fl = (const float*)(a.ws + WS_F32S) + (size_t)(b * SEQ) * 32 + 24 + h; float* out = (float*)(a.ws + WS_CUM) + (size_t)task * SEQ;
    float tot = 0.f;
    for (int i = 0; i < 32; ++i) { const float v = fl[(size_t)(32 * lane + i) * 32] + bf; tot += fminf(v, 0.f) - log1pf(expf(-fabsf(v))); }
    float inc = tot;
#pragma unroll
    for (int o = 1; o < 64; o <<= 1) { const float t = __shfl_up(inc, o); if (lane >= o) inc += t; }
    float run = inc - tot;
    for (int i = 0; i < 32; ++i) { const float v = fl[(size_t)(32 * lane + i) * 32] + bf; run += fminf(v, 0.f) - log1pf(expf(-fabsf(v))); out[32 * lane + i] = -run * LOG2E; }
}

__device__ __forceinline__ void init_t5_table(const Args& a, LAS unsigned char* lds) {
    LAS float* T = (LAS float*)(lds + att::L_TBL);
    for (int i = fresh_tid(); i < 1024; i += 512) { const int h = i >> 7, d = i & 127; T[i] = a.in[I_RELB][T5B[d] * 8 + h] * LOG2E; }
}
template <bool DRY> __device__ __forceinline__ void fox_unit(const Args& a, LAS unsigned char* lds, int b, int h, int qb) {
    using namespace att;
    unsigned char* ws = a.ws;
    const int tid = fresh_tid(), lane = tid & 63, r32 = lane & 31, hi = lane >> 5, wid = __builtin_amdgcn_readfirstlane(tid >> 6);
    const int q0 = qb * 256, q0w = q0 + wid * 32, qpos = q0w + r32;
    LAS float* cb = (LAS float*)(lds + L_CB); LAS float* wsf = (LAS float*)(lds + L_WSF) + wid * 64;
    const float* cum = (const float*)(ws + WS_CUM) + (size_t)(b * 8 + h) * SEQ;
    for (int i = tid; i < q0 + 256; i += 512) cb[i] = cum[i];
    bf16_t* Qw = (bf16_t*)(ws + WS_QF) + (size_t)(b * SEQ + q0w) * 512 + h * 64;
    bf16x8 qr[4]; load_q(qr, Qw, 512, r32, hi);
    f32x16 o[2]; o[0] = f32x16{}; o[1] = f32x16{}; float m = 0.f, l = 0.f;
    const int nt = 4 * qb + 4; const unsigned tmask = nt >= 32 ? 0xffffffffu : ((1u << nt) - 1u);
    const bf16_t* Kg = (const bf16_t*)(ws + WS_KVF) + (size_t)(b * SEQ) * 1024 + h * 64;
#ifndef FOX_ABL
#define FOX_ABL 0
#endif
    if (DRY) attn_loop2<FOX_ABL>(tmask, Kg, 1024, Kg + 512, 1024, lds, qr, o, m, l, TfFox{cb, qpos, hi, q0w}, q0w + 31);
    else attn_loop2<0>(tmask, Kg, 1024, Kg + 512, 1024, lds, qr, o, m, l, TfFox{cb, qpos, hi, q0w}, q0w + 31);
    l = halfsum(l);
    scale_rows(o, wsf, 1.0f / l, r32, hi);
    store_o<false>(o, lds, DRY ? (bf16_t*)(ws + WS_XB + 16 * MiB) + (size_t)(b * SEQ + q0w) * 512 + h * 64 : Qw, 512, nullptr, 0);
}
template <int PARTS> __device__ __forceinline__ void cmpwin_unit(const Args& a, LAS unsigned char* lds, int b, int g, int qb) {
    using namespace att;
    unsigned char* ws = a.ws;
    const int tid = fresh_tid(), lane = tid & 63, r32 = lane & 31, hi = lane >> 5, wid = __builtin_amdgcn_readfirstlane(tid >> 6);
    const int j = wid >> 1, sub = wid & 1, hg = g * 4 + j, q0w = qb * 64 + sub * 32, qpos = q0w + r32; const size_t qrow = (size_t)b * SEQ + qpos;
    const LAS float* tb = (const LAS float*)(lds + L_TBL) + hg * 128;
    LAS float* wsf = (LAS float*)(lds + L_WSF) + wid * 64; LAS float* PS = (LAS float*)(lds + L_PS); LAS float* IMP = (LAS float*)(lds + L_IMP); LAS unsigned* MW = (LAS unsigned*)(lds + L_MISC);
    const float* gates = (const float*)(ws + WS_F32S) + qrow * 32;
    if (tid == 0) MW[0] = 0u;
    bf16x8 qr[4]; load_q(qr, (const bf16_t*)(ws + WS_QN) + (size_t)(b * SEQ + q0w) * 512 + hg * 64, 512, r32, hi);
    const StageGeo sg = stage_geo(tid);
    { const bf16_t* Kc = (const bf16_t*)(ws + WS_KC) + (size_t)((b * 2 + g) * 128) * 64; const bf16_t* Vc = (const bf16_t*)(ws + WS_VC) + (size_t)((b * 2 + g) * 128) * 64;
#pragma unroll
        for (int t = 0; t < 2; ++t) { *(LAS u32x4*)(lds + L_SLOT + t * 16384 + sg.koff) = *(const u32x4*)(Kc + (size_t)(t * 64 + sg.krow) * 64 + sg.kcol);
            *(LAS u32x4*)(lds + L_SLOT + t * 16384 + sg.voff) = *(const u32x4*)(Vc + (size_t)(t * 64 + sg.vrow) * 64 + sg.vcol); } }
    __syncthreads();
    if (PARTS & 1) {
        f32x16 oc[2]; oc[0] = f32x16{}; oc[1] = f32x16{};
        f32x16 a0, a1, b0, b1; qkt(a0, a1, lds + L_SLOT, qr, r32, hi); qkt(b0, b1, lds + L_SLOT + 16384, qr, r32, hi);
        float mx = NEG;
#pragma unroll
        for (int r = 0; r < 16; ++r) { const int d = qpos - 16 * crow(r, hi) - 31;
            a0[r] = d >= 0 ? a0[r] + tb[min(d, 127)] : NEG; a1[r] = d - 512 >= 0 ? a1[r] + tb[min(d - 512, 127)] : NEG;
            b0[r] = d - 1024 >= 0 ? b0[r] + tb[min(d - 1024, 127)] : NEG; b1[r] = d - 1536 >= 0 ? b1[r] + tb[min(d - 1536, 127)] : NEG;
            mx = fmaxf(fmaxf(mx, fmaxf(a0[r], a1[r])), fmaxf(b0[r], b1[r])); }
        { auto rr = __builtin_amdgcn_permlane32_swap(__float_as_uint(mx), __float_as_uint(mx), false, false); mx = fmaxf(__uint_as_float(rr[0]), __uint_as_float(rr[1])); }
        const float mxs = mx == NEG ? 0.f : mx; float s = 0.f;
#pragma unroll
        for (int r = 0; r < 16; ++r) { a0[r] = fexp2(a0[r] - mxs); a1[r] = fexp2(a1[r] - mxs); b0[r] = fexp2(b0[r] - mxs); b1[r] = fexp2(b1[r] - mxs); s += (a0[r] + a1[r]) + (b0[r] + b1[r]); }
        s = halfsum(s); const float inv = s > 0.f ? 1.0f / s : 0.f;
#pragma unroll
        for (int r = 0; r < 16; ++r) { a0[r] *= inv; a1[r] *= inv; b0[r] *= inv; b1[r] *= inv; }
        {
            float own[4][4], x3[4][4], rcv[4][4];
#pragma unroll
            for (int i = 0; i < 4; ++i) {
                own[0][i] = 2.0f * (a0[4 * i] + a0[4 * i + 1] + a0[4 * i + 2]) + a0[4 * i + 3]; x3[0][i] = a0[4 * i + 3];
                own[1][i] = 2.0f * (a1[4 * i] + a1[4 * i + 1] + a1[4 * i + 2]) + a1[4 * i + 3]; x3[1][i] = a1[4 * i + 3];
                own[2][i] = 2.0f * (b0[4 * i] + b0[4 * i + 1] + b0[4 * i + 2]) + b0[4 * i + 3]; x3[2][i] = b0[4 * i + 3];
                own[3][i] = 2.0f * (b1[4 * i] + b1[4 * i + 1] + b1[4 * i + 2]) + b1[4 * i + 3]; x3[3][i] = b1[4 * i + 3]; }
#pragma unroll
            for (int k = 0; k < 4; ++k)
#pragma unroll
                for (int i = 0; i < 4; ++i) { auto rr = __builtin_amdgcn_permlane32_swap(__float_as_uint(x3[k][i]), __float_as_uint(x3[k][i]), false, false); rcv[k][i] = __uint_as_float(hi ? rr[0] : rr[1]); }
            LAS float* imh = PS + j * (64 * 33) + (sub * 32 + r32) * 33 + hi;
#pragma unroll
            for (int k = 0; k < 4; ++k)
#pragma unroll
                for (int i = 0; i < 4; ++i) { const float prev = i > 0 ? rcv[k][i - 1] : (k > 0 ? rcv[k - 1][3] : 0.f);
                    imh[8 * k + 2 * i] = own[k][i] + (hi ? rcv[k][i] : prev); }
        }
        const int vb0 = (int)(unsigned)(size_t)(lds + L_SLOT + 8192) + ((lane >> 4) & 1) * 32 + (lane & 3) * 8 + (4 * hi + ((lane & 15) >> 2)) * 64;
        bf16x8 x0, x1, x2, x3; pack_p(a0, a1, x0, x1, x2, x3); pv(oc, vb0, x0, x1, x2, x3);
        pack_p(b0, b1, x0, x1, x2, x3); pv(oc, vb0 + 16384, x0, x1, x2, x3);
        scale_rows(oc, wsf, sigmoidf_(gates[hg]), r32, hi);
        store_o<false>(oc, lds, (bf16_t*)(ws + WS_XB) + (size_t)(b * SEQ + q0w) * 512 + hg * 64, 512, nullptr, 0);
    }
    __syncthreads();
    if (PARTS & 2) {
        const int q = tid >> 3, jb = (tid & 7) * 4; const LAS float* ps = PS + q * 33; LAS float* im = IMP + q * 33;
#pragma unroll
        for (int jj = 0; jj < 4; ++jj) { const int jx = jb + jj;
            const float v = (ps[jx] + ps[64 * 33 + jx]) + (ps[2 * 64 * 33 + jx] + ps[3 * 64 * 33 + jx]);
            const bool valid = jx <= qb, forced = (jx == 0) || (jx == qb) || (jx == qb - 1);
            im[jx] = valid ? v + (forced ? 1e4f : 0.f) : -1e30f; }
        __syncthreads();
        unsigned bits = 0u;
#pragma unroll
        for (int jj = 0; jj < 4; ++jj) { const int jx = jb + jj; const float v = im[jx]; int cnt = 0;
#pragma unroll
            for (int j2 = 0; j2 < 32; ++j2) { const float v2 = im[j2]; cnt += (v2 > v || (v2 == v && j2 < jx)) ? 1 : 0; }
            if (cnt < 16 && jx <= qb) bits |= 1u << jx; }
        bits |= __shfl_xor(bits, 1); bits |= __shfl_xor(bits, 2); bits |= __shfl_xor(bits, 4);
        if ((tid & 7) == 0) { ((unsigned*)(ws + WS_MASK))[(size_t)(b * 2 + g) * SEQ + qb * 64 + q] = bits; __hip_atomic_fetch_or(MW, bits, __ATOMIC_RELAXED, __HIP_MEMORY_SCOPE_WORKGROUP); }
        __syncthreads();
        if (tid == 0) ((unsigned*)(ws + WS_UMASK))[(b * 2 + g) * 32 + qb] = MW[0];
    }
    if (PARTS & 4) {
    f32x16 o[2]; o[0] = f32x16{}; o[1] = f32x16{}; float m = -1e30f, l = 0.f;
    const int lo = qb > 8 ? qb - 8 : 0; const unsigned tmask = (qb >= 31 ? 0xffffffffu : ((2u << qb) - 1u)) & ~((1u << lo) - 1u);
    const bf16_t* Kg = (const bf16_t*)(ws + WS_KVN) + (size_t)(b * SEQ) * 768 + 512 + g * 64;
    attn_loop2(tmask, Kg, 768, Kg + 128, 768, lds, qr, o, m, l, TfT5{tb, qpos, hi, q0w, 512, 0u, false}, q0w + 31);
    l = halfsum(l);
    scale_rows(o, wsf, sigmoidf_(gates[16 + hg]) / l, r32, hi);
    { bf16_t* ocw = (bf16_t*)(ws + WS_XB) + (size_t)(b * SEQ + q0w) * 512 + hg * 64; store_o<true>(o, lds, ocw, 512, ocw, 512); }
    }
}
template <bool DRY> __device__ __forceinline__ void sel_unit(const Args& a, LAS unsigned char* lds, int b, int g, int qb) {
    using namespace att;
    unsigned char* ws = a.ws;
    const int tid = fresh_tid(), lane = tid & 63, r32 = lane & 31, hi = lane >> 5, wid = __builtin_amdgcn_readfirstlane(tid >> 6);
    const int j = wid >> 1, sub = wid & 1, hg = g * 4 + j, q0w = qb * 64 + sub * 32, qpos = q0w + r32; const size_t qrow = (size_t)b * SEQ + qpos;
    const LAS float* tb = (const LAS float*)(lds + L_TBL) + hg * 128; LAS float* wsf = (LAS float*)(lds + L_WSF) + wid * 64;
    bf16_t* Qw = (bf16_t*)(ws + WS_QN) + (size_t)(b * SEQ + q0w) * 512 + hg * 64;
    bf16x8 qr[4]; load_q(qr, Qw, 512, r32, hi);
    const unsigned mask = ((const unsigned*)(ws + WS_MASK))[(size_t)(b * 2 + g) * SEQ + qpos];
    const unsigned um = ((const unsigned*)(ws + WS_UMASK))[(b * 2 + g) * 32 + qb] & (qb >= 31 ? 0xffffffffu : ((2u << qb) - 1u));
    f32x16 o[2]; o[0] = f32x16{}; o[1] = f32x16{}; float m = -1e30f, l = 0.f;
    const bf16_t* Kg = (const bf16_t*)(ws + WS_KVN) + (size_t)(b * SEQ) * 768 + 256 + g * 64;
    attn_loop2(um, Kg, 768, Kg + 128, 768, lds, qr, o, m, l, TfT5{tb, qpos, hi, q0w, 1 << 30, mask, true}, q0w + 31);
    l = halfsum(l);
    const float g1 = sigmoidf_(((const float*)(ws + WS_F32S))[qrow * 32 + 8 + hg]);
    scale_rows(o, wsf, g1 / l, r32, hi);
    store_o<true>(o, lds, DRY ? (bf16_t*)(ws + WS_XB + 16 * MiB) + (size_t)(b * SEQ + q0w) * 512 + hg * 64 : Qw, 512, (const bf16_t*)(ws + WS_XB) + (size_t)(b * SEQ + q0w) * 512 + hg * 64, 512);
}
#ifndef PHMASK
#define PHMASK 0xffffffffu
#endif
#define PH(n) (((PHMASK) >> (n)) & 1u)
#ifndef DUPMASK
#define DUPMASK 0u
#endif
#define DUP(n) (((DUPMASK) >> (n)) & 1u)
#define REP(n) for (int rep_ = 0; rep_ < 1 + (int)DUP(n); ++rep_)
__global__ void __launch_bounds__(512, 2) hybrid_fwd(Args a) {
    extern __shared__ __attribute__((aligned(16))) unsigned char lds_raw[];
    LAS unsigned char* lds = (LAS unsigned char*)lds_raw;
    cg::grid_group grid = cg::this_grid();
    unsigned char* ws = a.ws;
    const int tid = fresh_tid(), lane = tid & 63, wave = __builtin_amdgcn_readfirstlane(tid >> 6);
    const int G = gridDim.x, bx = blockIdx.x, vcu = (G % 8 == 0) ? (bx % 8) * (G / 8) + bx / 8 : bx;
    const int gw = vcu * 8 + wave, NGW = G * 8;
    float* X = a.out;
    bf16_t* XB = (bf16_t*)(ws + WS_XB);
    float* SS = (float*)(ws + WS_SS);
    { volatile LAS unsigned* st0 = (volatile LAS unsigned*)(lds + LDS_BYTES - 256); if (tid < 32) st0[tid] = 0u; }
    __syncthreads();
    XcdBarrier xbar = xcd_barrier_post((unsigned*)(ws + WS_CTL) + CW_BAR, (volatile LAS unsigned*)(lds + LDS_BYTES - 256 + 32));
#ifdef USE_CG_SYNC
#define GSYNC() grid.sync()
#else
    if (a.lo == 0x7e57) grid.sync();
#define GSYNC() xcd_barrier(xbar)
#endif
    const float* fin_src = a.in[I_X];

#if STAGE_LIMIT >= 1
    REP(0) p0_prologue(a, lds, gw, NGW, wave, lane);
    GSYNC();
    { pg8::Gemm g{XB, (const bf16_t*)(ws + WS_WGU1), DM, DM, DM, 0, 0, 0, 0}; pg8::Order S; S.init(64, 22, 1, G, bx);
      pg8::EpiGU E{(bf16_t*)(ws + WS_H), SS}; REP(1) pg8::gemm_phase<pg8::EpiGU, true>(lds, g, S, E);
      if (bx >= 128) { LAS float* scr = (LAS float*)(lds + wave * 16384); for (int it = N_GU + (bx - 128) * 8 + wave; it < CONV_NA; it += 1024) conv_item(a, it, scr, lane); } }
    GSYNC();
    { pg8::Gemm g{(const bf16_t*)(ws + WS_H), (const bf16_t*)(ws + WS_WD1), FF, FF, FF, 0, 0, 0, 0}; pg8::Order S; S.init(64, 4, 1, G, bx);
      if (DUP(2)) { pg8::EpiNull E0{(float*)(ws + WS_POSC + 4096)}; pg8::gemm_phase<pg8::EpiNull, false>(lds, g, S, E0); }
      pg8::EpiRes<true, true> E{a.in[I_X], X, XB, SS + M, 0.5f}; pg8::gemm_phase<pg8::EpiRes<true, true>, false>(lds, g, S, E); }
    GSYNC();
    fin_src = X;
#endif
#if STAGE_LIMIT >= 2
#if PH(3)
    { pg8::Gemm g{XB, (const bf16_t*)(ws + WS_WIN), DM, DM, DM, 0, 0, 0, 0}; pg8::Order S; S.init(64, 20, 1, G, bx);
      pg8::EpiQKV E{(bf16_t*)(ws + WS_QN), (bf16_t*)(ws + WS_KVN), (bf16_t*)(ws + WS_QF), (bf16_t*)(ws + WS_KVF), (bf16_t*)(ws + WS_GAB), (float*)(ws + WS_F32S), SS + M};
      REP(3) pg8::gemm_phase<pg8::EpiQKV, true>(lds, g, S, E); }
#endif
    GSYNC();
#if PH(4)
    REP(4) if (bx < 128) { compress_unit(a, lds, bx); }
    else if (bx < 192) {
        if (bx < 160) { pg8::Gemm g{(const bf16_t*)(ws + WS_MEMB), (const bf16_t*)(ws + WS_WMKV), DM, DM, DM, 0, 0, 0, 0}; pg8::Order S; S.init(8, 4, 1, 32, bx - 128);
            pg8::EpiRowScale E{(bf16_t*)(ws + WS_KM), DM, (const float*)(ws + WS_SSM)}; pg8::gemm_phase<pg8::EpiRowScale, false>(lds, g, S, E); }
        else { pg8::Gemm g{(const bf16_t*)(ws + WS_WMKV) + (size_t)DM * DM, (const bf16_t*)(ws + WS_MEMB), DM, DM, DM, 0, 0, 0, 0}; pg8::Order S; S.init(4, 8, 1, 32, bx - 160);
            pg8::EpiColScale E{(bf16_t*)(ws + WS_VT), MROWS, (const float*)(ws + WS_SSM)}; pg8::gemm_phase<pg8::EpiColScale, false>(lds, g, S, E); }
    } else { if (wave == 0) cumsum_task(a, bx - 192, lane); }
    if (bx >= 128) { LAS float* scr = (LAS float*)(lds + wave * 16384); for (int it = CONV_NA + (bx - 128) * 8 + wave; it < CONV_NA + CONV_NB; it += 1024) conv_item(a, it, scr, lane); }
#endif
    GSYNC();
#if PH(5)
    init_t5_table(a, lds);
    { const int bh = vcu >> 2, s = vcu & 3; if (DUP(5)) { fox_unit<true>(a, lds, bh >> 3, bh & 7, 7 - s); fox_unit<true>(a, lds, bh >> 3, bh & 7, s); }
      fox_unit<false>(a, lds, bh >> 3, bh & 7, 7 - s); fox_unit<false>(a, lds, bh >> 3, bh & 7, s); }
#ifdef DUPPART
    { const int bg = vcu >> 4, s = vcu & 15; cmpwin_unit<DUPPART>(a, lds, bg >> 1, bg & 1, 31 - s); cmpwin_unit<DUPPART>(a, lds, bg >> 1, bg & 1, s); }
#endif
#ifndef NO_CMPWIN
    REP(15) { const int bg = vcu >> 4, s = vcu & 15; cmpwin_unit<7>(a, lds, bg >> 1, bg & 1, 31 - s); cmpwin_unit<7>(a, lds, bg >> 1, bg & 1, s); }
#endif
#endif
    GSYNC();
#if PH(6)
    { const int bg = vcu >> 4, s = vcu & 15; if (DUP(6)) { sel_unit<true>(a, lds, bg >> 1, bg & 1, 31 - s); sel_unit<true>(a, lds, bg >> 1, bg & 1, s); }
      sel_unit<false>(a, lds, bg >> 1, bg & 1, 31 - s); sel_unit<false>(a, lds, bg >> 1, bg & 1, s); }
#endif
    GSYNC();
#if PH(7)
    REP(7) { pg8::Order S; S.init(64, 4, 1, G, bx);
      { pg8::Gemm g{(const bf16_t*)(ws + WS_QN), (const bf16_t*)(ws + WS_WUPN), 512, 512, 512, 0, 0, 0, 0}; pg8::EpiUp<0> E{(const bf16_t*)(ws + WS_GAB), (bf16_t*)(ws + WS_Y)}; pg8::gemm_phase<pg8::EpiUp<0>, false>(lds, g, S, E); }
      { pg8::Gemm g{(const bf16_t*)(ws + WS_QF), (const bf16_t*)(ws + WS_WUPF), 512, 512, 512, 0, 0, 0, 0}; pg8::EpiUp<1> E{(const bf16_t*)(ws + WS_GAB), (bf16_t*)(ws + WS_Y)}; pg8::gemm_phase<pg8::EpiUp<1>, false>(lds, g, S, E); } }
#endif
    GSYNC();
#if PH(8)
    { pg8::Gemm g{(const bf16_t*)(ws + WS_Y), (const bf16_t*)(ws + WS_WOUT), DM, DM, DM, 0, 0, 0, 0}; pg8::Order S; S.init(64, 4, 1, G, bx);
      if (DUP(8)) { pg8::EpiNull E0{(float*)(ws + WS_POSC + 4096)}; pg8::gemm_phase<pg8::EpiNull, false>(lds, g, S, E0); }
      pg8::EpiRes<true, true> E{X, X, XB, SS + 2 * M, 1.0f}; pg8::gemm_phase<pg8::EpiRes<true, true>, false>(lds, g, S, E); }
#endif
    GSYNC();
#endif
#if STAGE_LIMIT >= 3
    { pg8::Gemm g{XB, (const bf16_t*)(ws + WS_WMQ), DM, DM, DM, 0, 0, 0, 0}; pg8::Order S; S.init(64, 4, 1, G, bx);
      pg8::EpiRowScale E{(bf16_t*)(ws + WS_QM), DM, SS + 2 * M}; REP(9) pg8::gemm_phase<pg8::EpiRowScale, false>(lds, g, S, E); }
    GSYNC();
    { pg8::Gemm g{(const bf16_t*)(ws + WS_QM), (const bf16_t*)(ws + WS_KM), DM, DM, 256, (long)SEQ * DM, 256, (long)MEMLEN * DM, 256}; pg8::Order S; S.init(8, 1, 32, G, bx);
      pg8::EpiSoftmax E{(bf16_t*)(ws + WS_PM)}; REP(10) pg8::gemm_phase<pg8::EpiSoftmax, false>(lds, g, S, E); }
    GSYNC();
    { pg8::Gemm g{(const bf16_t*)(ws + WS_PM), (const bf16_t*)(ws + WS_VT), 256, MROWS, 256, (long)4 * SEQ * 256, (long)SEQ * 256, 256, (long)256 * MROWS}; pg8::Order S; S.init(8, 1, 32, G, bx);
      pg8::EpiBatchBf16 E{(bf16_t*)(ws + WS_OM), DM, (long)SEQ * DM, 256}; REP(11) pg8::gemm_phase<pg8::EpiBatchBf16, false>(lds, g, S, E); }
    GSYNC();
    { pg8::Gemm g{(const bf16_t*)(ws + WS_OM), (const bf16_t*)(ws + WS_WMO), DM, DM, DM, 0, 0, 0, 0}; pg8::Order S; S.init(64, 4, 1, G, bx);
      pg8::EpiRes<true, true> E{X, X, XB, SS + 3 * M, 1.0f}; pg8::gemm_phase<pg8::EpiRes<true, true>, false>(lds, g, S, E); }
    GSYNC();
#endif
#if STAGE_LIMIT >= 4
    { pg8::Gemm g{XB, (const bf16_t*)(ws + WS_WGU2), DM, DM, DM, 0, 0, 0, 0}; pg8::Order S; S.init(64, 22, 1, G, bx);
      pg8::EpiGU E{(bf16_t*)(ws + WS_H), SS + 3 * M}; pg8::gemm_phase<pg8::EpiGU, true>(lds, g, S, E); }
    GSYNC();
    { pg8::Gemm g{(const bf16_t*)(ws + WS_H), (const bf16_t*)(ws + WS_WD2), FF, FF, FF, 0, 0, 0, 0}; pg8::Order S; S.init(64, 4, 1, G, bx);
      pg8::EpiRes<false, false> E{X, X, nullptr, nullptr, 0.5f}; pg8::gemm_phase<pg8::EpiRes<false, false>, false>(lds, g, S, E); }
    GSYNC();
#endif
#ifdef EXTRA_BARS
    for (int eb = 0; eb < EXTRA_BARS; ++eb) GSYNC();
#endif
    { const float* gn = a.in[I_FINN]; const int tid2 = fresh_tid(), lane = tid2 & 63, gw = vcu * 8 + (tid2 >> 6);
      for (int mrow = gw; mrow < M; mrow += NGW) {
          const f32x4* xr = (const f32x4*)(fin_src + (size_t)mrow * DM) + lane; f32x4* orow = (f32x4*)(X + (size_t)mrow * DM) + lane;
          f32x4 v[4]; float s = 0.f;
#pragma unroll
          for (int j = 0; j < 4; ++j) { v[j] = xr[64 * j]; s += (v[j][0] * v[j][0] + v[j][1] * v[j][1]) + (v[j][2] * v[j][2] + v[j][3] * v[j][3]); }
          const float rs = rstd_of(wave_sum(s));
#pragma unroll
          for (int j = 0; j < 4; ++j) orow[64 * j] = v[j] * rs * ((const f32x4*)gn)[lane + 64 * j];
      } }
}

extern "C" void kernel_launch(void* const* d_in, const int* in_sizes, int n_in, void* d_out, int out_size, void* d_ws, size_t ws_size, hipStream_t stream) {
    static int grid = 0;
    if (grid == 0) {
        if (n_in != 29 || out_size != M * DM || ws_size < WS_END) { fprintf(stderr, "kernel_launch: unexpected shapes (n_in %d out %d ws %zu)\n", n_in, out_size, ws_size); grid = -1; return; }
        int dev = 0, cus = 0, per_cu = 0;
        hipGetDevice(&dev); hipDeviceGetAttribute(&cus, hipDeviceAttributeMultiprocessorCount, dev);
        if (hipFuncSetAttribute((const void*)hybrid_fwd, hipFuncAttributeMaxDynamicSharedMemorySize, LDS_BYTES) != hipSuccess) { fprintf(stderr, "kernel_launch: hipFuncSetAttribute failed\n"); grid = -1; return; }
        if (hipOccupancyMaxActiveBlocksPerMultiprocessor(&per_cu, (const void*)hybrid_fwd, 512, LDS_BYTES) != hipSuccess || per_cu < 1) { fprintf(stderr, "kernel_launch: occupancy query failed (%d)\n", per_cu); per_cu = 1; }
        (void)hipGetLastError();
        grid = cus * (per_cu < 1 ? 1 : 1);
        if (grid != 256) fprintf(stderr, "kernel_launch: grid %d != 256: this kernel's phase maps assume 256 workgroups\n", grid);
    }
    if (grid < 0) return;
    hipMemsetAsync((char*)d_ws + WS_CTL, 0, CTL_ZERO_BYTES, stream);
    Args a{};
    for (int i = 0; i < 29; ++i) a.in[i] = (const float*)d_in[i];
    a.out = (float*)d_out; a.ws = (unsigned char*)d_ws; a.lo = 0; a.hi = 0;
    void* args[] = {&a};
    hipError_t e = hipLaunchCooperativeKernel((const void*)hybrid_fwd, dim3(grid), dim3(512), args, LDS_BYTES, stream);
    if (e != hipSuccess) fprintf(stderr, "kernel_launch: cooperative launch failed: %s (grid %d)\n", hipGetErrorString(e), grid);
}
```

```cpp
#define ATT_GRP(w) 0
#include <hip/hip_runtime.h>
#include <hip/hip_cooperative_groups.h>
#include <cstdio>
#include <cstdint>
namespace cg = cooperative_groups;

#define LAS __attribute__((address_space(3)))
typedef unsigned short bf16_t;
typedef short bf16x8 __attribute__((ext_vector_type(8)));
typedef short s16x4 __attribute__((ext_vector_type(4)));
typedef float f32x2 __attribute__((ext_vector_type(2)));
typedef float f32x4 __attribute__((ext_vector_type(4)));
typedef float f32x16 __attribute__((ext_vector_type(16)));
typedef unsigned u32x2 __attribute__((ext_vector_type(2)));
typedef unsigned u32x4 __attribute__((ext_vector_type(4)));
typedef __bf16 bf16x2_t __attribute__((ext_vector_type(2)));

constexpr int NB = 8, SEQ = 2048, DM = 1024, FF = 2816, M = NB * SEQ;
constexpr int MEMLEN = 256, MROWS = NB * MEMLEN;
constexpr float RMS_EPS = 1e-6f;
constexpr float LOG2E = 1.4426950408889634f;
constexpr float QS64 = 0.125f * LOG2E;
constexpr float QS256 = 0.0625f * LOG2E;

__device__ __forceinline__ int fresh_tid() { int t = threadIdx.x; asm volatile("" : "+v"(t)); return t; }
__device__ __forceinline__ unsigned cvtpk(float lo, float hi) { f32x2 v = {lo, hi}; bf16x2_t b = __builtin_convertvector(v, bf16x2_t); return __builtin_bit_cast(unsigned, b); }
__device__ __forceinline__ float bflo(unsigned w) { return __uint_as_float(w << 16); }
__device__ __forceinline__ float bfhi(unsigned w) { return __uint_as_float(w & 0xffff0000u); }
__device__ __forceinline__ u32x4 pack8(f32x4 a, f32x4 b) { u32x4 w; w.x = cvtpk(a[0], a[1]); w.y = cvtpk(a[2], a[3]); w.z = cvtpk(b[0], b[1]); w.w = cvtpk(b[2], b[3]); return w; }
__device__ __forceinline__ float fexp2(float x) { return __builtin_amdgcn_exp2f(x); }
__device__ __forceinline__ float frcp(float x) { return __builtin_amdgcn_rcpf(x); }
__device__ __forceinline__ float sigmoidf_(float x) { return frcp(1.0f + fexp2(-x * LOG2E)); }
__device__ __forceinline__ float rstd_of(float ss) { return __builtin_amdgcn_rsqf(ss * (1.0f / DM) + RMS_EPS); }

namespace pg8 {
constexpr int BM = 256, BK = 64, HALF = 128, HTB = HALF * BK * 2, STAGE_BYTES = 8 * HTB, NXCD = 8, WGM = 8;
__host__ __device__ __forceinline__ int lds_byte(int r, int c) { const int st = (r >> 4) * 2 + (c >> 5), rr = r & 15, cc = c & 31, ob = rr * 64 + cc * 2; return st * 1024 + (ob ^ (((ob >> 9) & 1) << 5)); }
__host__ __device__ __forceinline__ void stage_rc(int b, int& R, int& C) { const int st = b / 1024, sb = b % 1024, swz = sb ^ (((sb >> 9) & 1) << 5); R = (st >> 1) * 16 + swz / 64; C = (st & 1) * 32 + (swz % 64) / 2; }
__host__ __device__ __forceinline__ int perm32(int rho) { const int n = rho >> 4, i = rho & 15; return 8 * (i >> 2) + 4 * n + (i & 3); }

struct Unit { int pm, pn, pb; };
struct Gemm { const bf16_t* A; const bf16_t* Bt; int lda, ldb, K; long sAb, sAh, sBb, sBh; };

struct Order {
    int nM, nN, nwg, G, c;
    __device__ __forceinline__ void init(int nM_, int nN_, int nB_, int G_, int c_) { nM = nM_; nN = nN_; nwg = nM_ * nN_ * nB_; G = G_; c = c_; }
    __device__ __forceinline__ bool next(int i, Unit& u) const {
        if (c < 0) return false;
        const long L = (long)i * G + c; if (L >= nwg) return false;
        int wgid = (int)L; { const int q = nwg / NXCD, r = nwg % NXCD, xcd = wgid % NXCD, off = wgid / NXCD; wgid = (xcd < r ? xcd * (q + 1) : r * (q + 1) + (xcd - r) * q) + off; }
        const int per = nM * nN; u.pb = wgid / per; const int w = wgid % per;
        const int nig = WGM * nN, gid = w / nig, fm = gid * WGM, gsz = (nM - fm) < WGM ? (nM - fm) : WGM;
        u.pm = fm + ((w % nig) % gsz); u.pn = (w % nig) / gsz; return true;
    }
};

typedef f32x4 Acc[2][2][4][2];

template <class Epi, bool ALIGN_EPI>
__device__ __forceinline__ void gemm_phase(LAS unsigned char* lds, const Gemm g, const Order& S, const Epi& E) {
    const int tid = fresh_tid(), wid = __builtin_amdgcn_readfirstlane(tid >> 6), lane = tid & 63, wr = wid >> 2, wc = wid & 3, fr = lane & 15, fq = lane >> 4;
    const int K = g.K, nt = K / BK;
    unsigned voffA[2], voffB[2];
#pragma unroll
    for (int i = 0; i < 2; ++i) { int R, C; stage_rc(tid * 16 + i * 8192, R, C); const int Rb = (R & ~31) + perm32(R & 31);
        voffA[i] = (unsigned)(R * g.lda + C) * 2u; voffB[i] = (unsigned)(Rb * g.ldb + C) * 2u; }
    const size_t kstep = (size_t)(BK * 2);
    const size_t hstepA = (size_t)HALF * g.lda * 2, hstepB = (size_t)HALF * g.ldb * 2;
    const size_t tstepA = 2 * hstepA, tstepB = 2 * hstepB;
    const unsigned ldsw = (unsigned)wid * 1024u;
    const int aoff = lds_byte(wr * 64 + fr, fq * 8), boff = lds_byte(wc * 32 + fr, fq * 8);
#define PG8_SA(b, h) (((b) * 2 + (h)) * HTB)
#define PG8_SB(b, h) ((4 + (b) * 2 + (h)) * HTB)
#define PG8_STAGE(bufoff, gbase, voff) do { _Pragma("unroll") for (int _i = 0; _i < 2; ++_i) \
        __builtin_amdgcn_global_load_lds((const unsigned*)((const char*)(gbase) + (voff)[_i]), (LAS unsigned*)(lds + (bufoff) + ldsw + _i * 8192), 16, 0, 0); } while (0)
#define PG8_LDA(dst, b, h) do { _Pragma("unroll") for (int m = 0; m < 4; ++m) _Pragma("unroll") for (int k = 0; k < 2; ++k) dst[m][k] = *(const LAS bf16x8*)(lds + PG8_SA(b, h) + aoff + m * 2048 + k * 1024); } while (0)
#define PG8_LDB(dst, b, h) do { _Pragma("unroll") for (int n = 0; n < 2; ++n) _Pragma("unroll") for (int k = 0; k < 2; ++k) dst[n][k] = *(const LAS bf16x8*)(lds + PG8_SB(b, h) + boff + n * 2048 + k * 1024); } while (0)
#define PG8_MMA(ai, bj, At, Bt) do { __builtin_amdgcn_s_setprio(1); _Pragma("unroll") for (int m = 0; m < 4; ++m) _Pragma("unroll") for (int n = 0; n < 2; ++n) _Pragma("unroll") for (int k = 0; k < 2; ++k) \
        acc[ai][bj][m][n] = __builtin_amdgcn_mfma_f32_16x16x32_bf16(Bt[n][k], At[m][k], acc[ai][bj][m][n], 0, 0, 0); __builtin_amdgcn_s_setprio(0); } while (0)
#define PG8_WAIT_V(n) asm volatile("s_waitcnt vmcnt(" #n ")" ::: "memory")
#define PG8_WAIT_L(n) asm volatile("s_waitcnt lgkmcnt(" #n ")" ::: "memory")
#define PG8_BAR __builtin_amdgcn_s_barrier()
#define PG8_SCHED __builtin_amdgcn_sched_barrier(0)
#define PG8_OFFA(u) ((size_t)(((u).pb >> 2) * g.sAb + ((u).pb & 3) * g.sAh) * 2 + (size_t)(u).pm * tstepA)
#define PG8_OFFB(u) ((size_t)(((u).pb >> 2) * g.sBb + ((u).pb & 3) * g.sBh) * 2 + (size_t)(u).pn * tstepB)
    Unit cur, nxt; int ui = 0;
    if (!S.next(0, cur)) return;
    Acc acc;
#pragma unroll
    for (int a = 0; a < 2; ++a)
#pragma unroll
        for (int b = 0; b < 2; ++b)
#pragma unroll
            for (int m = 0; m < 4; ++m)
#pragma unroll
                for (int n = 0; n < 2; ++n) acc[a][b][m][n] = (f32x4){0.f, 0.f, 0.f, 0.f};
    bf16x8 At[4][2], B0[2][2], B1[2][2];
    const char* cA = (const char*)g.A + PG8_OFFA(cur); const char* cB = (const char*)g.Bt + PG8_OFFB(cur);
    {
        PG8_STAGE(PG8_SB(0, 0), cB, voffB); PG8_STAGE(PG8_SB(0, 1), cB + hstepB, voffB); PG8_STAGE(PG8_SA(0, 0), cA, voffA); PG8_STAGE(PG8_SA(0, 1), cA + hstepA, voffA);
        if (wr == 1) PG8_BAR;
        PG8_WAIT_V(2); PG8_BAR;
        PG8_STAGE(PG8_SB(1, 0), cB + kstep, voffB); PG8_STAGE(PG8_SA(1, 0), cA + kstep, voffA); PG8_STAGE(PG8_SB(1, 1), cB + hstepB + kstep, voffB);
        PG8_WAIT_V(6); PG8_BAR;
    }
    for (;;) {
        const bool has_next = S.next(ui + 1, nxt);
        const char* nA = has_next ? (const char*)g.A + PG8_OFFA(nxt) : cA; const char* nB = has_next ? (const char*)g.Bt + PG8_OFFB(nxt) : cB;
        for (int t = 0; t < nt; t += 2) {
            const bool last = (t == nt - 2);
            const char* a1 = cA + (size_t)(t + 1) * kstep;
            const char* a2 = last ? nA : cA + (size_t)(t + 2) * kstep; const char* b2 = last ? nB : cB + (size_t)(t + 2) * kstep;
            const char* a3 = a2 + kstep; const char* b3 = b2 + kstep;
            PG8_LDB(B0, 0, 0); PG8_LDB(B1, 0, 1); PG8_SCHED; PG8_LDA(At, 0, 0); PG8_STAGE(PG8_SA(1, 1), a1 + hstepA, voffA);
            PG8_WAIT_V(8); PG8_WAIT_L(0); PG8_BAR; PG8_MMA(0, 0, At, B0); PG8_MMA(0, 1, At, B1); PG8_BAR; PG8_SCHED;
            PG8_LDA(At, 0, 1); PG8_STAGE(PG8_SB(0, 0), b2, voffB); PG8_STAGE(PG8_SB(0, 1), b2 + hstepB, voffB); PG8_STAGE(PG8_SA(0, 0), a2, voffA);
            PG8_WAIT_V(8); PG8_WAIT_L(0); PG8_BAR; PG8_MMA(1, 0, At, B0); PG8_MMA(1, 1, At, B1); PG8_BAR; PG8_SCHED;
            PG8_LDB(B0, 1, 0); PG8_LDB(B1, 1, 1); PG8_SCHED; PG8_LDA(At, 1, 0); PG8_STAGE(PG8_SA(0, 1), a2 + hstepA, voffA);
            PG8_WAIT_V(8); PG8_WAIT_L(0); PG8_BAR; PG8_MMA(0, 0, At, B0); PG8_MMA(0, 1, At, B1); PG8_BAR; PG8_SCHED;
            PG8_LDA(At, 1, 1); PG8_STAGE(PG8_SB(1, 0), b3, voffB); PG8_STAGE(PG8_SB(1, 1), b3 + hstepB, voffB); PG8_STAGE(PG8_SA(1, 0), a3, voffA);
            PG8_WAIT_V(8); PG8_WAIT_L(0); PG8_BAR; PG8_MMA(1, 0, At, B0); PG8_MMA(1, 1, At, B1); PG8_BAR; PG8_SCHED;
        }
        if constexpr (ALIGN_EPI) { if (wr == 0) PG8_BAR; }
        if constexpr (!Epi::AFTER_DRAIN) { E(acc, cur, wr, wc, fr, fq); }
        if (!has_next) break;
#pragma unroll
        for (int a = 0; a < 2; ++a)
#pragma unroll
            for (int b = 0; b < 2; ++b)
#pragma unroll
                for (int m = 0; m < 4; ++m)
#pragma unroll
                    for (int n = 0; n < 2; ++n) acc[a][b][m][n] = (f32x4){0.f, 0.f, 0.f, 0.f};
        cur = nxt; cA = nA; cB = nB; ++ui;
        if constexpr (ALIGN_EPI) { if (wr == 1) PG8_BAR; }
    }
    PG8_WAIT_V(0);
    if constexpr (!ALIGN_EPI) { if (wr == 0) PG8_BAR; }
    PG8_BAR;
    if constexpr (Epi::AFTER_DRAIN) { E.fused(acc, cur, wr, wc, fr, fq, lds, wid, lane); }
#undef PG8_SA
#undef PG8_SB
#undef PG8_STAGE
#undef PG8_LDA
#undef PG8_LDB
#undef PG8_MMA
#undef PG8_WAIT_V
#undef PG8_WAIT_L
#undef PG8_BAR
#undef PG8_SCHED
#undef PG8_OFFA
#undef PG8_OFFB
}

struct EpiNull { static constexpr bool AFTER_DRAIN = false; float* sink; __device__ __forceinline__ void operator()(const Acc& acc, const Unit& u, int wr, int wc, int fr, int fq) const { f32x4 s = {0.f, 0.f, 0.f, 0.f};
_Pragma("unroll") for (int a = 0; a < 2; ++a) _Pragma("unroll") for (int b = 0; b < 2; ++b) _Pragma("unroll") for (int m = 0; m < 4; ++m) _Pragma("unroll") for (int n = 0; n < 2; ++n) s += acc[a][b][m][n];
 if (s[0] + s[1] + s[2] + s[3] == 1234567.25f) sink[0] = 1.f; } };
struct EpiGU {
    static constexpr bool AFTER_DRAIN = false;
    bf16_t* H; const float* ss;
    __device__ __forceinline__ void operator()(const Acc& acc, const Unit& u, int wr, int wc, int fr, int fq) const {
        const int row0 = u.pm * BM + wr * 64 + fr, col0 = u.pn * 128 + wc * 32 + fq * 8;
#pragma unroll
        for (int ai = 0; ai < 2; ++ai)
#pragma unroll
            for (int m = 0; m < 4; ++m) {
                const int row = row0 + ai * HALF + m * 16; const float rs = rstd_of(ss[row]);
                f32x4 h[2];
#pragma unroll
                for (int n = 0; n < 2; ++n) { const f32x4 gg = acc[ai][0][m][n] * rs, uu = acc[ai][1][m][n] * rs;
#pragma unroll
                    for (int j = 0; j < 4; ++j) h[n][j] = gg[j] * sigmoidf_(gg[j]) * uu[j]; }
                *(u32x4*)(H + (size_t)row * FF + col0) = pack8(h[0], h[1]);
            }
    }
};
template <bool WRITE_XB, bool WRITE_SS> struct EpiRes {
    static constexpr bool AFTER_DRAIN = false;
    const float* base; float* out; bf16_t* xb; float* ss; float scale;
    __device__ __forceinline__ void operator()(const Acc& acc, const Unit& u, int wr, int wc, int fr, int fq) const {
        const int row0 = u.pm * BM + wr * 64 + fr, col0 = u.pn * BM + wc * 32 + fq * 8;
#pragma unroll
        for (int ai = 0; ai < 2; ++ai)
#pragma unroll
            for (int m = 0; m < 4; ++m) {
                const int row = row0 + ai * HALF + m * 16; float sq = 0.f;
#pragma unroll
                for (int bj = 0; bj < 2; ++bj) { const size_t p = (size_t)row * DM + col0 + bj * HALF;
                    const f32x4 o0 = *(const f32x4*)(base + p), o1 = *(const f32x4*)(base + p + 4);
                    const f32x4 n0 = o0 + acc[ai][bj][m][0] * scale, n1 = o1 + acc[ai][bj][m][1] * scale;
                    *(f32x4*)(out + p) = n0; *(f32x4*)(out + p + 4) = n1;
                    if (WRITE_XB) *(u32x4*)(xb + p) = pack8(n0, n1);
                    if (WRITE_SS) sq += (n0[0] * n0[0] + n0[1] * n0[1]) + (n0[2] * n0[2] + n0[3] * n0[3]) + (n1[0] * n1[0] + n1[1] * n1[1]) + (n1[2] * n1[2] + n1[3] * n1[3]); }
                if (WRITE_SS) { sq += __shfl_xor(sq, 16); sq += __shfl_xor(sq, 32); if (fq == 0) unsafeAtomicAdd(ss + row, sq); }
                asm volatile("" ::: "memory");
            }
    }
};
struct EpiQKV {
    static constexpr bool AFTER_DRAIN = false;
    bf16_t *QN, *KVN, *QF, *KVF, *GAB; float* F32S; const float* ss;
    __device__ __forceinline__ void operator()(const Acc& acc, const Unit& u, int wr, int wc, int fr, int fq) const {
        const int row0 = u.pm * BM + wr * 64 + fr, pn = u.pn;
        if (pn == 19) {
            if (wc == 0) {
#pragma unroll
                for (int ai = 0; ai < 2; ++ai)
#pragma unroll
                    for (int m = 0; m < 4; ++m) { const int row = row0 + ai * HALF + m * 16; const float rs = rstd_of(ss[row]);
                        *(f32x4*)(F32S + (size_t)row * 32 + fq * 8) = acc[ai][0][m][0] * rs; *(f32x4*)(F32S + (size_t)row * 32 + fq * 8 + 4) = acc[ai][0][m][1] * rs; }
            }
            return;
        }
        bf16_t* dst; int pitch, coff;
        if (pn < 2) { dst = QN; pitch = 512; coff = pn * 256; }
        else if (pn < 5) { dst = KVN; pitch = 768; coff = (pn - 2) * 256; }
        else if (pn < 7) { dst = QF; pitch = 512; coff = (pn - 5) * 256; }
        else if (pn < 11) { dst = KVF; pitch = 1024; coff = (pn - 7) * 256; }
        else { dst = GAB; pitch = 2048; coff = (pn - 11) * 256; }
        coff += wc * 32 + fq * 8;
#pragma unroll
        for (int ai = 0; ai < 2; ++ai)
#pragma unroll
            for (int m = 0; m < 4; ++m) { const int row = row0 + ai * HALF + m * 16; const float rs = rstd_of(ss[row]);
#pragma unroll
                for (int bj = 0; bj < 2; ++bj) *(u32x4*)(dst + (size_t)row * pitch + coff + bj * HALF) = pack8(acc[ai][bj][m][0] * rs, acc[ai][bj][m][1] * rs); }
    }
};
template <int STEP> struct EpiUp {
    static constexpr bool AFTER_DRAIN = false;
    const bf16_t* GAB; bf16_t* Y;
    __device__ __forceinline__ void operator()(const Acc& acc, const Unit& u, int wr, int wc, int fr, int fq) const {
        const int row0 = u.pm * BM + wr * 64 + fr, col0 = u.pn * BM + wc * 32 + fq * 8;
#pragma unroll
        for (int ai = 0; ai < 2; ++ai)
#pragma unroll
            for (int m = 0; m < 4; ++m) { const int row = row0 + ai * HALF + m * 16;
#pragma unroll
                for (int bj = 0; bj < 2; ++bj) { const int c = col0 + bj * HALF;
                    const u32x4 gw = *(const u32x4*)(GAB + (size_t)row * 2048 + STEP * 1024 + c);
                    f32x4 v0, v1; const f32x4 a0 = acc[ai][bj][m][0], a1 = acc[ai][bj][m][1];
                    v0[0] = sigmoidf_(bflo(gw.x)) * a0[0]; v0[1] = sigmoidf_(bfhi(gw.x)) * a0[1]; v0[2] = sigmoidf_(bflo(gw.y)) * a0[2]; v0[3] = sigmoidf_(bfhi(gw.y)) * a0[3];
                    v1[0] = sigmoidf_(bflo(gw.z)) * a1[0]; v1[1] = sigmoidf_(bfhi(gw.z)) * a1[1]; v1[2] = sigmoidf_(bflo(gw.w)) * a1[2]; v1[3] = sigmoidf_(bfhi(gw.w)) * a1[3];
                    bf16_t* yp = Y + (size_t)row * DM + c;
                    if (STEP == 1) { const u32x4 y = *(const u32x4*)yp;
                        v0[0] += bflo(y.x); v0[1] += bfhi(y.x); v0[2] += bflo(y.y); v0[3] += bfhi(y.y); v1[0] += bflo(y.z); v1[1] += bfhi(y.z); v1[2] += bflo(y.w); v1[3] += bfhi(y.w); }
                    *(u32x4*)yp = pack8(v0, v1); }
                asm volatile("" ::: "memory"); }
    }
};
struct EpiRowScale {
    static constexpr bool AFTER_DRAIN = false;
    bf16_t* O; int ldo; const float* ss;
    __device__ __forceinline__ void operator()(const Acc& acc, const Unit& u, int wr, int wc, int fr, int fq) const {
        const int row0 = u.pm * BM + wr * 64 + fr, col0 = u.pn * BM + wc * 32 + fq * 8;
#pragma unroll
        for (int ai = 0; ai < 2; ++ai)
#pragma unroll
            for (int m = 0; m < 4; ++m) { const int row = row0 + ai * HALF + m * 16; const float rs = rstd_of(ss[row]);
#pragma unroll
                for (int bj = 0; bj < 2; ++bj) *(u32x4*)(O + (size_t)row * ldo + col0 + bj * HALF) = pack8(acc[ai][bj][m][0] * rs, acc[ai][bj][m][1] * rs); }
    }
};
struct EpiColScale {
    static constexpr bool AFTER_DRAIN = false;
    bf16_t* O; int ldo; const float* ss;
    __device__ __forceinline__ void operator()(const Acc& acc, const Unit& u, int wr, int wc, int fr, int fq) const {
        const int row0 = u.pm * BM + wr * 64 + fr, col0 = u.pn * BM + wc * 32 + fq * 8;
#pragma unroll
        for (int bj = 0; bj < 2; ++bj) { const int c = col0 + bj * HALF;
            f32x4 s0 = *(const f32x4*)(ss + c), s1 = *(const f32x4*)(ss + c + 4);
#pragma unroll
            for (int j = 0; j < 4; ++j) { s0[j] = rstd_of(s0[j]); s1[j] = rstd_of(s1[j]); }
#pragma unroll
            for (int ai = 0; ai < 2; ++ai)
#pragma unroll
                for (int m = 0; m < 4; ++m) { const int row = row0 + ai * HALF + m * 16;
                    *(u32x4*)(O + (size_t)row * ldo + c) = pack8(acc[ai][bj][m][0] * s0, acc[ai][bj][m][1] * s1); } }
    }
};
struct EpiBatchBf16 {
    static constexpr bool AFTER_DRAIN = false;
    bf16_t* O; int ldo; long sOb, sOh;
    __device__ __forceinline__ void operator()(const Acc& acc, const Unit& u, int wr, int wc, int fr, int fq) const {
        const int row0 = u.pm * BM + wr * 64 + fr, col0 = u.pn * BM + wc * 32 + fq * 8;
        bf16_t* Ob = O + (size_t)((u.pb >> 2) * sOb + (u.pb & 3) * sOh);
#pragma unroll
        for (int ai = 0; ai < 2; ++ai)
#pragma unroll
            for (int m = 0; m < 4; ++m) { const int row = row0 + ai * HALF + m * 16;
#pragma unroll
                for (int bj = 0; bj < 2; ++bj) *(u32x4*)(Ob + (size_t)row * ldo + col0 + bj * HALF) = pack8(acc[ai][bj][m][0], acc[ai][bj][m][1]); }
    }
};
struct EpiSoftmax {
    static constexpr bool AFTER_DRAIN = true;
    bf16_t* P;
    __device__ __forceinline__ void fused(Acc& acc, const Unit& u, int wr, int wc, int fr, int fq, LAS unsigned char* lds, int wid, int lane) const {
        LAS float* Pm = (LAS float*)lds;
        LAS float* Ps = (LAS float*)(lds + 8192);
#pragma unroll
        for (int ai = 0; ai < 2; ++ai)
#pragma unroll
            for (int m = 0; m < 4; ++m) { float mx = -3.0e38f;
#pragma unroll
                for (int bj = 0; bj < 2; ++bj)
#pragma unroll
                    for (int n = 0; n < 2; ++n) { const f32x4 x = acc[ai][bj][m][n]; mx = fmaxf(mx, fmaxf(fmaxf(x[0], x[1]), fmaxf(x[2], x[3]))); }
                mx = fmaxf(mx, __shfl_xor(mx, 16)); mx = fmaxf(mx, __shfl_xor(mx, 32));
                if (fq == 0) Pm[(ai * HALF + wr * 64 + m * 16 + fr) * 4 + wc] = mx; }
        __syncthreads();
#pragma unroll
        for (int ai = 0; ai < 2; ++ai)
#pragma unroll
            for (int m = 0; m < 4; ++m) { const int r = ai * HALF + wr * 64 + m * 16 + fr; const f32x4 t = *(const LAS f32x4*)(Pm + r * 4);
                const float mx = fmaxf(fmaxf(t[0], t[1]), fmaxf(t[2], t[3])); float s = 0.f;
#pragma unroll
                for (int bj = 0; bj < 2; ++bj)
#pragma unroll
                    for (int n = 0; n < 2; ++n) { f32x4 x = acc[ai][bj][m][n];
#pragma unroll
                        for (int j = 0; j < 4; ++j) { x[j] = fexp2(x[j] - mx); s += x[j]; }
                        acc[ai][bj][m][n] = x; }
                s += __shfl_xor(s, 16); s += __shfl_xor(s, 32);
                if (fq == 0) Ps[r * 4 + wc] = s; }
        __syncthreads();
        bf16_t* Pb = P + (size_t)u.pb * SEQ * 256;
        const int col0 = wc * 32 + fq * 8;
#pragma unroll
        for (int ai = 0; ai < 2; ++ai)
#pragma unroll
            for (int m = 0; m < 4; ++m) { const int r = ai * HALF + wr * 64 + m * 16 + fr; const f32x4 t = *(const LAS f32x4*)(Ps + r * 4);
                const float inv = 1.0f / ((t[0] + t[1]) + (t[2] + t[3])); const int row = u.pm * BM + r;
#pragma unroll
                for (int bj = 0; bj < 2; ++bj) *(u32x4*)(Pb + (size_t)row * 256 + col0 + bj * HALF) = pack8(acc[ai][bj][m][0] * inv, acc[ai][bj][m][1] * inv); }
        __syncthreads();
    }
};
struct EpiResNorm {
    static constexpr bool AFTER_DRAIN = true;
    const float* Xold; float* out; float scale; const float* gn; float* xbuf; unsigned* cnt;
    __device__ __forceinline__ void fused(Acc& acc, const Unit& u, int wr, int wc, int fr, int fq, LAS unsigned char* lds, int wid, int lane) const {
        LAS float* P = (LAS float*)lds;
        LAS float* S = (LAS float*)(lds + 4096);
        const int row0 = u.pm * BM + wr * 64 + fr, col0 = u.pn * BM + wc * 32 + fq * 8;
#pragma unroll
        for (int ai = 0; ai < 2; ++ai)
#pragma unroll
            for (int m = 0; m < 4; ++m) { const int row = row0 + ai * HALF + m * 16; float sq = 0.f;
#pragma unroll
                for (int bj = 0; bj < 2; ++bj) { const size_t p = (size_t)row * DM + col0 + bj * HALF;
                    const f32x4 o0 = *(const f32x4*)(Xold + p), o1 = *(const f32x4*)(Xold + p + 4);
                    const f32x4 n0 = o0 + acc[ai][bj][m][0] * scale, n1 = o1 + acc[ai][bj][m][1] * scale;
                    acc[ai][bj][m][0] = n0; acc[ai][bj][m][1] = n1;
                    sq += (n0[0] * n0[0] + n0[1] * n0[1]) + (n0[2] * n0[2] + n0[3] * n0[3]) + (n1[0] * n1[0] + n1[1] * n1[1]) + (n1[2] * n1[2] + n1[3] * n1[3]); }
                sq += __shfl_xor(sq, 16); sq += __shfl_xor(sq, 32);
                if (fq == 0) P[(ai * HALF + wr * 64 + m * 16 + fr) * 4 + wc] = sq;
                asm volatile("" ::: "memory"); }
        __syncthreads();
        const int prow = wid * 32 + (lane & 31);
        if (lane < 32) { const f32x4 t = *(const LAS f32x4*)(P + prow * 4);
            __hip_atomic_store(xbuf + (size_t)(u.pm * BM + prow) * 4 + u.pn, (t[0] + t[1]) + (t[2] + t[3]), __ATOMIC_RELAXED, __HIP_MEMORY_SCOPE_AGENT); }
        asm volatile("s_waitcnt vmcnt(0)" ::: "memory");
        if (lane == 0) __hip_atomic_fetch_add(cnt + 64 * u.pm, 1u, __ATOMIC_RELAXED, __HIP_MEMORY_SCOPE_AGENT);
        if (wid == 0) { unsigned sp = 0;
            while ((unsigned)__builtin_amdgcn_readfirstlane(__hip_atomic_load(cnt + 64 * u.pm, __ATOMIC_RELAXED, __HIP_MEMORY_SCOPE_AGENT)) < 32u) { __builtin_amdgcn_s_sleep(2); if (++sp > (1u << 20)) break; }
            __builtin_amdgcn_fence(__ATOMIC_ACQUIRE, "agent"); }
        asm volatile("s_waitcnt vmcnt(0) lgkmcnt(0)" ::: "memory");
        __syncthreads();
        if (lane < 32) { const float* sl = xbuf + (size_t)(u.pm * BM + prow) * 4; float s = 0.f;
#pragma unroll
            for (int t = 0; t < 4; ++t) s += __hip_atomic_load(sl + t, __ATOMIC_RELAXED, __HIP_MEMORY_SCOPE_AGENT);
            S[prow] = rstd_of(s); }
        __syncthreads();
        f32x4 gg[2][2];
#pragma unroll
        for (int bj = 0; bj < 2; ++bj) { gg[bj][0] = *(const f32x4*)(gn + col0 + bj * HALF); gg[bj][1] = *(const f32x4*)(gn + col0 + bj * HALF + 4); }
#pragma unroll
        for (int ai = 0; ai < 2; ++ai)
#pragma unroll
            for (int m = 0; m < 4; ++m) { const int r = ai * HALF + wr * 64 + m * 16 + fr; const float rs = S[r]; const size_t p0 = (size_t)(u.pm * BM + r) * DM + col0;
#pragma unroll
                for (int bj = 0; bj < 2; ++bj) { *(f32x4*)(out + p0 + bj * HALF) = acc[ai][bj][m][0] * rs * gg[bj][0]; *(f32x4*)(out + p0 + bj * HALF + 4) = acc[ai][bj][m][1] * rs * gg[bj][1]; } }
    }
};
}
namespace att {
__device__ __forceinline__ int crow(int r, int hi) { return (r & 3) + 8 * (r >> 2) + 4 * hi; }
#define SBAR() __builtin_amdgcn_sched_barrier(0)
constexpr float NEG = -INFINITY;
constexpr int L_SLOT = 0;
constexpr int L_VR = 24576;
constexpr int L_WSF = 49152;
constexpr int L_OST = L_WSF + 2048;
constexpr int L_TBL = L_OST + 32768;
constexpr int L_CB = L_TBL + 4096;
constexpr int L_PS = L_CB + 8192;
constexpr int L_IMP = L_PS + 4 * 64 * 33 * 4;
constexpr int L_MISC = L_IMP + 64 * 33 * 4;
constexpr int L_END = L_MISC + 64 + 256 + 64;
static_assert(L_END <= 147456 - 256, "attention LDS map");

__device__ __forceinline__ void qkt(f32x16& p0, f32x16& p1, const LAS unsigned char* Kslot, const bf16x8 (&qr)[4], int r32, int hi) {
    const LAS unsigned char* kb = Kslot + hi * 1024 + r32 * 16;
    p0 = f32x16{}; p1 = f32x16{};
#pragma unroll
    for (int d0 = 0; d0 < 4; ++d0) {
        const bf16x8 b0 = *(const LAS bf16x8*)(kb + d0 * 2048);
        const bf16x8 b1 = *(const LAS bf16x8*)(kb + d0 * 2048 + 512);
        p0 = __builtin_amdgcn_mfma_f32_32x32x16_bf16(b0, qr[d0], p0, 0, 0, 0);
        p1 = __builtin_amdgcn_mfma_f32_32x32x16_bf16(b1, qr[d0], p1, 0, 0, 0);
    }
}
__device__ __forceinline__ void pv(f32x16 (&o)[2], int vb, bf16x8 pa0, bf16x8 pa1, bf16x8 pa2, bf16x8 pa3) {
#pragma unroll
    for (int d0 = 0; d0 < 2; ++d0) { s16x4 lo[4], hi[4];
#pragma unroll
        for (int ks = 0; ks < 4; ++ks) {
            asm volatile("ds_read_b64_tr_b16 %0,%1 offset:%c2" : "=&v"(lo[ks]) : "v"(vb), "i"(d0 * 4096 + ks * 1024) : "memory");
            asm volatile("ds_read_b64_tr_b16 %0,%1 offset:%c2" : "=&v"(hi[ks]) : "v"(vb), "i"(d0 * 4096 + ks * 1024 + 512) : "memory"); }
        asm volatile("s_waitcnt lgkmcnt(0)" ::: "memory"); SBAR();
#define PK(k) (bf16x8){lo[k][0], lo[k][1], lo[k][2], lo[k][3], hi[k][0], hi[k][1], hi[k][2], hi[k][3]}
        o[d0] = __builtin_amdgcn_mfma_f32_32x32x16_bf16(pa0, PK(0), o[d0], 0, 0, 0);
        o[d0] = __builtin_amdgcn_mfma_f32_32x32x16_bf16(pa1, PK(1), o[d0], 0, 0, 0);
        o[d0] = __builtin_amdgcn_mfma_f32_32x32x16_bf16(pa2, PK(2), o[d0], 0, 0, 0);
        o[d0] = __builtin_amdgcn_mfma_f32_32x32x16_bf16(pa3, PK(3), o[d0], 0, 0, 0);
#undef PK
    }
}
__device__ __forceinline__ float rowmax32(const f32x16& p0, const f32x16& p1) {
    float a = fmaxf(p0[0], p1[0]);
#pragma unroll
    for (int r = 1; r < 16; ++r) a = fmaxf(a, fmaxf(p0[r], p1[r]));
    auto rr = __builtin_amdgcn_permlane32_swap(__float_as_uint(a), __float_as_uint(a), false, false);
    return fmaxf(__uint_as_float(rr[0]), __uint_as_float(rr[1]));
}
__device__ __forceinline__ float halfsum(float v) {
    auto rr = __builtin_amdgcn_permlane32_swap(__float_as_uint(v), __float_as_uint(v), false, false);
    return __uint_as_float(rr[0]) + __uint_as_float(rr[1]);
}
#define PKW(P, B) cvtpk(P[B], P[B + 1])
__device__ __forceinline__ void pack_p(const f32x16& p0, const f32x16& p1, bf16x8& a0, bf16x8& a1, bf16x8& a2, bf16x8& a3) {
    const u32x4 w0 = {PKW(p0, 0), PKW(p0, 2), PKW(p0, 4), PKW(p0, 6)}, w1 = {PKW(p0, 8), PKW(p0, 10), PKW(p0, 12), PKW(p0, 14)};
    const u32x4 w2 = {PKW(p1, 0), PKW(p1, 2), PKW(p1, 4), PKW(p1, 6)}, w3 = {PKW(p1, 8), PKW(p1, 10), PKW(p1, 12), PKW(p1, 14)};
    a0 = __builtin_bit_cast(bf16x8, w0); a1 = __builtin_bit_cast(bf16x8, w1); a2 = __builtin_bit_cast(bf16x8, w2); a3 = __builtin_bit_cast(bf16x8, w3);
}
#undef PKW
__device__ __forceinline__ void scale_rows(f32x16 (&o)[2], LAS float* wsf, float v, int r32, int hi) {
    if (hi == 0) wsf[r32] = v;
    asm volatile("s_waitcnt lgkmcnt(0)" ::: "memory");
#pragma unroll
    for (int i = 0; i < 4; ++i) { const f32x4 f = *(const LAS f32x4*)(wsf + 8 * i + 4 * hi);
#pragma unroll
        for (int j = 0; j < 4; ++j) { o[0][4 * i + j] *= f[j]; o[1][4 * i + j] *= f[j]; } }
    asm volatile("s_waitcnt lgkmcnt(0)" ::: "memory");
}
struct StageGeo { int krow, kcol, koff, vrow, vcol, voff; };
__device__ __forceinline__ StageGeo stage_geo(int tid) {
    StageGeo s; const int w = tid >> 6, ln = tid & 63;
    s.krow = ln; s.kcol = w * 8; s.koff = w * 1024 + ln * 16;
    s.vrow = 16 * (w & 3) + (ln >> 2); s.vcol = (w >> 2) * 32 + (ln & 3) * 8; s.voff = 8192 + w * 1024 + ln * 16;
    return s;
}
template <class Mod>
__device__ __forceinline__ void tile_step(const LAS unsigned char* slot, const bf16x8 (&qr)[4], f32x16 (&o)[2], float& m, float& l, LAS float* wsf, const Mod& mod, int r32, int hi, int vb) {
    f32x16 p0, p1;
    qkt(p0, p1, slot, qr, r32, hi);
    mod(p0, p1);
    const float rm = rowmax32(p0, p1);
    const float mn = fmaxf(m, rm);
    const float alpha = fexp2(m - mn);
    const bool need = __any(mn > m);
    m = mn;
    float s = 0.f;
#pragma unroll
    for (int r = 0; r < 16; ++r) { p0[r] = fexp2(p0[r] - mn); p1[r] = fexp2(p1[r] - mn); s += p0[r] + p1[r]; }
    l = l * alpha + s;
    if (need) scale_rows(o, wsf, alpha, r32, hi);
    bf16x8 a0, a1, a2, a3; pack_p(p0, p1, a0, a1, a2, a3);
    pv(o, vb, a0, a1, a2, a3);
}
template <class ModF>
__device__ __forceinline__ void attn_loop(unsigned tmask, const bf16_t* Kg, int pitchK, const bf16_t* Vg, int pitchV, LAS unsigned char* lds, const bf16x8 (&qr)[4],
                                          f32x16 (&o)[2], float& m, float& l, const ModF& modf, int wave_last_row) {
    const int tid = fresh_tid(), lane = tid & 63, r32 = lane & 31, hi = lane >> 5, wid = tid >> 6;
    const StageGeo sg = stage_geo(tid);
    LAS float* wsf = (LAS float*)(lds + L_WSF) + wid * 64;
    const int vb0 = (int)(unsigned)(size_t)(lds + L_SLOT + 8192) + ((lane >> 4) & 1) * 32 + (lane & 3) * 8 + (4 * hi + ((lane & 15) >> 2)) * 64;
    int kt = 31 - __clz((int)tmask);
    u32x4 kreg = *(const u32x4*)(Kg + (size_t)(kt * 64 + sg.krow) * pitchK + sg.kcol);
    u32x4 vreg = *(const u32x4*)(Vg + (size_t)(kt * 64 + sg.vrow) * pitchV + sg.vcol);
    *(LAS u32x4*)(lds + L_SLOT + sg.koff) = kreg; *(LAS u32x4*)(lds + L_SLOT + sg.voff) = vreg;
    __syncthreads();
    int s = 0;
    for (;;) {
        tmask &= ~(1u << kt);
        const int nk = tmask ? 31 - __clz((int)tmask) : -1;
        if (nk >= 0) { kreg = *(const u32x4*)(Kg + (size_t)(nk * 64 + sg.krow) * pitchK + sg.kcol); vreg = *(const u32x4*)(Vg + (size_t)(nk * 64 + sg.vrow) * pitchV + sg.vcol); }
        if (kt * 64 <= wave_last_row) tile_step(lds + L_SLOT + s * 16384, qr, o, m, l, wsf, modf(kt), r32, hi, vb0 + s * 16384);
        if (nk >= 0) { *(LAS u32x4*)(lds + L_SLOT + (s ^ 1) * 16384 + sg.koff) = kreg; *(LAS u32x4*)(lds + L_SLOT + (s ^ 1) * 16384 + sg.voff) = vreg; }
        __syncthreads();
        if (nk < 0) break;
        kt = nk; s ^= 1;
    }
}
template <bool ADD>
__device__ __forceinline__ void store_o(const f32x16 (&o)[2], LAS unsigned char* lds, bf16_t* dst, int pitch, const bf16_t* addsrc, int addpitch) {
    const int tid = fresh_tid(), lane = tid & 63, r32 = lane & 31, hi = lane >> 5, wid = tid >> 6;
    LAS bf16_t* stg = (LAS bf16_t*)(lds + L_OST) + wid * 2048;
#pragma unroll
    for (int r = 0; r < 16; ++r) { const int orow = crow(r, hi);
#pragma unroll
        for (int d0 = 0; d0 < 2; ++d0) stg[orow * 64 + d0 * 32 + r32] = (bf16_t)(cvtpk(o[d0][r], 0.f) & 0xffffu); }
    asm volatile("s_waitcnt lgkmcnt(0)" ::: "memory");
#pragma unroll
    for (int i = 0; i < 4; ++i) { const int row = i * 8 + (lane >> 3), ch = lane & 7;
        u32x4 v = *(const LAS u32x4*)(stg + row * 64 + ch * 8);
        if (ADD) { const u32x4 a = *(const u32x4*)(addsrc + (size_t)row * addpitch + ch * 8);
            v.x = cvtpk(bflo(v.x) + bflo(a.x), bfhi(v.x) + bfhi(a.x)); v.y = cvtpk(bflo(v.y) + bflo(a.y), bfhi(v.y) + bfhi(a.y));
            v.z = cvtpk(bflo(v.z) + bflo(a.z), bfhi(v.z) + bfhi(a.z)); v.w = cvtpk(bflo(v.w) + bflo(a.w), bfhi(v.w) + bfhi(a.w)); }
        *(u32x4*)(dst + (size_t)row * pitch + ch * 8) = v; }
    asm volatile("s_waitcnt lgkmcnt(0)" ::: "memory");
}
__device__ __forceinline__ void load_q(bf16x8 (&qr)[4], const bf16_t* Qw, int pitch, int r32, int hi) {
#pragma unroll
    for (int d0 = 0; d0 < 4; ++d0) qr[d0] = *(const bf16x8*)(Qw + (size_t)r32 * pitch + d0 * 16 + hi * 8);
}

struct ModFox { const LAS float* cb; int kbase, qpos, hi; bool diag;
    __device__ __forceinline__ void operator()(f32x16& p0, f32x16& p1) const {
#pragma unroll
        for (int i = 0; i < 4; ++i) { const f32x4 c0 = *(const LAS f32x4*)(cb + kbase + 8 * i + 4 * hi), c1 = *(const LAS f32x4*)(cb + kbase + 32 + 8 * i + 4 * hi);
#pragma unroll
            for (int j = 0; j < 4; ++j) { p0[4 * i + j] += c0[j]; p1[4 * i + j] += c1[j]; } }
        if (diag) {
#pragma unroll
            for (int r = 0; r < 16; ++r) { const int kv = kbase + crow(r, hi); if (kv > qpos) p0[r] = NEG; if (kv + 32 > qpos) p1[r] = NEG; } }
    } };
struct ModFoxF { const LAS float* cb; int qpos, hi, q0w;
    __device__ __forceinline__ ModFox operator()(int kt) const { return ModFox{cb, kt * 64, qpos, hi, kt * 64 + 63 > q0w}; } };
struct ModT5 { const LAS float* tb; int kbase, qpos, hi, window; bool enabled;
    __device__ __forceinline__ void operator()(f32x16& p0, f32x16& p1) const {
#pragma unroll
        for (int r = 0; r < 16; ++r) { const int d0 = qpos - (kbase + crow(r, hi)), d1 = d0 - 32;
            const float b0 = tb[min(max(d0, 0), 127)], b1 = tb[min(max(d1, 0), 127)];
            p0[r] = (enabled && d0 >= 0 && d0 < window) ? p0[r] + b0 : NEG;
            p1[r] = (enabled && d1 >= 0 && d1 < window) ? p1[r] + b1 : NEG; }
    } };
struct ModWinF { const LAS float* tb; int qpos, hi;
    __device__ __forceinline__ ModT5 operator()(int kt) const { return ModT5{tb, kt * 64, qpos, hi, 512, true}; } };
struct ModSelF { const LAS float* tb; int qpos, hi; unsigned mask;
    __device__ __forceinline__ ModT5 operator()(int kt) const { return ModT5{tb, kt * 64, qpos, hi, 1 << 30, ((mask >> kt) & 1u) != 0u}; } };

typedef short v4i16_t __attribute__((ext_vector_type(4)));
__device__ __forceinline__ s16x4 vtr(const LAS unsigned char* p) { return __builtin_bit_cast(s16x4, __builtin_amdgcn_ds_read_tr16_b64_v4i16((LAS v4i16_t*)p)); }
__device__ __forceinline__ void qkt_c(f32x16& p0, f32x16& p1, const LAS unsigned char* Kslot, const bf16x8 (&qr)[4], const f32x16& c0, const f32x16& c1, int r32, int hi) {
    const LAS unsigned char* kb = Kslot + hi * 1024 + r32 * 16;
    { const bf16x8 b0 = *(const LAS bf16x8*)(kb); const bf16x8 b1 = *(const LAS bf16x8*)(kb + 512);
      p0 = __builtin_amdgcn_mfma_f32_32x32x16_bf16(b0, qr[0], c0, 0, 0, 0); p1 = __builtin_amdgcn_mfma_f32_32x32x16_bf16(b1, qr[0], c1, 0, 0, 0); }
#pragma unroll
    for (int d0 = 1; d0 < 4; ++d0) {
        const bf16x8 b0 = *(const LAS bf16x8*)(kb + d0 * 2048); const bf16x8 b1 = *(const LAS bf16x8*)(kb + d0 * 2048 + 512);
        p0 = __builtin_amdgcn_mfma_f32_32x32x16_bf16(b0, qr[d0], p0, 0, 0, 0); p1 = __builtin_amdgcn_mfma_f32_32x32x16_bf16(b1, qr[d0], p1, 0, 0, 0); }
}
__device__ __forceinline__ void pv2(f32x16 (&o)[2], const LAS unsigned char* vp, bf16x8 pa0, bf16x8 pa1, bf16x8 pa2, bf16x8 pa3) {
#pragma unroll
    for (int d0 = 0; d0 < 2; ++d0) { s16x4 lo[4], hi[4];
#pragma unroll
        for (int ks = 0; ks < 4; ++ks) { lo[ks] = vtr(vp + d0 * 4096 + ks * 1024); hi[ks] = vtr(vp + d0 * 4096 + ks * 1024 + 512); }
#define PK(k) (bf16x8){lo[k][0], lo[k][1], lo[k][2], lo[k][3], hi[k][0], hi[k][1], hi[k][2], hi[k][3]}
        o[d0] = __builtin_amdgcn_mfma_f32_32x32x16_bf16(pa0, PK(0), o[d0], 0, 0, 0);
        o[d0] = __builtin_amdgcn_mfma_f32_32x32x16_bf16(pa1, PK(1), o[d0], 0, 0, 0);
        o[d0] = __builtin_amdgcn_mfma_f32_32x32x16_bf16(pa2, PK(2), o[d0], 0, 0, 0);
        o[d0] = __builtin_amdgcn_mfma_f32_32x32x16_bf16(pa3, PK(3), o[d0], 0, 0, 0);
#undef PK
    }
}
__device__ __forceinline__ float rowmax32b(const f32x16& p0, const f32x16& p1) {
    float a = __builtin_fmaxf(__builtin_fmaxf(p0[0], p0[1]), p1[0]), b = __builtin_fmaxf(__builtin_fmaxf(p0[2], p0[3]), p1[1]); a = __builtin_fmaxf(__builtin_fmaxf(a, p1[2]), p1[3]);
#pragma unroll
    for (int r = 4; r < 16; r += 4) { a = __builtin_fmaxf(__builtin_fmaxf(a, p0[r]), p0[r + 1]); b = __builtin_fmaxf(__builtin_fmaxf(b, p0[r + 2]), p0[r + 3]);
        a = __builtin_fmaxf(__builtin_fmaxf(a, p1[r]), p1[r + 1]); b = __builtin_fmaxf(__builtin_fmaxf(b, p1[r + 2]), p1[r + 3]); }
    const float m = __builtin_fmaxf(a, b);
    auto rr = __builtin_amdgcn_permlane32_swap(__float_as_uint(m), __float_as_uint(m), false, false);
    return __builtin_fmaxf(__uint_as_float(rr[0]), __uint_as_float(rr[1]));
}
constexpr float DEFER_THR = 6.0f;
#ifndef ATT_GRP
#define ATT_GRP(w) ((w) >> 2)
#endif
template <int ABL, class TF>
__device__ __forceinline__ void sm_pv(f32x16& sc0, f32x16& sc1, f32x16& sn0, f32x16& sn1, bool adjust_next, int kt, int par, bool& first, float& mref, float& l, f32x16 (&o)[2],
                                      LAS float* wsf, const LAS unsigned char* vp0, const TF& tf, int r32, int hi) {
    if (ABL & 16) { o[0][1] += sc0[3] + sc1[5]; return; }
    tf.post(kt, sc0, sc1);
    const float rm = rowmax32b(sc0, sc1);
    if (__any(first || rm > DEFER_THR)) {
        const float delta = first ? (rm == NEG ? 0.f : rm) : __builtin_fmaxf(rm, 0.f);
        mref += delta;
#pragma unroll
        for (int r = 0; r < 16; ++r) { sc0[r] -= delta; sc1[r] -= delta; }
        if (adjust_next) {
#pragma unroll
            for (int r = 0; r < 16; ++r) { sn0[r] -= delta; sn1[r] -= delta; } }
        const float f = fexp2(-delta); l *= f;
        if (!first) scale_rows(o, wsf, f, r32, hi);
        first = false;
    }
    float s = 0.f;
#pragma unroll
    for (int r = 0; r < 16; ++r) { if (!(ABL & 1)) { sc0[r] = fexp2(sc0[r]); sc1[r] = fexp2(sc1[r]); } s += sc0[r] + sc1[r]; }
    l += s;
    bf16x8 a0, a1, a2, a3; pack_p(sc0, sc1, a0, a1, a2, a3);
    if (!(ABL & 2)) pv2(o, vp0 + par * 8192, a0, a1, a2, a3); else { o[0][0] += __builtin_bit_cast(f32x4, a0)[0] + __builtin_bit_cast(f32x4, a3)[3]; }
}
__device__ __forceinline__ void glds16(const void* gsrc, unsigned lds_dst) { unsigned keep;
    asm volatile("s_mov_b32 %0, m0\n\ts_mov_b32 m0, %2\n\ts_nop 0\n\tglobal_load_lds_dwordx4 %1, off\n\ts_mov_b32 m0, %0" : "=&s"(keep) : "v"(gsrc), "s"(lds_dst) : "memory"); }
#define ATT_WAIT_BAR(N) asm volatile("s_waitcnt vmcnt(" #N ") lgkmcnt(0)\n\ts_barrier" ::: "memory")
template <int ABL = 0, class TF>
__device__ __forceinline__ void attn_loop2(unsigned tmask, const bf16_t* Kg, int pitchK, const bf16_t* Vg, int pitchV, LAS unsigned char* lds, const bf16x8 (&qr)[4],
                                           f32x16 (&o)[2], float& mref, float& l, const TF& tf, int wave_last_row) {
    const int tid = fresh_tid(), lane = tid & 63, r32 = lane & 31, hi = lane >> 5, wid = __builtin_amdgcn_readfirstlane(tid >> 6), grp = ATT_GRP(wid);
    LAS float* wsf = (LAS float*)(lds + L_WSF) + wid * 64;
    const LAS unsigned char* vp0 = lds + L_SLOT + L_VR + ((lane >> 4) & 1) * 32 + (lane & 3) * 8 + (4 * hi + ((lane & 15) >> 2)) * 64;
    const bf16_t* ksrc = Kg + (size_t)lane * pitchK + wid * 8;
    const bf16_t* vsrc = Vg + (size_t)(16 * (wid & 3) + (lane >> 2)) * pitchV + (wid >> 2) * 32 + (lane & 3) * 8;
    const unsigned ldsb = (unsigned)(size_t)(lds + L_SLOT) + (unsigned)wid * 1024u;
#define DMA_K(t, slot) glds16(ksrc + (size_t)(t) * 64 * pitchK, (unsigned)__builtin_amdgcn_readfirstlane(ldsb + (unsigned)(slot) * 8192u))
#define DMA_V(t, slot) glds16(vsrc + (size_t)(t) * 64 * pitchV, (unsigned)__builtin_amdgcn_readfirstlane(ldsb + (unsigned)L_VR + (unsigned)(slot) * 8192u))
#define NEXT_TILE(dst) do { if (tmask) { dst = 31 - __clz((int)tmask); tmask &= ~(1u << dst); } else dst = -1; } while (0)
    int t0, t1, t2, t3;
    NEXT_TILE(t0); NEXT_TILE(t1); NEXT_TILE(t2);
    const int tz = t0;
    DMA_K(t0, 0); DMA_V(t0, 0); DMA_K(t1 < 0 ? tz : t1, 1); DMA_V(t1 < 0 ? tz : t1, 1); DMA_K(t2 < 0 ? tz : t2, 2);
    ATT_WAIT_BAR(2);
    f32x16 sa0, sa1, sb0, sb1;
    bool first = true;
    mref = 0.f; l = 0.f;
    { f32x16 c0, c1; tf.cinit(t0, 0.f, c0, c1); qkt_c(sa0, sa1, lds + L_SLOT, qr, c0, c1, r32, hi); }
    asm volatile("s_waitcnt lgkmcnt(0)\n\ts_barrier" ::: "memory");
    int s0 = 0, s1 = 1, s2 = 2;
#define ATT_STEP(SC0, SC1, SN0, SN1) do { \
        NEXT_TILE(t3); \
        DMA_K(t3 < 0 ? tz : t3, s0); DMA_V(t2 < 0 ? tz : t2, s2); \
        const int t1c = t1 < 0 ? tz : t1; \
        if (grp == 0) { \
            { f32x16 c0, c1; if (ABL & 32) { c0 = f32x16{}; c1 = f32x16{}; c0[0] = mref; } else tf.cinit(t1c, mref, c0, c1); if (!(ABL & 4)) qkt_c(SN0, SN1, lds + L_SLOT + s1 * 8192, qr, c0, c1, r32, hi); else { SN0 = c0; SN1 = c1; } } \
            sm_pv<ABL>(SC0, SC1, SN0, SN1, true, t0, s0, first, mref, l, o, wsf, vp0, tf, r32, hi); \
        } else { \
            sm_pv<ABL>(SC0, SC1, SN0, SN1, false, t0, s0, first, mref, l, o, wsf, vp0, tf, r32, hi); \
            { f32x16 c0, c1; if (ABL & 32) { c0 = f32x16{}; c1 = f32x16{}; c0[0] = mref; } else tf.cinit(t1c, mref, c0, c1); if (!(ABL & 4)) qkt_c(SN0, SN1, lds + L_SLOT + s1 * 8192, qr, c0, c1, r32, hi); else { SN0 = c0; SN1 = c1; } } \
        } \
        ATT_WAIT_BAR(2); \
        t0 = t1; t1 = t2; t2 = t3; { const int s_ = s0; s0 = s1; s1 = s2; s2 = s_; } \
    } while (0)
    for (;;) {
        ATT_STEP(sa0, sa1, sb0, sb1); if (t0 < 0) break;
        ATT_STEP(sb0, sb1, sa0, sa1); if (t0 < 0) break;
    }
    asm volatile("s_waitcnt vmcnt(0)" ::: "memory");
    __syncthreads();
#undef ATT_STEP
#undef NEXT_TILE
#undef DMA_K
#undef DMA_V
}
struct TfFox { const LAS float* cb; int qpos, hi, q0w;
    __device__ __forceinline__ void cinit(int kt, float mref, f32x16& c0, f32x16& c1) const {
#pragma unroll
        for (int i = 0; i < 4; ++i) { const f32x4 a = *(const LAS f32x4*)(cb + kt * 64 + 8 * i + 4 * hi), b = *(const LAS f32x4*)(cb + kt * 64 + 32 + 8 * i + 4 * hi);
#pragma unroll
            for (int j = 0; j < 4; ++j) { c0[4 * i + j] = a[j] - mref; c1[4 * i + j] = b[j] - mref; } } }
    __device__ __forceinline__ void post(int kt, f32x16& p0, f32x16& p1) const {
        if (kt * 64 + 63 > q0w) {
#pragma unroll
            for (int r = 0; r < 16; ++r) { const int kv = kt * 64 + crow(r, hi); if (kv > qpos) p0[r] = NEG; if (kv + 32 > qpos) p1[r] = NEG; } } } };
struct TfT5 { const LAS float* tb; int qpos, hi, q0w, window; unsigned mask; bool use_mask;
    __device__ __forceinline__ void cinit(int kt, float mref, f32x16& c0, f32x16& c1) const {
        if (q0w - (kt * 64 + 63) >= 113) { const float c = tb[127] - mref;
#pragma unroll
            for (int r = 0; r < 16; ++r) { c0[r] = c; c1[r] = c; } }
        else {
#pragma unroll
            for (int r = 0; r < 16; ++r) { const int d0 = qpos - kt * 64 - crow(r, hi); c0[r] = tb[min(max(d0, 0), 127)] - mref; c1[r] = tb[min(max(d0 - 32, 0), 127)] - mref; } } }
    __device__ __forceinline__ void post(int kt, f32x16& p0, f32x16& p1) const {
        if (q0w - (kt * 64 + 63) < 0 || q0w + 31 - kt * 64 >= window) {
#pragma unroll
            for (int r = 0; r < 16; ++r) { const int d0 = qpos - kt * 64 - crow(r, hi), d1 = d0 - 32; if (d0 < 0 || d0 >= window) p0[r] = NEG; if (d1 < 0 || d1 >= window) p1[r] = NEG; } }
        if (use_mask) { const bool en = ((mask >> kt) & 1u) != 0u;
            if (!__all(en)) {
#pragma unroll
                for (int r = 0; r < 16; ++r) { p0[r] = en ? p0[r] : NEG; p1[r] = en ? p1[r] : NEG; } } } } };
}
#ifndef STAGE_LIMIT
#define STAGE_LIMIT 4
#endif
constexpr size_t MiB = 1u << 20;
constexpr size_t WS_CTL = 0, CTL_ZERO_BYTES = 2 * MiB;
constexpr size_t WS_SS = 256 * 1024;
constexpr size_t WS_SSM = 640 * 1024;
constexpr size_t WS_F32S = 2 * MiB;
constexpr size_t WS_CUM = 4 * MiB;
constexpr size_t WS_MASK = 4 * MiB + 512 * 1024;
constexpr size_t WS_UMASK = WS_MASK + 128 * 1024;
constexpr size_t WS_KC = 5 * MiB, WS_VC = 5 * MiB + 256 * 1024;
constexpr size_t WS_KMAX = 5 * MiB + 512 * 1024;
constexpr size_t WS_POSC = 704 * 1024;
constexpr size_t WS_WGU1 = 8 * MiB, WS_WD1 = 19 * MiB, WS_WIN = 25 * MiB, WS_WUPN = 35 * MiB, WS_WUPF = 36 * MiB, WS_WOUT = 37 * MiB, WS_WMQ = 39 * MiB,
                 WS_WMKV = 41 * MiB, WS_WMO = 45 * MiB, WS_WGU2 = 47 * MiB, WS_WD2 = 58 * MiB, WS_CW1K = 64 * MiB, WS_CW1V = 65 * MiB, WS_CW2K = 66 * MiB, WS_CW2V = 66 * MiB + 256 * 1024;
constexpr size_t WS_KM = 8 * MiB, WS_VT = 12 * MiB;
constexpr size_t WS_XB = 68 * MiB;
constexpr size_t WS_QN = 100 * MiB, WS_KVN = 116 * MiB, WS_QF = 140 * MiB, WS_KVF = 156 * MiB, WS_GAB = 188 * MiB;
constexpr size_t WS_H = 100 * MiB;
constexpr size_t WS_Y = WS_KVF;
constexpr size_t WS_QM = 108 * MiB, WS_PM = 188 * MiB, WS_OM = 140 * MiB;
constexpr size_t WS_MEMB = 252 * MiB, WS_END = 256 * MiB;
static_assert(WS_WD2 + (size_t)DM * FF * 2 <= WS_CW1K && WS_GAB + (size_t)M * 2048 * 2 <= WS_MEMB && WS_H + (size_t)M * FF * 2 <= WS_GAB, "ws map");
constexpr int CW_BAR = 4096;
constexpr size_t WS_XBUF = 1 * MiB;
constexpr size_t WS_FINCNT = 768 * 1024;
constexpr int RING_BYTES = 131072, LDS_BYTES = 147456;

__device__ const unsigned char T5B[128] = {0, 1, 2, 3, 4, 5, 6, 7, 8, 9, 10, 11, 12, 13, 14, 15, 16, 16, 16, 17, 17, 18, 18, 18, 19, 19, 19, 20, 20, 20, 20, 21, 21, 21, 21, 22, 22, 22, 22, 22, 23, 23, 23, 23, 23, 23, 24, 24, 24, 24, 24, 24, 25, 25, 25, 25, 25, 25, 25, 26, 26, 26, 26, 26, 26, 26, 26, 27, 27, 27, 27, 27, 27, 27, 27, 27, 27, 28, 28, 28, 28, 28, 28, 28, 28, 28, 28, 29, 29, 29, 29, 29, 29, 29, 29, 29, 29, 29, 29, 30, 30, 30, 30, 30, 30, 30, 30, 30, 30, 30, 30, 30, 30, 31, 31, 31, 31, 31, 31, 31, 31, 31, 31, 31, 31, 31, 31, 31};


#define XB_TMO      128
#define XB_XCNT(j)  (256  + 64 * (j))
#define XB_XSUB(j)  (1280 + 64 * (j))
#define XB_XGEN(j)  (2304 + 64 * (j))
#define XB_TOP      3328
#define XB_TOPGEN   3392
#define XCD_BAR_WORDS 3456
#define XB_SPIN_CAP (1u << 18)
__device__ __forceinline__ unsigned xb_ld(unsigned* p)              { return __hip_atomic_load(p, __ATOMIC_RELAXED, __HIP_MEMORY_SCOPE_AGENT); }
__device__ __forceinline__ unsigned xb_add(unsigned* p, unsigned v) { return __hip_atomic_fetch_add(p, v, __ATOMIC_RELAXED, __HIP_MEMORY_SCOPE_AGENT); }
__device__ __forceinline__ unsigned xb_xcc_id() { return (unsigned)__builtin_amdgcn_s_getreg((3 << 11) | 20) & 0xFu; }
#define XB_SPIN(cond, bar) do { unsigned _sp = 0; while (cond) { __builtin_amdgcn_s_sleep(1); \
    if ((++_sp & 255u) == 0u) { if (xb_ld(&(bar)[XB_TMO])) break; if (_sp > XB_SPIN_CAP) { atomicAdd(&(bar)[XB_TMO], 1u); break; } } } } while (0)
struct XcdBarrier { unsigned* bar; unsigned x; volatile LAS unsigned* st; };
__device__ __forceinline__ XcdBarrier xcd_barrier_post(unsigned* bar, volatile LAS unsigned* st) {
    XcdBarrier b; b.bar = bar; b.x = xb_xcc_id(); b.st = st;
    if (threadIdx.x == 0) (void)xb_add(&bar[XB_XCNT(b.x)], 1u);
    return b;
}
__device__ __forceinline__ void xcd_barrier_complete(unsigned* bar, unsigned x, unsigned& nloc, unsigned& nx) {
    const unsigned G = gridDim.x * gridDim.y * gridDim.z;
    unsigned sum, cnt, mine, sp = 0u;
    for (;;) {
        sum = 0u; cnt = 0u; mine = 0u;
#pragma unroll
        for (unsigned j = 0; j < 16; ++j) { const unsigned c = xb_ld(&bar[XB_XCNT(j)]); sum += c; cnt += (c > 0u) ? 1u : 0u; mine = (j == x) ? c : mine; }
        if (sum == G) break;
        __builtin_amdgcn_s_sleep(1);
        if ((++sp & 255u) == 0u) { if (xb_ld(&bar[XB_TMO])) break; if (sp > XB_SPIN_CAP) { atomicAdd(&bar[XB_TMO], 1u); break; } }
    }
    nloc = mine > 0u ? mine : 1u; nx = cnt > 0u ? cnt : 1u;
}
__device__ __forceinline__ void xcd_barrier(const XcdBarrier& b) {
    asm volatile("s_waitcnt vmcnt(0)" ::: "memory");
    __syncthreads();
    if (threadIdx.x == 0) {
        unsigned* bar = b.bar;
        __builtin_amdgcn_s_waitcnt(0);
        unsigned nloc = b.st[0], nx = b.st[1];
        if (nloc == 0u) { xcd_barrier_complete(bar, b.x, nloc, nx); b.st[0] = nloc; b.st[1] = nx; }
        const unsigned old = xb_add(&bar[XB_XSUB(b.x)], 1u);
        const unsigned gen = old / nloc;
        if (old + 1u == (gen + 1u) * nloc) {
            __builtin_amdgcn_fence(__ATOMIC_RELEASE, "agent");
            asm volatile("s_waitcnt vmcnt(0)" ::: "memory");
            const unsigned og = xb_add(&bar[XB_TOP], 1u);
            const unsigned tg = og / nx;
            if (og + 1u == (tg + 1u) * nx) xb_add(&bar[XB_TOPGEN], 1u);
            else XB_SPIN(xb_ld(&bar[XB_TOPGEN]) == tg, bar);
            __builtin_amdgcn_fence(__ATOMIC_ACQUIRE, "agent");
            xb_add(&bar[XB_XGEN(b.x)], 1u);
            asm volatile("s_waitcnt vmcnt(0)" ::: "memory");
        } else {
            XB_SPIN(xb_ld(&bar[XB_XGEN(b.x)]) == gen, bar);
            __builtin_amdgcn_fence(__ATOMIC_ACQUIRE, "agent");
            asm volatile("s_waitcnt vmcnt(0)" ::: "memory");
        }
    }
    __syncthreads();
}

struct Args { const float* in[29]; float* out; unsigned char* ws; int lo, hi; };
enum { I_X = 0, I_MEM, I_RELB, I_F1N, I_F1G, I_F1U, I_F1D, I_MIXN, I_WIN, I_BF, I_POSK, I_POSV, I_CK1, I_CK2, I_CV1, I_CV2, I_UPN, I_UPF, I_WOUT, I_MQN, I_MKVN, I_MWQ, I_MWKV, I_MWO, I_F2N, I_F2G, I_F2U, I_F2D, I_FINN };

__device__ __forceinline__ float wave_sum(float v) {
#pragma unroll
    for (int o = 1; o < 64; o <<= 1) v += __shfl_xor(v, o);
    return v;
}
template <class CM>
__device__ __forceinline__ void tr_item(const float* W, int ldsrc, int K, bf16_t* WT, int k0, int dstrow0, const float* gain, LAS float* scr, int lane, const CM& cm) {
    const int kr = lane >> 3, c4 = lane & 7; int sc; float scl; cm(dstrow0 + 4 * c4, sc, scl);
    f32x4 v[8]; float gk[8];
#pragma unroll
    for (int i = 0; i < 8; ++i) { const int kk = 8 * i + kr; v[i] = sc >= 0 ? *(const f32x4*)(W + (size_t)(k0 + kk) * ldsrc + sc) : (f32x4){0.f, 0.f, 0.f, 0.f}; gk[i] = gain ? gain[k0 + kk] : 1.f; }
#pragma unroll
    for (int i = 0; i < 8; ++i) { const int kk = 8 * i + kr; const float s = gk[i] * scl; LAS float* p = scr + kk * 33 + 4 * c4; p[0] = v[i][0] * s; p[1] = v[i][1] * s; p[2] = v[i][2] * s; p[3] = v[i][3] * s; }
    asm volatile("s_waitcnt lgkmcnt(0)" ::: "memory");
    const int c = lane & 7;
#pragma unroll
    for (int j = 0; j < 4; ++j) { const int nn = (lane >> 3) + 8 * j; const LAS float* s = scr + (8 * c) * 33 + nn;
        u32x4 o; o.x = cvtpk(s[0 * 33], s[1 * 33]); o.y = cvtpk(s[2 * 33], s[3 * 33]); o.z = cvtpk(s[4 * 33], s[5 * 33]); o.w = cvtpk(s[6 * 33], s[7 * 33]);
        *(u32x4*)(WT + (size_t)(dstrow0 + nn) * K + k0 + 8 * c) = o; }
    asm volatile("s_waitcnt lgkmcnt(0)" ::: "memory");
}
struct CmPlain { int off; float s; __device__ __forceinline__ void operator()(int n, int& sc, float& scl) const { sc = n + off; scl = s; } };
struct CmWin { __device__ __forceinline__ void operator()(int n, int& sc, float& scl) const {
    scl = 1.f;
    if (n < 512) { sc = n; scl = QS64; }
    else if (n < 1280) sc = n;
    else if (n < 1792) { sc = 1304 + (n - 1280); scl = QS64; }
    else if (n < 2816) sc = 1816 + (n - 1792);
    else if (n < 4864) sc = 2848 + (n - 2816);
    else if (n < 4888) sc = 1280 + (n - 4864);
    else if (n < 4896) sc = 2840 + (n - 4888);
    else sc = -1; } };
constexpr int N_GU = 16 * 176, N_D = 44 * 32, N_WIN = 16 * 160, N_UP = 8 * 32, N_SQ = 16 * 32, N_MKV = 16 * 64, N_C1 = 32 * 8, N_C2 = 4 * 2;
constexpr int CONV_NA = N_GU + N_D + N_WIN + N_MKV + 2 * N_C1 + 2 * N_C2, CONV_NB = N_GU + N_D + 2 * N_UP + 3 * N_SQ;
__device__ __forceinline__ void conv_item(const Args& a, int it, LAS float* scr, int lane) {
    unsigned char* ws = a.ws; int r = it;
    const int f = r >= CONV_NA; if (f) r -= CONV_NA;
    if (r < N_GU) { const int kb = r / 176, gi = r % 176, dr = gi * 32, tile = dr >> 8, within = dr & 255;
        const float* W = a.in[within < 128 ? (f ? I_F2G : I_F1G) : (f ? I_F2U : I_F1U)];
        tr_item(W, FF, DM, (bf16_t*)(ws + (f ? WS_WGU2 : WS_WGU1)), kb * 64, dr, a.in[f ? I_F2N : I_F1N], scr, lane, CmPlain{tile * 128 + (within & 127) - dr, 1.f}); return; }
    r -= N_GU;
    if (r < N_D) { const int kb = r / 32, gi = r % 32; tr_item(a.in[f ? I_F2D : I_F1D], DM, FF, (bf16_t*)(ws + (f ? WS_WD2 : WS_WD1)), kb * 64, gi * 32, nullptr, scr, lane, CmPlain{0, 1.f}); return; }
    r -= N_D;
    if (!f) {
        if (r < N_WIN) { const int kb = r / 160, gi = r % 160; tr_item(a.in[I_WIN], 4896, DM, (bf16_t*)(ws + WS_WIN), kb * 64, gi * 32, a.in[I_MIXN], scr, lane, CmWin{}); return; }
        r -= N_WIN;
        if (r < N_MKV) { const int kb = r / 64, gi = r % 64; tr_item(a.in[I_MWKV], 2048, DM, (bf16_t*)(ws + WS_WMKV), kb * 64, gi * 32, a.in[I_MKVN], scr, lane, CmPlain{0, 1.f}); return; }
        r -= N_MKV;
        if (r < 2 * N_C1) { const int g = r >= N_C1; r -= g * N_C1; const int kb = r / 8, gi = r % 8;
            tr_item(a.in[g ? I_CV1 : I_CK1], 256, 2048, (bf16_t*)(ws + (g ? WS_CW1V : WS_CW1K)), kb * 64, gi * 32, nullptr, scr, lane, CmPlain{0, 1.f}); return; }
        r -= 2 * N_C1;
        { const int g = r >= N_C2; r -= g * N_C2; const int kb = r / 2, gi = r % 2;
            tr_item(a.in[g ? I_CV2 : I_CK2], 64, 256, (bf16_t*)(ws + (g ? WS_CW2V : WS_CW2K)), kb * 64, gi * 32, nullptr, scr, lane, CmPlain{0, 1.f}); }
    } else {
        if (r < 2 * N_UP) { const int g = r >= N_UP; r -= g * N_UP; const int kb = r / 32, gi = r % 32;
            tr_item(a.in[g ? I_UPF : I_UPN], DM, 512, (bf16_t*)(ws + (g ? WS_WUPF : WS_WUPN)), kb * 64, gi * 32, nullptr, scr, lane, CmPlain{0, 1.f}); return; }
        r -= 2 * N_UP;
        { const int g = r / N_SQ; r -= g * N_SQ; const int kb = r / 32, gi = r % 32;
            tr_item(a.in[g == 0 ? I_WOUT : (g == 1 ? I_MWQ : I_MWO)], DM, DM, (bf16_t*)(ws + (g == 0 ? WS_WOUT : (g == 1 ? WS_WMQ : WS_WMO))), kb * 64, gi * 32, g == 1 ? a.in[I_MQN] : nullptr, scr, lane,
                    CmPlain{0, g == 1 ? QS256 : 1.f}); }
    }
}

__device__ __forceinline__ void p0_prologue(const Args& a, LAS unsigned char* lds, int gw, int NGW, int wave, int lane) {
    unsigned char* ws = a.ws;
    LAS float* scr = (LAS float*)(lds + wave * 16384);
    for (int it = gw; it < N_GU; it += NGW) conv_item(a, it, scr, lane);
    for (int mrow = gw; mrow < M + MROWS; mrow += NGW) {
        const bool ismem = mrow >= M; const int rr = ismem ? mrow - M : mrow;
        const f32x4* xr = (const f32x4*)((ismem ? a.in[I_MEM] : a.in[I_X]) + (size_t)rr * DM) + lane;
        unsigned long long* o8 = (unsigned long long*)((bf16_t*)(ws + (ismem ? WS_MEMB : WS_XB)) + (size_t)rr * DM) + lane;
        float s = 0.f; f32x4 v[4];
#pragma unroll
        for (int j = 0; j < 4; ++j) v[j] = xr[64 * j];
#pragma unroll
        for (int j = 0; j < 4; ++j) { s += (v[j][0] * v[j][0] + v[j][1] * v[j][1]) + (v[j][2] * v[j][2] + v[j][3] * v[j][3]);
            o8[64 * j] = (unsigned long long)cvtpk(v[j][0], v[j][1]) | ((unsigned long long)cvtpk(v[j][2], v[j][3]) << 32); }
        s = wave_sum(s);
        if (lane == 0) ((float*)(ws + (ismem ? WS_SSM : WS_SS)))[rr] = s;
    }
    for (int t = gw; t < 64; t += NGW) { const int kv = t >> 5, kc = (t & 31) * 64; const float* pos = a.in[kv ? I_POSV : I_POSK] + kc; const f32x4* w1 = (const f32x4*)(a.in[kv ? I_CV1 : I_CK1] + (size_t)kc * 256) + lane;
        f32x4 s = {0.f, 0.f, 0.f, 0.f};
#pragma unroll 8
        for (int k = 0; k < 64; ++k) s += w1[(size_t)k * 64] * pos[k];
        float* o = (float*)(ws + WS_POSC) + kv * 256 + 4 * lane;
        unsafeAtomicAdd(o, s[0]); unsafeAtomicAdd(o + 1, s[1]); unsafeAtomicAdd(o + 2, s[2]); unsafeAtomicAdd(o + 3, s[3]); }
}

__device__ __forceinline__ void compress_unit(const Args& a, LAS unsigned char* lds, int uidx) {
    unsigned char* ws = a.ws;
    const int tid = fresh_tid(), lane = tid & 63, r32 = lane & 31, hi = lane >> 5, wid = __builtin_amdgcn_readfirstlane(tid >> 6);
    const int kv = uidx >> 6, b = (uidx >> 3) & 7, g = (uidx >> 2) & 1, chunk = uidx & 3, n0 = chunk * 32;
    const bf16_t* W1 = (const bf16_t*)(ws + (kv ? WS_CW1V : WS_CW1K)); const bf16_t* W2 = (const bf16_t*)(ws + (kv ? WS_CW2V : WS_CW2K));
    const float* posc = (const float*)(ws + WS_POSC) + kv * 256;
    const bf16_t* asrc = (const bf16_t*)(ws + WS_KVN) + (size_t)(b * SEQ) * 768 + kv * 128 + g * 64;
    LAS bf16_t* As = (LAS bf16_t*)lds;
    for (int i = tid; i < 528 * 8; i += 512) { const int row = i >> 3, ch = i & 7; const int t = min(16 * n0 + row, SEQ - 1);
        *(LAS u32x4*)(As + row * 64 + ((ch ^ ((row >> 4) & 7)) * 8)) = *(const u32x4*)(asrc + (size_t)t * 768 + ch * 8); }
    __syncthreads();
    const bf16_t* brow = W1 + (size_t)(32 * wid + r32) * 2048 + hi * 8;
    f32x16 acc = f32x16{};
#pragma unroll 16
    for (int kk = 0; kk < 128; ++kk) { const int l = kk >> 2, dch = (kk & 3) * 2 + hi, row = 16 * r32 + l;
        const bf16x8 av = *(const LAS bf16x8*)(As + row * 64 + ((dch ^ ((row >> 4) & 7)) * 8)); const bf16x8 bv = *(const bf16x8*)(brow + kk * 16);
        acc = __builtin_amdgcn_mfma_f32_32x32x16_bf16(av, bv, acc, 0, 0, 0); }
    LAS bf16_t* Hs = (LAS bf16_t*)(lds + 81920);
    const float pc = posc[32 * wid + r32];
#pragma unroll
    for (int r = 0; r < 16; ++r) { const float x = acc[r] + pc; const float u = 0.7978845608028654f * (x + 0.044715f * x * x * x);
        const float ge = x * frcp(1.0f + fexp2(-2.0f * LOG2E * u)); Hs[att::crow(r, hi) * 264 + 32 * wid + r32] = (bf16_t)(cvtpk(ge, 0.f) & 0xffffu); }
    __syncthreads();
    if (wid < 2) { f32x16 acc2 = f32x16{};
#pragma unroll
        for (int kk = 0; kk < 16; ++kk) { const bf16x8 av = *(const LAS bf16x8*)(Hs + r32 * 264 + kk * 16 + hi * 8); const bf16x8 bv = *(const bf16x8*)(W2 + (size_t)(32 * wid + r32) * 256 + kk * 16 + hi * 8);
            acc2 = __builtin_amdgcn_mfma_f32_32x32x16_bf16(av, bv, acc2, 0, 0, 0); }
        bf16_t* outp = (bf16_t*)(ws + (kv ? WS_VC : WS_KC)) + (size_t)((b * 2 + g) * 128) * 64;
#pragma unroll
        for (int r = 0; r < 16; ++r) { const int n = n0 + att::crow(r, hi); const float v = n < 127 ? acc2[r] : 0.f; outp[(size_t)n * 64 + 32 * wid + r32] = (bf16_t)(cvtpk(v, 0.f) & 0xffffu); } }
    __syncthreads();
}
__device__ __forceinline__ void kmax_task(const Args& a, LAS unsigned char* lds, int task, int wave, int lane) {
    const int b = task >> 3, h = task & 7; float mx = 0.f;
    const bf16_t* K = (const bf16_t*)(a.ws + WS_KVF) + (size_t)(b * SEQ) * 1024 + h * 64;
#pragma unroll
    for (int rr = 0; rr < 4; ++rr) { const u32x4* p = (const u32x4*)(K + (size_t)(wave * 256 + rr * 64 + lane) * 1024); float ss = 0.f;
#pragma unroll
        for (int c = 0; c < 8; ++c) { const u32x4 v = p[c]; ss += (bflo(v.x) * bflo(v.x) + bfhi(v.x) * bfhi(v.x)) + (bflo(v.y) * bflo(v.y) + bfhi(v.y) * bfhi(v.y)) + (bflo(v.z) * bflo(v.z) + bfhi(v.z) * bfhi(v.z)) + (bflo(v.w) * bflo(v.w) + bfhi(v.w) * bfhi(v.w)); }
        mx = fmaxf(mx, ss); }
#pragma unroll
    for (int o = 1; o < 64; o <<= 1) mx = fmaxf(mx, __shfl_xor(mx, o));
    LAS float* red = (LAS float*)(lds + 120 * 1024);
    if (lane == 0) red[wave] = mx;
    __syncthreads();
    if (wave == 0 && lane == 0) { float m2 = red[0]; for (int i = 1; i < 8; ++i) m2 = fmaxf(m2, red[i]); ((float*)(a.ws + WS_KMAX))[task] = sqrtf(m2) * 1.01f; }
    __syncthreads();
}
__device__ __forceinline__ void cumsum_task(const Args& a, int task, int lane) {
    const int b = task >> 3, h = task & 7; const float bf = a.in[I_BF][h];
    const float* fl = (const float*)(a.ws + WS_F32S) + (size_t)(b * SEQ) * 32 + 24 + h; float* out = (float*)(a.ws + WS_CUM) + (size_t)task * SEQ;
    float tot = 0.f;
    for (int i = 0; i < 32; ++i) { const float v = fl[(size_t)(32 * lane + i) * 32] + bf; tot += fminf(v, 0.f) - log1pf(expf(-fabsf(v))); }
    float inc = tot;
#pragma unroll
    for (int o = 1; o < 64; o <<= 1) { const float t = __shfl_up(inc, o); if (lane >= o) inc += t; }
    float run = inc - tot;
    for (int i = 0; i < 32; ++i) { const float v = fl[(size_t)(32 * lane + i) * 32] + bf; run += fminf(v, 0.f) - log1pf(expf(-fabsf(v))); out[32 * lane + i] = -run * LOG2E; }
}

__device__ __forceinline__ void init_t5_table(const Args& a, LAS unsigned char* lds) {
    LAS float* T = (LAS float*)(lds + att::L_TBL);
    for (int i = fresh_tid(); i < 1024; i += 512) { const int h = i >> 7, d = i & 127; T[i] = a.in[I_RELB][T5B[d] * 8 + h] * LOG2E; }
}
template <bool DRY> __device__ __forceinline__ void fox_unit(const Args& a, LAS unsigned char* lds, int b, int h, int qb) {
    using namespace att;
    unsigned char* ws = a.ws;
    const int tid = fresh_tid(), lane = tid & 63, r32 = lane & 31, hi = lane >> 5, wid = __builtin_amdgcn_readfirstlane(tid >> 6);
    const int q0 = qb * 256, q0w = q0 + wid * 32, qpos = q0w + r32;
    LAS float* cb = (LAS float*)(lds + L_CB); LAS float* wsf = (LAS float*)(lds + L_WSF) + wid * 64;
    const float* cum = (const float*)(ws + WS_CUM) + (size_t)(b * 8 + h) * SEQ;
    for (int i = tid; i < q0 + 256; i += 512) cb[i] = cum[i];
    bf16_t* Qw = (bf16_t*)(ws + WS_QF) + (size_t)(b * SEQ + q0w) * 512 + h * 64;
    bf16x8 qr[4]; load_q(qr, Qw, 512, r32, hi);
    f32x16 o[2]; o[0] = f32x16{}; o[1] = f32x16{}; float m = 0.f, l = 0.f;
    const int nt = 4 * qb + 4; unsigned tmask = nt >= 32 ? 0xffffffffu : ((1u << nt) - 1u);
    const bf16_t* Kg = (const bf16_t*)(ws + WS_KVF) + (size_t)(b * SEQ) * 1024 + h * 64;
#ifndef NO_FOX_SKIP
    {
        float qq = 0.f;
#pragma unroll
        for (int d0 = 0; d0 < 4; ++d0) { const u32x4 v = __builtin_bit_cast(u32x4, qr[d0]);
            qq += (bflo(v.x) * bflo(v.x) + bfhi(v.x) * bfhi(v.x)) + (bflo(v.y) * bflo(v.y) + bfhi(v.y) * bfhi(v.y)) + (bflo(v.z) * bflo(v.z) + bfhi(v.z) * bfhi(v.z)) + (bflo(v.w) * bflo(v.w) + bfhi(v.w) * bfhi(v.w)); }
        qq = halfsum(qq);
#pragma unroll
        for (int o_ = 1; o_ < 32; o_ <<= 1) qq = fmaxf(qq, __shfl_xor(qq, o_));
        LAS float* red = (LAS float*)(lds + L_MISC + 16);
        if (lane == 0) red[wid] = qq;
        __syncthreads();
        float qmax = red[0];
#pragma unroll
        for (int i = 1; i < 8; ++i) qmax = fmaxf(qmax, red[i]);
        const float need = 2.0f * sqrtf(qmax) * 1.01f * ((const float*)(ws + WS_KMAX))[b * 8 + h] + 40.0f;
        const float cb0 = cum[q0];
        const bool skip = (lane < 32) && (lane < nt) && (cb0 - cum[64 * (lane < nt ? lane : 0) + 63] >= need);
        const unsigned long long bal = __ballot(skip);
        tmask &= ~(unsigned)bal;
        __syncthreads();
    }
#endif
#ifndef FOX_ABL
#define FOX_ABL 0
#endif
    if (DRY) attn_loop2<FOX_ABL>(tmask, Kg, 1024, Kg + 512, 1024, lds, qr, o, m, l, TfFox{cb, qpos, hi, q0w}, q0w + 31);
    else attn_loop2<0>(tmask, Kg, 1024, Kg + 512, 1024, lds, qr, o, m, l, TfFox{cb, qpos, hi, q0w}, q0w + 31);
    l = halfsum(l);
    scale_rows(o, wsf, 1.0f / l, r32, hi);
    store_o<false>(o, lds, DRY ? (bf16_t*)(ws + WS_XB + 16 * MiB) + (size_t)(b * SEQ + q0w) * 512 + h * 64 : Qw, 512, nullptr, 0);
}
template <int PARTS> __device__ __forceinline__ void cmpwin_unit(const Args& a, LAS unsigned char* lds, int b, int g, int qb) {
    using namespace att;
    unsigned char* ws = a.ws;
    const int tid = fresh_tid(), lane = tid & 63, r32 = lane & 31, hi = lane >> 5, wid = __builtin_amdgcn_readfirstlane(tid >> 6);
    const int j = wid >> 1, sub = wid & 1, hg = g * 4 + j, q0w = qb * 64 + sub * 32, qpos = q0w + r32; const size_t qrow = (size_t)b * SEQ + qpos;
    const LAS float* tb = (const LAS float*)(lds + L_TBL) + hg * 128;
    LAS float* wsf = (LAS float*)(lds + L_WSF) + wid * 64; LAS float* PS = (LAS float*)(lds + L_PS); LAS float* IMP = (LAS float*)(lds + L_IMP); LAS unsigned* MW = (LAS unsigned*)(lds + L_MISC);
    const float* gates = (const float*)(ws + WS_F32S) + qrow * 32;
    if (tid == 0) MW[0] = 0u;
    bf16x8 qr[4]; load_q(qr, (const bf16_t*)(ws + WS_QN) + (size_t)(b * SEQ + q0w) * 512 + hg * 64, 512, r32, hi);
    const StageGeo sg = stage_geo(tid);
    { const bf16_t* Kc = (const bf16_t*)(ws + WS_KC) + (size_t)((b * 2 + g) * 128) * 64; const bf16_t* Vc = (const bf16_t*)(ws + WS_VC) + (size_t)((b * 2 + g) * 128) * 64;
#pragma unroll
        for (int t = 0; t < 2; ++t) { *(LAS u32x4*)(lds + L_SLOT + t * 16384 + sg.koff) = *(const u32x4*)(Kc + (size_t)(t * 64 + sg.krow) * 64 + sg.kcol);
            *(LAS u32x4*)(lds + L_SLOT + t * 16384 + sg.voff) = *(const u32x4*)(Vc + (size_t)(t * 64 + sg.vrow) * 64 + sg.vcol); } }
    __syncthreads();
    if (PARTS & 1) {
        f32x16 oc[2]; oc[0] = f32x16{}; oc[1] = f32x16{};
        f32x16 a0, a1, b0, b1; qkt(a0, a1, lds + L_SLOT, qr, r32, hi); qkt(b0, b1, lds + L_SLOT + 16384, qr, r32, hi);
        float mx = NEG;
#pragma unroll
        for (int r = 0; r < 16; ++r) { const int d = qpos - 16 * crow(r, hi) - 31;
            a0[r] = d >= 0 ? a0[r] + tb[min(d, 127)] : NEG; a1[r] = d - 512 >= 0 ? a1[r] + tb[min(d - 512, 127)] : NEG;
            b0[r] = d - 1024 >= 0 ? b0[r] + tb[min(d - 1024, 127)] : NEG; b1[r] = d - 1536 >= 0 ? b1[r] + tb[min(d - 1536, 127)] : NEG;
            mx = fmaxf(fmaxf(mx, fmaxf(a0[r], a1[r])), fmaxf(b0[r], b1[r])); }
        { auto rr = __builtin_amdgcn_permlane32_swap(__float_as_uint(mx), __float_as_uint(mx), false, false); mx = fmaxf(__uint_as_float(rr[0]), __uint_as_float(rr[1])); }
        const float mxs = mx == NEG ? 0.f : mx; float s = 0.f;
#pragma unroll
        for (int r = 0; r < 16; ++r) { a0[r] = fexp2(a0[r] - mxs); a1[r] = fexp2(a1[r] - mxs); b0[r] = fexp2(b0[r] - mxs); b1[r] = fexp2(b1[r] - mxs); s += (a0[r] + a1[r]) + (b0[r] + b1[r]); }
        s = halfsum(s); const float inv = s > 0.f ? 1.0f / s : 0.f;
#pragma unroll
        for (int r = 0; r < 16; ++r) { a0[r] *= inv; a1[r] *= inv; b0[r] *= inv; b1[r] *= inv; }
        {
            float own[4][4], x3[4][4], rcv[4][4];
#pragma unroll
            for (int i = 0; i < 4; ++i) {
                own[0][i] = 2.0f * (a0[4 * i] + a0[4 * i + 1] + a0[4 * i + 2]) + a0[4 * i + 3]; x3[0][i] = a0[4 * i + 3];
                own[1][i] = 2.0f * (a1[4 * i] + a1[4 * i + 1] + a1[4 * i + 2]) + a1[4 * i + 3]; x3[1][i] = a1[4 * i + 3];
                own[2][i] = 2.0f * (b0[4 * i] + b0[4 * i + 1] + b0[4 * i + 2]) + b0[4 * i + 3]; x3[2][i] = b0[4 * i + 3];
                own[3][i] = 2.0f * (b1[4 * i] + b1[4 * i + 1] + b1[4 * i + 2]) + b1[4 * i + 3]; x3[3][i] = b1[4 * i + 3]; }
#pragma unroll
            for (int k = 0; k < 4; ++k)
#pragma unroll
                for (int i = 0; i < 4; ++i) { auto rr = __builtin_amdgcn_permlane32_swap(__float_as_uint(x3[k][i]), __float_as_uint(x3[k][i]), false, false); rcv[k][i] = __uint_as_float(hi ? rr[0] : rr[1]); }
            LAS float* imh = PS + j * (64 * 33) + (sub * 32 + r32) * 33 + hi;
#pragma unroll
            for (int k = 0; k < 4; ++k)
#pragma unroll
                for (int i = 0; i < 4; ++i) { const float prev = i > 0 ? rcv[k][i - 1] : (k > 0 ? rcv[k - 1][3] : 0.f);
                    imh[8 * k + 2 * i] = own[k][i] + (hi ? rcv[k][i] : prev); }
        }
        const int vb0 = (int)(unsigned)(size_t)(lds + L_SLOT + 8192) + ((lane >> 4) & 1) * 32 + (lane & 3) * 8 + (4 * hi + ((lane & 15) >> 2)) * 64;
        bf16x8 x0, x1, x2, x3; pack_p(a0, a1, x0, x1, x2, x3); pv(oc, vb0, x0, x1, x2, x3);
        pack_p(b0, b1, x0, x1, x2, x3); pv(oc, vb0 + 16384, x0, x1, x2, x3);
        scale_rows(oc, wsf, sigmoidf_(gates[hg]), r32, hi);
        store_o<false>(oc, lds, (bf16_t*)(ws + WS_XB) + (size_t)(b * SEQ + q0w) * 512 + hg * 64, 512, nullptr, 0);
    }
    __syncthreads();
    if (PARTS & 2) {
        const int q = tid >> 3, jb = (tid & 7) * 4; const LAS float* ps = PS + q * 33; LAS float* im = IMP + q * 33;
#pragma unroll
        for (int jj = 0; jj < 4; ++jj) { const int jx = jb + jj;
            const float v = (ps[jx] + ps[64 * 33 + jx]) + (ps[2 * 64 * 33 + jx] + ps[3 * 64 * 33 + jx]);
            const bool valid = jx <= qb, forced = (jx == 0) || (jx == qb) || (jx == qb - 1);
            im[jx] = valid ? v + (forced ? 1e4f : 0.f) : -1e30f; }
        __syncthreads();
        unsigned bits = 0u;
#pragma unroll
        for (int jj = 0; jj < 4; ++jj) { const int jx = jb + jj; const float v = im[jx]; int cnt = 0;
#pragma unroll
            for (int j2 = 0; j2 < 32; ++j2) { const float v2 = im[j2]; cnt += (v2 > v || (v2 == v && j2 < jx)) ? 1 : 0; }
            if (cnt < 16 && jx <= qb) bits |= 1u << jx; }
        bits |= __shfl_xor(bits, 1); bits |= __shfl_xor(bits, 2); bits |= __shfl_xor(bits, 4);
        if ((tid & 7) == 0) { MW[16 + q] = bits; __hip_atomic_fetch_or(MW, bits, __ATOMIC_RELAXED, __HIP_MEMORY_SCOPE_WORKGROUP); }
        __syncthreads();
    }
    if (PARTS & 2) {
    f32x16 o[2]; o[0] = f32x16{}; o[1] = f32x16{}; float m = 0.f, l = 0.f;
    const unsigned mask = MW[16 + sub * 32 + r32];
    const unsigned um = MW[0] & (qb >= 31 ? 0xffffffffu : ((2u << qb) - 1u));
    const bf16_t* Kg = (const bf16_t*)(ws + WS_KVN) + (size_t)(b * SEQ) * 768 + 256 + g * 64;
    attn_loop2(um, Kg, 768, Kg + 128, 768, lds, qr, o, m, l, TfT5{tb, qpos, hi, q0w, 1 << 30, mask, true}, q0w + 31);
    l = halfsum(l);
    scale_rows(o, wsf, sigmoidf_(gates[8 + hg]) / l, r32, hi);
    { bf16_t* ocw = (bf16_t*)(ws + WS_XB) + (size_t)(b * SEQ + q0w) * 512 + hg * 64; store_o<true>(o, lds, ocw, 512, ocw, 512); }
    }
    if (PARTS & 4) {
    f32x16 o[2]; o[0] = f32x16{}; o[1] = f32x16{}; float m = -1e30f, l = 0.f;
    const int lo = qb > 8 ? qb - 8 : 0; const unsigned tmask = (qb >= 31 ? 0xffffffffu : ((2u << qb) - 1u)) & ~((1u << lo) - 1u);
    const bf16_t* Kg = (const bf16_t*)(ws + WS_KVN) + (size_t)(b * SEQ) * 768 + 512 + g * 64;
    attn_loop2(tmask, Kg, 768, Kg + 128, 768, lds, qr, o, m, l, TfT5{tb, qpos, hi, q0w, 512, 0u, false}, q0w + 31);
    l = halfsum(l);
    scale_rows(o, wsf, sigmoidf_(gates[16 + hg]) / l, r32, hi);
    { const bf16_t* ocw = (const bf16_t*)(ws + WS_XB) + (size_t)(b * SEQ + q0w) * 512 + hg * 64; store_o<true>(o, lds, (bf16_t*)(ws + WS_QN) + (size_t)(b * SEQ + q0w) * 512 + hg * 64, 512, ocw, 512); }
    }
}
template <bool DRY> __device__ __forceinline__ void sel_unit(const Args& a, LAS unsigned char* lds, int b, int g, int qb) {
    using namespace att;
    unsigned char* ws = a.ws;
    const int tid = fresh_tid(), lane = tid & 63, r32 = lane & 31, hi = lane >> 5, wid = __builtin_amdgcn_readfirstlane(tid >> 6);
    const int j = wid >> 1, sub = wid & 1, hg = g * 4 + j, q0w = qb * 64 + sub * 32, qpos = q0w + r32; const size_t qrow = (size_t)b * SEQ + qpos;
    const LAS float* tb = (const LAS float*)(lds + L_TBL) + hg * 128; LAS float* wsf = (LAS float*)(lds + L_WSF) + wid * 64;
    bf16_t* Qw = (bf16_t*)(ws + WS_QN) + (size_t)(b * SEQ + q0w) * 512 + hg * 64;
    bf16x8 qr[4]; load_q(qr, Qw, 512, r32, hi);
    const unsigned mask = ((const unsigned*)(ws + WS_MASK))[(size_t)(b * 2 + g) * SEQ + qpos];
    const unsigned um = ((const unsigned*)(ws + WS_UMASK))[(b * 2 + g) * 32 + qb] & (qb >= 31 ? 0xffffffffu : ((2u << qb) - 1u));
    f32x16 o[2]; o[0] = f32x16{}; o[1] = f32x16{}; float m = -1e30f, l = 0.f;
    const bf16_t* Kg = (const bf16_t*)(ws + WS_KVN) + (size_t)(b * SEQ) * 768 + 256 + g * 64;
    attn_loop2(um, Kg, 768, Kg + 128, 768, lds, qr, o, m, l, TfT5{tb, qpos, hi, q0w, 1 << 30, mask, true}, q0w + 31);
    l = halfsum(l);
    const float g1 = sigmoidf_(((const float*)(ws + WS_F32S))[qrow * 32 + 8 + hg]);
    scale_rows(o, wsf, g1 / l, r32, hi);
    store_o<true>(o, lds, DRY ? (bf16_t*)(ws + WS_XB + 16 * MiB) + (size_t)(b * SEQ + q0w) * 512 + hg * 64 : Qw, 512, (const bf16_t*)(ws + WS_XB) + (size_t)(b * SEQ + q0w) * 512 + hg * 64, 512);
}
#ifndef PHMASK
#define PHMASK 0xffffffffu
#endif
#define PH(n) (((PHMASK) >> (n)) & 1u)
#ifndef DUPMASK
#define DUPMASK 0u
#endif
#define DUP(n) (((DUPMASK) >> (n)) & 1u)
#define REP(n) for (int rep_ = 0; rep_ < 1 + (int)DUP(n); ++rep_)
__global__ void __launch_bounds__(512, 2) hybrid_fwd(Args a) {
    extern __shared__ __attribute__((aligned(16))) unsigned char lds_raw[];
    LAS unsigned char* lds = (LAS unsigned char*)lds_raw;
    cg::grid_group grid = cg::this_grid();
    unsigned char* ws = a.ws;
    const int tid = fresh_tid(), lane = tid & 63, wave = __builtin_amdgcn_readfirstlane(tid >> 6);
    const int G = gridDim.x, bx = blockIdx.x, vcu = (G % 8 == 0) ? (bx % 8) * (G / 8) + bx / 8 : bx;
    const int gw = vcu * 8 + wave, NGW = G * 8;
    float* X = a.out;
    bf16_t* XB = (bf16_t*)(ws + WS_XB);
    float* SS = (float*)(ws + WS_SS);
    { volatile LAS unsigned* st0 = (volatile LAS unsigned*)(lds + LDS_BYTES - 256); if (tid < 32) st0[tid] = 0u; }
    __syncthreads();
    XcdBarrier xbar = xcd_barrier_post((unsigned*)(ws + WS_CTL) + CW_BAR, (volatile LAS unsigned*)(lds + LDS_BYTES - 256 + 32));
#ifdef USE_CG_SYNC
#define GSYNC() grid.sync()
#else
    if (a.lo == 0x7e57) grid.sync();
#define GSYNC() xcd_barrier(xbar)
#endif
    const float* fin_src = a.in[I_X];

#if STAGE_LIMIT >= 1
    REP(0) p0_prologue(a, lds, gw, NGW, wave, lane);
    GSYNC();
    { pg8::Gemm g{XB, (const bf16_t*)(ws + WS_WGU1), DM, DM, DM, 0, 0, 0, 0}; pg8::Order S; S.init(64, 22, 1, G, bx);
      pg8::EpiGU E{(bf16_t*)(ws + WS_H), SS};
#ifdef P1_NULLDUP
      { pg8::EpiNull E0{(float*)(ws + WS_POSC + 4096)}; pg8::gemm_phase<pg8::EpiNull, true>(lds, g, S, E0); }
#endif
      REP(1) pg8::gemm_phase<pg8::EpiGU, true>(lds, g, S, E);
      if (bx >= 128) { LAS float* scr = (LAS float*)(lds + wave * 16384); for (int it = N_GU + (bx - 128) * 8 + wave; it < CONV_NA; it += 1024) conv_item(a, it, scr, lane); } }
    GSYNC();
    { pg8::Gemm g{(const bf16_t*)(ws + WS_H), (const bf16_t*)(ws + WS_WD1), FF, FF, FF, 0, 0, 0, 0}; pg8::Order S; S.init(64, 4, 1, G, bx);
      if (DUP(2)) { pg8::EpiNull E0{(float*)(ws + WS_POSC + 4096)}; pg8::gemm_phase<pg8::EpiNull, false>(lds, g, S, E0); }
      pg8::EpiRes<true, true> E{a.in[I_X], X, XB, SS + M, 0.5f}; pg8::gemm_phase<pg8::EpiRes<true, true>, false>(lds, g, S, E); }
    GSYNC();
    fin_src = X;
#endif
#if STAGE_LIMIT >= 2
#if PH(3)
    { pg8::Gemm g{XB, (const bf16_t*)(ws + WS_WIN), DM, DM, DM, 0, 0, 0, 0}; pg8::Order S; S.init(64, 20, 1, G, bx);
      pg8::EpiQKV E{(bf16_t*)(ws + WS_QN), (bf16_t*)(ws + WS_KVN), (bf16_t*)(ws + WS_QF), (bf16_t*)(ws + WS_KVF), (bf16_t*)(ws + WS_GAB), (float*)(ws + WS_F32S), SS + M};
      REP(3) pg8::gemm_phase<pg8::EpiQKV, true>(lds, g, S, E); }
#endif
    GSYNC();
#if PH(4)
    REP(4) if (bx < 128) { compress_unit(a, lds, bx); }
    else if (bx < 192) {
        if (bx < 160) { pg8::Gemm g{(const bf16_t*)(ws + WS_MEMB), (const bf16_t*)(ws + WS_WMKV), DM, DM, DM, 0, 0, 0, 0}; pg8::Order S; S.init(8, 4, 1, 32, bx - 128);
            pg8::EpiRowScale E{(bf16_t*)(ws + WS_KM), DM, (const float*)(ws + WS_SSM)}; pg8::gemm_phase<pg8::EpiRowScale, false>(lds, g, S, E); }
        else { pg8::Gemm g{(const bf16_t*)(ws + WS_WMKV) + (size_t)DM * DM, (const bf16_t*)(ws + WS_MEMB), DM, DM, DM, 0, 0, 0, 0}; pg8::Order S; S.init(4, 8, 1, 32, bx - 160);
            pg8::EpiColScale E{(bf16_t*)(ws + WS_VT), MROWS, (const float*)(ws + WS_SSM)}; pg8::gemm_phase<pg8::EpiColScale, false>(lds, g, S, E); }
    } else { if (wave == 0) cumsum_task(a, bx - 192, lane); kmax_task(a, lds, bx - 192, wave, lane); }
    if (bx >= 128) { LAS float* scr = (LAS float*)(lds + wave * 16384); for (int it = CONV_NA + (bx - 128) * 8 + wave; it < CONV_NA + CONV_NB; it += 1024) conv_item(a, it, scr, lane); }
#endif
    GSYNC();
#if PH(5)
    init_t5_table(a, lds);
    { const int bh = vcu >> 2, s = vcu & 3; if (DUP(5)) { fox_unit<true>(a, lds, bh >> 3, bh & 7, 7 - s); fox_unit<true>(a, lds, bh >> 3, bh & 7, s); }
      fox_unit<false>(a, lds, bh >> 3, bh & 7, 7 - s); fox_unit<false>(a, lds, bh >> 3, bh & 7, s); }
#ifdef DUPPART
    { const int bg = vcu >> 4, s = vcu & 15; cmpwin_unit<DUPPART>(a, lds, bg >> 1, bg & 1, 31 - s); cmpwin_unit<DUPPART>(a, lds, bg >> 1, bg & 1, s); }
#endif
#ifndef NO_CMPWIN
    REP(15) { const int bg = vcu >> 4, s = vcu & 15; cmpwin_unit<7>(a, lds, bg >> 1, bg & 1, 31 - s); cmpwin_unit<7>(a, lds, bg >> 1, bg & 1, s); }
#endif
#endif
    GSYNC();
#if PH(7)
    REP(7) { pg8::Order S; S.init(64, 4, 1, G, bx);
      { pg8::Gemm g{(const bf16_t*)(ws + WS_QN), (const bf16_t*)(ws + WS_WUPN), 512, 512, 512, 0, 0, 0, 0}; pg8::EpiUp<0> E{(const bf16_t*)(ws + WS_GAB), (bf16_t*)(ws + WS_Y)}; pg8::gemm_phase<pg8::EpiUp<0>, false>(lds, g, S, E); }
      { pg8::Gemm g{(const bf16_t*)(ws + WS_QF), (const bf16_t*)(ws + WS_WUPF), 512, 512, 512, 0, 0, 0, 0}; pg8::EpiUp<1> E{(const bf16_t*)(ws + WS_GAB), (bf16_t*)(ws + WS_Y)}; pg8::gemm_phase<pg8::EpiUp<1>, false>(lds, g, S, E); } }
#endif
    GSYNC();
#if PH(8)
    { pg8::Gemm g{(const bf16_t*)(ws + WS_Y), (const bf16_t*)(ws + WS_WOUT), DM, DM, DM, 0, 0, 0, 0}; pg8::Order S; S.init(64, 4, 1, G, bx);
      if (DUP(8)) { pg8::EpiNull E0{(float*)(ws + WS_POSC + 4096)}; pg8::gemm_phase<pg8::EpiNull, false>(lds, g, S, E0); }
      pg8::EpiRes<true, true> E{X, X, XB, SS + 2 * M, 1.0f}; pg8::gemm_phase<pg8::EpiRes<true, true>, false>(lds, g, S, E); }
#endif
    GSYNC();
#endif
#if STAGE_LIMIT >= 3
    { pg8::Gemm g{XB, (const bf16_t*)(ws + WS_WMQ), DM, DM, DM, 0, 0, 0, 0}; pg8::Order S; S.init(64, 4, 1, G, bx);
      pg8::EpiRowScale E{(bf16_t*)(ws + WS_QM), DM, SS + 2 * M}; REP(9) pg8::gemm_phase<pg8::EpiRowScale, false>(lds, g, S, E); }
    GSYNC();
    { pg8::Gemm g{(const bf16_t*)(ws + WS_QM), (const bf16_t*)(ws + WS_KM), DM, DM, 256, (long)SEQ * DM, 256, (long)MEMLEN * DM, 256}; pg8::Order S; S.init(8, 1, 32, G, bx);
      pg8::EpiSoftmax E{(bf16_t*)(ws + WS_PM)}; REP(10) pg8::gemm_phase<pg8::EpiSoftmax, false>(lds, g, S, E); }
    GSYNC();
    { pg8::Gemm g{(const bf16_t*)(ws + WS_PM), (const bf16_t*)(ws + WS_VT), 256, MROWS, 256, (long)4 * SEQ * 256, (long)SEQ * 256, 256, (long)256 * MROWS}; pg8::Order S; S.init(8, 1, 32, G, bx);
      pg8::EpiBatchBf16 E{(bf16_t*)(ws + WS_OM), DM, (long)SEQ * DM, 256}; REP(11) pg8::gemm_phase<pg8::EpiBatchBf16, false>(lds, g, S, E); }
    GSYNC();
    { pg8::Gemm g{(const bf16_t*)(ws + WS_OM), (const bf16_t*)(ws + WS_WMO), DM, DM, DM, 0, 0, 0, 0}; pg8::Order S; S.init(64, 4, 1, G, bx);
      pg8::EpiRes<true, true> E{X, X, XB, SS + 3 * M, 1.0f}; pg8::gemm_phase<pg8::EpiRes<true, true>, false>(lds, g, S, E); }
    GSYNC();
#endif
#if STAGE_LIMIT >= 4
    { pg8::Gemm g{XB, (const bf16_t*)(ws + WS_WGU2), DM, DM, DM, 0, 0, 0, 0}; pg8::Order S; S.init(64, 22, 1, G, bx);
      pg8::EpiGU E{(bf16_t*)(ws + WS_H), SS + 3 * M}; pg8::gemm_phase<pg8::EpiGU, true>(lds, g, S, E); }
    GSYNC();
    { pg8::Gemm g{(const bf16_t*)(ws + WS_H), (const bf16_t*)(ws + WS_WD2), FF, FF, FF, 0, 0, 0, 0}; pg8::Order S; S.init(64, 4, 1, G, bx);
      pg8::EpiResNorm E{X, X, 0.5f, a.in[I_FINN], (float*)(ws + WS_XBUF), (unsigned*)(ws + WS_FINCNT)}; pg8::gemm_phase<pg8::EpiResNorm, false>(lds, g, S, E); }
    return;
#endif
#ifdef EXTRA_BARS
    for (int eb = 0; eb < EXTRA_BARS; ++eb) GSYNC();
#endif
    { const float* gn = a.in[I_FINN]; const int tid2 = fresh_tid(), lane = tid2 & 63, gw = vcu * 8 + (tid2 >> 6);
      for (int mrow = gw; mrow < M; mrow += NGW) {
          const f32x4* xr = (const f32x4*)(fin_src + (size_t)mrow * DM) + lane; f32x4* orow = (f32x4*)(X + (size_t)mrow * DM) + lane;
          f32x4 v[4]; float s = 0.f;
#pragma unroll
          for (int j = 0; j < 4; ++j) { v[j] = xr[64 * j]; s += (v[j][0] * v[j][0] + v[j][1] * v[j][1]) + (v[j][2] * v[j][2] + v[j][3] * v[j][3]); }
          const float rs = rstd_of(wave_sum(s));
#pragma unroll
          for (int j = 0; j < 4; ++j) orow[64 * j] = v[j] * rs * ((const f32x4*)gn)[lane + 64 * j];
      } }
}

extern "C" void kernel_launch(void* const* d_in, const int* in_sizes, int n_in, void* d_out, int out_size, void* d_ws, size_t ws_size, hipStream_t stream) {
    static int grid = 0;
    if (grid == 0) {
        if (n_in != 29 || out_size != M * DM || ws_size < WS_END) { fprintf(stderr, "kernel_launch: unexpected shapes (n_in %d out %d ws %zu)\n", n_in, out_size, ws_size); grid = -1; return; }
        int dev = 0, cus = 0, per_cu = 0;
        hipGetDevice(&dev); hipDeviceGetAttribute(&cus, hipDeviceAttributeMultiprocessorCount, dev);
        if (hipFuncSetAttribute((const void*)hybrid_fwd, hipFuncAttributeMaxDynamicSharedMemorySize, LDS_BYTES) != hipSuccess) { fprintf(stderr, "kernel_launch: hipFuncSetAttribute failed\n"); grid = -1; return; }
        if (hipOccupancyMaxActiveBlocksPerMultiprocessor(&per_cu, (const void*)hybrid_fwd, 512, LDS_BYTES) != hipSuccess || per_cu < 1) { fprintf(stderr, "kernel_launch: occupancy query failed (%d)\n", per_cu); per_cu = 1; }
        (void)hipGetLastError();
        grid = cus * (per_cu < 1 ? 1 : 1);
        if (grid != 256) fprintf(stderr, "kernel_launch: grid %d != 256: this kernel's phase maps assume 256 workgroups\n", grid);
    }
    if (grid < 0) return;
    hipMemsetAsync((char*)d_ws + WS_CTL, 0, CTL_ZERO_BYTES, stream);
    Args a{};
    for (int i = 0; i < 29; ++i) a.in[i] = (const float*)d_in[i];
    a.out = (float*)d_out; a.ws = (unsigned char*)d_ws; a.lo = 0; a.hi = 0;
    void* args[] = {&a};
    hipError_t e = hipLaunchCooperativeKernel((const void*)hybrid_fwd, dim3(grid), dim3(512), args, LDS_BYTES, stream);
    if (e != hipSuccess) fprintf(stderr, "kernel_launch: cooperative launch failed: %s (grid %d)\n", hipGetErrorString(e), grid);
}
```

```cpp
#define ATT_GRP(w) 0
#include <hip/hip_runtime.h>
#include <hip/hip_cooperative_groups.h>
#include <cstdio>
#include <cstdint>
namespace cg = cooperative_groups;

#define LAS __attribute__((address_space(3)))
typedef unsigned short bf16_t;
typedef short bf16x8 __attribute__((ext_vector_type(8)));
typedef short s16x4 __attribute__((ext_vector_type(4)));
typedef float f32x2 __attribute__((ext_vector_type(2)));
typedef float f32x4 __attribute__((ext_vector_type(4)));
typedef float f32x16 __attribute__((ext_vector_type(16)));
typedef unsigned u32x2 __attribute__((ext_vector_type(2)));
typedef unsigned u32x4 __attribute__((ext_vector_type(4)));
typedef __bf16 bf16x2_t __attribute__((ext_vector_type(2)));

constexpr int NB = 8, SEQ = 2048, DM = 1024, FF = 2816, M = NB * SEQ;
constexpr int MEMLEN = 256, MROWS = NB * MEMLEN;
constexpr float RMS_EPS = 1e-6f;
constexpr float LOG2E = 1.4426950408889634f;
constexpr float QS64 = 0.125f * LOG2E;
constexpr float QS256 = 0.0625f * LOG2E;

__device__ __forceinline__ int fresh_tid() { int t = threadIdx.x; asm volatile("" : "+v"(t)); return t; }
__device__ __forceinline__ unsigned cvtpk(float lo, float hi) { f32x2 v = {lo, hi}; bf16x2_t b = __builtin_convertvector(v, bf16x2_t); return __builtin_bit_cast(unsigned, b); }
__device__ __forceinline__ float bflo(unsigned w) { return __uint_as_float(w << 16); }
__device__ __forceinline__ float bfhi(unsigned w) { return __uint_as_float(w & 0xffff0000u); }
__device__ __forceinline__ u32x4 pack8(f32x4 a, f32x4 b) { u32x4 w; w.x = cvtpk(a[0], a[1]); w.y = cvtpk(a[2], a[3]); w.z = cvtpk(b[0], b[1]); w.w = cvtpk(b[2], b[3]); return w; }
__device__ __forceinline__ float fexp2(float x) { return __builtin_amdgcn_exp2f(x); }
__device__ __forceinline__ float frcp(float x) { return __builtin_amdgcn_rcpf(x); }
__device__ __forceinline__ float sigmoidf_(float x) { return frcp(1.0f + fexp2(-x * LOG2E)); }
__device__ __forceinline__ float rstd_of(float ss) { return __builtin_amdgcn_rsqf(ss * (1.0f / DM) + RMS_EPS); }

namespace pg8 {
constexpr int BM = 256, BK = 64, HALF = 128, HTB = HALF * BK * 2, STAGE_BYTES = 8 * HTB, NXCD = 8, WGM = 8;
__host__ __device__ __forceinline__ int lds_byte(int r, int c) { const int st = (r >> 4) * 2 + (c >> 5), rr = r & 15, cc = c & 31, ob = rr * 64 + cc * 2; return st * 1024 + (ob ^ (((ob >> 9) & 1) << 5)); }
__host__ __device__ __forceinline__ void stage_rc(int b, int& R, int& C) { const int st = b / 1024, sb = b % 1024, swz = sb ^ (((sb >> 9) & 1) << 5); R = (st >> 1) * 16 + swz / 64; C = (st & 1) * 32 + (swz % 64) / 2; }
__host__ __device__ __forceinline__ int perm32(int rho) { const int n = rho >> 4, i = rho & 15; return 8 * (i >> 2) + 4 * n + (i & 3); }

struct Unit { int pm, pn, pb; };
struct Gemm { const bf16_t* A; const bf16_t* Bt; int lda, ldb, K; long sAb, sAh, sBb, sBh; };

struct Order {
    int nM, nN, nwg, G, c;
    __device__ __forceinline__ void init(int nM_, int nN_, int nB_, int G_, int c_) { nM = nM_; nN = nN_; nwg = nM_ * nN_ * nB_; G = G_; c = c_; }
    __device__ __forceinline__ bool next(int i, Unit& u) const {
        if (c < 0) return false;
        const long L = (long)i * G + c; if (L >= nwg) return false;
        int wgid = (int)L; { const int q = nwg / NXCD, r = nwg % NXCD, xcd = wgid % NXCD, off = wgid / NXCD; wgid = (xcd < r ? xcd * (q + 1) : r * (q + 1) + (xcd - r) * q) + off; }
        const int per = nM * nN; u.pb = wgid / per; const int w = wgid % per;
        const int nig = WGM * nN, gid = w / nig, fm = gid * WGM, gsz = (nM - fm) < WGM ? (nM - fm) : WGM;
        u.pm = fm + ((w % nig) % gsz); u.pn = (w % nig) / gsz; return true;
    }
};

struct OneUnit { Unit u; __device__ __forceinline__ bool next(int i, Unit& o) const { if (i != 0) return false; o = u; return true; } };

typedef f32x4 Acc[2][2][4][2];

template <class Epi, bool ALIGN_EPI, class Sched>
__device__ __forceinline__ void gemm_phase(LAS unsigned char* lds, const Gemm g, const Sched& S, const Epi& E) {
    const int tid = fresh_tid(), wid = __builtin_amdgcn_readfirstlane(tid >> 6), lane = tid & 63, wr = wid >> 2, wc = wid & 3, fr = lane & 15, fq = lane >> 4;
    const int K = g.K, nt = K / BK;
    unsigned voffA[2], voffB[2];
#pragma unroll
    for (int i = 0; i < 2; ++i) { int R, C; stage_rc(tid * 16 + i * 8192, R, C); const int Rb = (R & ~31) + perm32(R & 31);
        voffA[i] = (unsigned)(R * g.lda + C) * 2u; voffB[i] = (unsigned)(Rb * g.ldb + C) * 2u; }
    const size_t kstep = (size_t)(BK * 2);
    const size_t hstepA = (size_t)HALF * g.lda * 2, hstepB = (size_t)HALF * g.ldb * 2;
    const size_t tstepA = 2 * hstepA, tstepB = 2 * hstepB;
    const unsigned ldsw = (unsigned)wid * 1024u;
    const int aoff = lds_byte(wr * 64 + fr, fq * 8), boff = lds_byte(wc * 32 + fr, fq * 8);
#define PG8_SA(b, h) (((b) * 2 + (h)) * HTB)
#define PG8_SB(b, h) ((4 + (b) * 2 + (h)) * HTB)
#define PG8_STAGE(bufoff, gbase, voff) do { _Pragma("unroll") for (int _i = 0; _i < 2; ++_i) \
        __builtin_amdgcn_global_load_lds((const unsigned*)((const char*)(gbase) + (voff)[_i]), (LAS unsigned*)(lds + (bufoff) + ldsw + _i * 8192), 16, 0, 0); } while (0)
#define PG8_LDA(dst, b, h) do { _Pragma("unroll") for (int m = 0; m < 4; ++m) _Pragma("unroll") for (int k = 0; k < 2; ++k) dst[m][k] = *(const LAS bf16x8*)(lds + PG8_SA(b, h) + aoff + m * 2048 + k * 1024); } while (0)
#define PG8_LDB(dst, b, h) do { _Pragma("unroll") for (int n = 0; n < 2; ++n) _Pragma("unroll") for (int k = 0; k < 2; ++k) dst[n][k] = *(const LAS bf16x8*)(lds + PG8_SB(b, h) + boff + n * 2048 + k * 1024); } while (0)
#define PG8_MMA(ai, bj, At, Bt) do { __builtin_amdgcn_s_setprio(1); _Pragma("unroll") for (int m = 0; m < 4; ++m) _Pragma("unroll") for (int n = 0; n < 2; ++n) _Pragma("unroll") for (int k = 0; k < 2; ++k) \
        acc[ai][bj][m][n] = __builtin_amdgcn_mfma_f32_16x16x32_bf16(Bt[n][k], At[m][k], acc[ai][bj][m][n], 0, 0, 0); __builtin_amdgcn_s_setprio(0); } while (0)
#define PG8_WAIT_V(n) asm volatile("s_waitcnt vmcnt(" #n ")" ::: "memory")
#define PG8_WAIT_L(n) asm volatile("s_waitcnt lgkmcnt(" #n ")" ::: "memory")
#define PG8_BAR __builtin_amdgcn_s_barrier()
#define PG8_SCHED __builtin_amdgcn_sched_barrier(0)
#define PG8_OFFA(u) ((size_t)(((u).pb >> 2) * g.sAb + ((u).pb & 3) * g.sAh) * 2 + (size_t)(u).pm * tstepA)
#define PG8_OFFB(u) ((size_t)(((u).pb >> 2) * g.sBb + ((u).pb & 3) * g.sBh) * 2 + (size_t)(u).pn * tstepB)
    Unit cur, nxt; int ui = 0;
    if (!S.next(0, cur)) return;
    Acc acc;
#pragma unroll
    for (int a = 0; a < 2; ++a)
#pragma unroll
        for (int b = 0; b < 2; ++b)
#pragma unroll
            for (int m = 0; m < 4; ++m)
#pragma unroll
                for (int n = 0; n < 2; ++n) acc[a][b][m][n] = (f32x4){0.f, 0.f, 0.f, 0.f};
    bf16x8 At[4][2], B0[2][2], B1[2][2];
    const char* cA = (const char*)g.A + PG8_OFFA(cur); const char* cB = (const char*)g.Bt + PG8_OFFB(cur);
    {
        PG8_STAGE(PG8_SB(0, 0), cB, voffB); PG8_STAGE(PG8_SB(0, 1), cB + hstepB, voffB); PG8_STAGE(PG8_SA(0, 0), cA, voffA); PG8_STAGE(PG8_SA(0, 1), cA + hstepA, voffA);
        if (wr == 1) PG8_BAR;
        PG8_WAIT_V(2); PG8_BAR;
        PG8_STAGE(PG8_SB(1, 0), cB + kstep, voffB); PG8_STAGE(PG8_SA(1, 0), cA + kstep, voffA); PG8_STAGE(PG8_SB(1, 1), cB + hstepB + kstep, voffB);
        PG8_WAIT_V(6); PG8_BAR;
    }
    for (;;) {
        const bool has_next = S.next(ui + 1, nxt);
        const char* nA = has_next ? (const char*)g.A + PG8_OFFA(nxt) : cA; const char* nB = has_next ? (const char*)g.Bt + PG8_OFFB(nxt) : cB;
        for (int t = 0; t < nt; t += 2) {
            const bool last = (t == nt - 2);
            const char* a1 = cA + (size_t)(t + 1) * kstep;
            const char* a2 = last ? nA : cA + (size_t)(t + 2) * kstep; const char* b2 = last ? nB : cB + (size_t)(t + 2) * kstep;
            const char* a3 = a2 + kstep; const char* b3 = b2 + kstep;
            PG8_LDB(B0, 0, 0); PG8_LDB(B1, 0, 1); PG8_SCHED; PG8_LDA(At, 0, 0); PG8_STAGE(PG8_SA(1, 1), a1 + hstepA, voffA);
            PG8_WAIT_V(8); PG8_WAIT_L(0); PG8_BAR; PG8_MMA(0, 0, At, B0); PG8_MMA(0, 1, At, B1); PG8_BAR; PG8_SCHED;
            PG8_LDA(At, 0, 1); PG8_STAGE(PG8_SB(0, 0), b2, voffB); PG8_STAGE(PG8_SB(0, 1), b2 + hstepB, voffB); PG8_STAGE(PG8_SA(0, 0), a2, voffA);
            PG8_WAIT_V(8); PG8_WAIT_L(0); PG8_BAR; PG8_MMA(1, 0, At, B0); PG8_MMA(1, 1, At, B1); PG8_BAR; PG8_SCHED;
            PG8_LDB(B0, 1, 0); PG8_LDB(B1, 1, 1); PG8_SCHED; PG8_LDA(At, 1, 0); PG8_STAGE(PG8_SA(0, 1), a2 + hstepA, voffA);
            PG8_WAIT_V(8); PG8_WAIT_L(0); PG8_BAR; PG8_MMA(0, 0, At, B0); PG8_MMA(0, 1, At, B1); PG8_BAR; PG8_SCHED;
            PG8_LDA(At, 1, 1); PG8_STAGE(PG8_SB(1, 0), b3, voffB); PG8_STAGE(PG8_SB(1, 1), b3 + hstepB, voffB); PG8_STAGE(PG8_SA(1, 0), a3, voffA);
            PG8_WAIT_V(8); PG8_WAIT_L(0); PG8_BAR; PG8_MMA(1, 0, At, B0); PG8_MMA(1, 1, At, B1); PG8_BAR; PG8_SCHED;
        }
        if constexpr (ALIGN_EPI) { if (wr == 0) PG8_BAR; }
        if constexpr (!Epi::AFTER_DRAIN) { const int l2_ = fresh_tid() & 63; E(acc, cur, wr, wc, l2_ & 15, l2_ >> 4); }
        if (!has_next) break;
#pragma unroll
        for (int a = 0; a < 2; ++a)
#pragma unroll
            for (int b = 0; b < 2; ++b)
#pragma unroll
                for (int m = 0; m < 4; ++m)
#pragma unroll
                    for (int n = 0; n < 2; ++n) acc[a][b][m][n] = (f32x4){0.f, 0.f, 0.f, 0.f};
        cur = nxt; cA = nA; cB = nB; ++ui;
        if constexpr (ALIGN_EPI) { if (wr == 1) PG8_BAR; }
    }
    PG8_WAIT_V(0);
    if constexpr (!ALIGN_EPI) { if (wr == 0) PG8_BAR; }
    PG8_BAR;
    if constexpr (Epi::AFTER_DRAIN) { const int l2_ = fresh_tid() & 63; E.fused(acc, cur, wr, wc, l2_ & 15, l2_ >> 4, lds, wid, l2_); }
#undef PG8_SA
#undef PG8_SB
#undef PG8_STAGE
#undef PG8_LDA
#undef PG8_LDB
#undef PG8_MMA
#undef PG8_WAIT_V
#undef PG8_WAIT_L
#undef PG8_BAR
#undef PG8_SCHED
#undef PG8_OFFA
#undef PG8_OFFB
}

struct EpiNull { static constexpr bool AFTER_DRAIN = false; float* sink; __device__ __forceinline__ void operator()(const Acc& acc, const Unit& u, int wr, int wc, int fr, int fq) const { f32x4 s = {0.f, 0.f, 0.f, 0.f};
_Pragma("unroll") for (int a = 0; a < 2; ++a) _Pragma("unroll") for (int b = 0; b < 2; ++b) _Pragma("unroll") for (int m = 0; m < 4; ++m) _Pragma("unroll") for (int n = 0; n < 2; ++n) s += acc[a][b][m][n];
 if (s[0] + s[1] + s[2] + s[3] == 1234567.25f) sink[0] = 1.f; } };
struct EpiGU {
    static constexpr bool AFTER_DRAIN = false;
    bf16_t* H; const float* ss;
    __device__ __forceinline__ void operator()(const Acc& acc, const Unit& u, int wr, int wc, int fr, int fq) const {
        const int row0 = u.pm * BM + wr * 64 + fr, col0 = u.pn * 128 + wc * 32 + fq * 8;
#pragma unroll
        for (int ai = 0; ai < 2; ++ai)
#pragma unroll
            for (int m = 0; m < 4; ++m) {
                const int row = row0 + ai * HALF + m * 16; const float rs = rstd_of(ss[row]);
                f32x4 h[2];
#pragma unroll
                for (int n = 0; n < 2; ++n) { const f32x4 gg = acc[ai][0][m][n] * rs, uu = acc[ai][1][m][n] * rs;
#pragma unroll
                    for (int j = 0; j < 4; ++j) h[n][j] = gg[j] * sigmoidf_(gg[j]) * uu[j]; }
                *(u32x4*)(H + (size_t)row * FF + col0) = pack8(h[0], h[1]);
            }
    }
};
template <bool WRITE_XB, bool WRITE_SS> struct EpiRes {
    static constexpr bool AFTER_DRAIN = false;
    const float* base; float* out; bf16_t* xb; float* ss; float scale;
    __device__ __forceinline__ void operator()(const Acc& acc, const Unit& u, int wr, int wc, int fr, int fq) const {
        const int row0 = u.pm * BM + wr * 64 + fr, col0 = u.pn * BM + wc * 32 + fq * 8;
#pragma unroll
        for (int ai = 0; ai < 2; ++ai)
#pragma unroll
            for (int m = 0; m < 4; ++m) {
                const int row = row0 + ai * HALF + m * 16; float sq = 0.f;
#pragma unroll
                for (int bj = 0; bj < 2; ++bj) { const size_t p = (size_t)row * DM + col0 + bj * HALF;
                    const f32x4 o0 = *(const f32x4*)(base + p), o1 = *(const f32x4*)(base + p + 4);
                    const f32x4 n0 = o0 + acc[ai][bj][m][0] * scale, n1 = o1 + acc[ai][bj][m][1] * scale;
                    *(f32x4*)(out + p) = n0; *(f32x4*)(out + p + 4) = n1;
                    if (WRITE_XB) *(u32x4*)(xb + p) = pack8(n0, n1);
                    if (WRITE_SS) sq += (n0[0] * n0[0] + n0[1] * n0[1]) + (n0[2] * n0[2] + n0[3] * n0[3]) + (n1[0] * n1[0] + n1[1] * n1[1]) + (n1[2] * n1[2] + n1[3] * n1[3]); }
                if (WRITE_SS) { sq += __shfl_xor(sq, 16); sq += __shfl_xor(sq, 32); if (fq == 0) unsafeAtomicAdd(ss + row, sq); }
                asm volatile("" ::: "memory");
            }
    }
};
struct EpiQKV {
    static constexpr bool AFTER_DRAIN = false;
    bf16_t *QN, *KVN, *QF, *KVF, *GAB; float* F32S; const float* ss;
    __device__ __forceinline__ void operator()(const Acc& acc, const Unit& u, int wr, int wc, int fr, int fq) const {
        const int row0 = u.pm * BM + wr * 64 + fr, pn = u.pn;
        if (pn == 19) {
            if (wc == 0) {
#pragma unroll
                for (int ai = 0; ai < 2; ++ai)
#pragma unroll
                    for (int m = 0; m < 4; ++m) { const int row = row0 + ai * HALF + m * 16; const float rs = rstd_of(ss[row]);
                        *(f32x4*)(F32S + (size_t)row * 32 + fq * 8) = acc[ai][0][m][0] * rs; *(f32x4*)(F32S + (size_t)row * 32 + fq * 8 + 4) = acc[ai][0][m][1] * rs; }
            }
            return;
        }
        bf16_t* dst; int pitch, coff;
        if (pn < 2) { dst = QN; pitch = 512; coff = pn * 256; }
        else if (pn < 5) { dst = KVN; pitch = 768; coff = (pn - 2) * 256; }
        else if (pn < 7) { dst = QF; pitch = 512; coff = (pn - 5) * 256; }
        else if (pn < 11) { dst = KVF; pitch = 1024; coff = (pn - 7) * 256; }
        else { dst = GAB; pitch = 2048; coff = (pn - 11) * 256; }
        coff += wc * 32 + fq * 8;
#pragma unroll
        for (int ai = 0; ai < 2; ++ai)
#pragma unroll
            for (int m = 0; m < 4; ++m) { const int row = row0 + ai * HALF + m * 16; const float rs = rstd_of(ss[row]);
#pragma unroll
                for (int bj = 0; bj < 2; ++bj) *(u32x4*)(dst + (size_t)row * pitch + coff + bj * HALF) = pack8(acc[ai][bj][m][0] * rs, acc[ai][bj][m][1] * rs); }
    }
};
template <int STEP> struct EpiUp {
    static constexpr bool AFTER_DRAIN = false;
    const bf16_t* GAB; bf16_t* Y;
    __device__ __forceinline__ void operator()(const Acc& acc, const Unit& u, int wr, int wc, int fr, int fq) const {
        const int row0 = u.pm * BM + wr * 64 + fr, col0 = u.pn * BM + wc * 32 + fq * 8;
#pragma unroll
        for (int ai = 0; ai < 2; ++ai)
#pragma unroll
            for (int m = 0; m < 4; ++m) { const int row = row0 + ai * HALF + m * 16;
#pragma unroll
                for (int bj = 0; bj < 2; ++bj) { const int c = col0 + bj * HALF;
                    const u32x4 gw = *(const u32x4*)(GAB + (size_t)row * 2048 + STEP * 1024 + c);
                    f32x4 v0, v1; const f32x4 a0 = acc[ai][bj][m][0], a1 = acc[ai][bj][m][1];
                    v0[0] = sigmoidf_(bflo(gw.x)) * a0[0]; v0[1] = sigmoidf_(bfhi(gw.x)) * a0[1]; v0[2] = sigmoidf_(bflo(gw.y)) * a0[2]; v0[3] = sigmoidf_(bfhi(gw.y)) * a0[3];
                    v1[0] = sigmoidf_(bflo(gw.z)) * a1[0]; v1[1] = sigmoidf_(bfhi(gw.z)) * a1[1]; v1[2] = sigmoidf_(bflo(gw.w)) * a1[2]; v1[3] = sigmoidf_(bfhi(gw.w)) * a1[3];
                    bf16_t* yp = Y + (size_t)row * DM + c;
                    if (STEP == 1) { const u32x4 y = *(const u32x4*)yp;
                        v0[0] += bflo(y.x); v0[1] += bfhi(y.x); v0[2] += bflo(y.y); v0[3] += bfhi(y.y); v1[0] += bflo(y.z); v1[1] += bfhi(y.z); v1[2] += bflo(y.w); v1[3] += bfhi(y.w); }
                    *(u32x4*)yp = pack8(v0, v1); }
                asm volatile("" ::: "memory"); }
    }
};
struct EpiRowScale {
    static constexpr bool AFTER_DRAIN = false;
    bf16_t* O; int ldo; const float* ss;
    __device__ __forceinline__ void operator()(const Acc& acc, const Unit& u, int wr, int wc, int fr, int fq) const {
        const int row0 = u.pm * BM + wr * 64 + fr, col0 = u.pn * BM + wc * 32 + fq * 8;
#pragma unroll
        for (int ai = 0; ai < 2; ++ai)
#pragma unroll
            for (int m = 0; m < 4; ++m) { const int row = row0 + ai * HALF + m * 16; const float rs = rstd_of(ss[row]);
#pragma unroll
                for (int bj = 0; bj < 2; ++bj) *(u32x4*)(O + (size_t)row * ldo + col0 + bj * HALF) = pack8(acc[ai][bj][m][0] * rs, acc[ai][bj][m][1] * rs); }
    }
};
struct EpiColScale {
    static constexpr bool AFTER_DRAIN = false;
    bf16_t* O; int ldo; const float* ss;
    __device__ __forceinline__ void operator()(const Acc& acc, const Unit& u, int wr, int wc, int fr, int fq) const {
        const int row0 = u.pm * BM + wr * 64 + fr, col0 = u.pn * BM + wc * 32 + fq * 8;
#pragma unroll
        for (int bj = 0; bj < 2; ++bj) { const int c = col0 + bj * HALF;
            f32x4 s0 = *(const f32x4*)(ss + c), s1 = *(const f32x4*)(ss + c + 4);
#pragma unroll
            for (int j = 0; j < 4; ++j) { s0[j] = rstd_of(s0[j]); s1[j] = rstd_of(s1[j]); }
#pragma unroll
            for (int ai = 0; ai < 2; ++ai)
#pragma unroll
                for (int m = 0; m < 4; ++m) { const int row = row0 + ai * HALF + m * 16;
                    *(u32x4*)(O + (size_t)row * ldo + c) = pack8(acc[ai][bj][m][0] * s0, acc[ai][bj][m][1] * s1); } }
    }
};
struct EpiBatchBf16 {
    static constexpr bool AFTER_DRAIN = false;
    bf16_t* O; int ldo; long sOb, sOh;
    __device__ __forceinline__ void operator()(const Acc& acc, const Unit& u, int wr, int wc, int fr, int fq) const {
        const int row0 = u.pm * BM + wr * 64 + fr, col0 = u.pn * BM + wc * 32 + fq * 8;
        bf16_t* Ob = O + (size_t)((u.pb >> 2) * sOb + (u.pb & 3) * sOh);
#pragma unroll
        for (int ai = 0; ai < 2; ++ai)
#pragma unroll
            for (int m = 0; m < 4; ++m) { const int row = row0 + ai * HALF + m * 16;
#pragma unroll
                for (int bj = 0; bj < 2; ++bj) *(u32x4*)(Ob + (size_t)row * ldo + col0 + bj * HALF) = pack8(acc[ai][bj][m][0], acc[ai][bj][m][1]); }
    }
};
struct EpiSoftmax {
    static constexpr bool AFTER_DRAIN = true;
    bf16_t* P;
    __device__ __forceinline__ void fused(Acc& acc, const Unit& u, int wr, int wc, int fr, int fq, LAS unsigned char* lds, int wid, int lane) const {
        LAS float* Pm = (LAS float*)lds;
        LAS float* Ps = (LAS float*)(lds + 8192);
#pragma unroll
        for (int ai = 0; ai < 2; ++ai)
#pragma unroll
            for (int m = 0; m < 4; ++m) { float mx = -3.0e38f;
#pragma unroll
                for (int bj = 0; bj < 2; ++bj)
#pragma unroll
                    for (int n = 0; n < 2; ++n) { const f32x4 x = acc[ai][bj][m][n]; mx = fmaxf(mx, fmaxf(fmaxf(x[0], x[1]), fmaxf(x[2], x[3]))); }
                mx = fmaxf(mx, __shfl_xor(mx, 16)); mx = fmaxf(mx, __shfl_xor(mx, 32));
                if (fq == 0) Pm[(ai * HALF + wr * 64 + m * 16 + fr) * 4 + wc] = mx; }
        __syncthreads();
#pragma unroll
        for (int ai = 0; ai < 2; ++ai)
#pragma unroll
            for (int m = 0; m < 4; ++m) { const int r = ai * HALF + wr * 64 + m * 16 + fr; const f32x4 t = *(const LAS f32x4*)(Pm + r * 4);
                const float mx = fmaxf(fmaxf(t[0], t[1]), fmaxf(t[2], t[3])); float s = 0.f;
#pragma unroll
                for (int bj = 0; bj < 2; ++bj)
#pragma unroll
                    for (int n = 0; n < 2; ++n) { f32x4 x = acc[ai][bj][m][n];
#pragma unroll
                        for (int j = 0; j < 4; ++j) { x[j] = fexp2(x[j] - mx); s += x[j]; }
                        acc[ai][bj][m][n] = x; }
                s += __shfl_xor(s, 16); s += __shfl_xor(s, 32);
                if (fq == 0) Ps[r * 4 + wc] = s; }
        __syncthreads();
        bf16_t* Pb = P + (size_t)u.pb * SEQ * 256;
        const int col0 = wc * 32 + fq * 8;
#pragma unroll
        for (int ai = 0; ai < 2; ++ai)
#pragma unroll
            for (int m = 0; m < 4; ++m) { const int r = ai * HALF + wr * 64 + m * 16 + fr; const f32x4 t = *(const LAS f32x4*)(Ps + r * 4);
                const float inv = frcp((t[0] + t[1]) + (t[2] + t[3])); const int row = u.pm * BM + r;
#pragma unroll
                for (int bj = 0; bj < 2; ++bj) *(u32x4*)(Pb + (size_t)row * 256 + col0 + bj * HALF) = pack8(acc[ai][bj][m][0] * inv, acc[ai][bj][m][1] * inv); }
        __syncthreads();
    }
};
struct EpiResNorm {
    static constexpr bool AFTER_DRAIN = true;
    const float* Xold; float* out; float scale; const float* gn; float* xbuf; unsigned* cnt;
    __device__ __forceinline__ void fused(Acc& acc, const Unit& u, int wr, int wc, int fr, int fq, LAS unsigned char* lds, int wid, int lane) const {
        LAS float* P = (LAS float*)lds;
        LAS float* S = (LAS float*)(lds + 4096);
        const int row0 = u.pm * BM + wr * 64 + fr, col0 = u.pn * BM + wc * 32 + fq * 8;
#pragma unroll
        for (int ai = 0; ai < 2; ++ai)
#pragma unroll
            for (int m = 0; m < 4; ++m) { const int row = row0 + ai * HALF + m * 16; float sq = 0.f;
#pragma unroll
                for (int bj = 0; bj < 2; ++bj) { const size_t p = (size_t)row * DM + col0 + bj * HALF;
                    const f32x4 o0 = *(const f32x4*)(Xold + p), o1 = *(const f32x4*)(Xold + p + 4);
                    const f32x4 n0 = o0 + acc[ai][bj][m][0] * scale, n1 = o1 + acc[ai][bj][m][1] * scale;
                    acc[ai][bj][m][0] = n0; acc[ai][bj][m][1] = n1;
                    sq += (n0[0] * n0[0] + n0[1] * n0[1]) + (n0[2] * n0[2] + n0[3] * n0[3]) + (n1[0] * n1[0] + n1[1] * n1[1]) + (n1[2] * n1[2] + n1[3] * n1[3]); }
                sq += __shfl_xor(sq, 16); sq += __shfl_xor(sq, 32);
                if (fq == 0) P[(ai * HALF + wr * 64 + m * 16 + fr) * 4 + wc] = sq;
                asm volatile("" ::: "memory"); }
        __syncthreads();
        const int prow = wid * 32 + (lane & 31);
        if (lane < 32) { const f32x4 t = *(const LAS f32x4*)(P + prow * 4);
            __hip_atomic_store(xbuf + (size_t)(u.pm * BM + prow) * 4 + u.pn, (t[0] + t[1]) + (t[2] + t[3]), __ATOMIC_RELAXED, __HIP_MEMORY_SCOPE_AGENT); }
        asm volatile("s_waitcnt vmcnt(0)" ::: "memory");
        if (lane == 0) __hip_atomic_fetch_add(cnt + 64 * u.pm, 1u, __ATOMIC_RELAXED, __HIP_MEMORY_SCOPE_AGENT);
        if (wid == 0) { unsigned sp = 0;
            while ((unsigned)__builtin_amdgcn_readfirstlane(__hip_atomic_load(cnt + 64 * u.pm, __ATOMIC_RELAXED, __HIP_MEMORY_SCOPE_AGENT)) < 32u) { __builtin_amdgcn_s_sleep(2); if (++sp > (1u << 20)) break; }
            __builtin_amdgcn_fence(__ATOMIC_ACQUIRE, "agent"); }
        asm volatile("s_waitcnt vmcnt(0) lgkmcnt(0)" ::: "memory");
        __syncthreads();
        if (lane < 32) { const float* sl = xbuf + (size_t)(u.pm * BM + prow) * 4; float s = 0.f;
#pragma unroll
            for (int t = 0; t < 4; ++t) s += __hip_atomic_load(sl + t, __ATOMIC_RELAXED, __HIP_MEMORY_SCOPE_AGENT);
            S[prow] = rstd_of(s); }
        __syncthreads();
        f32x4 gg[2][2];
#pragma unroll
        for (int bj = 0; bj < 2; ++bj) { gg[bj][0] = *(const f32x4*)(gn + col0 + bj * HALF); gg[bj][1] = *(const f32x4*)(gn + col0 + bj * HALF + 4); }
#pragma unroll
        for (int ai = 0; ai < 2; ++ai)
#pragma unroll
            for (int m = 0; m < 4; ++m) { const int r = ai * HALF + wr * 64 + m * 16 + fr; const float rs = S[r]; const size_t p0 = (size_t)(u.pm * BM + r) * DM + col0;
#pragma unroll
                for (int bj = 0; bj < 2; ++bj) { *(f32x4*)(out + p0 + bj * HALF) = acc[ai][bj][m][0] * rs * gg[bj][0]; *(f32x4*)(out + p0 + bj * HALF + 4) = acc[ai][bj][m][1] * rs * gg[bj][1]; } }
    }
};
}
namespace att {
__device__ __forceinline__ int crow(int r, int hi) { return (r & 3) + 8 * (r >> 2) + 4 * hi; }
#define SBAR() __builtin_amdgcn_sched_barrier(0)
constexpr float NEG = -INFINITY;
constexpr int L_SLOT = 0;
constexpr int L_VR = 24576;
constexpr int L_WSF = 49152;
constexpr int L_OST = L_WSF + 2048;
constexpr int L_TBL = L_OST + 32768;
constexpr int L_CB = L_TBL + 4096;
constexpr int L_PS = L_CB + 8192;
constexpr int L_IMP = L_PS + 4 * 64 * 33 * 4;
constexpr int L_MISC = L_IMP + 64 * 33 * 4;
constexpr int L_END = L_MISC + 64 + 256 + 64;
static_assert(L_END <= 147456 - 256, "attention LDS map");

__device__ __forceinline__ void qkt(f32x16& p0, f32x16& p1, const LAS unsigned char* Kslot, const bf16x8 (&qr)[4], int r32, int hi) {
    const LAS unsigned char* kb = Kslot + hi * 1024 + r32 * 16;
    p0 = f32x16{}; p1 = f32x16{};
#pragma unroll
    for (int d0 = 0; d0 < 4; ++d0) {
        const bf16x8 b0 = *(const LAS bf16x8*)(kb + d0 * 2048);
        const bf16x8 b1 = *(const LAS bf16x8*)(kb + d0 * 2048 + 512);
        p0 = __builtin_amdgcn_mfma_f32_32x32x16_bf16(b0, qr[d0], p0, 0, 0, 0);
        p1 = __builtin_amdgcn_mfma_f32_32x32x16_bf16(b1, qr[d0], p1, 0, 0, 0);
    }
}
__device__ __forceinline__ void pv(f32x16 (&o)[2], int vb, bf16x8 pa0, bf16x8 pa1, bf16x8 pa2, bf16x8 pa3) {
#pragma unroll
    for (int d0 = 0; d0 < 2; ++d0) { s16x4 lo[4], hi[4];
#pragma unroll
        for (int ks = 0; ks < 4; ++ks) {
            asm volatile("ds_read_b64_tr_b16 %0,%1 offset:%c2" : "=&v"(lo[ks]) : "v"(vb), "i"(d0 * 4096 + ks * 1024) : "memory");
            asm volatile("ds_read_b64_tr_b16 %0,%1 offset:%c2" : "=&v"(hi[ks]) : "v"(vb), "i"(d0 * 4096 + ks * 1024 + 512) : "memory"); }
        asm volatile("s_waitcnt lgkmcnt(0)" ::: "memory"); SBAR();
#define PK(k) (bf16x8){lo[k][0], lo[k][1], lo[k][2], lo[k][3], hi[k][0], hi[k][1], hi[k][2], hi[k][3]}
        o[d0] = __builtin_amdgcn_mfma_f32_32x32x16_bf16(pa0, PK(0), o[d0], 0, 0, 0);
        o[d0] = __builtin_amdgcn_mfma_f32_32x32x16_bf16(pa1, PK(1), o[d0], 0, 0, 0);
        o[d0] = __builtin_amdgcn_mfma_f32_32x32x16_bf16(pa2, PK(2), o[d0], 0, 0, 0);
        o[d0] = __builtin_amdgcn_mfma_f32_32x32x16_bf16(pa3, PK(3), o[d0], 0, 0, 0);
#undef PK
    }
}
__device__ __forceinline__ float rowmax32(const f32x16& p0, const f32x16& p1) {
    float a = fmaxf(p0[0], p1[0]);
#pragma unroll
    for (int r = 1; r < 16; ++r) a = fmaxf(a, fmaxf(p0[r], p1[r]));
    auto rr = __builtin_amdgcn_permlane32_swap(__float_as_uint(a), __float_as_uint(a), false, false);
    return fmaxf(__uint_as_float(rr[0]), __uint_as_float(rr[1]));
}
__device__ __forceinline__ float halfsum(float v) {
    auto rr = __builtin_amdgcn_permlane32_swap(__float_as_uint(v), __float_as_uint(v), false, false);
    return __uint_as_float(rr[0]) + __uint_as_float(rr[1]);
}
#define PKW(P, B) cvtpk(P[B], P[B + 1])
__device__ __forceinline__ void pack_p(const f32x16& p0, const f32x16& p1, bf16x8& a0, bf16x8& a1, bf16x8& a2, bf16x8& a3) {
    const u32x4 w0 = {PKW(p0, 0), PKW(p0, 2), PKW(p0, 4), PKW(p0, 6)}, w1 = {PKW(p0, 8), PKW(p0, 10), PKW(p0, 12), PKW(p0, 14)};
    const u32x4 w2 = {PKW(p1, 0), PKW(p1, 2), PKW(p1, 4), PKW(p1, 6)}, w3 = {PKW(p1, 8), PKW(p1, 10), PKW(p1, 12), PKW(p1, 14)};
    a0 = __builtin_bit_cast(bf16x8, w0); a1 = __builtin_bit_cast(bf16x8, w1); a2 = __builtin_bit_cast(bf16x8, w2); a3 = __builtin_bit_cast(bf16x8, w3);
}
#undef PKW
__device__ __forceinline__ void scale_rows(f32x16 (&o)[2], LAS float* wsf, float v, int r32, int hi) {
    if (hi == 0) wsf[r32] = v;
    asm volatile("s_waitcnt lgkmcnt(0)" ::: "memory");
#pragma unroll
    for (int i = 0; i < 4; ++i) { const f32x4 f = *(const LAS f32x4*)(wsf + 8 * i + 4 * hi);
#pragma unroll
        for (int j = 0; j < 4; ++j) { o[0][4 * i + j] *= f[j]; o[1][4 * i + j] *= f[j]; } }
    asm volatile("s_waitcnt lgkmcnt(0)" ::: "memory");
}
struct StageGeo { int krow, kcol, koff, vrow, vcol, voff; };
__device__ __forceinline__ StageGeo stage_geo(int tid) {
    StageGeo s; const int w = tid >> 6, ln = tid & 63;
    s.krow = ln; s.kcol = w * 8; s.koff = w * 1024 + ln * 16;
    s.vrow = 16 * (w & 3) + (ln >> 2); s.vcol = (w >> 2) * 32 + (ln & 3) * 8; s.voff = 8192 + w * 1024 + ln * 16;
    return s;
}
template <class Mod>
__device__ __forceinline__ void tile_step(const LAS unsigned char* slot, const bf16x8 (&qr)[4], f32x16 (&o)[2], float& m, float& l, LAS float* wsf, const Mod& mod, int r32, int hi, int vb) {
    f32x16 p0, p1;
    qkt(p0, p1, slot, qr, r32, hi);
    mod(p0, p1);
    const float rm = rowmax32(p0, p1);
    const float mn = fmaxf(m, rm);
    const float alpha = fexp2(m - mn);
    const bool need = __any(mn > m);
    m = mn;
    float s = 0.f;
#pragma unroll
    for (int r = 0; r < 16; ++r) { p0[r] = fexp2(p0[r] - mn); p1[r] = fexp2(p1[r] - mn); s += p0[r] + p1[r]; }
    l = l * alpha + s;
    if (need) scale_rows(o, wsf, alpha, r32, hi);
    bf16x8 a0, a1, a2, a3; pack_p(p0, p1, a0, a1, a2, a3);
    pv(o, vb, a0, a1, a2, a3);
}
template <class ModF>
__device__ __forceinline__ void attn_loop(unsigned tmask, const bf16_t* Kg, int pitchK, const bf16_t* Vg, int pitchV, LAS unsigned char* lds, const bf16x8 (&qr)[4],
                                          f32x16 (&o)[2], float& m, float& l, const ModF& modf, int wave_last_row) {
    const int tid = fresh_tid(), lane = tid & 63, r32 = lane & 31, hi = lane >> 5, wid = tid >> 6;
    const StageGeo sg = stage_geo(tid);
    LAS float* wsf = (LAS float*)(lds + L_WSF) + wid * 64;
    const int vb0 = (int)(unsigned)(size_t)(lds + L_SLOT + 8192) + ((lane >> 4) & 1) * 32 + (lane & 3) * 8 + (4 * hi + ((lane & 15) >> 2)) * 64;
    int kt = 31 - __clz((int)tmask);
    u32x4 kreg = *(const u32x4*)(Kg + (size_t)(kt * 64 + sg.krow) * pitchK + sg.kcol);
    u32x4 vreg = *(const u32x4*)(Vg + (size_t)(kt * 64 + sg.vrow) * pitchV + sg.vcol);
    *(LAS u32x4*)(lds + L_SLOT + sg.koff) = kreg; *(LAS u32x4*)(lds + L_SLOT + sg.voff) = vreg;
    __syncthreads();
    int s = 0;
    for (;;) {
        tmask &= ~(1u << kt);
        const int nk = tmask ? 31 - __clz((int)tmask) : -1;
        if (nk >= 0) { kreg = *(const u32x4*)(Kg + (size_t)(nk * 64 + sg.krow) * pitchK + sg.kcol); vreg = *(const u32x4*)(Vg + (size_t)(nk * 64 + sg.vrow) * pitchV + sg.vcol); }
        if (kt * 64 <= wave_last_row) tile_step(lds + L_SLOT + s * 16384, qr, o, m, l, wsf, modf(kt), r32, hi, vb0 + s * 16384);
        if (nk >= 0) { *(LAS u32x4*)(lds + L_SLOT + (s ^ 1) * 16384 + sg.koff) = kreg; *(LAS u32x4*)(lds + L_SLOT + (s ^ 1) * 16384 + sg.voff) = vreg; }
        __syncthreads();
        if (nk < 0) break;
        kt = nk; s ^= 1;
    }
}
template <bool ADD>
__device__ __forceinline__ void store_o(const f32x16 (&o)[2], LAS unsigned char* lds, bf16_t* dst, int pitch, const bf16_t* addsrc, int addpitch) {
    const int tid = fresh_tid(), lane = tid & 63, r32 = lane & 31, hi = lane >> 5, wid = tid >> 6;
    LAS bf16_t* stg = (LAS bf16_t*)(lds + L_OST) + wid * 2048;
#pragma unroll
    for (int r = 0; r < 16; ++r) { const int orow = crow(r, hi);
#pragma unroll
        for (int d0 = 0; d0 < 2; ++d0) stg[orow * 64 + d0 * 32 + r32] = (bf16_t)(cvtpk(o[d0][r], 0.f) & 0xffffu); }
    asm volatile("s_waitcnt lgkmcnt(0)" ::: "memory");
#pragma unroll
    for (int i = 0; i < 4; ++i) { const int row = i * 8 + (lane >> 3), ch = lane & 7;
        u32x4 v = *(const LAS u32x4*)(stg + row * 64 + ch * 8);
        if (ADD) { const u32x4 a = *(const u32x4*)(addsrc + (size_t)row * addpitch + ch * 8);
            v.x = cvtpk(bflo(v.x) + bflo(a.x), bfhi(v.x) + bfhi(a.x)); v.y = cvtpk(bflo(v.y) + bflo(a.y), bfhi(v.y) + bfhi(a.y));
            v.z = cvtpk(bflo(v.z) + bflo(a.z), bfhi(v.z) + bfhi(a.z)); v.w = cvtpk(bflo(v.w) + bflo(a.w), bfhi(v.w) + bfhi(a.w)); }
        *(u32x4*)(dst + (size_t)row * pitch + ch * 8) = v; }
    asm volatile("s_waitcnt lgkmcnt(0)" ::: "memory");
}
__device__ __forceinline__ void load_q(bf16x8 (&qr)[4], const bf16_t* Qw, int pitch, int r32, int hi) {
#pragma unroll
    for (int d0 = 0; d0 < 4; ++d0) qr[d0] = *(const bf16x8*)(Qw + (size_t)r32 * pitch + d0 * 16 + hi * 8);
}

struct ModFox { const LAS float* cb; int kbase, qpos, hi; bool diag;
    __device__ __forceinline__ void operator()(f32x16& p0, f32x16& p1) const {
#pragma unroll
        for (int i = 0; i < 4; ++i) { const f32x4 c0 = *(const LAS f32x4*)(cb + kbase + 8 * i + 4 * hi), c1 = *(const LAS f32x4*)(cb + kbase + 32 + 8 * i + 4 * hi);
#pragma unroll
            for (int j = 0; j < 4; ++j) { p0[4 * i + j] += c0[j]; p1[4 * i + j] += c1[j]; } }
        if (diag) {
#pragma unroll
            for (int r = 0; r < 16; ++r) { const int kv = kbase + crow(r, hi); if (kv > qpos) p0[r] = NEG; if (kv + 32 > qpos) p1[r] = NEG; } }
    } };
struct ModFoxF { const LAS float* cb; int qpos, hi, q0w;
    __device__ __forceinline__ ModFox operator()(int kt) const { return ModFox{cb, kt * 64, qpos, hi, kt * 64 + 63 > q0w}; } };
struct ModT5 { const LAS float* tb; int kbase, qpos, hi, window; bool enabled;
    __device__ __forceinline__ void operator()(f32x16& p0, f32x16& p1) const {
#pragma unroll
        for (int r = 0; r < 16; ++r) { const int d0 = qpos - (kbase + crow(r, hi)), d1 = d0 - 32;
            const float b0 = tb[min(max(d0, 0), 127)], b1 = tb[min(max(d1, 0), 127)];
            p0[r] = (enabled && d0 >= 0 && d0 < window) ? p0[r] + b0 : NEG;
            p1[r] = (enabled && d1 >= 0 && d1 < window) ? p1[r] + b1 : NEG; }
    } };
struct ModWinF { const LAS float* tb; int qpos, hi;
    __device__ __forceinline__ ModT5 operator()(int kt) const { return ModT5{tb, kt * 64, qpos, hi, 512, true}; } };
struct ModSelF { const LAS float* tb; int qpos, hi; unsigned mask;
    __device__ __forceinline__ ModT5 operator()(int kt) const { return ModT5{tb, kt * 64, qpos, hi, 1 << 30, ((mask >> kt) & 1u) != 0u}; } };

typedef short v4i16_t __attribute__((ext_vector_type(4)));
__device__ __forceinline__ s16x4 vtr(const LAS unsigned char* p) { return __builtin_bit_cast(s16x4, __builtin_amdgcn_ds_read_tr16_b64_v4i16((LAS v4i16_t*)p)); }
__device__ __forceinline__ void qkt_c(f32x16& p0, f32x16& p1, const LAS unsigned char* Kslot, const bf16x8 (&qr)[4], const f32x16& c0, const f32x16& c1, int r32, int hi) {
    const LAS unsigned char* kb = Kslot + hi * 1024 + r32 * 16;
    { const bf16x8 b0 = *(const LAS bf16x8*)(kb); const bf16x8 b1 = *(const LAS bf16x8*)(kb + 512);
      p0 = __builtin_amdgcn_mfma_f32_32x32x16_bf16(b0, qr[0], c0, 0, 0, 0); p1 = __builtin_amdgcn_mfma_f32_32x32x16_bf16(b1, qr[0], c1, 0, 0, 0); }
#pragma unroll
    for (int d0 = 1; d0 < 4; ++d0) {
        const bf16x8 b0 = *(const LAS bf16x8*)(kb + d0 * 2048); const bf16x8 b1 = *(const LAS bf16x8*)(kb + d0 * 2048 + 512);
        p0 = __builtin_amdgcn_mfma_f32_32x32x16_bf16(b0, qr[d0], p0, 0, 0, 0); p1 = __builtin_amdgcn_mfma_f32_32x32x16_bf16(b1, qr[d0], p1, 0, 0, 0); }
}
__device__ __forceinline__ void pv2(f32x16 (&o)[2], const LAS unsigned char* vp, bf16x8 pa0, bf16x8 pa1, bf16x8 pa2, bf16x8 pa3) {
#pragma unroll
    for (int d0 = 0; d0 < 2; ++d0) { s16x4 lo[4], hi[4];
#pragma unroll
        for (int ks = 0; ks < 4; ++ks) { lo[ks] = vtr(vp + d0 * 4096 + ks * 1024); hi[ks] = vtr(vp + d0 * 4096 + ks * 1024 + 512); }
#define PK(k) (bf16x8){lo[k][0], lo[k][1], lo[k][2], lo[k][3], hi[k][0], hi[k][1], hi[k][2], hi[k][3]}
        o[d0] = __builtin_amdgcn_mfma_f32_32x32x16_bf16(pa0, PK(0), o[d0], 0, 0, 0);
        o[d0] = __builtin_amdgcn_mfma_f32_32x32x16_bf16(pa1, PK(1), o[d0], 0, 0, 0);
        o[d0] = __builtin_amdgcn_mfma_f32_32x32x16_bf16(pa2, PK(2), o[d0], 0, 0, 0);
        o[d0] = __builtin_amdgcn_mfma_f32_32x32x16_bf16(pa3, PK(3), o[d0], 0, 0, 0);
#undef PK
    }
}
__device__ __forceinline__ float rowmax32b(const f32x16& p0, const f32x16& p1) {
    float a = __builtin_fmaxf(__builtin_fmaxf(p0[0], p0[1]), p1[0]), b = __builtin_fmaxf(__builtin_fmaxf(p0[2], p0[3]), p1[1]); a = __builtin_fmaxf(__builtin_fmaxf(a, p1[2]), p1[3]);
#pragma unroll
    for (int r = 4; r < 16; r += 4) { a = __builtin_fmaxf(__builtin_fmaxf(a, p0[r]), p0[r + 1]); b = __builtin_fmaxf(__builtin_fmaxf(b, p0[r + 2]), p0[r + 3]);
        a = __builtin_fmaxf(__builtin_fmaxf(a, p1[r]), p1[r + 1]); b = __builtin_fmaxf(__builtin_fmaxf(b, p1[r + 2]), p1[r + 3]); }
    const float m = __builtin_fmaxf(a, b);
    auto rr = __builtin_amdgcn_permlane32_swap(__float_as_uint(m), __float_as_uint(m), false, false);
    return __builtin_fmaxf(__uint_as_float(rr[0]), __uint_as_float(rr[1]));
}
constexpr float DEFER_THR = 6.0f;
#ifndef ATT_GRP
#define ATT_GRP(w) ((w) >> 2)
#endif
template <int ABL, class TF>
__device__ __forceinline__ void sm_pv(f32x16& sc0, f32x16& sc1, f32x16& sn0, f32x16& sn1, bool adjust_next, int kt, int par, bool& first, float& mref, float& l, f32x16 (&o)[2],
                                      LAS float* wsf, const LAS unsigned char* vp0, const TF& tf, int r32, int hi) {
    if (ABL & 16) { o[0][1] += sc0[3] + sc1[5]; return; }
    tf.post(kt, sc0, sc1);
    const float rm = rowmax32b(sc0, sc1);
    if (__any(first || rm > DEFER_THR)) {
        const float delta = first ? (rm == NEG ? 0.f : rm) : __builtin_fmaxf(rm, 0.f);
        mref += delta;
#pragma unroll
        for (int r = 0; r < 16; ++r) { sc0[r] -= delta; sc1[r] -= delta; }
        if (adjust_next) {
#pragma unroll
            for (int r = 0; r < 16; ++r) { sn0[r] -= delta; sn1[r] -= delta; } }
        const float f = fexp2(-delta); l *= f;
        if (!first) scale_rows(o, wsf, f, r32, hi);
        first = false;
    }
    float s = 0.f;
#pragma unroll
    for (int r = 0; r < 16; ++r) { if (!(ABL & 1)) { sc0[r] = fexp2(sc0[r]); sc1[r] = fexp2(sc1[r]); } s += sc0[r] + sc1[r]; }
    l += s;
    bf16x8 a0, a1, a2, a3; pack_p(sc0, sc1, a0, a1, a2, a3);
    if (!(ABL & 2)) pv2(o, vp0 + par * 8192, a0, a1, a2, a3); else { o[0][0] += __builtin_bit_cast(f32x4, a0)[0] + __builtin_bit_cast(f32x4, a3)[3]; }
}
__device__ __forceinline__ void glds16(const void* gsrc, unsigned lds_dst) { unsigned keep;
    asm volatile("s_mov_b32 %0, m0\n\ts_mov_b32 m0, %2\n\ts_nop 0\n\tglobal_load_lds_dwordx4 %1, off\n\ts_mov_b32 m0, %0" : "=&s"(keep) : "v"(gsrc), "s"(lds_dst) : "memory"); }
#define ATT_WAIT_BAR(N) asm volatile("s_waitcnt vmcnt(" #N ") lgkmcnt(0)\n\ts_barrier" ::: "memory")
template <int ABL = 0, class TF>
__device__ __forceinline__ void attn_loop2(unsigned tmask, const bf16_t* Kg, int pitchK, const bf16_t* Vg, int pitchV, LAS unsigned char* lds, const bf16x8 (&qr)[4],
                                           f32x16 (&o)[2], float& mref, float& l, const TF& tf, int wave_last_row) {
    const int tid = fresh_tid(), lane = tid & 63, r32 = lane & 31, hi = lane >> 5, wid = __builtin_amdgcn_readfirstlane(tid >> 6), grp = ATT_GRP(wid);
    LAS float* wsf = (LAS float*)(lds + L_WSF) + wid * 64;
    const LAS unsigned char* vp0 = lds + L_SLOT + L_VR + ((lane >> 4) & 1) * 32 + (lane & 3) * 8 + (4 * hi + ((lane & 15) >> 2)) * 64;
    const bf16_t* ksrc = Kg + (size_t)lane * pitchK + wid * 8;
    const bf16_t* vsrc = Vg + (size_t)(16 * (wid & 3) + (lane >> 2)) * pitchV + (wid >> 2) * 32 + (lane & 3) * 8;
    const unsigned ldsb = (unsigned)(size_t)(lds + L_SLOT) + (unsigned)wid * 1024u;
#define DMA_K(t, slot) glds16(ksrc + (size_t)(t) * 64 * pitchK, (unsigned)__builtin_amdgcn_readfirstlane(ldsb + (unsigned)(slot) * 8192u))
#define DMA_V(t, slot) glds16(vsrc + (size_t)(t) * 64 * pitchV, (unsigned)__builtin_amdgcn_readfirstlane(ldsb + (unsigned)L_VR + (unsigned)(slot) * 8192u))
#define NEXT_TILE(dst) do { if (tmask) { dst = 31 - __clz((int)tmask); tmask &= ~(1u << dst); } else dst = -1; } while (0)
    int t0, t1, t2, t3;
    NEXT_TILE(t0); NEXT_TILE(t1); NEXT_TILE(t2);
    const int tz = t0;
    DMA_K(t0, 0); DMA_V(t0, 0); DMA_K(t1 < 0 ? tz : t1, 1); DMA_V(t1 < 0 ? tz : t1, 1); DMA_K(t2 < 0 ? tz : t2, 2);
    ATT_WAIT_BAR(2);
    f32x16 sa0, sa1, sb0, sb1;
    bool first = true;
    mref = 0.f; l = 0.f;
    { f32x16 c0, c1; tf.cinit(t0, 0.f, c0, c1); qkt_c(sa0, sa1, lds + L_SLOT, qr, c0, c1, r32, hi); }
    asm volatile("s_waitcnt lgkmcnt(0)\n\ts_barrier" ::: "memory");
    int s0 = 0, s1 = 1, s2 = 2;
#define ATT_STEP(SC0, SC1, SN0, SN1) do { \
        NEXT_TILE(t3); \
        DMA_K(t3 < 0 ? tz : t3, s0); DMA_V(t2 < 0 ? tz : t2, s2); \
        const int t1c = t1 < 0 ? tz : t1; \
        if (grp == 0) { \
            { f32x16 c0, c1; if (ABL & 32) { c0 = f32x16{}; c1 = f32x16{}; c0[0] = mref; } else tf.cinit(t1c, mref, c0, c1); if (!(ABL & 4)) qkt_c(SN0, SN1, lds + L_SLOT + s1 * 8192, qr, c0, c1, r32, hi); else { SN0 = c0; SN1 = c1; } } \
            sm_pv<ABL>(SC0, SC1, SN0, SN1, true, t0, s0, first, mref, l, o, wsf, vp0, tf, r32, hi); \
        } else { \
            sm_pv<ABL>(SC0, SC1, SN0, SN1, false, t0, s0, first, mref, l, o, wsf, vp0, tf, r32, hi); \
            { f32x16 c0, c1; if (ABL & 32) { c0 = f32x16{}; c1 = f32x16{}; c0[0] = mref; } else tf.cinit(t1c, mref, c0, c1); if (!(ABL & 4)) qkt_c(SN0, SN1, lds + L_SLOT + s1 * 8192, qr, c0, c1, r32, hi); else { SN0 = c0; SN1 = c1; } } \
        } \
        ATT_WAIT_BAR(2); \
        t0 = t1; t1 = t2; t2 = t3; { const int s_ = s0; s0 = s1; s1 = s2; s2 = s_; } \
    } while (0)
    for (;;) {
        ATT_STEP(sa0, sa1, sb0, sb1); if (t0 < 0) break;
        ATT_STEP(sb0, sb1, sa0, sa1); if (t0 < 0) break;
    }
    asm volatile("s_waitcnt vmcnt(0)" ::: "memory");
    __syncthreads();
#undef ATT_STEP
#undef NEXT_TILE
#undef DMA_K
#undef DMA_V
}
struct TfFox { const LAS float* cb; int qpos, hi, q0w;
    __device__ __forceinline__ void cinit(int kt, float mref, f32x16& c0, f32x16& c1) const {
#pragma unroll
        for (int i = 0; i < 4; ++i) { const f32x4 a = *(const LAS f32x4*)(cb + kt * 64 + 8 * i + 4 * hi), b = *(const LAS f32x4*)(cb + kt * 64 + 32 + 8 * i + 4 * hi);
#pragma unroll
            for (int j = 0; j < 4; ++j) { c0[4 * i + j] = a[j] - mref; c1[4 * i + j] = b[j] - mref; } } }
    __device__ __forceinline__ void post(int kt, f32x16& p0, f32x16& p1) const {
        if (kt * 64 + 63 > q0w) {
#pragma unroll
            for (int r = 0; r < 16; ++r) { const int kv = kt * 64 + crow(r, hi); if (kv > qpos) p0[r] = NEG; if (kv + 32 > qpos) p1[r] = NEG; } } } };
struct TfT5 { const LAS float* tb; int qpos, hi, q0w, window; unsigned mask; bool use_mask;
    __device__ __forceinline__ void cinit(int kt, float mref, f32x16& c0, f32x16& c1) const {
        if (q0w - (kt * 64 + 63) >= 113) { const float c = tb[127] - mref;
#pragma unroll
            for (int r = 0; r < 16; ++r) { c0[r] = c; c1[r] = c; } }
        else {
#pragma unroll
            for (int r = 0; r < 16; ++r) { const int d0 = qpos - kt * 64 - crow(r, hi); c0[r] = tb[min(max(d0, 0), 127)] - mref; c1[r] = tb[min(max(d0 - 32, 0), 127)] - mref; } } }
    __device__ __forceinline__ void post(int kt, f32x16& p0, f32x16& p1) const {
        if (q0w - (kt * 64 + 63) < 0 || q0w + 31 - kt * 64 >= window) {
#pragma unroll
            for (int r = 0; r < 16; ++r) { const int d0 = qpos - kt * 64 - crow(r, hi), d1 = d0 - 32; if (d0 < 0 || d0 >= window) p0[r] = NEG; if (d1 < 0 || d1 >= window) p1[r] = NEG; } }
        if (use_mask) { const bool en = ((mask >> kt) & 1u) != 0u;
            if (!__all(en)) {
#pragma unroll
                for (int r = 0; r < 16; ++r) { p0[r] = en ? p0[r] : NEG; p1[r] = en ? p1[r] : NEG; } } } } };
}
#ifndef STAGE_LIMIT
#define STAGE_LIMIT 4
#endif
constexpr size_t MiB = 1u << 20;
constexpr size_t WS_CTL = 0, CTL_ZERO_BYTES = 2 * MiB;
constexpr size_t WS_SS = 256 * 1024;
constexpr size_t WS_SSM = 640 * 1024;
constexpr size_t WS_F32S = 2 * MiB;
constexpr size_t WS_CUM = 4 * MiB;
constexpr size_t WS_MASK = 4 * MiB + 512 * 1024;
constexpr size_t WS_UMASK = WS_MASK + 128 * 1024;
constexpr size_t WS_KC = 5 * MiB, WS_VC = 5 * MiB + 256 * 1024;
constexpr size_t WS_KMAX = 5 * MiB + 512 * 1024;
constexpr size_t WS_POSC = 704 * 1024;
constexpr size_t WS_WGU1 = 8 * MiB, WS_WD1 = 19 * MiB, WS_WIN = 25 * MiB, WS_WUPN = 35 * MiB, WS_WUPF = 36 * MiB, WS_WOUT = 37 * MiB, WS_WMQ = 39 * MiB,
                 WS_WMKV = 41 * MiB, WS_WMO = 45 * MiB, WS_WGU2 = 47 * MiB, WS_WD2 = 58 * MiB, WS_CW1K = 64 * MiB, WS_CW1V = 65 * MiB, WS_CW2K = 66 * MiB, WS_CW2V = 66 * MiB + 256 * 1024;
constexpr size_t WS_KM = 8 * MiB, WS_VT = 12 * MiB;
constexpr size_t WS_XB = 68 * MiB;
constexpr size_t WS_QN = 100 * MiB, WS_KVN = 116 * MiB, WS_QF = 140 * MiB, WS_KVF = 156 * MiB, WS_GAB = 188 * MiB;
constexpr size_t WS_H = 100 * MiB;
constexpr size_t WS_Y = WS_KVF;
constexpr size_t WS_QM = 108 * MiB, WS_PM = 188 * MiB, WS_OM = 140 * MiB;
constexpr size_t WS_MEMB = 252 * MiB, WS_END = 256 * MiB;
static_assert(WS_WD2 + (size_t)DM * FF * 2 <= WS_CW1K && WS_GAB + (size_t)M * 2048 * 2 <= WS_MEMB && WS_H + (size_t)M * FF * 2 <= WS_GAB, "ws map");
constexpr int CW_BAR = 4096;
constexpr size_t WS_XBUF = 1 * MiB;
constexpr size_t WS_FINCNT = 768 * 1024;
constexpr int RING_BYTES = 131072, LDS_BYTES = 147456;

__device__ const unsigned char T5B[128] = {0, 1, 2, 3, 4, 5, 6, 7, 8, 9, 10, 11, 12, 13, 14, 15, 16, 16, 16, 17, 17, 18, 18, 18, 19, 19, 19, 20, 20, 20, 20, 21, 21, 21, 21, 22, 22, 22, 22, 22, 23, 23, 23, 23, 23, 23, 24, 24, 24, 24, 24, 24, 25, 25, 25, 25, 25, 25, 25, 26, 26, 26, 26, 26, 26, 26, 26, 27, 27, 27, 27, 27, 27, 27, 27, 27, 27, 28, 28, 28, 28, 28, 28, 28, 28, 28, 28, 29, 29, 29, 29, 29, 29, 29, 29, 29, 29, 29, 29, 30, 30, 30, 30, 30, 30, 30, 30, 30, 30, 30, 30, 30, 30, 31, 31, 31, 31, 31, 31, 31, 31, 31, 31, 31, 31, 31, 31, 31};


#define XB_TMO      128
#define XB_XCNT(j)  (256  + 64 * (j))
#define XB_XSUB(j)  (1280 + 64 * (j))
#define XB_XGEN(j)  (2304 + 64 * (j))
#define XB_TOP      3328
#define XB_TOPGEN   3392
#define XCD_BAR_WORDS 3456
#define XB_SPIN_CAP (1u << 18)
__device__ __forceinline__ unsigned xb_ld(unsigned* p)              { return __hip_atomic_load(p, __ATOMIC_RELAXED, __HIP_MEMORY_SCOPE_AGENT); }
__device__ __forceinline__ unsigned xb_add(unsigned* p, unsigned v) { return __hip_atomic_fetch_add(p, v, __ATOMIC_RELAXED, __HIP_MEMORY_SCOPE_AGENT); }
__device__ __forceinline__ unsigned xb_xcc_id() { return (unsigned)__builtin_amdgcn_s_getreg((3 << 11) | 20) & 0xFu; }
#define XB_SPIN(cond, bar) do { unsigned _sp = 0; while (cond) { __builtin_amdgcn_s_sleep(1); \
    if ((++_sp & 255u) == 0u) { if (xb_ld(&(bar)[XB_TMO])) break; if (_sp > XB_SPIN_CAP) { atomicAdd(&(bar)[XB_TMO], 1u); break; } } } } while (0)
struct XcdBarrier { unsigned* bar; unsigned x; volatile LAS unsigned* st; };
__device__ __forceinline__ XcdBarrier xcd_barrier_post(unsigned* bar, volatile LAS unsigned* st) {
    XcdBarrier b; b.bar = bar; b.x = xb_xcc_id(); b.st = st;
    if (threadIdx.x == 0) (void)xb_add(&bar[XB_XCNT(b.x)], 1u);
    return b;
}
__device__ __forceinline__ void xcd_barrier_complete(unsigned* bar, unsigned x, unsigned& nloc, unsigned& nx) {
    const unsigned G = gridDim.x * gridDim.y * gridDim.z;
    unsigned sum, cnt, mine, sp = 0u;
    for (;;) {
        sum = 0u; cnt = 0u; mine = 0u;
#pragma unroll
        for (unsigned j = 0; j < 16; ++j) { const unsigned c = xb_ld(&bar[XB_XCNT(j)]); sum += c; cnt += (c > 0u) ? 1u : 0u; mine = (j == x) ? c : mine; }
        if (sum == G) break;
        __builtin_amdgcn_s_sleep(1);
        if ((++sp & 255u) == 0u) { if (xb_ld(&bar[XB_TMO])) break; if (sp > XB_SPIN_CAP) { atomicAdd(&bar[XB_TMO], 1u); break; } }
    }
    nloc = mine > 0u ? mine : 1u; nx = cnt > 0u ? cnt : 1u;
}
__device__ __forceinline__ void xcd_barrier(const XcdBarrier& b) {
    asm volatile("s_waitcnt vmcnt(0)" ::: "memory");
    __syncthreads();
    if (threadIdx.x == 0) {
        unsigned* bar = b.bar;
        __builtin_amdgcn_s_waitcnt(0);
        unsigned nloc = b.st[0], nx = b.st[1];
        if (nloc == 0u) { xcd_barrier_complete(bar, b.x, nloc, nx); b.st[0] = nloc; b.st[1] = nx; }
        const unsigned old = xb_add(&bar[XB_XSUB(b.x)], 1u);
        const unsigned gen = old / nloc;
        if (old + 1u == (gen + 1u) * nloc) {
            __builtin_amdgcn_fence(__ATOMIC_RELEASE, "agent");
            asm volatile("s_waitcnt vmcnt(0)" ::: "memory");
            const unsigned og = xb_add(&bar[XB_TOP], 1u);
            const unsigned tg = og / nx;
            if (og + 1u == (tg + 1u) * nx) xb_add(&bar[XB_TOPGEN], 1u);
            else XB_SPIN(xb_ld(&bar[XB_TOPGEN]) == tg, bar);
            __builtin_amdgcn_fence(__ATOMIC_ACQUIRE, "agent");
            xb_add(&bar[XB_XGEN(b.x)], 1u);
            asm volatile("s_waitcnt vmcnt(0)" ::: "memory");
        } else {
            XB_SPIN(xb_ld(&bar[XB_XGEN(b.x)]) == gen, bar);
            __builtin_amdgcn_fence(__ATOMIC_ACQUIRE, "agent");
            asm volatile("s_waitcnt vmcnt(0)" ::: "memory");
        }
    }
    __syncthreads();
}

struct Args { const float* in[29]; float* out; unsigned char* ws; int lo, hi; };
enum { I_X = 0, I_MEM, I_RELB, I_F1N, I_F1G, I_F1U, I_F1D, I_MIXN, I_WIN, I_BF, I_POSK, I_POSV, I_CK1, I_CK2, I_CV1, I_CV2, I_UPN, I_UPF, I_WOUT, I_MQN, I_MKVN, I_MWQ, I_MWKV, I_MWO, I_F2N, I_F2G, I_F2U, I_F2D, I_FINN };

__device__ __forceinline__ float wave_sum(float v) {
#pragma unroll
    for (int o = 1; o < 64; o <<= 1) v += __shfl_xor(v, o);
    return v;
}
template <class CM>
__device__ __forceinline__ void tr_item(const float* W, int ldsrc, int K, bf16_t* WT, int k0, int dstrow0, const float* gain, LAS float* scr, int lane, const CM& cm) {
    const int kr = lane >> 3, c4 = lane & 7; int sc; float scl; cm(dstrow0 + 4 * c4, sc, scl);
    f32x4 v[8]; float gk[8];
#pragma unroll
    for (int i = 0; i < 8; ++i) { const int kk = 8 * i + kr; v[i] = sc >= 0 ? *(const f32x4*)(W + (size_t)(k0 + kk) * ldsrc + sc) : (f32x4){0.f, 0.f, 0.f, 0.f}; gk[i] = gain ? gain[k0 + kk] : 1.f; }
#pragma unroll
    for (int i = 0; i < 8; ++i) { const int kk = 8 * i + kr; const float s = gk[i] * scl; LAS float* p = scr + kk * 33 + 4 * c4; p[0] = v[i][0] * s; p[1] = v[i][1] * s; p[2] = v[i][2] * s; p[3] = v[i][3] * s; }
    asm volatile("s_waitcnt lgkmcnt(0)" ::: "memory");
    const int c = lane & 7;
#pragma unroll
    for (int j = 0; j < 4; ++j) { const int nn = (lane >> 3) + 8 * j; const LAS float* s = scr + (8 * c) * 33 + nn;
        u32x4 o; o.x = cvtpk(s[0 * 33], s[1 * 33]); o.y = cvtpk(s[2 * 33], s[3 * 33]); o.z = cvtpk(s[4 * 33], s[5 * 33]); o.w = cvtpk(s[6 * 33], s[7 * 33]);
        *(u32x4*)(WT + (size_t)(dstrow0 + nn) * K + k0 + 8 * c) = o; }
    asm volatile("s_waitcnt lgkmcnt(0)" ::: "memory");
}
struct CmPlain { int off; float s; __device__ __forceinline__ void operator()(int n, int& sc, float& scl) const { sc = n + off; scl = s; } };
struct CmWin { __device__ __forceinline__ void operator()(int n, int& sc, float& scl) const {
    scl = 1.f;
    if (n < 512) { sc = n; scl = QS64; }
    else if (n < 1280) sc = n;
    else if (n < 1792) { sc = 1304 + (n - 1280); scl = QS64; }
    else if (n < 2816) sc = 1816 + (n - 1792);
    else if (n < 4864) sc = 2848 + (n - 2816);
    else if (n < 4888) sc = 1280 + (n - 4864);
    else if (n < 4896) sc = 2840 + (n - 4888);
    else sc = -1; } };
constexpr int N_GU = 16 * 176, N_D = 44 * 32, N_WIN = 16 * 160, N_UP = 8 * 32, N_SQ = 16 * 32, N_MKV = 16 * 64, N_C1 = 32 * 8, N_C2 = 4 * 2;
constexpr int CONV_NA = N_GU + N_D + N_WIN + N_MKV + 2 * N_C1 + 2 * N_C2, CONV_NB = N_GU + N_D + 2 * N_UP + 3 * N_SQ;
__device__ __forceinline__ void conv_item(const Args& a, int it, LAS float* scr, int lane) {
    unsigned char* ws = a.ws; int r = it;
    const int f = r >= CONV_NA; if (f) r -= CONV_NA;
    if (r < N_GU) { const int kb = r / 176, gi = r % 176, dr = gi * 32, tile = dr >> 8, within = dr & 255;
        const float* W = a.in[within < 128 ? (f ? I_F2G : I_F1G) : (f ? I_F2U : I_F1U)];
        tr_item(W, FF, DM, (bf16_t*)(ws + (f ? WS_WGU2 : WS_WGU1)), kb * 64, dr, a.in[f ? I_F2N : I_F1N], scr, lane, CmPlain{tile * 128 + (within & 127) - dr, 1.f}); return; }
    r -= N_GU;
    if (r < N_D) { const int kb = r / 32, gi = r % 32; tr_item(a.in[f ? I_F2D : I_F1D], DM, FF, (bf16_t*)(ws + (f ? WS_WD2 : WS_WD1)), kb * 64, gi * 32, nullptr, scr, lane, CmPlain{0, 1.f}); return; }
    r -= N_D;
    if (!f) {
        if (r < N_WIN) { const int kb = r / 160, gi = r % 160; tr_item(a.in[I_WIN], 4896, DM, (bf16_t*)(ws + WS_WIN), kb * 64, gi * 32, a.in[I_MIXN], scr, lane, CmWin{}); return; }
        r -= N_WIN;
        if (r < N_MKV) { const int kb = r / 64, gi = r % 64; tr_item(a.in[I_MWKV], 2048, DM, (bf16_t*)(ws + WS_WMKV), kb * 64, gi * 32, a.in[I_MKVN], scr, lane, CmPlain{0, 1.f}); return; }
        r -= N_MKV;
        if (r < 2 * N_C1) { const int g = r >= N_C1; r -= g * N_C1; const int kb = r / 8, gi = r % 8;
            tr_item(a.in[g ? I_CV1 : I_CK1], 256, 2048, (bf16_t*)(ws + (g ? WS_CW1V : WS_CW1K)), kb * 64, gi * 32, nullptr, scr, lane, CmPlain{0, 1.f}); return; }
        r -= 2 * N_C1;
        { const int g = r >= N_C2; r -= g * N_C2; const int kb = r / 2, gi = r % 2;
            tr_item(a.in[g ? I_CV2 : I_CK2], 64, 256, (bf16_t*)(ws + (g ? WS_CW2V : WS_CW2K)), kb * 64, gi * 32, nullptr, scr, lane, CmPlain{0, 1.f}); }
    } else {
        if (r < 2 * N_UP) { const int g = r >= N_UP; r -= g * N_UP; const int kb = r / 32, gi = r % 32;
            tr_item(a.in[g ? I_UPF : I_UPN], DM, 512, (bf16_t*)(ws + (g ? WS_WUPF : WS_WUPN)), kb * 64, gi * 32, nullptr, scr, lane, CmPlain{0, 1.f}); return; }
        r -= 2 * N_UP;
        { const int g = r / N_SQ; r -= g * N_SQ; const int kb = r / 32, gi = r % 32;
            tr_item(a.in[g == 0 ? I_WOUT : (g == 1 ? I_MWQ : I_MWO)], DM, DM, (bf16_t*)(ws + (g == 0 ? WS_WOUT : (g == 1 ? WS_WMQ : WS_WMO))), kb * 64, gi * 32, g == 1 ? a.in[I_MQN] : nullptr, scr, lane,
                    CmPlain{0, g == 1 ? QS256 : 1.f}); }
    }
}

__device__ __forceinline__ void p0_prologue(const Args& a, LAS unsigned char* lds, int gw, int NGW, int wave, int lane) {
    unsigned char* ws = a.ws;
    LAS float* scr = (LAS float*)(lds + wave * 16384);
    for (int it = gw; it < N_GU; it += NGW) conv_item(a, it, scr, lane);
    for (int mrow = gw; mrow < M + MROWS; mrow += NGW) {
        const bool ismem = mrow >= M; const int rr = ismem ? mrow - M : mrow;
        const f32x4* xr = (const f32x4*)((ismem ? a.in[I_MEM] : a.in[I_X]) + (size_t)rr * DM) + lane;
        unsigned long long* o8 = (unsigned long long*)((bf16_t*)(ws + (ismem ? WS_MEMB : WS_XB)) + (size_t)rr * DM) + lane;
        float s = 0.f; f32x4 v[4];
#pragma unroll
        for (int j = 0; j < 4; ++j) v[j] = xr[64 * j];
#pragma unroll
        for (int j = 0; j < 4; ++j) { s += (v[j][0] * v[j][0] + v[j][1] * v[j][1]) + (v[j][2] * v[j][2] + v[j][3] * v[j][3]);
            o8[64 * j] = (unsigned long long)cvtpk(v[j][0], v[j][1]) | ((unsigned long long)cvtpk(v[j][2], v[j][3]) << 32); }
        s = wave_sum(s);
        if (lane == 0) ((float*)(ws + (ismem ? WS_SSM : WS_SS)))[rr] = s;
    }
    for (int t = gw; t < 64; t += NGW) { const int kv = t >> 5, kc = (t & 31) * 64; const float* pos = a.in[kv ? I_POSV : I_POSK] + kc; const f32x4* w1 = (const f32x4*)(a.in[kv ? I_CV1 : I_CK1] + (size_t)kc * 256) + lane;
        f32x4 s = {0.f, 0.f, 0.f, 0.f};
#pragma unroll 8
        for (int k = 0; k < 64; ++k) s += w1[(size_t)k * 64] * pos[k];
        float* o = (float*)(ws + WS_POSC) + kv * 256 + 4 * lane;
        unsafeAtomicAdd(o, s[0]); unsafeAtomicAdd(o + 1, s[1]); unsafeAtomicAdd(o + 2, s[2]); unsafeAtomicAdd(o + 3, s[3]); }
}

__device__ __forceinline__ void compress_unit(const Args& a, LAS unsigned char* lds, int uidx) {
    unsigned char* ws = a.ws;
    const int tid = fresh_tid(), lane = tid & 63, r32 = lane & 31, hi = lane >> 5, wid = __builtin_amdgcn_readfirstlane(tid >> 6);
    const int kv = uidx >> 6, b = (uidx >> 3) & 7, g = (uidx >> 2) & 1, chunk = uidx & 3, n0 = chunk * 32;
    const bf16_t* W1 = (const bf16_t*)(ws + (kv ? WS_CW1V : WS_CW1K)); const bf16_t* W2 = (const bf16_t*)(ws + (kv ? WS_CW2V : WS_CW2K));
    const float* posc = (const float*)(ws + WS_POSC) + kv * 256;
    const bf16_t* asrc = (const bf16_t*)(ws + WS_KVN) + (size_t)(b * SEQ) * 768 + kv * 128 + g * 64;
    LAS bf16_t* As = (LAS bf16_t*)lds;
    for (int i = tid; i < 528 * 8; i += 512) { const int row = i >> 3, ch = i & 7; const int t = min(16 * n0 + row, SEQ - 1);
        *(LAS u32x4*)(As + row * 64 + ((ch ^ ((row >> 4) & 7)) * 8)) = *(const u32x4*)(asrc + (size_t)t * 768 + ch * 8); }
    __syncthreads();
    const bf16_t* brow = W1 + (size_t)(32 * wid + r32) * 2048 + hi * 8;
    f32x16 acc = f32x16{};
#pragma unroll 16
    for (int kk = 0; kk < 128; ++kk) { const int l = kk >> 2, dch = (kk & 3) * 2 + hi, row = 16 * r32 + l;
        const bf16x8 av = *(const LAS bf16x8*)(As + row * 64 + ((dch ^ ((row >> 4) & 7)) * 8)); const bf16x8 bv = *(const bf16x8*)(brow + kk * 16);
        acc = __builtin_amdgcn_mfma_f32_32x32x16_bf16(av, bv, acc, 0, 0, 0); }
    LAS bf16_t* Hs = (LAS bf16_t*)(lds + 81920);
    const float pc = posc[32 * wid + r32];
#pragma unroll
    for (int r = 0; r < 16; ++r) { const float x = acc[r] + pc; const float u = 0.7978845608028654f * (x + 0.044715f * x * x * x);
        const float ge = x * frcp(1.0f + fexp2(-2.0f * LOG2E * u)); Hs[att::crow(r, hi) * 264 + 32 * wid + r32] = (bf16_t)(cvtpk(ge, 0.f) & 0xffffu); }
    __syncthreads();
    if (wid < 2) { f32x16 acc2 = f32x16{};
#pragma unroll
        for (int kk = 0; kk < 16; ++kk) { const bf16x8 av = *(const LAS bf16x8*)(Hs + r32 * 264 + kk * 16 + hi * 8); const bf16x8 bv = *(const bf16x8*)(W2 + (size_t)(32 * wid + r32) * 256 + kk * 16 + hi * 8);
            acc2 = __builtin_amdgcn_mfma_f32_32x32x16_bf16(av, bv, acc2, 0, 0, 0); }
        bf16_t* outp = (bf16_t*)(ws + (kv ? WS_VC : WS_KC)) + (size_t)((b * 2 + g) * 128) * 64;
#pragma unroll
        for (int r = 0; r < 16; ++r) { const int n = n0 + att::crow(r, hi); const float v = n < 127 ? acc2[r] : 0.f; outp[(size_t)n * 64 + 32 * wid + r32] = (bf16_t)(cvtpk(v, 0.f) & 0xffffu); } }
    __syncthreads();
}
__device__ __forceinline__ void kmax_task(const Args& a, LAS unsigned char* lds, int task, int wave, int lane) {
    const int b = task >> 3, h = task & 7; float mx = 0.f;
    const bf16_t* K = (const bf16_t*)(a.ws + WS_KVF) + (size_t)(b * SEQ) * 1024 + h * 64;
#pragma unroll
    for (int rr = 0; rr < 4; ++rr) { const u32x4* p = (const u32x4*)(K + (size_t)(wave * 256 + rr * 64 + lane) * 1024); float ss = 0.f;
#pragma unroll
        for (int c = 0; c < 8; ++c) { const u32x4 v = p[c]; ss += (bflo(v.x) * bflo(v.x) + bfhi(v.x) * bfhi(v.x)) + (bflo(v.y) * bflo(v.y) + bfhi(v.y) * bfhi(v.y)) + (bflo(v.z) * bflo(v.z) + bfhi(v.z) * bfhi(v.z)) + (bflo(v.w) * bflo(v.w) + bfhi(v.w) * bfhi(v.w)); }
        mx = fmaxf(mx, ss); }
#pragma unroll
    for (int o = 1; o < 64; o <<= 1) mx = fmaxf(mx, __shfl_xor(mx, o));
    LAS float* red = (LAS float*)(lds + 120 * 1024);
    if (lane == 0) red[wave] = mx;
    __syncthreads();
    if (wave == 0 && lane == 0) { float m2 = red[0]; for (int i = 1; i < 8; ++i) m2 = fmaxf(m2, red[i]); ((float*)(a.ws + WS_KMAX))[task] = sqrtf(m2) * 1.01f; }
    __syncthreads();
}
__device__ __forceinline__ void cumsum_task(const Args& a, int task, int lane) {
    const int b = task >> 3, h = task & 7; const float bf = a.in[I_BF][h];
    const float* fl = (const float*)(a.ws + WS_F32S) + (size_t)(b * SEQ) * 32 + 24 + h; float* out = (float*)(a.ws + WS_CUM) + (size_t)task * SEQ;
    float v[32];
#pragma unroll
    for (int i = 0; i < 32; ++i) v[i] = fl[(size_t)(64 * i + lane) * 32];
    float carry = 0.f;
#pragma unroll
    for (int i = 0; i < 32; ++i) { const float x = v[i] + bf; float inc = fminf(x, 0.f) - log1pf(expf(-fabsf(x)));
#pragma unroll
        for (int o = 1; o < 64; o <<= 1) { const float t = __shfl_up(inc, o); if (lane >= o) inc += t; }
        inc += carry; out[64 * i + lane] = -inc * LOG2E; carry = __shfl(inc, 63); }
}

__device__ __forceinline__ void init_t5_table(const Args& a, LAS unsigned char* lds) {
    LAS float* T = (LAS float*)(lds + att::L_TBL);
    for (int i = fresh_tid(); i < 1024; i += 512) { const int h = i >> 7, d = i & 127; T[i] = a.in[I_RELB][T5B[d] * 8 + h] * LOG2E; }
}
template <bool DRY> __device__ __forceinline__ void fox_unit(const Args& a, LAS unsigned char* lds, int b, int h, int qb) {
    using namespace att;
    unsigned char* ws = a.ws;
    const int tid = fresh_tid(), lane = tid & 63, r32 = lane & 31, hi = lane >> 5, wid = __builtin_amdgcn_readfirstlane(tid >> 6);
    const int q0 = qb * 256, q0w = q0 + wid * 32, qpos = q0w + r32;
    LAS float* cb = (LAS float*)(lds + L_CB); LAS float* wsf = (LAS float*)(lds + L_WSF) + wid * 64;
    const float* cum = (const float*)(ws + WS_CUM) + (size_t)(b * 8 + h) * SEQ;
    for (int i = tid; i < q0 + 256; i += 512) cb[i] = cum[i];
    bf16_t* Qw = (bf16_t*)(ws + WS_QF) + (size_t)(b * SEQ + q0w) * 512 + h * 64;
    bf16x8 qr[4]; load_q(qr, Qw, 512, r32, hi);
    f32x16 o[2]; o[0] = f32x16{}; o[1] = f32x16{}; float m = 0.f, l = 0.f;
    const int nt = 4 * qb + 4; unsigned tmask = nt >= 32 ? 0xffffffffu : ((1u << nt) - 1u);
    const bf16_t* Kg = (const bf16_t*)(ws + WS_KVF) + (size_t)(b * SEQ) * 1024 + h * 64;
#ifndef NO_FOX_SKIP
    {
        float qq = 0.f;
#pragma unroll
        for (int d0 = 0; d0 < 4; ++d0) { const u32x4 v = __builtin_bit_cast(u32x4, qr[d0]);
            qq += (bflo(v.x) * bflo(v.x) + bfhi(v.x) * bfhi(v.x)) + (bflo(v.y) * bflo(v.y) + bfhi(v.y) * bfhi(v.y)) + (bflo(v.z) * bflo(v.z) + bfhi(v.z) * bfhi(v.z)) + (bflo(v.w) * bflo(v.w) + bfhi(v.w) * bfhi(v.w)); }
        qq = halfsum(qq);
#pragma unroll
        for (int o_ = 1; o_ < 32; o_ <<= 1) qq = fmaxf(qq, __shfl_xor(qq, o_));
        LAS float* red = (LAS float*)(lds + L_MISC + 16);
        if (lane == 0) red[wid] = qq;
        __syncthreads();
        float qmax = red[0];
#pragma unroll
        for (int i = 1; i < 8; ++i) qmax = fmaxf(qmax, red[i]);
        const float need = 2.0f * sqrtf(qmax) * 1.01f * ((const float*)(ws + WS_KMAX))[b * 8 + h] + 40.0f;
        const float cb0 = cum[q0];
        const bool skip = (lane < 32) && (lane < nt) && (cb0 - cum[64 * (lane < nt ? lane : 0) + 63] >= need);
        const unsigned long long bal = __ballot(skip);
        tmask &= ~(unsigned)bal;
        __syncthreads();
    }
#endif
#ifndef FOX_ABL
#define FOX_ABL 0
#endif
    if (DRY) attn_loop2<FOX_ABL>(tmask, Kg, 1024, Kg + 512, 1024, lds, qr, o, m, l, TfFox{cb, qpos, hi, q0w}, q0w + 31);
    else attn_loop2<0>(tmask, Kg, 1024, Kg + 512, 1024, lds, qr, o, m, l, TfFox{cb, qpos, hi, q0w}, q0w + 31);
    l = halfsum(l);
    scale_rows(o, wsf, 1.0f / l, r32, hi);
    store_o<false>(o, lds, DRY ? (bf16_t*)(ws + WS_XB + 16 * MiB) + (size_t)(b * SEQ + q0w) * 512 + h * 64 : Qw, 512, nullptr, 0);
}
template <int PARTS> __device__ __forceinline__ void cmpwin_unit(const Args& a, LAS unsigned char* lds, int b, int g, int qb) {
    using namespace att;
    unsigned char* ws = a.ws;
    const int tid = fresh_tid(), lane = tid & 63, r32 = lane & 31, hi = lane >> 5, wid = __builtin_amdgcn_readfirstlane(tid >> 6);
    const int j = wid >> 1, sub = wid & 1, hg = g * 4 + j, q0w = qb * 64 + sub * 32, qpos = q0w + r32; const size_t qrow = (size_t)b * SEQ + qpos;
    const LAS float* tb = (const LAS float*)(lds + L_TBL) + hg * 128;
    LAS float* wsf = (LAS float*)(lds + L_WSF) + wid * 64; LAS float* PS = (LAS float*)(lds + L_PS); LAS float* IMP = (LAS float*)(lds + L_IMP); LAS unsigned* MW = (LAS unsigned*)(lds + L_MISC);
    const float* gates = (const float*)(ws + WS_F32S) + qrow * 32;
    if (tid == 0) MW[0] = 0u;
    bf16x8 qr[4]; load_q(qr, (const bf16_t*)(ws + WS_QN) + (size_t)(b * SEQ + q0w) * 512 + hg * 64, 512, r32, hi);
    const StageGeo sg = stage_geo(tid);
    { const bf16_t* Kc = (const bf16_t*)(ws + WS_KC) + (size_t)((b * 2 + g) * 128) * 64; const bf16_t* Vc = (const bf16_t*)(ws + WS_VC) + (size_t)((b * 2 + g) * 128) * 64;
#pragma unroll
        for (int t = 0; t < 2; ++t) { *(LAS u32x4*)(lds + L_SLOT + t * 16384 + sg.koff) = *(const u32x4*)(Kc + (size_t)(t * 64 + sg.krow) * 64 + sg.kcol);
            *(LAS u32x4*)(lds + L_SLOT + t * 16384 + sg.voff) = *(const u32x4*)(Vc + (size_t)(t * 64 + sg.vrow) * 64 + sg.vcol); } }
    __syncthreads();
    if (PARTS & 1) {
        f32x16 oc[2]; oc[0] = f32x16{}; oc[1] = f32x16{};
        f32x16 a0, a1, b0, b1; qkt(a0, a1, lds + L_SLOT, qr, r32, hi); qkt(b0, b1, lds + L_SLOT + 16384, qr, r32, hi);
        float mx = NEG;
#pragma unroll
        for (int r = 0; r < 16; ++r) { const int d = qpos - 16 * crow(r, hi) - 31;
            a0[r] = d >= 0 ? a0[r] + tb[min(d, 127)] : NEG; a1[r] = d - 512 >= 0 ? a1[r] + tb[min(d - 512, 127)] : NEG;
            b0[r] = d - 1024 >= 0 ? b0[r] + tb[min(d - 1024, 127)] : NEG; b1[r] = d - 1536 >= 0 ? b1[r] + tb[min(d - 1536, 127)] : NEG;
            mx = fmaxf(fmaxf(mx, fmaxf(a0[r], a1[r])), fmaxf(b0[r], b1[r])); }
        { auto rr = __builtin_amdgcn_permlane32_swap(__float_as_uint(mx), __float_as_uint(mx), false, false); mx = fmaxf(__uint_as_float(rr[0]), __uint_as_float(rr[1])); }
        const float mxs = mx == NEG ? 0.f : mx; float s = 0.f;
#pragma unroll
        for (int r = 0; r < 16; ++r) { a0[r] = fexp2(a0[r] - mxs); a1[r] = fexp2(a1[r] - mxs); b0[r] = fexp2(b0[r] - mxs); b1[r] = fexp2(b1[r] - mxs); s += (a0[r] + a1[r]) + (b0[r] + b1[r]); }
        s = halfsum(s); const float inv = s > 0.f ? 1.0f / s : 0.f;
#pragma unroll
        for (int r = 0; r < 16; ++r) { a0[r] *= inv; a1[r] *= inv; b0[r] *= inv; b1[r] *= inv; }
        {
            float own[4][4], x3[4][4], rcv[4][4];
#pragma unroll
            for (int i = 0; i < 4; ++i) {
                own[0][i] = 2.0f * (a0[4 * i] + a0[4 * i + 1] + a0[4 * i + 2]) + a0[4 * i + 3]; x3[0][i] = a0[4 * i + 3];
                own[1][i] = 2.0f * (a1[4 * i] + a1[4 * i + 1] + a1[4 * i + 2]) + a1[4 * i + 3]; x3[1][i] = a1[4 * i + 3];
                own[2][i] = 2.0f * (b0[4 * i] + b0[4 * i + 1] + b0[4 * i + 2]) + b0[4 * i + 3]; x3[2][i] = b0[4 * i + 3];
                own[3][i] = 2.0f * (b1[4 * i] + b1[4 * i + 1] + b1[4 * i + 2]) + b1[4 * i + 3]; x3[3][i] = b1[4 * i + 3]; }
#pragma unroll
            for (int k = 0; k < 4; ++k)
#pragma unroll
                for (int i = 0; i < 4; ++i) { auto rr = __builtin_amdgcn_permlane32_swap(__float_as_uint(x3[k][i]), __float_as_uint(x3[k][i]), false, false); rcv[k][i] = __uint_as_float(hi ? rr[0] : rr[1]); }
            LAS float* imh = PS + j * (64 * 33) + (sub * 32 + r32) * 33 + hi;
#pragma unroll
            for (int k = 0; k < 4; ++k)
#pragma unroll
                for (int i = 0; i < 4; ++i) { const float prev = i > 0 ? rcv[k][i - 1] : (k > 0 ? rcv[k - 1][3] : 0.f);
                    imh[8 * k + 2 * i] = own[k][i] + (hi ? rcv[k][i] : prev); }
        }
        const int vb0 = (int)(unsigned)(size_t)(lds + L_SLOT + 8192) + ((lane >> 4) & 1) * 32 + (lane & 3) * 8 + (4 * hi + ((lane & 15) >> 2)) * 64;
        bf16x8 x0, x1, x2, x3; pack_p(a0, a1, x0, x1, x2, x3); pv(oc, vb0, x0, x1, x2, x3);
        pack_p(b0, b1, x0, x1, x2, x3); pv(oc, vb0 + 16384, x0, x1, x2, x3);
        scale_rows(oc, wsf, sigmoidf_(gates[hg]), r32, hi);
        store_o<false>(oc, lds, (bf16_t*)(ws + WS_XB) + (size_t)(b * SEQ + q0w) * 512 + hg * 64, 512, nullptr, 0);
    }
    __syncthreads();
    if (PARTS & 2) {
        const int q = tid >> 3, jb = (tid & 7) * 4; const LAS float* ps = PS + q * 33; LAS float* im = IMP + q * 33;
#pragma unroll
        for (int jj = 0; jj < 4; ++jj) { const int jx = jb + jj;
            const float v = (ps[jx] + ps[64 * 33 + jx]) + (ps[2 * 64 * 33 + jx] + ps[3 * 64 * 33 + jx]);
            const bool valid = jx <= qb, forced = (jx == 0) || (jx == qb) || (jx == qb - 1);
            im[jx] = valid ? v + (forced ? 1e4f : 0.f) : -1e30f; }
        __syncthreads();
        unsigned bits = 0u;
#pragma unroll
        for (int jj = 0; jj < 4; ++jj) { const int jx = jb + jj; const float v = im[jx]; int cnt = 0;
#pragma unroll
            for (int j2 = 0; j2 < 32; ++j2) { const float v2 = im[j2]; cnt += (v2 > v || (v2 == v && j2 < jx)) ? 1 : 0; }
            if (cnt < 16 && jx <= qb) bits |= 1u << jx; }
        bits |= __shfl_xor(bits, 1); bits |= __shfl_xor(bits, 2); bits |= __shfl_xor(bits, 4);
        if ((tid & 7) == 0) { MW[16 + q] = bits; __hip_atomic_fetch_or(MW, bits, __ATOMIC_RELAXED, __HIP_MEMORY_SCOPE_WORKGROUP); }
        __syncthreads();
    }
    if (PARTS & 2) {
    f32x16 o[2]; o[0] = f32x16{}; o[1] = f32x16{}; float m = 0.f, l = 0.f;
    const unsigned mask = MW[16 + sub * 32 + r32];
    const unsigned um = MW[0] & (qb >= 31 ? 0xffffffffu : ((2u << qb) - 1u));
    const bf16_t* Kg = (const bf16_t*)(ws + WS_KVN) + (size_t)(b * SEQ) * 768 + 256 + g * 64;
    attn_loop2(um, Kg, 768, Kg + 128, 768, lds, qr, o, m, l, TfT5{tb, qpos, hi, q0w, 1 << 30, mask, true}, q0w + 31);
    l = halfsum(l);
    scale_rows(o, wsf, sigmoidf_(gates[8 + hg]) / l, r32, hi);
    { bf16_t* ocw = (bf16_t*)(ws + WS_XB) + (size_t)(b * SEQ + q0w) * 512 + hg * 64; store_o<true>(o, lds, ocw, 512, ocw, 512); }
    }
    if (PARTS & 4) {
    f32x16 o[2]; o[0] = f32x16{}; o[1] = f32x16{}; float m = -1e30f, l = 0.f;
    const int lo = qb > 8 ? qb - 8 : 0; const unsigned tmask = (qb >= 31 ? 0xffffffffu : ((2u << qb) - 1u)) & ~((1u << lo) - 1u);
    const bf16_t* Kg = (const bf16_t*)(ws + WS_KVN) + (size_t)(b * SEQ) * 768 + 512 + g * 64;
    attn_loop2(tmask, Kg, 768, Kg + 128, 768, lds, qr, o, m, l, TfT5{tb, qpos, hi, q0w, 512, 0u, false}, q0w + 31);
    l = halfsum(l);
    scale_rows(o, wsf, sigmoidf_(gates[16 + hg]) / l, r32, hi);
    { const bf16_t* ocw = (const bf16_t*)(ws + WS_XB) + (size_t)(b * SEQ + q0w) * 512 + hg * 64; store_o<true>(o, lds, (bf16_t*)(ws + WS_QN) + (size_t)(b * SEQ + q0w) * 512 + hg * 64, 512, ocw, 512); }
    }
}
template <bool DRY> __device__ __forceinline__ void sel_unit(const Args& a, LAS unsigned char* lds, int b, int g, int qb) {
    using namespace att;
    unsigned char* ws = a.ws;
    const int tid = fresh_tid(), lane = tid & 63, r32 = lane & 31, hi = lane >> 5, wid = __builtin_amdgcn_readfirstlane(tid >> 6);
    const int j = wid >> 1, sub = wid & 1, hg = g * 4 + j, q0w = qb * 64 + sub * 32, qpos = q0w + r32; const size_t qrow = (size_t)b * SEQ + qpos;
    const LAS float* tb = (const LAS float*)(lds + L_TBL) + hg * 128; LAS float* wsf = (LAS float*)(lds + L_WSF) + wid * 64;
    bf16_t* Qw = (bf16_t*)(ws + WS_QN) + (size_t)(b * SEQ + q0w) * 512 + hg * 64;
    bf16x8 qr[4]; load_q(qr, Qw, 512, r32, hi);
    const unsigned mask = ((const unsigned*)(ws + WS_MASK))[(size_t)(b * 2 + g) * SEQ + qpos];
    const unsigned um = ((const unsigned*)(ws + WS_UMASK))[(b * 2 + g) * 32 + qb] & (qb >= 31 ? 0xffffffffu : ((2u << qb) - 1u));
    f32x16 o[2]; o[0] = f32x16{}; o[1] = f32x16{}; float m = -1e30f, l = 0.f;
    const bf16_t* Kg = (const bf16_t*)(ws + WS_KVN) + (size_t)(b * SEQ) * 768 + 256 + g * 64;
    attn_loop2(um, Kg, 768, Kg + 128, 768, lds, qr, o, m, l, TfT5{tb, qpos, hi, q0w, 1 << 30, mask, true}, q0w + 31);
    l = halfsum(l);
    const float g1 = sigmoidf_(((const float*)(ws + WS_F32S))[qrow * 32 + 8 + hg]);
    scale_rows(o, wsf, g1 / l, r32, hi);
    store_o<true>(o, lds, DRY ? (bf16_t*)(ws + WS_XB + 16 * MiB) + (size_t)(b * SEQ + q0w) * 512 + hg * 64 : Qw, 512, (const bf16_t*)(ws + WS_XB) + (size_t)(b * SEQ + q0w) * 512 + hg * 64, 512);
}
#ifndef PHMASK
#define PHMASK 0xffffffffu
#endif
#define PH(n) (((PHMASK) >> (n)) & 1u)
#ifndef DUPMASK
#define DUPMASK 0u
#endif
#define DUP(n) (((DUPMASK) >> (n)) & 1u)
#define REP(n) for (int rep_ = 0; rep_ < 1 + (int)DUP(n); ++rep_)
__global__ void __launch_bounds__(512, 2) hybrid_fwd(Args a) {
    extern __shared__ __attribute__((aligned(16))) unsigned char lds_raw[];
    LAS unsigned char* lds = (LAS unsigned char*)lds_raw;
    cg::grid_group grid = cg::this_grid();
    unsigned char* ws = a.ws;
    const int tid = fresh_tid(), lane = tid & 63, wave = __builtin_amdgcn_readfirstlane(tid >> 6);
    const int G = gridDim.x, bx = blockIdx.x, vcu = (G % 8 == 0) ? (bx % 8) * (G / 8) + bx / 8 : bx;
    const int gw = vcu * 8 + wave, NGW = G * 8;
    float* X = a.out;
    bf16_t* XB = (bf16_t*)(ws + WS_XB);
    float* SS = (float*)(ws + WS_SS);
    { volatile LAS unsigned* st0 = (volatile LAS unsigned*)(lds + LDS_BYTES - 256); if (tid < 32) st0[tid] = 0u; }
    __syncthreads();
    XcdBarrier xbar = xcd_barrier_post((unsigned*)(ws + WS_CTL) + CW_BAR, (volatile LAS unsigned*)(lds + LDS_BYTES - 256 + 32));
#ifdef USE_CG_SYNC
#define GSYNC() grid.sync()
#else
    if (a.lo == 0x7e57) grid.sync();
#ifdef TSTAMP
    int gs_cnt = 0; unsigned long long t_start = __builtin_amdgcn_s_memrealtime(), t_rec = 0;
#define GSYNC() do { xcd_barrier(xbar); if (++gs_cnt == TSTAMP) t_rec = __builtin_amdgcn_s_memrealtime(); } while (0)
#else
#define GSYNC() xcd_barrier(xbar)
#endif
#endif
    const float* fin_src = a.in[I_X];

#if STAGE_LIMIT >= 1
    REP(0) p0_prologue(a, lds, gw, NGW, wave, lane);
    GSYNC();
    { pg8::Gemm g{XB, (const bf16_t*)(ws + WS_WGU1), DM, DM, DM, 0, 0, 0, 0}; pg8::Order S; S.init(64, 22, 1, G, bx);
      pg8::EpiGU E{(bf16_t*)(ws + WS_H), SS};
#ifdef P1_NULLDUP
      { pg8::EpiNull E0{(float*)(ws + WS_POSC + 4096)}; pg8::gemm_phase<pg8::EpiNull, true>(lds, g, S, E0); }
#endif
      REP(1) pg8::gemm_phase<pg8::EpiGU, true>(lds, g, S, E);
      if (bx >= 128) { LAS float* scr = (LAS float*)(lds + wave * 16384); for (int it = N_GU + (bx - 128) * 8 + wave; it < CONV_NA; it += 1024) conv_item(a, it, scr, lane); } }
    GSYNC();
    { pg8::Gemm g{(const bf16_t*)(ws + WS_H), (const bf16_t*)(ws + WS_WD1), FF, FF, FF, 0, 0, 0, 0}; pg8::Order S; S.init(64, 4, 1, G, bx);
      if (DUP(2)) { pg8::EpiNull E0{(float*)(ws + WS_POSC + 4096)}; pg8::gemm_phase<pg8::EpiNull, false>(lds, g, S, E0); }
      pg8::EpiRes<true, true> E{a.in[I_X], X, XB, SS + M, 0.5f}; pg8::gemm_phase<pg8::EpiRes<true, true>, false>(lds, g, S, E); }
    GSYNC();
    fin_src = X;
#endif
#if STAGE_LIMIT >= 2
#if PH(3)
    { pg8::Gemm g{XB, (const bf16_t*)(ws + WS_WIN), DM, DM, DM, 0, 0, 0, 0}; pg8::Order S; S.init(64, 20, 1, G, bx);
      pg8::EpiQKV E{(bf16_t*)(ws + WS_QN), (bf16_t*)(ws + WS_KVN), (bf16_t*)(ws + WS_QF), (bf16_t*)(ws + WS_KVF), (bf16_t*)(ws + WS_GAB), (float*)(ws + WS_F32S), SS + M};
      REP(3) pg8::gemm_phase<pg8::EpiQKV, true>(lds, g, S, E); }
#endif
    GSYNC();
#if PH(4)
    REP(4) if (bx < 128) { compress_unit(a, lds, bx); }
    else if (bx < 192) {
        if (bx < 160) { pg8::Gemm g{(const bf16_t*)(ws + WS_MEMB), (const bf16_t*)(ws + WS_WMKV), DM, DM, DM, 0, 0, 0, 0}; pg8::Order S; S.init(8, 4, 1, 32, bx - 128);
            pg8::EpiRowScale E{(bf16_t*)(ws + WS_KM), DM, (const float*)(ws + WS_SSM)}; pg8::gemm_phase<pg8::EpiRowScale, false>(lds, g, S, E); }
        else { pg8::Gemm g{(const bf16_t*)(ws + WS_WMKV) + (size_t)DM * DM, (const bf16_t*)(ws + WS_MEMB), DM, DM, DM, 0, 0, 0, 0}; pg8::Order S; S.init(4, 8, 1, 32, bx - 160);
            pg8::EpiColScale E{(bf16_t*)(ws + WS_VT), MROWS, (const float*)(ws + WS_SSM)}; pg8::gemm_phase<pg8::EpiColScale, false>(lds, g, S, E); }
    } else { if (wave == 0) cumsum_task(a, bx - 192, lane); kmax_task(a, lds, bx - 192, wave, lane); }
    if (bx >= 128) { LAS float* scr = (LAS float*)(lds + wave * 16384); for (int it = CONV_NA + (bx - 128) * 8 + wave; it < CONV_NA + CONV_NB; it += 1024) conv_item(a, it, scr, lane); }
#endif
    GSYNC();
#if PH(5)
    init_t5_table(a, lds);
    { const int bh = vcu >> 2, s = vcu & 3; if (DUP(5)) { fox_unit<true>(a, lds, bh >> 3, bh & 7, 7 - s); fox_unit<true>(a, lds, bh >> 3, bh & 7, s); }
      fox_unit<false>(a, lds, bh >> 3, bh & 7, 7 - s); fox_unit<false>(a, lds, bh >> 3, bh & 7, s); }
#ifdef DUPPART
    { const int bg = vcu >> 4, s = vcu & 15; cmpwin_unit<DUPPART>(a, lds, bg >> 1, bg & 1, 31 - s); cmpwin_unit<DUPPART>(a, lds, bg >> 1, bg & 1, s); }
#endif
#ifndef NO_CMPWIN
    REP(15) { const int bg = vcu >> 4, s = vcu & 15; cmpwin_unit<7>(a, lds, bg >> 1, bg & 1, 31 - s); cmpwin_unit<7>(a, lds, bg >> 1, bg & 1, s); }
#endif
#endif
    GSYNC();
#if PH(7)
    REP(7) { pg8::Order S; S.init(64, 4, 1, G, bx);
      { pg8::Gemm g{(const bf16_t*)(ws + WS_QN), (const bf16_t*)(ws + WS_WUPN), 512, 512, 512, 0, 0, 0, 0}; pg8::EpiUp<0> E{(const bf16_t*)(ws + WS_GAB), (bf16_t*)(ws + WS_Y)}; pg8::gemm_phase<pg8::EpiUp<0>, false>(lds, g, S, E); }
      { pg8::Gemm g{(const bf16_t*)(ws + WS_QF), (const bf16_t*)(ws + WS_WUPF), 512, 512, 512, 0, 0, 0, 0}; pg8::EpiUp<1> E{(const bf16_t*)(ws + WS_GAB), (bf16_t*)(ws + WS_Y)}; pg8::gemm_phase<pg8::EpiUp<1>, false>(lds, g, S, E); } }
#endif
    GSYNC();
#if PH(8)
    { pg8::Gemm g{(const bf16_t*)(ws + WS_Y), (const bf16_t*)(ws + WS_WOUT), DM, DM, DM, 0, 0, 0, 0}; pg8::Order S; S.init(64, 4, 1, G, bx);
      if (DUP(8)) { pg8::EpiNull E0{(float*)(ws + WS_POSC + 4096)}; pg8::gemm_phase<pg8::EpiNull, false>(lds, g, S, E0); }
      pg8::EpiRes<true, true> E{X, X, XB, SS + 2 * M, 1.0f}; pg8::gemm_phase<pg8::EpiRes<true, true>, false>(lds, g, S, E); }
#endif
    GSYNC();
#endif
#if STAGE_LIMIT >= 3
    { pg8::Gemm g{XB, (const bf16_t*)(ws + WS_WMQ), DM, DM, DM, 0, 0, 0, 0}; pg8::Order S; S.init(64, 4, 1, G, bx);
      pg8::EpiRowScale E{(bf16_t*)(ws + WS_QM), DM, SS + 2 * M}; REP(9) pg8::gemm_phase<pg8::EpiRowScale, false>(lds, g, S, E); }
    GSYNC();
    { pg8::Gemm g{(const bf16_t*)(ws + WS_QM), (const bf16_t*)(ws + WS_KM), DM, DM, 256, (long)SEQ * DM, 256, (long)MEMLEN * DM, 256}; pg8::Order S; S.init(8, 1, 32, G, bx);
      pg8::EpiSoftmax E{(bf16_t*)(ws + WS_PM)}; REP(10) pg8::gemm_phase<pg8::EpiSoftmax, false>(lds, g, S, E); }
    GSYNC();
    { pg8::Gemm g{(const bf16_t*)(ws + WS_PM), (const bf16_t*)(ws + WS_VT), 256, MROWS, 256, (long)4 * SEQ * 256, (long)SEQ * 256, 256, (long)256 * MROWS}; pg8::Order S; S.init(8, 1, 32, G, bx);
      pg8::EpiBatchBf16 E{(bf16_t*)(ws + WS_OM), DM, (long)SEQ * DM, 256}; REP(11) pg8::gemm_phase<pg8::EpiBatchBf16, false>(lds, g, S, E); }
    GSYNC();
    { pg8::Gemm g{(const bf16_t*)(ws + WS_OM), (const bf16_t*)(ws + WS_WMO), DM, DM, DM, 0, 0, 0, 0}; pg8::Order S; S.init(64, 4, 1, G, bx);
      pg8::EpiRes<true, true> E{X, X, XB, SS + 3 * M, 1.0f}; pg8::gemm_phase<pg8::EpiRes<true, true>, false>(lds, g, S, E); }
    GSYNC();
#endif
#if STAGE_LIMIT >= 4
    { pg8::Gemm g{XB, (const bf16_t*)(ws + WS_WGU2), DM, DM, DM, 0, 0, 0, 0}; pg8::Order S; S.init(64, 22, 1, G, bx);
      pg8::EpiGU E{(bf16_t*)(ws + WS_H), SS + 3 * M}; pg8::gemm_phase<pg8::EpiGU, true>(lds, g, S, E); }
    GSYNC();
    { pg8::Gemm g{(const bf16_t*)(ws + WS_H), (const bf16_t*)(ws + WS_WD2), FF, FF, FF, 0, 0, 0, 0}; pg8::Order S; S.init(64, 4, 1, G, bx);
      pg8::EpiResNorm E{X, X, 0.5f, a.in[I_FINN], (float*)(ws + WS_XBUF), (unsigned*)(ws + WS_FINCNT)}; pg8::gemm_phase<pg8::EpiResNorm, false>(lds, g, S, E); }
#ifdef TSTAMP
    GSYNC();
    if (t_rec == 0) t_rec = __builtin_amdgcn_s_memrealtime();
    if (bx == 0) { const int n = (int)((t_rec - t_start) * 80 / 100); for (int i = tid; i < n; i += 512) X[i] += 0.1f; }
#endif
    return;
#endif
#ifdef EXTRA_BARS
    for (int eb = 0; eb < EXTRA_BARS; ++eb) GSYNC();
#endif
    { const float* gn = a.in[I_FINN]; const int tid2 = fresh_tid(), lane = tid2 & 63, gw = vcu * 8 + (tid2 >> 6);
      for (int mrow = gw; mrow < M; mrow += NGW) {
          const f32x4* xr = (const f32x4*)(fin_src + (size_t)mrow * DM) + lane; f32x4* orow = (f32x4*)(X + (size_t)mrow * DM) + lane;
          f32x4 v[4]; float s = 0.f;
#pragma unroll
          for (int j = 0; j < 4; ++j) { v[j] = xr[64 * j]; s += (v[j][0] * v[j][0] + v[j][1] * v[j][1]) + (v[j][2] * v[j][2] + v[j][3] * v[j][3]); }
          const float rs = rstd_of(wave_sum(s));
#pragma unroll
          for (int j = 0; j < 4; ++j) orow[64 * j] = v[j] * rs * ((const f32x4*)gn)[lane + 64 * j];
      } }
}

extern "C" void kernel_launch(void* const* d_in, const int* in_sizes, int n_in, void* d_out, int out_size, void* d_ws, size_t ws_size, hipStream_t stream) {
    static int grid = 0;
    if (grid == 0) {
        if (n_in != 29 || out_size != M * DM || ws_size < WS_END) { fprintf(stderr, "kernel_launch: unexpected shapes (n_in %d out %d ws %zu)\n", n_in, out_size, ws_size); grid = -1; return; }
        int dev = 0, cus = 0, per_cu = 0;
        hipGetDevice(&dev); hipDeviceGetAttribute(&cus, hipDeviceAttributeMultiprocessorCount, dev);
        if (hipFuncSetAttribute((const void*)hybrid_fwd, hipFuncAttributeMaxDynamicSharedMemorySize, LDS_BYTES) != hipSuccess) { fprintf(stderr, "kernel_launch: hipFuncSetAttribute failed\n"); grid = -1; return; }
        if (hipOccupancyMaxActiveBlocksPerMultiprocessor(&per_cu, (const void*)hybrid_fwd, 512, LDS_BYTES) != hipSuccess || per_cu < 1) { fprintf(stderr, "kernel_launch: occupancy query failed (%d)\n", per_cu); per_cu = 1; }
        (void)hipGetLastError();
        grid = cus * (per_cu < 1 ? 1 : 1);
        if (grid != 256) fprintf(stderr, "kernel_launch: grid %d != 256: this kernel's phase maps assume 256 workgroups\n", grid);
    }
    if (grid < 0) return;
    hipMemsetAsync((char*)d_ws + WS_CTL, 0, CTL_ZERO_BYTES, stream);
    Args a{};
    for (int i = 0; i < 29; ++i) a.in[i] = (const float*)d_in[i];
    a.out = (float*)d_out; a.ws = (unsigned char*)d_ws; a.lo = 0; a.hi = 0;
    void* args[] = {&a};
    hipError_t e = hipLaunchCooperativeKernel((const void*)hybrid_fwd, dim3(grid), dim3(512), args, LDS_BYTES, stream);
    if (e != hipSuccess) fprintf(stderr, "kernel_launch: cooperative launch failed: %s (grid %d)\n", hipGetErrorString(e), grid);
}
```

```cpp
#define ATT_GRP(w) 0
#include <hip/hip_runtime.h>
#include <hip/hip_cooperative_groups.h>
#include <cstdio>
#include <cstdint>
namespace cg = cooperative_groups;

#define LAS __attribute__((address_space(3)))
typedef unsigned short bf16_t;
typedef short bf16x8 __attribute__((ext_vector_type(8)));
typedef short s16x4 __attribute__((ext_vector_type(4)));
typedef float f32x2 __attribute__((ext_vector_type(2)));
typedef float f32x4 __attribute__((ext_vector_type(4)));
typedef float f32x16 __attribute__((ext_vector_type(16)));
typedef unsigned u32x2 __attribute__((ext_vector_type(2)));
typedef unsigned u32x4 __attribute__((ext_vector_type(4)));
typedef __bf16 bf16x2_t __attribute__((ext_vector_type(2)));

constexpr int NB = 8, SEQ = 2048, DM = 1024, FF = 2816, M = NB * SEQ;
constexpr int MEMLEN = 256, MROWS = NB * MEMLEN;
constexpr float RMS_EPS = 1e-6f;
constexpr float LOG2E = 1.4426950408889634f;
constexpr float QS64 = 0.125f * LOG2E;
constexpr float QS256 = 0.0625f * LOG2E;

__device__ __forceinline__ int fresh_tid() { int t = threadIdx.x; asm volatile("" : "+v"(t)); return t; }
__device__ __forceinline__ unsigned cvtpk(float lo, float hi) { f32x2 v = {lo, hi}; bf16x2_t b = __builtin_convertvector(v, bf16x2_t); return __builtin_bit_cast(unsigned, b); }
__device__ __forceinline__ float bflo(unsigned w) { return __uint_as_float(w << 16); }
__device__ __forceinline__ float bfhi(unsigned w) { return __uint_as_float(w & 0xffff0000u); }
__device__ __forceinline__ u32x4 pack8(f32x4 a, f32x4 b) { u32x4 w; w.x = cvtpk(a[0], a[1]); w.y = cvtpk(a[2], a[3]); w.z = cvtpk(b[0], b[1]); w.w = cvtpk(b[2], b[3]); return w; }
__device__ __forceinline__ float fexp2(float x) { return __builtin_amdgcn_exp2f(x); }
__device__ __forceinline__ float frcp(float x) { return __builtin_amdgcn_rcpf(x); }
__device__ __forceinline__ float sigmoidf_(float x) { return frcp(1.0f + fexp2(-x * LOG2E)); }
__device__ __forceinline__ float rstd_of(float ss) { return __builtin_amdgcn_rsqf(ss * (1.0f / DM) + RMS_EPS); }

namespace pg8 {
constexpr int BM = 256, BK = 64, HALF = 128, HTB = HALF * BK * 2, STAGE_BYTES = 8 * HTB, NXCD = 8, WGM = 8;
__host__ __device__ __forceinline__ int lds_byte(int r, int c) { const int st = (r >> 4) * 2 + (c >> 5), rr = r & 15, cc = c & 31, ob = rr * 64 + cc * 2; return st * 1024 + (ob ^ (((ob >> 9) & 1) << 5)); }
__host__ __device__ __forceinline__ void stage_rc(int b, int& R, int& C) { const int st = b / 1024, sb = b % 1024, swz = sb ^ (((sb >> 9) & 1) << 5); R = (st >> 1) * 16 + swz / 64; C = (st & 1) * 32 + (swz % 64) / 2; }
__host__ __device__ __forceinline__ int perm32(int rho) { const int n = rho >> 4, i = rho & 15; return 8 * (i >> 2) + 4 * n + (i & 3); }

struct Unit { int pm, pn, pb; };
struct Gemm { const bf16_t* A; const bf16_t* Bt; int lda, ldb, K; long sAb, sAh, sBb, sBh; };

struct Order {
    int nM, nN, nwg, G, c, pbs;
    __device__ __forceinline__ void init(int nM_, int nN_, int nB_, int G_, int c_, int pbs_ = -1) { nM = nM_; nN = nN_; nwg = nM_ * nN_ * nB_; G = G_; c = c_; pbs = pbs_; }
    __device__ __forceinline__ bool next(int i, Unit& u) const {
        if (c < 0) return false;
        const long L = (long)i * G + c; if (L >= nwg) return false;
        int wgid = (int)L; { const int q = nwg / NXCD, r = nwg % NXCD, xcd = wgid % NXCD, off = wgid / NXCD; wgid = (xcd < r ? xcd * (q + 1) : r * (q + 1) + (xcd - r) * q) + off; }
        const int per = nM * nN; u.pb = wgid / per; const int w = wgid % per;
        const int nig = WGM * nN, gid = w / nig, fm = gid * WGM, gsz = (nM - fm) < WGM ? (nM - fm) : WGM;
        u.pm = fm + ((w % nig) % gsz); u.pn = (w % nig) / gsz; if (pbs >= 0) u.pb = u.pm >> pbs; return true;
    }
};

struct OneUnit { Unit u; __device__ __forceinline__ bool next(int i, Unit& o) const { if (i != 0) return false; o = u; return true; } };

typedef f32x4 Acc[2][2][4][2];

template <class Epi, bool ALIGN_EPI, class Sched>
__device__ __forceinline__ void gemm_phase(LAS unsigned char* lds, const Gemm g, const Sched& S, const Epi& E) {
    const int tid = fresh_tid(), wid = __builtin_amdgcn_readfirstlane(tid >> 6), lane = tid & 63, wr = wid >> 2, wc = wid & 3, fr = lane & 15, fq = lane >> 4;
    const int K = g.K, nt = K / BK;
    unsigned voffA[2], voffB[2];
#pragma unroll
    for (int i = 0; i < 2; ++i) { int R, C; stage_rc(tid * 16 + i * 8192, R, C); const int Rb = (R & ~31) + perm32(R & 31);
        voffA[i] = (unsigned)(R * g.lda + C) * 2u; voffB[i] = (unsigned)(Rb * g.ldb + C) * 2u; }
    const size_t kstep = (size_t)(BK * 2);
    const size_t hstepA = (size_t)HALF * g.lda * 2, hstepB = (size_t)HALF * g.ldb * 2;
    const size_t tstepA = 2 * hstepA, tstepB = 2 * hstepB;
    const unsigned ldsw = (unsigned)wid * 1024u;
    const int aoff = lds_byte(wr * 64 + fr, fq * 8), boff = lds_byte(wc * 32 + fr, fq * 8);
#define PG8_SA(b, h) (((b) * 2 + (h)) * HTB)
#define PG8_SB(b, h) ((4 + (b) * 2 + (h)) * HTB)
#define PG8_STAGE(bufoff, gbase, voff) do { _Pragma("unroll") for (int _i = 0; _i < 2; ++_i) \
        __builtin_amdgcn_global_load_lds((const unsigned*)((const char*)(gbase) + (voff)[_i]), (LAS unsigned*)(lds + (bufoff) + ldsw + _i * 8192), 16, 0, 0); } while (0)
#define PG8_LDA(dst, b, h) do { _Pragma("unroll") for (int m = 0; m < 4; ++m) _Pragma("unroll") for (int k = 0; k < 2; ++k) dst[m][k] = *(const LAS bf16x8*)(lds + PG8_SA(b, h) + aoff + m * 2048 + k * 1024); } while (0)
#define PG8_LDB(dst, b, h) do { _Pragma("unroll") for (int n = 0; n < 2; ++n) _Pragma("unroll") for (int k = 0; k < 2; ++k) dst[n][k] = *(const LAS bf16x8*)(lds + PG8_SB(b, h) + boff + n * 2048 + k * 1024); } while (0)
#define PG8_MMA(ai, bj, At, Bt) do { __builtin_amdgcn_s_setprio(1); _Pragma("unroll") for (int m = 0; m < 4; ++m) _Pragma("unroll") for (int n = 0; n < 2; ++n) _Pragma("unroll") for (int k = 0; k < 2; ++k) \
        acc[ai][bj][m][n] = __builtin_amdgcn_mfma_f32_16x16x32_bf16(Bt[n][k], At[m][k], acc[ai][bj][m][n], 0, 0, 0); __builtin_amdgcn_s_setprio(0); } while (0)
#define PG8_WAIT_V(n) asm volatile("s_waitcnt vmcnt(" #n ")" ::: "memory")
#define PG8_WAIT_L(n) asm volatile("s_waitcnt lgkmcnt(" #n ")" ::: "memory")
#define PG8_BAR __builtin_amdgcn_s_barrier()
#define PG8_SCHED __builtin_amdgcn_sched_barrier(0)
#define PG8_OFFA(u) ((size_t)(((u).pb >> 2) * g.sAb + ((u).pb & 3) * g.sAh) * 2 + (size_t)(u).pm * tstepA)
#define PG8_OFFB(u) ((size_t)(((u).pb >> 2) * g.sBb + ((u).pb & 3) * g.sBh) * 2 + (size_t)(u).pn * tstepB)
    Unit cur, nxt; int ui = 0;
    if (!S.next(0, cur)) return;
    Acc acc;
#pragma unroll
    for (int a = 0; a < 2; ++a)
#pragma unroll
        for (int b = 0; b < 2; ++b)
#pragma unroll
            for (int m = 0; m < 4; ++m)
#pragma unroll
                for (int n = 0; n < 2; ++n) acc[a][b][m][n] = (f32x4){0.f, 0.f, 0.f, 0.f};
    bf16x8 At[4][2], B0[2][2], B1[2][2];
    const char* cA = (const char*)g.A + PG8_OFFA(cur); const char* cB = (const char*)g.Bt + PG8_OFFB(cur);
    {
        PG8_STAGE(PG8_SB(0, 0), cB, voffB); PG8_STAGE(PG8_SB(0, 1), cB + hstepB, voffB); PG8_STAGE(PG8_SA(0, 0), cA, voffA); PG8_STAGE(PG8_SA(0, 1), cA + hstepA, voffA);
        if (wr == 1) PG8_BAR;
        PG8_WAIT_V(2); PG8_BAR;
        PG8_STAGE(PG8_SB(1, 0), cB + kstep, voffB); PG8_STAGE(PG8_SA(1, 0), cA + kstep, voffA); PG8_STAGE(PG8_SB(1, 1), cB + hstepB + kstep, voffB);
        PG8_WAIT_V(6); PG8_BAR;
    }
    for (;;) {
        const bool has_next = S.next(ui + 1, nxt);
        const char* nA = has_next ? (const char*)g.A + PG8_OFFA(nxt) : cA; const char* nB = has_next ? (const char*)g.Bt + PG8_OFFB(nxt) : cB;
        for (int t = 0; t < nt; t += 2) {
            const bool last = (t == nt - 2);
            const char* a1 = cA + (size_t)(t + 1) * kstep;
            const char* a2 = last ? nA : cA + (size_t)(t + 2) * kstep; const char* b2 = last ? nB : cB + (size_t)(t + 2) * kstep;
            const char* a3 = a2 + kstep; const char* b3 = b2 + kstep;
            PG8_LDB(B0, 0, 0); PG8_LDB(B1, 0, 1); PG8_SCHED; PG8_LDA(At, 0, 0); PG8_STAGE(PG8_SA(1, 1), a1 + hstepA, voffA);
            PG8_WAIT_V(8); PG8_WAIT_L(0); PG8_BAR; PG8_MMA(0, 0, At, B0); PG8_MMA(0, 1, At, B1); PG8_BAR; PG8_SCHED;
            PG8_LDA(At, 0, 1); PG8_STAGE(PG8_SB(0, 0), b2, voffB); PG8_STAGE(PG8_SB(0, 1), b2 + hstepB, voffB); PG8_STAGE(PG8_SA(0, 0), a2, voffA);
            PG8_WAIT_V(8); PG8_WAIT_L(0); PG8_BAR; PG8_MMA(1, 0, At, B0); PG8_MMA(1, 1, At, B1); PG8_BAR; PG8_SCHED;
            PG8_LDB(B0, 1, 0); PG8_LDB(B1, 1, 1); PG8_SCHED; PG8_LDA(At, 1, 0); PG8_STAGE(PG8_SA(0, 1), a2 + hstepA, voffA);
            PG8_WAIT_V(8); PG8_WAIT_L(0); PG8_BAR; PG8_MMA(0, 0, At, B0); PG8_MMA(0, 1, At, B1); PG8_BAR; PG8_SCHED;
            PG8_LDA(At, 1, 1); PG8_STAGE(PG8_SB(1, 0), b3, voffB); PG8_STAGE(PG8_SB(1, 1), b3 + hstepB, voffB); PG8_STAGE(PG8_SA(1, 0), a3, voffA);
            PG8_WAIT_V(8); PG8_WAIT_L(0); PG8_BAR; PG8_MMA(1, 0, At, B0); PG8_MMA(1, 1, At, B1); PG8_BAR; PG8_SCHED;
        }
        if constexpr (ALIGN_EPI) { if (wr == 0) PG8_BAR; }
        if constexpr (!Epi::AFTER_DRAIN) { const int l2_ = fresh_tid() & 63; E(acc, cur, wr, wc, l2_ & 15, l2_ >> 4); }
        if (!has_next) break;
#pragma unroll
        for (int a = 0; a < 2; ++a)
#pragma unroll
            for (int b = 0; b < 2; ++b)
#pragma unroll
                for (int m = 0; m < 4; ++m)
#pragma unroll
                    for (int n = 0; n < 2; ++n) acc[a][b][m][n] = (f32x4){0.f, 0.f, 0.f, 0.f};
        cur = nxt; cA = nA; cB = nB; ++ui;
        if constexpr (ALIGN_EPI) { if (wr == 1) PG8_BAR; }
    }
    PG8_WAIT_V(0);
    if constexpr (!ALIGN_EPI) { if (wr == 0) PG8_BAR; }
    PG8_BAR;
    if constexpr (Epi::AFTER_DRAIN) { const int l2_ = fresh_tid() & 63; E.fused(acc, cur, wr, wc, l2_ & 15, l2_ >> 4, lds, wid, l2_); }
#undef PG8_SA
#undef PG8_SB
#undef PG8_STAGE
#undef PG8_LDA
#undef PG8_LDB
#undef PG8_MMA
#undef PG8_WAIT_V
#undef PG8_WAIT_L
#undef PG8_BAR
#undef PG8_SCHED
#undef PG8_OFFA
#undef PG8_OFFB
}

struct EpiNull { static constexpr bool AFTER_DRAIN = false; float* sink; __device__ __forceinline__ void operator()(const Acc& acc, const Unit& u, int wr, int wc, int fr, int fq) const { f32x4 s = {0.f, 0.f, 0.f, 0.f};
_Pragma("unroll") for (int a = 0; a < 2; ++a) _Pragma("unroll") for (int b = 0; b < 2; ++b) _Pragma("unroll") for (int m = 0; m < 4; ++m) _Pragma("unroll") for (int n = 0; n < 2; ++n) s += acc[a][b][m][n];
 if (s[0] + s[1] + s[2] + s[3] == 1234567.25f) sink[0] = 1.f; } };
struct EpiGU {
    static constexpr bool AFTER_DRAIN = false;
    bf16_t* H; const float* ss;
    __device__ __forceinline__ void operator()(const Acc& acc, const Unit& u, int wr, int wc, int fr, int fq) const {
        const int row0 = u.pm * BM + wr * 64 + fr, col0 = u.pn * 128 + wc * 32 + fq * 8;
#pragma unroll
        for (int ai = 0; ai < 2; ++ai)
#pragma unroll
            for (int m = 0; m < 4; ++m) {
                const int row = row0 + ai * HALF + m * 16; const float rs = rstd_of(ss[row]);
                f32x4 h[2];
#pragma unroll
                for (int n = 0; n < 2; ++n) { const f32x4 gg = acc[ai][0][m][n] * rs, uu = acc[ai][1][m][n] * rs;
#pragma unroll
                    for (int j = 0; j < 4; ++j) h[n][j] = gg[j] * sigmoidf_(gg[j]) * uu[j]; }
                *(u32x4*)(H + (size_t)row * FF + col0) = pack8(h[0], h[1]);
            }
    }
};
template <bool WRITE_XB, bool WRITE_SS> struct EpiRes {
    static constexpr bool AFTER_DRAIN = false;
    const float* base; float* out; bf16_t* xb; float* ss; float scale;
    __device__ __forceinline__ void operator()(const Acc& acc, const Unit& u, int wr, int wc, int fr, int fq) const {
        const int row0 = u.pm * BM + wr * 64 + fr, col0 = u.pn * BM + wc * 32 + fq * 8;
#pragma unroll
        for (int ai = 0; ai < 2; ++ai)
#pragma unroll
            for (int m2 = 0; m2 < 4; m2 += 2) {
                f32x4 o[2][2][2];
#pragma unroll
                for (int mm = 0; mm < 2; ++mm)
#pragma unroll
                    for (int bj = 0; bj < 2; ++bj) { const size_t p = (size_t)(row0 + ai * HALF + (m2 + mm) * 16) * DM + col0 + bj * HALF; o[mm][bj][0] = *(const f32x4*)(base + p); o[mm][bj][1] = *(const f32x4*)(base + p + 4); }
#pragma unroll
                for (int mm = 0; mm < 2; ++mm) { const int m = m2 + mm, row = row0 + ai * HALF + m * 16; float sq = 0.f;
#pragma unroll
                    for (int bj = 0; bj < 2; ++bj) { const size_t p = (size_t)row * DM + col0 + bj * HALF;
                        const f32x4 n0 = o[mm][bj][0] + acc[ai][bj][m][0] * scale, n1 = o[mm][bj][1] + acc[ai][bj][m][1] * scale;
                        *(f32x4*)(out + p) = n0; *(f32x4*)(out + p + 4) = n1;
                        if (WRITE_XB) *(u32x4*)(xb + p) = pack8(n0, n1);
                        if (WRITE_SS) sq += (n0[0] * n0[0] + n0[1] * n0[1]) + (n0[2] * n0[2] + n0[3] * n0[3]) + (n1[0] * n1[0] + n1[1] * n1[1]) + (n1[2] * n1[2] + n1[3] * n1[3]); }
                    if (WRITE_SS) { sq += __shfl_xor(sq, 16); sq += __shfl_xor(sq, 32); if (fq == 0) unsafeAtomicAdd(ss + row, sq); } }
                asm volatile("" ::: "memory");
            }
    }
};
struct EpiQKV {
    static constexpr bool AFTER_DRAIN = false;
    bf16_t *QN, *KVN, *QF, *KVF, *GAB; float* F32S; const float* ss;
    __device__ __forceinline__ void operator()(const Acc& acc, const Unit& u, int wr, int wc, int fr, int fq) const {
        const int row0 = u.pm * BM + wr * 64 + fr, pn = u.pn;
        if (pn == 19) {
            if (wc == 0) {
#pragma unroll
                for (int ai = 0; ai < 2; ++ai)
#pragma unroll
                    for (int m = 0; m < 4; ++m) { const int row = row0 + ai * HALF + m * 16; const float rs = rstd_of(ss[row]);
                        *(f32x4*)(F32S + (size_t)row * 32 + fq * 8) = acc[ai][0][m][0] * rs; *(f32x4*)(F32S + (size_t)row * 32 + fq * 8 + 4) = acc[ai][0][m][1] * rs; }
            }
            return;
        }
        bf16_t* dst; int pitch, coff;
        if (pn < 2) { dst = QN; pitch = 512; coff = pn * 256; }
        else if (pn < 5) { dst = KVN; pitch = 768; coff = (pn - 2) * 256; }
        else if (pn < 7) { dst = QF; pitch = 512; coff = (pn - 5) * 256; }
        else if (pn < 11) { dst = KVF; pitch = 1024; coff = (pn - 7) * 256; }
        else { dst = GAB; pitch = 2048; coff = (pn - 11) * 256; }
        coff += wc * 32 + fq * 8;
#pragma unroll
        for (int ai = 0; ai < 2; ++ai)
#pragma unroll
            for (int m = 0; m < 4; ++m) { const int row = row0 + ai * HALF + m * 16; const float rs = rstd_of(ss[row]);
#pragma unroll
                for (int bj = 0; bj < 2; ++bj) *(u32x4*)(dst + (size_t)row * pitch + coff + bj * HALF) = pack8(acc[ai][bj][m][0] * rs, acc[ai][bj][m][1] * rs); }
    }
};
template <int STEP> struct EpiUp {
    static constexpr bool AFTER_DRAIN = false;
    const bf16_t* GAB; bf16_t* Y;
    __device__ __forceinline__ void operator()(const Acc& acc, const Unit& u, int wr, int wc, int fr, int fq) const {
        const int row0 = u.pm * BM + wr * 64 + fr, col0 = u.pn * BM + wc * 32 + fq * 8;
#pragma unroll
        for (int ai = 0; ai < 2; ++ai)
#pragma unroll
            for (int m = 0; m < 4; ++m) { const int row = row0 + ai * HALF + m * 16;
#pragma unroll
                for (int bj = 0; bj < 2; ++bj) { const int c = col0 + bj * HALF;
                    const u32x4 gw = *(const u32x4*)(GAB + (size_t)row * 2048 + STEP * 1024 + c);
                    f32x4 v0, v1; const f32x4 a0 = acc[ai][bj][m][0], a1 = acc[ai][bj][m][1];
                    v0[0] = sigmoidf_(bflo(gw.x)) * a0[0]; v0[1] = sigmoidf_(bfhi(gw.x)) * a0[1]; v0[2] = sigmoidf_(bflo(gw.y)) * a0[2]; v0[3] = sigmoidf_(bfhi(gw.y)) * a0[3];
                    v1[0] = sigmoidf_(bflo(gw.z)) * a1[0]; v1[1] = sigmoidf_(bfhi(gw.z)) * a1[1]; v1[2] = sigmoidf_(bflo(gw.w)) * a1[2]; v1[3] = sigmoidf_(bfhi(gw.w)) * a1[3];
                    bf16_t* yp = Y + (size_t)row * DM + c;
                    if (STEP == 1) { const u32x4 y = *(const u32x4*)yp;
                        v0[0] += bflo(y.x); v0[1] += bfhi(y.x); v0[2] += bflo(y.y); v0[3] += bfhi(y.y); v1[0] += bflo(y.z); v1[1] += bfhi(y.z); v1[2] += bflo(y.w); v1[3] += bfhi(y.w); }
                    *(u32x4*)yp = pack8(v0, v1); }
                asm volatile("" ::: "memory"); }
    }
};
struct EpiRowScale {
    static constexpr bool AFTER_DRAIN = false;
    bf16_t* O; int ldo; const float* ss;
    __device__ __forceinline__ void operator()(const Acc& acc, const Unit& u, int wr, int wc, int fr, int fq) const {
        const int row0 = u.pm * BM + wr * 64 + fr, col0 = u.pn * BM + wc * 32 + fq * 8;
#pragma unroll
        for (int ai = 0; ai < 2; ++ai)
#pragma unroll
            for (int m = 0; m < 4; ++m) { const int row = row0 + ai * HALF + m * 16; const float rs = rstd_of(ss[row]);
#pragma unroll
                for (int bj = 0; bj < 2; ++bj) *(u32x4*)(O + (size_t)row * ldo + col0 + bj * HALF) = pack8(acc[ai][bj][m][0] * rs, acc[ai][bj][m][1] * rs); }
    }
};
struct EpiColScale {
    static constexpr bool AFTER_DRAIN = false;
    bf16_t* O; int ldo; const float* ss;
    __device__ __forceinline__ void operator()(const Acc& acc, const Unit& u, int wr, int wc, int fr, int fq) const {
        const int row0 = u.pm * BM + wr * 64 + fr, col0 = u.pn * BM + wc * 32 + fq * 8;
#pragma unroll
        for (int bj = 0; bj < 2; ++bj) { const int c = col0 + bj * HALF;
            f32x4 s0 = *(const f32x4*)(ss + c), s1 = *(const f32x4*)(ss + c + 4);
#pragma unroll
            for (int j = 0; j < 4; ++j) { s0[j] = rstd_of(s0[j]); s1[j] = rstd_of(s1[j]); }
#pragma unroll
            for (int ai = 0; ai < 2; ++ai)
#pragma unroll
                for (int m = 0; m < 4; ++m) { const int row = row0 + ai * HALF + m * 16;
                    *(u32x4*)(O + (size_t)row * ldo + c) = pack8(acc[ai][bj][m][0] * s0, acc[ai][bj][m][1] * s1); } }
    }
};
struct EpiBatchBf16 {
    static constexpr bool AFTER_DRAIN = false;
    bf16_t* O; int ldo; long sOb, sOh;
    __device__ __forceinline__ void operator()(const Acc& acc, const Unit& u, int wr, int wc, int fr, int fq) const {
        const int row0 = u.pm * BM + wr * 64 + fr, col0 = u.pn * BM + wc * 32 + fq * 8;
        bf16_t* Ob = O + (size_t)((u.pb >> 2) * sOb + (u.pb & 3) * sOh);
#pragma unroll
        for (int ai = 0; ai < 2; ++ai)
#pragma unroll
            for (int m = 0; m < 4; ++m) { const int row = row0 + ai * HALF + m * 16;
#pragma unroll
                for (int bj = 0; bj < 2; ++bj) *(u32x4*)(Ob + (size_t)row * ldo + col0 + bj * HALF) = pack8(acc[ai][bj][m][0], acc[ai][bj][m][1]); }
    }
};
struct EpiSoftmax {
    static constexpr bool AFTER_DRAIN = true;
    bf16_t* P;
    __device__ __forceinline__ void fused(Acc& acc, const Unit& u, int wr, int wc, int fr, int fq, LAS unsigned char* lds, int wid, int lane) const {
        LAS float* Pm = (LAS float*)lds;
        LAS float* Ps = (LAS float*)(lds + 8192);
#pragma unroll
        for (int ai = 0; ai < 2; ++ai)
#pragma unroll
            for (int m = 0; m < 4; ++m) { float mx = -3.0e38f;
#pragma unroll
                for (int bj = 0; bj < 2; ++bj)
#pragma unroll
                    for (int n = 0; n < 2; ++n) { const f32x4 x = acc[ai][bj][m][n]; mx = fmaxf(mx, fmaxf(fmaxf(x[0], x[1]), fmaxf(x[2], x[3]))); }
                mx = fmaxf(mx, __shfl_xor(mx, 16)); mx = fmaxf(mx, __shfl_xor(mx, 32));
                if (fq == 0) Pm[(ai * HALF + wr * 64 + m * 16 + fr) * 4 + wc] = mx; }
        __syncthreads();
#pragma unroll
        for (int ai = 0; ai < 2; ++ai)
#pragma unroll
            for (int m = 0; m < 4; ++m) { const int r = ai * HALF + wr * 64 + m * 16 + fr; const f32x4 t = *(const LAS f32x4*)(Pm + r * 4);
                const float mx = fmaxf(fmaxf(t[0], t[1]), fmaxf(t[2], t[3])); float s = 0.f;
#pragma unroll
                for (int bj = 0; bj < 2; ++bj)
#pragma unroll
                    for (int n = 0; n < 2; ++n) { f32x4 x = acc[ai][bj][m][n];
#pragma unroll
                        for (int j = 0; j < 4; ++j) { x[j] = fexp2(x[j] - mx); s += x[j]; }
                        acc[ai][bj][m][n] = x; }
                s += __shfl_xor(s, 16); s += __shfl_xor(s, 32);
                if (fq == 0) Ps[r * 4 + wc] = s; }
        __syncthreads();
        bf16_t* Pb = P + (size_t)u.pb * SEQ * 256;
        const int col0 = wc * 32 + fq * 8;
#pragma unroll
        for (int ai = 0; ai < 2; ++ai)
#pragma unroll
            for (int m = 0; m < 4; ++m) { const int r = ai * HALF + wr * 64 + m * 16 + fr; const f32x4 t = *(const LAS f32x4*)(Ps + r * 4);
                const float inv = frcp((t[0] + t[1]) + (t[2] + t[3])); const int row = u.pm * BM + r;
#pragma unroll
                for (int bj = 0; bj < 2; ++bj) *(u32x4*)(Pb + (size_t)row * 256 + col0 + bj * HALF) = pack8(acc[ai][bj][m][0] * inv, acc[ai][bj][m][1] * inv); }
        __syncthreads();
    }
};
struct EpiSoftmaxRS {
    static constexpr bool AFTER_DRAIN = true;
    bf16_t* P; int ldp; const float* ss;
    __device__ __forceinline__ void fused(Acc& acc, const Unit& u, int wr, int wc, int fr, int fq, LAS unsigned char* lds, int wid, int lane) const {
        LAS float* Pm = (LAS float*)lds; LAS float* Ps = (LAS float*)(lds + 8192);
#pragma unroll
        for (int ai = 0; ai < 2; ++ai)
#pragma unroll
            for (int m = 0; m < 4; ++m) { const float rs = rstd_of(ss[u.pm * BM + ai * HALF + wr * 64 + m * 16 + fr]); float mx = -3.0e38f;
#pragma unroll
                for (int bj = 0; bj < 2; ++bj)
#pragma unroll
                    for (int n = 0; n < 2; ++n) { const f32x4 x = acc[ai][bj][m][n] * rs; acc[ai][bj][m][n] = x; mx = fmaxf(mx, fmaxf(fmaxf(x[0], x[1]), fmaxf(x[2], x[3]))); }
                mx = fmaxf(mx, __shfl_xor(mx, 16)); mx = fmaxf(mx, __shfl_xor(mx, 32));
                if (fq == 0) Pm[(ai * HALF + wr * 64 + m * 16 + fr) * 4 + wc] = mx; }
        __syncthreads();
#pragma unroll
        for (int ai = 0; ai < 2; ++ai)
#pragma unroll
            for (int m = 0; m < 4; ++m) { const int r = ai * HALF + wr * 64 + m * 16 + fr; const f32x4 t = *(const LAS f32x4*)(Pm + r * 4);
                const float mx = fmaxf(fmaxf(t[0], t[1]), fmaxf(t[2], t[3])); float s = 0.f;
#pragma unroll
                for (int bj = 0; bj < 2; ++bj)
#pragma unroll
                    for (int n = 0; n < 2; ++n) { f32x4 x = acc[ai][bj][m][n];
#pragma unroll
                        for (int j = 0; j < 4; ++j) { x[j] = fexp2(x[j] - mx); s += x[j]; }
                        acc[ai][bj][m][n] = x; }
                s += __shfl_xor(s, 16); s += __shfl_xor(s, 32);
                if (fq == 0) Ps[r * 4 + wc] = s; }
        __syncthreads();
        const int col0 = u.pn * BM + wc * 32 + fq * 8;
#pragma unroll
        for (int ai = 0; ai < 2; ++ai)
#pragma unroll
            for (int m = 0; m < 4; ++m) { const int r = ai * HALF + wr * 64 + m * 16 + fr; const f32x4 t = *(const LAS f32x4*)(Ps + r * 4);
                const float inv = frcp((t[0] + t[1]) + (t[2] + t[3])); const int row = u.pm * BM + r;
#pragma unroll
                for (int bj = 0; bj < 2; ++bj) *(u32x4*)(P + (size_t)row * ldp + col0 + bj * HALF) = pack8(acc[ai][bj][m][0] * inv, acc[ai][bj][m][1] * inv); }
        __syncthreads();
    }
};
struct EpiResNorm {
    static constexpr bool AFTER_DRAIN = true;
    const float* Xold; float* out; float scale; const float* gn; float* xbuf; unsigned* cnt;
    __device__ __forceinline__ void fused(Acc& acc, const Unit& u, int wr, int wc, int fr, int fq, LAS unsigned char* lds, int wid, int lane) const {
        LAS float* P = (LAS float*)lds;
        LAS float* S = (LAS float*)(lds + 4096);
        const int row0 = u.pm * BM + wr * 64 + fr, col0 = u.pn * BM + wc * 32 + fq * 8;
#pragma unroll
        for (int ai = 0; ai < 2; ++ai)
#pragma unroll
            for (int m = 0; m < 4; ++m) { const int row = row0 + ai * HALF + m * 16; float sq = 0.f;
#pragma unroll
                for (int bj = 0; bj < 2; ++bj) { const size_t p = (size_t)row * DM + col0 + bj * HALF;
                    const f32x4 o0 = *(const f32x4*)(Xold + p), o1 = *(const f32x4*)(Xold + p + 4);
                    const f32x4 n0 = o0 + acc[ai][bj][m][0] * scale, n1 = o1 + acc[ai][bj][m][1] * scale;
                    acc[ai][bj][m][0] = n0; acc[ai][bj][m][1] = n1;
                    sq += (n0[0] * n0[0] + n0[1] * n0[1]) + (n0[2] * n0[2] + n0[3] * n0[3]) + (n1[0] * n1[0] + n1[1] * n1[1]) + (n1[2] * n1[2] + n1[3] * n1[3]); }
                sq += __shfl_xor(sq, 16); sq += __shfl_xor(sq, 32);
                if (fq == 0) P[(ai * HALF + wr * 64 + m * 16 + fr) * 4 + wc] = sq;
                if (m & 1) asm volatile("" ::: "memory"); }
        __syncthreads();
        const int prow = wid * 32 + (lane & 31);
        if (lane < 32) { const f32x4 t = *(const LAS f32x4*)(P + prow * 4);
            __hip_atomic_store(xbuf + (size_t)(u.pm * BM + prow) * 4 + u.pn, (t[0] + t[1]) + (t[2] + t[3]), __ATOMIC_RELAXED, __HIP_MEMORY_SCOPE_AGENT); }
        asm volatile("s_waitcnt vmcnt(0)" ::: "memory");
        if (lane == 0) __hip_atomic_fetch_add(cnt + 64 * u.pm, 1u, __ATOMIC_RELAXED, __HIP_MEMORY_SCOPE_AGENT);
        if (wid == 0) { unsigned sp = 0;
            while ((unsigned)__builtin_amdgcn_readfirstlane(__hip_atomic_load(cnt + 64 * u.pm, __ATOMIC_RELAXED, __HIP_MEMORY_SCOPE_AGENT)) < 32u) { __builtin_amdgcn_s_sleep(2); if (++sp > (1u << 20)) break; }
            __builtin_amdgcn_fence(__ATOMIC_ACQUIRE, "agent"); }
        asm volatile("s_waitcnt vmcnt(0) lgkmcnt(0)" ::: "memory");
        __syncthreads();
        if (lane < 32) { const float* sl = xbuf + (size_t)(u.pm * BM + prow) * 4; float s = 0.f;
#pragma unroll
            for (int t = 0; t < 4; ++t) s += __hip_atomic_load(sl + t, __ATOMIC_RELAXED, __HIP_MEMORY_SCOPE_AGENT);
            S[prow] = rstd_of(s); }
        __syncthreads();
        f32x4 gg[2][2];
#pragma unroll
        for (int bj = 0; bj < 2; ++bj) { gg[bj][0] = *(const f32x4*)(gn + col0 + bj * HALF); gg[bj][1] = *(const f32x4*)(gn + col0 + bj * HALF + 4); }
#pragma unroll
        for (int ai = 0; ai < 2; ++ai)
#pragma unroll
            for (int m = 0; m < 4; ++m) { const int r = ai * HALF + wr * 64 + m * 16 + fr; const float rs = S[r]; const size_t p0 = (size_t)(u.pm * BM + r) * DM + col0;
#pragma unroll
                for (int bj = 0; bj < 2; ++bj) { *(f32x4*)(out + p0 + bj * HALF) = acc[ai][bj][m][0] * rs * gg[bj][0]; *(f32x4*)(out + p0 + bj * HALF + 4) = acc[ai][bj][m][1] * rs * gg[bj][1]; } }
    }
};
}
namespace att {
__device__ __forceinline__ int crow(int r, int hi) { return (r & 3) + 8 * (r >> 2) + 4 * hi; }
#define SBAR() __builtin_amdgcn_sched_barrier(0)
constexpr float NEG = -INFINITY;
constexpr int L_SLOT = 0;
constexpr int L_VR = 24576;
constexpr int L_WSF = 49152;
constexpr int L_OST = L_WSF + 2048;
constexpr int L_TBL = L_OST + 32768;
constexpr int L_CB = L_TBL + 4096;
constexpr int L_PS = L_CB + 8192;
constexpr int L_IMP = L_PS + 4 * 64 * 33 * 4;
constexpr int L_MISC = L_IMP + 64 * 33 * 4;
constexpr int L_END = L_MISC + 64 + 256 + 64;
static_assert(L_END <= 147456 - 256, "attention LDS map");

__device__ __forceinline__ void qkt(f32x16& p0, f32x16& p1, const LAS unsigned char* Kslot, const bf16x8 (&qr)[4], int r32, int hi) {
    const LAS unsigned char* kb = Kslot + hi * 1024 + r32 * 16;
    p0 = f32x16{}; p1 = f32x16{};
#pragma unroll
    for (int d0 = 0; d0 < 4; ++d0) {
        const bf16x8 b0 = *(const LAS bf16x8*)(kb + d0 * 2048);
        const bf16x8 b1 = *(const LAS bf16x8*)(kb + d0 * 2048 + 512);
        p0 = __builtin_amdgcn_mfma_f32_32x32x16_bf16(b0, qr[d0], p0, 0, 0, 0);
        p1 = __builtin_amdgcn_mfma_f32_32x32x16_bf16(b1, qr[d0], p1, 0, 0, 0);
    }
}
__device__ __forceinline__ void pv(f32x16 (&o)[2], int vb, bf16x8 pa0, bf16x8 pa1, bf16x8 pa2, bf16x8 pa3) {
#pragma unroll
    for (int d0 = 0; d0 < 2; ++d0) { s16x4 lo[4], hi[4];
#pragma unroll
        for (int ks = 0; ks < 4; ++ks) {
            asm volatile("ds_read_b64_tr_b16 %0,%1 offset:%c2" : "=&v"(lo[ks]) : "v"(vb), "i"(d0 * 4096 + ks * 1024) : "memory");
            asm volatile("ds_read_b64_tr_b16 %0,%1 offset:%c2" : "=&v"(hi[ks]) : "v"(vb), "i"(d0 * 4096 + ks * 1024 + 512) : "memory"); }
        asm volatile("s_waitcnt lgkmcnt(0)" ::: "memory"); SBAR();
#define PK(k) (bf16x8){lo[k][0], lo[k][1], lo[k][2], lo[k][3], hi[k][0], hi[k][1], hi[k][2], hi[k][3]}
        o[d0] = __builtin_amdgcn_mfma_f32_32x32x16_bf16(pa0, PK(0), o[d0], 0, 0, 0);
        o[d0] = __builtin_amdgcn_mfma_f32_32x32x16_bf16(pa1, PK(1), o[d0], 0, 0, 0);
        o[d0] = __builtin_amdgcn_mfma_f32_32x32x16_bf16(pa2, PK(2), o[d0], 0, 0, 0);
        o[d0] = __builtin_amdgcn_mfma_f32_32x32x16_bf16(pa3, PK(3), o[d0], 0, 0, 0);
#undef PK
    }
}
__device__ __forceinline__ float rowmax32(const f32x16& p0, const f32x16& p1) {
    float a = fmaxf(p0[0], p1[0]);
#pragma unroll
    for (int r = 1; r < 16; ++r) a = fmaxf(a, fmaxf(p0[r], p1[r]));
    auto rr = __builtin_amdgcn_permlane32_swap(__float_as_uint(a), __float_as_uint(a), false, false);
    return fmaxf(__uint_as_float(rr[0]), __uint_as_float(rr[1]));
}
__device__ __forceinline__ float halfsum(float v) {
    auto rr = __builtin_amdgcn_permlane32_swap(__float_as_uint(v), __float_as_uint(v), false, false);
    return __uint_as_float(rr[0]) + __uint_as_float(rr[1]);
}
#define PKW(P, B) cvtpk(P[B], P[B + 1])
__device__ __forceinline__ void pack_p(const f32x16& p0, const f32x16& p1, bf16x8& a0, bf16x8& a1, bf16x8& a2, bf16x8& a3) {
    const u32x4 w0 = {PKW(p0, 0), PKW(p0, 2), PKW(p0, 4), PKW(p0, 6)}, w1 = {PKW(p0, 8), PKW(p0, 10), PKW(p0, 12), PKW(p0, 14)};
    const u32x4 w2 = {PKW(p1, 0), PKW(p1, 2), PKW(p1, 4), PKW(p1, 6)}, w3 = {PKW(p1, 8), PKW(p1, 10), PKW(p1, 12), PKW(p1, 14)};
    a0 = __builtin_bit_cast(bf16x8, w0); a1 = __builtin_bit_cast(bf16x8, w1); a2 = __builtin_bit_cast(bf16x8, w2); a3 = __builtin_bit_cast(bf16x8, w3);
}
#undef PKW
__device__ __forceinline__ void scale_rows(f32x16 (&o)[2], LAS float* wsf, float v, int r32, int hi) {
    if (hi == 0) wsf[r32] = v;
    asm volatile("s_waitcnt lgkmcnt(0)" ::: "memory");
#pragma unroll
    for (int i = 0; i < 4; ++i) { const f32x4 f = *(const LAS f32x4*)(wsf + 8 * i + 4 * hi);
#pragma unroll
        for (int j = 0; j < 4; ++j) { o[0][4 * i + j] *= f[j]; o[1][4 * i + j] *= f[j]; } }
    asm volatile("s_waitcnt lgkmcnt(0)" ::: "memory");
}
struct StageGeo { int krow, kcol, koff, vrow, vcol, voff; };
__device__ __forceinline__ StageGeo stage_geo(int tid) {
    StageGeo s; const int w = tid >> 6, ln = tid & 63;
    s.krow = ln; s.kcol = w * 8; s.koff = w * 1024 + ln * 16;
    s.vrow = 16 * (w & 3) + (ln >> 2); s.vcol = (w >> 2) * 32 + (ln & 3) * 8; s.voff = 8192 + w * 1024 + ln * 16;
    return s;
}
template <class Mod>
__device__ __forceinline__ void tile_step(const LAS unsigned char* slot, const bf16x8 (&qr)[4], f32x16 (&o)[2], float& m, float& l, LAS float* wsf, const Mod& mod, int r32, int hi, int vb) {
    f32x16 p0, p1;
    qkt(p0, p1, slot, qr, r32, hi);
    mod(p0, p1);
    const float rm = rowmax32(p0, p1);
    const float mn = fmaxf(m, rm);
    const float alpha = fexp2(m - mn);
    const bool need = __any(mn > m);
    m = mn;
    float s = 0.f;
#pragma unroll
    for (int r = 0; r < 16; ++r) { p0[r] = fexp2(p0[r] - mn); p1[r] = fexp2(p1[r] - mn); s += p0[r] + p1[r]; }
    l = l * alpha + s;
    if (need) scale_rows(o, wsf, alpha, r32, hi);
    bf16x8 a0, a1, a2, a3; pack_p(p0, p1, a0, a1, a2, a3);
    pv(o, vb, a0, a1, a2, a3);
}
template <class ModF>
__device__ __forceinline__ void attn_loop(unsigned tmask, const bf16_t* Kg, int pitchK, const bf16_t* Vg, int pitchV, LAS unsigned char* lds, const bf16x8 (&qr)[4],
                                          f32x16 (&o)[2], float& m, float& l, const ModF& modf, int wave_last_row) {
    const int tid = fresh_tid(), lane = tid & 63, r32 = lane & 31, hi = lane >> 5, wid = tid >> 6;
    const StageGeo sg = stage_geo(tid);
    LAS float* wsf = (LAS float*)(lds + L_WSF) + wid * 64;
    const int vb0 = (int)(unsigned)(size_t)(lds + L_SLOT + 8192) + ((lane >> 4) & 1) * 32 + (lane & 3) * 8 + (4 * hi + ((lane & 15) >> 2)) * 64;
    int kt = 31 - __clz((int)tmask);
    u32x4 kreg = *(const u32x4*)(Kg + (size_t)(kt * 64 + sg.krow) * pitchK + sg.kcol);
    u32x4 vreg = *(const u32x4*)(Vg + (size_t)(kt * 64 + sg.vrow) * pitchV + sg.vcol);
    *(LAS u32x4*)(lds + L_SLOT + sg.koff) = kreg; *(LAS u32x4*)(lds + L_SLOT + sg.voff) = vreg;
    __syncthreads();
    int s = 0;
    for (;;) {
        tmask &= ~(1u << kt);
        const int nk = tmask ? 31 - __clz((int)tmask) : -1;
        if (nk >= 0) { kreg = *(const u32x4*)(Kg + (size_t)(nk * 64 + sg.krow) * pitchK + sg.kcol); vreg = *(const u32x4*)(Vg + (size_t)(nk * 64 + sg.vrow) * pitchV + sg.vcol); }
        if (kt * 64 <= wave_last_row) tile_step(lds + L_SLOT + s * 16384, qr, o, m, l, wsf, modf(kt), r32, hi, vb0 + s * 16384);
        if (nk >= 0) { *(LAS u32x4*)(lds + L_SLOT + (s ^ 1) * 16384 + sg.koff) = kreg; *(LAS u32x4*)(lds + L_SLOT + (s ^ 1) * 16384 + sg.voff) = vreg; }
        __syncthreads();
        if (nk < 0) break;
        kt = nk; s ^= 1;
    }
}
template <bool ADD>
__device__ __forceinline__ void store_o(const f32x16 (&o)[2], LAS unsigned char* lds, bf16_t* dst, int pitch, const bf16_t* addsrc, int addpitch) {
    const int tid = fresh_tid(), lane = tid & 63, r32 = lane & 31, hi = lane >> 5, wid = tid >> 6;
    LAS bf16_t* stg = (LAS bf16_t*)(lds + L_OST) + wid * 2048;
#pragma unroll
    for (int r = 0; r < 16; ++r) { const int orow = crow(r, hi);
#pragma unroll
        for (int d0 = 0; d0 < 2; ++d0) stg[orow * 64 + d0 * 32 + r32] = (bf16_t)(cvtpk(o[d0][r], 0.f) & 0xffffu); }
    asm volatile("s_waitcnt lgkmcnt(0)" ::: "memory");
#pragma unroll
    for (int i = 0; i < 4; ++i) { const int row = i * 8 + (lane >> 3), ch = lane & 7;
        u32x4 v = *(const LAS u32x4*)(stg + row * 64 + ch * 8);
        if (ADD) { const u32x4 a = *(const u32x4*)(addsrc + (size_t)row * addpitch + ch * 8);
            v.x = cvtpk(bflo(v.x) + bflo(a.x), bfhi(v.x) + bfhi(a.x)); v.y = cvtpk(bflo(v.y) + bflo(a.y), bfhi(v.y) + bfhi(a.y));
            v.z = cvtpk(bflo(v.z) + bflo(a.z), bfhi(v.z) + bfhi(a.z)); v.w = cvtpk(bflo(v.w) + bflo(a.w), bfhi(v.w) + bfhi(a.w)); }
        *(u32x4*)(dst + (size_t)row * pitch + ch * 8) = v; }
    asm volatile("s_waitcnt lgkmcnt(0)" ::: "memory");
}
__device__ __forceinline__ void load_q(bf16x8 (&qr)[4], const bf16_t* Qw, int pitch, int r32, int hi) {
#pragma unroll
    for (int d0 = 0; d0 < 4; ++d0) qr[d0] = *(const bf16x8*)(Qw + (size_t)r32 * pitch + d0 * 16 + hi * 8);
}

struct ModFox { const LAS float* cb; int kbase, qpos, hi; bool diag;
    __device__ __forceinline__ void operator()(f32x16& p0, f32x16& p1) const {
#pragma unroll
        for (int i = 0; i < 4; ++i) { const f32x4 c0 = *(const LAS f32x4*)(cb + kbase + 8 * i + 4 * hi), c1 = *(const LAS f32x4*)(cb + kbase + 32 + 8 * i + 4 * hi);
#pragma unroll
            for (int j = 0; j < 4; ++j) { p0[4 * i + j] += c0[j]; p1[4 * i + j] += c1[j]; } }
        if (diag) {
#pragma unroll
            for (int r = 0; r < 16; ++r) { const int kv = kbase + crow(r, hi); if (kv > qpos) p0[r] = NEG; if (kv + 32 > qpos) p1[r] = NEG; } }
    } };
struct ModFoxF { const LAS float* cb; int qpos, hi, q0w;
    __device__ __forceinline__ ModFox operator()(int kt) const { return ModFox{cb, kt * 64, qpos, hi, kt * 64 + 63 > q0w}; } };
struct ModT5 { const LAS float* tb; int kbase, qpos, hi, window; bool enabled;
    __device__ __forceinline__ void operator()(f32x16& p0, f32x16& p1) const {
#pragma unroll
        for (int r = 0; r < 16; ++r) { const int d0 = qpos - (kbase + crow(r, hi)), d1 = d0 - 32;
            const float b0 = tb[min(max(d0, 0), 127)], b1 = tb[min(max(d1, 0), 127)];
            p0[r] = (enabled && d0 >= 0 && d0 < window) ? p0[r] + b0 : NEG;
            p1[r] = (enabled && d1 >= 0 && d1 < window) ? p1[r] + b1 : NEG; }
    } };
struct ModWinF { const LAS float* tb; int qpos, hi;
    __device__ __forceinline__ ModT5 operator()(int kt) const { return ModT5{tb, kt * 64, qpos, hi, 512, true}; } };
struct ModSelF { const LAS float* tb; int qpos, hi; unsigned mask;
    __device__ __forceinline__ ModT5 operator()(int kt) const { return ModT5{tb, kt * 64, qpos, hi, 1 << 30, ((mask >> kt) & 1u) != 0u}; } };

typedef short v4i16_t __attribute__((ext_vector_type(4)));
__device__ __forceinline__ s16x4 vtr(const LAS unsigned char* p) { return __builtin_bit_cast(s16x4, __builtin_amdgcn_ds_read_tr16_b64_v4i16((LAS v4i16_t*)p)); }
__device__ __forceinline__ void qkt_c(f32x16& p0, f32x16& p1, const LAS unsigned char* Kslot, const bf16x8 (&qr)[4], const f32x16& c0, const f32x16& c1, int r32, int hi) {
    const LAS unsigned char* kb = Kslot + hi * 1024 + r32 * 16;
    { const bf16x8 b0 = *(const LAS bf16x8*)(kb); const bf16x8 b1 = *(const LAS bf16x8*)(kb + 512);
      p0 = __builtin_amdgcn_mfma_f32_32x32x16_bf16(b0, qr[0], c0, 0, 0, 0); p1 = __builtin_amdgcn_mfma_f32_32x32x16_bf16(b1, qr[0], c1, 0, 0, 0); }
#pragma unroll
    for (int d0 = 1; d0 < 4; ++d0) {
        const bf16x8 b0 = *(const LAS bf16x8*)(kb + d0 * 2048); const bf16x8 b1 = *(const LAS bf16x8*)(kb + d0 * 2048 + 512);
        p0 = __builtin_amdgcn_mfma_f32_32x32x16_bf16(b0, qr[d0], p0, 0, 0, 0); p1 = __builtin_amdgcn_mfma_f32_32x32x16_bf16(b1, qr[d0], p1, 0, 0, 0); }
}
__device__ __forceinline__ void pv2(f32x16 (&o)[2], const LAS unsigned char* vp, bf16x8 pa0, bf16x8 pa1, bf16x8 pa2, bf16x8 pa3) {
    s16x4 lo[2][4], hi[2][4];
#pragma unroll
    for (int ks = 0; ks < 4; ++ks)
#pragma unroll
        for (int d0 = 0; d0 < 2; ++d0) { lo[d0][ks] = vtr(vp + d0 * 4096 + ks * 1024); hi[d0][ks] = vtr(vp + d0 * 4096 + ks * 1024 + 512); }
#define PK(d, k) (bf16x8){lo[d][k][0], lo[d][k][1], lo[d][k][2], lo[d][k][3], hi[d][k][0], hi[d][k][1], hi[d][k][2], hi[d][k][3]}
    o[0] = __builtin_amdgcn_mfma_f32_32x32x16_bf16(pa0, PK(0, 0), o[0], 0, 0, 0); o[1] = __builtin_amdgcn_mfma_f32_32x32x16_bf16(pa0, PK(1, 0), o[1], 0, 0, 0);
    o[0] = __builtin_amdgcn_mfma_f32_32x32x16_bf16(pa1, PK(0, 1), o[0], 0, 0, 0); o[1] = __builtin_amdgcn_mfma_f32_32x32x16_bf16(pa1, PK(1, 1), o[1], 0, 0, 0);
    o[0] = __builtin_amdgcn_mfma_f32_32x32x16_bf16(pa2, PK(0, 2), o[0], 0, 0, 0); o[1] = __builtin_amdgcn_mfma_f32_32x32x16_bf16(pa2, PK(1, 2), o[1], 0, 0, 0);
    o[0] = __builtin_amdgcn_mfma_f32_32x32x16_bf16(pa3, PK(0, 3), o[0], 0, 0, 0); o[1] = __builtin_amdgcn_mfma_f32_32x32x16_bf16(pa3, PK(1, 3), o[1], 0, 0, 0);
#undef PK
}
__device__ __forceinline__ float rowmax32b(const f32x16& p0, const f32x16& p1) {
    float a = __builtin_fmaxf(__builtin_fmaxf(p0[0], p0[1]), p1[0]), b = __builtin_fmaxf(__builtin_fmaxf(p0[2], p0[3]), p1[1]); a = __builtin_fmaxf(__builtin_fmaxf(a, p1[2]), p1[3]);
#pragma unroll
    for (int r = 4; r < 16; r += 4) { a = __builtin_fmaxf(__builtin_fmaxf(a, p0[r]), p0[r + 1]); b = __builtin_fmaxf(__builtin_fmaxf(b, p0[r + 2]), p0[r + 3]);
        a = __builtin_fmaxf(__builtin_fmaxf(a, p1[r]), p1[r + 1]); b = __builtin_fmaxf(__builtin_fmaxf(b, p1[r + 2]), p1[r + 3]); }
    const float m = __builtin_fmaxf(a, b);
    auto rr = __builtin_amdgcn_permlane32_swap(__float_as_uint(m), __float_as_uint(m), false, false);
    return __builtin_fmaxf(__uint_as_float(rr[0]), __uint_as_float(rr[1]));
}
constexpr float DEFER_THR = 6.0f;
#ifndef ATT_GRP
#define ATT_GRP(w) ((w) >> 2)
#endif
template <int ABL, class TF>
__device__ __forceinline__ void sm_pv(f32x16& sc0, f32x16& sc1, f32x16& sn0, f32x16& sn1, bool adjust_next, int kt, int par, bool& first, float& mref, float& l, f32x16 (&o)[2],
                                      LAS float* wsf, const LAS unsigned char* vp0, const TF& tf, int r32, int hi) {
    if (ABL & 16) { o[0][1] += sc0[3] + sc1[5]; return; }
    tf.post(kt, sc0, sc1);
    const float rm = rowmax32b(sc0, sc1);
    if (__any(first || rm > DEFER_THR)) {
        const float delta = first ? (rm == NEG ? 0.f : rm) : __builtin_fmaxf(rm, 0.f);
        mref += delta;
#pragma unroll
        for (int r = 0; r < 16; ++r) { sc0[r] -= delta; sc1[r] -= delta; }
        if (adjust_next) {
#pragma unroll
            for (int r = 0; r < 16; ++r) { sn0[r] -= delta; sn1[r] -= delta; } }
        const float f = fexp2(-delta); l *= f;
        if (!first) scale_rows(o, wsf, f, r32, hi);
        first = false;
    }
    float s = 0.f;
#pragma unroll
    for (int r = 0; r < 16; ++r) { if (!(ABL & 1)) { sc0[r] = fexp2(sc0[r]); sc1[r] = fexp2(sc1[r]); } s += sc0[r] + sc1[r]; }
    l += s;
    bf16x8 a0, a1, a2, a3; pack_p(sc0, sc1, a0, a1, a2, a3);
    if (!(ABL & 2)) pv2(o, vp0 + par * 8192, a0, a1, a2, a3); else { o[0][0] += __builtin_bit_cast(f32x4, a0)[0] + __builtin_bit_cast(f32x4, a3)[3]; }
}
__device__ __forceinline__ void qk_exp(f32x16& n0, f32x16& n1, f32x16& s0, f32x16& s1, const f32x16& c0, const f32x16& c1, const LAS unsigned char* Kslot, const bf16x8 (&qr)[4],
                                       float& l, bf16x8& a0, bf16x8& a1, bf16x8& a2, bf16x8& a3, int r32, int hi) {
    const LAS unsigned char* kb = Kslot + hi * 1024 + r32 * 16;
    bf16x8 kf[8];
#pragma unroll
    for (int d0 = 0; d0 < 4; ++d0) { kf[2 * d0] = *(const LAS bf16x8*)(kb + d0 * 2048); kf[2 * d0 + 1] = *(const LAS bf16x8*)(kb + d0 * 2048 + 512); }
    float s = 0.f; unsigned w[16];
#define QE_GAP(i, X, B) do { X[B] = fexp2(X[B]); X[B + 1] = fexp2(X[B + 1]); X[B + 2] = fexp2(X[B + 2]); X[B + 3] = fexp2(X[B + 3]); s += (X[B] + X[B + 1]) + (X[B + 2] + X[B + 3]); \
        w[2 * (i)] = cvtpk(X[B], X[B + 1]); w[2 * (i) + 1] = cvtpk(X[B + 2], X[B + 3]); SBAR(); } while (0)
    SBAR();
    n0 = __builtin_amdgcn_mfma_f32_32x32x16_bf16(kf[0], qr[0], c0, 0, 0, 0); QE_GAP(0, s0, 0);
    n1 = __builtin_amdgcn_mfma_f32_32x32x16_bf16(kf[1], qr[0], c1, 0, 0, 0); QE_GAP(1, s0, 4);
    n0 = __builtin_amdgcn_mfma_f32_32x32x16_bf16(kf[2], qr[1], n0, 0, 0, 0); QE_GAP(2, s0, 8);
    n1 = __builtin_amdgcn_mfma_f32_32x32x16_bf16(kf[3], qr[1], n1, 0, 0, 0); QE_GAP(3, s0, 12);
    n0 = __builtin_amdgcn_mfma_f32_32x32x16_bf16(kf[4], qr[2], n0, 0, 0, 0); QE_GAP(4, s1, 0);
    n1 = __builtin_amdgcn_mfma_f32_32x32x16_bf16(kf[5], qr[2], n1, 0, 0, 0); QE_GAP(5, s1, 4);
    n0 = __builtin_amdgcn_mfma_f32_32x32x16_bf16(kf[6], qr[3], n0, 0, 0, 0); QE_GAP(6, s1, 8);
    n1 = __builtin_amdgcn_mfma_f32_32x32x16_bf16(kf[7], qr[3], n1, 0, 0, 0); QE_GAP(7, s1, 12);
#undef QE_GAP
    l += s;
    const u32x4 w0 = {w[0], w[1], w[2], w[3]}, w1 = {w[4], w[5], w[6], w[7]}, w2 = {w[8], w[9], w[10], w[11]}, w3 = {w[12], w[13], w[14], w[15]};
    a0 = __builtin_bit_cast(bf16x8, w0); a1 = __builtin_bit_cast(bf16x8, w1); a2 = __builtin_bit_cast(bf16x8, w2); a3 = __builtin_bit_cast(bf16x8, w3);
}
__device__ __forceinline__ void glds16(const void* gsrc, unsigned lds_dst) { unsigned keep;
    asm volatile("s_mov_b32 %0, m0\n\ts_mov_b32 m0, %2\n\ts_nop 0\n\tglobal_load_lds_dwordx4 %1, off\n\ts_mov_b32 m0, %0" : "=&s"(keep) : "v"(gsrc), "s"(lds_dst) : "memory"); }
#define ATT_WAIT_BAR(N) asm volatile("s_waitcnt vmcnt(" #N ") lgkmcnt(0)\n\ts_barrier" ::: "memory")
template <int ABL = 0, class TF>
__device__ __forceinline__ void attn_loop2(unsigned tmask, const bf16_t* Kg, int pitchK, const bf16_t* Vg, int pitchV, LAS unsigned char* lds, const bf16x8 (&qr)[4],
                                           f32x16 (&o)[2], float& mref, float& l, const TF& tf, int wave_last_row) {
    const int tid = fresh_tid(), lane = tid & 63, r32 = lane & 31, hi = lane >> 5, wid = __builtin_amdgcn_readfirstlane(tid >> 6), grp = ATT_GRP(wid);
    LAS float* wsf = (LAS float*)(lds + L_WSF) + wid * 64;
    const LAS unsigned char* vp0 = lds + L_SLOT + L_VR + ((lane >> 4) & 1) * 32 + (lane & 3) * 8 + (4 * hi + ((lane & 15) >> 2)) * 64;
    const bf16_t* ksrc = Kg + (size_t)lane * pitchK + wid * 8;
    const bf16_t* vsrc = Vg + (size_t)(16 * (wid & 3) + (lane >> 2)) * pitchV + (wid >> 2) * 32 + (lane & 3) * 8;
    const unsigned ldsb = (unsigned)(size_t)(lds + L_SLOT) + (unsigned)wid * 1024u;
#define DMA_K(t, slot) glds16(ksrc + (size_t)(t) * 64 * pitchK, (unsigned)__builtin_amdgcn_readfirstlane(ldsb + (unsigned)(slot) * 8192u))
#define DMA_V(t, slot) glds16(vsrc + (size_t)(t) * 64 * pitchV, (unsigned)__builtin_amdgcn_readfirstlane(ldsb + (unsigned)L_VR + (unsigned)(slot) * 8192u))
#define NEXT_TILE(dst) do { if (tmask) { dst = 31 - __clz((int)tmask); tmask &= ~(1u << dst); } else dst = -1; } while (0)
    int t0, t1, t2, t3;
    NEXT_TILE(t0); NEXT_TILE(t1); NEXT_TILE(t2);
    const int tz = t0;
    DMA_K(t0, 0); DMA_V(t0, 0); DMA_K(t1 < 0 ? tz : t1, 1); DMA_V(t1 < 0 ? tz : t1, 1); DMA_K(t2 < 0 ? tz : t2, 2);
    ATT_WAIT_BAR(2);
    f32x16 sa0, sa1, sb0, sb1, cfar;
    bool first = true;
    mref = 0.f; l = 0.f;
    const float fbias = tf.farbias();
#pragma unroll
    for (int r = 0; r < 16; ++r) cfar[r] = fbias;
    { f32x16 c0, c1; tf.cinit(t0, 0.f, c0, c1); qkt_c(sa0, sa1, lds + L_SLOT, qr, c0, c1, r32, hi); }
    asm volatile("s_waitcnt lgkmcnt(0)\n\ts_barrier" ::: "memory");
    int s0 = 0, s1 = 1, s2 = 2;
#define ATT_STEP(SC0, SC1, SN0, SN1) do { \
        NEXT_TILE(t3); \
        DMA_K((ABL & 128) || t3 < 0 ? tz : t3, s0); DMA_V((ABL & 128) || t2 < 0 ? tz : t2, s2); \
        const int t1c = t1 < 0 ? tz : t1; \
        tf.post(t0, SC0, SC1); \
        { const float rm = rowmax32b(SC0, SC1); \
          if (__any(first || rm > DEFER_THR)) { \
            const float delta = first ? (rm == NEG ? 0.f : rm) : __builtin_fmaxf(rm, 0.f); \
            mref += delta; \
            _Pragma("unroll") for (int r = 0; r < 16; ++r) { SC0[r] -= delta; SC1[r] -= delta; } \
            const float f = fexp2(-delta); l *= f; \
            if (!first) scale_rows(o, wsf, f, r32, hi); \
            _Pragma("unroll") for (int r = 0; r < 16; ++r) cfar[r] = fbias - mref; \
            first = false; } } \
        { bf16x8 a0, a1, a2, a3; \
          if (tf.far(t1c)) qk_exp(SN0, SN1, SC0, SC1, cfar, cfar, lds + L_SLOT + s1 * 8192, qr, l, a0, a1, a2, a3, r32, hi); \
          else { f32x16 c0, c1; tf.cinit(t1c, mref, c0, c1); qk_exp(SN0, SN1, SC0, SC1, c0, c1, lds + L_SLOT + s1 * 8192, qr, l, a0, a1, a2, a3, r32, hi); } \
          pv2(o, vp0 + s0 * 8192, a0, a1, a2, a3); } \
        ATT_WAIT_BAR(2); \
        t0 = t1; t1 = t2; t2 = t3; { const int s_ = s0; s0 = s1; s1 = s2; s2 = s_; } \
    } while (0)
    for (;;) {
        ATT_STEP(sa0, sa1, sb0, sb1); if (t0 < 0) break;
        ATT_STEP(sb0, sb1, sa0, sa1); if (t0 < 0) break;
    }
    asm volatile("s_waitcnt vmcnt(0)" ::: "memory");
    __syncthreads();
#undef ATT_STEP
#undef NEXT_TILE
#undef DMA_K
#undef DMA_V
}
struct TfFox { const LAS float* cb; int qpos, hi, q0w;
    __device__ __forceinline__ bool far(int) const { return false; }
    __device__ __forceinline__ float farbias() const { return 0.f; }
    __device__ __forceinline__ void cinit(int kt, float mref, f32x16& c0, f32x16& c1) const {
#pragma unroll
        for (int i = 0; i < 4; ++i) { const f32x4 a = *(const LAS f32x4*)(cb + kt * 64 + 8 * i + 4 * hi), b = *(const LAS f32x4*)(cb + kt * 64 + 32 + 8 * i + 4 * hi);
#pragma unroll
            for (int j = 0; j < 4; ++j) { c0[4 * i + j] = a[j] - mref; c1[4 * i + j] = b[j] - mref; } } }
    __device__ __forceinline__ void post(int kt, f32x16& p0, f32x16& p1) const {
        if (kt * 64 + 63 > q0w) {
#pragma unroll
            for (int r = 0; r < 16; ++r) { const int kv = kt * 64 + crow(r, hi); if (kv > qpos) p0[r] = NEG; if (kv + 32 > qpos) p1[r] = NEG; } } } };
struct TfT5 { const LAS float* tb; int qpos, hi, q0w, window; unsigned mask; bool use_mask;
    __device__ __forceinline__ bool far(int kt) const { return q0w - (kt * 64 + 63) >= 113; }
    __device__ __forceinline__ float farbias() const { return tb[127]; }
    __device__ __forceinline__ void cinit(int kt, float mref, f32x16& c0, f32x16& c1) const {
        if (q0w - (kt * 64 + 63) >= 113) { const float c = tb[127] - mref;
#pragma unroll
            for (int r = 0; r < 16; ++r) { c0[r] = c; c1[r] = c; } }
        else {
#pragma unroll
            for (int r = 0; r < 16; ++r) { const int d0 = qpos - kt * 64 - crow(r, hi); c0[r] = tb[min(max(d0, 0), 127)] - mref; c1[r] = tb[min(max(d0 - 32, 0), 127)] - mref; } } }
    __device__ __forceinline__ void post(int kt, f32x16& p0, f32x16& p1) const {
        if (q0w - (kt * 64 + 63) < 0 || q0w + 31 - kt * 64 >= window) {
#pragma unroll
            for (int r = 0; r < 16; ++r) { const int d0 = qpos - kt * 64 - crow(r, hi), d1 = d0 - 32; if (d0 < 0 || d0 >= window) p0[r] = NEG; if (d1 < 0 || d1 >= window) p1[r] = NEG; } }
        if (use_mask) { const bool en = ((mask >> kt) & 1u) != 0u;
            if (!__all(en)) {
#pragma unroll
                for (int r = 0; r < 16; ++r) { p0[r] = en ? p0[r] : NEG; p1[r] = en ? p1[r] : NEG; } } } } };
}
#ifndef STAGE_LIMIT
#define STAGE_LIMIT 4
#endif
constexpr size_t MiB = 1u << 20;
constexpr size_t WS_CTL = 0, CTL_ZERO_BYTES = 64 * 1024;
constexpr size_t WS_SS = 256 * 1024;
constexpr size_t WS_SSM = 640 * 1024;
constexpr size_t WS_F32S = 2 * MiB;
constexpr size_t WS_CUM = 4 * MiB;
constexpr size_t WS_MASK = 4 * MiB + 512 * 1024;
constexpr size_t WS_UMASK = WS_MASK + 128 * 1024;
constexpr size_t WS_KC = 5 * MiB, WS_VC = 5 * MiB + 256 * 1024;
constexpr size_t WS_KMAX = 5 * MiB + 512 * 1024;
constexpr size_t WS_POSC = 32 * 1024;
constexpr size_t WS_WGU1 = 8 * MiB, WS_WD1 = 19 * MiB, WS_WIN = 25 * MiB, WS_WUPN = 35 * MiB, WS_WUPF = 36 * MiB, WS_WOUT = 37 * MiB, WS_WMQ = 39 * MiB,
                 WS_WMKV = 41 * MiB, WS_WMO = 45 * MiB, WS_WGU2 = 47 * MiB, WS_WD2 = 58 * MiB, WS_CW1K = 64 * MiB, WS_CW1V = 65 * MiB, WS_CW2K = 66 * MiB, WS_CW2V = 66 * MiB + 256 * 1024;
constexpr size_t WS_KVM = 8 * MiB;
constexpr size_t WS_XB = 68 * MiB;
constexpr size_t WS_QN = 100 * MiB, WS_KVN = 116 * MiB, WS_QF = 140 * MiB, WS_KVF = 156 * MiB, WS_GAB = 188 * MiB;
constexpr size_t WS_H = 100 * MiB;
constexpr size_t WS_Y = WS_KVF;
constexpr size_t WS_MT = 188 * MiB, WS_NT = 204 * MiB, WS_PM = 220 * MiB;
constexpr size_t WS_MEMB = 252 * MiB, WS_END = 256 * MiB;
static_assert(WS_WD2 + (size_t)DM * FF * 2 <= WS_CW1K && WS_GAB + (size_t)M * 2048 * 2 <= WS_MEMB && WS_H + (size_t)M * FF * 2 <= WS_GAB, "ws map");
constexpr int CW_BAR = 4096;
constexpr size_t WS_XBUF = 1 * MiB;
constexpr size_t WS_FINCNT = 40 * 1024;
constexpr int RING_BYTES = 131072, LDS_BYTES = 147456;

__device__ const unsigned char T5B[128] = {0, 1, 2, 3, 4, 5, 6, 7, 8, 9, 10, 11, 12, 13, 14, 15, 16, 16, 16, 17, 17, 18, 18, 18, 19, 19, 19, 20, 20, 20, 20, 21, 21, 21, 21, 22, 22, 22, 22, 22, 23, 23, 23, 23, 23, 23, 24, 24, 24, 24, 24, 24, 25, 25, 25, 25, 25, 25, 25, 26, 26, 26, 26, 26, 26, 26, 26, 27, 27, 27, 27, 27, 27, 27, 27, 27, 27, 28, 28, 28, 28, 28, 28, 28, 28, 28, 28, 29, 29, 29, 29, 29, 29, 29, 29, 29, 29, 29, 29, 30, 30, 30, 30, 30, 30, 30, 30, 30, 30, 30, 30, 30, 30, 31, 31, 31, 31, 31, 31, 31, 31, 31, 31, 31, 31, 31, 31, 31};


#define XB_TMO      128
#define XB_XCNT(j)  (256  + 64 * (j))
#define XB_XSUB(j)  (1280 + 64 * (j))
#define XB_XGEN(j)  (2304 + 64 * (j))
#define XB_TOP      3328
#define XB_TOPGEN   3392
#define XCD_BAR_WORDS 3456
#define XB_SPIN_CAP (1u << 18)
__device__ __forceinline__ unsigned xb_ld(unsigned* p)              { return __hip_atomic_load(p, __ATOMIC_RELAXED, __HIP_MEMORY_SCOPE_AGENT); }
__device__ __forceinline__ unsigned xb_add(unsigned* p, unsigned v) { return __hip_atomic_fetch_add(p, v, __ATOMIC_RELAXED, __HIP_MEMORY_SCOPE_AGENT); }
__device__ __forceinline__ unsigned xb_xcc_id() { return (unsigned)__builtin_amdgcn_s_getreg((3 << 11) | 20) & 0xFu; }
#define XB_SPIN(cond, bar) do { unsigned _sp = 0; while (cond) { __builtin_amdgcn_s_sleep(1); \
    if ((++_sp & 255u) == 0u) { if (xb_ld(&(bar)[XB_TMO])) break; if (_sp > XB_SPIN_CAP) { atomicAdd(&(bar)[XB_TMO], 1u); break; } } } } while (0)
struct XcdBarrier { unsigned* bar; unsigned x; volatile LAS unsigned* st; };
__device__ __forceinline__ XcdBarrier xcd_barrier_post(unsigned* bar, volatile LAS unsigned* st) {
    XcdBarrier b; b.bar = bar; b.x = xb_xcc_id(); b.st = st;
    if (threadIdx.x == 0) (void)xb_add(&bar[XB_XCNT(b.x)], 1u);
    return b;
}
__device__ __forceinline__ void xcd_barrier_complete(unsigned* bar, unsigned x, unsigned& nloc, unsigned& nx) {
    const unsigned G = gridDim.x * gridDim.y * gridDim.z;
    unsigned sum, cnt, mine, sp = 0u;
    for (;;) {
        sum = 0u; cnt = 0u; mine = 0u;
#pragma unroll
        for (unsigned j = 0; j < 16; ++j) { const unsigned c = xb_ld(&bar[XB_XCNT(j)]); sum += c; cnt += (c > 0u) ? 1u : 0u; mine = (j == x) ? c : mine; }
        if (sum == G) break;
        __builtin_amdgcn_s_sleep(1);
        if ((++sp & 255u) == 0u) { if (xb_ld(&bar[XB_TMO])) break; if (sp > XB_SPIN_CAP) { atomicAdd(&bar[XB_TMO], 1u); break; } }
    }
    nloc = mine > 0u ? mine : 1u; nx = cnt > 0u ? cnt : 1u;
}
__device__ __forceinline__ void xcd_barrier(const XcdBarrier& b) {
    asm volatile("s_waitcnt vmcnt(0)" ::: "memory");
    __syncthreads();
    if (threadIdx.x == 0) {
        unsigned* bar = b.bar;
        __builtin_amdgcn_s_waitcnt(0);
        unsigned nloc = b.st[0], nx = b.st[1];
        if (nloc == 0u) { xcd_barrier_complete(bar, b.x, nloc, nx); b.st[0] = nloc; b.st[1] = nx; }
        const unsigned old = xb_add(&bar[XB_XSUB(b.x)], 1u);
        const unsigned gen = old / nloc;
        if (old + 1u == (gen + 1u) * nloc) {
            __builtin_amdgcn_fence(__ATOMIC_RELEASE, "agent");
            asm volatile("s_waitcnt vmcnt(0)" ::: "memory");
            const unsigned og = xb_add(&bar[XB_TOP], 1u);
            const unsigned tg = og / nx;
            if (og + 1u == (tg + 1u) * nx) xb_add(&bar[XB_TOPGEN], 1u);
            else XB_SPIN(xb_ld(&bar[XB_TOPGEN]) == tg, bar);
            __builtin_amdgcn_fence(__ATOMIC_ACQUIRE, "agent");
            xb_add(&bar[XB_XGEN(b.x)], 1u);
            asm volatile("s_waitcnt vmcnt(0)" ::: "memory");
        } else {
            XB_SPIN(xb_ld(&bar[XB_XGEN(b.x)]) == gen, bar);
            __builtin_amdgcn_fence(__ATOMIC_ACQUIRE, "agent");
            asm volatile("s_waitcnt vmcnt(0)" ::: "memory");
        }
    }
    __syncthreads();
}

struct Args { const float* in[29]; float* out; unsigned char* ws; int lo, hi; };
enum { I_X = 0, I_MEM, I_RELB, I_F1N, I_F1G, I_F1U, I_F1D, I_MIXN, I_WIN, I_BF, I_POSK, I_POSV, I_CK1, I_CK2, I_CV1, I_CV2, I_UPN, I_UPF, I_WOUT, I_MQN, I_MKVN, I_MWQ, I_MWKV, I_MWO, I_F2N, I_F2G, I_F2U, I_F2D, I_FINN };

__device__ __forceinline__ float wave_sum(float v) {
#pragma unroll
    for (int o = 1; o < 64; o <<= 1) v += __shfl_xor(v, o);
    return v;
}
struct ItemD { const float* wp; const float* gp; bf16_t* wt; int ldsrc, K, k0, dstrow0; float scl; bool zero; };
struct ItemR { f32x4 v[8]; float gk[8]; };
__device__ __forceinline__ void cm_plain(int n, int off, int& sc) { sc = n + off; }
__device__ __forceinline__ void cm_win(int n, int& sc, float& scl) {
    scl = 1.f;
    if (n < 512) { sc = n; scl = QS64; }
    else if (n < 1280) sc = n;
    else if (n < 1792) { sc = 1304 + (n - 1280); scl = QS64; }
    else if (n < 2816) sc = 1816 + (n - 1792);
    else if (n < 4864) sc = 2848 + (n - 2816);
    else if (n < 4888) sc = 1280 + (n - 4864);
    else if (n < 4896) sc = 2840 + (n - 4888);
    else sc = -1; }
constexpr int N_GU = 16 * 176, N_D = 44 * 32, N_WIN = 16 * 160, N_UP = 8 * 32, N_SQ = 16 * 32, N_MKV = 16 * 64, N_C1 = 32 * 8, N_C2 = 4 * 2;
constexpr int CONV_NA = N_GU + N_D + N_WIN + N_MKV + 2 * N_C1 + 2 * N_C2, CONV_NB = N_GU + N_D + 2 * N_UP + 3 * N_SQ;
__device__ __forceinline__ ItemD conv_decode(const Args& a, int it, int lane) {
    unsigned char* ws = a.ws; int r = it; ItemD d; const int c4 = lane & 7, kr = lane >> 3;
    const float* W; int ldsrc, K, kb, dr, off = 0; const float* gain = nullptr; bf16_t* wt; float scl = 1.f; bool win = false;
    const int f = r >= CONV_NA; if (f) r -= CONV_NA;
    if (r < N_GU) { kb = r / 176; const int gi = r % 176; dr = gi * 32; const int tile = dr >> 8, within = dr & 255;
        W = a.in[within < 128 ? (f ? I_F2G : I_F1G) : (f ? I_F2U : I_F1U)]; ldsrc = FF; K = DM; wt = (bf16_t*)(ws + (f ? WS_WGU2 : WS_WGU1)); gain = a.in[f ? I_F2N : I_F1N]; off = tile * 128 + (within & 127) - dr; }
    else if ((r -= N_GU) < N_D) { kb = r / 32; dr = (r % 32) * 32; W = a.in[f ? I_F2D : I_F1D]; ldsrc = DM; K = FF; wt = (bf16_t*)(ws + (f ? WS_WD2 : WS_WD1)); }
    else if (!f) { r -= N_D;
        if (r < N_WIN) { kb = r / 160; dr = (r % 160) * 32; W = a.in[I_WIN]; ldsrc = 4896; K = DM; wt = (bf16_t*)(ws + WS_WIN); gain = a.in[I_MIXN]; win = true; }
        else if ((r -= N_WIN) < N_MKV) { kb = r / 64; dr = (r % 64) * 32; W = a.in[I_MWKV]; ldsrc = 2048; K = DM; wt = (bf16_t*)(ws + WS_WMKV); gain = a.in[I_MKVN]; }
        else if ((r -= N_MKV) < 2 * N_C1) { const int g = r >= N_C1; r -= g * N_C1; kb = r / 8; dr = (r % 8) * 32; W = a.in[g ? I_CV1 : I_CK1]; ldsrc = 256; K = 2048; wt = (bf16_t*)(ws + (g ? WS_CW1V : WS_CW1K)); }
        else { r -= 2 * N_C1; const int g = r >= N_C2; r -= g * N_C2; kb = r / 2; dr = (r % 2) * 32; W = a.in[g ? I_CV2 : I_CK2]; ldsrc = 64; K = 256; wt = (bf16_t*)(ws + (g ? WS_CW2V : WS_CW2K)); }
    } else { r -= N_D;
        if (r < 2 * N_UP) { const int g = r >= N_UP; r -= g * N_UP; kb = r / 32; dr = (r % 32) * 32; W = a.in[g ? I_UPF : I_UPN]; ldsrc = DM; K = 512; wt = (bf16_t*)(ws + (g ? WS_WUPF : WS_WUPN)); }
        else { r -= 2 * N_UP; const int g = r / N_SQ; r -= g * N_SQ; kb = r / 32; dr = (r % 32) * 32; W = a.in[g == 0 ? I_WOUT : (g == 1 ? I_MWQ : I_MWO)]; ldsrc = DM; K = DM;
            wt = (bf16_t*)(ws + (g == 0 ? WS_WOUT : (g == 1 ? WS_WMQ : WS_WMO))); if (g == 1) { W = a.in[I_MWO]; wt = (bf16_t*)(ws + WS_WMO); } }
    }
    int sc; if (win) cm_win(dr + 4 * c4, sc, scl); else cm_plain(dr + 4 * c4, off, sc);
    d.zero = sc < 0; d.wp = W + (size_t)(kb * 64 + kr) * ldsrc + (sc < 0 ? 0 : sc); d.gp = gain ? gain + kb * 64 + kr : nullptr; d.wt = wt; d.ldsrc = ldsrc; d.K = K; d.k0 = kb * 64; d.dstrow0 = dr; d.scl = scl;
    return d;
}
__device__ __forceinline__ void conv_load(const ItemD& d, ItemR& r) {
#pragma unroll
    for (int i = 0; i < 8; ++i) { r.v[i] = d.zero ? (f32x4){0.f, 0.f, 0.f, 0.f} : *(const f32x4*)(d.wp + (size_t)(8 * i) * d.ldsrc); r.gk[i] = d.gp ? d.gp[8 * i] : 1.f; }
}
__device__ __forceinline__ void conv_finish(const ItemD& d, const ItemR& r, LAS float* scr, int lane) {
    const int kr = lane >> 3, c4 = lane & 7;
#pragma unroll
    for (int i = 0; i < 8; ++i) { const int kk = 8 * i + kr; const float s = r.gk[i] * d.scl; LAS float* p = scr + kk * 33 + 4 * c4; p[0] = r.v[i][0] * s; p[1] = r.v[i][1] * s; p[2] = r.v[i][2] * s; p[3] = r.v[i][3] * s; }
    asm volatile("s_waitcnt lgkmcnt(0)" ::: "memory");
    const int c = lane & 7;
#pragma unroll
    for (int j = 0; j < 4; ++j) { const int nn = (lane >> 3) + 8 * j; const LAS float* s = scr + (8 * c) * 33 + nn;
        u32x4 o; o.x = cvtpk(s[0 * 33], s[1 * 33]); o.y = cvtpk(s[2 * 33], s[3 * 33]); o.z = cvtpk(s[4 * 33], s[5 * 33]); o.w = cvtpk(s[6 * 33], s[7 * 33]);
        *(u32x4*)(d.wt + (size_t)(d.dstrow0 + nn) * d.K + d.k0 + 8 * c) = o; }
    asm volatile("s_waitcnt lgkmcnt(0)" ::: "memory");
}
__device__ __forceinline__ void conv_run(const Args& a, int it0, int itend, int stride, LAS float* scr, int lane) {
    if (it0 >= itend) return;
    ItemD d0 = conv_decode(a, it0, lane); ItemR r0; conv_load(d0, r0);
    for (int it = it0 + stride; ; it += stride) {
        const bool more = it < itend;
        ItemD d1; ItemR r1;
        if (more) { d1 = conv_decode(a, it, lane); conv_load(d1, r1); }
        conv_finish(d0, r0, scr, lane);
        if (!more) break;
        d0 = d1; r0 = r1;
    }
}

__device__ __forceinline__ void p0_prologue(const Args& a, LAS unsigned char* lds, int gw, int NGW, int wave, int lane) {
    unsigned char* ws = a.ws;
    LAS float* scr = (LAS float*)(lds + wave * 16384);
    conv_run(a, gw, N_GU, NGW, scr, lane);
    { f32x4* z = (f32x4*)(ws + WS_SS + (size_t)M * 4); for (int i = gw * 64 + lane; i < 3 * M / 4; i += NGW * 64) z[i] = (f32x4){0.f, 0.f, 0.f, 0.f}; }
    for (int mrow = gw; mrow < M + MROWS; mrow += NGW) {
        const bool ismem = mrow >= M; const int rr = ismem ? mrow - M : mrow;
        const f32x4* xr = (const f32x4*)((ismem ? a.in[I_MEM] : a.in[I_X]) + (size_t)rr * DM) + lane;
        unsigned long long* o8 = (unsigned long long*)((bf16_t*)(ws + (ismem ? WS_MEMB : WS_XB)) + (size_t)rr * DM) + lane;
        float s = 0.f; f32x4 v[4];
#pragma unroll
        for (int j = 0; j < 4; ++j) v[j] = xr[64 * j];
#pragma unroll
        for (int j = 0; j < 4; ++j) { s += (v[j][0] * v[j][0] + v[j][1] * v[j][1]) + (v[j][2] * v[j][2] + v[j][3] * v[j][3]);
            o8[64 * j] = (unsigned long long)cvtpk(v[j][0], v[j][1]) | ((unsigned long long)cvtpk(v[j][2], v[j][3]) << 32); }
        s = wave_sum(s);
        if (lane == 0) ((float*)(ws + (ismem ? WS_SSM : WS_SS)))[rr] = s;
    }
    for (int t = gw; t < 64; t += NGW) { const int kv = t >> 5, kc = (t & 31) * 64; const float* pos = a.in[kv ? I_POSV : I_POSK] + kc; const f32x4* w1 = (const f32x4*)(a.in[kv ? I_CV1 : I_CK1] + (size_t)kc * 256) + lane;
        f32x4 s = {0.f, 0.f, 0.f, 0.f};
#pragma unroll 8
        for (int k = 0; k < 64; ++k) s += w1[(size_t)k * 64] * pos[k];
        float* o = (float*)(ws + WS_POSC) + kv * 256 + 4 * lane;
        unsafeAtomicAdd(o, s[0]); unsafeAtomicAdd(o + 1, s[1]); unsafeAtomicAdd(o + 2, s[2]); unsafeAtomicAdd(o + 3, s[3]); }
}

__device__ __forceinline__ void wqn_rows(const Args& a, int w0, int nw, int lane) {
    for (int d = w0; d < DM; d += nw) { const float s = a.in[I_MQN][d] * QS256; const f32x4* xr = (const f32x4*)(a.in[I_MWQ] + (size_t)d * DM) + lane;
        unsigned long long* o8 = (unsigned long long*)((bf16_t*)(a.ws + WS_WMQ) + (size_t)d * DM) + lane; f32x4 v[4];
#pragma unroll
        for (int j = 0; j < 4; ++j) v[j] = xr[64 * j];
#pragma unroll
        for (int j = 0; j < 4; ++j) o8[64 * j] = (unsigned long long)cvtpk(v[j][0] * s, v[j][1] * s) | ((unsigned long long)cvtpk(v[j][2] * s, v[j][3] * s) << 32); }
}
__device__ __forceinline__ void compress_unit(const Args& a, LAS unsigned char* lds, int uidx) {
    unsigned char* ws = a.ws;
    const int tid = fresh_tid(), lane = tid & 63, r32 = lane & 31, hi = lane >> 5, wid = __builtin_amdgcn_readfirstlane(tid >> 6);
    const int kv = uidx >> 6, b = (uidx >> 3) & 7, g = (uidx >> 2) & 1, chunk = uidx & 3, n0 = chunk * 32;
    const bf16_t* W1 = (const bf16_t*)(ws + (kv ? WS_CW1V : WS_CW1K)); const bf16_t* W2 = (const bf16_t*)(ws + (kv ? WS_CW2V : WS_CW2K));
    const float* posc = (const float*)(ws + WS_POSC) + kv * 256;
    const bf16_t* asrc = (const bf16_t*)(ws + WS_KVN) + (size_t)(b * SEQ) * 768 + kv * 128 + g * 64;
    LAS bf16_t* As = (LAS bf16_t*)lds;
    for (int i = tid; i < 528 * 8; i += 512) { const int row = i >> 3, ch = i & 7; const int t = min(16 * n0 + row, SEQ - 1);
        *(LAS u32x4*)(As + row * 64 + ((ch ^ ((row >> 4) & 7)) * 8)) = *(const u32x4*)(asrc + (size_t)t * 768 + ch * 8); }
    __syncthreads();
    const bf16_t* brow = W1 + (size_t)(32 * wid + r32) * 2048 + hi * 8;
    f32x16 acc = f32x16{};
#pragma unroll 16
    for (int kk = 0; kk < 128; ++kk) { const int l = kk >> 2, dch = (kk & 3) * 2 + hi, row = 16 * r32 + l;
        const bf16x8 av = *(const LAS bf16x8*)(As + row * 64 + ((dch ^ ((row >> 4) & 7)) * 8)); const bf16x8 bv = *(const bf16x8*)(brow + kk * 16);
        acc = __builtin_amdgcn_mfma_f32_32x32x16_bf16(av, bv, acc, 0, 0, 0); }
    LAS bf16_t* Hs = (LAS bf16_t*)(lds + 81920);
    const float pc = posc[32 * wid + r32];
#pragma unroll
    for (int r = 0; r < 16; ++r) { const float x = acc[r] + pc; const float u = 0.7978845608028654f * (x + 0.044715f * x * x * x);
        const float ge = x * frcp(1.0f + fexp2(-2.0f * LOG2E * u)); Hs[att::crow(r, hi) * 264 + 32 * wid + r32] = (bf16_t)(cvtpk(ge, 0.f) & 0xffffu); }
    __syncthreads();
    if (wid < 2) { f32x16 acc2 = f32x16{};
#pragma unroll
        for (int kk = 0; kk < 16; ++kk) { const bf16x8 av = *(const LAS bf16x8*)(Hs + r32 * 264 + kk * 16 + hi * 8); const bf16x8 bv = *(const bf16x8*)(W2 + (size_t)(32 * wid + r32) * 256 + kk * 16 + hi * 8);
            acc2 = __builtin_amdgcn_mfma_f32_32x32x16_bf16(av, bv, acc2, 0, 0, 0); }
        bf16_t* outp = (bf16_t*)(ws + (kv ? WS_VC : WS_KC)) + (size_t)((b * 2 + g) * 128) * 64;
#pragma unroll
        for (int r = 0; r < 16; ++r) { const int n = n0 + att::crow(r, hi); const float v = n < 127 ? acc2[r] : 0.f; outp[(size_t)n * 64 + 32 * wid + r32] = (bf16_t)(cvtpk(v, 0.f) & 0xffffu); } }
    __syncthreads();
}
__device__ __forceinline__ void kmax_task(const Args& a, LAS unsigned char* lds, int task, int wave, int lane) {
    const int b = task >> 3, h = task & 7; float mx = 0.f;
    const bf16_t* K = (const bf16_t*)(a.ws + WS_KVF) + (size_t)(b * SEQ) * 1024 + h * 64;
#pragma unroll
    for (int rr = 0; rr < 4; ++rr) { const u32x4* p = (const u32x4*)(K + (size_t)(wave * 256 + rr * 64 + lane) * 1024); float ss = 0.f;
#pragma unroll
        for (int c = 0; c < 8; ++c) { const u32x4 v = p[c]; ss += (bflo(v.x) * bflo(v.x) + bfhi(v.x) * bfhi(v.x)) + (bflo(v.y) * bflo(v.y) + bfhi(v.y) * bfhi(v.y)) + (bflo(v.z) * bflo(v.z) + bfhi(v.z) * bfhi(v.z)) + (bflo(v.w) * bflo(v.w) + bfhi(v.w) * bfhi(v.w)); }
        mx = fmaxf(mx, ss); }
#pragma unroll
    for (int o = 1; o < 64; o <<= 1) mx = fmaxf(mx, __shfl_xor(mx, o));
    LAS float* red = (LAS float*)(lds + 120 * 1024);
    if (lane == 0) red[wave] = mx;
    __syncthreads();
    if (wave == 0 && lane == 0) { float m2 = red[0]; for (int i = 1; i < 8; ++i) m2 = fmaxf(m2, red[i]); ((float*)(a.ws + WS_KMAX))[task] = sqrtf(m2) * 1.01f; }
    __syncthreads();
}
__device__ __forceinline__ void cumsum_task(const Args& a, int task, int lane) {
    const int b = task >> 3, h = task & 7; const float bf = a.in[I_BF][h];
    const float* fl = (const float*)(a.ws + WS_F32S) + (size_t)(b * SEQ) * 32 + 24 + h; float* out = (float*)(a.ws + WS_CUM) + (size_t)task * SEQ;
    float v[32];
#pragma unroll
    for (int i = 0; i < 32; ++i) v[i] = fl[(size_t)(64 * i + lane) * 32];
    float carry = 0.f;
#pragma unroll
    for (int i = 0; i < 32; ++i) { const float x = v[i] + bf; float inc = fminf(x, 0.f) - log1pf(expf(-fabsf(x)));
#pragma unroll
        for (int o = 1; o < 64; o <<= 1) { const float t = __shfl_up(inc, o); if (lane >= o) inc += t; }
        inc += carry; out[64 * i + lane] = -inc * LOG2E; carry = __shfl(inc, 63); }
}

__device__ __forceinline__ void init_t5_table(const Args& a, LAS unsigned char* lds) {
    LAS float* T = (LAS float*)(lds + att::L_TBL);
    for (int i = fresh_tid(); i < 1024; i += 512) { const int h = i >> 7, d = i & 127; T[i] = a.in[I_RELB][T5B[d] * 8 + h] * LOG2E; }
}
template <bool DRY> __device__ __forceinline__ void fox_unit(const Args& a, LAS unsigned char* lds, int b, int h, int qb) {
    using namespace att;
    unsigned char* ws = a.ws;
    const int tid = fresh_tid(), lane = tid & 63, r32 = lane & 31, hi = lane >> 5, wid = __builtin_amdgcn_readfirstlane(tid >> 6);
    const int q0 = qb * 256, q0w = q0 + wid * 32, qpos = q0w + r32;
    LAS float* cb = (LAS float*)(lds + L_CB); LAS float* wsf = (LAS float*)(lds + L_WSF) + wid * 64;
    const float* cum = (const float*)(ws + WS_CUM) + (size_t)(b * 8 + h) * SEQ;
    for (int i = tid; i < q0 + 256; i += 512) cb[i] = cum[i];
    bf16_t* Qw = (bf16_t*)(ws + WS_QF) + (size_t)(b * SEQ + q0w) * 512 + h * 64;
    bf16x8 qr[4]; load_q(qr, Qw, 512, r32, hi);
    f32x16 o[2]; o[0] = f32x16{}; o[1] = f32x16{}; float m = 0.f, l = 0.f;
    const int nt = 4 * qb + 4; unsigned tmask = nt >= 32 ? 0xffffffffu : ((1u << nt) - 1u);
    const bf16_t* Kg = (const bf16_t*)(ws + WS_KVF) + (size_t)(b * SEQ) * 1024 + h * 64;
#ifndef NO_FOX_SKIP
    {
        float qq = 0.f;
#pragma unroll
        for (int d0 = 0; d0 < 4; ++d0) { const u32x4 v = __builtin_bit_cast(u32x4, qr[d0]);
            qq += (bflo(v.x) * bflo(v.x) + bfhi(v.x) * bfhi(v.x)) + (bflo(v.y) * bflo(v.y) + bfhi(v.y) * bfhi(v.y)) + (bflo(v.z) * bflo(v.z) + bfhi(v.z) * bfhi(v.z)) + (bflo(v.w) * bflo(v.w) + bfhi(v.w) * bfhi(v.w)); }
        qq = halfsum(qq);
#pragma unroll
        for (int o_ = 1; o_ < 32; o_ <<= 1) qq = fmaxf(qq, __shfl_xor(qq, o_));
        LAS float* red = (LAS float*)(lds + L_MISC + 16);
        if (lane == 0) red[wid] = qq;
        __syncthreads();
        float qmax = red[0];
#pragma unroll
        for (int i = 1; i < 8; ++i) qmax = fmaxf(qmax, red[i]);
        const float need = 2.0f * sqrtf(qmax) * 1.01f * ((const float*)(ws + WS_KMAX))[b * 8 + h] + 40.0f;
        const float cb0 = cum[q0];
        const bool skip = (lane < 32) && (lane < nt) && (cb0 - cum[64 * (lane < nt ? lane : 0) + 63] >= need);
        const unsigned long long bal = __ballot(skip);
        tmask &= ~(unsigned)bal;
        __syncthreads();
    }
#endif
#ifndef FOX_ABL
#define FOX_ABL 0
#endif
    if (DRY && (FOX_ABL & 64)) tmask = 1u << (31 - __clz((int)tmask));
    if (DRY) attn_loop2<FOX_ABL>(tmask, Kg, 1024, Kg + 512, 1024, lds, qr, o, m, l, TfFox{cb, qpos, hi, q0w}, q0w + 31);
    else attn_loop2<0>(tmask, Kg, 1024, Kg + 512, 1024, lds, qr, o, m, l, TfFox{cb, qpos, hi, q0w}, q0w + 31);
    l = halfsum(l);
    scale_rows(o, wsf, 1.0f / l, r32, hi);
    store_o<false>(o, lds, DRY ? (bf16_t*)(ws + WS_XB + 16 * MiB) + (size_t)(b * SEQ + q0w) * 512 + h * 64 : Qw, 512, nullptr, 0);
}
template <int PARTS> __device__ __forceinline__ void cmpwin_unit(const Args& a, LAS unsigned char* lds, int b, int g, int qb) {
    using namespace att;
    unsigned char* ws = a.ws;
    const int tid = fresh_tid(), lane = tid & 63, r32 = lane & 31, hi = lane >> 5, wid = __builtin_amdgcn_readfirstlane(tid >> 6);
    const int j = wid >> 1, sub = wid & 1, hg = g * 4 + j, q0w = qb * 64 + sub * 32, qpos = q0w + r32; const size_t qrow = (size_t)b * SEQ + qpos;
    const LAS float* tb = (const LAS float*)(lds + L_TBL) + hg * 128;
    LAS float* wsf = (LAS float*)(lds + L_WSF) + wid * 64; LAS float* PS = (LAS float*)(lds + L_PS); LAS float* IMP = (LAS float*)(lds + L_IMP); LAS unsigned* MW = (LAS unsigned*)(lds + L_MISC);
    const float* gates = (const float*)(ws + WS_F32S) + qrow * 32;
    if (tid == 0) MW[0] = 0u;
    bf16x8 qr[4]; load_q(qr, (const bf16_t*)(ws + WS_QN) + (size_t)(b * SEQ + q0w) * 512 + hg * 64, 512, r32, hi);
    const StageGeo sg = stage_geo(tid);
    { const bf16_t* Kc = (const bf16_t*)(ws + WS_KC) + (size_t)((b * 2 + g) * 128) * 64; const bf16_t* Vc = (const bf16_t*)(ws + WS_VC) + (size_t)((b * 2 + g) * 128) * 64;
#pragma unroll
        for (int t = 0; t < 2; ++t) { *(LAS u32x4*)(lds + L_SLOT + t * 16384 + sg.koff) = *(const u32x4*)(Kc + (size_t)(t * 64 + sg.krow) * 64 + sg.kcol);
            *(LAS u32x4*)(lds + L_SLOT + t * 16384 + sg.voff) = *(const u32x4*)(Vc + (size_t)(t * 64 + sg.vrow) * 64 + sg.vcol); } }
    __syncthreads();
    if (PARTS & 1) {
        f32x16 oc[2]; oc[0] = f32x16{}; oc[1] = f32x16{};
        f32x16 a0, a1, b0, b1; qkt(a0, a1, lds + L_SLOT, qr, r32, hi); qkt(b0, b1, lds + L_SLOT + 16384, qr, r32, hi);
        float mx = NEG;
#pragma unroll
        for (int r = 0; r < 16; ++r) { const int d = qpos - 16 * crow(r, hi) - 31;
            a0[r] = d >= 0 ? a0[r] + tb[min(d, 127)] : NEG; a1[r] = d - 512 >= 0 ? a1[r] + tb[min(d - 512, 127)] : NEG;
            b0[r] = d - 1024 >= 0 ? b0[r] + tb[min(d - 1024, 127)] : NEG; b1[r] = d - 1536 >= 0 ? b1[r] + tb[min(d - 1536, 127)] : NEG;
            mx = fmaxf(fmaxf(mx, fmaxf(a0[r], a1[r])), fmaxf(b0[r], b1[r])); }
        { auto rr = __builtin_amdgcn_permlane32_swap(__float_as_uint(mx), __float_as_uint(mx), false, false); mx = fmaxf(__uint_as_float(rr[0]), __uint_as_float(rr[1])); }
        const float mxs = mx == NEG ? 0.f : mx; float s = 0.f;
#pragma unroll
        for (int r = 0; r < 16; ++r) { a0[r] = fexp2(a0[r] - mxs); a1[r] = fexp2(a1[r] - mxs); b0[r] = fexp2(b0[r] - mxs); b1[r] = fexp2(b1[r] - mxs); s += (a0[r] + a1[r]) + (b0[r] + b1[r]); }
        s = halfsum(s); const float inv = s > 0.f ? 1.0f / s : 0.f;
#pragma unroll
        for (int r = 0; r < 16; ++r) { a0[r] *= inv; a1[r] *= inv; b0[r] *= inv; b1[r] *= inv; }
        {
            float own[4][4], x3[4][4], rcv[4][4];
#pragma unroll
            for (int i = 0; i < 4; ++i) {
                own[0][i] = 2.0f * (a0[4 * i] + a0[4 * i + 1] + a0[4 * i + 2]) + a0[4 * i + 3]; x3[0][i] = a0[4 * i + 3];
                own[1][i] = 2.0f * (a1[4 * i] + a1[4 * i + 1] + a1[4 * i + 2]) + a1[4 * i + 3]; x3[1][i] = a1[4 * i + 3];
                own[2][i] = 2.0f * (b0[4 * i] + b0[4 * i + 1] + b0[4 * i + 2]) + b0[4 * i + 3]; x3[2][i] = b0[4 * i + 3];
                own[3][i] = 2.0f * (b1[4 * i] + b1[4 * i + 1] + b1[4 * i + 2]) + b1[4 * i + 3]; x3[3][i] = b1[4 * i + 3]; }
#pragma unroll
            for (int k = 0; k < 4; ++k)
#pragma unroll
                for (int i = 0; i < 4; ++i) { auto rr = __builtin_amdgcn_permlane32_swap(__float_as_uint(x3[k][i]), __float_as_uint(x3[k][i]), false, false); rcv[k][i] = __uint_as_float(hi ? rr[0] : rr[1]); }
            LAS float* imh = PS + j * (64 * 33) + (sub * 32 + r32) * 33 + hi;
#pragma unroll
            for (int k = 0; k < 4; ++k)
#pragma unroll
                for (int i = 0; i < 4; ++i) { const float prev = i > 0 ? rcv[k][i - 1] : (k > 0 ? rcv[k - 1][3] : 0.f);
                    imh[8 * k + 2 * i] = own[k][i] + (hi ? rcv[k][i] : prev); }
        }
        const int vb0 = (int)(unsigned)(size_t)(lds + L_SLOT + 8192) + ((lane >> 4) & 1) * 32 + (lane & 3) * 8 + (4 * hi + ((lane & 15) >> 2)) * 64;
        bf16x8 x0, x1, x2, x3; pack_p(a0, a1, x0, x1, x2, x3); pv(oc, vb0, x0, x1, x2, x3);
        pack_p(b0, b1, x0, x1, x2, x3); pv(oc, vb0 + 16384, x0, x1, x2, x3);
        scale_rows(oc, wsf, sigmoidf_(gates[hg]), r32, hi);
        store_o<false>(oc, lds, (bf16_t*)(ws + WS_XB) + (size_t)(b * SEQ + q0w) * 512 + hg * 64, 512, nullptr, 0);
    }
    __syncthreads();
    if (PARTS & 2) {
        const int q = tid >> 3, jb = (tid & 7) * 4; const LAS float* ps = PS + q * 33; LAS float* im = IMP + q * 33;
#pragma unroll
        for (int jj = 0; jj < 4; ++jj) { const int jx = jb + jj;
            const float v = (ps[jx] + ps[64 * 33 + jx]) + (ps[2 * 64 * 33 + jx] + ps[3 * 64 * 33 + jx]);
            const bool valid = jx <= qb, forced = (jx == 0) || (jx == qb) || (jx == qb - 1);
            im[jx] = valid ? v + (forced ? 1e4f : 0.f) : -1e30f; }
        __syncthreads();
        unsigned bits = 0u;
#pragma unroll
        for (int jj = 0; jj < 4; ++jj) { const int jx = jb + jj; const float v = im[jx]; int cnt = 0;
#pragma unroll
            for (int j2 = 0; j2 < 32; ++j2) { const float v2 = im[j2]; cnt += (v2 > v || (v2 == v && j2 < jx)) ? 1 : 0; }
            if (cnt < 16 && jx <= qb) bits |= 1u << jx; }
        bits |= __shfl_xor(bits, 1); bits |= __shfl_xor(bits, 2); bits |= __shfl_xor(bits, 4);
        if ((tid & 7) == 0) { MW[16 + q] = bits; __hip_atomic_fetch_or(MW, bits, __ATOMIC_RELAXED, __HIP_MEMORY_SCOPE_WORKGROUP); }
        __syncthreads();
    }
    if (PARTS & 2) {
    f32x16 o[2]; o[0] = f32x16{}; o[1] = f32x16{}; float m = 0.f, l = 0.f;
    const unsigned mask = MW[16 + sub * 32 + r32];
    const unsigned um = MW[0] & (qb >= 31 ? 0xffffffffu : ((2u << qb) - 1u));
    const bf16_t* Kg = (const bf16_t*)(ws + WS_KVN) + (size_t)(b * SEQ) * 768 + 256 + g * 64;
    attn_loop2(um, Kg, 768, Kg + 128, 768, lds, qr, o, m, l, TfT5{tb, qpos, hi, q0w, 1 << 30, mask, true}, q0w + 31);
    l = halfsum(l);
    scale_rows(o, wsf, sigmoidf_(gates[8 + hg]) / l, r32, hi);
    { bf16_t* ocw = (bf16_t*)(ws + WS_XB) + (size_t)(b * SEQ + q0w) * 512 + hg * 64; store_o<true>(o, lds, ocw, 512, ocw, 512); }
    }
    if (PARTS & 4) {
    f32x16 o[2]; o[0] = f32x16{}; o[1] = f32x16{}; float m = -1e30f, l = 0.f;
    const int lo = qb > 8 ? qb - 8 : 0; const unsigned tmask = (qb >= 31 ? 0xffffffffu : ((2u << qb) - 1u)) & ~((1u << lo) - 1u);
    const bf16_t* Kg = (const bf16_t*)(ws + WS_KVN) + (size_t)(b * SEQ) * 768 + 512 + g * 64;
    attn_loop2(tmask, Kg, 768, Kg + 128, 768, lds, qr, o, m, l, TfT5{tb, qpos, hi, q0w, 512, 0u, false}, q0w + 31);
    l = halfsum(l);
    scale_rows(o, wsf, sigmoidf_(gates[16 + hg]) / l, r32, hi);
    { const bf16_t* ocw = (const bf16_t*)(ws + WS_XB) + (size_t)(b * SEQ + q0w) * 512 + hg * 64; store_o<true>(o, lds, (bf16_t*)(ws + WS_QN) + (size_t)(b * SEQ + q0w) * 512 + hg * 64, 512, ocw, 512); }
    }
}
template <bool DRY> __device__ __forceinline__ void sel_unit(const Args& a, LAS unsigned char* lds, int b, int g, int qb) {
    using namespace att;
    unsigned char* ws = a.ws;
    const int tid = fresh_tid(), lane = tid & 63, r32 = lane & 31, hi = lane >> 5, wid = __builtin_amdgcn_readfirstlane(tid >> 6);
    const int j = wid >> 1, sub = wid & 1, hg = g * 4 + j, q0w = qb * 64 + sub * 32, qpos = q0w + r32; const size_t qrow = (size_t)b * SEQ + qpos;
    const LAS float* tb = (const LAS float*)(lds + L_TBL) + hg * 128; LAS float* wsf = (LAS float*)(lds + L_WSF) + wid * 64;
    bf16_t* Qw = (bf16_t*)(ws + WS_QN) + (size_t)(b * SEQ + q0w) * 512 + hg * 64;
    bf16x8 qr[4]; load_q(qr, Qw, 512, r32, hi);
    const unsigned mask = ((const unsigned*)(ws + WS_MASK))[(size_t)(b * 2 + g) * SEQ + qpos];
    const unsigned um = ((const unsigned*)(ws + WS_UMASK))[(b * 2 + g) * 32 + qb] & (qb >= 31 ? 0xffffffffu : ((2u << qb) - 1u));
    f32x16 o[2]; o[0] = f32x16{}; o[1] = f32x16{}; float m = -1e30f, l = 0.f;
    const bf16_t* Kg = (const bf16_t*)(ws + WS_KVN) + (size_t)(b * SEQ) * 768 + 256 + g * 64;
    attn_loop2(um, Kg, 768, Kg + 128, 768, lds, qr, o, m, l, TfT5{tb, qpos, hi, q0w, 1 << 30, mask, true}, q0w + 31);
    l = halfsum(l);
    const float g1 = sigmoidf_(((const float*)(ws + WS_F32S))[qrow * 32 + 8 + hg]);
    scale_rows(o, wsf, g1 / l, r32, hi);
    store_o<true>(o, lds, DRY ? (bf16_t*)(ws + WS_XB + 16 * MiB) + (size_t)(b * SEQ + q0w) * 512 + hg * 64 : Qw, 512, (const bf16_t*)(ws + WS_XB) + (size_t)(b * SEQ + q0w) * 512 + hg * 64, 512);
}
#ifndef PHMASK
#define PHMASK 0xffffffffu
#endif
#define PH(n) (((PHMASK) >> (n)) & 1u)
#ifndef SINGLE_ALIGN
#define SINGLE_ALIGN true
#endif
#ifndef DUPMASK
#define DUPMASK 0u
#endif
#define DUP(n) (((DUPMASK) >> (n)) & 1u)
#define REP(n) for (int rep_ = 0; rep_ < 1 + (int)DUP(n); ++rep_)
__global__ void __launch_bounds__(512, 2) hybrid_fwd(Args a) {
    extern __shared__ __attribute__((aligned(16))) unsigned char lds_raw[];
    LAS unsigned char* lds = (LAS unsigned char*)lds_raw;
    cg::grid_group grid = cg::this_grid();
    unsigned char* ws = a.ws;
    const int tid = fresh_tid(), lane = tid & 63, wave = __builtin_amdgcn_readfirstlane(tid >> 6);
    const int G = gridDim.x, bx = blockIdx.x, vcu = (G % 8 == 0) ? (bx % 8) * (G / 8) + bx / 8 : bx;
    const int gw = vcu * 8 + wave, NGW = G * 8;
    float* X = a.out;
    bf16_t* XB = (bf16_t*)(ws + WS_XB);
    float* SS = (float*)(ws + WS_SS);
    { volatile LAS unsigned* st0 = (volatile LAS unsigned*)(lds + LDS_BYTES - 256); if (tid < 32) st0[tid] = 0u; }
    __syncthreads();
    XcdBarrier xbar = xcd_barrier_post((unsigned*)(ws + WS_CTL) + CW_BAR, (volatile LAS unsigned*)(lds + LDS_BYTES - 256 + 32));
#ifdef USE_CG_SYNC
#define GSYNC() grid.sync()
#else
    if (a.lo == 0x7e57) grid.sync();
#ifdef TSTAMP
    int gs_cnt = 0; unsigned long long t_start = __builtin_amdgcn_s_memrealtime(), t_rec = 0;
    unsigned long long t_prev = t_start;
#define GSYNC() do { xcd_barrier(xbar); ++gs_cnt; if (gs_cnt == TSTAMP - 1) t_prev = __builtin_amdgcn_s_memrealtime(); if (gs_cnt == TSTAMP) t_rec = __builtin_amdgcn_s_memrealtime(); } while (0)
#else
#define GSYNC() xcd_barrier(xbar)
#endif
#endif
    const float* fin_src = a.in[I_X];

#if STAGE_LIMIT >= 1
    REP(0) p0_prologue(a, lds, gw, NGW, wave, lane);
    GSYNC();
    { pg8::Gemm g{XB, (const bf16_t*)(ws + WS_WGU1), DM, DM, DM, 0, 0, 0, 0}; pg8::Order S; S.init(64, 22, 1, G, bx);
      pg8::EpiGU E{(bf16_t*)(ws + WS_H), SS};
#ifdef P1_NULLDUP
      { pg8::EpiNull E0{(float*)(ws + WS_POSC + 4096)}; pg8::gemm_phase<pg8::EpiNull, true>(lds, g, S, E0); }
#endif
      REP(1) pg8::gemm_phase<pg8::EpiGU, true>(lds, g, S, E);
      if (bx >= 128) { LAS float* scr = (LAS float*)(lds + wave * 16384); conv_run(a, N_GU + (bx - 128) * 8 + wave, CONV_NA, 1024, scr, lane); } }
    GSYNC();
    { pg8::Gemm g{(const bf16_t*)(ws + WS_H), (const bf16_t*)(ws + WS_WD1), FF, FF, FF, 0, 0, 0, 0}; pg8::Order S; S.init(64, 4, 1, G, bx);
      if (DUP(2)) { pg8::EpiNull E0{(float*)(ws + WS_POSC + 4096)}; pg8::gemm_phase<pg8::EpiNull, false>(lds, g, S, E0); }
      pg8::EpiRes<true, true> E{a.in[I_X], X, XB, SS + M, 0.5f}; pg8::gemm_phase<pg8::EpiRes<true, true>, false>(lds, g, S, E); }
    GSYNC();
    fin_src = X;
#endif
#if STAGE_LIMIT >= 2
#if PH(3)
    { pg8::Gemm g{XB, (const bf16_t*)(ws + WS_WIN), DM, DM, DM, 0, 0, 0, 0}; pg8::Order S; S.init(64, 20, 1, G, bx);
      pg8::EpiQKV E{(bf16_t*)(ws + WS_QN), (bf16_t*)(ws + WS_KVN), (bf16_t*)(ws + WS_QF), (bf16_t*)(ws + WS_KVF), (bf16_t*)(ws + WS_GAB), (float*)(ws + WS_F32S), SS + M};
      REP(3) pg8::gemm_phase<pg8::EpiQKV, true>(lds, g, S, E); }
#endif
    GSYNC();
#if PH(4)
    REP(4) if (bx < 128) { compress_unit(a, lds, bx); }
    else if (bx < 192) {
        { pg8::Gemm g{(const bf16_t*)(ws + WS_MEMB), (const bf16_t*)(ws + WS_WMKV), DM, DM, DM, 0, 0, 0, 0}; pg8::Order S; S.init(8, 8, 1, 64, bx - 128);
            pg8::EpiRowScale E{(bf16_t*)(ws + WS_KVM), 2 * DM, (const float*)(ws + WS_SSM)}; pg8::gemm_phase<pg8::EpiRowScale, false>(lds, g, S, E); }
    } else { if (wave == 0) cumsum_task(a, bx - 192, lane); kmax_task(a, lds, bx - 192, wave, lane); }
    if (bx >= 128) { LAS float* scr = (LAS float*)(lds + wave * 16384); conv_run(a, CONV_NA + (bx - 128) * 8 + wave, CONV_NA + CONV_NB, 1024, scr, lane); wqn_rows(a, (bx - 128) * 8 + wave, 1024, lane); }
#endif
    GSYNC();
#if PH(5)
    init_t5_table(a, lds);
    { const int bh = vcu >> 2, s = vcu & 3; if (DUP(5)) { fox_unit<true>(a, lds, bh >> 3, bh & 7, 7 - s); fox_unit<true>(a, lds, bh >> 3, bh & 7, s); }
      fox_unit<false>(a, lds, bh >> 3, bh & 7, 7 - s); fox_unit<false>(a, lds, bh >> 3, bh & 7, s); }
#ifdef DUPPART
    { const int bg = vcu >> 4, s = vcu & 15; cmpwin_unit<DUPPART>(a, lds, bg >> 1, bg & 1, 31 - s); cmpwin_unit<DUPPART>(a, lds, bg >> 1, bg & 1, s); }
#endif
#ifndef NO_CMPWIN
    REP(15) { const int bg = vcu >> 4, s = vcu & 15; cmpwin_unit<7>(a, lds, bg >> 1, bg & 1, 31 - s); cmpwin_unit<7>(a, lds, bg >> 1, bg & 1, s); }
#endif
#endif
    GSYNC();
#if PH(7)
    REP(7) { pg8::Order S; S.init(64, 4, 1, G, bx);
      { pg8::Gemm g{(const bf16_t*)(ws + WS_QN), (const bf16_t*)(ws + WS_WUPN), 512, 512, 512, 0, 0, 0, 0}; pg8::EpiUp<0> E{(const bf16_t*)(ws + WS_GAB), (bf16_t*)(ws + WS_Y)}; pg8::gemm_phase<pg8::EpiUp<0>, false>(lds, g, S, E); }
      { pg8::Gemm g{(const bf16_t*)(ws + WS_QF), (const bf16_t*)(ws + WS_WUPF), 512, 512, 512, 0, 0, 0, 0}; pg8::EpiUp<1> E{(const bf16_t*)(ws + WS_GAB), (bf16_t*)(ws + WS_Y)}; pg8::gemm_phase<pg8::EpiUp<1>, false>(lds, g, S, E); } }
#endif
    GSYNC();
#if PH(8)
    { pg8::Gemm g{(const bf16_t*)(ws + WS_Y), (const bf16_t*)(ws + WS_WOUT), DM, DM, DM, 0, 0, 0, 0}; pg8::Order S; S.init(64, 4, 1, G, bx);
      if (DUP(8)) { pg8::EpiNull E0{(float*)(ws + WS_POSC + 4096)}; pg8::gemm_phase<pg8::EpiNull, false>(lds, g, S, E0); }
      pg8::EpiRes<true, true> E{X, X, XB, SS + 2 * M, 1.0f}; pg8::gemm_phase<pg8::EpiRes<true, true>, false>(lds, g, S, E); }
    if (bx < 128) { pg8::Gemm g{(const bf16_t*)(ws + WS_KVM), (const bf16_t*)(ws + WS_WMQ), 2 * DM, DM, 256, (long)MEMLEN * 2 * DM, 256, 0, 256};
        pg8::OneUnit S{pg8::Unit{0, bx & 3, bx >> 2}}; pg8::EpiBatchBf16 E{(bf16_t*)(ws + WS_MT), DM, (long)DM * DM, (long)256 * DM}; pg8::gemm_phase<pg8::EpiBatchBf16, false>(lds, g, S, E); }
    else { pg8::Gemm g{(const bf16_t*)(ws + WS_WMO), (const bf16_t*)(ws + WS_KVM) + DM, DM, 2 * DM, 256, 0, 256, (long)MEMLEN * 2 * DM, 256};
        pg8::OneUnit S{pg8::Unit{(bx - 128) & 3, 0, (bx - 128) >> 2}}; pg8::EpiBatchBf16 E{(bf16_t*)(ws + WS_NT), DM, (long)DM * DM, 256}; pg8::gemm_phase<pg8::EpiBatchBf16, false>(lds, g, S, E); }
#endif
    GSYNC();
#endif
#if STAGE_LIMIT >= 3
    { pg8::Gemm g{XB, (const bf16_t*)(ws + WS_MT), DM, DM, DM, 0, 0, (long)4 * DM * DM, (long)DM * DM}; pg8::Order S; S.init(64, 4, 1, G, bx, 3);
      pg8::EpiSoftmaxRS E{(bf16_t*)(ws + WS_PM), DM, SS + 2 * M}; pg8::gemm_phase<pg8::EpiSoftmaxRS, false>(lds, g, S, E); }
    GSYNC();
    { pg8::Gemm g{(const bf16_t*)(ws + WS_PM), (const bf16_t*)(ws + WS_NT), DM, DM, DM, 0, 0, (long)4 * DM * DM, (long)DM * DM}; pg8::Order S; S.init(64, 4, 1, G, bx, 3);
      pg8::EpiRes<true, true> E{X, X, XB, SS + 3 * M, 1.0f}; pg8::gemm_phase<pg8::EpiRes<true, true>, false>(lds, g, S, E); }
    GSYNC();
#endif
#if STAGE_LIMIT >= 4
    { pg8::Gemm g{XB, (const bf16_t*)(ws + WS_WGU2), DM, DM, DM, 0, 0, 0, 0}; pg8::Order S; S.init(64, 22, 1, G, bx);
      pg8::EpiGU E{(bf16_t*)(ws + WS_H), SS + 3 * M}; REP(13) pg8::gemm_phase<pg8::EpiGU, true>(lds, g, S, E); }
    GSYNC();
    { pg8::Gemm g{(const bf16_t*)(ws + WS_H), (const bf16_t*)(ws + WS_WD2), FF, FF, FF, 0, 0, 0, 0}; pg8::Order S; S.init(64, 4, 1, G, bx);
      pg8::EpiResNorm E{X, X, 0.5f, a.in[I_FINN], (float*)(ws + WS_XBUF), (unsigned*)(ws + WS_FINCNT)}; pg8::gemm_phase<pg8::EpiResNorm, false>(lds, g, S, E); }
#ifdef TSTAMP
    GSYNC();
    if (t_rec == 0) t_rec = __builtin_amdgcn_s_memrealtime();
    if (bx == 0) { const int n = (int)((t_rec - t_prev) * 400 / 100); for (int i = tid; i < n; i += 512) X[i] += 0.1f; }
#endif
    return;
#endif
#ifdef EXTRA_BARS
    for (int eb = 0; eb < EXTRA_BARS; ++eb) GSYNC();
#endif
    { const float* gn = a.in[I_FINN]; const int tid2 = fresh_tid(), lane = tid2 & 63, gw = vcu * 8 + (tid2 >> 6);
      for (int mrow = gw; mrow < M; mrow += NGW) {
          const f32x4* xr = (const f32x4*)(fin_src + (size_t)mrow * DM) + lane; f32x4* orow = (f32x4*)(X + (size_t)mrow * DM) + lane;
          f32x4 v[4]; float s = 0.f;
#pragma unroll
          for (int j = 0; j < 4; ++j) { v[j] = xr[64 * j]; s += (v[j][0] * v[j][0] + v[j][1] * v[j][1]) + (v[j][2] * v[j][2] + v[j][3] * v[j][3]); }
          const float rs = rstd_of(wave_sum(s));
#pragma unroll
          for (int j = 0; j < 4; ++j) orow[64 * j] = v[j] * rs * ((const f32x4*)gn)[lane + 64 * j];
      } }
}

extern "C" void kernel_launch(void* const* d_in, const int* in_sizes, int n_in, void* d_out, int out_size, void* d_ws, size_t ws_size, hipStream_t stream) {
    static int grid = 0;
    if (grid == 0) {
        if (n_in != 29 || out_size != M * DM || ws_size < WS_END) { fprintf(stderr, "kernel_launch: unexpected shapes (n_in %d out %d ws %zu)\n", n_in, out_size, ws_size); grid = -1; return; }
        int dev = 0, cus = 0, per_cu = 0;
        hipGetDevice(&dev); hipDeviceGetAttribute(&cus, hipDeviceAttributeMultiprocessorCount, dev);
        if (hipFuncSetAttribute((const void*)hybrid_fwd, hipFuncAttributeMaxDynamicSharedMemorySize, LDS_BYTES) != hipSuccess) { fprintf(stderr, "kernel_launch: hipFuncSetAttribute failed\n"); grid = -1; return; }
        if (hipOccupancyMaxActiveBlocksPerMultiprocessor(&per_cu, (const void*)hybrid_fwd, 512, LDS_BYTES) != hipSuccess || per_cu < 1) { fprintf(stderr, "kernel_launch: occupancy query failed (%d)\n", per_cu); per_cu = 1; }
        (void)hipGetLastError();
        grid = cus * (per_cu < 1 ? 1 : 1);
        if (grid != 256) fprintf(stderr, "kernel_launch: grid %d != 256: this kernel's phase maps assume 256 workgroups\n", grid);
    }
    if (grid < 0) return;
    hipMemsetAsync((char*)d_ws + WS_CTL, 0, CTL_ZERO_BYTES, stream);
    Args a{};
    for (int i = 0; i < 29; ++i) a.in[i] = (const float*)d_in[i];
    a.out = (float*)d_out; a.ws = (unsigned char*)d_ws; a.lo = 0; a.hi = 0;
    void* args[] = {&a};
#ifdef PLAIN_LAUNCH
    hipLaunchKernelGGL(hybrid_fwd, dim3(grid), dim3(512), LDS_BYTES, stream, a); hipError_t e = hipPeekAtLastError(); (void)args;
#else
    hipError_t e = hipLaunchCooperativeKernel((const void*)hybrid_fwd, dim3(grid), dim3(512), args, LDS_BYTES, stream);
#endif
    if (e != hipSuccess) fprintf(stderr, "kernel_launch: cooperative launch failed: %s (grid %d)\n", hipGetErrorString(e), grid);
}
```

```cpp
#define ATT_GRP(w) 0
#include <hip/hip_runtime.h>
#include <hip/hip_cooperative_groups.h>
#include <cstdio>
#include <cstdint>
namespace cg = cooperative_groups;

#define LAS __attribute__((address_space(3)))
typedef unsigned short bf16_t;
typedef short bf16x8 __attribute__((ext_vector_type(8)));
typedef short s16x4 __attribute__((ext_vector_type(4)));
typedef float f32x2 __attribute__((ext_vector_type(2)));
typedef float f32x4 __attribute__((ext_vector_type(4)));
typedef float f32x16 __attribute__((ext_vector_type(16)));
typedef unsigned u32x2 __attribute__((ext_vector_type(2)));
typedef unsigned u32x4 __attribute__((ext_vector_type(4)));
typedef __bf16 bf16x2_t __attribute__((ext_vector_type(2)));

constexpr int NB = 8, SEQ = 2048, DM = 1024, FF = 2816, M = NB * SEQ;
constexpr int MEMLEN = 256, MROWS = NB * MEMLEN;
constexpr float RMS_EPS = 1e-6f;
constexpr float LOG2E = 1.4426950408889634f;
constexpr float QS64 = 0.125f * LOG2E;
constexpr float QS256 = 0.0625f * LOG2E;

__device__ __forceinline__ int fresh_tid() { int t = threadIdx.x; asm volatile("" : "+v"(t)); return t; }
__device__ __forceinline__ unsigned cvtpk(float lo, float hi) { f32x2 v = {lo, hi}; bf16x2_t b = __builtin_convertvector(v, bf16x2_t); return __builtin_bit_cast(unsigned, b); }
__device__ __forceinline__ float bflo(unsigned w) { return __uint_as_float(w << 16); }
__device__ __forceinline__ float bfhi(unsigned w) { return __uint_as_float(w & 0xffff0000u); }
__device__ __forceinline__ u32x4 pack8(f32x4 a, f32x4 b) { u32x4 w; w.x = cvtpk(a[0], a[1]); w.y = cvtpk(a[2], a[3]); w.z = cvtpk(b[0], b[1]); w.w = cvtpk(b[2], b[3]); return w; }
__device__ __forceinline__ float fexp2(float x) { return __builtin_amdgcn_exp2f(x); }
__device__ __forceinline__ float frcp(float x) { return __builtin_amdgcn_rcpf(x); }
__device__ __forceinline__ float sigmoidf_(float x) { return frcp(1.0f + fexp2(-x * LOG2E)); }
__device__ __forceinline__ float rstd_of(float ss) { return __builtin_amdgcn_rsqf(ss * (1.0f / DM) + RMS_EPS); }

namespace pg8 {
constexpr int BM = 256, BK = 64, HALF = 128, HTB = HALF * BK * 2, STAGE_BYTES = 8 * HTB, NXCD = 8, WGM = 8;
__host__ __device__ __forceinline__ int lds_byte(int r, int c) { const int st = (r >> 4) * 2 + (c >> 5), rr = r & 15, cc = c & 31, ob = rr * 64 + cc * 2; return st * 1024 + (ob ^ (((ob >> 9) & 1) << 5)); }
__host__ __device__ __forceinline__ void stage_rc(int b, int& R, int& C) { const int st = b / 1024, sb = b % 1024, swz = sb ^ (((sb >> 9) & 1) << 5); R = (st >> 1) * 16 + swz / 64; C = (st & 1) * 32 + (swz % 64) / 2; }
__host__ __device__ __forceinline__ int perm32(int rho) { const int n = rho >> 4, i = rho & 15; return 8 * (i >> 2) + 4 * n + (i & 3); }

struct Unit { int pm, pn, pb, ui; };
struct Gemm { const bf16_t* A; const bf16_t* Bt; int lda, ldb, K; long sAb, sAh, sBb, sBh; };

struct Order {
    int nM, nN, nwg, G, c, pbs;
    __device__ __forceinline__ void init(int nM_, int nN_, int nB_, int G_, int c_, int pbs_ = -1) { nM = nM_; nN = nN_; nwg = nM_ * nN_ * nB_; G = G_; c = c_; pbs = pbs_; }
    __device__ __forceinline__ bool next(int i, Unit& u) const {
        if (c < 0) return false;
        const long L = (long)i * G + c; if (L >= nwg) return false;
        int wgid = (int)L; { const int q = nwg / NXCD, r = nwg % NXCD, xcd = wgid % NXCD, off = wgid / NXCD; wgid = (xcd < r ? xcd * (q + 1) : r * (q + 1) + (xcd - r) * q) + off; }
        const int per = nM * nN; u.pb = wgid / per; const int w = wgid % per;
        const int nig = WGM * nN, gid = w / nig, fm = gid * WGM, gsz = (nM - fm) < WGM ? (nM - fm) : WGM;
        u.pm = fm + ((w % nig) % gsz); u.pn = (w % nig) / gsz; if (pbs >= 0) u.pb = u.pm >> pbs; return true;
    }
};

struct OneUnit { Unit u; __device__ __forceinline__ bool next(int i, Unit& o) const { if (i != 0) return false; o = u; o.ui = 0; return true; } };

typedef f32x4 Acc[2][2][4][2];

template <class Epi, bool ALIGN_EPI, class Sched>
__device__ __forceinline__ void gemm_phase(LAS unsigned char* lds, const Gemm g, const Sched& S, const Epi& E) {
    const int tid = fresh_tid(), wid = __builtin_amdgcn_readfirstlane(tid >> 6), lane = tid & 63, wr = wid >> 2, wc = wid & 3, fr = lane & 15, fq = lane >> 4;
    const int K = g.K, nt = K / BK;
    unsigned voffA[2], voffB[2];
#pragma unroll
    for (int i = 0; i < 2; ++i) { int R, C; stage_rc(tid * 16 + i * 8192, R, C); const int Rb = (R & ~31) + perm32(R & 31);
        voffA[i] = (unsigned)(R * g.lda + C) * 2u; voffB[i] = (unsigned)(Rb * g.ldb + C) * 2u; }
    const size_t kstep = (size_t)(BK * 2);
    const size_t hstepA = (size_t)HALF * g.lda * 2, hstepB = (size_t)HALF * g.ldb * 2;
    const size_t tstepA = 2 * hstepA, tstepB = 2 * hstepB;
    const unsigned ldsw = (unsigned)wid * 1024u;
    const int aoff = lds_byte(wr * 64 + fr, fq * 8), boff = lds_byte(wc * 32 + fr, fq * 8);
#define PG8_SA(b, h) (((b) * 2 + (h)) * HTB)
#define PG8_SB(b, h) ((4 + (b) * 2 + (h)) * HTB)
#define PG8_STAGE(bufoff, gbase, voff) do { _Pragma("unroll") for (int _i = 0; _i < 2; ++_i) \
        __builtin_amdgcn_global_load_lds((const unsigned*)((const char*)(gbase) + (voff)[_i]), (LAS unsigned*)(lds + (bufoff) + ldsw + _i * 8192), 16, 0, 0); } while (0)
#define PG8_LDA(dst, b, h) do { _Pragma("unroll") for (int m = 0; m < 4; ++m) _Pragma("unroll") for (int k = 0; k < 2; ++k) dst[m][k] = *(const LAS bf16x8*)(lds + PG8_SA(b, h) + aoff + m * 2048 + k * 1024); } while (0)
#define PG8_LDB(dst, b, h) do { _Pragma("unroll") for (int n = 0; n < 2; ++n) _Pragma("unroll") for (int k = 0; k < 2; ++k) dst[n][k] = *(const LAS bf16x8*)(lds + PG8_SB(b, h) + boff + n * 2048 + k * 1024); } while (0)
#define PG8_MMA(ai, bj, At, Bt) do { __builtin_amdgcn_s_setprio(1); _Pragma("unroll") for (int m = 0; m < 4; ++m) _Pragma("unroll") for (int n = 0; n < 2; ++n) _Pragma("unroll") for (int k = 0; k < 2; ++k) \
        acc[ai][bj][m][n] = __builtin_amdgcn_mfma_f32_16x16x32_bf16(Bt[n][k], At[m][k], acc[ai][bj][m][n], 0, 0, 0); __builtin_amdgcn_s_setprio(0); } while (0)
#define PG8_WAIT_V(n) asm volatile("s_waitcnt vmcnt(" #n ")" ::: "memory")
#define PG8_WAIT_L(n) asm volatile("s_waitcnt lgkmcnt(" #n ")" ::: "memory")
#define PG8_BAR __builtin_amdgcn_s_barrier()
#define PG8_SCHED __builtin_amdgcn_sched_barrier(0)
#define PG8_OFFA(u) ((size_t)(((u).pb >> 2) * g.sAb + ((u).pb & 3) * g.sAh) * 2 + (size_t)(u).pm * tstepA)
#define PG8_OFFB(u) ((size_t)(((u).pb >> 2) * g.sBb + ((u).pb & 3) * g.sBh) * 2 + (size_t)(u).pn * tstepB)
    Unit cur, nxt; int ui = 0;
    if (!S.next(0, cur)) return;
    cur.ui = 0;
    Acc acc;
#pragma unroll
    for (int a = 0; a < 2; ++a)
#pragma unroll
        for (int b = 0; b < 2; ++b)
#pragma unroll
            for (int m = 0; m < 4; ++m)
#pragma unroll
                for (int n = 0; n < 2; ++n) acc[a][b][m][n] = (f32x4){0.f, 0.f, 0.f, 0.f};
    bf16x8 At[4][2], B0[2][2], B1[2][2];
    const char* cA = (const char*)g.A + PG8_OFFA(cur); const char* cB = (const char*)g.Bt + PG8_OFFB(cur);
    {
        PG8_STAGE(PG8_SB(0, 0), cB, voffB); PG8_STAGE(PG8_SB(0, 1), cB + hstepB, voffB); PG8_STAGE(PG8_SA(0, 0), cA, voffA); PG8_STAGE(PG8_SA(0, 1), cA + hstepA, voffA);
        if (wr == 1) PG8_BAR;
        PG8_WAIT_V(2); PG8_BAR;
        PG8_STAGE(PG8_SB(1, 0), cB + kstep, voffB); PG8_STAGE(PG8_SA(1, 0), cA + kstep, voffA); PG8_STAGE(PG8_SB(1, 1), cB + hstepB + kstep, voffB);
        PG8_WAIT_V(6); PG8_BAR;
    }
    for (;;) {
        const bool has_next = S.next(ui + 1, nxt); nxt.ui = ui + 1;
        const char* nA = has_next ? (const char*)g.A + PG8_OFFA(nxt) : cA; const char* nB = has_next ? (const char*)g.Bt + PG8_OFFB(nxt) : cB;
        for (int t = 0; t < nt; t += 2) {
            const bool last = (t == nt - 2);
            const char* a1 = cA + (size_t)(t + 1) * kstep;
            const char* a2 = last ? nA : cA + (size_t)(t + 2) * kstep; const char* b2 = last ? nB : cB + (size_t)(t + 2) * kstep;
            const char* a3 = a2 + kstep; const char* b3 = b2 + kstep;
            PG8_LDB(B0, 0, 0); PG8_LDB(B1, 0, 1); PG8_SCHED; PG8_LDA(At, 0, 0); PG8_STAGE(PG8_SA(1, 1), a1 + hstepA, voffA);
            PG8_WAIT_V(8); PG8_WAIT_L(0); PG8_BAR; PG8_MMA(0, 0, At, B0); PG8_MMA(0, 1, At, B1); PG8_BAR; PG8_SCHED;
            PG8_LDA(At, 0, 1); PG8_STAGE(PG8_SB(0, 0), b2, voffB); PG8_STAGE(PG8_SB(0, 1), b2 + hstepB, voffB); PG8_STAGE(PG8_SA(0, 0), a2, voffA);
            PG8_WAIT_V(8); PG8_WAIT_L(0); PG8_BAR; PG8_MMA(1, 0, At, B0); PG8_MMA(1, 1, At, B1); PG8_BAR; PG8_SCHED;
            PG8_LDB(B0, 1, 0); PG8_LDB(B1, 1, 1); PG8_SCHED; PG8_LDA(At, 1, 0); PG8_STAGE(PG8_SA(0, 1), a2 + hstepA, voffA);
            PG8_WAIT_V(8); PG8_WAIT_L(0); PG8_BAR; PG8_MMA(0, 0, At, B0); PG8_MMA(0, 1, At, B1); PG8_BAR; PG8_SCHED;
            PG8_LDA(At, 1, 1); PG8_STAGE(PG8_SB(1, 0), b3, voffB); PG8_STAGE(PG8_SB(1, 1), b3 + hstepB, voffB); PG8_STAGE(PG8_SA(1, 0), a3, voffA);
            PG8_WAIT_V(8); PG8_WAIT_L(0); PG8_BAR; PG8_MMA(1, 0, At, B0); PG8_MMA(1, 1, At, B1); PG8_BAR; PG8_SCHED;
        }
        if constexpr (ALIGN_EPI) { if (wr == 0) PG8_BAR; }
        if constexpr (!Epi::AFTER_DRAIN) { const int l2_ = fresh_tid() & 63; E(acc, cur, wr, wc, l2_ & 15, l2_ >> 4); }
        if (!has_next) break;
#pragma unroll
        for (int a = 0; a < 2; ++a)
#pragma unroll
            for (int b = 0; b < 2; ++b)
#pragma unroll
                for (int m = 0; m < 4; ++m)
#pragma unroll
                    for (int n = 0; n < 2; ++n) acc[a][b][m][n] = (f32x4){0.f, 0.f, 0.f, 0.f};
        cur = nxt; cA = nA; cB = nB; ++ui;
        if constexpr (ALIGN_EPI) { if (wr == 1) PG8_BAR; }
    }
    PG8_WAIT_V(0);
    if constexpr (!ALIGN_EPI) { if (wr == 0) PG8_BAR; }
    PG8_BAR;
    if constexpr (Epi::AFTER_DRAIN) { const int l2_ = fresh_tid() & 63; E.fused(acc, cur, wr, wc, l2_ & 15, l2_ >> 4, lds, wid, l2_); }
#undef PG8_SA
#undef PG8_SB
#undef PG8_STAGE
#undef PG8_LDA
#undef PG8_LDB
#undef PG8_MMA
#undef PG8_WAIT_V
#undef PG8_WAIT_L
#undef PG8_BAR
#undef PG8_SCHED
#undef PG8_OFFA
#undef PG8_OFFB
}

struct EpiNull { static constexpr bool AFTER_DRAIN = false; float* sink; __device__ __forceinline__ void operator()(const Acc& acc, const Unit& u, int wr, int wc, int fr, int fq) const { f32x4 s = {0.f, 0.f, 0.f, 0.f};
_Pragma("unroll") for (int a = 0; a < 2; ++a) _Pragma("unroll") for (int b = 0; b < 2; ++b) _Pragma("unroll") for (int m = 0; m < 4; ++m) _Pragma("unroll") for (int n = 0; n < 2; ++n) s += acc[a][b][m][n];
 if (s[0] + s[1] + s[2] + s[3] == 1234567.25f) sink[0] = 1.f; } };
struct EpiGU {
    static constexpr bool AFTER_DRAIN = false;
    bf16_t* H; const LAS float* aux;
    __device__ __forceinline__ void operator()(const Acc& acc, const Unit& u, int wr, int wc, int fr, int fq) const {
        const int row0 = u.pm * BM + wr * 64 + fr, col0 = u.pn * 128 + wc * 32 + fq * 8;
        float rsv[2][4];
#pragma unroll
        for (int ai = 0; ai < 2; ++ai)
#pragma unroll
            for (int m = 0; m < 4; ++m) rsv[ai][m] = aux[u.ui * 256 + wr * 64 + fr + ai * HALF + m * 16];
#pragma unroll
        for (int ai = 0; ai < 2; ++ai)
#pragma unroll
            for (int m = 0; m < 4; ++m) {
                const int row = row0 + ai * HALF + m * 16; const float rs = rstd_of(rsv[ai][m]);
                f32x4 h[2];
#pragma unroll
                for (int n = 0; n < 2; ++n) { const f32x4 gg = acc[ai][0][m][n] * rs, uu = acc[ai][1][m][n] * rs;
#pragma unroll
                    for (int j = 0; j < 4; ++j) h[n][j] = gg[j] * sigmoidf_(gg[j]) * uu[j]; }
                *(u32x4*)(H + (size_t)row * FF + col0) = pack8(h[0], h[1]);
            }
    }
};
template <bool WRITE_XB, bool WRITE_SS> struct EpiRes {
    static constexpr bool AFTER_DRAIN = false;
    const float* base; float* out; bf16_t* xb; float* ss; float scale;
    __device__ __forceinline__ void operator()(const Acc& acc, const Unit& u, int wr, int wc, int fr, int fq) const {
        const int row0 = u.pm * BM + wr * 64 + fr, col0 = u.pn * BM + wc * 32 + fq * 8;
#pragma unroll
        for (int ai = 0; ai < 2; ++ai)
#pragma unroll
            for (int m2 = 0; m2 < 4; m2 += 2) {
                f32x4 o[2][2][2];
#pragma unroll
                for (int mm = 0; mm < 2; ++mm)
#pragma unroll
                    for (int bj = 0; bj < 2; ++bj) { const size_t p = (size_t)(row0 + ai * HALF + (m2 + mm) * 16) * DM + col0 + bj * HALF; o[mm][bj][0] = *(const f32x4*)(base + p); o[mm][bj][1] = *(const f32x4*)(base + p + 4); }
#pragma unroll
                for (int mm = 0; mm < 2; ++mm) { const int m = m2 + mm, row = row0 + ai * HALF + m * 16; float sq = 0.f;
#pragma unroll
                    for (int bj = 0; bj < 2; ++bj) { const size_t p = (size_t)row * DM + col0 + bj * HALF;
                        const f32x4 n0 = o[mm][bj][0] + acc[ai][bj][m][0] * scale, n1 = o[mm][bj][1] + acc[ai][bj][m][1] * scale;
                        *(f32x4*)(out + p) = n0; *(f32x4*)(out + p + 4) = n1;
                        if (WRITE_XB) *(u32x4*)(xb + p) = pack8(n0, n1);
                        if (WRITE_SS) sq += (n0[0] * n0[0] + n0[1] * n0[1]) + (n0[2] * n0[2] + n0[3] * n0[3]) + (n1[0] * n1[0] + n1[1] * n1[1]) + (n1[2] * n1[2] + n1[3] * n1[3]); }
                    if (WRITE_SS) { sq += __shfl_xor(sq, 16); sq += __shfl_xor(sq, 32); if (fq == 0) unsafeAtomicAdd(ss + row, sq); } }
                asm volatile("" ::: "memory");
            }
    }
};
template <bool BASE_F32> struct EpiResB {
    static constexpr bool AFTER_DRAIN = false;
    const float* basef; bf16_t* xb; float* ss; float scale;
    __device__ __forceinline__ void operator()(const Acc& acc, const Unit& u, int wr, int wc, int fr, int fq) const {
        const int row0 = u.pm * BM + wr * 64 + fr, col0 = u.pn * BM + wc * 32 + fq * 8;
#pragma unroll
        for (int ai = 0; ai < 2; ++ai) {
            f32x4 of[4][2][2]; u32x4 ob[4][2];
#pragma unroll
            for (int m = 0; m < 4; ++m)
#pragma unroll
                for (int bj = 0; bj < 2; ++bj) { const size_t p = (size_t)(row0 + ai * HALF + m * 16) * DM + col0 + bj * HALF;
                    if (BASE_F32) { of[m][bj][0] = *(const f32x4*)(basef + p); of[m][bj][1] = *(const f32x4*)(basef + p + 4); } else ob[m][bj] = *(const u32x4*)(xb + p); }
#pragma unroll
            for (int m = 0; m < 4; ++m) { const int row = row0 + ai * HALF + m * 16; float sq = 0.f;
#pragma unroll
                for (int bj = 0; bj < 2; ++bj) { const size_t p = (size_t)row * DM + col0 + bj * HALF; f32x4 o0, o1;
                    if (BASE_F32) { o0 = of[m][bj][0]; o1 = of[m][bj][1]; }
                    else { const u32x4 w = ob[m][bj]; o0 = (f32x4){bflo(w.x), bfhi(w.x), bflo(w.y), bfhi(w.y)}; o1 = (f32x4){bflo(w.z), bfhi(w.z), bflo(w.w), bfhi(w.w)}; }
                    const f32x4 n0 = o0 + acc[ai][bj][m][0] * scale, n1 = o1 + acc[ai][bj][m][1] * scale;
                    *(u32x4*)(xb + p) = pack8(n0, n1);
                    sq += (n0[0] * n0[0] + n0[1] * n0[1]) + (n0[2] * n0[2] + n0[3] * n0[3]) + (n1[0] * n1[0] + n1[1] * n1[1]) + (n1[2] * n1[2] + n1[3] * n1[3]); }
                sq += __shfl_xor(sq, 16); sq += __shfl_xor(sq, 32); if (fq == 0) unsafeAtomicAdd(ss + row, sq); }
            asm volatile("" ::: "memory"); }
    }
};
struct EpiQKV {
    static constexpr bool AFTER_DRAIN = false;
    bf16_t *QN, *KVN, *QF, *KVF, *GAB; float* F32S; const LAS float* aux;
    __device__ __forceinline__ void operator()(const Acc& acc, const Unit& u, int wr, int wc, int fr, int fq) const {
        const int row0 = u.pm * BM + wr * 64 + fr, pn = u.pn;
        if (pn == 19) {
            if (wc == 0) {
#pragma unroll
                for (int ai = 0; ai < 2; ++ai)
#pragma unroll
                    for (int m = 0; m < 4; ++m) { const int row = row0 + ai * HALF + m * 16; const float rs = rstd_of(aux[u.ui * 256 + wr * 64 + fr + ai * HALF + m * 16]);
                        *(f32x4*)(F32S + (size_t)row * 32 + fq * 8) = acc[ai][0][m][0] * rs; *(f32x4*)(F32S + (size_t)row * 32 + fq * 8 + 4) = acc[ai][0][m][1] * rs; }
            }
            return;
        }
        bf16_t* dst; int pitch, coff;
        if (pn < 2) { dst = QN; pitch = 512; coff = pn * 256; }
        else if (pn < 5) { dst = KVN; pitch = 768; coff = (pn - 2) * 256; }
        else if (pn < 7) { dst = QF; pitch = 512; coff = (pn - 5) * 256; }
        else if (pn < 11) { dst = KVF; pitch = 1024; coff = (pn - 7) * 256; }
        else { dst = GAB; pitch = 2048; coff = (pn - 11) * 256; }
        coff += wc * 32 + fq * 8;
        float rsv[2][4];
#pragma unroll
        for (int ai = 0; ai < 2; ++ai)
#pragma unroll
            for (int m = 0; m < 4; ++m) rsv[ai][m] = aux[u.ui * 256 + wr * 64 + fr + ai * HALF + m * 16];
#pragma unroll
        for (int ai = 0; ai < 2; ++ai)
#pragma unroll
            for (int m = 0; m < 4; ++m) { const int row = row0 + ai * HALF + m * 16; const float rs = rstd_of(rsv[ai][m]);
#pragma unroll
                for (int bj = 0; bj < 2; ++bj) *(u32x4*)(dst + (size_t)row * pitch + coff + bj * HALF) = pack8(acc[ai][bj][m][0] * rs, acc[ai][bj][m][1] * rs); }
    }
};
template <int STEP> struct EpiUp {
    static constexpr bool AFTER_DRAIN = false;
    const bf16_t* GAB; bf16_t* Y;
    __device__ __forceinline__ void operator()(const Acc& acc, const Unit& u, int wr, int wc, int fr, int fq) const {
        const int row0 = u.pm * BM + wr * 64 + fr, col0 = u.pn * BM + wc * 32 + fq * 8;
#pragma unroll
        for (int ai = 0; ai < 2; ++ai) {
            u32x4 gw[4][2], yw[4][2];
#pragma unroll
            for (int m = 0; m < 4; ++m)
#pragma unroll
                for (int bj = 0; bj < 2; ++bj) { const int row = row0 + ai * HALF + m * 16, c = col0 + bj * HALF;
                    gw[m][bj] = *(const u32x4*)(GAB + (size_t)row * 2048 + STEP * 1024 + c); if (STEP == 1) yw[m][bj] = *(const u32x4*)(Y + (size_t)row * DM + c); }
#pragma unroll
            for (int m = 0; m < 4; ++m)
#pragma unroll
                for (int bj = 0; bj < 2; ++bj) { const int row = row0 + ai * HALF + m * 16, c = col0 + bj * HALF; const u32x4 g4 = gw[m][bj];
                    f32x4 v0, v1; const f32x4 a0 = acc[ai][bj][m][0], a1 = acc[ai][bj][m][1];
                    v0[0] = sigmoidf_(bflo(g4.x)) * a0[0]; v0[1] = sigmoidf_(bfhi(g4.x)) * a0[1]; v0[2] = sigmoidf_(bflo(g4.y)) * a0[2]; v0[3] = sigmoidf_(bfhi(g4.y)) * a0[3];
                    v1[0] = sigmoidf_(bflo(g4.z)) * a1[0]; v1[1] = sigmoidf_(bfhi(g4.z)) * a1[1]; v1[2] = sigmoidf_(bflo(g4.w)) * a1[2]; v1[3] = sigmoidf_(bfhi(g4.w)) * a1[3];
                    if (STEP == 1) { const u32x4 y = yw[m][bj];
                        v0[0] += bflo(y.x); v0[1] += bfhi(y.x); v0[2] += bflo(y.y); v0[3] += bfhi(y.y); v1[0] += bflo(y.z); v1[1] += bfhi(y.z); v1[2] += bflo(y.w); v1[3] += bfhi(y.w); }
                    *(u32x4*)(Y + (size_t)row * DM + c) = pack8(v0, v1); }
            asm volatile("" ::: "memory"); }
    }
};
struct EpiRowScale {
    static constexpr bool AFTER_DRAIN = false;
    bf16_t* O; int ldo; const float* ss;
    __device__ __forceinline__ void operator()(const Acc& acc, const Unit& u, int wr, int wc, int fr, int fq) const {
        const int row0 = u.pm * BM + wr * 64 + fr, col0 = u.pn * BM + wc * 32 + fq * 8;
        float rsv[2][4];
#pragma unroll
        for (int ai = 0; ai < 2; ++ai)
#pragma unroll
            for (int m = 0; m < 4; ++m) rsv[ai][m] = ss[row0 + ai * HALF + m * 16];
#pragma unroll
        for (int ai = 0; ai < 2; ++ai)
#pragma unroll
            for (int m = 0; m < 4; ++m) { const int row = row0 + ai * HALF + m * 16; const float rs = rstd_of(rsv[ai][m]);
#pragma unroll
                for (int bj = 0; bj < 2; ++bj) *(u32x4*)(O + (size_t)row * ldo + col0 + bj * HALF) = pack8(acc[ai][bj][m][0] * rs, acc[ai][bj][m][1] * rs); }
    }
};
struct EpiColScale {
    static constexpr bool AFTER_DRAIN = false;
    bf16_t* O; int ldo; const float* ss;
    __device__ __forceinline__ void operator()(const Acc& acc, const Unit& u, int wr, int wc, int fr, int fq) const {
        const int row0 = u.pm * BM + wr * 64 + fr, col0 = u.pn * BM + wc * 32 + fq * 8;
#pragma unroll
        for (int bj = 0; bj < 2; ++bj) { const int c = col0 + bj * HALF;
            f32x4 s0 = *(const f32x4*)(ss + c), s1 = *(const f32x4*)(ss + c + 4);
#pragma unroll
            for (int j = 0; j < 4; ++j) { s0[j] = rstd_of(s0[j]); s1[j] = rstd_of(s1[j]); }
#pragma unroll
            for (int ai = 0; ai < 2; ++ai)
#pragma unroll
                for (int m = 0; m < 4; ++m) { const int row = row0 + ai * HALF + m * 16;
                    *(u32x4*)(O + (size_t)row * ldo + c) = pack8(acc[ai][bj][m][0] * s0, acc[ai][bj][m][1] * s1); } }
    }
};
struct EpiBatchBf16 {
    static constexpr bool AFTER_DRAIN = false;
    bf16_t* O; int ldo; long sOb, sOh;
    __device__ __forceinline__ void operator()(const Acc& acc, const Unit& u, int wr, int wc, int fr, int fq) const {
        const int row0 = u.pm * BM + wr * 64 + fr, col0 = u.pn * BM + wc * 32 + fq * 8;
        bf16_t* Ob = O + (size_t)((u.pb >> 2) * sOb + (u.pb & 3) * sOh);
#pragma unroll
        for (int ai = 0; ai < 2; ++ai)
#pragma unroll
            for (int m = 0; m < 4; ++m) { const int row = row0 + ai * HALF + m * 16;
#pragma unroll
                for (int bj = 0; bj < 2; ++bj) *(u32x4*)(Ob + (size_t)row * ldo + col0 + bj * HALF) = pack8(acc[ai][bj][m][0], acc[ai][bj][m][1]); }
    }
};
struct EpiSoftmax {
    static constexpr bool AFTER_DRAIN = true;
    bf16_t* P;
    __device__ __forceinline__ void fused(Acc& acc, const Unit& u, int wr, int wc, int fr, int fq, LAS unsigned char* lds, int wid, int lane) const {
        LAS float* Pm = (LAS float*)lds;
        LAS float* Ps = (LAS float*)(lds + 8192);
#pragma unroll
        for (int ai = 0; ai < 2; ++ai)
#pragma unroll
            for (int m = 0; m < 4; ++m) { float mx = -3.0e38f;
#pragma unroll
                for (int bj = 0; bj < 2; ++bj)
#pragma unroll
                    for (int n = 0; n < 2; ++n) { const f32x4 x = acc[ai][bj][m][n]; mx = fmaxf(mx, fmaxf(fmaxf(x[0], x[1]), fmaxf(x[2], x[3]))); }
                mx = fmaxf(mx, __shfl_xor(mx, 16)); mx = fmaxf(mx, __shfl_xor(mx, 32));
                if (fq == 0) Pm[(ai * HALF + wr * 64 + m * 16 + fr) * 4 + wc] = mx; }
        __syncthreads();
#pragma unroll
        for (int ai = 0; ai < 2; ++ai)
#pragma unroll
            for (int m = 0; m < 4; ++m) { const int r = ai * HALF + wr * 64 + m * 16 + fr; const f32x4 t = *(const LAS f32x4*)(Pm + r * 4);
                const float mx = fmaxf(fmaxf(t[0], t[1]), fmaxf(t[2], t[3])); float s = 0.f;
#pragma unroll
                for (int bj = 0; bj < 2; ++bj)
#pragma unroll
                    for (int n = 0; n < 2; ++n) { f32x4 x = acc[ai][bj][m][n];
#pragma unroll
                        for (int j = 0; j < 4; ++j) { x[j] = fexp2(x[j] - mx); s += x[j]; }
                        acc[ai][bj][m][n] = x; }
                s += __shfl_xor(s, 16); s += __shfl_xor(s, 32);
                if (fq == 0) Ps[r * 4 + wc] = s; }
        __syncthreads();
        bf16_t* Pb = P + (size_t)u.pb * SEQ * 256;
        const int col0 = wc * 32 + fq * 8;
#pragma unroll
        for (int ai = 0; ai < 2; ++ai)
#pragma unroll
            for (int m = 0; m < 4; ++m) { const int r = ai * HALF + wr * 64 + m * 16 + fr; const f32x4 t = *(const LAS f32x4*)(Ps + r * 4);
                const float inv = frcp((t[0] + t[1]) + (t[2] + t[3])); const int row = u.pm * BM + r;
#pragma unroll
                for (int bj = 0; bj < 2; ++bj) *(u32x4*)(Pb + (size_t)row * 256 + col0 + bj * HALF) = pack8(acc[ai][bj][m][0] * inv, acc[ai][bj][m][1] * inv); }
        __syncthreads();
    }
};
struct EpiSoftmaxRS {
    static constexpr bool AFTER_DRAIN = true;
    bf16_t* P; int ldp; const float* ss;
    __device__ __forceinline__ void fused(Acc& acc, const Unit& u, int wr, int wc, int fr, int fq, LAS unsigned char* lds, int wid, int lane) const {
        LAS float* Pm = (LAS float*)lds; LAS float* Ps = (LAS float*)(lds + 8192);
#pragma unroll
        for (int ai = 0; ai < 2; ++ai)
#pragma unroll
            for (int m = 0; m < 4; ++m) { const float rs = rstd_of(ss[u.pm * BM + ai * HALF + wr * 64 + m * 16 + fr]); float mx = -3.0e38f;
#pragma unroll
                for (int bj = 0; bj < 2; ++bj)
#pragma unroll
                    for (int n = 0; n < 2; ++n) { const f32x4 x = acc[ai][bj][m][n] * rs; acc[ai][bj][m][n] = x; mx = fmaxf(mx, fmaxf(fmaxf(x[0], x[1]), fmaxf(x[2], x[3]))); }
                mx = fmaxf(mx, __shfl_xor(mx, 16)); mx = fmaxf(mx, __shfl_xor(mx, 32));
                if (fq == 0) Pm[(ai * HALF + wr * 64 + m * 16 + fr) * 4 + wc] = mx; }
        __syncthreads();
#pragma unroll
        for (int ai = 0; ai < 2; ++ai)
#pragma unroll
            for (int m = 0; m < 4; ++m) { const int r = ai * HALF + wr * 64 + m * 16 + fr; const f32x4 t = *(const LAS f32x4*)(Pm + r * 4);
                const float mx = fmaxf(fmaxf(t[0], t[1]), fmaxf(t[2], t[3])); float s = 0.f;
#pragma unroll
                for (int bj = 0; bj < 2; ++bj)
#pragma unroll
                    for (int n = 0; n < 2; ++n) { f32x4 x = acc[ai][bj][m][n];
#pragma unroll
                        for (int j = 0; j < 4; ++j) { x[j] = fexp2(x[j] - mx); s += x[j]; }
                        acc[ai][bj][m][n] = x; }
                s += __shfl_xor(s, 16); s += __shfl_xor(s, 32);
                if (fq == 0) Ps[r * 4 + wc] = s; }
        __syncthreads();
        const int col0 = u.pn * BM + wc * 32 + fq * 8;
#pragma unroll
        for (int ai = 0; ai < 2; ++ai)
#pragma unroll
            for (int m = 0; m < 4; ++m) { const int r = ai * HALF + wr * 64 + m * 16 + fr; const f32x4 t = *(const LAS f32x4*)(Ps + r * 4);
                const float inv = frcp((t[0] + t[1]) + (t[2] + t[3])); const int row = u.pm * BM + r;
#pragma unroll
                for (int bj = 0; bj < 2; ++bj) *(u32x4*)(P + (size_t)row * ldp + col0 + bj * HALF) = pack8(acc[ai][bj][m][0] * inv, acc[ai][bj][m][1] * inv); }
        __syncthreads();
    }
};
struct EpiResNorm {
    static constexpr bool AFTER_DRAIN = true;
    const bf16_t* Xold; float* out; float scale; const float* gn; float* xbuf; unsigned* cnt;
    __device__ __forceinline__ void fused(Acc& acc, const Unit& u, int wr, int wc, int fr, int fq, LAS unsigned char* lds, int wid, int lane) const {
        LAS float* P = (LAS float*)lds;
        LAS float* S = (LAS float*)(lds + 4096);
        const int row0 = u.pm * BM + wr * 64 + fr, col0 = u.pn * BM + wc * 32 + fq * 8;
#pragma unroll
        for (int ai = 0; ai < 2; ++ai)
#pragma unroll
            for (int m = 0; m < 4; ++m) { const int row = row0 + ai * HALF + m * 16; float sq = 0.f;
#pragma unroll
                for (int bj = 0; bj < 2; ++bj) { const size_t p = (size_t)row * DM + col0 + bj * HALF;
                    const u32x4 w = *(const u32x4*)(Xold + p); const f32x4 o0 = {bflo(w.x), bfhi(w.x), bflo(w.y), bfhi(w.y)}, o1 = {bflo(w.z), bfhi(w.z), bflo(w.w), bfhi(w.w)};
                    const f32x4 n0 = o0 + acc[ai][bj][m][0] * scale, n1 = o1 + acc[ai][bj][m][1] * scale;
                    acc[ai][bj][m][0] = n0; acc[ai][bj][m][1] = n1;
                    sq += (n0[0] * n0[0] + n0[1] * n0[1]) + (n0[2] * n0[2] + n0[3] * n0[3]) + (n1[0] * n1[0] + n1[1] * n1[1]) + (n1[2] * n1[2] + n1[3] * n1[3]); }
                sq += __shfl_xor(sq, 16); sq += __shfl_xor(sq, 32);
                if (fq == 0) P[(ai * HALF + wr * 64 + m * 16 + fr) * 4 + wc] = sq;
                if (m & 1) asm volatile("" ::: "memory"); }
        __syncthreads();
        const int prow = wid * 32 + (lane & 31);
        if (lane < 32) { const f32x4 t = *(const LAS f32x4*)(P + prow * 4);
            __hip_atomic_store(xbuf + (size_t)(u.pm * BM + prow) * 4 + u.pn, (t[0] + t[1]) + (t[2] + t[3]), __ATOMIC_RELAXED, __HIP_MEMORY_SCOPE_AGENT); }
        asm volatile("s_waitcnt vmcnt(0)" ::: "memory");
        if (lane == 0) __hip_atomic_fetch_add(cnt + 64 * u.pm, 1u, __ATOMIC_RELAXED, __HIP_MEMORY_SCOPE_AGENT);
        if (wid == 0) { unsigned sp = 0;
            while ((unsigned)__builtin_amdgcn_readfirstlane(__hip_atomic_load(cnt + 64 * u.pm, __ATOMIC_RELAXED, __HIP_MEMORY_SCOPE_AGENT)) < 32u) { __builtin_amdgcn_s_sleep(2); if (++sp > (1u << 20)) break; }
            __builtin_amdgcn_fence(__ATOMIC_ACQUIRE, "agent"); }
        asm volatile("s_waitcnt vmcnt(0) lgkmcnt(0)" ::: "memory");
        __syncthreads();
        if (lane < 32) { const float* sl = xbuf + (size_t)(u.pm * BM + prow) * 4; float s = 0.f;
#pragma unroll
            for (int t = 0; t < 4; ++t) s += __hip_atomic_load(sl + t, __ATOMIC_RELAXED, __HIP_MEMORY_SCOPE_AGENT);
            S[prow] = rstd_of(s); }
        __syncthreads();
        f32x4 gg[2][2];
#pragma unroll
        for (int bj = 0; bj < 2; ++bj) { gg[bj][0] = *(const f32x4*)(gn + col0 + bj * HALF); gg[bj][1] = *(const f32x4*)(gn + col0 + bj * HALF + 4); }
#pragma unroll
        for (int ai = 0; ai < 2; ++ai)
#pragma unroll
            for (int m = 0; m < 4; ++m) { const int r = ai * HALF + wr * 64 + m * 16 + fr; const float rs = S[r]; const size_t p0 = (size_t)(u.pm * BM + r) * DM + col0;
#pragma unroll
                for (int bj = 0; bj < 2; ++bj) { *(f32x4*)(out + p0 + bj * HALF) = acc[ai][bj][m][0] * rs * gg[bj][0]; *(f32x4*)(out + p0 + bj * HALF + 4) = acc[ai][bj][m][1] * rs * gg[bj][1]; } }
    }
};
}
namespace att {
__device__ __forceinline__ int crow(int r, int hi) { return (r & 3) + 8 * (r >> 2) + 4 * hi; }
#define SBAR() __builtin_amdgcn_sched_barrier(0)
constexpr float NEG = -INFINITY;
constexpr int L_SLOT = 0;
constexpr int L_VR = 24576;
constexpr int L_WSF = 49152;
constexpr int L_OST = L_WSF + 2048;
constexpr int L_TBL = L_OST + 32768;
constexpr int L_CB = L_TBL + 4096;
constexpr int L_PS = L_CB + 8192;
constexpr int L_IMP = L_PS + 4 * 64 * 33 * 4;
constexpr int L_MISC = L_IMP + 64 * 33 * 4;
constexpr int L_END = L_MISC + 64 + 256 + 64;
static_assert(L_END <= 147456 - 256, "attention LDS map");

__device__ __forceinline__ void qkt(f32x16& p0, f32x16& p1, const LAS unsigned char* Kslot, const bf16x8 (&qr)[4], int r32, int hi) {
    const LAS unsigned char* kb = Kslot + hi * 1024 + r32 * 16;
    p0 = f32x16{}; p1 = f32x16{};
#pragma unroll
    for (int d0 = 0; d0 < 4; ++d0) {
        const bf16x8 b0 = *(const LAS bf16x8*)(kb + d0 * 2048);
        const bf16x8 b1 = *(const LAS bf16x8*)(kb + d0 * 2048 + 512);
        p0 = __builtin_amdgcn_mfma_f32_32x32x16_bf16(b0, qr[d0], p0, 0, 0, 0);
        p1 = __builtin_amdgcn_mfma_f32_32x32x16_bf16(b1, qr[d0], p1, 0, 0, 0);
    }
}
__device__ __forceinline__ void pv(f32x16 (&o)[2], int vb, bf16x8 pa0, bf16x8 pa1, bf16x8 pa2, bf16x8 pa3) {
#pragma unroll
    for (int d0 = 0; d0 < 2; ++d0) { s16x4 lo[4], hi[4];
#pragma unroll
        for (int ks = 0; ks < 4; ++ks) {
            asm volatile("ds_read_b64_tr_b16 %0,%1 offset:%c2" : "=&v"(lo[ks]) : "v"(vb), "i"(d0 * 4096 + ks * 1024) : "memory");
            asm volatile("ds_read_b64_tr_b16 %0,%1 offset:%c2" : "=&v"(hi[ks]) : "v"(vb), "i"(d0 * 4096 + ks * 1024 + 512) : "memory"); }
        asm volatile("s_waitcnt lgkmcnt(0)" ::: "memory"); SBAR();
#define PK(k) (bf16x8){lo[k][0], lo[k][1], lo[k][2], lo[k][3], hi[k][0], hi[k][1], hi[k][2], hi[k][3]}
        o[d0] = __builtin_amdgcn_mfma_f32_32x32x16_bf16(pa0, PK(0), o[d0], 0, 0, 0);
        o[d0] = __builtin_amdgcn_mfma_f32_32x32x16_bf16(pa1, PK(1), o[d0], 0, 0, 0);
        o[d0] = __builtin_amdgcn_mfma_f32_32x32x16_bf16(pa2, PK(2), o[d0], 0, 0, 0);
        o[d0] = __builtin_amdgcn_mfma_f32_32x32x16_bf16(pa3, PK(3), o[d0], 0, 0, 0);
#undef PK
    }
}
__device__ __forceinline__ float rowmax32(const f32x16& p0, const f32x16& p1) {
    float a = fmaxf(p0[0], p1[0]);
#pragma unroll
    for (int r = 1; r < 16; ++r) a = fmaxf(a, fmaxf(p0[r], p1[r]));
    auto rr = __builtin_amdgcn_permlane32_swap(__float_as_uint(a), __float_as_uint(a), false, false);
    return fmaxf(__uint_as_float(rr[0]), __uint_as_float(rr[1]));
}
__device__ __forceinline__ float halfsum(float v) {
    auto rr = __builtin_amdgcn_permlane32_swap(__float_as_uint(v), __float_as_uint(v), false, false);
    return __uint_as_float(rr[0]) + __uint_as_float(rr[1]);
}
#define PKW(P, B) cvtpk(P[B], P[B + 1])
__device__ __forceinline__ void pack_p(const f32x16& p0, const f32x16& p1, bf16x8& a0, bf16x8& a1, bf16x8& a2, bf16x8& a3) {
    const u32x4 w0 = {PKW(p0, 0), PKW(p0, 2), PKW(p0, 4), PKW(p0, 6)}, w1 = {PKW(p0, 8), PKW(p0, 10), PKW(p0, 12), PKW(p0, 14)};
    const u32x4 w2 = {PKW(p1, 0), PKW(p1, 2), PKW(p1, 4), PKW(p1, 6)}, w3 = {PKW(p1, 8), PKW(p1, 10), PKW(p1, 12), PKW(p1, 14)};
    a0 = __builtin_bit_cast(bf16x8, w0); a1 = __builtin_bit_cast(bf16x8, w1); a2 = __builtin_bit_cast(bf16x8, w2); a3 = __builtin_bit_cast(bf16x8, w3);
}
#undef PKW
__device__ __forceinline__ void scale_rows(f32x16 (&o)[2], LAS float* wsf, float v, int r32, int hi) {
    if (hi == 0) wsf[r32] = v;
    asm volatile("s_waitcnt lgkmcnt(0)" ::: "memory");
#pragma unroll
    for (int i = 0; i < 4; ++i) { const f32x4 f = *(const LAS f32x4*)(wsf + 8 * i + 4 * hi);
#pragma unroll
        for (int j = 0; j < 4; ++j) { o[0][4 * i + j] *= f[j]; o[1][4 * i + j] *= f[j]; } }
    asm volatile("s_waitcnt lgkmcnt(0)" ::: "memory");
}
struct StageGeo { int krow, kcol, koff, vrow, vcol, voff; };
__device__ __forceinline__ StageGeo stage_geo(int tid) {
    StageGeo s; const int w = tid >> 6, ln = tid & 63;
    s.krow = ln; s.kcol = w * 8; s.koff = w * 1024 + ln * 16;
    s.vrow = 16 * (w & 3) + (ln >> 2); s.vcol = (w >> 2) * 32 + (ln & 3) * 8; s.voff = 8192 + w * 1024 + ln * 16;
    return s;
}
template <class Mod>
__device__ __forceinline__ void tile_step(const LAS unsigned char* slot, const bf16x8 (&qr)[4], f32x16 (&o)[2], float& m, float& l, LAS float* wsf, const Mod& mod, int r32, int hi, int vb) {
    f32x16 p0, p1;
    qkt(p0, p1, slot, qr, r32, hi);
    mod(p0, p1);
    const float rm = rowmax32(p0, p1);
    const float mn = fmaxf(m, rm);
    const float alpha = fexp2(m - mn);
    const bool need = __any(mn > m);
    m = mn;
    float s = 0.f;
#pragma unroll
    for (int r = 0; r < 16; ++r) { p0[r] = fexp2(p0[r] - mn); p1[r] = fexp2(p1[r] - mn); s += p0[r] + p1[r]; }
    l = l * alpha + s;
    if (need) scale_rows(o, wsf, alpha, r32, hi);
    bf16x8 a0, a1, a2, a3; pack_p(p0, p1, a0, a1, a2, a3);
    pv(o, vb, a0, a1, a2, a3);
}
template <class ModF>
__device__ __forceinline__ void attn_loop(unsigned tmask, const bf16_t* Kg, int pitchK, const bf16_t* Vg, int pitchV, LAS unsigned char* lds, const bf16x8 (&qr)[4],
                                          f32x16 (&o)[2], float& m, float& l, const ModF& modf, int wave_last_row) {
    const int tid = fresh_tid(), lane = tid & 63, r32 = lane & 31, hi = lane >> 5, wid = tid >> 6;
    const StageGeo sg = stage_geo(tid);
    LAS float* wsf = (LAS float*)(lds + L_WSF) + wid * 64;
    const int vb0 = (int)(unsigned)(size_t)(lds + L_SLOT + 8192) + ((lane >> 4) & 1) * 32 + (lane & 3) * 8 + (4 * hi + ((lane & 15) >> 2)) * 64;
    int kt = 31 - __clz((int)tmask);
    u32x4 kreg = *(const u32x4*)(Kg + (size_t)(kt * 64 + sg.krow) * pitchK + sg.kcol);
    u32x4 vreg = *(const u32x4*)(Vg + (size_t)(kt * 64 + sg.vrow) * pitchV + sg.vcol);
    *(LAS u32x4*)(lds + L_SLOT + sg.koff) = kreg; *(LAS u32x4*)(lds + L_SLOT + sg.voff) = vreg;
    __syncthreads();
    int s = 0;
    for (;;) {
        tmask &= ~(1u << kt);
        const int nk = tmask ? 31 - __clz((int)tmask) : -1;
        if (nk >= 0) { kreg = *(const u32x4*)(Kg + (size_t)(nk * 64 + sg.krow) * pitchK + sg.kcol); vreg = *(const u32x4*)(Vg + (size_t)(nk * 64 + sg.vrow) * pitchV + sg.vcol); }
        if (kt * 64 <= wave_last_row) tile_step(lds + L_SLOT + s * 16384, qr, o, m, l, wsf, modf(kt), r32, hi, vb0 + s * 16384);
        if (nk >= 0) { *(LAS u32x4*)(lds + L_SLOT + (s ^ 1) * 16384 + sg.koff) = kreg; *(LAS u32x4*)(lds + L_SLOT + (s ^ 1) * 16384 + sg.voff) = vreg; }
        __syncthreads();
        if (nk < 0) break;
        kt = nk; s ^= 1;
    }
}
template <bool ADD>
__device__ __forceinline__ void store_o(const f32x16 (&o)[2], LAS unsigned char* lds, bf16_t* dst, int pitch, const bf16_t* addsrc, int addpitch) {
    const int tid = fresh_tid(), lane = tid & 63, r32 = lane & 31, hi = lane >> 5, wid = tid >> 6;
    LAS bf16_t* stg = (LAS bf16_t*)(lds + L_OST) + wid * 2048;
#pragma unroll
    for (int r = 0; r < 16; ++r) { const int orow = crow(r, hi);
#pragma unroll
        for (int d0 = 0; d0 < 2; ++d0) stg[orow * 64 + d0 * 32 + r32] = (bf16_t)(cvtpk(o[d0][r], 0.f) & 0xffffu); }
    asm volatile("s_waitcnt lgkmcnt(0)" ::: "memory");
#pragma unroll
    for (int i = 0; i < 4; ++i) { const int row = i * 8 + (lane >> 3), ch = lane & 7;
        u32x4 v = *(const LAS u32x4*)(stg + row * 64 + ch * 8);
        if (ADD) { const u32x4 a = *(const u32x4*)(addsrc + (size_t)row * addpitch + ch * 8);
            v.x = cvtpk(bflo(v.x) + bflo(a.x), bfhi(v.x) + bfhi(a.x)); v.y = cvtpk(bflo(v.y) + bflo(a.y), bfhi(v.y) + bfhi(a.y));
            v.z = cvtpk(bflo(v.z) + bflo(a.z), bfhi(v.z) + bfhi(a.z)); v.w = cvtpk(bflo(v.w) + bflo(a.w), bfhi(v.w) + bfhi(a.w)); }
        *(u32x4*)(dst + (size_t)row * pitch + ch * 8) = v; }
    asm volatile("s_waitcnt lgkmcnt(0)" ::: "memory");
}
__device__ __forceinline__ void load_q(bf16x8 (&qr)[4], const bf16_t* Qw, int pitch, int r32, int hi) {
#pragma unroll
    for (int d0 = 0; d0 < 4; ++d0) qr[d0] = *(const bf16x8*)(Qw + (size_t)r32 * pitch + d0 * 16 + hi * 8);
}

struct ModFox { const LAS float* cb; int kbase, qpos, hi; bool diag;
    __device__ __forceinline__ void operator()(f32x16& p0, f32x16& p1) const {
#pragma unroll
        for (int i = 0; i < 4; ++i) { const f32x4 c0 = *(const LAS f32x4*)(cb + kbase + 8 * i + 4 * hi), c1 = *(const LAS f32x4*)(cb + kbase + 32 + 8 * i + 4 * hi);
#pragma unroll
            for (int j = 0; j < 4; ++j) { p0[4 * i + j] += c0[j]; p1[4 * i + j] += c1[j]; } }
        if (diag) {
#pragma unroll
            for (int r = 0; r < 16; ++r) { const int kv = kbase + crow(r, hi); if (kv > qpos) p0[r] = NEG; if (kv + 32 > qpos) p1[r] = NEG; } }
    } };
struct ModFoxF { const LAS float* cb; int qpos, hi, q0w;
    __device__ __forceinline__ ModFox operator()(int kt) const { return ModFox{cb, kt * 64, qpos, hi, kt * 64 + 63 > q0w}; } };
struct ModT5 { const LAS float* tb; int kbase, qpos, hi, window; bool enabled;
    __device__ __forceinline__ void operator()(f32x16& p0, f32x16& p1) const {
#pragma unroll
        for (int r = 0; r < 16; ++r) { const int d0 = qpos - (kbase + crow(r, hi)), d1 = d0 - 32;
            const float b0 = tb[min(max(d0, 0), 127)], b1 = tb[min(max(d1, 0), 127)];
            p0[r] = (enabled && d0 >= 0 && d0 < window) ? p0[r] + b0 : NEG;
            p1[r] = (enabled && d1 >= 0 && d1 < window) ? p1[r] + b1 : NEG; }
    } };
struct ModWinF { const LAS float* tb; int qpos, hi;
    __device__ __forceinline__ ModT5 operator()(int kt) const { return ModT5{tb, kt * 64, qpos, hi, 512, true}; } };
struct ModSelF { const LAS float* tb; int qpos, hi; unsigned mask;
    __device__ __forceinline__ ModT5 operator()(int kt) const { return ModT5{tb, kt * 64, qpos, hi, 1 << 30, ((mask >> kt) & 1u) != 0u}; } };

typedef short v4i16_t __attribute__((ext_vector_type(4)));
__device__ __forceinline__ s16x4 vtr(const LAS unsigned char* p) { return __builtin_bit_cast(s16x4, __builtin_amdgcn_ds_read_tr16_b64_v4i16((LAS v4i16_t*)p)); }
__device__ __forceinline__ void qkt_c(f32x16& p0, f32x16& p1, const LAS unsigned char* Kslot, const bf16x8 (&qr)[4], const f32x16& c0, const f32x16& c1, int r32, int hi) {
    const LAS unsigned char* kb = Kslot + hi * 1024 + r32 * 16;
    { const bf16x8 b0 = *(const LAS bf16x8*)(kb); const bf16x8 b1 = *(const LAS bf16x8*)(kb + 512);
      p0 = __builtin_amdgcn_mfma_f32_32x32x16_bf16(b0, qr[0], c0, 0, 0, 0); p1 = __builtin_amdgcn_mfma_f32_32x32x16_bf16(b1, qr[0], c1, 0, 0, 0); }
#pragma unroll
    for (int d0 = 1; d0 < 4; ++d0) {
        const bf16x8 b0 = *(const LAS bf16x8*)(kb + d0 * 2048); const bf16x8 b1 = *(const LAS bf16x8*)(kb + d0 * 2048 + 512);
        p0 = __builtin_amdgcn_mfma_f32_32x32x16_bf16(b0, qr[d0], p0, 0, 0, 0); p1 = __builtin_amdgcn_mfma_f32_32x32x16_bf16(b1, qr[d0], p1, 0, 0, 0); }
}
__device__ __forceinline__ void pv2(f32x16 (&o)[2], const LAS unsigned char* vp, bf16x8 pa0, bf16x8 pa1, bf16x8 pa2, bf16x8 pa3) {
    s16x4 lo[2][4], hi[2][4];
#pragma unroll
    for (int ks = 0; ks < 4; ++ks)
#pragma unroll
        for (int d0 = 0; d0 < 2; ++d0) { lo[d0][ks] = vtr(vp + d0 * 4096 + ks * 1024); hi[d0][ks] = vtr(vp + d0 * 4096 + ks * 1024 + 512); }
#define PK(d, k) (bf16x8){lo[d][k][0], lo[d][k][1], lo[d][k][2], lo[d][k][3], hi[d][k][0], hi[d][k][1], hi[d][k][2], hi[d][k][3]}
    o[0] = __builtin_amdgcn_mfma_f32_32x32x16_bf16(pa0, PK(0, 0), o[0], 0, 0, 0); o[1] = __builtin_amdgcn_mfma_f32_32x32x16_bf16(pa0, PK(1, 0), o[1], 0, 0, 0);
    o[0] = __builtin_amdgcn_mfma_f32_32x32x16_bf16(pa1, PK(0, 1), o[0], 0, 0, 0); o[1] = __builtin_amdgcn_mfma_f32_32x32x16_bf16(pa1, PK(1, 1), o[1], 0, 0, 0);
    o[0] = __builtin_amdgcn_mfma_f32_32x32x16_bf16(pa2, PK(0, 2), o[0], 0, 0, 0); o[1] = __builtin_amdgcn_mfma_f32_32x32x16_bf16(pa2, PK(1, 2), o[1], 0, 0, 0);
    o[0] = __builtin_amdgcn_mfma_f32_32x32x16_bf16(pa3, PK(0, 3), o[0], 0, 0, 0); o[1] = __builtin_amdgcn_mfma_f32_32x32x16_bf16(pa3, PK(1, 3), o[1], 0, 0, 0);
#undef PK
}
__device__ __forceinline__ float rowmax32b(const f32x16& p0, const f32x16& p1) {
    float a = __builtin_fmaxf(__builtin_fmaxf(p0[0], p0[1]), p1[0]), b = __builtin_fmaxf(__builtin_fmaxf(p0[2], p0[3]), p1[1]); a = __builtin_fmaxf(__builtin_fmaxf(a, p1[2]), p1[3]);
#pragma unroll
    for (int r = 4; r < 16; r += 4) { a = __builtin_fmaxf(__builtin_fmaxf(a, p0[r]), p0[r + 1]); b = __builtin_fmaxf(__builtin_fmaxf(b, p0[r + 2]), p0[r + 3]);
        a = __builtin_fmaxf(__builtin_fmaxf(a, p1[r]), p1[r + 1]); b = __builtin_fmaxf(__builtin_fmaxf(b, p1[r + 2]), p1[r + 3]); }
    const float m = __builtin_fmaxf(a, b);
    auto rr = __builtin_amdgcn_permlane32_swap(__float_as_uint(m), __float_as_uint(m), false, false);
    return __builtin_fmaxf(__uint_as_float(rr[0]), __uint_as_float(rr[1]));
}
constexpr float DEFER_THR = 6.0f;
#ifndef ATT_GRP
#define ATT_GRP(w) ((w) >> 2)
#endif
template <int ABL, class TF>
__device__ __forceinline__ void sm_pv(f32x16& sc0, f32x16& sc1, f32x16& sn0, f32x16& sn1, bool adjust_next, int kt, int par, bool& first, float& mref, float& l, f32x16 (&o)[2],
                                      LAS float* wsf, const LAS unsigned char* vp0, const TF& tf, int r32, int hi) {
    if (ABL & 16) { o[0][1] += sc0[3] + sc1[5]; return; }
    tf.post(kt, sc0, sc1);
    const float rm = rowmax32b(sc0, sc1);
    if (__any(first || rm > DEFER_THR)) {
        const float delta = first ? (rm == NEG ? 0.f : rm) : __builtin_fmaxf(rm, 0.f);
        mref += delta;
#pragma unroll
        for (int r = 0; r < 16; ++r) { sc0[r] -= delta; sc1[r] -= delta; }
        if (adjust_next) {
#pragma unroll
            for (int r = 0; r < 16; ++r) { sn0[r] -= delta; sn1[r] -= delta; } }
        const float f = fexp2(-delta); l *= f;
        if (!first) scale_rows(o, wsf, f, r32, hi);
        first = false;
    }
    float s = 0.f;
#pragma unroll
    for (int r = 0; r < 16; ++r) { if (!(ABL & 1)) { sc0[r] = fexp2(sc0[r]); sc1[r] = fexp2(sc1[r]); } s += sc0[r] + sc1[r]; }
    l += s;
    bf16x8 a0, a1, a2, a3; pack_p(sc0, sc1, a0, a1, a2, a3);
    if (!(ABL & 2)) pv2(o, vp0 + par * 8192, a0, a1, a2, a3); else { o[0][0] += __builtin_bit_cast(f32x4, a0)[0] + __builtin_bit_cast(f32x4, a3)[3]; }
}
__device__ __forceinline__ void qk_exp(f32x16& n0, f32x16& n1, f32x16& s0, f32x16& s1, const f32x16& c0, const f32x16& c1, const LAS unsigned char* Kslot, const bf16x8 (&qr)[4],
                                       float& l, bf16x8& a0, bf16x8& a1, bf16x8& a2, bf16x8& a3, int r32, int hi) {
    const LAS unsigned char* kb = Kslot + hi * 1024 + r32 * 16;
    bf16x8 kf[8];
#pragma unroll
    for (int d0 = 0; d0 < 4; ++d0) { kf[2 * d0] = *(const LAS bf16x8*)(kb + d0 * 2048); kf[2 * d0 + 1] = *(const LAS bf16x8*)(kb + d0 * 2048 + 512); }
    float s = 0.f; unsigned w[16];
#define QE_GAP(i, X, B) do { X[B] = fexp2(X[B]); X[B + 1] = fexp2(X[B + 1]); X[B + 2] = fexp2(X[B + 2]); X[B + 3] = fexp2(X[B + 3]); s += (X[B] + X[B + 1]) + (X[B + 2] + X[B + 3]); \
        w[2 * (i)] = cvtpk(X[B], X[B + 1]); w[2 * (i) + 1] = cvtpk(X[B + 2], X[B + 3]); SBAR(); } while (0)
    SBAR();
    n0 = __builtin_amdgcn_mfma_f32_32x32x16_bf16(kf[0], qr[0], c0, 0, 0, 0); QE_GAP(0, s0, 0);
    n1 = __builtin_amdgcn_mfma_f32_32x32x16_bf16(kf[1], qr[0], c1, 0, 0, 0); QE_GAP(1, s0, 4);
    n0 = __builtin_amdgcn_mfma_f32_32x32x16_bf16(kf[2], qr[1], n0, 0, 0, 0); QE_GAP(2, s0, 8);
    n1 = __builtin_amdgcn_mfma_f32_32x32x16_bf16(kf[3], qr[1], n1, 0, 0, 0); QE_GAP(3, s0, 12);
    n0 = __builtin_amdgcn_mfma_f32_32x32x16_bf16(kf[4], qr[2], n0, 0, 0, 0); QE_GAP(4, s1, 0);
    n1 = __builtin_amdgcn_mfma_f32_32x32x16_bf16(kf[5], qr[2], n1, 0, 0, 0); QE_GAP(5, s1, 4);
    n0 = __builtin_amdgcn_mfma_f32_32x32x16_bf16(kf[6], qr[3], n0, 0, 0, 0); QE_GAP(6, s1, 8);
    n1 = __builtin_amdgcn_mfma_f32_32x32x16_bf16(kf[7], qr[3], n1, 0, 0, 0); QE_GAP(7, s1, 12);
#undef QE_GAP
    l += s;
    const u32x4 w0 = {w[0], w[1], w[2], w[3]}, w1 = {w[4], w[5], w[6], w[7]}, w2 = {w[8], w[9], w[10], w[11]}, w3 = {w[12], w[13], w[14], w[15]};
    a0 = __builtin_bit_cast(bf16x8, w0); a1 = __builtin_bit_cast(bf16x8, w1); a2 = __builtin_bit_cast(bf16x8, w2); a3 = __builtin_bit_cast(bf16x8, w3);
}
__device__ __forceinline__ void glds16(const void* gsrc, unsigned lds_dst) { unsigned keep;
    asm volatile("s_mov_b32 %0, m0\n\ts_mov_b32 m0, %2\n\ts_nop 0\n\tglobal_load_lds_dwordx4 %1, off\n\ts_mov_b32 m0, %0" : "=&s"(keep) : "v"(gsrc), "s"(lds_dst) : "memory"); }
#define ATT_WAIT_BAR(N) asm volatile("s_waitcnt vmcnt(" #N ") lgkmcnt(0)\n\ts_barrier" ::: "memory")
template <int ABL = 0, class TF>
__device__ __forceinline__ void attn_loop2(unsigned tmask, const bf16_t* Kg, int pitchK, const bf16_t* Vg, int pitchV, LAS unsigned char* lds, const bf16x8 (&qr)[4],
                                           f32x16 (&o)[2], float& mref, float& l, const TF& tf, int wave_last_row) {
    const int tid = fresh_tid(), lane = tid & 63, r32 = lane & 31, hi = lane >> 5, wid = __builtin_amdgcn_readfirstlane(tid >> 6), grp = ATT_GRP(wid);
    LAS float* wsf = (LAS float*)(lds + L_WSF) + wid * 64;
    const LAS unsigned char* vp0 = lds + L_SLOT + L_VR + ((lane >> 4) & 1) * 32 + (lane & 3) * 8 + (4 * hi + ((lane & 15) >> 2)) * 64;
    const bf16_t* ksrc = Kg + (size_t)lane * pitchK + wid * 8;
    const bf16_t* vsrc = Vg + (size_t)(16 * (wid & 3) + (lane >> 2)) * pitchV + (wid >> 2) * 32 + (lane & 3) * 8;
    const unsigned ldsb = (unsigned)(size_t)(lds + L_SLOT) + (unsigned)wid * 1024u;
#define DMA_K(t, slot) glds16(ksrc + (size_t)(t) * 64 * pitchK, (unsigned)__builtin_amdgcn_readfirstlane(ldsb + (unsigned)(slot) * 8192u))
#define DMA_V(t, slot) glds16(vsrc + (size_t)(t) * 64 * pitchV, (unsigned)__builtin_amdgcn_readfirstlane(ldsb + (unsigned)L_VR + (unsigned)(slot) * 8192u))
#define NEXT_TILE(dst) do { if (tmask) { dst = 31 - __clz((int)tmask); tmask &= ~(1u << dst); } else dst = -1; } while (0)
    int t0, t1, t2, t3;
    NEXT_TILE(t0); NEXT_TILE(t1); NEXT_TILE(t2);
    const int tz = t0;
    DMA_K(t0, 0); DMA_V(t0, 0); DMA_K(t1 < 0 ? tz : t1, 1); DMA_V(t1 < 0 ? tz : t1, 1); DMA_K(t2 < 0 ? tz : t2, 2);
    ATT_WAIT_BAR(2);
    f32x16 sa0, sa1, sb0, sb1, cfar;
    bool first = true, seen = false;
    mref = 0.f; l = 0.f;
    const float fbias = tf.farbias();
#pragma unroll
    for (int r = 0; r < 16; ++r) cfar[r] = fbias;
    { f32x16 c0, c1; tf.cinit(t0, 0.f, c0, c1); qkt_c(sa0, sa1, lds + L_SLOT, qr, c0, c1, r32, hi); }
    asm volatile("s_waitcnt lgkmcnt(0)\n\ts_barrier" ::: "memory");
    int s0 = 0, s1 = 1, s2 = 2;
#define ATT_STEP(SC0, SC1, SN0, SN1) do { \
        NEXT_TILE(t3); \
        DMA_K((ABL & 128) || t3 < 0 ? tz : t3, s0); DMA_V((ABL & 128) || t2 < 0 ? tz : t2, s2); \
        const int t1c = t1 < 0 ? tz : t1; \
        tf.post(t0, SC0, SC1); \
        { const float rm = rowmax32b(SC0, SC1); \
          if (__any(first || rm > DEFER_THR || (!seen && rm != NEG))) { \
            const float delta = !seen ? (rm == NEG ? 0.f : rm) : __builtin_fmaxf(rm, 0.f);     \
            seen = seen || (rm != NEG); \
            mref += delta; \
            _Pragma("unroll") for (int r = 0; r < 16; ++r) { SC0[r] -= delta; SC1[r] -= delta; } \
            const float f = fexp2(-delta); l *= f; \
            if (!first) scale_rows(o, wsf, f, r32, hi); \
            _Pragma("unroll") for (int r = 0; r < 16; ++r) cfar[r] = fbias - mref; \
            first = false; } } \
        { bf16x8 a0, a1, a2, a3; \
          if (tf.far(t1c)) qk_exp(SN0, SN1, SC0, SC1, cfar, cfar, lds + L_SLOT + s1 * 8192, qr, l, a0, a1, a2, a3, r32, hi); \
          else { f32x16 c0, c1; tf.cinit(t1c, mref, c0, c1); qk_exp(SN0, SN1, SC0, SC1, c0, c1, lds + L_SLOT + s1 * 8192, qr, l, a0, a1, a2, a3, r32, hi); } \
          pv2(o, vp0 + s0 * 8192, a0, a1, a2, a3); } \
        ATT_WAIT_BAR(2); \
        t0 = t1; t1 = t2; t2 = t3; { const int s_ = s0; s0 = s1; s1 = s2; s2 = s_; } \
    } while (0)
    for (;;) {
        ATT_STEP(sa0, sa1, sb0, sb1); if (t0 < 0) break;
        ATT_STEP(sb0, sb1, sa0, sa1); if (t0 < 0) break;
    }
    asm volatile("s_waitcnt vmcnt(0)" ::: "memory");
    __syncthreads();
#undef ATT_STEP
#undef NEXT_TILE
#undef DMA_K
#undef DMA_V
}
struct TfFox { const LAS float* cb; int qpos, hi, q0w;
    __device__ __forceinline__ bool far(int) const { return false; }
    __device__ __forceinline__ float farbias() const { return 0.f; }
    __device__ __forceinline__ void cinit(int kt, float mref, f32x16& c0, f32x16& c1) const {
#pragma unroll
        for (int i = 0; i < 4; ++i) { const f32x4 a = *(const LAS f32x4*)(cb + kt * 64 + 8 * i + 4 * hi), b = *(const LAS f32x4*)(cb + kt * 64 + 32 + 8 * i + 4 * hi);
#pragma unroll
            for (int j = 0; j < 4; ++j) { c0[4 * i + j] = a[j] - mref; c1[4 * i + j] = b[j] - mref; } } }
    __device__ __forceinline__ void post(int kt, f32x16& p0, f32x16& p1) const {
        if (kt * 64 + 63 > q0w) {
#pragma unroll
            for (int r = 0; r < 16; ++r) { const int kv = kt * 64 + crow(r, hi); if (kv > qpos) p0[r] = NEG; if (kv + 32 > qpos) p1[r] = NEG; } } } };
struct TfT5 { const LAS float* tb; int qpos, hi, q0w, window; unsigned mask; bool use_mask;
    __device__ __forceinline__ bool far(int kt) const { return q0w - (kt * 64 + 63) >= 113; }
    __device__ __forceinline__ float farbias() const { return tb[127]; }
    __device__ __forceinline__ void cinit(int kt, float mref, f32x16& c0, f32x16& c1) const {
        if (q0w - (kt * 64 + 63) >= 113) { const float c = tb[127] - mref;
#pragma unroll
            for (int r = 0; r < 16; ++r) { c0[r] = c; c1[r] = c; } }
        else {
#pragma unroll
            for (int r = 0; r < 16; ++r) { const int d0 = qpos - kt * 64 - crow(r, hi); c0[r] = tb[min(max(d0, 0), 127)] - mref; c1[r] = tb[min(max(d0 - 32, 0), 127)] - mref; } } }
    __device__ __forceinline__ void post(int kt, f32x16& p0, f32x16& p1) const {
        if (q0w - (kt * 64 + 63) < 0 || q0w + 31 - kt * 64 >= window) {
#pragma unroll
            for (int r = 0; r < 16; ++r) { const int d0 = qpos - kt * 64 - crow(r, hi), d1 = d0 - 32; if (d0 < 0 || d0 >= window) p0[r] = NEG; if (d1 < 0 || d1 >= window) p1[r] = NEG; } }
        if (use_mask) { const bool en = ((mask >> kt) & 1u) != 0u;
            if (!__all(en)) {
#pragma unroll
                for (int r = 0; r < 16; ++r) { p0[r] = en ? p0[r] : NEG; p1[r] = en ? p1[r] : NEG; } } } } };
}
#ifndef STAGE_LIMIT
#define STAGE_LIMIT 4
#endif
constexpr size_t MiB = 1u << 20;
constexpr size_t WS_CTL = 0, CTL_ZERO_BYTES = 64 * 1024;
constexpr size_t WS_SS = 256 * 1024;
constexpr size_t WS_SSM = 640 * 1024;
constexpr size_t WS_F32S = 2 * MiB;
constexpr size_t WS_CUM = 4 * MiB;
constexpr size_t WS_MASK = 4 * MiB + 512 * 1024;
constexpr size_t WS_UMASK = WS_MASK + 128 * 1024;
constexpr size_t WS_KC = 5 * MiB, WS_VC = 5 * MiB + 256 * 1024;
constexpr size_t WS_KMAX = 5 * MiB + 512 * 1024;
constexpr size_t WS_POSC = 32 * 1024;
constexpr size_t WS_WGU1 = 8 * MiB, WS_WD1 = 19 * MiB, WS_WIN = 25 * MiB, WS_WUPN = 35 * MiB, WS_WUPF = 36 * MiB, WS_WOUT = 37 * MiB, WS_WMQ = 39 * MiB,
                 WS_WMKV = 41 * MiB, WS_WMO = 45 * MiB, WS_WGU2 = 47 * MiB, WS_WD2 = 58 * MiB, WS_CW1K = 64 * MiB, WS_CW1V = 65 * MiB, WS_CW2K = 66 * MiB, WS_CW2V = 66 * MiB + 256 * 1024;
constexpr size_t WS_KVM = 8 * MiB;
constexpr size_t WS_XB = 68 * MiB;
constexpr size_t WS_QN = 100 * MiB, WS_KVN = 116 * MiB, WS_QF = 140 * MiB, WS_KVF = 156 * MiB, WS_GAB = 188 * MiB;
constexpr size_t WS_H = 100 * MiB;
constexpr size_t WS_Y = WS_KVF;
constexpr size_t WS_MT = 188 * MiB, WS_NT = 204 * MiB, WS_PM = 220 * MiB;
constexpr size_t WS_MEMB = 252 * MiB, WS_END = 256 * MiB;
static_assert(WS_WD2 + (size_t)DM * FF * 2 <= WS_CW1K && WS_GAB + (size_t)M * 2048 * 2 <= WS_MEMB && WS_H + (size_t)M * FF * 2 <= WS_GAB, "ws map");
constexpr int CW_BAR = 4096;
constexpr size_t WS_XBUF = 1 * MiB;
constexpr size_t WS_FINCNT = 40 * 1024;
constexpr int RING_BYTES = 131072, LDS_BYTES = 147456;

__device__ const unsigned char T5B[128] = {0, 1, 2, 3, 4, 5, 6, 7, 8, 9, 10, 11, 12, 13, 14, 15, 16, 16, 16, 17, 17, 18, 18, 18, 19, 19, 19, 20, 20, 20, 20, 21, 21, 21, 21, 22, 22, 22, 22, 22, 23, 23, 23, 23, 23, 23, 24, 24, 24, 24, 24, 24, 25, 25, 25, 25, 25, 25, 25, 26, 26, 26, 26, 26, 26, 26, 26, 27, 27, 27, 27, 27, 27, 27, 27, 27, 27, 28, 28, 28, 28, 28, 28, 28, 28, 28, 28, 29, 29, 29, 29, 29, 29, 29, 29, 29, 29, 29, 29, 30, 30, 30, 30, 30, 30, 30, 30, 30, 30, 30, 30, 30, 30, 31, 31, 31, 31, 31, 31, 31, 31, 31, 31, 31, 31, 31, 31, 31};


#define XB_TMO      128
#define XB_XCNT(j)  (256  + 64 * (j))
#define XB_XSUB(j)  (1280 + 64 * (j))
#define XB_XGEN(j)  (2304 + 64 * (j))
#define XB_TOP      3328
#define XB_TOPGEN   3392
#define XCD_BAR_WORDS 3456
#define XB_SPIN_CAP (1u << 18)
__device__ __forceinline__ unsigned xb_ld(unsigned* p)              { return __hip_atomic_load(p, __ATOMIC_RELAXED, __HIP_MEMORY_SCOPE_AGENT); }
__device__ __forceinline__ unsigned xb_add(unsigned* p, unsigned v) { return __hip_atomic_fetch_add(p, v, __ATOMIC_RELAXED, __HIP_MEMORY_SCOPE_AGENT); }
__device__ __forceinline__ unsigned xb_xcc_id() { return (unsigned)__builtin_amdgcn_s_getreg((3 << 11) | 20) & 0xFu; }
#define XB_SPIN(cond, bar) do { unsigned _sp = 0; while (cond) { __builtin_amdgcn_s_sleep(1); \
    if ((++_sp & 255u) == 0u) { if (xb_ld(&(bar)[XB_TMO])) break; if (_sp > XB_SPIN_CAP) { atomicAdd(&(bar)[XB_TMO], 1u); break; } } } } while (0)
struct XcdBarrier { unsigned* bar; unsigned x; volatile LAS unsigned* st; };
__device__ __forceinline__ XcdBarrier xcd_barrier_post(unsigned* bar, volatile LAS unsigned* st) {
    XcdBarrier b; b.bar = bar; b.x = xb_xcc_id(); b.st = st;
    if (threadIdx.x == 0) (void)xb_add(&bar[XB_XCNT(b.x)], 1u);
    return b;
}
__device__ __forceinline__ void xcd_barrier_complete(unsigned* bar, unsigned x, unsigned& nloc, unsigned& nx) {
    const unsigned G = gridDim.x * gridDim.y * gridDim.z;
    unsigned sum, cnt, mine, sp = 0u;
    for (;;) {
        sum = 0u; cnt = 0u; mine = 0u;
#pragma unroll
        for (unsigned j = 0; j < 16; ++j) { const unsigned c = xb_ld(&bar[XB_XCNT(j)]); sum += c; cnt += (c > 0u) ? 1u : 0u; mine = (j == x) ? c : mine; }
        if (sum == G) break;
        __builtin_amdgcn_s_sleep(1);
        if ((++sp & 255u) == 0u) { if (xb_ld(&bar[XB_TMO])) break; if (sp > XB_SPIN_CAP) { atomicAdd(&bar[XB_TMO], 1u); break; } }
    }
    nloc = mine > 0u ? mine : 1u; nx = cnt > 0u ? cnt : 1u;
}
__device__ __forceinline__ void xcd_barrier(const XcdBarrier& b) {
    asm volatile("s_waitcnt vmcnt(0)" ::: "memory");
    __syncthreads();
    if (threadIdx.x == 0) {
        unsigned* bar = b.bar;
        __builtin_amdgcn_s_waitcnt(0);
        unsigned nloc = b.st[0], nx = b.st[1];
        if (nloc == 0u) { xcd_barrier_complete(bar, b.x, nloc, nx); b.st[0] = nloc; b.st[1] = nx; }
        const unsigned old = xb_add(&bar[XB_XSUB(b.x)], 1u);
        const unsigned gen = old / nloc;
        if (old + 1u == (gen + 1u) * nloc) {
            __builtin_amdgcn_fence(__ATOMIC_RELEASE, "agent");
            asm volatile("s_waitcnt vmcnt(0)" ::: "memory");
            const unsigned og = xb_add(&bar[XB_TOP], 1u);
            const unsigned tg = og / nx;
            if (og + 1u == (tg + 1u) * nx) xb_add(&bar[XB_TOPGEN], 1u);
            else XB_SPIN(xb_ld(&bar[XB_TOPGEN]) == tg, bar);
            __builtin_amdgcn_fence(__ATOMIC_ACQUIRE, "agent");
            xb_add(&bar[XB_XGEN(b.x)], 1u);
            asm volatile("s_waitcnt vmcnt(0)" ::: "memory");
        } else {
            XB_SPIN(xb_ld(&bar[XB_XGEN(b.x)]) == gen, bar);
            __builtin_amdgcn_fence(__ATOMIC_ACQUIRE, "agent");
            asm volatile("s_waitcnt vmcnt(0)" ::: "memory");
        }
    }
    __syncthreads();
}

struct Args { const float* in[29]; float* out; unsigned char* ws; int lo, hi; };
enum { I_X = 0, I_MEM, I_RELB, I_F1N, I_F1G, I_F1U, I_F1D, I_MIXN, I_WIN, I_BF, I_POSK, I_POSV, I_CK1, I_CK2, I_CV1, I_CV2, I_UPN, I_UPF, I_WOUT, I_MQN, I_MKVN, I_MWQ, I_MWKV, I_MWO, I_F2N, I_F2G, I_F2U, I_F2D, I_FINN };

__device__ __forceinline__ float wave_sum(float v) {
#pragma unroll
    for (int o = 1; o < 64; o <<= 1) v += __shfl_xor(v, o);
    return v;
}
struct ItemD { const float* wp; const float* gp; bf16_t* wt; int ldsrc, K, k0, dstrow0; float scl; bool zero; };
struct ItemR { f32x4 v[8]; float gk[8]; };
__device__ __forceinline__ void cm_plain(int n, int off, int& sc) { sc = n + off; }
__device__ __forceinline__ void cm_win(int n, int& sc, float& scl) {
    scl = 1.f;
    if (n < 512) { sc = n; scl = QS64; }
    else if (n < 1280) sc = n;
    else if (n < 1792) { sc = 1304 + (n - 1280); scl = QS64; }
    else if (n < 2816) sc = 1816 + (n - 1792);
    else if (n < 4864) sc = 2848 + (n - 2816);
    else if (n < 4888) sc = 1280 + (n - 4864);
    else if (n < 4896) sc = 2840 + (n - 4888);
    else sc = -1; }
constexpr int N_GU = 16 * 176, N_D = 44 * 32, N_WIN = 16 * 160, N_UP = 8 * 32, N_SQ = 16 * 32, N_MKV = 16 * 64, N_C1 = 32 * 8, N_C2 = 4 * 2;
constexpr int CONV_NA = N_GU + N_D + N_WIN + N_MKV + 2 * N_C1 + 2 * N_C2, CONV_NB = N_GU + N_D + 2 * N_UP + 3 * N_SQ;
__device__ __forceinline__ ItemD conv_decode(const Args& a, int it, int lane) {
    unsigned char* ws = a.ws; int r = it; ItemD d; const int c4 = lane & 7, kr = lane >> 3;
    const float* W; int ldsrc, K, kb, dr, off = 0; const float* gain = nullptr; bf16_t* wt; float scl = 1.f; bool win = false;
    const int f = r >= CONV_NA; if (f) r -= CONV_NA;
    if (r < N_GU) { kb = r / 176; const int gi = r % 176; dr = gi * 32; const int tile = dr >> 8, within = dr & 255;
        W = a.in[within < 128 ? (f ? I_F2G : I_F1G) : (f ? I_F2U : I_F1U)]; ldsrc = FF; K = DM; wt = (bf16_t*)(ws + (f ? WS_WGU2 : WS_WGU1)); gain = a.in[f ? I_F2N : I_F1N]; off = tile * 128 + (within & 127) - dr; }
    else if ((r -= N_GU) < N_D) { kb = r / 32; dr = (r % 32) * 32; W = a.in[f ? I_F2D : I_F1D]; ldsrc = DM; K = FF; wt = (bf16_t*)(ws + (f ? WS_WD2 : WS_WD1)); }
    else if (!f) { r -= N_D;
        if (r < N_WIN) { kb = r / 160; dr = (r % 160) * 32; W = a.in[I_WIN]; ldsrc = 4896; K = DM; wt = (bf16_t*)(ws + WS_WIN); gain = a.in[I_MIXN]; win = true; }
        else if ((r -= N_WIN) < N_MKV) { kb = r / 64; dr = (r % 64) * 32; W = a.in[I_MWKV]; ldsrc = 2048; K = DM; wt = (bf16_t*)(ws + WS_WMKV); gain = a.in[I_MKVN]; }
        else if ((r -= N_MKV) < 2 * N_C1) { const int g = r >= N_C1; r -= g * N_C1; kb = r / 8; dr = (r % 8) * 32; W = a.in[g ? I_CV1 : I_CK1]; ldsrc = 256; K = 2048; wt = (bf16_t*)(ws + (g ? WS_CW1V : WS_CW1K)); }
        else { r -= 2 * N_C1; const int g = r >= N_C2; r -= g * N_C2; kb = r / 2; dr = (r % 2) * 32; W = a.in[g ? I_CV2 : I_CK2]; ldsrc = 64; K = 256; wt = (bf16_t*)(ws + (g ? WS_CW2V : WS_CW2K)); }
    } else { r -= N_D;
        if (r < 2 * N_UP) { const int g = r >= N_UP; r -= g * N_UP; kb = r / 32; dr = (r % 32) * 32; W = a.in[g ? I_UPF : I_UPN]; ldsrc = DM; K = 512; wt = (bf16_t*)(ws + (g ? WS_WUPF : WS_WUPN)); }
        else { r -= 2 * N_UP; const int g = r / N_SQ; r -= g * N_SQ; kb = r / 32; dr = (r % 32) * 32; W = a.in[g == 0 ? I_WOUT : (g == 1 ? I_MWQ : I_MWO)]; ldsrc = DM; K = DM;
            wt = (bf16_t*)(ws + (g == 0 ? WS_WOUT : (g == 1 ? WS_WMQ : WS_WMO))); if (g == 1) { W = a.in[I_MWO]; wt = (bf16_t*)(ws + WS_WMO); } }
    }
    int sc; if (win) cm_win(dr + 4 * c4, sc, scl); else cm_plain(dr + 4 * c4, off, sc);
    d.zero = sc < 0; d.wp = W + (size_t)(kb * 64 + kr) * ldsrc + (sc < 0 ? 0 : sc); d.gp = gain ? gain + kb * 64 + kr : nullptr; d.wt = wt; d.ldsrc = ldsrc; d.K = K; d.k0 = kb * 64; d.dstrow0 = dr; d.scl = scl;
    return d;
}
__device__ __forceinline__ void conv_load(const ItemD& d, ItemR& r) {
#pragma unroll
    for (int i = 0; i < 8; ++i) { r.v[i] = d.zero ? (f32x4){0.f, 0.f, 0.f, 0.f} : *(const f32x4*)(d.wp + (size_t)(8 * i) * d.ldsrc); r.gk[i] = d.gp ? d.gp[8 * i] : 1.f; }
}
__device__ __forceinline__ void conv_finish(const ItemD& d, const ItemR& r, LAS float* scr, int lane) {
    const int kr = lane >> 3, c4 = lane & 7;
#pragma unroll
    for (int i = 0; i < 8; ++i) { const int kk = 8 * i + kr; const float s = r.gk[i] * d.scl; LAS float* p = scr + kk * 33 + 4 * c4; p[0] = r.v[i][0] * s; p[1] = r.v[i][1] * s; p[2] = r.v[i][2] * s; p[3] = r.v[i][3] * s; }
    asm volatile("s_waitcnt lgkmcnt(0)" ::: "memory");
    const int c = lane & 7;
#pragma unroll
    for (int j = 0; j < 4; ++j) { const int nn = (lane >> 3) + 8 * j; const LAS float* s = scr + (8 * c) * 33 + nn;
        u32x4 o; o.x = cvtpk(s[0 * 33], s[1 * 33]); o.y = cvtpk(s[2 * 33], s[3 * 33]); o.z = cvtpk(s[4 * 33], s[5 * 33]); o.w = cvtpk(s[6 * 33], s[7 * 33]);
        *(u32x4*)(d.wt + (size_t)(d.dstrow0 + nn) * d.K + d.k0 + 8 * c) = o; }
    asm volatile("s_waitcnt lgkmcnt(0)" ::: "memory");
}
__device__ __forceinline__ void conv_run(const Args& a, int it0, int itend, int stride, LAS float* scr, int lane) {
    if (it0 >= itend) return;
    ItemD d0 = conv_decode(a, it0, lane); ItemR r0; conv_load(d0, r0);
    for (int it = it0 + stride; ; it += stride) {
        const bool more = it < itend;
        ItemD d1; ItemR r1;
        if (more) { d1 = conv_decode(a, it, lane); conv_load(d1, r1); }
        conv_finish(d0, r0, scr, lane);
        if (!more) break;
        d0 = d1; r0 = r1;
    }
}

__device__ __forceinline__ void p0_prologue(const Args& a, LAS unsigned char* lds, int gw, int NGW, int wave, int lane) {
    unsigned char* ws = a.ws;
    LAS float* scr = (LAS float*)(lds + wave * 16384);
    conv_run(a, gw, N_GU, NGW, scr, lane);
    { f32x4* z = (f32x4*)(ws + WS_SS + (size_t)M * 4); for (int i = gw * 64 + lane; i < 3 * M / 4; i += NGW * 64) z[i] = (f32x4){0.f, 0.f, 0.f, 0.f}; }
    for (int mrow = gw; mrow < M + MROWS; mrow += NGW) {
        const bool ismem = mrow >= M; const int rr = ismem ? mrow - M : mrow;
        const f32x4* xr = (const f32x4*)((ismem ? a.in[I_MEM] : a.in[I_X]) + (size_t)rr * DM) + lane;
        unsigned long long* o8 = (unsigned long long*)((bf16_t*)(ws + (ismem ? WS_MEMB : WS_XB)) + (size_t)rr * DM) + lane;
        float s = 0.f; f32x4 v[4];
#pragma unroll
        for (int j = 0; j < 4; ++j) v[j] = xr[64 * j];
#pragma unroll
        for (int j = 0; j < 4; ++j) { s += (v[j][0] * v[j][0] + v[j][1] * v[j][1]) + (v[j][2] * v[j][2] + v[j][3] * v[j][3]);
            o8[64 * j] = (unsigned long long)cvtpk(v[j][0], v[j][1]) | ((unsigned long long)cvtpk(v[j][2], v[j][3]) << 32); }
        s = wave_sum(s);
        if (lane == 0) ((float*)(ws + (ismem ? WS_SSM : WS_SS)))[rr] = s;
    }
    for (int t = gw; t < 64; t += NGW) { const int kv = t >> 5, kc = (t & 31) * 64; const float* pos = a.in[kv ? I_POSV : I_POSK] + kc; const f32x4* w1 = (const f32x4*)(a.in[kv ? I_CV1 : I_CK1] + (size_t)kc * 256) + lane;
        f32x4 s = {0.f, 0.f, 0.f, 0.f};
#pragma unroll 8
        for (int k = 0; k < 64; ++k) s += w1[(size_t)k * 64] * pos[k];
        float* o = (float*)(ws + WS_POSC) + kv * 256 + 4 * lane;
        unsafeAtomicAdd(o, s[0]); unsafeAtomicAdd(o + 1, s[1]); unsafeAtomicAdd(o + 2, s[2]); unsafeAtomicAdd(o + 3, s[3]); }
}

__device__ __forceinline__ void wqn_rows(const Args& a, int w0, int nw, int lane) {
    for (int d = w0; d < DM; d += nw) { const float s = a.in[I_MQN][d] * QS256; const f32x4* xr = (const f32x4*)(a.in[I_MWQ] + (size_t)d * DM) + lane;
        unsigned long long* o8 = (unsigned long long*)((bf16_t*)(a.ws + WS_WMQ) + (size_t)d * DM) + lane; f32x4 v[4];
#pragma unroll
        for (int j = 0; j < 4; ++j) v[j] = xr[64 * j];
#pragma unroll
        for (int j = 0; j < 4; ++j) o8[64 * j] = (unsigned long long)cvtpk(v[j][0] * s, v[j][1] * s) | ((unsigned long long)cvtpk(v[j][2] * s, v[j][3] * s) << 32); }
}
__device__ __forceinline__ void compress_unit(const Args& a, LAS unsigned char* lds, int uidx) {
    unsigned char* ws = a.ws;
    const int tid = fresh_tid(), lane = tid & 63, r32 = lane & 31, hi = lane >> 5, wid = __builtin_amdgcn_readfirstlane(tid >> 6);
    const int kv = uidx >> 6, b = (uidx >> 3) & 7, g = (uidx >> 2) & 1, chunk = uidx & 3, n0 = chunk * 32;
    const bf16_t* W1 = (const bf16_t*)(ws + (kv ? WS_CW1V : WS_CW1K)); const bf16_t* W2 = (const bf16_t*)(ws + (kv ? WS_CW2V : WS_CW2K));
    const float* posc = (const float*)(ws + WS_POSC) + kv * 256;
    const bf16_t* asrc = (const bf16_t*)(ws + WS_KVN) + (size_t)(b * SEQ) * 768 + kv * 128 + g * 64;
    LAS bf16_t* As = (LAS bf16_t*)lds;
    for (int i = tid; i < 528 * 8; i += 512) { const int row = i >> 3, ch = i & 7; const int t = min(16 * n0 + row, SEQ - 1);
        *(LAS u32x4*)(As + row * 64 + ((ch ^ ((row >> 4) & 7)) * 8)) = *(const u32x4*)(asrc + (size_t)t * 768 + ch * 8); }
    __syncthreads();
    const bf16_t* brow = W1 + (size_t)(32 * wid + r32) * 2048 + hi * 8;
    f32x16 acc = f32x16{}, accb = f32x16{};
#pragma unroll 8
    for (int kk = 0; kk < 128; kk += 2) {
        { const int l = kk >> 2, dch = (kk & 3) * 2 + hi, row = 16 * r32 + l;
          const bf16x8 av = *(const LAS bf16x8*)(As + row * 64 + ((dch ^ ((row >> 4) & 7)) * 8)); const bf16x8 bv = *(const bf16x8*)(brow + kk * 16);
          acc = __builtin_amdgcn_mfma_f32_32x32x16_bf16(av, bv, acc, 0, 0, 0); }
        { const int k1 = kk + 1, l = k1 >> 2, dch = (k1 & 3) * 2 + hi, row = 16 * r32 + l;
          const bf16x8 av = *(const LAS bf16x8*)(As + row * 64 + ((dch ^ ((row >> 4) & 7)) * 8)); const bf16x8 bv = *(const bf16x8*)(brow + k1 * 16);
          accb = __builtin_amdgcn_mfma_f32_32x32x16_bf16(av, bv, accb, 0, 0, 0); } }
    acc += accb;
    LAS bf16_t* Hs = (LAS bf16_t*)(lds + 81920);
    const float pc = posc[32 * wid + r32];
#pragma unroll
    for (int r = 0; r < 16; ++r) { const float x = acc[r] + pc; const float u = 0.7978845608028654f * (x + 0.044715f * x * x * x);
        const float ge = x * frcp(1.0f + fexp2(-2.0f * LOG2E * u)); Hs[att::crow(r, hi) * 264 + 32 * wid + r32] = (bf16_t)(cvtpk(ge, 0.f) & 0xffffu); }
    __syncthreads();
    if (wid < 2) { f32x16 acc2 = f32x16{};
#pragma unroll
        for (int kk = 0; kk < 16; ++kk) { const bf16x8 av = *(const LAS bf16x8*)(Hs + r32 * 264 + kk * 16 + hi * 8); const bf16x8 bv = *(const bf16x8*)(W2 + (size_t)(32 * wid + r32) * 256 + kk * 16 + hi * 8);
            acc2 = __builtin_amdgcn_mfma_f32_32x32x16_bf16(av, bv, acc2, 0, 0, 0); }
        bf16_t* outp = (bf16_t*)(ws + (kv ? WS_VC : WS_KC)) + (size_t)((b * 2 + g) * 128) * 64;
#pragma unroll
        for (int r = 0; r < 16; ++r) { const int n = n0 + att::crow(r, hi); const float v = n < 127 ? acc2[r] : 0.f; outp[(size_t)n * 64 + 32 * wid + r32] = (bf16_t)(cvtpk(v, 0.f) & 0xffffu); } }
    __syncthreads();
}
__device__ __forceinline__ void kmax_task(const Args& a, LAS unsigned char* lds, int task, int wave, int lane) {
    const int b = task >> 3, h = task & 7; float mx = 0.f;
    const bf16_t* K = (const bf16_t*)(a.ws + WS_KVF) + (size_t)(b * SEQ) * 1024 + h * 64;
#pragma unroll
    for (int rr = 0; rr < 4; ++rr) { const u32x4* p = (const u32x4*)(K + (size_t)(wave * 256 + rr * 64 + lane) * 1024); float ss = 0.f;
#pragma unroll
        for (int c = 0; c < 8; ++c) { const u32x4 v = p[c]; ss += (bflo(v.x) * bflo(v.x) + bfhi(v.x) * bfhi(v.x)) + (bflo(v.y) * bflo(v.y) + bfhi(v.y) * bfhi(v.y)) + (bflo(v.z) * bflo(v.z) + bfhi(v.z) * bfhi(v.z)) + (bflo(v.w) * bflo(v.w) + bfhi(v.w) * bfhi(v.w)); }
        mx = fmaxf(mx, ss); }
#pragma unroll
    for (int o = 1; o < 64; o <<= 1) mx = fmaxf(mx, __shfl_xor(mx, o));
    LAS float* red = (LAS float*)(lds + 120 * 1024);
    if (lane == 0) red[wave] = mx;
    __syncthreads();
    if (wave == 0 && lane == 0) { float m2 = red[0]; for (int i = 1; i < 8; ++i) m2 = fmaxf(m2, red[i]); ((float*)(a.ws + WS_KMAX))[task] = sqrtf(m2) * 1.01f; }
    __syncthreads();
}
__device__ __forceinline__ void cumsum_task(const Args& a, int task, int lane) {
    const int b = task >> 3, h = task & 7; const float bf = a.in[I_BF][h];
    const float* fl = (const float*)(a.ws + WS_F32S) + (size_t)(b * SEQ) * 32 + 24 + h; float* out = (float*)(a.ws + WS_CUM) + (size_t)task * SEQ;
    float v[32];
#pragma unroll
    for (int i = 0; i < 32; ++i) v[i] = fl[(size_t)(64 * i + lane) * 32];
    float carry = 0.f;
#pragma unroll
    for (int i = 0; i < 32; ++i) { const float x = v[i] + bf; float inc = fminf(x, 0.f) - log1pf(expf(-fabsf(x)));
#pragma unroll
        for (int o = 1; o < 64; o <<= 1) { const float t = __shfl_up(inc, o); if (lane >= o) inc += t; }
        inc += carry; out[64 * i + lane] = -inc * LOG2E; carry = __shfl(inc, 63); }
}

__device__ __forceinline__ void init_t5_table(const Args& a, LAS unsigned char* lds) {
    LAS float* T = (LAS float*)(lds + att::L_TBL);
    for (int i = fresh_tid(); i < 1024; i += 512) { const int h = i >> 7, d = i & 127; T[i] = a.in[I_RELB][T5B[d] * 8 + h] * LOG2E; }
}
template <bool DRY> __device__ __forceinline__ void fox_unit(const Args& a, LAS unsigned char* lds, int b, int h, int qb) {
    using namespace att;
    unsigned char* ws = a.ws;
    const int tid = fresh_tid(), lane = tid & 63, r32 = lane & 31, hi = lane >> 5, wid = __builtin_amdgcn_readfirstlane(tid >> 6);
    const int q0 = qb * 256, q0w = q0 + wid * 32, qpos = q0w + r32;
    LAS float* cb = (LAS float*)(lds + L_CB); LAS float* wsf = (LAS float*)(lds + L_WSF) + wid * 64;
    const float* cum = (const float*)(ws + WS_CUM) + (size_t)(b * 8 + h) * SEQ;
    for (int i = tid; i < q0 + 256; i += 512) cb[i] = cum[i];
    bf16_t* Qw = (bf16_t*)(ws + WS_QF) + (size_t)(b * SEQ + q0w) * 512 + h * 64;
    bf16x8 qr[4]; load_q(qr, Qw, 512, r32, hi);
    f32x16 o[2]; o[0] = f32x16{}; o[1] = f32x16{}; float m = 0.f, l = 0.f;
    const int nt = 4 * qb + 4; unsigned tmask = nt >= 32 ? 0xffffffffu : ((1u << nt) - 1u);
    const bf16_t* Kg = (const bf16_t*)(ws + WS_KVF) + (size_t)(b * SEQ) * 1024 + h * 64;
#ifndef NO_FOX_SKIP
    {
        float qq = 0.f;
#pragma unroll
        for (int d0 = 0; d0 < 4; ++d0) { const u32x4 v = __builtin_bit_cast(u32x4, qr[d0]);
            qq += (bflo(v.x) * bflo(v.x) + bfhi(v.x) * bfhi(v.x)) + (bflo(v.y) * bflo(v.y) + bfhi(v.y) * bfhi(v.y)) + (bflo(v.z) * bflo(v.z) + bfhi(v.z) * bfhi(v.z)) + (bflo(v.w) * bflo(v.w) + bfhi(v.w) * bfhi(v.w)); }
        qq = halfsum(qq);
#pragma unroll
        for (int o_ = 1; o_ < 32; o_ <<= 1) qq = fmaxf(qq, __shfl_xor(qq, o_));
        LAS float* red = (LAS float*)(lds + L_MISC + 16);
        if (lane == 0) red[wid] = qq;
        __syncthreads();
        float qmax = red[0];
#pragma unroll
        for (int i = 1; i < 8; ++i) qmax = fmaxf(qmax, red[i]);
        const float need = 2.0f * sqrtf(qmax) * 1.01f * ((const float*)(ws + WS_KMAX))[b * 8 + h] + 40.0f;
        const float cb0 = cum[q0];
        const bool skip = (lane < 32) && (lane < nt) && (cb0 - cum[64 * (lane < nt ? lane : 0) + 63] >= need);
        const unsigned long long bal = __ballot(skip);
        tmask &= ~(unsigned)bal;
        __syncthreads();
    }
#endif
#ifndef FOX_ABL
#define FOX_ABL 0
#endif
    if (DRY && (FOX_ABL & 64)) tmask = 1u << (31 - __clz((int)tmask));
    if (DRY) attn_loop2<FOX_ABL>(tmask, Kg, 1024, Kg + 512, 1024, lds, qr, o, m, l, TfFox{cb, qpos, hi, q0w}, q0w + 31);
    else attn_loop2<0>(tmask, Kg, 1024, Kg + 512, 1024, lds, qr, o, m, l, TfFox{cb, qpos, hi, q0w}, q0w + 31);
    l = halfsum(l);
    scale_rows(o, wsf, 1.0f / l, r32, hi);
    store_o<false>(o, lds, DRY ? (bf16_t*)((unsigned char*)a.out + 16 * MiB) + (size_t)(b * SEQ + q0w) * 512 + h * 64 : Qw, 512, nullptr, 0);
}
template <int PARTS> __device__ __forceinline__ void cmpwin_unit(const Args& a, LAS unsigned char* lds, int b, int g, int qb) {
    using namespace att;
    unsigned char* ws = a.ws;
    const int tid = fresh_tid(), lane = tid & 63, r32 = lane & 31, hi = lane >> 5, wid = __builtin_amdgcn_readfirstlane(tid >> 6);
    const int j = wid >> 1, sub = wid & 1, hg = g * 4 + j, q0w = qb * 64 + sub * 32, qpos = q0w + r32; const size_t qrow = (size_t)b * SEQ + qpos;
    const LAS float* tb = (const LAS float*)(lds + L_TBL) + hg * 128;
    LAS float* wsf = (LAS float*)(lds + L_WSF) + wid * 64; LAS float* PS = (LAS float*)(lds + L_PS); LAS float* IMP = (LAS float*)(lds + L_IMP); LAS unsigned* MW = (LAS unsigned*)(lds + L_MISC);
    const float* gates = (const float*)(ws + WS_F32S) + qrow * 32;
    if (tid == 0) MW[0] = 0u;
    bf16x8 qr[4]; load_q(qr, (const bf16_t*)(ws + WS_QN) + (size_t)(b * SEQ + q0w) * 512 + hg * 64, 512, r32, hi);
    const StageGeo sg = stage_geo(tid);
    { const bf16_t* Kc = (const bf16_t*)(ws + WS_KC) + (size_t)((b * 2 + g) * 128) * 64; const bf16_t* Vc = (const bf16_t*)(ws + WS_VC) + (size_t)((b * 2 + g) * 128) * 64;
#pragma unroll
        for (int t = 0; t < 2; ++t) { *(LAS u32x4*)(lds + L_SLOT + t * 16384 + sg.koff) = *(const u32x4*)(Kc + (size_t)(t * 64 + sg.krow) * 64 + sg.kcol);
            *(LAS u32x4*)(lds + L_SLOT + t * 16384 + sg.voff) = *(const u32x4*)(Vc + (size_t)(t * 64 + sg.vrow) * 64 + sg.vcol); } }
    __syncthreads();
    if (PARTS & 1) {
        f32x16 oc[2]; oc[0] = f32x16{}; oc[1] = f32x16{};
        f32x16 a0, a1, b0, b1; qkt(a0, a1, lds + L_SLOT, qr, r32, hi); qkt(b0, b1, lds + L_SLOT + 16384, qr, r32, hi);
        float mx = NEG;
#pragma unroll
        for (int r = 0; r < 16; ++r) { const int d = qpos - 16 * crow(r, hi) - 31;
            a0[r] = d >= 0 ? a0[r] + tb[min(d, 127)] : NEG; a1[r] = d - 512 >= 0 ? a1[r] + tb[min(d - 512, 127)] : NEG;
            b0[r] = d - 1024 >= 0 ? b0[r] + tb[min(d - 1024, 127)] : NEG; b1[r] = d - 1536 >= 0 ? b1[r] + tb[min(d - 1536, 127)] : NEG;
            mx = fmaxf(fmaxf(mx, fmaxf(a0[r], a1[r])), fmaxf(b0[r], b1[r])); }
        { auto rr = __builtin_amdgcn_permlane32_swap(__float_as_uint(mx), __float_as_uint(mx), false, false); mx = fmaxf(__uint_as_float(rr[0]), __uint_as_float(rr[1])); }
        const float mxs = mx == NEG ? 0.f : mx; float s = 0.f;
#pragma unroll
        for (int r = 0; r < 16; ++r) { a0[r] = fexp2(a0[r] - mxs); a1[r] = fexp2(a1[r] - mxs); b0[r] = fexp2(b0[r] - mxs); b1[r] = fexp2(b1[r] - mxs); s += (a0[r] + a1[r]) + (b0[r] + b1[r]); }
        s = halfsum(s); const float inv = s > 0.f ? 1.0f / s : 0.f;
#pragma unroll
        for (int r = 0; r < 16; ++r) { a0[r] *= inv; a1[r] *= inv; b0[r] *= inv; b1[r] *= inv; }
        {
            float own[4][4], x3[4][4], rcv[4][4];
#pragma unroll
            for (int i = 0; i < 4; ++i) {
                own[0][i] = 2.0f * (a0[4 * i] + a0[4 * i + 1] + a0[4 * i + 2]) + a0[4 * i + 3]; x3[0][i] = a0[4 * i + 3];
                own[1][i] = 2.0f * (a1[4 * i] + a1[4 * i + 1] + a1[4 * i + 2]) + a1[4 * i + 3]; x3[1][i] = a1[4 * i + 3];
                own[2][i] = 2.0f * (b0[4 * i] + b0[4 * i + 1] + b0[4 * i + 2]) + b0[4 * i + 3]; x3[2][i] = b0[4 * i + 3];
                own[3][i] = 2.0f * (b1[4 * i] + b1[4 * i + 1] + b1[4 * i + 2]) + b1[4 * i + 3]; x3[3][i] = b1[4 * i + 3]; }
#pragma unroll
            for (int k = 0; k < 4; ++k)
#pragma unroll
                for (int i = 0; i < 4; ++i) { auto rr = __builtin_amdgcn_permlane32_swap(__float_as_uint(x3[k][i]), __float_as_uint(x3[k][i]), false, false); rcv[k][i] = __uint_as_float(hi ? rr[0] : rr[1]); }
            LAS float* imh = PS + j * (64 * 33) + (sub * 32 + r32) * 33 + hi;
#pragma unroll
            for (int k = 0; k < 4; ++k)
#pragma unroll
                for (int i = 0; i < 4; ++i) { const float prev = i > 0 ? rcv[k][i - 1] : (k > 0 ? rcv[k - 1][3] : 0.f);
                    imh[8 * k + 2 * i] = own[k][i] + (hi ? rcv[k][i] : prev); }
        }
        const int vb0 = (int)(unsigned)(size_t)(lds + L_SLOT + 8192) + ((lane >> 4) & 1) * 32 + (lane & 3) * 8 + (4 * hi + ((lane & 15) >> 2)) * 64;
        bf16x8 x0, x1, x2, x3; pack_p(a0, a1, x0, x1, x2, x3); pv(oc, vb0, x0, x1, x2, x3);
        pack_p(b0, b1, x0, x1, x2, x3); pv(oc, vb0 + 16384, x0, x1, x2, x3);
        scale_rows(oc, wsf, sigmoidf_(gates[hg]), r32, hi);
        store_o<false>(oc, lds, (bf16_t*)a.out + (size_t)(b * SEQ + q0w) * 512 + hg * 64, 512, nullptr, 0);
    }
    __syncthreads();
    if (PARTS & 2) {
        const int q = tid >> 3, jb = (tid & 7) * 4; const LAS float* ps = PS + q * 33; LAS float* im = IMP + q * 33;
#pragma unroll
        for (int jj = 0; jj < 4; ++jj) { const int jx = jb + jj;
            const float v = (ps[jx] + ps[64 * 33 + jx]) + (ps[2 * 64 * 33 + jx] + ps[3 * 64 * 33 + jx]);
            const bool valid = jx <= qb, forced = (jx == 0) || (jx == qb) || (jx == qb - 1);
            im[jx] = valid ? v + (forced ? 1e4f : 0.f) : -1e30f; }
        __syncthreads();
        unsigned bits = 0u;
#pragma unroll
        for (int jj = 0; jj < 4; ++jj) { const int jx = jb + jj; const float v = im[jx]; int cnt = 0;
#pragma unroll
            for (int j2 = 0; j2 < 32; ++j2) { const float v2 = im[j2]; cnt += (v2 > v || (v2 == v && j2 < jx)) ? 1 : 0; }
            if (cnt < 16 && jx <= qb) bits |= 1u << jx; }
        bits |= __shfl_xor(bits, 1); bits |= __shfl_xor(bits, 2); bits |= __shfl_xor(bits, 4);
        if ((tid & 7) == 0) { MW[16 + q] = bits; __hip_atomic_fetch_or(MW, bits, __ATOMIC_RELAXED, __HIP_MEMORY_SCOPE_WORKGROUP); }
        __syncthreads();
    }
    if (PARTS & 2) {
    f32x16 o[2]; o[0] = f32x16{}; o[1] = f32x16{}; float m = 0.f, l = 0.f;
    const unsigned mask = MW[16 + sub * 32 + r32];
    const unsigned um = MW[0] & (qb >= 31 ? 0xffffffffu : ((2u << qb) - 1u));
    const bf16_t* Kg = (const bf16_t*)(ws + WS_KVN) + (size_t)(b * SEQ) * 768 + 256 + g * 64;
    attn_loop2(um, Kg, 768, Kg + 128, 768, lds, qr, o, m, l, TfT5{tb, qpos, hi, q0w, 1 << 30, mask, true}, q0w + 31);
    l = halfsum(l);
    scale_rows(o, wsf, sigmoidf_(gates[8 + hg]) / l, r32, hi);
    { bf16_t* ocw = (bf16_t*)a.out + (size_t)(b * SEQ + q0w) * 512 + hg * 64; store_o<true>(o, lds, ocw, 512, ocw, 512); }
    }
    if (PARTS & 4) {
    f32x16 o[2]; o[0] = f32x16{}; o[1] = f32x16{}; float m = -1e30f, l = 0.f;
    const int lo = qb > 8 ? qb - 8 : 0; const unsigned tmask = (qb >= 31 ? 0xffffffffu : ((2u << qb) - 1u)) & ~((1u << lo) - 1u);
    const bf16_t* Kg = (const bf16_t*)(ws + WS_KVN) + (size_t)(b * SEQ) * 768 + 512 + g * 64;
    attn_loop2(tmask, Kg, 768, Kg + 128, 768, lds, qr, o, m, l, TfT5{tb, qpos, hi, q0w, 512, 0u, false}, q0w + 31);
    l = halfsum(l);
    scale_rows(o, wsf, sigmoidf_(gates[16 + hg]) / l, r32, hi);
    { const bf16_t* ocw = (const bf16_t*)a.out + (size_t)(b * SEQ + q0w) * 512 + hg * 64; store_o<true>(o, lds, (bf16_t*)(ws + WS_QN) + (size_t)(b * SEQ + q0w) * 512 + hg * 64, 512, ocw, 512); }
    }
}
template <bool DRY> __device__ __forceinline__ void sel_unit(const Args& a, LAS unsigned char* lds, int b, int g, int qb) {
    using namespace att;
    unsigned char* ws = a.ws;
    const int tid = fresh_tid(), lane = tid & 63, r32 = lane & 31, hi = lane >> 5, wid = __builtin_amdgcn_readfirstlane(tid >> 6);
    const int j = wid >> 1, sub = wid & 1, hg = g * 4 + j, q0w = qb * 64 + sub * 32, qpos = q0w + r32; const size_t qrow = (size_t)b * SEQ + qpos;
    const LAS float* tb = (const LAS float*)(lds + L_TBL) + hg * 128; LAS float* wsf = (LAS float*)(lds + L_WSF) + wid * 64;
    bf16_t* Qw = (bf16_t*)(ws + WS_QN) + (size_t)(b * SEQ + q0w) * 512 + hg * 64;
    bf16x8 qr[4]; load_q(qr, Qw, 512, r32, hi);
    const unsigned mask = ((const unsigned*)(ws + WS_MASK))[(size_t)(b * 2 + g) * SEQ + qpos];
    const unsigned um = ((const unsigned*)(ws + WS_UMASK))[(b * 2 + g) * 32 + qb] & (qb >= 31 ? 0xffffffffu : ((2u << qb) - 1u));
    f32x16 o[2]; o[0] = f32x16{}; o[1] = f32x16{}; float m = -1e30f, l = 0.f;
    const bf16_t* Kg = (const bf16_t*)(ws + WS_KVN) + (size_t)(b * SEQ) * 768 + 256 + g * 64;
    attn_loop2(um, Kg, 768, Kg + 128, 768, lds, qr, o, m, l, TfT5{tb, qpos, hi, q0w, 1 << 30, mask, true}, q0w + 31);
    l = halfsum(l);
    const float g1 = sigmoidf_(((const float*)(ws + WS_F32S))[qrow * 32 + 8 + hg]);
    scale_rows(o, wsf, g1 / l, r32, hi);
    store_o<true>(o, lds, DRY ? (bf16_t*)((unsigned char*)a.out + 16 * MiB) + (size_t)(b * SEQ + q0w) * 512 + hg * 64 : Qw, 512, (const bf16_t*)a.out + (size_t)(b * SEQ + q0w) * 512 + hg * 64, 512);
}
#ifndef PHMASK
#define PHMASK 0xffffffffu
#endif
#define PH(n) (((PHMASK) >> (n)) & 1u)
#ifndef MULTI_ALIGN
#define MULTI_ALIGN true
#endif
#ifndef SINGLE_ALIGN
#define SINGLE_ALIGN true
#endif
#ifndef DUPMASK
#define DUPMASK 0u
#endif
#define DUP(n) (((DUPMASK) >> (n)) & 1u)
#define REP(n) for (int rep_ = 0; rep_ < 1 + (int)DUP(n); ++rep_)
#define STAGE_SS(S_, ssptr) do { LAS float* aux_ = (LAS float*)(lds + RING_BYTES); pg8::Unit u_; const int t_ = fresh_tid(); \
        for (int i_ = 0; S_.next(i_, u_); ++i_) if (t_ < 256) aux_[i_ * 256 + t_] = (ssptr)[u_.pm * 256 + t_]; \
        __syncthreads(); } while (0)
__global__ void __launch_bounds__(512, 2) hybrid_fwd(Args a) {
    extern __shared__ __attribute__((aligned(16))) unsigned char lds_raw[];
    LAS unsigned char* lds = (LAS unsigned char*)lds_raw;
    cg::grid_group grid = cg::this_grid();
    unsigned char* ws = a.ws;
    const int tid = fresh_tid(), lane = tid & 63, wave = __builtin_amdgcn_readfirstlane(tid >> 6);
    const int G = gridDim.x, bx = blockIdx.x, vcu = (G % 8 == 0) ? (bx % 8) * (G / 8) + bx / 8 : bx;
    const int gw = vcu * 8 + wave, NGW = G * 8;
    float* X = a.out;
    bf16_t* XB = (bf16_t*)(ws + WS_XB);
    float* SS = (float*)(ws + WS_SS);
    { volatile LAS unsigned* st0 = (volatile LAS unsigned*)(lds + LDS_BYTES - 256); if (tid < 32) st0[tid] = 0u; }
    __syncthreads();
    XcdBarrier xbar = xcd_barrier_post((unsigned*)(ws + WS_CTL) + CW_BAR, (volatile LAS unsigned*)(lds + LDS_BYTES - 256 + 32));
#ifdef USE_CG_SYNC
#define GSYNC() grid.sync()
#else
    if (a.lo == 0x7e57) grid.sync();
#ifdef TSTAMP
    int gs_cnt = 0; unsigned long long t_start = __builtin_amdgcn_s_memrealtime(), t_rec = 0;
    unsigned long long t_prev = t_start;
#define GSYNC() do { xcd_barrier(xbar); ++gs_cnt; if (gs_cnt == TSTAMP - 1) t_prev = __builtin_amdgcn_s_memrealtime(); if (gs_cnt == TSTAMP) t_rec = __builtin_amdgcn_s_memrealtime(); } while (0)
#else
#define GSYNC() xcd_barrier(xbar)
#endif
#endif
    const float* fin_src = a.in[I_X];

#if STAGE_LIMIT >= 1
    REP(0) p0_prologue(a, lds, gw, NGW, wave, lane);
    GSYNC();
    { pg8::Gemm g{XB, (const bf16_t*)(ws + WS_WGU1), DM, DM, DM, 0, 0, 0, 0}; pg8::Order S; S.init(64, 22, 1, G, bx);
      STAGE_SS(S, SS); pg8::EpiGU E{(bf16_t*)(ws + WS_H), (const LAS float*)(lds + RING_BYTES)};
#ifdef P1_NULLDUP
      { pg8::EpiNull E0{(float*)(ws + WS_POSC + 4096)}; pg8::gemm_phase<pg8::EpiNull, true>(lds, g, S, E0); }
#endif
      REP(1) pg8::gemm_phase<pg8::EpiGU, MULTI_ALIGN>(lds, g, S, E);
      if (bx >= 128) { LAS float* scr = (LAS float*)(lds + wave * 16384); conv_run(a, N_GU + (bx - 128) * 8 + wave, CONV_NA, 1024, scr, lane); } }
    GSYNC();
    { pg8::Gemm g{(const bf16_t*)(ws + WS_H), (const bf16_t*)(ws + WS_WD1), FF, FF, FF, 0, 0, 0, 0}; pg8::Order S; S.init(64, 4, 1, G, bx);
      if (DUP(2)) { pg8::EpiNull E0{(float*)(ws + WS_POSC + 4096)}; pg8::gemm_phase<pg8::EpiNull, false>(lds, g, S, E0); }
      pg8::EpiResB<true> E{a.in[I_X], XB, SS + M, 0.5f}; pg8::gemm_phase<pg8::EpiResB<true>, false>(lds, g, S, E); }
    GSYNC();
    fin_src = X;
#endif
#if STAGE_LIMIT >= 2
#if PH(3)
    { pg8::Gemm g{XB, (const bf16_t*)(ws + WS_WIN), DM, DM, DM, 0, 0, 0, 0}; pg8::Order S; S.init(64, 20, 1, G, bx);
      pg8::EpiQKV E{(bf16_t*)(ws + WS_QN), (bf16_t*)(ws + WS_KVN), (bf16_t*)(ws + WS_QF), (bf16_t*)(ws + WS_KVF), (bf16_t*)(ws + WS_GAB), (float*)(ws + WS_F32S), (const LAS float*)(lds + RING_BYTES)};
      STAGE_SS(S, SS + M);
      REP(3) pg8::gemm_phase<pg8::EpiQKV, MULTI_ALIGN>(lds, g, S, E); }
#endif
    GSYNC();
#if PH(4)
    REP(4) if (bx < 128) { compress_unit(a, lds, bx); }
    else if (bx < 192) {
        { pg8::Gemm g{(const bf16_t*)(ws + WS_MEMB), (const bf16_t*)(ws + WS_WMKV), DM, DM, DM, 0, 0, 0, 0}; pg8::Order S; S.init(8, 8, 1, 64, bx - 128);
            pg8::EpiRowScale E{(bf16_t*)(ws + WS_KVM), 2 * DM, (const float*)(ws + WS_SSM)}; pg8::gemm_phase<pg8::EpiRowScale, false>(lds, g, S, E); }
    } else { if (wave == 0) cumsum_task(a, bx - 192, lane); kmax_task(a, lds, bx - 192, wave, lane); }
    if (bx >= 128) {
        LAS float* scr = (LAS float*)(lds + wave * 16384);
        if (bx < 192) conv_run(a, CONV_NA + (bx - 128) * 8 + wave, CONV_NA + CONV_NB, 1536, scr, lane);
        else { const int s0_ = 512 + ((bx - 192) * 8 + wave) * 2; conv_run(a, CONV_NA + s0_, CONV_NA + CONV_NB, 1536, scr, lane); conv_run(a, CONV_NA + s0_ + 1, CONV_NA + CONV_NB, 1536, scr, lane); }
        wqn_rows(a, (bx - 128) * 8 + wave, 1024, lane); }
#endif
    GSYNC();
#if PH(5)
    init_t5_table(a, lds);
    { const int bh = vcu >> 2, s = vcu & 3; if (DUP(5)) { fox_unit<true>(a, lds, bh >> 3, bh & 7, 7 - s); fox_unit<true>(a, lds, bh >> 3, bh & 7, s); }
      fox_unit<false>(a, lds, bh >> 3, bh & 7, 7 - s); fox_unit<false>(a, lds, bh >> 3, bh & 7, s); }
#ifdef DUPPART
    { const int bg = vcu >> 4, s = vcu & 15; cmpwin_unit<DUPPART>(a, lds, bg >> 1, bg & 1, 31 - s); cmpwin_unit<DUPPART>(a, lds, bg >> 1, bg & 1, s); }
#endif
#ifndef NO_CMPWIN
    REP(15) { const int bg = vcu >> 4, s = vcu & 15; cmpwin_unit<7>(a, lds, bg >> 1, bg & 1, 31 - s); cmpwin_unit<7>(a, lds, bg >> 1, bg & 1, s); }
#endif
#endif
    GSYNC();
#if PH(7)
    REP(7) { pg8::Order S; S.init(64, 4, 1, G, bx);
      { pg8::Gemm g{(const bf16_t*)(ws + WS_QN), (const bf16_t*)(ws + WS_WUPN), 512, 512, 512, 0, 0, 0, 0}; pg8::EpiUp<0> E{(const bf16_t*)(ws + WS_GAB), (bf16_t*)(ws + WS_Y)}; pg8::gemm_phase<pg8::EpiUp<0>, false>(lds, g, S, E); }
      { pg8::Gemm g{(const bf16_t*)(ws + WS_QF), (const bf16_t*)(ws + WS_WUPF), 512, 512, 512, 0, 0, 0, 0}; pg8::EpiUp<1> E{(const bf16_t*)(ws + WS_GAB), (bf16_t*)(ws + WS_Y)}; pg8::gemm_phase<pg8::EpiUp<1>, false>(lds, g, S, E); } }
#endif
    GSYNC();
#if PH(8)
    { pg8::Gemm g{(const bf16_t*)(ws + WS_Y), (const bf16_t*)(ws + WS_WOUT), DM, DM, DM, 0, 0, 0, 0}; pg8::Order S; S.init(64, 4, 1, G, bx);
      if (DUP(8)) { pg8::EpiNull E0{(float*)(ws + WS_POSC + 4096)}; pg8::gemm_phase<pg8::EpiNull, false>(lds, g, S, E0); }
      pg8::EpiResB<false> E{nullptr, XB, SS + 2 * M, 1.0f}; pg8::gemm_phase<pg8::EpiResB<false>, false>(lds, g, S, E); }
    if (bx < 128) { pg8::Gemm g{(const bf16_t*)(ws + WS_KVM), (const bf16_t*)(ws + WS_WMQ), 2 * DM, DM, 256, (long)MEMLEN * 2 * DM, 256, 0, 256};
        pg8::OneUnit S{pg8::Unit{0, bx & 3, bx >> 2}}; pg8::EpiBatchBf16 E{(bf16_t*)(ws + WS_MT), DM, (long)DM * DM, (long)256 * DM}; pg8::gemm_phase<pg8::EpiBatchBf16, false>(lds, g, S, E); }
    else { pg8::Gemm g{(const bf16_t*)(ws + WS_WMO), (const bf16_t*)(ws + WS_KVM) + DM, DM, 2 * DM, 256, 0, 256, (long)MEMLEN * 2 * DM, 256};
        pg8::OneUnit S{pg8::Unit{(bx - 128) & 3, 0, (bx - 128) >> 2}}; pg8::EpiBatchBf16 E{(bf16_t*)(ws + WS_NT), DM, (long)DM * DM, 256}; pg8::gemm_phase<pg8::EpiBatchBf16, false>(lds, g, S, E); }
#endif
    GSYNC();
#endif
#if STAGE_LIMIT >= 3
    { pg8::Gemm g{XB, (const bf16_t*)(ws + WS_MT), DM, DM, DM, 0, 0, (long)4 * DM * DM, (long)DM * DM}; pg8::Order S; S.init(64, 4, 1, G, bx, 3);
      pg8::EpiSoftmaxRS E{(bf16_t*)(ws + WS_PM), DM, SS + 2 * M}; pg8::gemm_phase<pg8::EpiSoftmaxRS, false>(lds, g, S, E); }
    GSYNC();
    { pg8::Gemm g{(const bf16_t*)(ws + WS_PM), (const bf16_t*)(ws + WS_NT), DM, DM, DM, 0, 0, (long)4 * DM * DM, (long)DM * DM}; pg8::Order S; S.init(64, 4, 1, G, bx, 3);
      pg8::EpiResB<false> E{nullptr, XB, SS + 3 * M, 1.0f}; pg8::gemm_phase<pg8::EpiResB<false>, false>(lds, g, S, E); }
    GSYNC();
#endif
#if STAGE_LIMIT >= 4
    { pg8::Gemm g{XB, (const bf16_t*)(ws + WS_WGU2), DM, DM, DM, 0, 0, 0, 0}; pg8::Order S; S.init(64, 22, 1, G, bx);
      STAGE_SS(S, SS + 3 * M); pg8::EpiGU E{(bf16_t*)(ws + WS_H), (const LAS float*)(lds + RING_BYTES)}; REP(13) pg8::gemm_phase<pg8::EpiGU, MULTI_ALIGN>(lds, g, S, E); }
    GSYNC();
    { pg8::Gemm g{(const bf16_t*)(ws + WS_H), (const bf16_t*)(ws + WS_WD2), FF, FF, FF, 0, 0, 0, 0}; pg8::Order S; S.init(64, 4, 1, G, bx);
      pg8::EpiResNorm E{XB, X, 0.5f, a.in[I_FINN], (float*)(ws + WS_XBUF), (unsigned*)(ws + WS_FINCNT)}; pg8::gemm_phase<pg8::EpiResNorm, false>(lds, g, S, E); }
#ifdef TSTAMP
    GSYNC();
    if (t_rec == 0) t_rec = __builtin_amdgcn_s_memrealtime();
    if (bx == 0) { const int n = (int)((t_rec - t_prev) * 400 / 100); for (int i = tid; i < n; i += 512) X[i] += 0.1f; }
#endif
    return;
#endif
#ifdef EXTRA_BARS
    for (int eb = 0; eb < EXTRA_BARS; ++eb) GSYNC();
#endif
    { const float* gn = a.in[I_FINN]; const int tid2 = fresh_tid(), lane = tid2 & 63, gw = vcu * 8 + (tid2 >> 6);
      for (int mrow = gw; mrow < M; mrow += NGW) {
          const f32x4* xr = (const f32x4*)(fin_src + (size_t)mrow * DM) + lane; f32x4* orow = (f32x4*)(X + (size_t)mrow * DM) + lane;
          f32x4 v[4]; float s = 0.f;
#pragma unroll
          for (int j = 0; j < 4; ++j) { v[j] = xr[64 * j]; s += (v[j][0] * v[j][0] + v[j][1] * v[j][1]) + (v[j][2] * v[j][2] + v[j][3] * v[j][3]); }
          const float rs = rstd_of(wave_sum(s));
#pragma unroll
          for (int j = 0; j < 4; ++j) orow[64 * j] = v[j] * rs * ((const f32x4*)gn)[lane + 64 * j];
      } }
}

extern "C" void kernel_launch(void* const* d_in, const int* in_sizes, int n_in, void* d_out, int out_size, void* d_ws, size_t ws_size, hipStream_t stream) {
    static int grid = 0;
    if (grid == 0) {
        if (n_in != 29 || out_size != M * DM || ws_size < WS_END) { fprintf(stderr, "kernel_launch: unexpected shapes (n_in %d out %d ws %zu)\n", n_in, out_size, ws_size); grid = -1; return; }
        int dev = 0, cus = 0, per_cu = 0;
        hipGetDevice(&dev); hipDeviceGetAttribute(&cus, hipDeviceAttributeMultiprocessorCount, dev);
        if (hipFuncSetAttribute((const void*)hybrid_fwd, hipFuncAttributeMaxDynamicSharedMemorySize, LDS_BYTES) != hipSuccess) { fprintf(stderr, "kernel_launch: hipFuncSetAttribute failed\n"); grid = -1; return; }
        if (hipOccupancyMaxActiveBlocksPerMultiprocessor(&per_cu, (const void*)hybrid_fwd, 512, LDS_BYTES) != hipSuccess || per_cu < 1) { fprintf(stderr, "kernel_launch: occupancy query failed (%d)\n", per_cu); per_cu = 1; }
        (void)hipGetLastError();
        grid = cus * (per_cu < 1 ? 1 : 1);
        if (grid != 256) fprintf(stderr, "kernel_launch: grid %d != 256: this kernel's phase maps assume 256 workgroups\n", grid);
    }
    if (grid < 0) return;
    hipMemsetAsync((char*)d_ws + WS_CTL, 0, CTL_ZERO_BYTES, stream);
    Args a{};
    for (int i = 0; i < 29; ++i) a.in[i] = (const float*)d_in[i];
    a.out = (float*)d_out; a.ws = (unsigned char*)d_ws; a.lo = 0; a.hi = 0;
    void* args[] = {&a};
#ifdef PLAIN_LAUNCH
    hipLaunchKernelGGL(hybrid_fwd, dim3(grid), dim3(512), LDS_BYTES, stream, a); hipError_t e = hipPeekAtLastError(); (void)args;
#else
    hipError_t e = hipLaunchCooperativeKernel((const void*)hybrid_fwd, dim3(grid), dim3(512), args, LDS_BYTES, stream);
#endif
    if (e != hipSuccess) fprintf(stderr, "kernel_launch: cooperative launch failed: %s (grid %d)\n", hipGetErrorString(e), grid);
}
```

```cpp
#define ATT_GRP(w) 0
#include <hip/hip_runtime.h>
#include <hip/hip_cooperative_groups.h>
#include <cstdio>
#include <cstdint>
namespace cg = cooperative_groups;

#define LAS __attribute__((address_space(3)))
typedef unsigned short bf16_t;
typedef short bf16x8 __attribute__((ext_vector_type(8)));
typedef short s16x4 __attribute__((ext_vector_type(4)));
typedef float f32x2 __attribute__((ext_vector_type(2)));
typedef float f32x4 __attribute__((ext_vector_type(4)));
typedef float f32x16 __attribute__((ext_vector_type(16)));
typedef unsigned u32x2 __attribute__((ext_vector_type(2)));
typedef unsigned u32x4 __attribute__((ext_vector_type(4)));
typedef __bf16 bf16x2_t __attribute__((ext_vector_type(2)));

constexpr int NB = 8, SEQ = 2048, DM = 1024, FF = 2816, M = NB * SEQ;
constexpr int MEMLEN = 256, MROWS = NB * MEMLEN;
constexpr float RMS_EPS = 1e-6f;
constexpr float LOG2E = 1.4426950408889634f;
constexpr float QS64 = 0.125f * LOG2E;
constexpr float QS256 = 0.0625f * LOG2E;

__device__ __forceinline__ int fresh_tid() { int t = threadIdx.x; asm volatile("" : "+v"(t)); return t; }
__device__ __forceinline__ unsigned cvtpk(float lo, float hi) { f32x2 v = {lo, hi}; bf16x2_t b = __builtin_convertvector(v, bf16x2_t); return __builtin_bit_cast(unsigned, b); }
__device__ __forceinline__ float bflo(unsigned w) { return __uint_as_float(w << 16); }
__device__ __forceinline__ float bfhi(unsigned w) { return __uint_as_float(w & 0xffff0000u); }
__device__ __forceinline__ u32x4 pack8(f32x4 a, f32x4 b) { u32x4 w; w.x = cvtpk(a[0], a[1]); w.y = cvtpk(a[2], a[3]); w.z = cvtpk(b[0], b[1]); w.w = cvtpk(b[2], b[3]); return w; }
__device__ __forceinline__ float fexp2(float x) { return __builtin_amdgcn_exp2f(x); }
__device__ __forceinline__ float frcp(float x) { return __builtin_amdgcn_rcpf(x); }
__device__ __forceinline__ float sigmoidf_(float x) { return frcp(1.0f + fexp2(-x * LOG2E)); }
__device__ __forceinline__ float rstd_of(float ss) { return __builtin_amdgcn_rsqf(ss * (1.0f / DM) + RMS_EPS); }

namespace pg8 {
constexpr int BM = 256, BK = 64, HALF = 128, HTB = HALF * BK * 2, STAGE_BYTES = 8 * HTB, NXCD = 8, WGM = 8;
__host__ __device__ __forceinline__ int lds_byte(int r, int c) { const int st = (r >> 4) * 2 + (c >> 5), rr = r & 15, cc = c & 31, ob = rr * 64 + cc * 2; return st * 1024 + (ob ^ (((ob >> 9) & 1) << 5)); }
__host__ __device__ __forceinline__ void stage_rc(int b, int& R, int& C) { const int st = b / 1024, sb = b % 1024, swz = sb ^ (((sb >> 9) & 1) << 5); R = (st >> 1) * 16 + swz / 64; C = (st & 1) * 32 + (swz % 64) / 2; }
__host__ __device__ __forceinline__ int perm32(int rho) { const int n = rho >> 4, i = rho & 15; return 8 * (i >> 2) + 4 * n + (i & 3); }

struct Unit { int pm, pn, pb, ui; };
struct Gemm { const bf16_t* A; const bf16_t* Bt; int lda, ldb, K; long sAb, sAh, sBb, sBh; };

struct Order {
    int nM, nN, nwg, G, c, pbs;
    __device__ __forceinline__ void init(int nM_, int nN_, int nB_, int G_, int c_, int pbs_ = -1) { nM = nM_; nN = nN_; nwg = nM_ * nN_ * nB_; G = G_; c = c_; pbs = pbs_; }
    __device__ __forceinline__ bool next(int i, Unit& u) const {
        if (c < 0) return false;
        const long L = (long)i * G + c; if (L >= nwg) return false;
        int wgid = (int)L; { const int q = nwg / NXCD, r = nwg % NXCD, xcd = wgid % NXCD, off = wgid / NXCD; wgid = (xcd < r ? xcd * (q + 1) : r * (q + 1) + (xcd - r) * q) + off; }
        const int per = nM * nN; u.pb = wgid / per; const int w = wgid % per;
        const int nig = WGM * nN, gid = w / nig, fm = gid * WGM, gsz = (nM - fm) < WGM ? (nM - fm) : WGM;
        u.pm = fm + ((w % nig) % gsz); u.pn = (w % nig) / gsz; if (pbs >= 0) u.pb = u.pm >> pbs; return true;
    }
};

struct OneUnit { Unit u; __device__ __forceinline__ bool next(int i, Unit& o) const { if (i != 0) return false; o = u; o.ui = 0; return true; } };

typedef f32x4 Acc[2][2][4][2];

template <class Epi, bool ALIGN_EPI, class Sched>
__device__ __forceinline__ void gemm_phase(LAS unsigned char* lds, const Gemm g, const Sched& S, const Epi& E) {
    const int tid = fresh_tid(), wid = __builtin_amdgcn_readfirstlane(tid >> 6), lane = tid & 63, wr = wid >> 2, wc = wid & 3, fr = lane & 15, fq = lane >> 4;
    const int K = g.K, nt = K / BK;
    unsigned voffA[2], voffB[2];
#pragma unroll
    for (int i = 0; i < 2; ++i) { int R, C; stage_rc(tid * 16 + i * 8192, R, C); const int Rb = (R & ~31) + perm32(R & 31);
        voffA[i] = (unsigned)(R * g.lda + C) * 2u; voffB[i] = (unsigned)(Rb * g.ldb + C) * 2u; }
    const size_t kstep = (size_t)(BK * 2);
    const size_t hstepA = (size_t)HALF * g.lda * 2, hstepB = (size_t)HALF * g.ldb * 2;
    const size_t tstepA = 2 * hstepA, tstepB = 2 * hstepB;
    const unsigned ldsw = (unsigned)wid * 1024u;
    const int aoff = lds_byte(wr * 64 + fr, fq * 8), boff = lds_byte(wc * 32 + fr, fq * 8);
#define PG8_SA(b, h) (((b) * 2 + (h)) * HTB)
#define PG8_SB(b, h) ((4 + (b) * 2 + (h)) * HTB)
#define PG8_STAGE(bufoff, gbase, voff) do { _Pragma("unroll") for (int _i = 0; _i < 2; ++_i) \
        __builtin_amdgcn_global_load_lds((const unsigned*)((const char*)(gbase) + (voff)[_i]), (LAS unsigned*)(lds + (bufoff) + ldsw + _i * 8192), 16, 0, 0); } while (0)
#define PG8_LDA(dst, b, h) do { _Pragma("unroll") for (int m = 0; m < 4; ++m) _Pragma("unroll") for (int k = 0; k < 2; ++k) dst[m][k] = *(const LAS bf16x8*)(lds + PG8_SA(b, h) + aoff + m * 2048 + k * 1024); } while (0)
#define PG8_LDB(dst, b, h) do { _Pragma("unroll") for (int n = 0; n < 2; ++n) _Pragma("unroll") for (int k = 0; k < 2; ++k) dst[n][k] = *(const LAS bf16x8*)(lds + PG8_SB(b, h) + boff + n * 2048 + k * 1024); } while (0)
#define PG8_MMA(ai, bj, At, Bt) do { __builtin_amdgcn_s_setprio(1); _Pragma("unroll") for (int m = 0; m < 4; ++m) _Pragma("unroll") for (int n = 0; n < 2; ++n) _Pragma("unroll") for (int k = 0; k < 2; ++k) \
        acc[ai][bj][m][n] = __builtin_amdgcn_mfma_f32_16x16x32_bf16(Bt[n][k], At[m][k], acc[ai][bj][m][n], 0, 0, 0); __builtin_amdgcn_s_setprio(0); } while (0)
#define PG8_WAIT_V(n) asm volatile("s_waitcnt vmcnt(" #n ")" ::: "memory")
#define PG8_WAIT_L(n) asm volatile("s_waitcnt lgkmcnt(" #n ")" ::: "memory")
#define PG8_BAR __builtin_amdgcn_s_barrier()
#define PG8_SCHED __builtin_amdgcn_sched_barrier(0)
#define PG8_OFFA(u) ((size_t)(((u).pb >> 2) * g.sAb + ((u).pb & 3) * g.sAh) * 2 + (size_t)(u).pm * tstepA)
#define PG8_OFFB(u) ((size_t)(((u).pb >> 2) * g.sBb + ((u).pb & 3) * g.sBh) * 2 + (size_t)(u).pn * tstepB)
    Unit cur, nxt; int ui = 0;
    if (!S.next(0, cur)) return;
    cur.ui = 0;
    Acc acc;
#pragma unroll
    for (int a = 0; a < 2; ++a)
#pragma unroll
        for (int b = 0; b < 2; ++b)
#pragma unroll
            for (int m = 0; m < 4; ++m)
#pragma unroll
                for (int n = 0; n < 2; ++n) acc[a][b][m][n] = (f32x4){0.f, 0.f, 0.f, 0.f};
    bf16x8 At[4][2], B0[2][2], B1[2][2];
    const char* cA = (const char*)g.A + PG8_OFFA(cur); const char* cB = (const char*)g.Bt + PG8_OFFB(cur);
    {
        PG8_STAGE(PG8_SB(0, 0), cB, voffB); PG8_STAGE(PG8_SB(0, 1), cB + hstepB, voffB); PG8_STAGE(PG8_SA(0, 0), cA, voffA); PG8_STAGE(PG8_SA(0, 1), cA + hstepA, voffA);
        if (wr == 1) PG8_BAR;
        PG8_WAIT_V(2); PG8_BAR;
        PG8_STAGE(PG8_SB(1, 0), cB + kstep, voffB); PG8_STAGE(PG8_SA(1, 0), cA + kstep, voffA); PG8_STAGE(PG8_SB(1, 1), cB + hstepB + kstep, voffB);
        PG8_WAIT_V(6); PG8_BAR;
    }
    for (;;) {
        const bool has_next = S.next(ui + 1, nxt); nxt.ui = ui + 1;
        const char* nA = has_next ? (const char*)g.A + PG8_OFFA(nxt) : cA; const char* nB = has_next ? (const char*)g.Bt + PG8_OFFB(nxt) : cB;
        for (int t = 0; t < nt; t += 2) {
            const bool last = (t == nt - 2);
            const char* a1 = cA + (size_t)(t + 1) * kstep;
            const char* a2 = last ? nA : cA + (size_t)(t + 2) * kstep; const char* b2 = last ? nB : cB + (size_t)(t + 2) * kstep;
            const char* a3 = a2 + kstep; const char* b3 = b2 + kstep;
            PG8_LDB(B0, 0, 0); PG8_LDB(B1, 0, 1); PG8_SCHED; PG8_LDA(At, 0, 0); PG8_STAGE(PG8_SA(1, 1), a1 + hstepA, voffA);
            PG8_WAIT_V(8); PG8_WAIT_L(0); PG8_BAR; PG8_MMA(0, 0, At, B0); PG8_MMA(0, 1, At, B1); PG8_BAR; PG8_SCHED;
            PG8_LDA(At, 0, 1); PG8_STAGE(PG8_SB(0, 0), b2, voffB); PG8_STAGE(PG8_SB(0, 1), b2 + hstepB, voffB); PG8_STAGE(PG8_SA(0, 0), a2, voffA);
            PG8_WAIT_V(8); PG8_WAIT_L(0); PG8_BAR; PG8_MMA(1, 0, At, B0); PG8_MMA(1, 1, At, B1); PG8_BAR; PG8_SCHED;
            PG8_LDB(B0, 1, 0); PG8_LDB(B1, 1, 1); PG8_SCHED; PG8_LDA(At, 1, 0); PG8_STAGE(PG8_SA(0, 1), a2 + hstepA, voffA);
            PG8_WAIT_V(8); PG8_WAIT_L(0); PG8_BAR; PG8_MMA(0, 0, At, B0); PG8_MMA(0, 1, At, B1); PG8_BAR; PG8_SCHED;
            PG8_LDA(At, 1, 1); PG8_STAGE(PG8_SB(1, 0), b3, voffB); PG8_STAGE(PG8_SB(1, 1), b3 + hstepB, voffB); PG8_STAGE(PG8_SA(1, 0), a3, voffA);
            PG8_WAIT_V(8); PG8_WAIT_L(0); PG8_BAR; PG8_MMA(1, 0, At, B0); PG8_MMA(1, 1, At, B1); PG8_BAR; PG8_SCHED;
        }
        if constexpr (ALIGN_EPI) { if (wr == 0) PG8_BAR; }
        if constexpr (!Epi::AFTER_DRAIN) { const int l2_ = fresh_tid() & 63; E(acc, cur, wr, wc, l2_ & 15, l2_ >> 4); }
        if (!has_next) break;
#pragma unroll
        for (int a = 0; a < 2; ++a)
#pragma unroll
            for (int b = 0; b < 2; ++b)
#pragma unroll
                for (int m = 0; m < 4; ++m)
#pragma unroll
                    for (int n = 0; n < 2; ++n) acc[a][b][m][n] = (f32x4){0.f, 0.f, 0.f, 0.f};
        cur = nxt; cA = nA; cB = nB; ++ui;
        if constexpr (ALIGN_EPI) { if (wr == 1) PG8_BAR; }
    }
    PG8_WAIT_V(0);
    if constexpr (!ALIGN_EPI) { if (wr == 0) PG8_BAR; }
    PG8_BAR;
    if constexpr (Epi::AFTER_DRAIN) { const int l2_ = fresh_tid() & 63; E.fused(acc, cur, wr, wc, l2_ & 15, l2_ >> 4, lds, wid, l2_); }
#undef PG8_SA
#undef PG8_SB
#undef PG8_STAGE
#undef PG8_LDA
#undef PG8_LDB
#undef PG8_MMA
#undef PG8_WAIT_V
#undef PG8_WAIT_L
#undef PG8_BAR
#undef PG8_SCHED
#undef PG8_OFFA
#undef PG8_OFFB
}

struct EpiNull { static constexpr bool AFTER_DRAIN = false; float* sink; __device__ __forceinline__ void operator()(const Acc& acc, const Unit& u, int wr, int wc, int fr, int fq) const { f32x4 s = {0.f, 0.f, 0.f, 0.f};
_Pragma("unroll") for (int a = 0; a < 2; ++a) _Pragma("unroll") for (int b = 0; b < 2; ++b) _Pragma("unroll") for (int m = 0; m < 4; ++m) _Pragma("unroll") for (int n = 0; n < 2; ++n) s += acc[a][b][m][n];
 if (s[0] + s[1] + s[2] + s[3] == 1234567.25f) sink[0] = 1.f; } };
struct EpiGU {
    static constexpr bool AFTER_DRAIN = false;
    bf16_t* H; const LAS float* aux;
    __device__ __forceinline__ void operator()(const Acc& acc, const Unit& u, int wr, int wc, int fr, int fq) const {
        const int row0 = u.pm * BM + wr * 64 + fr, col0 = u.pn * 128 + wc * 32 + fq * 8;
        float rsv[2][4];
#pragma unroll
        for (int ai = 0; ai < 2; ++ai)
#pragma unroll
            for (int m = 0; m < 4; ++m) rsv[ai][m] = aux[u.ui * 256 + wr * 64 + fr + ai * HALF + m * 16];
#pragma unroll
        for (int ai = 0; ai < 2; ++ai)
#pragma unroll
            for (int m = 0; m < 4; ++m) {
                const int row = row0 + ai * HALF + m * 16; const float rs = rstd_of(rsv[ai][m]);
                f32x4 h[2];
#pragma unroll
                for (int n = 0; n < 2; ++n) { const f32x4 gg = acc[ai][0][m][n] * rs, uu = acc[ai][1][m][n] * rs;
#pragma unroll
                    for (int j = 0; j < 4; ++j) h[n][j] = gg[j] * sigmoidf_(gg[j]) * uu[j]; }
                *(u32x4*)(H + (size_t)row * FF + col0) = pack8(h[0], h[1]);
            }
    }
};
template <bool WRITE_XB, bool WRITE_SS> struct EpiRes {
    static constexpr bool AFTER_DRAIN = false;
    const float* base; float* out; bf16_t* xb; float* ss; float scale;
    __device__ __forceinline__ void operator()(const Acc& acc, const Unit& u, int wr, int wc, int fr, int fq) const {
        const int row0 = u.pm * BM + wr * 64 + fr, col0 = u.pn * BM + wc * 32 + fq * 8;
#pragma unroll
        for (int ai = 0; ai < 2; ++ai)
#pragma unroll
            for (int m2 = 0; m2 < 4; m2 += 2) {
                f32x4 o[2][2][2];
#pragma unroll
                for (int mm = 0; mm < 2; ++mm)
#pragma unroll
                    for (int bj = 0; bj < 2; ++bj) { const size_t p = (size_t)(row0 + ai * HALF + (m2 + mm) * 16) * DM + col0 + bj * HALF; o[mm][bj][0] = *(const f32x4*)(base + p); o[mm][bj][1] = *(const f32x4*)(base + p + 4); }
#pragma unroll
                for (int mm = 0; mm < 2; ++mm) { const int m = m2 + mm, row = row0 + ai * HALF + m * 16; float sq = 0.f;
#pragma unroll
                    for (int bj = 0; bj < 2; ++bj) { const size_t p = (size_t)row * DM + col0 + bj * HALF;
                        const f32x4 n0 = o[mm][bj][0] + acc[ai][bj][m][0] * scale, n1 = o[mm][bj][1] + acc[ai][bj][m][1] * scale;
                        *(f32x4*)(out + p) = n0; *(f32x4*)(out + p + 4) = n1;
                        if (WRITE_XB) *(u32x4*)(xb + p) = pack8(n0, n1);
                        if (WRITE_SS) sq += (n0[0] * n0[0] + n0[1] * n0[1]) + (n0[2] * n0[2] + n0[3] * n0[3]) + (n1[0] * n1[0] + n1[1] * n1[1]) + (n1[2] * n1[2] + n1[3] * n1[3]); }
                    if (WRITE_SS) { sq += __shfl_xor(sq, 16); sq += __shfl_xor(sq, 32); if (fq == 0) unsafeAtomicAdd(ss + row, sq); } }
                asm volatile("" ::: "memory");
            }
    }
};
template <bool BASE_F32> struct EpiResB {
    static constexpr bool AFTER_DRAIN = false;
    const float* basef; bf16_t* xb; float* ss; float scale;
    __device__ __forceinline__ void operator()(const Acc& acc, const Unit& u, int wr, int wc, int fr, int fq) const {
        const int row0 = u.pm * BM + wr * 64 + fr, col0 = u.pn * BM + wc * 32 + fq * 8;
#pragma unroll
        for (int ai = 0; ai < 2; ++ai) {
            f32x4 of[4][2][2]; u32x4 ob[4][2];
#pragma unroll
            for (int m = 0; m < 4; ++m)
#pragma unroll
                for (int bj = 0; bj < 2; ++bj) { const size_t p = (size_t)(row0 + ai * HALF + m * 16) * DM + col0 + bj * HALF;
                    if (BASE_F32) { of[m][bj][0] = *(const f32x4*)(basef + p); of[m][bj][1] = *(const f32x4*)(basef + p + 4); } else ob[m][bj] = *(const u32x4*)(xb + p); }
#pragma unroll
            for (int m = 0; m < 4; ++m) { const int row = row0 + ai * HALF + m * 16; float sq = 0.f;
#pragma unroll
                for (int bj = 0; bj < 2; ++bj) { const size_t p = (size_t)row * DM + col0 + bj * HALF; f32x4 o0, o1;
                    if (BASE_F32) { o0 = of[m][bj][0]; o1 = of[m][bj][1]; }
                    else { const u32x4 w = ob[m][bj]; o0 = (f32x4){bflo(w.x), bfhi(w.x), bflo(w.y), bfhi(w.y)}; o1 = (f32x4){bflo(w.z), bfhi(w.z), bflo(w.w), bfhi(w.w)}; }
                    const f32x4 n0 = o0 + acc[ai][bj][m][0] * scale, n1 = o1 + acc[ai][bj][m][1] * scale;
                    *(u32x4*)(xb + p) = pack8(n0, n1);
                    sq += (n0[0] * n0[0] + n0[1] * n0[1]) + (n0[2] * n0[2] + n0[3] * n0[3]) + (n1[0] * n1[0] + n1[1] * n1[1]) + (n1[2] * n1[2] + n1[3] * n1[3]); }
                sq += __shfl_xor(sq, 16); sq += __shfl_xor(sq, 32); if (fq == 0) unsafeAtomicAdd(ss + row, sq); }
            asm volatile("" ::: "memory"); }
    }
};
struct EpiQKV {
    static constexpr bool AFTER_DRAIN = false;
    bf16_t *QN, *KVN, *QF, *KVF, *GAB; float* F32S; const LAS float* aux;
    __device__ __forceinline__ void operator()(const Acc& acc, const Unit& u, int wr, int wc, int fr, int fq) const {
        const int row0 = u.pm * BM + wr * 64 + fr, pn = u.pn;
        if (pn == 19) {
            if (wc == 0) {
#pragma unroll
                for (int ai = 0; ai < 2; ++ai)
#pragma unroll
                    for (int m = 0; m < 4; ++m) { const int row = row0 + ai * HALF + m * 16; const float rs = rstd_of(aux[u.ui * 256 + wr * 64 + fr + ai * HALF + m * 16]);
                        *(f32x4*)(F32S + (size_t)row * 32 + fq * 8) = acc[ai][0][m][0] * rs; *(f32x4*)(F32S + (size_t)row * 32 + fq * 8 + 4) = acc[ai][0][m][1] * rs; }
            }
            return;
        }
        bf16_t* dst; int pitch, coff;
        if (pn < 2) { dst = QN; pitch = 512; coff = pn * 256; }
        else if (pn < 5) { dst = KVN; pitch = 768; coff = (pn - 2) * 256; }
        else if (pn < 7) { dst = QF; pitch = 512; coff = (pn - 5) * 256; }
        else if (pn < 11) { dst = KVF; pitch = 1024; coff = (pn - 7) * 256; }
        else { dst = GAB; pitch = 2048; coff = (pn - 11) * 256; }
        coff += wc * 32 + fq * 8;
        float rsv[2][4];
#pragma unroll
        for (int ai = 0; ai < 2; ++ai)
#pragma unroll
            for (int m = 0; m < 4; ++m) rsv[ai][m] = aux[u.ui * 256 + wr * 64 + fr + ai * HALF + m * 16];
#pragma unroll
        for (int ai = 0; ai < 2; ++ai)
#pragma unroll
            for (int m = 0; m < 4; ++m) { const int row = row0 + ai * HALF + m * 16; const float rs = rstd_of(rsv[ai][m]);
#pragma unroll
                for (int bj = 0; bj < 2; ++bj) *(u32x4*)(dst + (size_t)row * pitch + coff + bj * HALF) = pack8(acc[ai][bj][m][0] * rs, acc[ai][bj][m][1] * rs); }
    }
};
template <int STEP> struct EpiUp {
    static constexpr bool AFTER_DRAIN = false;
    const bf16_t* GAB; bf16_t* Y;
    __device__ __forceinline__ void operator()(const Acc& acc, const Unit& u, int wr, int wc, int fr, int fq) const {
        const int row0 = u.pm * BM + wr * 64 + fr, col0 = u.pn * BM + wc * 32 + fq * 8;
#pragma unroll
        for (int ai = 0; ai < 2; ++ai) {
            u32x4 gw[4][2], yw[4][2];
#pragma unroll
            for (int m = 0; m < 4; ++m)
#pragma unroll
                for (int bj = 0; bj < 2; ++bj) { const int row = row0 + ai * HALF + m * 16, c = col0 + bj * HALF;
                    gw[m][bj] = *(const u32x4*)(GAB + (size_t)row * 2048 + STEP * 1024 + c); if (STEP == 1) yw[m][bj] = *(const u32x4*)(Y + (size_t)row * DM + c); }
#pragma unroll
            for (int m = 0; m < 4; ++m)
#pragma unroll
                for (int bj = 0; bj < 2; ++bj) { const int row = row0 + ai * HALF + m * 16, c = col0 + bj * HALF; const u32x4 g4 = gw[m][bj];
                    f32x4 v0, v1; const f32x4 a0 = acc[ai][bj][m][0], a1 = acc[ai][bj][m][1];
                    v0[0] = sigmoidf_(bflo(g4.x)) * a0[0]; v0[1] = sigmoidf_(bfhi(g4.x)) * a0[1]; v0[2] = sigmoidf_(bflo(g4.y)) * a0[2]; v0[3] = sigmoidf_(bfhi(g4.y)) * a0[3];
                    v1[0] = sigmoidf_(bflo(g4.z)) * a1[0]; v1[1] = sigmoidf_(bfhi(g4.z)) * a1[1]; v1[2] = sigmoidf_(bflo(g4.w)) * a1[2]; v1[3] = sigmoidf_(bfhi(g4.w)) * a1[3];
                    if (STEP == 1) { const u32x4 y = yw[m][bj];
                        v0[0] += bflo(y.x); v0[1] += bfhi(y.x); v0[2] += bflo(y.y); v0[3] += bfhi(y.y); v1[0] += bflo(y.z); v1[1] += bfhi(y.z); v1[2] += bflo(y.w); v1[3] += bfhi(y.w); }
                    *(u32x4*)(Y + (size_t)row * DM + c) = pack8(v0, v1); }
            asm volatile("" ::: "memory"); }
    }
};
struct EpiRowScale {
    static constexpr bool AFTER_DRAIN = false;
    bf16_t* O; int ldo; const float* ss;
    __device__ __forceinline__ void operator()(const Acc& acc, const Unit& u, int wr, int wc, int fr, int fq) const {
        const int row0 = u.pm * BM + wr * 64 + fr, col0 = u.pn * BM + wc * 32 + fq * 8;
        float rsv[2][4];
#pragma unroll
        for (int ai = 0; ai < 2; ++ai)
#pragma unroll
            for (int m = 0; m < 4; ++m) rsv[ai][m] = ss[row0 + ai * HALF + m * 16];
#pragma unroll
        for (int ai = 0; ai < 2; ++ai)
#pragma unroll
            for (int m = 0; m < 4; ++m) { const int row = row0 + ai * HALF + m * 16; const float rs = rstd_of(rsv[ai][m]);
#pragma unroll
                for (int bj = 0; bj < 2; ++bj) *(u32x4*)(O + (size_t)row * ldo + col0 + bj * HALF) = pack8(acc[ai][bj][m][0] * rs, acc[ai][bj][m][1] * rs); }
    }
};
struct EpiColScale {
    static constexpr bool AFTER_DRAIN = false;
    bf16_t* O; int ldo; const float* ss;
    __device__ __forceinline__ void operator()(const Acc& acc, const Unit& u, int wr, int wc, int fr, int fq) const {
        const int row0 = u.pm * BM + wr * 64 + fr, col0 = u.pn * BM + wc * 32 + fq * 8;
#pragma unroll
        for (int bj = 0; bj < 2; ++bj) { const int c = col0 + bj * HALF;
            f32x4 s0 = *(const f32x4*)(ss + c), s1 = *(const f32x4*)(ss + c + 4);
#pragma unroll
            for (int j = 0; j < 4; ++j) { s0[j] = rstd_of(s0[j]); s1[j] = rstd_of(s1[j]); }
#pragma unroll
            for (int ai = 0; ai < 2; ++ai)
#pragma unroll
                for (int m = 0; m < 4; ++m) { const int row = row0 + ai * HALF + m * 16;
                    *(u32x4*)(O + (size_t)row * ldo + c) = pack8(acc[ai][bj][m][0] * s0, acc[ai][bj][m][1] * s1); } }
    }
};
struct EpiBatchBf16 {
    static constexpr bool AFTER_DRAIN = false;
    bf16_t* O; int ldo; long sOb, sOh;
    __device__ __forceinline__ void operator()(const Acc& acc, const Unit& u, int wr, int wc, int fr, int fq) const {
        const int row0 = u.pm * BM + wr * 64 + fr, col0 = u.pn * BM + wc * 32 + fq * 8;
        bf16_t* Ob = O + (size_t)((u.pb >> 2) * sOb + (u.pb & 3) * sOh);
#pragma unroll
        for (int ai = 0; ai < 2; ++ai)
#pragma unroll
            for (int m = 0; m < 4; ++m) { const int row = row0 + ai * HALF + m * 16;
#pragma unroll
                for (int bj = 0; bj < 2; ++bj) *(u32x4*)(Ob + (size_t)row * ldo + col0 + bj * HALF) = pack8(acc[ai][bj][m][0], acc[ai][bj][m][1]); }
    }
};
struct EpiSoftmax {
    static constexpr bool AFTER_DRAIN = true;
    bf16_t* P;
    __device__ __forceinline__ void fused(Acc& acc, const Unit& u, int wr, int wc, int fr, int fq, LAS unsigned char* lds, int wid, int lane) const {
        LAS float* Pm = (LAS float*)lds;
        LAS float* Ps = (LAS float*)(lds + 8192);
#pragma unroll
        for (int ai = 0; ai < 2; ++ai)
#pragma unroll
            for (int m = 0; m < 4; ++m) { float mx = -3.0e38f;
#pragma unroll
                for (int bj = 0; bj < 2; ++bj)
#pragma unroll
                    for (int n = 0; n < 2; ++n) { const f32x4 x = acc[ai][bj][m][n]; mx = fmaxf(mx, fmaxf(fmaxf(x[0], x[1]), fmaxf(x[2], x[3]))); }
                mx = fmaxf(mx, __shfl_xor(mx, 16)); mx = fmaxf(mx, __shfl_xor(mx, 32));
                if (fq == 0) Pm[(ai * HALF + wr * 64 + m * 16 + fr) * 4 + wc] = mx; }
        __syncthreads();
#pragma unroll
        for (int ai = 0; ai < 2; ++ai)
#pragma unroll
            for (int m = 0; m < 4; ++m) { const int r = ai * HALF + wr * 64 + m * 16 + fr; const f32x4 t = *(const LAS f32x4*)(Pm + r * 4);
                const float mx = fmaxf(fmaxf(t[0], t[1]), fmaxf(t[2], t[3])); float s = 0.f;
#pragma unroll
                for (int bj = 0; bj < 2; ++bj)
#pragma unroll
                    for (int n = 0; n < 2; ++n) { f32x4 x = acc[ai][bj][m][n];
#pragma unroll
                        for (int j = 0; j < 4; ++j) { x[j] = fexp2(x[j] - mx); s += x[j]; }
                        acc[ai][bj][m][n] = x; }
                s += __shfl_xor(s, 16); s += __shfl_xor(s, 32);
                if (fq == 0) Ps[r * 4 + wc] = s; }
        __syncthreads();
        bf16_t* Pb = P + (size_t)u.pb * SEQ * 256;
        const int col0 = wc * 32 + fq * 8;
#pragma unroll
        for (int ai = 0; ai < 2; ++ai)
#pragma unroll
            for (int m = 0; m < 4; ++m) { const int r = ai * HALF + wr * 64 + m * 16 + fr; const f32x4 t = *(const LAS f32x4*)(Ps + r * 4);
                const float inv = frcp((t[0] + t[1]) + (t[2] + t[3])); const int row = u.pm * BM + r;
#pragma unroll
                for (int bj = 0; bj < 2; ++bj) *(u32x4*)(Pb + (size_t)row * 256 + col0 + bj * HALF) = pack8(acc[ai][bj][m][0] * inv, acc[ai][bj][m][1] * inv); }
        __syncthreads();
    }
};
struct EpiSoftmaxRS {
    static constexpr bool AFTER_DRAIN = true;
    bf16_t* P; int ldp; const float* ss;
    __device__ __forceinline__ void fused(Acc& acc, const Unit& u, int wr, int wc, int fr, int fq, LAS unsigned char* lds, int wid, int lane) const {
        LAS float* Pm = (LAS float*)lds; LAS float* Ps = (LAS float*)(lds + 8192);
#pragma unroll
        for (int ai = 0; ai < 2; ++ai)
#pragma unroll
            for (int m = 0; m < 4; ++m) { const float rs = rstd_of(ss[u.pm * BM + ai * HALF + wr * 64 + m * 16 + fr]); float mx = -3.0e38f;
#pragma unroll
                for (int bj = 0; bj < 2; ++bj)
#pragma unroll
                    for (int n = 0; n < 2; ++n) { const f32x4 x = acc[ai][bj][m][n] * rs; acc[ai][bj][m][n] = x; mx = fmaxf(mx, fmaxf(fmaxf(x[0], x[1]), fmaxf(x[2], x[3]))); }
                mx = fmaxf(mx, __shfl_xor(mx, 16)); mx = fmaxf(mx, __shfl_xor(mx, 32));
                if (fq == 0) Pm[(ai * HALF + wr * 64 + m * 16 + fr) * 4 + wc] = mx; }
        __syncthreads();
#pragma unroll
        for (int ai = 0; ai < 2; ++ai)
#pragma unroll
            for (int m = 0; m < 4; ++m) { const int r = ai * HALF + wr * 64 + m * 16 + fr; const f32x4 t = *(const LAS f32x4*)(Pm + r * 4);
                const float mx = fmaxf(fmaxf(t[0], t[1]), fmaxf(t[2], t[3])); float s = 0.f;
#pragma unroll
                for (int bj = 0; bj < 2; ++bj)
#pragma unroll
                    for (int n = 0; n < 2; ++n) { f32x4 x = acc[ai][bj][m][n];
#pragma unroll
                        for (int j = 0; j < 4; ++j) { x[j] = fexp2(x[j] - mx); s += x[j]; }
                        acc[ai][bj][m][n] = x; }
                s += __shfl_xor(s, 16); s += __shfl_xor(s, 32);
                if (fq == 0) Ps[r * 4 + wc] = s; }
        __syncthreads();
        const int col0 = u.pn * BM + wc * 32 + fq * 8;
#pragma unroll
        for (int ai = 0; ai < 2; ++ai)
#pragma unroll
            for (int m = 0; m < 4; ++m) { const int r = ai * HALF + wr * 64 + m * 16 + fr; const f32x4 t = *(const LAS f32x4*)(Ps + r * 4);
                const float inv = frcp((t[0] + t[1]) + (t[2] + t[3])); const int row = u.pm * BM + r;
#pragma unroll
                for (int bj = 0; bj < 2; ++bj) *(u32x4*)(P + (size_t)row * ldp + col0 + bj * HALF) = pack8(acc[ai][bj][m][0] * inv, acc[ai][bj][m][1] * inv); }
        __syncthreads();
    }
};
struct EpiResNorm {
    static constexpr bool AFTER_DRAIN = true;
    const bf16_t* Xold; float* out; float scale; const float* gn; float* xbuf; unsigned* cnt;
    __device__ __forceinline__ void fused(Acc& acc, const Unit& u, int wr, int wc, int fr, int fq, LAS unsigned char* lds, int wid, int lane) const {
        LAS float* P = (LAS float*)lds;
        LAS float* S = (LAS float*)(lds + 4096);
        const int row0 = u.pm * BM + wr * 64 + fr, col0 = u.pn * BM + wc * 32 + fq * 8;
#pragma unroll
        for (int ai = 0; ai < 2; ++ai)
#pragma unroll
            for (int m = 0; m < 4; ++m) { const int row = row0 + ai * HALF + m * 16; float sq = 0.f;
#pragma unroll
                for (int bj = 0; bj < 2; ++bj) { const size_t p = (size_t)row * DM + col0 + bj * HALF;
                    const u32x4 w = *(const u32x4*)(Xold + p); const f32x4 o0 = {bflo(w.x), bfhi(w.x), bflo(w.y), bfhi(w.y)}, o1 = {bflo(w.z), bfhi(w.z), bflo(w.w), bfhi(w.w)};
                    const f32x4 n0 = o0 + acc[ai][bj][m][0] * scale, n1 = o1 + acc[ai][bj][m][1] * scale;
                    acc[ai][bj][m][0] = n0; acc[ai][bj][m][1] = n1;
                    sq += (n0[0] * n0[0] + n0[1] * n0[1]) + (n0[2] * n0[2] + n0[3] * n0[3]) + (n1[0] * n1[0] + n1[1] * n1[1]) + (n1[2] * n1[2] + n1[3] * n1[3]); }
                sq += __shfl_xor(sq, 16); sq += __shfl_xor(sq, 32);
                if (fq == 0) P[(ai * HALF + wr * 64 + m * 16 + fr) * 4 + wc] = sq;
                if (m & 1) asm volatile("" ::: "memory"); }
        __syncthreads();
        const int prow = wid * 32 + (lane & 31);
        if (lane < 32) { const f32x4 t = *(const LAS f32x4*)(P + prow * 4);
            __hip_atomic_store(xbuf + (size_t)(u.pm * BM + prow) * 4 + u.pn, (t[0] + t[1]) + (t[2] + t[3]), __ATOMIC_RELAXED, __HIP_MEMORY_SCOPE_AGENT); }
        asm volatile("s_waitcnt vmcnt(0)" ::: "memory");
        if (lane == 0) __hip_atomic_fetch_add(cnt + 64 * u.pm, 1u, __ATOMIC_RELAXED, __HIP_MEMORY_SCOPE_AGENT);
        if (wid == 0) { unsigned sp = 0;
            while ((unsigned)__builtin_amdgcn_readfirstlane(__hip_atomic_load(cnt + 64 * u.pm, __ATOMIC_RELAXED, __HIP_MEMORY_SCOPE_AGENT)) < 32u) { __builtin_amdgcn_s_sleep(2); if (++sp > (1u << 20)) break; }
            __builtin_amdgcn_fence(__ATOMIC_ACQUIRE, "agent"); }
        asm volatile("s_waitcnt vmcnt(0) lgkmcnt(0)" ::: "memory");
        __syncthreads();
        if (lane < 32) { const float* sl = xbuf + (size_t)(u.pm * BM + prow) * 4; float s = 0.f;
#pragma unroll
            for (int t = 0; t < 4; ++t) s += __hip_atomic_load(sl + t, __ATOMIC_RELAXED, __HIP_MEMORY_SCOPE_AGENT);
            S[prow] = rstd_of(s); }
        __syncthreads();
        f32x4 gg[2][2];
#pragma unroll
        for (int bj = 0; bj < 2; ++bj) { gg[bj][0] = *(const f32x4*)(gn + col0 + bj * HALF); gg[bj][1] = *(const f32x4*)(gn + col0 + bj * HALF + 4); }
#pragma unroll
        for (int ai = 0; ai < 2; ++ai)
#pragma unroll
            for (int m = 0; m < 4; ++m) { const int r = ai * HALF + wr * 64 + m * 16 + fr; const float rs = S[r]; const size_t p0 = (size_t)(u.pm * BM + r) * DM + col0;
#pragma unroll
                for (int bj = 0; bj < 2; ++bj) { *(f32x4*)(out + p0 + bj * HALF) = acc[ai][bj][m][0] * rs * gg[bj][0]; *(f32x4*)(out + p0 + bj * HALF + 4) = acc[ai][bj][m][1] * rs * gg[bj][1]; } }
    }
};
}
namespace att {
__device__ __forceinline__ int crow(int r, int hi) { return (r & 3) + 8 * (r >> 2) + 4 * hi; }
#define SBAR() __builtin_amdgcn_sched_barrier(0)
constexpr float NEG = -INFINITY;
constexpr int L_SLOT = 0;
constexpr int L_VR = 24576;
constexpr int L_WSF = 49152;
constexpr int L_OST = L_WSF + 2048;
constexpr int L_TBL = L_OST + 32768;
constexpr int L_CB = L_TBL + 4096;
constexpr int L_PS = L_CB + 8192;
constexpr int L_IMP = L_PS + 4 * 64 * 33 * 4;
constexpr int L_MISC = L_IMP + 64 * 33 * 4;
constexpr int L_END = L_MISC + 64 + 256 + 64 + 64;
static_assert(L_END <= 147456 - 256, "attention LDS map");

__device__ __forceinline__ void qkt(f32x16& p0, f32x16& p1, const LAS unsigned char* Kslot, const bf16x8 (&qr)[4], int r32, int hi) {
    const LAS unsigned char* kb = Kslot + hi * 1024 + r32 * 16;
    p0 = f32x16{}; p1 = f32x16{};
#pragma unroll
    for (int d0 = 0; d0 < 4; ++d0) {
        const bf16x8 b0 = *(const LAS bf16x8*)(kb + d0 * 2048);
        const bf16x8 b1 = *(const LAS bf16x8*)(kb + d0 * 2048 + 512);
        p0 = __builtin_amdgcn_mfma_f32_32x32x16_bf16(b0, qr[d0], p0, 0, 0, 0);
        p1 = __builtin_amdgcn_mfma_f32_32x32x16_bf16(b1, qr[d0], p1, 0, 0, 0);
    }
}
__device__ __forceinline__ void pv(f32x16 (&o)[2], int vb, bf16x8 pa0, bf16x8 pa1, bf16x8 pa2, bf16x8 pa3) {
#pragma unroll
    for (int d0 = 0; d0 < 2; ++d0) { s16x4 lo[4], hi[4];
#pragma unroll
        for (int ks = 0; ks < 4; ++ks) {
            asm volatile("ds_read_b64_tr_b16 %0,%1 offset:%c2" : "=&v"(lo[ks]) : "v"(vb), "i"(d0 * 4096 + ks * 1024) : "memory");
            asm volatile("ds_read_b64_tr_b16 %0,%1 offset:%c2" : "=&v"(hi[ks]) : "v"(vb), "i"(d0 * 4096 + ks * 1024 + 512) : "memory"); }
        asm volatile("s_waitcnt lgkmcnt(0)" ::: "memory"); SBAR();
#define PK(k) (bf16x8){lo[k][0], lo[k][1], lo[k][2], lo[k][3], hi[k][0], hi[k][1], hi[k][2], hi[k][3]}
        o[d0] = __builtin_amdgcn_mfma_f32_32x32x16_bf16(pa0, PK(0), o[d0], 0, 0, 0);
        o[d0] = __builtin_amdgcn_mfma_f32_32x32x16_bf16(pa1, PK(1), o[d0], 0, 0, 0);
        o[d0] = __builtin_amdgcn_mfma_f32_32x32x16_bf16(pa2, PK(2), o[d0], 0, 0, 0);
        o[d0] = __builtin_amdgcn_mfma_f32_32x32x16_bf16(pa3, PK(3), o[d0], 0, 0, 0);
#undef PK
    }
}
__device__ __forceinline__ float rowmax32(const f32x16& p0, const f32x16& p1) {
    float a = fmaxf(p0[0], p1[0]);
#pragma unroll
    for (int r = 1; r < 16; ++r) a = fmaxf(a, fmaxf(p0[r], p1[r]));
    auto rr = __builtin_amdgcn_permlane32_swap(__float_as_uint(a), __float_as_uint(a), false, false);
    return fmaxf(__uint_as_float(rr[0]), __uint_as_float(rr[1]));
}
__device__ __forceinline__ float halfsum(float v) {
    auto rr = __builtin_amdgcn_permlane32_swap(__float_as_uint(v), __float_as_uint(v), false, false);
    return __uint_as_float(rr[0]) + __uint_as_float(rr[1]);
}
#define PKW(P, B) cvtpk(P[B], P[B + 1])
__device__ __forceinline__ void pack_p(const f32x16& p0, const f32x16& p1, bf16x8& a0, bf16x8& a1, bf16x8& a2, bf16x8& a3) {
    const u32x4 w0 = {PKW(p0, 0), PKW(p0, 2), PKW(p0, 4), PKW(p0, 6)}, w1 = {PKW(p0, 8), PKW(p0, 10), PKW(p0, 12), PKW(p0, 14)};
    const u32x4 w2 = {PKW(p1, 0), PKW(p1, 2), PKW(p1, 4), PKW(p1, 6)}, w3 = {PKW(p1, 8), PKW(p1, 10), PKW(p1, 12), PKW(p1, 14)};
    a0 = __builtin_bit_cast(bf16x8, w0); a1 = __builtin_bit_cast(bf16x8, w1); a2 = __builtin_bit_cast(bf16x8, w2); a3 = __builtin_bit_cast(bf16x8, w3);
}
#undef PKW
__device__ __forceinline__ void scale_rows(f32x16 (&o)[2], LAS float* wsf, float v, int r32, int hi) {
    if (hi == 0) wsf[r32] = v;
    asm volatile("s_waitcnt lgkmcnt(0)" ::: "memory");
#pragma unroll
    for (int i = 0; i < 4; ++i) { const f32x4 f = *(const LAS f32x4*)(wsf + 8 * i + 4 * hi);
#pragma unroll
        for (int j = 0; j < 4; ++j) { o[0][4 * i + j] *= f[j]; o[1][4 * i + j] *= f[j]; } }
    asm volatile("s_waitcnt lgkmcnt(0)" ::: "memory");
}
struct StageGeo { int krow, kcol, koff, vrow, vcol, voff; };
__device__ __forceinline__ StageGeo stage_geo(int tid) {
    StageGeo s; const int w = tid >> 6, ln = tid & 63;
    s.krow = ln; s.kcol = w * 8; s.koff = w * 1024 + ln * 16;
    s.vrow = 16 * (w & 3) + (ln >> 2); s.vcol = (w >> 2) * 32 + (ln & 3) * 8; s.voff = 8192 + w * 1024 + ln * 16;
    return s;
}
template <class Mod>
__device__ __forceinline__ void tile_step(const LAS unsigned char* slot, const bf16x8 (&qr)[4], f32x16 (&o)[2], float& m, float& l, LAS float* wsf, const Mod& mod, int r32, int hi, int vb) {
    f32x16 p0, p1;
    qkt(p0, p1, slot, qr, r32, hi);
    mod(p0, p1);
    const float rm = rowmax32(p0, p1);
    const float mn = fmaxf(m, rm);
    const float alpha = fexp2(m - mn);
    const bool need = __any(mn > m);
    m = mn;
    float s = 0.f;
#pragma unroll
    for (int r = 0; r < 16; ++r) { p0[r] = fexp2(p0[r] - mn); p1[r] = fexp2(p1[r] - mn); s += p0[r] + p1[r]; }
    l = l * alpha + s;
    if (need) scale_rows(o, wsf, alpha, r32, hi);
    bf16x8 a0, a1, a2, a3; pack_p(p0, p1, a0, a1, a2, a3);
    pv(o, vb, a0, a1, a2, a3);
}
template <class ModF>
__device__ __forceinline__ void attn_loop(unsigned tmask, const bf16_t* Kg, int pitchK, const bf16_t* Vg, int pitchV, LAS unsigned char* lds, const bf16x8 (&qr)[4],
                                          f32x16 (&o)[2], float& m, float& l, const ModF& modf, int wave_last_row) {
    const int tid = fresh_tid(), lane = tid & 63, r32 = lane & 31, hi = lane >> 5, wid = tid >> 6;
    const StageGeo sg = stage_geo(tid);
    LAS float* wsf = (LAS float*)(lds + L_WSF) + wid * 64;
    const int vb0 = (int)(unsigned)(size_t)(lds + L_SLOT + 8192) + ((lane >> 4) & 1) * 32 + (lane & 3) * 8 + (4 * hi + ((lane & 15) >> 2)) * 64;
    int kt = 31 - __clz((int)tmask);
    u32x4 kreg = *(const u32x4*)(Kg + (size_t)(kt * 64 + sg.krow) * pitchK + sg.kcol);
    u32x4 vreg = *(const u32x4*)(Vg + (size_t)(kt * 64 + sg.vrow) * pitchV + sg.vcol);
    *(LAS u32x4*)(lds + L_SLOT + sg.koff) = kreg; *(LAS u32x4*)(lds + L_SLOT + sg.voff) = vreg;
    __syncthreads();
    int s = 0;
    for (;;) {
        tmask &= ~(1u << kt);
        const int nk = tmask ? 31 - __clz((int)tmask) : -1;
        if (nk >= 0) { kreg = *(const u32x4*)(Kg + (size_t)(nk * 64 + sg.krow) * pitchK + sg.kcol); vreg = *(const u32x4*)(Vg + (size_t)(nk * 64 + sg.vrow) * pitchV + sg.vcol); }
        if (kt * 64 <= wave_last_row) tile_step(lds + L_SLOT + s * 16384, qr, o, m, l, wsf, modf(kt), r32, hi, vb0 + s * 16384);
        if (nk >= 0) { *(LAS u32x4*)(lds + L_SLOT + (s ^ 1) * 16384 + sg.koff) = kreg; *(LAS u32x4*)(lds + L_SLOT + (s ^ 1) * 16384 + sg.voff) = vreg; }
        __syncthreads();
        if (nk < 0) break;
        kt = nk; s ^= 1;
    }
}
template <bool ADD>
__device__ __forceinline__ void store_o(const f32x16 (&o)[2], LAS unsigned char* lds, bf16_t* dst, int pitch, const bf16_t* addsrc, int addpitch) {
    const int tid = fresh_tid(), lane = tid & 63, r32 = lane & 31, hi = lane >> 5, wid = tid >> 6;
    LAS bf16_t* stg = (LAS bf16_t*)(lds + L_OST) + wid * 2048;
#pragma unroll
    for (int r = 0; r < 16; ++r) { const int orow = crow(r, hi);
#pragma unroll
        for (int d0 = 0; d0 < 2; ++d0) stg[orow * 64 + d0 * 32 + r32] = (bf16_t)(cvtpk(o[d0][r], 0.f) & 0xffffu); }
    asm volatile("s_waitcnt lgkmcnt(0)" ::: "memory");
#pragma unroll
    for (int i = 0; i < 4; ++i) { const int row = i * 8 + (lane >> 3), ch = lane & 7;
        u32x4 v = *(const LAS u32x4*)(stg + row * 64 + ch * 8);
        if (ADD) { const u32x4 a = *(const u32x4*)(addsrc + (size_t)row * addpitch + ch * 8);
            v.x = cvtpk(bflo(v.x) + bflo(a.x), bfhi(v.x) + bfhi(a.x)); v.y = cvtpk(bflo(v.y) + bflo(a.y), bfhi(v.y) + bfhi(a.y));
            v.z = cvtpk(bflo(v.z) + bflo(a.z), bfhi(v.z) + bfhi(a.z)); v.w = cvtpk(bflo(v.w) + bflo(a.w), bfhi(v.w) + bfhi(a.w)); }
        *(u32x4*)(dst + (size_t)row * pitch + ch * 8) = v; }
    asm volatile("s_waitcnt lgkmcnt(0)" ::: "memory");
}
__device__ __forceinline__ void load_q(bf16x8 (&qr)[4], const bf16_t* Qw, int pitch, int r32, int hi) {
#pragma unroll
    for (int d0 = 0; d0 < 4; ++d0) qr[d0] = *(const bf16x8*)(Qw + (size_t)r32 * pitch + d0 * 16 + hi * 8);
}

struct ModFox { const LAS float* cb; int kbase, qpos, hi; bool diag;
    __device__ __forceinline__ void operator()(f32x16& p0, f32x16& p1) const {
#pragma unroll
        for (int i = 0; i < 4; ++i) { const f32x4 c0 = *(const LAS f32x4*)(cb + kbase + 8 * i + 4 * hi), c1 = *(const LAS f32x4*)(cb + kbase + 32 + 8 * i + 4 * hi);
#pragma unroll
            for (int j = 0; j < 4; ++j) { p0[4 * i + j] += c0[j]; p1[4 * i + j] += c1[j]; } }
        if (diag) {
#pragma unroll
            for (int r = 0; r < 16; ++r) { const int kv = kbase + crow(r, hi); if (kv > qpos) p0[r] = NEG; if (kv + 32 > qpos) p1[r] = NEG; } }
    } };
struct ModFoxF { const LAS float* cb; int qpos, hi, q0w;
    __device__ __forceinline__ ModFox operator()(int kt) const { return ModFox{cb, kt * 64, qpos, hi, kt * 64 + 63 > q0w}; } };
struct ModT5 { const LAS float* tb; int kbase, qpos, hi, window; bool enabled;
    __device__ __forceinline__ void operator()(f32x16& p0, f32x16& p1) const {
#pragma unroll
        for (int r = 0; r < 16; ++r) { const int d0 = qpos - (kbase + crow(r, hi)), d1 = d0 - 32;
            const float b0 = tb[min(max(d0, 0), 127)], b1 = tb[min(max(d1, 0), 127)];
            p0[r] = (enabled && d0 >= 0 && d0 < window) ? p0[r] + b0 : NEG;
            p1[r] = (enabled && d1 >= 0 && d1 < window) ? p1[r] + b1 : NEG; }
    } };
struct ModWinF { const LAS float* tb; int qpos, hi;
    __device__ __forceinline__ ModT5 operator()(int kt) const { return ModT5{tb, kt * 64, qpos, hi, 512, true}; } };
struct ModSelF { const LAS float* tb; int qpos, hi; unsigned mask;
    __device__ __forceinline__ ModT5 operator()(int kt) const { return ModT5{tb, kt * 64, qpos, hi, 1 << 30, ((mask >> kt) & 1u) != 0u}; } };

typedef short v4i16_t __attribute__((ext_vector_type(4)));
__device__ __forceinline__ s16x4 vtr(const LAS unsigned char* p) { return __builtin_bit_cast(s16x4, __builtin_amdgcn_ds_read_tr16_b64_v4i16((LAS v4i16_t*)p)); }
__device__ __forceinline__ void qkt_c(f32x16& p0, f32x16& p1, const LAS unsigned char* Kslot, const bf16x8 (&qr)[4], const f32x16& c0, const f32x16& c1, int r32, int hi) {
    const LAS unsigned char* kb = Kslot + hi * 1024 + r32 * 16;
    { const bf16x8 b0 = *(const LAS bf16x8*)(kb); const bf16x8 b1 = *(const LAS bf16x8*)(kb + 512);
      p0 = __builtin_amdgcn_mfma_f32_32x32x16_bf16(b0, qr[0], c0, 0, 0, 0); p1 = __builtin_amdgcn_mfma_f32_32x32x16_bf16(b1, qr[0], c1, 0, 0, 0); }
#pragma unroll
    for (int d0 = 1; d0 < 4; ++d0) {
        const bf16x8 b0 = *(const LAS bf16x8*)(kb + d0 * 2048); const bf16x8 b1 = *(const LAS bf16x8*)(kb + d0 * 2048 + 512);
        p0 = __builtin_amdgcn_mfma_f32_32x32x16_bf16(b0, qr[d0], p0, 0, 0, 0); p1 = __builtin_amdgcn_mfma_f32_32x32x16_bf16(b1, qr[d0], p1, 0, 0, 0); }
}
__device__ __forceinline__ void pv2(f32x16 (&o)[2], const LAS unsigned char* vp, bf16x8 pa0, bf16x8 pa1, bf16x8 pa2, bf16x8 pa3) {
    s16x4 lo[2][4], hi[2][4];
#pragma unroll
    for (int ks = 0; ks < 4; ++ks)
#pragma unroll
        for (int d0 = 0; d0 < 2; ++d0) { lo[d0][ks] = vtr(vp + d0 * 4096 + ks * 1024); hi[d0][ks] = vtr(vp + d0 * 4096 + ks * 1024 + 512); }
#define PK(d, k) (bf16x8){lo[d][k][0], lo[d][k][1], lo[d][k][2], lo[d][k][3], hi[d][k][0], hi[d][k][1], hi[d][k][2], hi[d][k][3]}
    o[0] = __builtin_amdgcn_mfma_f32_32x32x16_bf16(pa0, PK(0, 0), o[0], 0, 0, 0); o[1] = __builtin_amdgcn_mfma_f32_32x32x16_bf16(pa0, PK(1, 0), o[1], 0, 0, 0);
    o[0] = __builtin_amdgcn_mfma_f32_32x32x16_bf16(pa1, PK(0, 1), o[0], 0, 0, 0); o[1] = __builtin_amdgcn_mfma_f32_32x32x16_bf16(pa1, PK(1, 1), o[1], 0, 0, 0);
    o[0] = __builtin_amdgcn_mfma_f32_32x32x16_bf16(pa2, PK(0, 2), o[0], 0, 0, 0); o[1] = __builtin_amdgcn_mfma_f32_32x32x16_bf16(pa2, PK(1, 2), o[1], 0, 0, 0);
    o[0] = __builtin_amdgcn_mfma_f32_32x32x16_bf16(pa3, PK(0, 3), o[0], 0, 0, 0); o[1] = __builtin_amdgcn_mfma_f32_32x32x16_bf16(pa3, PK(1, 3), o[1], 0, 0, 0);
#undef PK
}
__device__ __forceinline__ float rowmax32b(const f32x16& p0, const f32x16& p1) {
    float a = __builtin_fmaxf(__builtin_fmaxf(p0[0], p0[1]), p1[0]), b = __builtin_fmaxf(__builtin_fmaxf(p0[2], p0[3]), p1[1]); a = __builtin_fmaxf(__builtin_fmaxf(a, p1[2]), p1[3]);
#pragma unroll
    for (int r = 4; r < 16; r += 4) { a = __builtin_fmaxf(__builtin_fmaxf(a, p0[r]), p0[r + 1]); b = __builtin_fmaxf(__builtin_fmaxf(b, p0[r + 2]), p0[r + 3]);
        a = __builtin_fmaxf(__builtin_fmaxf(a, p1[r]), p1[r + 1]); b = __builtin_fmaxf(__builtin_fmaxf(b, p1[r + 2]), p1[r + 3]); }
    const float m = __builtin_fmaxf(a, b);
    auto rr = __builtin_amdgcn_permlane32_swap(__float_as_uint(m), __float_as_uint(m), false, false);
    return __builtin_fmaxf(__uint_as_float(rr[0]), __uint_as_float(rr[1]));
}
constexpr float DEFER_THR = 6.0f;
#ifndef ATT_GRP
#define ATT_GRP(w) ((w) >> 2)
#endif
template <int ABL, class TF>
__device__ __forceinline__ void sm_pv(f32x16& sc0, f32x16& sc1, f32x16& sn0, f32x16& sn1, bool adjust_next, int kt, int par, bool& first, float& mref, float& l, f32x16 (&o)[2],
                                      LAS float* wsf, const LAS unsigned char* vp0, const TF& tf, int r32, int hi) {
    if (ABL & 16) { o[0][1] += sc0[3] + sc1[5]; return; }
    tf.post(kt, sc0, sc1);
    const float rm = rowmax32b(sc0, sc1);
    if (__any(first || rm > DEFER_THR)) {
        const float delta = first ? (rm == NEG ? 0.f : rm) : __builtin_fmaxf(rm, 0.f);
        mref += delta;
#pragma unroll
        for (int r = 0; r < 16; ++r) { sc0[r] -= delta; sc1[r] -= delta; }
        if (adjust_next) {
#pragma unroll
            for (int r = 0; r < 16; ++r) { sn0[r] -= delta; sn1[r] -= delta; } }
        const float f = fexp2(-delta); l *= f;
        if (!first) scale_rows(o, wsf, f, r32, hi);
        first = false;
    }
    float s = 0.f;
#pragma unroll
    for (int r = 0; r < 16; ++r) { if (!(ABL & 1)) { sc0[r] = fexp2(sc0[r]); sc1[r] = fexp2(sc1[r]); } s += sc0[r] + sc1[r]; }
    l += s;
    bf16x8 a0, a1, a2, a3; pack_p(sc0, sc1, a0, a1, a2, a3);
    if (!(ABL & 2)) pv2(o, vp0 + par * 8192, a0, a1, a2, a3); else { o[0][0] += __builtin_bit_cast(f32x4, a0)[0] + __builtin_bit_cast(f32x4, a3)[3]; }
}
__device__ __forceinline__ void qk_exp(f32x16& n0, f32x16& n1, f32x16& s0, f32x16& s1, const f32x16& c0, const f32x16& c1, const LAS unsigned char* Kslot, const bf16x8 (&qr)[4],
                                       float& l, bf16x8& a0, bf16x8& a1, bf16x8& a2, bf16x8& a3, int r32, int hi) {
    const LAS unsigned char* kb = Kslot + hi * 1024 + r32 * 16;
    bf16x8 kf[8];
#pragma unroll
    for (int d0 = 0; d0 < 4; ++d0) { kf[2 * d0] = *(const LAS bf16x8*)(kb + d0 * 2048); kf[2 * d0 + 1] = *(const LAS bf16x8*)(kb + d0 * 2048 + 512); }
    float s = 0.f; unsigned w[16];
#define QE_GAP(i, X, B) do { X[B] = fexp2(X[B]); X[B + 1] = fexp2(X[B + 1]); X[B + 2] = fexp2(X[B + 2]); X[B + 3] = fexp2(X[B + 3]); s += (X[B] + X[B + 1]) + (X[B + 2] + X[B + 3]); \
        w[2 * (i)] = cvtpk(X[B], X[B + 1]); w[2 * (i) + 1] = cvtpk(X[B + 2], X[B + 3]); SBAR(); } while (0)
    SBAR();
    n0 = __builtin_amdgcn_mfma_f32_32x32x16_bf16(kf[0], qr[0], c0, 0, 0, 0); QE_GAP(0, s0, 0);
    n1 = __builtin_amdgcn_mfma_f32_32x32x16_bf16(kf[1], qr[0], c1, 0, 0, 0); QE_GAP(1, s0, 4);
    n0 = __builtin_amdgcn_mfma_f32_32x32x16_bf16(kf[2], qr[1], n0, 0, 0, 0); QE_GAP(2, s0, 8);
    n1 = __builtin_amdgcn_mfma_f32_32x32x16_bf16(kf[3], qr[1], n1, 0, 0, 0); QE_GAP(3, s0, 12);
    n0 = __builtin_amdgcn_mfma_f32_32x32x16_bf16(kf[4], qr[2], n0, 0, 0, 0); QE_GAP(4, s1, 0);
    n1 = __builtin_amdgcn_mfma_f32_32x32x16_bf16(kf[5], qr[2], n1, 0, 0, 0); QE_GAP(5, s1, 4);
    n0 = __builtin_amdgcn_mfma_f32_32x32x16_bf16(kf[6], qr[3], n0, 0, 0, 0); QE_GAP(6, s1, 8);
    n1 = __builtin_amdgcn_mfma_f32_32x32x16_bf16(kf[7], qr[3], n1, 0, 0, 0); QE_GAP(7, s1, 12);
#undef QE_GAP
    l += s;
    const u32x4 w0 = {w[0], w[1], w[2], w[3]}, w1 = {w[4], w[5], w[6], w[7]}, w2 = {w[8], w[9], w[10], w[11]}, w3 = {w[12], w[13], w[14], w[15]};
    a0 = __builtin_bit_cast(bf16x8, w0); a1 = __builtin_bit_cast(bf16x8, w1); a2 = __builtin_bit_cast(bf16x8, w2); a3 = __builtin_bit_cast(bf16x8, w3);
}
__device__ __forceinline__ void glds16(const void* gsrc, unsigned lds_dst) { unsigned keep;
    asm volatile("s_mov_b32 %0, m0\n\ts_mov_b32 m0, %2\n\ts_nop 0\n\tglobal_load_lds_dwordx4 %1, off\n\ts_mov_b32 m0, %0" : "=&s"(keep) : "v"(gsrc), "s"(lds_dst) : "memory"); }
#define ATT_WAIT_BAR(N) asm volatile("s_waitcnt vmcnt(" #N ") lgkmcnt(0)\n\ts_barrier" ::: "memory")
template <int ABL = 0, class TF>
__device__ __forceinline__ void attn_loop2(unsigned tmask, const bf16_t* Kg, int pitchK, const bf16_t* Vg, int pitchV, LAS unsigned char* lds, const bf16x8 (&qr)[4],
                                           f32x16 (&o)[2], float& mref, float& l, const TF& tf, int wave_last_row) {
    const int tid = fresh_tid(), lane = tid & 63, r32 = lane & 31, hi = lane >> 5, wid = __builtin_amdgcn_readfirstlane(tid >> 6), grp = ATT_GRP(wid);
    LAS float* wsf = (LAS float*)(lds + L_WSF) + wid * 64;
    const LAS unsigned char* vp0 = lds + L_SLOT + L_VR + ((lane >> 4) & 1) * 32 + (lane & 3) * 8 + (4 * hi + ((lane & 15) >> 2)) * 64;
    const bf16_t* ksrc = Kg + (size_t)lane * pitchK + wid * 8;
    const bf16_t* vsrc = Vg + (size_t)(16 * (wid & 3) + (lane >> 2)) * pitchV + (wid >> 2) * 32 + (lane & 3) * 8;
    const unsigned ldsb = (unsigned)(size_t)(lds + L_SLOT) + (unsigned)wid * 1024u;
#define DMA_K(t, slot) glds16(ksrc + (size_t)(t) * 64 * pitchK, (unsigned)__builtin_amdgcn_readfirstlane(ldsb + (unsigned)(slot) * 8192u))
#define DMA_V(t, slot) glds16(vsrc + (size_t)(t) * 64 * pitchV, (unsigned)__builtin_amdgcn_readfirstlane(ldsb + (unsigned)L_VR + (unsigned)(slot) * 8192u))
#define NEXT_TILE(dst) do { if (tmask) { dst = 31 - __clz((int)tmask); tmask &= ~(1u << dst); } else dst = -1; } while (0)
    int t0, t1, t2, t3;
    NEXT_TILE(t0); NEXT_TILE(t1); NEXT_TILE(t2);
    const int tz = t0;
    DMA_K(t0, 0); DMA_V(t0, 0); DMA_K(t1 < 0 ? tz : t1, 1); DMA_V(t1 < 0 ? tz : t1, 1); DMA_K(t2 < 0 ? tz : t2, 2);
    ATT_WAIT_BAR(2);
    f32x16 sa0, sa1, sb0, sb1, cfar;
    bool first = true, seen = false;
    mref = 0.f; l = 0.f;
    const float fbias = tf.farbias();
#pragma unroll
    for (int r = 0; r < 16; ++r) cfar[r] = fbias;
    { f32x16 c0, c1; tf.cinit(t0, 0.f, c0, c1); qkt_c(sa0, sa1, lds + L_SLOT, qr, c0, c1, r32, hi); }
    asm volatile("s_waitcnt lgkmcnt(0)\n\ts_barrier" ::: "memory");
    int s0 = 0, s1 = 1, s2 = 2;
#define ATT_STEP(SC0, SC1, SN0, SN1) do { \
        NEXT_TILE(t3); \
        DMA_K((ABL & 128) || t3 < 0 ? tz : t3, s0); DMA_V((ABL & 128) || t2 < 0 ? tz : t2, s2); \
        const int t1c = t1 < 0 ? tz : t1; \
        tf.post(t0, SC0, SC1); \
        { const float rm = rowmax32b(SC0, SC1); \
          if (__any(first || rm > DEFER_THR || (!seen && rm != NEG))) { \
            const float delta = !seen ? (rm == NEG ? 0.f : rm) : __builtin_fmaxf(rm, 0.f);     \
            seen = seen || (rm != NEG); \
            mref += delta; \
            _Pragma("unroll") for (int r = 0; r < 16; ++r) { SC0[r] -= delta; SC1[r] -= delta; } \
            const float f = fexp2(-delta); l *= f; \
            if (!first) scale_rows(o, wsf, f, r32, hi); \
            _Pragma("unroll") for (int r = 0; r < 16; ++r) cfar[r] = fbias - mref; \
            first = false; } } \
        { bf16x8 a0, a1, a2, a3; \
          if (tf.far(t1c)) qk_exp(SN0, SN1, SC0, SC1, cfar, cfar, lds + L_SLOT + s1 * 8192, qr, l, a0, a1, a2, a3, r32, hi); \
          else { f32x16 c0, c1; tf.cinit(t1c, mref, c0, c1); qk_exp(SN0, SN1, SC0, SC1, c0, c1, lds + L_SLOT + s1 * 8192, qr, l, a0, a1, a2, a3, r32, hi); } \
          pv2(o, vp0 + s0 * 8192, a0, a1, a2, a3); } \
        ATT_WAIT_BAR(2); \
        t0 = t1; t1 = t2; t2 = t3; { const int s_ = s0; s0 = s1; s1 = s2; s2 = s_; } \
    } while (0)
    for (;;) {
        ATT_STEP(sa0, sa1, sb0, sb1); if (t0 < 0) break;
        ATT_STEP(sb0, sb1, sa0, sa1); if (t0 < 0) break;
    }
    asm volatile("s_waitcnt vmcnt(0)" ::: "memory");
    __syncthreads();
#undef ATT_STEP
#undef NEXT_TILE
#undef DMA_K
#undef DMA_V
}
struct TfFox { const LAS float* cb; int qpos, hi, q0w;
    __device__ __forceinline__ bool far(int) const { return false; }
    __device__ __forceinline__ float farbias() const { return 0.f; }
    __device__ __forceinline__ void cinit(int kt, float mref, f32x16& c0, f32x16& c1) const {
#pragma unroll
        for (int i = 0; i < 4; ++i) { const f32x4 a = *(const LAS f32x4*)(cb + kt * 64 + 8 * i + 4 * hi), b = *(const LAS f32x4*)(cb + kt * 64 + 32 + 8 * i + 4 * hi);
#pragma unroll
            for (int j = 0; j < 4; ++j) { c0[4 * i + j] = a[j] - mref; c1[4 * i + j] = b[j] - mref; } } }
    __device__ __forceinline__ void post(int kt, f32x16& p0, f32x16& p1) const {
        if (kt * 64 + 63 > q0w) {
#pragma unroll
            for (int r = 0; r < 16; ++r) { const int kv = kt * 64 + crow(r, hi); if (kv > qpos) p0[r] = NEG; if (kv + 32 > qpos) p1[r] = NEG; } } } };
struct TfT5 { const LAS float* tb; int qpos, hi, q0w, window; unsigned mask; bool use_mask;
    __device__ __forceinline__ bool far(int kt) const { return q0w - (kt * 64 + 63) >= 113; }
    __device__ __forceinline__ float farbias() const { return tb[127]; }
    __device__ __forceinline__ void cinit(int kt, float mref, f32x16& c0, f32x16& c1) const {
        if (q0w - (kt * 64 + 63) >= 113) { const float c = tb[127] - mref;
#pragma unroll
            for (int r = 0; r < 16; ++r) { c0[r] = c; c1[r] = c; } }
        else {
#pragma unroll
            for (int r = 0; r < 16; ++r) { const int d0 = qpos - kt * 64 - crow(r, hi); c0[r] = tb[min(max(d0, 0), 127)] - mref; c1[r] = tb[min(max(d0 - 32, 0), 127)] - mref; } } }
    __device__ __forceinline__ void post(int kt, f32x16& p0, f32x16& p1) const {
        if (q0w - (kt * 64 + 63) < 0 || q0w + 31 - kt * 64 >= window) {
#pragma unroll
            for (int r = 0; r < 16; ++r) { const int d0 = qpos - kt * 64 - crow(r, hi), d1 = d0 - 32; if (d0 < 0 || d0 >= window) p0[r] = NEG; if (d1 < 0 || d1 >= window) p1[r] = NEG; } }
        if (use_mask) { const bool en = ((mask >> kt) & 1u) != 0u;
            if (!__all(en)) {
#pragma unroll
                for (int r = 0; r < 16; ++r) { p0[r] = en ? p0[r] : NEG; p1[r] = en ? p1[r] : NEG; } } } } };
}
#ifndef STAGE_LIMIT
#define STAGE_LIMIT 4
#endif
constexpr size_t MiB = 1u << 20;
constexpr size_t WS_CTL = 0, CTL_ZERO_BYTES = 64 * 1024;
constexpr size_t WS_SS = 256 * 1024;
constexpr size_t WS_SSM = 640 * 1024;
constexpr size_t WS_F32S = 2 * MiB;
constexpr size_t WS_CUM = 4 * MiB;
constexpr size_t WS_MASK = 4 * MiB + 512 * 1024;
constexpr size_t WS_UMASK = WS_MASK + 128 * 1024;
constexpr size_t WS_KC = 5 * MiB, WS_VC = 5 * MiB + 256 * 1024;
constexpr size_t WS_KMAX = 5 * MiB + 512 * 1024;
constexpr size_t WS_POSC = 32 * 1024;
constexpr size_t WS_WGU1 = 8 * MiB, WS_WD1 = 19 * MiB, WS_WIN = 25 * MiB, WS_WUPN = 35 * MiB, WS_WUPF = 36 * MiB, WS_WOUT = 37 * MiB, WS_WMQ = 39 * MiB,
                 WS_WMKV = 41 * MiB, WS_WMO = 45 * MiB, WS_WGU2 = 47 * MiB, WS_WD2 = 58 * MiB, WS_CW1K = 64 * MiB, WS_CW1V = 65 * MiB, WS_CW2K = 66 * MiB, WS_CW2V = 66 * MiB + 256 * 1024;
constexpr size_t WS_KVM = 8 * MiB;
constexpr size_t WS_XB = 68 * MiB;
constexpr size_t WS_QN = 100 * MiB, WS_KVN = 116 * MiB, WS_QF = 140 * MiB, WS_KVF = 156 * MiB, WS_GAB = 188 * MiB;
constexpr size_t WS_H = 100 * MiB;
constexpr size_t WS_Y = WS_KVF;
constexpr size_t WS_MT = 188 * MiB, WS_NT = 204 * MiB, WS_PM = 220 * MiB;
constexpr size_t WS_MEMB = 252 * MiB, WS_END = 256 * MiB;
static_assert(WS_WD2 + (size_t)DM * FF * 2 <= WS_CW1K && WS_GAB + (size_t)M * 2048 * 2 <= WS_MEMB && WS_H + (size_t)M * FF * 2 <= WS_GAB, "ws map");
constexpr int CW_BAR = 4096;
constexpr size_t WS_XBUF = 1 * MiB;
constexpr size_t WS_FINCNT = 40 * 1024;
constexpr int RING_BYTES = 131072, LDS_BYTES = 147456;

__device__ const unsigned char T5B[128] = {0, 1, 2, 3, 4, 5, 6, 7, 8, 9, 10, 11, 12, 13, 14, 15, 16, 16, 16, 17, 17, 18, 18, 18, 19, 19, 19, 20, 20, 20, 20, 21, 21, 21, 21, 22, 22, 22, 22, 22, 23, 23, 23, 23, 23, 23, 24, 24, 24, 24, 24, 24, 25, 25, 25, 25, 25, 25, 25, 26, 26, 26, 26, 26, 26, 26, 26, 27, 27, 27, 27, 27, 27, 27, 27, 27, 27, 28, 28, 28, 28, 28, 28, 28, 28, 28, 28, 29, 29, 29, 29, 29, 29, 29, 29, 29, 29, 29, 29, 30, 30, 30, 30, 30, 30, 30, 30, 30, 30, 30, 30, 30, 30, 31, 31, 31, 31, 31, 31, 31, 31, 31, 31, 31, 31, 31, 31, 31};


#define XB_TMO      128
#define XB_XCNT(j)  (256  + 64 * (j))
#define XB_XSUB(j)  (1280 + 64 * (j))
#define XB_XGEN(j)  (2304 + 64 * (j))
#define XB_TOP      3328
#define XB_TOPGEN   3392
#define XCD_BAR_WORDS 3456
#define XB_SPIN_CAP (1u << 18)
__device__ __forceinline__ unsigned xb_ld(unsigned* p)              { return __hip_atomic_load(p, __ATOMIC_RELAXED, __HIP_MEMORY_SCOPE_AGENT); }
__device__ __forceinline__ unsigned xb_add(unsigned* p, unsigned v) { return __hip_atomic_fetch_add(p, v, __ATOMIC_RELAXED, __HIP_MEMORY_SCOPE_AGENT); }
__device__ __forceinline__ unsigned xb_xcc_id() { return (unsigned)__builtin_amdgcn_s_getreg((3 << 11) | 20) & 0xFu; }
#define XB_SPIN(cond, bar) do { unsigned _sp = 0; while (cond) { __builtin_amdgcn_s_sleep(1); \
    if ((++_sp & 255u) == 0u) { if (xb_ld(&(bar)[XB_TMO])) break; if (_sp > XB_SPIN_CAP) { atomicAdd(&(bar)[XB_TMO], 1u); break; } } } } while (0)
struct XcdBarrier { unsigned* bar; unsigned x; volatile LAS unsigned* st; };
__device__ __forceinline__ XcdBarrier xcd_barrier_post(unsigned* bar, volatile LAS unsigned* st) {
    XcdBarrier b; b.bar = bar; b.x = xb_xcc_id(); b.st = st;
    if (threadIdx.x == 0) (void)xb_add(&bar[XB_XCNT(b.x)], 1u);
    return b;
}
__device__ __forceinline__ void xcd_barrier_complete(unsigned* bar, unsigned x, unsigned& nloc, unsigned& nx) {
    const unsigned G = gridDim.x * gridDim.y * gridDim.z;
    unsigned sum, cnt, mine, sp = 0u;
    for (;;) {
        sum = 0u; cnt = 0u; mine = 0u;
#pragma unroll
        for (unsigned j = 0; j < 16; ++j) { const unsigned c = xb_ld(&bar[XB_XCNT(j)]); sum += c; cnt += (c > 0u) ? 1u : 0u; mine = (j == x) ? c : mine; }
        if (sum == G) break;
        __builtin_amdgcn_s_sleep(1);
        if ((++sp & 255u) == 0u) { if (xb_ld(&bar[XB_TMO])) break; if (sp > XB_SPIN_CAP) { atomicAdd(&bar[XB_TMO], 1u); break; } }
    }
    nloc = mine > 0u ? mine : 1u; nx = cnt > 0u ? cnt : 1u;
}
__device__ __forceinline__ void xcd_barrier(const XcdBarrier& b) {
    asm volatile("s_waitcnt vmcnt(0)" ::: "memory");
    __syncthreads();
    if (threadIdx.x == 0) {
        unsigned* bar = b.bar;
        __builtin_amdgcn_s_waitcnt(0);
        unsigned nloc = b.st[0], nx = b.st[1];
        if (nloc == 0u) { xcd_barrier_complete(bar, b.x, nloc, nx); b.st[0] = nloc; b.st[1] = nx; }
        const unsigned old = xb_add(&bar[XB_XSUB(b.x)], 1u);
        const unsigned gen = old / nloc;
        if (old + 1u == (gen + 1u) * nloc) {
            __builtin_amdgcn_fence(__ATOMIC_RELEASE, "agent");
            asm volatile("s_waitcnt vmcnt(0)" ::: "memory");
            const unsigned og = xb_add(&bar[XB_TOP], 1u);
            const unsigned tg = og / nx;
            if (og + 1u == (tg + 1u) * nx) xb_add(&bar[XB_TOPGEN], 1u);
            else XB_SPIN(xb_ld(&bar[XB_TOPGEN]) == tg, bar);
            __builtin_amdgcn_fence(__ATOMIC_ACQUIRE, "agent");
            xb_add(&bar[XB_XGEN(b.x)], 1u);
            asm volatile("s_waitcnt vmcnt(0)" ::: "memory");
        } else {
            XB_SPIN(xb_ld(&bar[XB_XGEN(b.x)]) == gen, bar);
            __builtin_amdgcn_fence(__ATOMIC_ACQUIRE, "agent");
            asm volatile("s_waitcnt vmcnt(0)" ::: "memory");
        }
    }
    __syncthreads();
}

struct Args { const float* in[29]; float* out; unsigned char* ws; int lo, hi; };
enum { I_X = 0, I_MEM, I_RELB, I_F1N, I_F1G, I_F1U, I_F1D, I_MIXN, I_WIN, I_BF, I_POSK, I_POSV, I_CK1, I_CK2, I_CV1, I_CV2, I_UPN, I_UPF, I_WOUT, I_MQN, I_MKVN, I_MWQ, I_MWKV, I_MWO, I_F2N, I_F2G, I_F2U, I_F2D, I_FINN };

__device__ __forceinline__ float wave_sum(float v) {
#pragma unroll
    for (int o = 1; o < 64; o <<= 1) v += __shfl_xor(v, o);
    return v;
}
struct ItemD { const float* wp; const float* gp; bf16_t* wt; int ldsrc, K, k0, dstrow0; float scl; bool zero; };
struct ItemR { f32x4 v[8]; float gk[8]; };
__device__ __forceinline__ void cm_plain(int n, int off, int& sc) { sc = n + off; }
__device__ __forceinline__ void cm_win(int n, int& sc, float& scl) {
    scl = 1.f;
    if (n < 512) { sc = n; scl = QS64; }
    else if (n < 1280) sc = n;
    else if (n < 1792) { sc = 1304 + (n - 1280); scl = QS64; }
    else if (n < 2816) sc = 1816 + (n - 1792);
    else if (n < 4864) sc = 2848 + (n - 2816);
    else if (n < 4888) sc = 1280 + (n - 4864);
    else if (n < 4896) sc = 2840 + (n - 4888);
    else sc = -1; }
constexpr int N_GU = 16 * 176, N_D = 44 * 32, N_WIN = 16 * 160, N_UP = 8 * 32, N_SQ = 16 * 32, N_MKV = 16 * 64, N_C1 = 32 * 8, N_C2 = 4 * 2;
constexpr int CONV_NA = N_GU + N_D + N_WIN + N_MKV + 2 * N_C1 + 2 * N_C2, CONV_NB = N_GU + N_D + 2 * N_UP + 3 * N_SQ;
__device__ __forceinline__ ItemD conv_decode(const Args& a, int it, int lane) {
    unsigned char* ws = a.ws; int r = it; ItemD d; const int c4 = lane & 7, kr = lane >> 3;
    const float* W; int ldsrc, K, kb, dr, off = 0; const float* gain = nullptr; bf16_t* wt; float scl = 1.f; bool win = false;
    const int f = r >= CONV_NA; if (f) r -= CONV_NA;
    if (r < N_GU) { kb = r / 176; const int gi = r % 176; dr = gi * 32; const int tile = dr >> 8, within = dr & 255;
        W = a.in[within < 128 ? (f ? I_F2G : I_F1G) : (f ? I_F2U : I_F1U)]; ldsrc = FF; K = DM; wt = (bf16_t*)(ws + (f ? WS_WGU2 : WS_WGU1)); gain = a.in[f ? I_F2N : I_F1N]; off = tile * 128 + (within & 127) - dr; }
    else if ((r -= N_GU) < N_D) { kb = r / 32; dr = (r % 32) * 32; W = a.in[f ? I_F2D : I_F1D]; ldsrc = DM; K = FF; wt = (bf16_t*)(ws + (f ? WS_WD2 : WS_WD1)); }
    else if (!f) { r -= N_D;
        if (r < N_WIN) { kb = r / 160; dr = (r % 160) * 32; W = a.in[I_WIN]; ldsrc = 4896; K = DM; wt = (bf16_t*)(ws + WS_WIN); gain = a.in[I_MIXN]; win = true; }
        else if ((r -= N_WIN) < N_MKV) { kb = r / 64; dr = (r % 64) * 32; W = a.in[I_MWKV]; ldsrc = 2048; K = DM; wt = (bf16_t*)(ws + WS_WMKV); gain = a.in[I_MKVN]; }
        else if ((r -= N_MKV) < 2 * N_C1) { const int g = r >= N_C1; r -= g * N_C1; kb = r / 8; dr = (r % 8) * 32; W = a.in[g ? I_CV1 : I_CK1]; ldsrc = 256; K = 2048; wt = (bf16_t*)(ws + (g ? WS_CW1V : WS_CW1K)); }
        else { r -= 2 * N_C1; const int g = r >= N_C2; r -= g * N_C2; kb = r / 2; dr = (r % 2) * 32; W = a.in[g ? I_CV2 : I_CK2]; ldsrc = 64; K = 256; wt = (bf16_t*)(ws + (g ? WS_CW2V : WS_CW2K)); }
    } else { r -= N_D;
        if (r < 2 * N_UP) { const int g = r >= N_UP; r -= g * N_UP; kb = r / 32; dr = (r % 32) * 32; W = a.in[g ? I_UPF : I_UPN]; ldsrc = DM; K = 512; wt = (bf16_t*)(ws + (g ? WS_WUPF : WS_WUPN)); }
        else { r -= 2 * N_UP; const int g = r / N_SQ; r -= g * N_SQ; kb = r / 32; dr = (r % 32) * 32; W = a.in[g == 0 ? I_WOUT : (g == 1 ? I_MWQ : I_MWO)]; ldsrc = DM; K = DM;
            wt = (bf16_t*)(ws + (g == 0 ? WS_WOUT : (g == 1 ? WS_WMQ : WS_WMO))); if (g == 1) { W = a.in[I_MWO]; wt = (bf16_t*)(ws + WS_WMO); } }
    }
    int sc; if (win) cm_win(dr + 4 * c4, sc, scl); else cm_plain(dr + 4 * c4, off, sc);
    d.zero = sc < 0; d.wp = W + (size_t)(kb * 64 + kr) * ldsrc + (sc < 0 ? 0 : sc); d.gp = gain ? gain + kb * 64 + kr : nullptr; d.wt = wt; d.ldsrc = ldsrc; d.K = K; d.k0 = kb * 64; d.dstrow0 = dr; d.scl = scl;
    return d;
}
__device__ __forceinline__ void conv_load(const ItemD& d, ItemR& r) {
#pragma unroll
    for (int i = 0; i < 8; ++i) { r.v[i] = d.zero ? (f32x4){0.f, 0.f, 0.f, 0.f} : *(const f32x4*)(d.wp + (size_t)(8 * i) * d.ldsrc); r.gk[i] = d.gp ? d.gp[8 * i] : 1.f; }
}
__device__ __forceinline__ void conv_finish(const ItemD& d, const ItemR& r, LAS float* scr, int lane) {
    const int kr = lane >> 3, c4 = lane & 7;
#pragma unroll
    for (int i = 0; i < 8; ++i) { const int kk = 8 * i + kr; const float s = r.gk[i] * d.scl; LAS float* p = scr + kk * 33 + 4 * c4; p[0] = r.v[i][0] * s; p[1] = r.v[i][1] * s; p[2] = r.v[i][2] * s; p[3] = r.v[i][3] * s; }
    asm volatile("s_waitcnt lgkmcnt(0)" ::: "memory");
    const int c = lane & 7;
#pragma unroll
    for (int j = 0; j < 4; ++j) { const int nn = (lane >> 3) + 8 * j; const LAS float* s = scr + (8 * c) * 33 + nn;
        u32x4 o; o.x = cvtpk(s[0 * 33], s[1 * 33]); o.y = cvtpk(s[2 * 33], s[3 * 33]); o.z = cvtpk(s[4 * 33], s[5 * 33]); o.w = cvtpk(s[6 * 33], s[7 * 33]);
        *(u32x4*)(d.wt + (size_t)(d.dstrow0 + nn) * d.K + d.k0 + 8 * c) = o; }
    asm volatile("s_waitcnt lgkmcnt(0)" ::: "memory");
}
__device__ __forceinline__ void conv_run(const Args& a, int it0, int itend, int stride, LAS float* scr, int lane) {
    if (it0 >= itend) return;
    ItemD d0 = conv_decode(a, it0, lane); ItemR r0; conv_load(d0, r0);
    for (int it = it0 + stride; ; it += stride) {
        const bool more = it < itend;
        ItemD d1; ItemR r1;
        if (more) { d1 = conv_decode(a, it, lane); conv_load(d1, r1); }
        conv_finish(d0, r0, scr, lane);
        if (!more) break;
        d0 = d1; r0 = r1;
    }
}

__device__ __forceinline__ void p0_prologue(const Args& a, LAS unsigned char* lds, int gw, int NGW, int wave, int lane) {
    unsigned char* ws = a.ws;
    LAS float* scr = (LAS float*)(lds + wave * 16384);
    conv_run(a, gw, N_GU, NGW, scr, lane);
    { f32x4* z = (f32x4*)(ws + WS_SS + (size_t)M * 4); for (int i = gw * 64 + lane; i < 3 * M / 4; i += NGW * 64) z[i] = (f32x4){0.f, 0.f, 0.f, 0.f}; }
    for (int mrow = gw; mrow < M + MROWS; mrow += NGW) {
        const bool ismem = mrow >= M; const int rr = ismem ? mrow - M : mrow;
        const f32x4* xr = (const f32x4*)((ismem ? a.in[I_MEM] : a.in[I_X]) + (size_t)rr * DM) + lane;
        unsigned long long* o8 = (unsigned long long*)((bf16_t*)(ws + (ismem ? WS_MEMB : WS_XB)) + (size_t)rr * DM) + lane;
        float s = 0.f; f32x4 v[4];
#pragma unroll
        for (int j = 0; j < 4; ++j) v[j] = xr[64 * j];
#pragma unroll
        for (int j = 0; j < 4; ++j) { s += (v[j][0] * v[j][0] + v[j][1] * v[j][1]) + (v[j][2] * v[j][2] + v[j][3] * v[j][3]);
            o8[64 * j] = (unsigned long long)cvtpk(v[j][0], v[j][1]) | ((unsigned long long)cvtpk(v[j][2], v[j][3]) << 32); }
        s = wave_sum(s);
        if (lane == 0) ((float*)(ws + (ismem ? WS_SSM : WS_SS)))[rr] = s;
    }
    for (int t = gw; t < 64; t += NGW) { const int kv = t >> 5, kc = (t & 31) * 64; const float* pos = a.in[kv ? I_POSV : I_POSK] + kc; const f32x4* w1 = (const f32x4*)(a.in[kv ? I_CV1 : I_CK1] + (size_t)kc * 256) + lane;
        f32x4 s = {0.f, 0.f, 0.f, 0.f};
#pragma unroll 8
        for (int k = 0; k < 64; ++k) s += w1[(size_t)k * 64] * pos[k];
        float* o = (float*)(ws + WS_POSC) + kv * 256 + 4 * lane;
        unsafeAtomicAdd(o, s[0]); unsafeAtomicAdd(o + 1, s[1]); unsafeAtomicAdd(o + 2, s[2]); unsafeAtomicAdd(o + 3, s[3]); }
}

__device__ __forceinline__ void wqn_rows(const Args& a, int w0, int nw, int lane) {
    for (int d = w0; d < DM; d += nw) { const float s = a.in[I_MQN][d] * QS256; const f32x4* xr = (const f32x4*)(a.in[I_MWQ] + (size_t)d * DM) + lane;
        unsigned long long* o8 = (unsigned long long*)((bf16_t*)(a.ws + WS_WMQ) + (size_t)d * DM) + lane; f32x4 v[4];
#pragma unroll
        for (int j = 0; j < 4; ++j) v[j] = xr[64 * j];
#pragma unroll
        for (int j = 0; j < 4; ++j) o8[64 * j] = (unsigned long long)cvtpk(v[j][0] * s, v[j][1] * s) | ((unsigned long long)cvtpk(v[j][2] * s, v[j][3] * s) << 32); }
}
__device__ __forceinline__ void compress_unit(const Args& a, LAS unsigned char* lds, int uidx) {
    unsigned char* ws = a.ws;
    const int tid = fresh_tid(), lane = tid & 63, r32 = lane & 31, hi = lane >> 5, wid = __builtin_amdgcn_readfirstlane(tid >> 6);
    const int kv = uidx >> 6, b = (uidx >> 3) & 7, g = (uidx >> 2) & 1, chunk = uidx & 3, n0 = chunk * 32;
    const bf16_t* W1 = (const bf16_t*)(ws + (kv ? WS_CW1V : WS_CW1K)); const bf16_t* W2 = (const bf16_t*)(ws + (kv ? WS_CW2V : WS_CW2K));
    const float* posc = (const float*)(ws + WS_POSC) + kv * 256;
    const bf16_t* asrc = (const bf16_t*)(ws + WS_KVN) + (size_t)(b * SEQ) * 768 + kv * 128 + g * 64;
    LAS bf16_t* As = (LAS bf16_t*)lds;
    for (int i = tid; i < 528 * 8; i += 512) { const int row = i >> 3, ch = i & 7; const int t = min(16 * n0 + row, SEQ - 1);
        *(LAS u32x4*)(As + row * 64 + ((ch ^ ((row >> 4) & 7)) * 8)) = *(const u32x4*)(asrc + (size_t)t * 768 + ch * 8); }
    __syncthreads();
    const bf16_t* brow = W1 + (size_t)(32 * wid + r32) * 2048 + hi * 8;
    f32x16 acc = f32x16{}, accb = f32x16{};
#pragma unroll 8
    for (int kk = 0; kk < 128; kk += 2) {
        { const int l = kk >> 2, dch = (kk & 3) * 2 + hi, row = 16 * r32 + l;
          const bf16x8 av = *(const LAS bf16x8*)(As + row * 64 + ((dch ^ ((row >> 4) & 7)) * 8)); const bf16x8 bv = *(const bf16x8*)(brow + kk * 16);
          acc = __builtin_amdgcn_mfma_f32_32x32x16_bf16(av, bv, acc, 0, 0, 0); }
        { const int k1 = kk + 1, l = k1 >> 2, dch = (k1 & 3) * 2 + hi, row = 16 * r32 + l;
          const bf16x8 av = *(const LAS bf16x8*)(As + row * 64 + ((dch ^ ((row >> 4) & 7)) * 8)); const bf16x8 bv = *(const bf16x8*)(brow + k1 * 16);
          accb = __builtin_amdgcn_mfma_f32_32x32x16_bf16(av, bv, accb, 0, 0, 0); } }
    acc += accb;
    LAS bf16_t* Hs = (LAS bf16_t*)(lds + 81920);
    const float pc = posc[32 * wid + r32];
#pragma unroll
    for (int r = 0; r < 16; ++r) { const float x = acc[r] + pc; const float u = 0.7978845608028654f * (x + 0.044715f * x * x * x);
        const float ge = x * frcp(1.0f + fexp2(-2.0f * LOG2E * u)); Hs[att::crow(r, hi) * 264 + 32 * wid + r32] = (bf16_t)(cvtpk(ge, 0.f) & 0xffffu); }
    __syncthreads();
    if (wid < 2) { f32x16 acc2 = f32x16{};
#pragma unroll
        for (int kk = 0; kk < 16; ++kk) { const bf16x8 av = *(const LAS bf16x8*)(Hs + r32 * 264 + kk * 16 + hi * 8); const bf16x8 bv = *(const bf16x8*)(W2 + (size_t)(32 * wid + r32) * 256 + kk * 16 + hi * 8);
            acc2 = __builtin_amdgcn_mfma_f32_32x32x16_bf16(av, bv, acc2, 0, 0, 0); }
        bf16_t* outp = (bf16_t*)(ws + (kv ? WS_VC : WS_KC)) + (size_t)((b * 2 + g) * 128) * 64;
#pragma unroll
        for (int r = 0; r < 16; ++r) { const int n = n0 + att::crow(r, hi); const float v = n < 127 ? acc2[r] : 0.f; outp[(size_t)n * 64 + 32 * wid + r32] = (bf16_t)(cvtpk(v, 0.f) & 0xffffu); } }
    __syncthreads();
}
__device__ __forceinline__ void kmax_task(const Args& a, LAS unsigned char* lds, int task, int wave, int lane) {
    const int b = task >> 3, h = task & 7; float mx = 0.f;
    const bf16_t* K = (const bf16_t*)(a.ws + WS_KVF) + (size_t)(b * SEQ) * 1024 + h * 64;
#pragma unroll
    for (int rr = 0; rr < 4; ++rr) { const u32x4* p = (const u32x4*)(K + (size_t)(wave * 256 + rr * 64 + lane) * 1024); float ss = 0.f;
#pragma unroll
        for (int c = 0; c < 8; ++c) { const u32x4 v = p[c]; ss += (bflo(v.x) * bflo(v.x) + bfhi(v.x) * bfhi(v.x)) + (bflo(v.y) * bflo(v.y) + bfhi(v.y) * bfhi(v.y)) + (bflo(v.z) * bflo(v.z) + bfhi(v.z) * bfhi(v.z)) + (bflo(v.w) * bflo(v.w) + bfhi(v.w) * bfhi(v.w)); }
        mx = fmaxf(mx, ss); }
#pragma unroll
    for (int o = 1; o < 64; o <<= 1) mx = fmaxf(mx, __shfl_xor(mx, o));
    LAS float* red = (LAS float*)(lds + 120 * 1024);
    if (lane == 0) red[wave] = mx;
    __syncthreads();
    if (wave == 0 && lane == 0) { float m2 = red[0]; for (int i = 1; i < 8; ++i) m2 = fmaxf(m2, red[i]); ((float*)(a.ws + WS_KMAX))[task] = sqrtf(m2) * 1.01f; }
    __syncthreads();
}
__device__ __forceinline__ void cumsum_task(const Args& a, int task, int lane) {
    const int b = task >> 3, h = task & 7; const float bf = a.in[I_BF][h];
    const float* fl = (const float*)(a.ws + WS_F32S) + (size_t)(b * SEQ) * 32 + 24 + h; float* out = (float*)(a.ws + WS_CUM) + (size_t)task * SEQ;
    float v[32];
#pragma unroll
    for (int i = 0; i < 32; ++i) v[i] = fl[(size_t)(64 * i + lane) * 32];
    float carry = 0.f;
#pragma unroll
    for (int i = 0; i < 32; ++i) { const float x = v[i] + bf; float inc = fminf(x, 0.f) - log1pf(expf(-fabsf(x)));
#pragma unroll
        for (int o = 1; o < 64; o <<= 1) { const float t = __shfl_up(inc, o); if (lane >= o) inc += t; }
        inc += carry; out[64 * i + lane] = -inc * LOG2E; carry = __shfl(inc, 63); }
}

__device__ __forceinline__ void init_t5_table(const Args& a, LAS unsigned char* lds) {
    LAS float* T = (LAS float*)(lds + att::L_TBL);
    for (int i = fresh_tid(); i < 1024; i += 512) { const int h = i >> 7, d = i & 127; T[i] = a.in[I_RELB][T5B[d] * 8 + h] * LOG2E; }
}
template <bool DRY> __device__ __forceinline__ void fox_unit(const Args& a, LAS unsigned char* lds, int b, int h, int qb) {
    using namespace att;
    unsigned char* ws = a.ws;
    const int tid = fresh_tid(), lane = tid & 63, r32 = lane & 31, hi = lane >> 5, wid = __builtin_amdgcn_readfirstlane(tid >> 6);
    const int q0 = qb * 256, q0w = q0 + wid * 32, qpos = q0w + r32;
    LAS float* cb = (LAS float*)(lds + L_CB); LAS float* wsf = (LAS float*)(lds + L_WSF) + wid * 64;
    const float* cum = (const float*)(ws + WS_CUM) + (size_t)(b * 8 + h) * SEQ;
    for (int i = tid; i < q0 + 256; i += 512) cb[i] = cum[i];
    bf16_t* Qw = (bf16_t*)(ws + WS_QF) + (size_t)(b * SEQ + q0w) * 512 + h * 64;
    bf16x8 qr[4]; load_q(qr, Qw, 512, r32, hi);
    f32x16 o[2]; o[0] = f32x16{}; o[1] = f32x16{}; float m = 0.f, l = 0.f;
    const int nt = 4 * qb + 4; unsigned tmask = nt >= 32 ? 0xffffffffu : ((1u << nt) - 1u);
    const bf16_t* Kg = (const bf16_t*)(ws + WS_KVF) + (size_t)(b * SEQ) * 1024 + h * 64;
#ifndef NO_FOX_SKIP
    {
        const float cb0 = cum[q0], cbt = cum[64 * (lane < nt ? lane : 0) + 63], kmx = ((const float*)(ws + WS_KMAX))[b * 8 + h];
        float qq = 0.f;
#pragma unroll
        for (int d0 = 0; d0 < 4; ++d0) { const u32x4 v = __builtin_bit_cast(u32x4, qr[d0]);
            qq += (bflo(v.x) * bflo(v.x) + bfhi(v.x) * bfhi(v.x)) + (bflo(v.y) * bflo(v.y) + bfhi(v.y) * bfhi(v.y)) + (bflo(v.z) * bflo(v.z) + bfhi(v.z) * bfhi(v.z)) + (bflo(v.w) * bflo(v.w) + bfhi(v.w) * bfhi(v.w)); }
        qq = halfsum(qq);
#pragma unroll
        for (int o_ = 1; o_ < 32; o_ <<= 1) qq = fmaxf(qq, __shfl_xor(qq, o_));
        LAS float* red = (LAS float*)(lds + L_MISC + 384 + (qb & 1) * 32);
        if (lane == 0) red[wid] = qq;
        __syncthreads();
        float qmax = red[0];
#pragma unroll
        for (int i = 1; i < 8; ++i) qmax = fmaxf(qmax, red[i]);
        const float need = 2.0f * sqrtf(qmax) * 1.01f * kmx + 40.0f;
        const bool skip = (lane < 32) && (lane < nt) && (cb0 - cbt >= need);
        const unsigned long long bal = __ballot(skip);
        tmask &= ~(unsigned)bal;
    }
#endif
#ifndef FOX_ABL
#define FOX_ABL 0
#endif
    if (DRY && (FOX_ABL & 64)) tmask = 1u << (31 - __clz((int)tmask));
    if (DRY) attn_loop2<FOX_ABL>(tmask, Kg, 1024, Kg + 512, 1024, lds, qr, o, m, l, TfFox{cb, qpos, hi, q0w}, q0w + 31);
    else attn_loop2<0>(tmask, Kg, 1024, Kg + 512, 1024, lds, qr, o, m, l, TfFox{cb, qpos, hi, q0w}, q0w + 31);
    l = halfsum(l);
    scale_rows(o, wsf, 1.0f / l, r32, hi);
    store_o<false>(o, lds, DRY ? (bf16_t*)((unsigned char*)a.out + 16 * MiB) + (size_t)(b * SEQ + q0w) * 512 + h * 64 : Qw, 512, nullptr, 0);
}
template <int PARTS> __device__ __forceinline__ void cmpwin_unit(const Args& a, LAS unsigned char* lds, int b, int g, int qb) {
    using namespace att;
    unsigned char* ws = a.ws;
    const int tid = fresh_tid(), lane = tid & 63, r32 = lane & 31, hi = lane >> 5, wid = __builtin_amdgcn_readfirstlane(tid >> 6);
    const int j = wid >> 1, sub = wid & 1, hg = g * 4 + j, q0w = qb * 64 + sub * 32, qpos = q0w + r32; const size_t qrow = (size_t)b * SEQ + qpos;
    const LAS float* tb = (const LAS float*)(lds + L_TBL) + hg * 128;
    LAS float* wsf = (LAS float*)(lds + L_WSF) + wid * 64; LAS float* PS = (LAS float*)(lds + L_PS); LAS float* IMP = (LAS float*)(lds + L_IMP); LAS unsigned* MW = (LAS unsigned*)(lds + L_MISC);
    const float* gates = (const float*)(ws + WS_F32S) + qrow * 32;
    if (tid == 0) MW[0] = 0u;
    bf16x8 qr[4]; load_q(qr, (const bf16_t*)(ws + WS_QN) + (size_t)(b * SEQ + q0w) * 512 + hg * 64, 512, r32, hi);
    const StageGeo sg = stage_geo(tid);
    { const bf16_t* Kc = (const bf16_t*)(ws + WS_KC) + (size_t)((b * 2 + g) * 128) * 64; const bf16_t* Vc = (const bf16_t*)(ws + WS_VC) + (size_t)((b * 2 + g) * 128) * 64;
#pragma unroll
        for (int t = 0; t < 2; ++t) { *(LAS u32x4*)(lds + L_SLOT + t * 16384 + sg.koff) = *(const u32x4*)(Kc + (size_t)(t * 64 + sg.krow) * 64 + sg.kcol);
            *(LAS u32x4*)(lds + L_SLOT + t * 16384 + sg.voff) = *(const u32x4*)(Vc + (size_t)(t * 64 + sg.vrow) * 64 + sg.vcol); } }
    __syncthreads();
    if (PARTS & 1) {
        f32x16 oc[2]; oc[0] = f32x16{}; oc[1] = f32x16{};
        f32x16 a0, a1, b0, b1; qkt(a0, a1, lds + L_SLOT, qr, r32, hi); qkt(b0, b1, lds + L_SLOT + 16384, qr, r32, hi);
        float mx = NEG;
#pragma unroll
        for (int r = 0; r < 16; ++r) { const int d = qpos - 16 * crow(r, hi) - 31;
            a0[r] = d >= 0 ? a0[r] + tb[min(d, 127)] : NEG; a1[r] = d - 512 >= 0 ? a1[r] + tb[min(d - 512, 127)] : NEG;
            b0[r] = d - 1024 >= 0 ? b0[r] + tb[min(d - 1024, 127)] : NEG; b1[r] = d - 1536 >= 0 ? b1[r] + tb[min(d - 1536, 127)] : NEG;
            mx = fmaxf(fmaxf(mx, fmaxf(a0[r], a1[r])), fmaxf(b0[r], b1[r])); }
        { auto rr = __builtin_amdgcn_permlane32_swap(__float_as_uint(mx), __float_as_uint(mx), false, false); mx = fmaxf(__uint_as_float(rr[0]), __uint_as_float(rr[1])); }
        const float mxs = mx == NEG ? 0.f : mx; float s = 0.f;
#pragma unroll
        for (int r = 0; r < 16; ++r) { a0[r] = fexp2(a0[r] - mxs); a1[r] = fexp2(a1[r] - mxs); b0[r] = fexp2(b0[r] - mxs); b1[r] = fexp2(b1[r] - mxs); s += (a0[r] + a1[r]) + (b0[r] + b1[r]); }
        s = halfsum(s); const float inv = s > 0.f ? 1.0f / s : 0.f;
#pragma unroll
        for (int r = 0; r < 16; ++r) { a0[r] *= inv; a1[r] *= inv; b0[r] *= inv; b1[r] *= inv; }
        {
            float own[4][4], x3[4][4], rcv[4][4];
#pragma unroll
            for (int i = 0; i < 4; ++i) {
                own[0][i] = 2.0f * (a0[4 * i] + a0[4 * i + 1] + a0[4 * i + 2]) + a0[4 * i + 3]; x3[0][i] = a0[4 * i + 3];
                own[1][i] = 2.0f * (a1[4 * i] + a1[4 * i + 1] + a1[4 * i + 2]) + a1[4 * i + 3]; x3[1][i] = a1[4 * i + 3];
                own[2][i] = 2.0f * (b0[4 * i] + b0[4 * i + 1] + b0[4 * i + 2]) + b0[4 * i + 3]; x3[2][i] = b0[4 * i + 3];
                own[3][i] = 2.0f * (b1[4 * i] + b1[4 * i + 1] + b1[4 * i + 2]) + b1[4 * i + 3]; x3[3][i] = b1[4 * i + 3]; }
#pragma unroll
            for (int k = 0; k < 4; ++k)
#pragma unroll
                for (int i = 0; i < 4; ++i) { auto rr = __builtin_amdgcn_permlane32_swap(__float_as_uint(x3[k][i]), __float_as_uint(x3[k][i]), false, false); rcv[k][i] = __uint_as_float(hi ? rr[0] : rr[1]); }
            LAS float* imh = PS + j * (64 * 33) + (sub * 32 + r32) * 33 + hi;
#pragma unroll
            for (int k = 0; k < 4; ++k)
#pragma unroll
                for (int i = 0; i < 4; ++i) { const float prev = i > 0 ? rcv[k][i - 1] : (k > 0 ? rcv[k - 1][3] : 0.f);
                    imh[8 * k + 2 * i] = own[k][i] + (hi ? rcv[k][i] : prev); }
        }
        const int vb0 = (int)(unsigned)(size_t)(lds + L_SLOT + 8192) + ((lane >> 4) & 1) * 32 + (lane & 3) * 8 + (4 * hi + ((lane & 15) >> 2)) * 64;
        bf16x8 x0, x1, x2, x3; pack_p(a0, a1, x0, x1, x2, x3); pv(oc, vb0, x0, x1, x2, x3);
        pack_p(b0, b1, x0, x1, x2, x3); pv(oc, vb0 + 16384, x0, x1, x2, x3);
        scale_rows(oc, wsf, sigmoidf_(gates[hg]), r32, hi);
        store_o<false>(oc, lds, (bf16_t*)a.out + (size_t)(b * SEQ + q0w) * 512 + hg * 64, 512, nullptr, 0);
    }
    __syncthreads();
    if (PARTS & 2) {
        const int q = tid >> 3, jb = (tid & 7) * 4; const LAS float* ps = PS + q * 33; LAS float* im = IMP + q * 33;
#pragma unroll
        for (int jj = 0; jj < 4; ++jj) { const int jx = jb + jj;
            const float v = (ps[jx] + ps[64 * 33 + jx]) + (ps[2 * 64 * 33 + jx] + ps[3 * 64 * 33 + jx]);
            const bool valid = jx <= qb, forced = (jx == 0) || (jx == qb) || (jx == qb - 1);
            im[jx] = valid ? v + (forced ? 1e4f : 0.f) : -1e30f; }
        __syncthreads();
        unsigned bits = 0u;
#pragma unroll
        for (int jj = 0; jj < 4; ++jj) { const int jx = jb + jj; const float v = im[jx]; int cnt = 0;
#pragma unroll
            for (int j2 = 0; j2 < 32; ++j2) { const float v2 = im[j2]; cnt += (v2 > v || (v2 == v && j2 < jx)) ? 1 : 0; }
            if (cnt < 16 && jx <= qb) bits |= 1u << jx; }
        bits |= __shfl_xor(bits, 1); bits |= __shfl_xor(bits, 2); bits |= __shfl_xor(bits, 4);
        if ((tid & 7) == 0) { MW[16 + q] = bits; __hip_atomic_fetch_or(MW, bits, __ATOMIC_RELAXED, __HIP_MEMORY_SCOPE_WORKGROUP); }
        __syncthreads();
    }
    if (PARTS & 2) {
    f32x16 o[2]; o[0] = f32x16{}; o[1] = f32x16{}; float m = 0.f, l = 0.f;
    const unsigned mask = MW[16 + sub * 32 + r32];
    const unsigned um = MW[0] & (qb >= 31 ? 0xffffffffu : ((2u << qb) - 1u));
    const bf16_t* Kg = (const bf16_t*)(ws + WS_KVN) + (size_t)(b * SEQ) * 768 + 256 + g * 64;
    attn_loop2(um, Kg, 768, Kg + 128, 768, lds, qr, o, m, l, TfT5{tb, qpos, hi, q0w, 1 << 30, mask, true}, q0w + 31);
    l = halfsum(l);
    scale_rows(o, wsf, sigmoidf_(gates[8 + hg]) / l, r32, hi);
    { bf16_t* ocw = (bf16_t*)a.out + (size_t)(b * SEQ + q0w) * 512 + hg * 64; store_o<true>(o, lds, ocw, 512, ocw, 512); }
    }
    if (PARTS & 4) {
    f32x16 o[2]; o[0] = f32x16{}; o[1] = f32x16{}; float m = -1e30f, l = 0.f;
    const int lo = qb > 8 ? qb - 8 : 0; const unsigned tmask = (qb >= 31 ? 0xffffffffu : ((2u << qb) - 1u)) & ~((1u << lo) - 1u);
    const bf16_t* Kg = (const bf16_t*)(ws + WS_KVN) + (size_t)(b * SEQ) * 768 + 512 + g * 64;
    attn_loop2(tmask, Kg, 768, Kg + 128, 768, lds, qr, o, m, l, TfT5{tb, qpos, hi, q0w, 512, 0u, false}, q0w + 31);
    l = halfsum(l);
    scale_rows(o, wsf, sigmoidf_(gates[16 + hg]) / l, r32, hi);
    { const bf16_t* ocw = (const bf16_t*)a.out + (size_t)(b * SEQ + q0w) * 512 + hg * 64; store_o<true>(o, lds, (bf16_t*)(ws + WS_QN) + (size_t)(b * SEQ + q0w) * 512 + hg * 64, 512, ocw, 512); }
    }
}
template <bool DRY> __device__ __forceinline__ void sel_unit(const Args& a, LAS unsigned char* lds, int b, int g, int qb) {
    using namespace att;
    unsigned char* ws = a.ws;
    const int tid = fresh_tid(), lane = tid & 63, r32 = lane & 31, hi = lane >> 5, wid = __builtin_amdgcn_readfirstlane(tid >> 6);
    const int j = wid >> 1, sub = wid & 1, hg = g * 4 + j, q0w = qb * 64 + sub * 32, qpos = q0w + r32; const size_t qrow = (size_t)b * SEQ + qpos;
    const LAS float* tb = (const LAS float*)(lds + L_TBL) + hg * 128; LAS float* wsf = (LAS float*)(lds + L_WSF) + wid * 64;
    bf16_t* Qw = (bf16_t*)(ws + WS_QN) + (size_t)(b * SEQ + q0w) * 512 + hg * 64;
    bf16x8 qr[4]; load_q(qr, Qw, 512, r32, hi);
    const unsigned mask = ((const unsigned*)(ws + WS_MASK))[(size_t)(b * 2 + g) * SEQ + qpos];
    const unsigned um = ((const unsigned*)(ws + WS_UMASK))[(b * 2 + g) * 32 + qb] & (qb >= 31 ? 0xffffffffu : ((2u << qb) - 1u));
    f32x16 o[2]; o[0] = f32x16{}; o[1] = f32x16{}; float m = -1e30f, l = 0.f;
    const bf16_t* Kg = (const bf16_t*)(ws + WS_KVN) + (size_t)(b * SEQ) * 768 + 256 + g * 64;
    attn_loop2(um, Kg, 768, Kg + 128, 768, lds, qr, o, m, l, TfT5{tb, qpos, hi, q0w, 1 << 30, mask, true}, q0w + 31);
    l = halfsum(l);
    const float g1 = sigmoidf_(((const float*)(ws + WS_F32S))[qrow * 32 + 8 + hg]);
    scale_rows(o, wsf, g1 / l, r32, hi);
    store_o<true>(o, lds, DRY ? (bf16_t*)((unsigned char*)a.out + 16 * MiB) + (size_t)(b * SEQ + q0w) * 512 + hg * 64 : Qw, 512, (const bf16_t*)a.out + (size_t)(b * SEQ + q0w) * 512 + hg * 64, 512);
}
#ifndef PHMASK
#define PHMASK 0xffffffffu
#endif
#define PH(n) (((PHMASK) >> (n)) & 1u)
#ifndef MULTI_ALIGN
#define MULTI_ALIGN true
#endif
#ifndef SINGLE_ALIGN
#define SINGLE_ALIGN true
#endif
#ifndef DUPMASK
#define DUPMASK 0u
#endif
#define DUP(n) (((DUPMASK) >> (n)) & 1u)
#define REP(n) for (int rep_ = 0; rep_ < 1 + (int)DUP(n); ++rep_)
#define STAGE_SS(S_, ssptr) do { LAS float* aux_ = (LAS float*)(lds + RING_BYTES); pg8::Unit u_; const int t_ = fresh_tid(); \
        for (int i_ = 0; S_.next(i_, u_); ++i_) if (t_ < 256) aux_[i_ * 256 + t_] = (ssptr)[u_.pm * 256 + t_]; \
        __syncthreads(); } while (0)
__global__ void __launch_bounds__(512, 2) hybrid_fwd(Args a) {
    extern __shared__ __attribute__((aligned(16))) unsigned char lds_raw[];
    LAS unsigned char* lds = (LAS unsigned char*)lds_raw;
    cg::grid_group grid = cg::this_grid();
    unsigned char* ws = a.ws;
    const int tid = fresh_tid(), lane = tid & 63, wave = __builtin_amdgcn_readfirstlane(tid >> 6);
    const int G = gridDim.x, bx = blockIdx.x, vcu = (G % 8 == 0) ? (bx % 8) * (G / 8) + bx / 8 : bx;
    const int gw = vcu * 8 + wave, NGW = G * 8;
    float* X = a.out;
    bf16_t* XB = (bf16_t*)(ws + WS_XB);
    float* SS = (float*)(ws + WS_SS);
    { volatile LAS unsigned* st0 = (volatile LAS unsigned*)(lds + LDS_BYTES - 256); if (tid < 32) st0[tid] = 0u; }
    __syncthreads();
    XcdBarrier xbar = xcd_barrier_post((unsigned*)(ws + WS_CTL) + CW_BAR, (volatile LAS unsigned*)(lds + LDS_BYTES - 256 + 32));
#ifdef USE_CG_SYNC
#define GSYNC() grid.sync()
#else
    if (a.lo == 0x7e57) grid.sync();
#ifdef TSTAMP
    int gs_cnt = 0; unsigned long long t_start = __builtin_amdgcn_s_memrealtime(), t_rec = 0;
    unsigned long long t_prev = t_start;
#define GSYNC() do { xcd_barrier(xbar); ++gs_cnt; if (gs_cnt == TSTAMP - 1) t_prev = __builtin_amdgcn_s_memrealtime(); if (gs_cnt == TSTAMP) t_rec = __builtin_amdgcn_s_memrealtime(); } while (0)
#else
#define GSYNC() xcd_barrier(xbar)
#endif
#endif
    const float* fin_src = a.in[I_X];

#if STAGE_LIMIT >= 1
    REP(0) p0_prologue(a, lds, gw, NGW, wave, lane);
    GSYNC();
    { pg8::Gemm g{XB, (const bf16_t*)(ws + WS_WGU1), DM, DM, DM, 0, 0, 0, 0}; pg8::Order S; S.init(64, 22, 1, G, bx);
      STAGE_SS(S, SS); pg8::EpiGU E{(bf16_t*)(ws + WS_H), (const LAS float*)(lds + RING_BYTES)};
#ifdef P1_NULLDUP
      { pg8::EpiNull E0{(float*)(ws + WS_POSC + 4096)}; pg8::gemm_phase<pg8::EpiNull, true>(lds, g, S, E0); }
#endif
      REP(1) pg8::gemm_phase<pg8::EpiGU, MULTI_ALIGN>(lds, g, S, E);
      if (bx >= 128) { LAS float* scr = (LAS float*)(lds + wave * 16384); conv_run(a, N_GU + (bx - 128) * 8 + wave, CONV_NA, 1024, scr, lane); } }
    GSYNC();
    { pg8::Gemm g{(const bf16_t*)(ws + WS_H), (const bf16_t*)(ws + WS_WD1), FF, FF, FF, 0, 0, 0, 0}; pg8::Order S; S.init(64, 4, 1, G, bx);
      if (DUP(2)) { pg8::EpiNull E0{(float*)(ws + WS_POSC + 4096)}; pg8::gemm_phase<pg8::EpiNull, false>(lds, g, S, E0); }
      pg8::EpiResB<false> E{nullptr, XB, SS + M, 0.5f}; pg8::gemm_phase<pg8::EpiResB<false>, false>(lds, g, S, E); }
    GSYNC();
    fin_src = X;
#endif
#if STAGE_LIMIT >= 2
#if PH(3)
    { pg8::Gemm g{XB, (const bf16_t*)(ws + WS_WIN), DM, DM, DM, 0, 0, 0, 0}; pg8::Order S; S.init(64, 20, 1, G, bx);
      pg8::EpiQKV E{(bf16_t*)(ws + WS_QN), (bf16_t*)(ws + WS_KVN), (bf16_t*)(ws + WS_QF), (bf16_t*)(ws + WS_KVF), (bf16_t*)(ws + WS_GAB), (float*)(ws + WS_F32S), (const LAS float*)(lds + RING_BYTES)};
      STAGE_SS(S, SS + M);
      REP(3) pg8::gemm_phase<pg8::EpiQKV, MULTI_ALIGN>(lds, g, S, E); }
#endif
    GSYNC();
#if PH(4)
    REP(4) if (bx < 128) { compress_unit(a, lds, bx); }
    else if (bx < 192) {
        { pg8::Gemm g{(const bf16_t*)(ws + WS_MEMB), (const bf16_t*)(ws + WS_WMKV), DM, DM, DM, 0, 0, 0, 0}; pg8::Order S; S.init(8, 8, 1, 64, bx - 128);
            pg8::EpiRowScale E{(bf16_t*)(ws + WS_KVM), 2 * DM, (const float*)(ws + WS_SSM)}; pg8::gemm_phase<pg8::EpiRowScale, false>(lds, g, S, E); }
    } else { if (wave == 0) cumsum_task(a, bx - 192, lane); kmax_task(a, lds, bx - 192, wave, lane); }
    if (bx >= 128) {
        LAS float* scr = (LAS float*)(lds + wave * 16384);
        if (bx < 192) conv_run(a, CONV_NA + (bx - 128) * 8 + wave, CONV_NA + CONV_NB, 1536, scr, lane);
        else { const int s0_ = 512 + ((bx - 192) * 8 + wave) * 2; conv_run(a, CONV_NA + s0_, CONV_NA + CONV_NB, 1536, scr, lane); conv_run(a, CONV_NA + s0_ + 1, CONV_NA + CONV_NB, 1536, scr, lane); }
        wqn_rows(a, (bx - 128) * 8 + wave, 1024, lane); }
#endif
    GSYNC();
#if PH(5)
    init_t5_table(a, lds);
    { const int bh = vcu >> 2, s = vcu & 3; if (DUP(5)) { fox_unit<true>(a, lds, bh >> 3, bh & 7, 7 - s); fox_unit<true>(a, lds, bh >> 3, bh & 7, s); }
      fox_unit<false>(a, lds, bh >> 3, bh & 7, 7 - s); fox_unit<false>(a, lds, bh >> 3, bh & 7, s); }
#ifdef DUPPART
    { const int bg = vcu >> 4, s = vcu & 15; cmpwin_unit<DUPPART>(a, lds, bg >> 1, bg & 1, 31 - s); cmpwin_unit<DUPPART>(a, lds, bg >> 1, bg & 1, s); }
#endif
#ifndef NO_CMPWIN
    REP(15) { const int bg = vcu >> 4, s = vcu & 15; cmpwin_unit<7>(a, lds, bg >> 1, bg & 1, 31 - s); cmpwin_unit<7>(a, lds, bg >> 1, bg & 1, s); }
#endif
#endif
    GSYNC();
#if PH(7)
    REP(7) { pg8::Order S; S.init(64, 4, 1, G, bx);
      { pg8::Gemm g{(const bf16_t*)(ws + WS_QN), (const bf16_t*)(ws + WS_WUPN), 512, 512, 512, 0, 0, 0, 0}; pg8::EpiUp<0> E{(const bf16_t*)(ws + WS_GAB), (bf16_t*)(ws + WS_Y)}; pg8::gemm_phase<pg8::EpiUp<0>, false>(lds, g, S, E); }
      { pg8::Gemm g{(const bf16_t*)(ws + WS_QF), (const bf16_t*)(ws + WS_WUPF), 512, 512, 512, 0, 0, 0, 0}; pg8::EpiUp<1> E{(const bf16_t*)(ws + WS_GAB), (bf16_t*)(ws + WS_Y)}; pg8::gemm_phase<pg8::EpiUp<1>, false>(lds, g, S, E); } }
#endif
    GSYNC();
#if PH(8)
    { pg8::Gemm g{(const bf16_t*)(ws + WS_Y), (const bf16_t*)(ws + WS_WOUT), DM, DM, DM, 0, 0, 0, 0}; pg8::Order S; S.init(64, 4, 1, G, bx);
      if (DUP(8)) { pg8::EpiNull E0{(float*)(ws + WS_POSC + 4096)}; pg8::gemm_phase<pg8::EpiNull, false>(lds, g, S, E0); }
      pg8::EpiResB<false> E{nullptr, XB, SS + 2 * M, 1.0f}; pg8::gemm_phase<pg8::EpiResB<false>, false>(lds, g, S, E); }
    if (bx < 128) { pg8::Gemm g{(const bf16_t*)(ws + WS_KVM), (const bf16_t*)(ws + WS_WMQ), 2 * DM, DM, 256, (long)MEMLEN * 2 * DM, 256, 0, 256};
        pg8::OneUnit S{pg8::Unit{0, bx & 3, bx >> 2}}; pg8::EpiBatchBf16 E{(bf16_t*)(ws + WS_MT), DM, (long)DM * DM, (long)256 * DM}; pg8::gemm_phase<pg8::EpiBatchBf16, false>(lds, g, S, E); }
    else { pg8::Gemm g{(const bf16_t*)(ws + WS_WMO), (const bf16_t*)(ws + WS_KVM) + DM, DM, 2 * DM, 256, 0, 256, (long)MEMLEN * 2 * DM, 256};
        pg8::OneUnit S{pg8::Unit{(bx - 128) & 3, 0, (bx - 128) >> 2}}; pg8::EpiBatchBf16 E{(bf16_t*)(ws + WS_NT), DM, (long)DM * DM, 256}; pg8::gemm_phase<pg8::EpiBatchBf16, false>(lds, g, S, E); }
#endif
    GSYNC();
#endif
#if STAGE_LIMIT >= 3
    { pg8::Gemm g{XB, (const bf16_t*)(ws + WS_MT), DM, DM, DM, 0, 0, (long)4 * DM * DM, (long)DM * DM}; pg8::Order S; S.init(64, 4, 1, G, bx, 3);
      pg8::EpiSoftmaxRS E{(bf16_t*)(ws + WS_PM), DM, SS + 2 * M}; pg8::gemm_phase<pg8::EpiSoftmaxRS, false>(lds, g, S, E); }
    GSYNC();
    { pg8::Gemm g{(const bf16_t*)(ws + WS_PM), (const bf16_t*)(ws + WS_NT), DM, DM, DM, 0, 0, (long)4 * DM * DM, (long)DM * DM}; pg8::Order S; S.init(64, 4, 1, G, bx, 3);
      pg8::EpiResB<false> E{nullptr, XB, SS + 3 * M, 1.0f}; pg8::gemm_phase<pg8::EpiResB<false>, false>(lds, g, S, E); }
    GSYNC();
#endif
#if STAGE_LIMIT >= 4
    { pg8::Gemm g{XB, (const bf16_t*)(ws + WS_WGU2), DM, DM, DM, 0, 0, 0, 0}; pg8::Order S; S.init(64, 22, 1, G, bx);
      STAGE_SS(S, SS + 3 * M); pg8::EpiGU E{(bf16_t*)(ws + WS_H), (const LAS float*)(lds + RING_BYTES)}; REP(13) pg8::gemm_phase<pg8::EpiGU, MULTI_ALIGN>(lds, g, S, E); }
    GSYNC();
    { pg8::Gemm g{(const bf16_t*)(ws + WS_H), (const bf16_t*)(ws + WS_WD2), FF, FF, FF, 0, 0, 0, 0}; pg8::Order S; S.init(64, 4, 1, G, bx);
      pg8::EpiResNorm E{XB, X, 0.5f, a.in[I_FINN], (float*)(ws + WS_XBUF), (unsigned*)(ws + WS_FINCNT)}; pg8::gemm_phase<pg8::EpiResNorm, false>(lds, g, S, E); }
#ifdef TSTAMP
    GSYNC();
    if (t_rec == 0) t_rec = __builtin_amdgcn_s_memrealtime();
    if (bx == 0) { const int n = (int)((t_rec - t_prev) * 400 / 100); for (int i = tid; i < n; i += 512) X[i] += 0.1f; }
#endif
    return;
#endif
#ifdef EXTRA_BARS
    for (int eb = 0; eb < EXTRA_BARS; ++eb) GSYNC();
#endif
    { const float* gn = a.in[I_FINN]; const int tid2 = fresh_tid(), lane = tid2 & 63, gw = vcu * 8 + (tid2 >> 6);
      for (int mrow = gw; mrow < M; mrow += NGW) {
          const f32x4* xr = (const f32x4*)(fin_src + (size_t)mrow * DM) + lane; f32x4* orow = (f32x4*)(X + (size_t)mrow * DM) + lane;
          f32x4 v[4]; float s = 0.f;
#pragma unroll
          for (int j = 0; j < 4; ++j) { v[j] = xr[64 * j]; s += (v[j][0] * v[j][0] + v[j][1] * v[j][1]) + (v[j][2] * v[j][2] + v[j][3] * v[j][3]); }
          const float rs = rstd_of(wave_sum(s));
#pragma unroll
          for (int j = 0; j < 4; ++j) orow[64 * j] = v[j] * rs * ((const f32x4*)gn)[lane + 64 * j];
      } }
}

extern "C" void kernel_launch(void* const* d_in, const int* in_sizes, int n_in, void* d_out, int out_size, void* d_ws, size_t ws_size, hipStream_t stream) {
    static int grid = 0;
    if (grid == 0) {
        if (n_in != 29 || out_size != M * DM || ws_size < WS_END) { fprintf(stderr, "kernel_launch: unexpected shapes (n_in %d out %d ws %zu)\n", n_in, out_size, ws_size); grid = -1; return; }
        int dev = 0, cus = 0, per_cu = 0;
        hipGetDevice(&dev); hipDeviceGetAttribute(&cus, hipDeviceAttributeMultiprocessorCount, dev);
        if (hipFuncSetAttribute((const void*)hybrid_fwd, hipFuncAttributeMaxDynamicSharedMemorySize, LDS_BYTES) != hipSuccess) { fprintf(stderr, "kernel_launch: hipFuncSetAttribute failed\n"); grid = -1; return; }
        if (hipOccupancyMaxActiveBlocksPerMultiprocessor(&per_cu, (const void*)hybrid_fwd, 512, LDS_BYTES) != hipSuccess || per_cu < 1) { fprintf(stderr, "kernel_launch: occupancy query failed (%d)\n", per_cu); per_cu = 1; }
        (void)hipGetLastError();
        grid = cus * (per_cu < 1 ? 1 : 1);
        if (grid != 256) fprintf(stderr, "kernel_launch: grid %d != 256: this kernel's phase maps assume 256 workgroups\n", grid);
    }
    if (grid < 0) return;
    hipMemsetAsync((char*)d_ws + WS_CTL, 0, CTL_ZERO_BYTES, stream);
    Args a{};
    for (int i = 0; i < 29; ++i) a.in[i] = (const float*)d_in[i];
    a.out = (float*)d_out; a.ws = (unsigned char*)d_ws; a.lo = 0; a.hi = 0;
    void* args[] = {&a};
#ifdef PLAIN_LAUNCH
    hipLaunchKernelGGL(hybrid_fwd, dim3(grid), dim3(512), LDS_BYTES, stream, a); hipError_t e = hipPeekAtLastError(); (void)args;
#else
    hipError_t e = hipLaunchCooperativeKernel((const void*)hybrid_fwd, dim3(grid), dim3(512), args, LDS_BYTES, stream);
#endif
    if (e != hipSuccess) fprintf(stderr, "kernel_launch: cooperative launch failed: %s (grid %d)\n", hipGetErrorString(e), grid);
}
```

```cpp
#define ATT_GRP(w) 0
#include <hip/hip_runtime.h>
#include <hip/hip_cooperative_groups.h>
#include <cstdio>
#include <cstdint>
namespace cg = cooperative_groups;

#define LAS __attribute__((address_space(3)))
typedef unsigned short bf16_t;
typedef short bf16x8 __attribute__((ext_vector_type(8)));
typedef short s16x4 __attribute__((ext_vector_type(4)));
typedef float f32x2 __attribute__((ext_vector_type(2)));
typedef float f32x4 __attribute__((ext_vector_type(4)));
typedef float f32x16 __attribute__((ext_vector_type(16)));
typedef unsigned u32x2 __attribute__((ext_vector_type(2)));
typedef unsigned u32x4 __attribute__((ext_vector_type(4)));
typedef __bf16 bf16x2_t __attribute__((ext_vector_type(2)));

constexpr int NB = 8, SEQ = 2048, DM = 1024, FF = 2816, M = NB * SEQ;
constexpr int MEMLEN = 256, MROWS = NB * MEMLEN;
constexpr float RMS_EPS = 1e-6f;
constexpr float LOG2E = 1.4426950408889634f;
constexpr float QS64 = 0.125f * LOG2E;
constexpr float QS256 = 0.0625f * LOG2E;

__device__ __forceinline__ int fresh_tid() { int t = threadIdx.x; asm volatile("" : "+v"(t)); return t; }
__device__ __forceinline__ unsigned cvtpk(float lo, float hi) { f32x2 v = {lo, hi}; bf16x2_t b = __builtin_convertvector(v, bf16x2_t); return __builtin_bit_cast(unsigned, b); }
__device__ __forceinline__ float bflo(unsigned w) { return __uint_as_float(w << 16); }
__device__ __forceinline__ float bfhi(unsigned w) { return __uint_as_float(w & 0xffff0000u); }
__device__ __forceinline__ u32x4 pack8(f32x4 a, f32x4 b) { u32x4 w; w.x = cvtpk(a[0], a[1]); w.y = cvtpk(a[2], a[3]); w.z = cvtpk(b[0], b[1]); w.w = cvtpk(b[2], b[3]); return w; }
__device__ __forceinline__ float fexp2(float x) { return __builtin_amdgcn_exp2f(x); }
__device__ __forceinline__ float frcp(float x) { return __builtin_amdgcn_rcpf(x); }
__device__ __forceinline__ float sigmoidf_(float x) { return frcp(1.0f + fexp2(-x * LOG2E)); }
__device__ __forceinline__ float rstd_of(float ss) { return __builtin_amdgcn_rsqf(ss * (1.0f / DM) + RMS_EPS); }
constexpr float SSQ_SCALE = 1048576.0f;
__device__ __forceinline__ float ssq_f(unsigned long long q) { return (float)q * (1.0f / SSQ_SCALE); }

namespace pg8 {
constexpr int BM = 256, BK = 64, HALF = 128, HTB = HALF * BK * 2, STAGE_BYTES = 8 * HTB, NXCD = 8, WGM = 8;
__host__ __device__ __forceinline__ int lds_byte(int r, int c) { const int st = (r >> 4) * 2 + (c >> 5), rr = r & 15, cc = c & 31, ob = rr * 64 + cc * 2; return st * 1024 + (ob ^ (((ob >> 9) & 1) << 5)); }
__host__ __device__ __forceinline__ void stage_rc(int b, int& R, int& C) { const int st = b / 1024, sb = b % 1024, swz = sb ^ (((sb >> 9) & 1) << 5); R = (st >> 1) * 16 + swz / 64; C = (st & 1) * 32 + (swz % 64) / 2; }
__host__ __device__ __forceinline__ int perm32(int rho) { const int n = rho >> 4, i = rho & 15; return 8 * (i >> 2) + 4 * n + (i & 3); }

struct Unit { int pm, pn, pb, ui; };
struct Gemm { const bf16_t* A; const bf16_t* Bt; int lda, ldb, K; long sAb, sAh, sBb, sBh; };

struct Order {
    int nM, nN, nwg, G, c, pbs;
    __device__ __forceinline__ void init(int nM_, int nN_, int nB_, int G_, int c_, int pbs_ = -1) { nM = nM_; nN = nN_; nwg = nM_ * nN_ * nB_; G = G_; c = c_; pbs = pbs_; }
    __device__ __forceinline__ bool next(int i, Unit& u) const {
        if (c < 0) return false;
        const long L = (long)i * G + c; if (L >= nwg) return false;
        int wgid = (int)L; { const int q = nwg / NXCD, r = nwg % NXCD, xcd = wgid % NXCD, off = wgid / NXCD; wgid = (xcd < r ? xcd * (q + 1) : r * (q + 1) + (xcd - r) * q) + off; }
        const int per = nM * nN; u.pb = wgid / per; const int w = wgid % per;
        const int nig = WGM * nN, gid = w / nig, fm = gid * WGM, gsz = (nM - fm) < WGM ? (nM - fm) : WGM;
        u.pm = fm + ((w % nig) % gsz); u.pn = (w % nig) / gsz; if (pbs >= 0) u.pb = u.pm >> pbs; return true;
    }
};

struct PairOrder { Order base; __device__ __forceinline__ bool next(int i, Unit& o) const { if (i >= 2) return false; base.next(0, o); o.pb = i; return true; } };
struct OneUnit { Unit u; __device__ __forceinline__ bool next(int i, Unit& o) const { if (i != 0) return false; o = u; o.ui = 0; return true; } };

typedef f32x4 Acc[2][2][4][2];

template <class Epi, bool ALIGN_EPI, class Sched>
__device__ __forceinline__ void gemm_phase(LAS unsigned char* lds, const Gemm g, const Sched& S, const Epi& E) {
    const int tid = fresh_tid(), wid = __builtin_amdgcn_readfirstlane(tid >> 6), lane = tid & 63, wr = wid >> 2, wc = wid & 3, fr = lane & 15, fq = lane >> 4;
    const int K = g.K, nt = K / BK;
    unsigned voffA[2], voffB[2];
#pragma unroll
    for (int i = 0; i < 2; ++i) { int R, C; stage_rc(tid * 16 + i * 8192, R, C); const int Rb = (R & ~31) + perm32(R & 31);
        voffA[i] = (unsigned)(R * g.lda + C) * 2u; voffB[i] = (unsigned)(Rb * g.ldb + C) * 2u; }
    const size_t kstep = (size_t)(BK * 2);
    const size_t hstepA = (size_t)HALF * g.lda * 2, hstepB = (size_t)HALF * g.ldb * 2;
    const size_t tstepA = 2 * hstepA, tstepB = 2 * hstepB;
    const unsigned ldsw = (unsigned)wid * 1024u;
    const int aoff = lds_byte(wr * 64 + fr, fq * 8), boff = lds_byte(wc * 32 + fr, fq * 8);
#define PG8_SA(b, h) (((b) * 2 + (h)) * HTB)
#define PG8_SB(b, h) ((4 + (b) * 2 + (h)) * HTB)
#define PG8_STAGE(bufoff, gbase, voff) do { _Pragma("unroll") for (int _i = 0; _i < 2; ++_i) \
        __builtin_amdgcn_global_load_lds((const unsigned*)((const char*)(gbase) + (voff)[_i]), (LAS unsigned*)(lds + (bufoff) + ldsw + _i * 8192), 16, 0, 0); } while (0)
#define PG8_LDA(dst, b, h) do { _Pragma("unroll") for (int m = 0; m < 4; ++m) _Pragma("unroll") for (int k = 0; k < 2; ++k) dst[m][k] = *(const LAS bf16x8*)(lds + PG8_SA(b, h) + aoff + m * 2048 + k * 1024); } while (0)
#define PG8_LDB(dst, b, h) do { _Pragma("unroll") for (int n = 0; n < 2; ++n) _Pragma("unroll") for (int k = 0; k < 2; ++k) dst[n][k] = *(const LAS bf16x8*)(lds + PG8_SB(b, h) + boff + n * 2048 + k * 1024); } while (0)
#define PG8_MMA(ai, bj, At, Bt) do { __builtin_amdgcn_s_setprio(1); _Pragma("unroll") for (int m = 0; m < 4; ++m) _Pragma("unroll") for (int n = 0; n < 2; ++n) _Pragma("unroll") for (int k = 0; k < 2; ++k) \
        acc[ai][bj][m][n] = __builtin_amdgcn_mfma_f32_16x16x32_bf16(Bt[n][k], At[m][k], acc[ai][bj][m][n], 0, 0, 0); __builtin_amdgcn_s_setprio(0); } while (0)
#define PG8_WAIT_V(n) asm volatile("s_waitcnt vmcnt(" #n ")" ::: "memory")
#define PG8_WAIT_L(n) asm volatile("s_waitcnt lgkmcnt(" #n ")" ::: "memory")
#define PG8_BAR __builtin_amdgcn_s_barrier()
#define PG8_SCHED __builtin_amdgcn_sched_barrier(0)
#define PG8_OFFA(u) ((size_t)(((u).pb >> 2) * g.sAb + ((u).pb & 3) * g.sAh) * 2 + (size_t)(u).pm * tstepA)
#define PG8_OFFB(u) ((size_t)(((u).pb >> 2) * g.sBb + ((u).pb & 3) * g.sBh) * 2 + (size_t)(u).pn * tstepB)
    Unit cur, nxt; int ui = 0;
    if (!S.next(0, cur)) return;
    cur.ui = 0;
    Acc acc;
#pragma unroll
    for (int a = 0; a < 2; ++a)
#pragma unroll
        for (int b = 0; b < 2; ++b)
#pragma unroll
            for (int m = 0; m < 4; ++m)
#pragma unroll
                for (int n = 0; n < 2; ++n) acc[a][b][m][n] = (f32x4){0.f, 0.f, 0.f, 0.f};
    bf16x8 At[4][2], B0[2][2], B1[2][2];
    const char* cA = (const char*)g.A + PG8_OFFA(cur); const char* cB = (const char*)g.Bt + PG8_OFFB(cur);
    {
        PG8_STAGE(PG8_SB(0, 0), cB, voffB); PG8_STAGE(PG8_SB(0, 1), cB + hstepB, voffB); PG8_STAGE(PG8_SA(0, 0), cA, voffA); PG8_STAGE(PG8_SA(0, 1), cA + hstepA, voffA);
        if (wr == 1) PG8_BAR;
        PG8_WAIT_V(2); PG8_BAR;
        PG8_STAGE(PG8_SB(1, 0), cB + kstep, voffB); PG8_STAGE(PG8_SA(1, 0), cA + kstep, voffA); PG8_STAGE(PG8_SB(1, 1), cB + hstepB + kstep, voffB);
        PG8_WAIT_V(6); PG8_BAR;
    }
    for (;;) {
        const bool has_next = S.next(ui + 1, nxt); nxt.ui = ui + 1;
        const char* nA = has_next ? (const char*)g.A + PG8_OFFA(nxt) : cA; const char* nB = has_next ? (const char*)g.Bt + PG8_OFFB(nxt) : cB;
        for (int t = 0; t < nt; t += 2) {
            const bool last = (t == nt - 2);
            const char* a1 = cA + (size_t)(t + 1) * kstep;
            const char* a2 = last ? nA : cA + (size_t)(t + 2) * kstep; const char* b2 = last ? nB : cB + (size_t)(t + 2) * kstep;
            const char* a3 = a2 + kstep; const char* b3 = b2 + kstep;
            PG8_LDB(B0, 0, 0); PG8_LDB(B1, 0, 1); PG8_SCHED; PG8_LDA(At, 0, 0); PG8_STAGE(PG8_SA(1, 1), a1 + hstepA, voffA);
            PG8_WAIT_V(8); PG8_WAIT_L(0); PG8_BAR; PG8_MMA(0, 0, At, B0); PG8_MMA(0, 1, At, B1); PG8_BAR; PG8_SCHED;
            PG8_LDA(At, 0, 1); PG8_STAGE(PG8_SB(0, 0), b2, voffB); PG8_STAGE(PG8_SB(0, 1), b2 + hstepB, voffB); PG8_STAGE(PG8_SA(0, 0), a2, voffA);
            PG8_WAIT_V(8); PG8_WAIT_L(0); PG8_BAR; PG8_MMA(1, 0, At, B0); PG8_MMA(1, 1, At, B1); PG8_BAR; PG8_SCHED;
            PG8_LDB(B0, 1, 0); PG8_LDB(B1, 1, 1); PG8_SCHED; PG8_LDA(At, 1, 0); PG8_STAGE(PG8_SA(0, 1), a2 + hstepA, voffA);
            PG8_WAIT_V(8); PG8_WAIT_L(0); PG8_BAR; PG8_MMA(0, 0, At, B0); PG8_MMA(0, 1, At, B1); PG8_BAR; PG8_SCHED;
            PG8_LDA(At, 1, 1); PG8_STAGE(PG8_SB(1, 0), b3, voffB); PG8_STAGE(PG8_SB(1, 1), b3 + hstepB, voffB); PG8_STAGE(PG8_SA(1, 0), a3, voffA);
            PG8_WAIT_V(8); PG8_WAIT_L(0); PG8_BAR; PG8_MMA(1, 0, At, B0); PG8_MMA(1, 1, At, B1); PG8_BAR; PG8_SCHED;
        }
        if constexpr (ALIGN_EPI) { if (wr == 0) PG8_BAR; }
        if constexpr (!Epi::AFTER_DRAIN) { const int l2_ = fresh_tid() & 63; E(acc, cur, wr, wc, l2_ & 15, l2_ >> 4); }
        if (!has_next) break;
#pragma unroll
        for (int a = 0; a < 2; ++a)
#pragma unroll
            for (int b = 0; b < 2; ++b)
#pragma unroll
                for (int m = 0; m < 4; ++m)
#pragma unroll
                    for (int n = 0; n < 2; ++n) acc[a][b][m][n] = (f32x4){0.f, 0.f, 0.f, 0.f};
        cur = nxt; cA = nA; cB = nB; ++ui;
        if constexpr (ALIGN_EPI) { if (wr == 1) PG8_BAR; }
    }
    PG8_WAIT_V(0);
    if constexpr (!ALIGN_EPI) { if (wr == 0) PG8_BAR; }
    PG8_BAR;
    if constexpr (Epi::AFTER_DRAIN) { const int l2_ = fresh_tid() & 63; E.fused(acc, cur, wr, wc, l2_ & 15, l2_ >> 4, lds, wid, l2_); }
#undef PG8_SA
#undef PG8_SB
#undef PG8_STAGE
#undef PG8_LDA
#undef PG8_LDB
#undef PG8_MMA
#undef PG8_WAIT_V
#undef PG8_WAIT_L
#undef PG8_BAR
#undef PG8_SCHED
#undef PG8_OFFA
#undef PG8_OFFB
}

struct EpiNull { static constexpr bool AFTER_DRAIN = false; float* sink; __device__ __forceinline__ void operator()(const Acc& acc, const Unit& u, int wr, int wc, int fr, int fq) const { f32x4 s = {0.f, 0.f, 0.f, 0.f};
_Pragma("unroll") for (int a = 0; a < 2; ++a) _Pragma("unroll") for (int b = 0; b < 2; ++b) _Pragma("unroll") for (int m = 0; m < 4; ++m) _Pragma("unroll") for (int n = 0; n < 2; ++n) s += acc[a][b][m][n];
 if (s[0] + s[1] + s[2] + s[3] == 1234567.25f) sink[0] = 1.f; } };
struct EpiGU {
    static constexpr bool AFTER_DRAIN = false;
    bf16_t* H; const LAS float* aux;
    __device__ __forceinline__ void operator()(const Acc& acc, const Unit& u, int wr, int wc, int fr, int fq) const {
        const int row0 = u.pm * BM + wr * 64 + fr, col0 = u.pn * 128 + wc * 32 + fq * 8;
        float rsv[2][4];
#pragma unroll
        for (int ai = 0; ai < 2; ++ai)
#pragma unroll
            for (int m = 0; m < 4; ++m) rsv[ai][m] = aux[u.ui * 256 + wr * 64 + fr + ai * HALF + m * 16];
#pragma unroll
        for (int ai = 0; ai < 2; ++ai)
#pragma unroll
            for (int m = 0; m < 4; ++m) {
                const int row = row0 + ai * HALF + m * 16; const float rs = rstd_of(rsv[ai][m]);
                f32x4 h[2];
#pragma unroll
                for (int n = 0; n < 2; ++n) { const f32x4 gg = acc[ai][0][m][n] * rs, uu = acc[ai][1][m][n] * rs;
#pragma unroll
                    for (int j = 0; j < 4; ++j) h[n][j] = gg[j] * sigmoidf_(gg[j]) * uu[j]; }
                *(u32x4*)(H + (size_t)row * FF + col0) = pack8(h[0], h[1]);
            }
    }
};
template <bool WRITE_XB, bool WRITE_SS> struct EpiRes {
    static constexpr bool AFTER_DRAIN = false;
    const float* base; float* out; bf16_t* xb; float* ss; float scale;
    __device__ __forceinline__ void operator()(const Acc& acc, const Unit& u, int wr, int wc, int fr, int fq) const {
        const int row0 = u.pm * BM + wr * 64 + fr, col0 = u.pn * BM + wc * 32 + fq * 8;
#pragma unroll
        for (int ai = 0; ai < 2; ++ai)
#pragma unroll
            for (int m2 = 0; m2 < 4; m2 += 2) {
                f32x4 o[2][2][2];
#pragma unroll
                for (int mm = 0; mm < 2; ++mm)
#pragma unroll
                    for (int bj = 0; bj < 2; ++bj) { const size_t p = (size_t)(row0 + ai * HALF + (m2 + mm) * 16) * DM + col0 + bj * HALF; o[mm][bj][0] = *(const f32x4*)(base + p); o[mm][bj][1] = *(const f32x4*)(base + p + 4); }
#pragma unroll
                for (int mm = 0; mm < 2; ++mm) { const int m = m2 + mm, row = row0 + ai * HALF + m * 16; float sq = 0.f;
#pragma unroll
                    for (int bj = 0; bj < 2; ++bj) { const size_t p = (size_t)row * DM + col0 + bj * HALF;
                        const f32x4 n0 = o[mm][bj][0] + acc[ai][bj][m][0] * scale, n1 = o[mm][bj][1] + acc[ai][bj][m][1] * scale;
                        *(f32x4*)(out + p) = n0; *(f32x4*)(out + p + 4) = n1;
                        if (WRITE_XB) *(u32x4*)(xb + p) = pack8(n0, n1);
                        if (WRITE_SS) sq += (n0[0] * n0[0] + n0[1] * n0[1]) + (n0[2] * n0[2] + n0[3] * n0[3]) + (n1[0] * n1[0] + n1[1] * n1[1]) + (n1[2] * n1[2] + n1[3] * n1[3]); }
                    if (WRITE_SS) { sq += __shfl_xor(sq, 16); sq += __shfl_xor(sq, 32); if (fq == 0) unsafeAtomicAdd(ss + row, sq); } }
                asm volatile("" ::: "memory");
            }
    }
};
template <bool BASE_F32> struct EpiResB {
    static constexpr bool AFTER_DRAIN = false;
    const float* basef; bf16_t* xb; unsigned long long* ss; float scale;
    __device__ __forceinline__ void operator()(const Acc& acc, const Unit& u, int wr, int wc, int fr, int fq) const {
        const int row0 = u.pm * BM + wr * 64 + fr, col0 = u.pn * BM + wc * 32 + fq * 8;
#pragma unroll
        for (int ai = 0; ai < 2; ++ai) {
            f32x4 of[4][2][2]; u32x4 ob[4][2];
#pragma unroll
            for (int m = 0; m < 4; ++m)
#pragma unroll
                for (int bj = 0; bj < 2; ++bj) { const size_t p = (size_t)(row0 + ai * HALF + m * 16) * DM + col0 + bj * HALF;
                    if (BASE_F32) { of[m][bj][0] = *(const f32x4*)(basef + p); of[m][bj][1] = *(const f32x4*)(basef + p + 4); } else ob[m][bj] = *(const u32x4*)(xb + p); }
#pragma unroll
            for (int m = 0; m < 4; ++m) { const int row = row0 + ai * HALF + m * 16; float sq = 0.f;
#pragma unroll
                for (int bj = 0; bj < 2; ++bj) { const size_t p = (size_t)row * DM + col0 + bj * HALF; f32x4 o0, o1;
                    if (BASE_F32) { o0 = of[m][bj][0]; o1 = of[m][bj][1]; }
                    else { const u32x4 w = ob[m][bj]; o0 = (f32x4){bflo(w.x), bfhi(w.x), bflo(w.y), bfhi(w.y)}; o1 = (f32x4){bflo(w.z), bfhi(w.z), bflo(w.w), bfhi(w.w)}; }
                    const f32x4 n0 = o0 + acc[ai][bj][m][0] * scale, n1 = o1 + acc[ai][bj][m][1] * scale;
                    *(u32x4*)(xb + p) = pack8(n0, n1);
                    sq += (n0[0] * n0[0] + n0[1] * n0[1]) + (n0[2] * n0[2] + n0[3] * n0[3]) + (n1[0] * n1[0] + n1[1] * n1[1]) + (n1[2] * n1[2] + n1[3] * n1[3]); }
                sq += __shfl_xor(sq, 16); sq += __shfl_xor(sq, 32); if (fq == 0) __hip_atomic_fetch_add(ss + row, (unsigned long long)(sq * SSQ_SCALE + 0.5f), __ATOMIC_RELAXED, __HIP_MEMORY_SCOPE_AGENT); }
            asm volatile("" ::: "memory"); }
    }
};
struct EpiQKV {
    static constexpr bool AFTER_DRAIN = false;
    bf16_t *QN, *KVN, *QF, *KVF, *GAB; float* F32S; const LAS float* aux;
    __device__ __forceinline__ void operator()(const Acc& acc, const Unit& u, int wr, int wc, int fr, int fq) const {
        const int row0 = u.pm * BM + wr * 64 + fr, pn = u.pn;
        if (pn == 19) {
            if (wc == 0) {
#pragma unroll
                for (int ai = 0; ai < 2; ++ai)
#pragma unroll
                    for (int m = 0; m < 4; ++m) { const int row = row0 + ai * HALF + m * 16; const float rs = rstd_of(aux[u.ui * 256 + wr * 64 + fr + ai * HALF + m * 16]);
                        *(f32x4*)(F32S + (size_t)row * 32 + fq * 8) = acc[ai][0][m][0] * rs; *(f32x4*)(F32S + (size_t)row * 32 + fq * 8 + 4) = acc[ai][0][m][1] * rs; }
            }
            return;
        }
        bf16_t* dst; int pitch, coff;
        if (pn < 2) { dst = QN; pitch = 512; coff = pn * 256; }
        else if (pn < 5) { dst = KVN; pitch = 768; coff = (pn - 2) * 256; }
        else if (pn < 7) { dst = QF; pitch = 512; coff = (pn - 5) * 256; }
        else if (pn < 11) { dst = KVF; pitch = 1024; coff = (pn - 7) * 256; }
        else { dst = GAB; pitch = 2048; coff = (pn - 11) * 256; }
        coff += wc * 32 + fq * 8;
        float rsv[2][4];
#pragma unroll
        for (int ai = 0; ai < 2; ++ai)
#pragma unroll
            for (int m = 0; m < 4; ++m) rsv[ai][m] = aux[u.ui * 256 + wr * 64 + fr + ai * HALF + m * 16];
#pragma unroll
        for (int ai = 0; ai < 2; ++ai)
#pragma unroll
            for (int m = 0; m < 4; ++m) { const int row = row0 + ai * HALF + m * 16; const float rs = rstd_of(rsv[ai][m]);
#pragma unroll
                for (int bj = 0; bj < 2; ++bj) *(u32x4*)(dst + (size_t)row * pitch + coff + bj * HALF) = pack8(acc[ai][bj][m][0] * rs, acc[ai][bj][m][1] * rs); }
    }
};
template <int STEP_> struct EpiUp {
    static constexpr bool AFTER_DRAIN = false;
    const bf16_t* GAB; bf16_t* Y;
    __device__ __forceinline__ void operator()(const Acc& acc, const Unit& u, int wr, int wc, int fr, int fq) const {
        const int STEP = STEP_ == 2 ? u.pb : STEP_;
        const int row0 = u.pm * BM + wr * 64 + fr, col0 = u.pn * BM + wc * 32 + fq * 8;
#pragma unroll
        for (int ai = 0; ai < 2; ++ai) {
            u32x4 gw[4][2], yw[4][2];
#pragma unroll
            for (int m = 0; m < 4; ++m)
#pragma unroll
                for (int bj = 0; bj < 2; ++bj) { const int row = row0 + ai * HALF + m * 16, c = col0 + bj * HALF;
                    gw[m][bj] = *(const u32x4*)(GAB + (size_t)row * 2048 + STEP * 1024 + c); if (STEP == 1) yw[m][bj] = *(const u32x4*)(Y + (size_t)row * DM + c); }
#pragma unroll
            for (int m = 0; m < 4; ++m)
#pragma unroll
                for (int bj = 0; bj < 2; ++bj) { const int row = row0 + ai * HALF + m * 16, c = col0 + bj * HALF; const u32x4 g4 = gw[m][bj];
                    f32x4 v0, v1; const f32x4 a0 = acc[ai][bj][m][0], a1 = acc[ai][bj][m][1];
                    v0[0] = sigmoidf_(bflo(g4.x)) * a0[0]; v0[1] = sigmoidf_(bfhi(g4.x)) * a0[1]; v0[2] = sigmoidf_(bflo(g4.y)) * a0[2]; v0[3] = sigmoidf_(bfhi(g4.y)) * a0[3];
                    v1[0] = sigmoidf_(bflo(g4.z)) * a1[0]; v1[1] = sigmoidf_(bfhi(g4.z)) * a1[1]; v1[2] = sigmoidf_(bflo(g4.w)) * a1[2]; v1[3] = sigmoidf_(bfhi(g4.w)) * a1[3];
                    if (STEP == 1) { const u32x4 y = yw[m][bj];
                        v0[0] += bflo(y.x); v0[1] += bfhi(y.x); v0[2] += bflo(y.y); v0[3] += bfhi(y.y); v1[0] += bflo(y.z); v1[1] += bfhi(y.z); v1[2] += bflo(y.w); v1[3] += bfhi(y.w); }
                    *(u32x4*)(Y + (size_t)row * DM + c) = pack8(v0, v1); }
            asm volatile("" ::: "memory"); }
    }
};
struct EpiRowScale {
    static constexpr bool AFTER_DRAIN = false;
    bf16_t* O; int ldo; const float* ss;
    __device__ __forceinline__ void operator()(const Acc& acc, const Unit& u, int wr, int wc, int fr, int fq) const {
        const int row0 = u.pm * BM + wr * 64 + fr, col0 = u.pn * BM + wc * 32 + fq * 8;
        float rsv[2][4];
#pragma unroll
        for (int ai = 0; ai < 2; ++ai)
#pragma unroll
            for (int m = 0; m < 4; ++m) rsv[ai][m] = ss[row0 + ai * HALF + m * 16];
#pragma unroll
        for (int ai = 0; ai < 2; ++ai)
#pragma unroll
            for (int m = 0; m < 4; ++m) { const int row = row0 + ai * HALF + m * 16; const float rs = rstd_of(rsv[ai][m]);
#pragma unroll
                for (int bj = 0; bj < 2; ++bj) *(u32x4*)(O + (size_t)row * ldo + col0 + bj * HALF) = pack8(acc[ai][bj][m][0] * rs, acc[ai][bj][m][1] * rs); }
    }
};
struct EpiColScale {
    static constexpr bool AFTER_DRAIN = false;
    bf16_t* O; int ldo; const float* ss;
    __device__ __forceinline__ void operator()(const Acc& acc, const Unit& u, int wr, int wc, int fr, int fq) const {
        const int row0 = u.pm * BM + wr * 64 + fr, col0 = u.pn * BM + wc * 32 + fq * 8;
#pragma unroll
        for (int bj = 0; bj < 2; ++bj) { const int c = col0 + bj * HALF;
            f32x4 s0 = *(const f32x4*)(ss + c), s1 = *(const f32x4*)(ss + c + 4);
#pragma unroll
            for (int j = 0; j < 4; ++j) { s0[j] = rstd_of(s0[j]); s1[j] = rstd_of(s1[j]); }
#pragma unroll
            for (int ai = 0; ai < 2; ++ai)
#pragma unroll
                for (int m = 0; m < 4; ++m) { const int row = row0 + ai * HALF + m * 16;
                    *(u32x4*)(O + (size_t)row * ldo + c) = pack8(acc[ai][bj][m][0] * s0, acc[ai][bj][m][1] * s1); } }
    }
};
struct EpiBatchBf16 {
    static constexpr bool AFTER_DRAIN = false;
    bf16_t* O; int ldo; long sOb, sOh;
    __device__ __forceinline__ void operator()(const Acc& acc, const Unit& u, int wr, int wc, int fr, int fq) const {
        const int row0 = u.pm * BM + wr * 64 + fr, col0 = u.pn * BM + wc * 32 + fq * 8;
        bf16_t* Ob = O + (size_t)((u.pb >> 2) * sOb + (u.pb & 3) * sOh);
#pragma unroll
        for (int ai = 0; ai < 2; ++ai)
#pragma unroll
            for (int m = 0; m < 4; ++m) { const int row = row0 + ai * HALF + m * 16;
#pragma unroll
                for (int bj = 0; bj < 2; ++bj) *(u32x4*)(Ob + (size_t)row * ldo + col0 + bj * HALF) = pack8(acc[ai][bj][m][0], acc[ai][bj][m][1]); }
    }
};
struct EpiSoftmax {
    static constexpr bool AFTER_DRAIN = true;
    bf16_t* P;
    __device__ __forceinline__ void fused(Acc& acc, const Unit& u, int wr, int wc, int fr, int fq, LAS unsigned char* lds, int wid, int lane) const {
        LAS float* Pm = (LAS float*)lds;
        LAS float* Ps = (LAS float*)(lds + 8192);
#pragma unroll
        for (int ai = 0; ai < 2; ++ai)
#pragma unroll
            for (int m = 0; m < 4; ++m) { float mx = -3.0e38f;
#pragma unroll
                for (int bj = 0; bj < 2; ++bj)
#pragma unroll
                    for (int n = 0; n < 2; ++n) { const f32x4 x = acc[ai][bj][m][n]; mx = fmaxf(mx, fmaxf(fmaxf(x[0], x[1]), fmaxf(x[2], x[3]))); }
                mx = fmaxf(mx, __shfl_xor(mx, 16)); mx = fmaxf(mx, __shfl_xor(mx, 32));
                if (fq == 0) Pm[(ai * HALF + wr * 64 + m * 16 + fr) * 4 + wc] = mx; }
        __syncthreads();
#pragma unroll
        for (int ai = 0; ai < 2; ++ai)
#pragma unroll
            for (int m = 0; m < 4; ++m) { const int r = ai * HALF + wr * 64 + m * 16 + fr; const f32x4 t = *(const LAS f32x4*)(Pm + r * 4);
                const float mx = fmaxf(fmaxf(t[0], t[1]), fmaxf(t[2], t[3])); float s = 0.f;
#pragma unroll
                for (int bj = 0; bj < 2; ++bj)
#pragma unroll
                    for (int n = 0; n < 2; ++n) { f32x4 x = acc[ai][bj][m][n];
#pragma unroll
                        for (int j = 0; j < 4; ++j) { x[j] = fexp2(x[j] - mx); s += x[j]; }
                        acc[ai][bj][m][n] = x; }
                s += __shfl_xor(s, 16); s += __shfl_xor(s, 32);
                if (fq == 0) Ps[r * 4 + wc] = s; }
        __syncthreads();
        bf16_t* Pb = P + (size_t)u.pb * SEQ * 256;
        const int col0 = wc * 32 + fq * 8;
#pragma unroll
        for (int ai = 0; ai < 2; ++ai)
#pragma unroll
            for (int m = 0; m < 4; ++m) { const int r = ai * HALF + wr * 64 + m * 16 + fr; const f32x4 t = *(const LAS f32x4*)(Ps + r * 4);
                const float inv = frcp((t[0] + t[1]) + (t[2] + t[3])); const int row = u.pm * BM + r;
#pragma unroll
                for (int bj = 0; bj < 2; ++bj) *(u32x4*)(Pb + (size_t)row * 256 + col0 + bj * HALF) = pack8(acc[ai][bj][m][0] * inv, acc[ai][bj][m][1] * inv); }
        __syncthreads();
    }
};
struct EpiSoftmaxRS {
    static constexpr bool AFTER_DRAIN = true;
    bf16_t* P; int ldp; const unsigned long long* ss;
    __device__ __forceinline__ void fused(Acc& acc, const Unit& u, int wr, int wc, int fr, int fq, LAS unsigned char* lds, int wid, int lane) const {
        LAS float* Pm = (LAS float*)lds; LAS float* Ps = (LAS float*)(lds + 8192);
#pragma unroll
        for (int ai = 0; ai < 2; ++ai)
#pragma unroll
            for (int m = 0; m < 4; ++m) { const float rs = rstd_of(ssq_f(ss[u.pm * BM + ai * HALF + wr * 64 + m * 16 + fr])); float mx = -3.0e38f;
#pragma unroll
                for (int bj = 0; bj < 2; ++bj)
#pragma unroll
                    for (int n = 0; n < 2; ++n) { const f32x4 x = acc[ai][bj][m][n] * rs; acc[ai][bj][m][n] = x; mx = fmaxf(mx, fmaxf(fmaxf(x[0], x[1]), fmaxf(x[2], x[3]))); }
                mx = fmaxf(mx, __shfl_xor(mx, 16)); mx = fmaxf(mx, __shfl_xor(mx, 32));
                if (fq == 0) Pm[(ai * HALF + wr * 64 + m * 16 + fr) * 4 + wc] = mx; }
        __syncthreads();
#pragma unroll
        for (int ai = 0; ai < 2; ++ai)
#pragma unroll
            for (int m = 0; m < 4; ++m) { const int r = ai * HALF + wr * 64 + m * 16 + fr; const f32x4 t = *(const LAS f32x4*)(Pm + r * 4);
                const float mx = fmaxf(fmaxf(t[0], t[1]), fmaxf(t[2], t[3])); float s = 0.f;
#pragma unroll
                for (int bj = 0; bj < 2; ++bj)
#pragma unroll
                    for (int n = 0; n < 2; ++n) { f32x4 x = acc[ai][bj][m][n];
#pragma unroll
                        for (int j = 0; j < 4; ++j) { x[j] = fexp2(x[j] - mx); s += x[j]; }
                        acc[ai][bj][m][n] = x; }
                s += __shfl_xor(s, 16); s += __shfl_xor(s, 32);
                if (fq == 0) Ps[r * 4 + wc] = s; }
        __syncthreads();
        const int col0 = u.pn * BM + wc * 32 + fq * 8;
#pragma unroll
        for (int ai = 0; ai < 2; ++ai)
#pragma unroll
            for (int m = 0; m < 4; ++m) { const int r = ai * HALF + wr * 64 + m * 16 + fr; const f32x4 t = *(const LAS f32x4*)(Ps + r * 4);
                const float inv = frcp((t[0] + t[1]) + (t[2] + t[3])); const int row = u.pm * BM + r;
#pragma unroll
                for (int bj = 0; bj < 2; ++bj) *(u32x4*)(P + (size_t)row * ldp + col0 + bj * HALF) = pack8(acc[ai][bj][m][0] * inv, acc[ai][bj][m][1] * inv); }
        __syncthreads();
    }
};
struct EpiResNorm {
    static constexpr bool AFTER_DRAIN = true;
    const bf16_t* Xold; float* out; float scale; const float* gn; float* xbuf; unsigned* cnt;
    __device__ __forceinline__ void fused(Acc& acc, const Unit& u, int wr, int wc, int fr, int fq, LAS unsigned char* lds, int wid, int lane) const {
        LAS float* P = (LAS float*)lds;
        LAS float* S = (LAS float*)(lds + 4096);
        const int row0 = u.pm * BM + wr * 64 + fr, col0 = u.pn * BM + wc * 32 + fq * 8;
#pragma unroll
        for (int ai = 0; ai < 2; ++ai)
#pragma unroll
            for (int m = 0; m < 4; ++m) { const int row = row0 + ai * HALF + m * 16; float sq = 0.f;
#pragma unroll
                for (int bj = 0; bj < 2; ++bj) { const size_t p = (size_t)row * DM + col0 + bj * HALF;
                    const u32x4 w = *(const u32x4*)(Xold + p); const f32x4 o0 = {bflo(w.x), bfhi(w.x), bflo(w.y), bfhi(w.y)}, o1 = {bflo(w.z), bfhi(w.z), bflo(w.w), bfhi(w.w)};
                    const f32x4 n0 = o0 + acc[ai][bj][m][0] * scale, n1 = o1 + acc[ai][bj][m][1] * scale;
                    acc[ai][bj][m][0] = n0; acc[ai][bj][m][1] = n1;
                    sq += (n0[0] * n0[0] + n0[1] * n0[1]) + (n0[2] * n0[2] + n0[3] * n0[3]) + (n1[0] * n1[0] + n1[1] * n1[1]) + (n1[2] * n1[2] + n1[3] * n1[3]); }
                sq += __shfl_xor(sq, 16); sq += __shfl_xor(sq, 32);
                if (fq == 0) P[(ai * HALF + wr * 64 + m * 16 + fr) * 4 + wc] = sq;
                if (m & 1) asm volatile("" ::: "memory"); }
        __syncthreads();
        const int prow = wid * 32 + (lane & 31);
        if (lane < 32) { const f32x4 t = *(const LAS f32x4*)(P + prow * 4);
            __hip_atomic_store(xbuf + (size_t)(u.pm * BM + prow) * 4 + u.pn, (t[0] + t[1]) + (t[2] + t[3]), __ATOMIC_RELAXED, __HIP_MEMORY_SCOPE_AGENT); }
        asm volatile("s_waitcnt vmcnt(0)" ::: "memory");
        if (lane == 0) __hip_atomic_fetch_add(cnt + 64 * u.pm, 1u, __ATOMIC_RELAXED, __HIP_MEMORY_SCOPE_AGENT);
        if (wid == 0) { unsigned sp = 0;
            while ((unsigned)__builtin_amdgcn_readfirstlane(__hip_atomic_load(cnt + 64 * u.pm, __ATOMIC_RELAXED, __HIP_MEMORY_SCOPE_AGENT)) < 32u) { __builtin_amdgcn_s_sleep(2); if (++sp > (1u << 20)) break; }
            __builtin_amdgcn_fence(__ATOMIC_ACQUIRE, "agent"); }
        asm volatile("s_waitcnt vmcnt(0) lgkmcnt(0)" ::: "memory");
        __syncthreads();
        if (lane < 32) { const float* sl = xbuf + (size_t)(u.pm * BM + prow) * 4; float s = 0.f;
#pragma unroll
            for (int t = 0; t < 4; ++t) s += __hip_atomic_load(sl + t, __ATOMIC_RELAXED, __HIP_MEMORY_SCOPE_AGENT);
            S[prow] = rstd_of(s); }
        __syncthreads();
        f32x4 gg[2][2];
#pragma unroll
        for (int bj = 0; bj < 2; ++bj) { gg[bj][0] = *(const f32x4*)(gn + col0 + bj * HALF); gg[bj][1] = *(const f32x4*)(gn + col0 + bj * HALF + 4); }
#pragma unroll
        for (int ai = 0; ai < 2; ++ai)
#pragma unroll
            for (int m = 0; m < 4; ++m) { const int r = ai * HALF + wr * 64 + m * 16 + fr; const float rs = S[r]; const size_t p0 = (size_t)(u.pm * BM + r) * DM + col0;
#pragma unroll
                for (int bj = 0; bj < 2; ++bj) { *(f32x4*)(out + p0 + bj * HALF) = acc[ai][bj][m][0] * rs * gg[bj][0]; *(f32x4*)(out + p0 + bj * HALF + 4) = acc[ai][bj][m][1] * rs * gg[bj][1]; } }
    }
};
}
namespace att {
__device__ __forceinline__ int crow(int r, int hi) { return (r & 3) + 8 * (r >> 2) + 4 * hi; }
#define SBAR() __builtin_amdgcn_sched_barrier(0)
constexpr float NEG = -INFINITY;
constexpr int L_SLOT = 0;
constexpr int L_VR = 24576;
constexpr int L_WSF = 49152;
constexpr int L_OST = L_WSF + 2048;
constexpr int L_TBL = L_OST + 32768;
constexpr int L_CB = L_TBL + 4096;
constexpr int L_PS = L_CB + 8192;
constexpr int L_IMP = L_PS + 4 * 64 * 33 * 4;
constexpr int L_MISC = L_IMP + 64 * 33 * 4;
constexpr int L_END = L_MISC + 64 + 256 + 64 + 64;
static_assert(L_END <= 147456 - 256, "attention LDS map");

__device__ __forceinline__ void qkt(f32x16& p0, f32x16& p1, const LAS unsigned char* Kslot, const bf16x8 (&qr)[4], int r32, int hi) {
    const LAS unsigned char* kb = Kslot + hi * 1024 + r32 * 16;
    p0 = f32x16{}; p1 = f32x16{};
#pragma unroll
    for (int d0 = 0; d0 < 4; ++d0) {
        const bf16x8 b0 = *(const LAS bf16x8*)(kb + d0 * 2048);
        const bf16x8 b1 = *(const LAS bf16x8*)(kb + d0 * 2048 + 512);
        p0 = __builtin_amdgcn_mfma_f32_32x32x16_bf16(b0, qr[d0], p0, 0, 0, 0);
        p1 = __builtin_amdgcn_mfma_f32_32x32x16_bf16(b1, qr[d0], p1, 0, 0, 0);
    }
}
__device__ __forceinline__ void pv(f32x16 (&o)[2], int vb, bf16x8 pa0, bf16x8 pa1, bf16x8 pa2, bf16x8 pa3) {
#pragma unroll
    for (int d0 = 0; d0 < 2; ++d0) { s16x4 lo[4], hi[4];
#pragma unroll
        for (int ks = 0; ks < 4; ++ks) {
            asm volatile("ds_read_b64_tr_b16 %0,%1 offset:%c2" : "=&v"(lo[ks]) : "v"(vb), "i"(d0 * 4096 + ks * 1024) : "memory");
            asm volatile("ds_read_b64_tr_b16 %0,%1 offset:%c2" : "=&v"(hi[ks]) : "v"(vb), "i"(d0 * 4096 + ks * 1024 + 512) : "memory"); }
        asm volatile("s_waitcnt lgkmcnt(0)" ::: "memory"); SBAR();
#define PK(k) (bf16x8){lo[k][0], lo[k][1], lo[k][2], lo[k][3], hi[k][0], hi[k][1], hi[k][2], hi[k][3]}
        o[d0] = __builtin_amdgcn_mfma_f32_32x32x16_bf16(pa0, PK(0), o[d0], 0, 0, 0);
        o[d0] = __builtin_amdgcn_mfma_f32_32x32x16_bf16(pa1, PK(1), o[d0], 0, 0, 0);
        o[d0] = __builtin_amdgcn_mfma_f32_32x32x16_bf16(pa2, PK(2), o[d0], 0, 0, 0);
        o[d0] = __builtin_amdgcn_mfma_f32_32x32x16_bf16(pa3, PK(3), o[d0], 0, 0, 0);
#undef PK
    }
}
__device__ __forceinline__ float rowmax32(const f32x16& p0, const f32x16& p1) {
    float a = fmaxf(p0[0], p1[0]);
#pragma unroll
    for (int r = 1; r < 16; ++r) a = fmaxf(a, fmaxf(p0[r], p1[r]));
    auto rr = __builtin_amdgcn_permlane32_swap(__float_as_uint(a), __float_as_uint(a), false, false);
    return fmaxf(__uint_as_float(rr[0]), __uint_as_float(rr[1]));
}
__device__ __forceinline__ float halfsum(float v) {
    auto rr = __builtin_amdgcn_permlane32_swap(__float_as_uint(v), __float_as_uint(v), false, false);
    return __uint_as_float(rr[0]) + __uint_as_float(rr[1]);
}
#define PKW(P, B) cvtpk(P[B], P[B + 1])
__device__ __forceinline__ void pack_p(const f32x16& p0, const f32x16& p1, bf16x8& a0, bf16x8& a1, bf16x8& a2, bf16x8& a3) {
    const u32x4 w0 = {PKW(p0, 0), PKW(p0, 2), PKW(p0, 4), PKW(p0, 6)}, w1 = {PKW(p0, 8), PKW(p0, 10), PKW(p0, 12), PKW(p0, 14)};
    const u32x4 w2 = {PKW(p1, 0), PKW(p1, 2), PKW(p1, 4), PKW(p1, 6)}, w3 = {PKW(p1, 8), PKW(p1, 10), PKW(p1, 12), PKW(p1, 14)};
    a0 = __builtin_bit_cast(bf16x8, w0); a1 = __builtin_bit_cast(bf16x8, w1); a2 = __builtin_bit_cast(bf16x8, w2); a3 = __builtin_bit_cast(bf16x8, w3);
}
#undef PKW
__device__ __forceinline__ void scale_rows(f32x16 (&o)[2], LAS float* wsf, float v, int r32, int hi) {
    if (hi == 0) wsf[r32] = v;
    asm volatile("s_waitcnt lgkmcnt(0)" ::: "memory");
#pragma unroll
    for (int i = 0; i < 4; ++i) { const f32x4 f = *(const LAS f32x4*)(wsf + 8 * i + 4 * hi);
#pragma unroll
        for (int j = 0; j < 4; ++j) { o[0][4 * i + j] *= f[j]; o[1][4 * i + j] *= f[j]; } }
    asm volatile("s_waitcnt lgkmcnt(0)" ::: "memory");
}
struct StageGeo { int krow, kcol, koff, vrow, vcol, voff; };
__device__ __forceinline__ StageGeo stage_geo(int tid) {
    StageGeo s; const int w = tid >> 6, ln = tid & 63;
    s.krow = ln; s.kcol = w * 8; s.koff = w * 1024 + ln * 16;
    s.vrow = 16 * (w & 3) + (ln >> 2); s.vcol = (w >> 2) * 32 + (ln & 3) * 8; s.voff = 8192 + w * 1024 + ln * 16;
    return s;
}
template <class Mod>
__device__ __forceinline__ void tile_step(const LAS unsigned char* slot, const bf16x8 (&qr)[4], f32x16 (&o)[2], float& m, float& l, LAS float* wsf, const Mod& mod, int r32, int hi, int vb) {
    f32x16 p0, p1;
    qkt(p0, p1, slot, qr, r32, hi);
    mod(p0, p1);
    const float rm = rowmax32(p0, p1);
    const float mn = fmaxf(m, rm);
    const float alpha = fexp2(m - mn);
    const bool need = __any(mn > m);
    m = mn;
    float s = 0.f;
#pragma unroll
    for (int r = 0; r < 16; ++r) { p0[r] = fexp2(p0[r] - mn); p1[r] = fexp2(p1[r] - mn); s += p0[r] + p1[r]; }
    l = l * alpha + s;
    if (need) scale_rows(o, wsf, alpha, r32, hi);
    bf16x8 a0, a1, a2, a3; pack_p(p0, p1, a0, a1, a2, a3);
    pv(o, vb, a0, a1, a2, a3);
}
template <class ModF>
__device__ __forceinline__ void attn_loop(unsigned tmask, const bf16_t* Kg, int pitchK, const bf16_t* Vg, int pitchV, LAS unsigned char* lds, const bf16x8 (&qr)[4],
                                          f32x16 (&o)[2], float& m, float& l, const ModF& modf, int wave_last_row) {
    const int tid = fresh_tid(), lane = tid & 63, r32 = lane & 31, hi = lane >> 5, wid = tid >> 6;
    const StageGeo sg = stage_geo(tid);
    LAS float* wsf = (LAS float*)(lds + L_WSF) + wid * 64;
    const int vb0 = (int)(unsigned)(size_t)(lds + L_SLOT + 8192) + ((lane >> 4) & 1) * 32 + (lane & 3) * 8 + (4 * hi + ((lane & 15) >> 2)) * 64;
    int kt = 31 - __clz((int)tmask);
    u32x4 kreg = *(const u32x4*)(Kg + (size_t)(kt * 64 + sg.krow) * pitchK + sg.kcol);
    u32x4 vreg = *(const u32x4*)(Vg + (size_t)(kt * 64 + sg.vrow) * pitchV + sg.vcol);
    *(LAS u32x4*)(lds + L_SLOT + sg.koff) = kreg; *(LAS u32x4*)(lds + L_SLOT + sg.voff) = vreg;
    __syncthreads();
    int s = 0;
    for (;;) {
        tmask &= ~(1u << kt);
        const int nk = tmask ? 31 - __clz((int)tmask) : -1;
        if (nk >= 0) { kreg = *(const u32x4*)(Kg + (size_t)(nk * 64 + sg.krow) * pitchK + sg.kcol); vreg = *(const u32x4*)(Vg + (size_t)(nk * 64 + sg.vrow) * pitchV + sg.vcol); }
        if (kt * 64 <= wave_last_row) tile_step(lds + L_SLOT + s * 16384, qr, o, m, l, wsf, modf(kt), r32, hi, vb0 + s * 16384);
        if (nk >= 0) { *(LAS u32x4*)(lds + L_SLOT + (s ^ 1) * 16384 + sg.koff) = kreg; *(LAS u32x4*)(lds + L_SLOT + (s ^ 1) * 16384 + sg.voff) = vreg; }
        __syncthreads();
        if (nk < 0) break;
        kt = nk; s ^= 1;
    }
}
template <bool ADD>
__device__ __forceinline__ void store_o(const f32x16 (&o)[2], LAS unsigned char* lds, bf16_t* dst, int pitch, const bf16_t* addsrc, int addpitch) {
    const int tid = fresh_tid(), lane = tid & 63, r32 = lane & 31, hi = lane >> 5, wid = tid >> 6;
    LAS bf16_t* stg = (LAS bf16_t*)(lds + L_OST) + wid * 2048;
#pragma unroll
    for (int r = 0; r < 16; ++r) { const int orow = crow(r, hi);
#pragma unroll
        for (int d0 = 0; d0 < 2; ++d0) stg[orow * 64 + d0 * 32 + r32] = (bf16_t)(cvtpk(o[d0][r], 0.f) & 0xffffu); }
    asm volatile("s_waitcnt lgkmcnt(0)" ::: "memory");
#pragma unroll
    for (int i = 0; i < 4; ++i) { const int row = i * 8 + (lane >> 3), ch = lane & 7;
        u32x4 v = *(const LAS u32x4*)(stg + row * 64 + ch * 8);
        if (ADD) { const u32x4 a = *(const u32x4*)(addsrc + (size_t)row * addpitch + ch * 8);
            v.x = cvtpk(bflo(v.x) + bflo(a.x), bfhi(v.x) + bfhi(a.x)); v.y = cvtpk(bflo(v.y) + bflo(a.y), bfhi(v.y) + bfhi(a.y));
            v.z = cvtpk(bflo(v.z) + bflo(a.z), bfhi(v.z) + bfhi(a.z)); v.w = cvtpk(bflo(v.w) + bflo(a.w), bfhi(v.w) + bfhi(a.w)); }
        *(u32x4*)(dst + (size_t)row * pitch + ch * 8) = v; }
    asm volatile("s_waitcnt lgkmcnt(0)" ::: "memory");
}
__device__ __forceinline__ void load_q(bf16x8 (&qr)[4], const bf16_t* Qw, int pitch, int r32, int hi) {
#pragma unroll
    for (int d0 = 0; d0 < 4; ++d0) qr[d0] = *(const bf16x8*)(Qw + (size_t)r32 * pitch + d0 * 16 + hi * 8);
}

struct ModFox { const LAS float* cb; int kbase, qpos, hi; bool diag;
    __device__ __forceinline__ void operator()(f32x16& p0, f32x16& p1) const {
#pragma unroll
        for (int i = 0; i < 4; ++i) { const f32x4 c0 = *(const LAS f32x4*)(cb + kbase + 8 * i + 4 * hi), c1 = *(const LAS f32x4*)(cb + kbase + 32 + 8 * i + 4 * hi);
#pragma unroll
            for (int j = 0; j < 4; ++j) { p0[4 * i + j] += c0[j]; p1[4 * i + j] += c1[j]; } }
        if (diag) {
#pragma unroll
            for (int r = 0; r < 16; ++r) { const int kv = kbase + crow(r, hi); if (kv > qpos) p0[r] = NEG; if (kv + 32 > qpos) p1[r] = NEG; } }
    } };
struct ModFoxF { const LAS float* cb; int qpos, hi, q0w;
    __device__ __forceinline__ ModFox operator()(int kt) const { return ModFox{cb, kt * 64, qpos, hi, kt * 64 + 63 > q0w}; } };
struct ModT5 { const LAS float* tb; int kbase, qpos, hi, window; bool enabled;
    __device__ __forceinline__ void operator()(f32x16& p0, f32x16& p1) const {
#pragma unroll
        for (int r = 0; r < 16; ++r) { const int d0 = qpos - (kbase + crow(r, hi)), d1 = d0 - 32;
            const float b0 = tb[min(max(d0, 0), 127)], b1 = tb[min(max(d1, 0), 127)];
            p0[r] = (enabled && d0 >= 0 && d0 < window) ? p0[r] + b0 : NEG;
            p1[r] = (enabled && d1 >= 0 && d1 < window) ? p1[r] + b1 : NEG; }
    } };
struct ModWinF { const LAS float* tb; int qpos, hi;
    __device__ __forceinline__ ModT5 operator()(int kt) const { return ModT5{tb, kt * 64, qpos, hi, 512, true}; } };
struct ModSelF { const LAS float* tb; int qpos, hi; unsigned mask;
    __device__ __forceinline__ ModT5 operator()(int kt) const { return ModT5{tb, kt * 64, qpos, hi, 1 << 30, ((mask >> kt) & 1u) != 0u}; } };

typedef short v4i16_t __attribute__((ext_vector_type(4)));
__device__ __forceinline__ s16x4 vtr(const LAS unsigned char* p) { return __builtin_bit_cast(s16x4, __builtin_amdgcn_ds_read_tr16_b64_v4i16((LAS v4i16_t*)p)); }
__device__ __forceinline__ void qkt_c(f32x16& p0, f32x16& p1, const LAS unsigned char* Kslot, const bf16x8 (&qr)[4], const f32x16& c0, const f32x16& c1, int r32, int hi) {
    const LAS unsigned char* kb = Kslot + hi * 1024 + r32 * 16;
    { const bf16x8 b0 = *(const LAS bf16x8*)(kb); const bf16x8 b1 = *(const LAS bf16x8*)(kb + 512);
      p0 = __builtin_amdgcn_mfma_f32_32x32x16_bf16(b0, qr[0], c0, 0, 0, 0); p1 = __builtin_amdgcn_mfma_f32_32x32x16_bf16(b1, qr[0], c1, 0, 0, 0); }
#pragma unroll
    for (int d0 = 1; d0 < 4; ++d0) {
        const bf16x8 b0 = *(const LAS bf16x8*)(kb + d0 * 2048); const bf16x8 b1 = *(const LAS bf16x8*)(kb + d0 * 2048 + 512);
        p0 = __builtin_amdgcn_mfma_f32_32x32x16_bf16(b0, qr[d0], p0, 0, 0, 0); p1 = __builtin_amdgcn_mfma_f32_32x32x16_bf16(b1, qr[d0], p1, 0, 0, 0); }
}
__device__ __forceinline__ void pv2(f32x16 (&o)[2], const LAS unsigned char* vp, bf16x8 pa0, bf16x8 pa1, bf16x8 pa2, bf16x8 pa3) {
    s16x4 lo[2][4], hi[2][4];
#pragma unroll
    for (int ks = 0; ks < 4; ++ks)
#pragma unroll
        for (int d0 = 0; d0 < 2; ++d0) { lo[d0][ks] = vtr(vp + d0 * 4096 + ks * 1024); hi[d0][ks] = vtr(vp + d0 * 4096 + ks * 1024 + 512); }
#define PK(d, k) (bf16x8){lo[d][k][0], lo[d][k][1], lo[d][k][2], lo[d][k][3], hi[d][k][0], hi[d][k][1], hi[d][k][2], hi[d][k][3]}
    o[0] = __builtin_amdgcn_mfma_f32_32x32x16_bf16(pa0, PK(0, 0), o[0], 0, 0, 0); o[1] = __builtin_amdgcn_mfma_f32_32x32x16_bf16(pa0, PK(1, 0), o[1], 0, 0, 0);
    o[0] = __builtin_amdgcn_mfma_f32_32x32x16_bf16(pa1, PK(0, 1), o[0], 0, 0, 0); o[1] = __builtin_amdgcn_mfma_f32_32x32x16_bf16(pa1, PK(1, 1), o[1], 0, 0, 0);
    o[0] = __builtin_amdgcn_mfma_f32_32x32x16_bf16(pa2, PK(0, 2), o[0], 0, 0, 0); o[1] = __builtin_amdgcn_mfma_f32_32x32x16_bf16(pa2, PK(1, 2), o[1], 0, 0, 0);
    o[0] = __builtin_amdgcn_mfma_f32_32x32x16_bf16(pa3, PK(0, 3), o[0], 0, 0, 0); o[1] = __builtin_amdgcn_mfma_f32_32x32x16_bf16(pa3, PK(1, 3), o[1], 0, 0, 0);
#undef PK
}
__device__ __forceinline__ float rowmax32b(const f32x16& p0, const f32x16& p1) {
    float a = __builtin_fmaxf(__builtin_fmaxf(p0[0], p0[1]), p1[0]), b = __builtin_fmaxf(__builtin_fmaxf(p0[2], p0[3]), p1[1]); a = __builtin_fmaxf(__builtin_fmaxf(a, p1[2]), p1[3]);
#pragma unroll
    for (int r = 4; r < 16; r += 4) { a = __builtin_fmaxf(__builtin_fmaxf(a, p0[r]), p0[r + 1]); b = __builtin_fmaxf(__builtin_fmaxf(b, p0[r + 2]), p0[r + 3]);
        a = __builtin_fmaxf(__builtin_fmaxf(a, p1[r]), p1[r + 1]); b = __builtin_fmaxf(__builtin_fmaxf(b, p1[r + 2]), p1[r + 3]); }
    const float m = __builtin_fmaxf(a, b);
    auto rr = __builtin_amdgcn_permlane32_swap(__float_as_uint(m), __float_as_uint(m), false, false);
    return __builtin_fmaxf(__uint_as_float(rr[0]), __uint_as_float(rr[1]));
}
constexpr float DEFER_THR = 6.0f;
#ifndef ATT_GRP
#define ATT_GRP(w) ((w) >> 2)
#endif
template <int ABL, class TF>
__device__ __forceinline__ void sm_pv(f32x16& sc0, f32x16& sc1, f32x16& sn0, f32x16& sn1, bool adjust_next, int kt, int par, bool& first, float& mref, float& l, f32x16 (&o)[2],
                                      LAS float* wsf, const LAS unsigned char* vp0, const TF& tf, int r32, int hi) {
    if (ABL & 16) { o[0][1] += sc0[3] + sc1[5]; return; }
    tf.post(kt, sc0, sc1);
    const float rm = rowmax32b(sc0, sc1);
    if (__any(first || rm > DEFER_THR)) {
        const float delta = first ? (rm == NEG ? 0.f : rm) : __builtin_fmaxf(rm, 0.f);
        mref += delta;
#pragma unroll
        for (int r = 0; r < 16; ++r) { sc0[r] -= delta; sc1[r] -= delta; }
        if (adjust_next) {
#pragma unroll
            for (int r = 0; r < 16; ++r) { sn0[r] -= delta; sn1[r] -= delta; } }
        const float f = fexp2(-delta); l *= f;
        if (!first) scale_rows(o, wsf, f, r32, hi);
        first = false;
    }
    float s = 0.f;
#pragma unroll
    for (int r = 0; r < 16; ++r) { if (!(ABL & 1)) { sc0[r] = fexp2(sc0[r]); sc1[r] = fexp2(sc1[r]); } s += sc0[r] + sc1[r]; }
    l += s;
    bf16x8 a0, a1, a2, a3; pack_p(sc0, sc1, a0, a1, a2, a3);
    if (!(ABL & 2)) pv2(o, vp0 + par * 8192, a0, a1, a2, a3); else { o[0][0] += __builtin_bit_cast(f32x4, a0)[0] + __builtin_bit_cast(f32x4, a3)[3]; }
}
__device__ __forceinline__ void load_kf(bf16x8 (&kf)[8], const LAS unsigned char* Kslot, int r32, int hi) {
    const LAS unsigned char* kb = Kslot + hi * 1024 + r32 * 16;
#pragma unroll
    for (int d0 = 0; d0 < 4; ++d0) { kf[2 * d0] = *(const LAS bf16x8*)(kb + d0 * 2048); kf[2 * d0 + 1] = *(const LAS bf16x8*)(kb + d0 * 2048 + 512); }
}
__device__ __forceinline__ void qk_exp(f32x16& n0, f32x16& n1, f32x16& s0, f32x16& s1, const f32x16& c0, const f32x16& c1, const bf16x8 (&kf)[8], const bf16x8 (&qr)[4],
                                       float& l, bf16x8& a0, bf16x8& a1, bf16x8& a2, bf16x8& a3) {
    float s = 0.f; unsigned w[16];
#define QE_GAP(i, X, B) do { X[B] = fexp2(X[B]); X[B + 1] = fexp2(X[B + 1]); X[B + 2] = fexp2(X[B + 2]); X[B + 3] = fexp2(X[B + 3]); s += (X[B] + X[B + 1]) + (X[B + 2] + X[B + 3]); \
        w[2 * (i)] = cvtpk(X[B], X[B + 1]); w[2 * (i) + 1] = cvtpk(X[B + 2], X[B + 3]); SBAR(); } while (0)
    SBAR();
    n0 = __builtin_amdgcn_mfma_f32_32x32x16_bf16(kf[0], qr[0], c0, 0, 0, 0); QE_GAP(0, s0, 0);
    n1 = __builtin_amdgcn_mfma_f32_32x32x16_bf16(kf[1], qr[0], c1, 0, 0, 0); QE_GAP(1, s0, 4);
    n0 = __builtin_amdgcn_mfma_f32_32x32x16_bf16(kf[2], qr[1], n0, 0, 0, 0); QE_GAP(2, s0, 8);
    n1 = __builtin_amdgcn_mfma_f32_32x32x16_bf16(kf[3], qr[1], n1, 0, 0, 0); QE_GAP(3, s0, 12);
    n0 = __builtin_amdgcn_mfma_f32_32x32x16_bf16(kf[4], qr[2], n0, 0, 0, 0); QE_GAP(4, s1, 0);
    n1 = __builtin_amdgcn_mfma_f32_32x32x16_bf16(kf[5], qr[2], n1, 0, 0, 0); QE_GAP(5, s1, 4);
    n0 = __builtin_amdgcn_mfma_f32_32x32x16_bf16(kf[6], qr[3], n0, 0, 0, 0); QE_GAP(6, s1, 8);
    n1 = __builtin_amdgcn_mfma_f32_32x32x16_bf16(kf[7], qr[3], n1, 0, 0, 0); QE_GAP(7, s1, 12);
#undef QE_GAP
    l += s;
    const u32x4 w0 = {w[0], w[1], w[2], w[3]}, w1 = {w[4], w[5], w[6], w[7]}, w2 = {w[8], w[9], w[10], w[11]}, w3 = {w[12], w[13], w[14], w[15]};
    a0 = __builtin_bit_cast(bf16x8, w0); a1 = __builtin_bit_cast(bf16x8, w1); a2 = __builtin_bit_cast(bf16x8, w2); a3 = __builtin_bit_cast(bf16x8, w3);
}
__device__ __forceinline__ void glds16(const void* gsrc, unsigned lds_dst) { unsigned keep;
    asm volatile("s_mov_b32 %0, m0\n\ts_mov_b32 m0, %2\n\ts_nop 0\n\tglobal_load_lds_dwordx4 %1, off\n\ts_mov_b32 m0, %0" : "=&s"(keep) : "v"(gsrc), "s"(lds_dst) : "memory"); }
#define ATT_WAIT_BAR(N) asm volatile("s_waitcnt vmcnt(" #N ") lgkmcnt(0)\n\ts_barrier" ::: "memory")
template <int ABL = 0, class TF>
__device__ __forceinline__ void attn_loop2(unsigned tmask, const bf16_t* Kg, int pitchK, const bf16_t* Vg, int pitchV, LAS unsigned char* lds, const bf16x8 (&qr)[4],
                                           f32x16 (&o)[2], float& mref, float& l, const TF& tf, int wave_last_row) {
    const int tid = fresh_tid(), lane = tid & 63, r32 = lane & 31, hi = lane >> 5, wid = __builtin_amdgcn_readfirstlane(tid >> 6), grp = ATT_GRP(wid);
    LAS float* wsf = (LAS float*)(lds + L_WSF) + wid * 64;
    const LAS unsigned char* vp0 = lds + L_SLOT + L_VR + ((lane >> 4) & 1) * 32 + (lane & 3) * 8 + (4 * hi + ((lane & 15) >> 2)) * 64;
    const bf16_t* ksrc = Kg + (size_t)lane * pitchK + wid * 8;
    const bf16_t* vsrc = Vg + (size_t)(16 * (wid & 3) + (lane >> 2)) * pitchV + (wid >> 2) * 32 + (lane & 3) * 8;
    const unsigned ldsb = (unsigned)(size_t)(lds + L_SLOT) + (unsigned)wid * 1024u;
#define DMA_K(t, slot) glds16(ksrc + (size_t)(t) * 64 * pitchK, (unsigned)__builtin_amdgcn_readfirstlane(ldsb + (unsigned)(slot) * 8192u))
#define DMA_V(t, slot) glds16(vsrc + (size_t)(t) * 64 * pitchV, (unsigned)__builtin_amdgcn_readfirstlane(ldsb + (unsigned)L_VR + (unsigned)(slot) * 8192u))
#define NEXT_TILE(dst) do { if (tmask) { dst = 31 - __clz((int)tmask); tmask &= ~(1u << dst); } else dst = -1; } while (0)
    int t0, t1, t2, t3;
    NEXT_TILE(t0); NEXT_TILE(t1); NEXT_TILE(t2);
    const int tz = t0;
    DMA_K(t0, 0); DMA_V(t0, 0); DMA_K(t1 < 0 ? tz : t1, 1); DMA_V(t1 < 0 ? tz : t1, 1); DMA_K(t2 < 0 ? tz : t2, 2);
    ATT_WAIT_BAR(2);
    f32x16 sa0, sa1, sb0, sb1, cfar;
    bool first = true, seen = false;
    mref = 0.f; l = 0.f;
    const float fbias = tf.farbias();
#pragma unroll
    for (int r = 0; r < 16; ++r) cfar[r] = fbias;
    { f32x16 c0, c1; tf.cinit(t0, 0.f, c0, c1); qkt_c(sa0, sa1, lds + L_SLOT, qr, c0, c1, r32, hi); }
    asm volatile("s_waitcnt lgkmcnt(0)\n\ts_barrier" ::: "memory");
    int s0 = 0, s1 = 1, s2 = 2;
#define ATT_STEP(SC0, SC1, SN0, SN1) do { \
        NEXT_TILE(t3); \
        DMA_K((ABL & 128) || t3 < 0 ? tz : t3, s0); DMA_V((ABL & 128) || t2 < 0 ? tz : t2, s2); \
        const int t1c = t1 < 0 ? tz : t1; \
        bf16x8 kf[8]; load_kf(kf, lds + L_SLOT + s1 * 8192, r32, hi);          \
        const bool farn = tf.far(t1c); \
        if (TF::HOIST_BIAS && !farn) tf.bias_raw(t1c, SN0, SN1); \
        SBAR(); \
        tf.post(t0, SC0, SC1); \
        { const float rm = rowmax32b(SC0, SC1); \
          if (__any(first || rm > DEFER_THR || (!seen && rm != NEG))) { \
            const float delta = !seen ? (rm == NEG ? 0.f : rm) : __builtin_fmaxf(rm, 0.f);     \
            seen = seen || (rm != NEG); \
            mref += delta; \
            _Pragma("unroll") for (int r = 0; r < 16; ++r) { SC0[r] -= delta; SC1[r] -= delta; } \
            const float f = fexp2(-delta); l *= f; \
            if (!first) scale_rows(o, wsf, f, r32, hi); \
            _Pragma("unroll") for (int r = 0; r < 16; ++r) cfar[r] = fbias - mref; \
            first = false; } } \
        { bf16x8 a0, a1, a2, a3; \
          if (farn) qk_exp(SN0, SN1, SC0, SC1, cfar, cfar, kf, qr, l, a0, a1, a2, a3); \
          else { f32x16 c0, c1; if (TF::HOIST_BIAS) { _Pragma("unroll") for (int r = 0; r < 16; ++r) { c0[r] = SN0[r] - mref; c1[r] = SN1[r] - mref; } } else tf.cinit(t1c, mref, c0, c1); \
                 qk_exp(SN0, SN1, SC0, SC1, c0, c1, kf, qr, l, a0, a1, a2, a3); } \
          pv2(o, vp0 + s0 * 8192, a0, a1, a2, a3); } \
        ATT_WAIT_BAR(2); \
        t0 = t1; t1 = t2; t2 = t3; { const int s_ = s0; s0 = s1; s1 = s2; s2 = s_; } \
    } while (0)
    for (;;) {
        ATT_STEP(sa0, sa1, sb0, sb1); if (t0 < 0) break;
        ATT_STEP(sb0, sb1, sa0, sa1); if (t0 < 0) break;
    }
    asm volatile("s_waitcnt vmcnt(0)" ::: "memory");
    __syncthreads();
#undef ATT_STEP
#undef NEXT_TILE
#undef DMA_K
#undef DMA_V
}
struct TfFox { const LAS float* cb; int qpos, hi, q0w;
    static constexpr bool HOIST_BIAS = true;
    __device__ __forceinline__ bool far(int) const { return false; }
    __device__ __forceinline__ float farbias() const { return 0.f; }
    __device__ __forceinline__ void cinit(int kt, float mref, f32x16& c0, f32x16& c1) const {
#pragma unroll
        for (int i = 0; i < 4; ++i) { const f32x4 a = *(const LAS f32x4*)(cb + kt * 64 + 8 * i + 4 * hi), b = *(const LAS f32x4*)(cb + kt * 64 + 32 + 8 * i + 4 * hi);
#pragma unroll
            for (int j = 0; j < 4; ++j) { c0[4 * i + j] = a[j] - mref; c1[4 * i + j] = b[j] - mref; } } }
    __device__ __forceinline__ void bias_raw(int kt, f32x16& c0, f32x16& c1) const {
#pragma unroll
        for (int i = 0; i < 4; ++i) { const f32x4 a = *(const LAS f32x4*)(cb + kt * 64 + 8 * i + 4 * hi), b = *(const LAS f32x4*)(cb + kt * 64 + 32 + 8 * i + 4 * hi);
#pragma unroll
            for (int j = 0; j < 4; ++j) { c0[4 * i + j] = a[j]; c1[4 * i + j] = b[j]; } } }
    __device__ __forceinline__ void post(int kt, f32x16& p0, f32x16& p1) const {
        if (kt * 64 + 63 > q0w) {
#pragma unroll
            for (int r = 0; r < 16; ++r) { const int kv = kt * 64 + crow(r, hi); if (kv > qpos) p0[r] = NEG; if (kv + 32 > qpos) p1[r] = NEG; } } } };
struct TfT5 { const LAS float* tb; int qpos, hi, q0w, window; unsigned mask; bool use_mask;
    static constexpr bool HOIST_BIAS = false;
    __device__ __forceinline__ bool far(int kt) const { return q0w - (kt * 64 + 63) >= 113; }
    __device__ __forceinline__ float farbias() const { return tb[127]; }
    __device__ __forceinline__ void cinit(int kt, float mref, f32x16& c0, f32x16& c1) const {
        if (q0w - (kt * 64 + 63) >= 113) { const float c = tb[127] - mref;
#pragma unroll
            for (int r = 0; r < 16; ++r) { c0[r] = c; c1[r] = c; } }
        else {
#pragma unroll
            for (int r = 0; r < 16; ++r) { const int d0 = qpos - kt * 64 - crow(r, hi); c0[r] = tb[min(max(d0, 0), 127)] - mref; c1[r] = tb[min(max(d0 - 32, 0), 127)] - mref; } } }
    __device__ __forceinline__ void bias_raw(int kt, f32x16& c0, f32x16& c1) const {
#pragma unroll
        for (int r = 0; r < 16; ++r) { const int d0 = qpos - kt * 64 - crow(r, hi); c0[r] = tb[min(max(d0, 0), 127)]; c1[r] = tb[min(max(d0 - 32, 0), 127)]; } }
    __device__ __forceinline__ void post(int kt, f32x16& p0, f32x16& p1) const {
        if (q0w - (kt * 64 + 63) < 0 || q0w + 31 - kt * 64 >= window) {
#pragma unroll
            for (int r = 0; r < 16; ++r) { const int d0 = qpos - kt * 64 - crow(r, hi), d1 = d0 - 32; if (d0 < 0 || d0 >= window) p0[r] = NEG; if (d1 < 0 || d1 >= window) p1[r] = NEG; } }
        if (use_mask) { const bool en = ((mask >> kt) & 1u) != 0u;
            if (!__all(en)) {
#pragma unroll
                for (int r = 0; r < 16; ++r) { p0[r] = en ? p0[r] : NEG; p1[r] = en ? p1[r] : NEG; } } } } };
}
#ifndef STAGE_LIMIT
#define STAGE_LIMIT 4
#endif
constexpr size_t MiB = 1u << 20;
constexpr size_t WS_CTL = 0, CTL_ZERO_BYTES = 64 * 1024;
constexpr size_t WS_SS = 256 * 1024;
constexpr size_t WS_SSQ = 320 * 1024;
constexpr size_t WS_SSM = 720 * 1024;
constexpr size_t WS_F32S = 2 * MiB;
constexpr size_t WS_CUM = 4 * MiB;
constexpr size_t WS_MASK = 4 * MiB + 512 * 1024;
constexpr size_t WS_UMASK = WS_MASK + 128 * 1024;
constexpr size_t WS_KC = 5 * MiB, WS_VC = 5 * MiB + 256 * 1024;
constexpr size_t WS_KMAX = 5 * MiB + 512 * 1024;
constexpr size_t WS_POSCP = 5 * MiB + 768 * 1024;
constexpr size_t WS_POSC = 32 * 1024;
constexpr size_t WS_WGU1 = 8 * MiB, WS_WD1 = 19 * MiB, WS_WIN = 25 * MiB, WS_WUPN = 35 * MiB, WS_WUPF = 36 * MiB, WS_WOUT = 37 * MiB, WS_WMQ = 39 * MiB,
                 WS_WMKV = 41 * MiB, WS_WMO = 45 * MiB, WS_WGU2 = 47 * MiB, WS_WD2 = 58 * MiB, WS_CW1K = 64 * MiB, WS_CW1V = 65 * MiB, WS_CW2K = 66 * MiB, WS_CW2V = 66 * MiB + 256 * 1024;
constexpr size_t WS_KVM = 8 * MiB;
constexpr size_t WS_XB = 68 * MiB;
constexpr size_t WS_QN = 100 * MiB, WS_KVN = 116 * MiB, WS_QF = 140 * MiB, WS_KVF = 156 * MiB, WS_GAB = 188 * MiB;
constexpr size_t WS_H = 100 * MiB;
constexpr size_t WS_Y = WS_KVF;
constexpr size_t WS_MT = 188 * MiB, WS_NT = 204 * MiB, WS_PM = 220 * MiB;
constexpr size_t WS_MEMB = 252 * MiB, WS_END = 256 * MiB;
static_assert(WS_WD2 + (size_t)DM * FF * 2 <= WS_CW1K && WS_GAB + (size_t)M * 2048 * 2 <= WS_MEMB && WS_H + (size_t)M * FF * 2 <= WS_GAB, "ws map");
constexpr int CW_BAR = 4096;
constexpr size_t WS_XBUF = 1 * MiB;
constexpr size_t WS_FINCNT = 40 * 1024;
constexpr int RING_BYTES = 131072, LDS_BYTES = 147456;

__device__ const unsigned char T5B[128] = {0, 1, 2, 3, 4, 5, 6, 7, 8, 9, 10, 11, 12, 13, 14, 15, 16, 16, 16, 17, 17, 18, 18, 18, 19, 19, 19, 20, 20, 20, 20, 21, 21, 21, 21, 22, 22, 22, 22, 22, 23, 23, 23, 23, 23, 23, 24, 24, 24, 24, 24, 24, 25, 25, 25, 25, 25, 25, 25, 26, 26, 26, 26, 26, 26, 26, 26, 27, 27, 27, 27, 27, 27, 27, 27, 27, 27, 28, 28, 28, 28, 28, 28, 28, 28, 28, 28, 29, 29, 29, 29, 29, 29, 29, 29, 29, 29, 29, 29, 30, 30, 30, 30, 30, 30, 30, 30, 30, 30, 30, 30, 30, 30, 31, 31, 31, 31, 31, 31, 31, 31, 31, 31, 31, 31, 31, 31, 31};


#define XB_TMO      128
#define XB_XCNT(j)  (256  + 64 * (j))
#define XB_XSUB(j)  (1280 + 64 * (j))
#define XB_XGEN(j)  (2304 + 64 * (j))
#define XB_TOP      3328
#define XB_TOPGEN   3392
#define XCD_BAR_WORDS 3456
#define XB_SPIN_CAP (1u << 18)
__device__ __forceinline__ unsigned xb_ld(unsigned* p)              { return __hip_atomic_load(p, __ATOMIC_RELAXED, __HIP_MEMORY_SCOPE_AGENT); }
__device__ __forceinline__ unsigned xb_add(unsigned* p, unsigned v) { return __hip_atomic_fetch_add(p, v, __ATOMIC_RELAXED, __HIP_MEMORY_SCOPE_AGENT); }
__device__ __forceinline__ unsigned xb_xcc_id() { return (unsigned)__builtin_amdgcn_s_getreg((3 << 11) | 20) & 0xFu; }
#define XB_SPIN(cond, bar) do { unsigned _sp = 0; while (cond) { __builtin_amdgcn_s_sleep(1); \
    if ((++_sp & 255u) == 0u) { if (xb_ld(&(bar)[XB_TMO])) break; if (_sp > XB_SPIN_CAP) { atomicAdd(&(bar)[XB_TMO], 1u); break; } } } } while (0)
struct XcdBarrier { unsigned* bar; unsigned x; volatile LAS unsigned* st; };
__device__ __forceinline__ XcdBarrier xcd_barrier_post(unsigned* bar, volatile LAS unsigned* st) {
    XcdBarrier b; b.bar = bar; b.x = xb_xcc_id(); b.st = st;
    if (threadIdx.x == 0) (void)xb_add(&bar[XB_XCNT(b.x)], 1u);
    return b;
}
__device__ __forceinline__ void xcd_barrier_complete(unsigned* bar, unsigned x, unsigned& nloc, unsigned& nx) {
    const unsigned G = gridDim.x * gridDim.y * gridDim.z;
    unsigned sum, cnt, mine, sp = 0u;
    for (;;) {
        sum = 0u; cnt = 0u; mine = 0u;
#pragma unroll
        for (unsigned j = 0; j < 16; ++j) { const unsigned c = xb_ld(&bar[XB_XCNT(j)]); sum += c; cnt += (c > 0u) ? 1u : 0u; mine = (j == x) ? c : mine; }
        if (sum == G) break;
        __builtin_amdgcn_s_sleep(1);
        if ((++sp & 255u) == 0u) { if (xb_ld(&bar[XB_TMO])) break; if (sp > XB_SPIN_CAP) { atomicAdd(&bar[XB_TMO], 1u); break; } }
    }
    nloc = mine > 0u ? mine : 1u; nx = cnt > 0u ? cnt : 1u;
}
__device__ __forceinline__ void xcd_barrier(const XcdBarrier& b) {
    asm volatile("s_waitcnt vmcnt(0)" ::: "memory");
    __syncthreads();
    if (threadIdx.x == 0) {
        unsigned* bar = b.bar;
        __builtin_amdgcn_s_waitcnt(0);
        unsigned nloc = b.st[0], nx = b.st[1];
        if (nloc == 0u) { xcd_barrier_complete(bar, b.x, nloc, nx); b.st[0] = nloc; b.st[1] = nx; }
        const unsigned old = xb_add(&bar[XB_XSUB(b.x)], 1u);
        const unsigned gen = old / nloc;
        if (old + 1u == (gen + 1u) * nloc) {
            __builtin_amdgcn_fence(__ATOMIC_RELEASE, "agent");
            asm volatile("s_waitcnt vmcnt(0)" ::: "memory");
            const unsigned og = xb_add(&bar[XB_TOP], 1u);
            const unsigned tg = og / nx;
            if (og + 1u == (tg + 1u) * nx) xb_add(&bar[XB_TOPGEN], 1u);
            else XB_SPIN(xb_ld(&bar[XB_TOPGEN]) == tg, bar);
            __builtin_amdgcn_fence(__ATOMIC_ACQUIRE, "agent");
            xb_add(&bar[XB_XGEN(b.x)], 1u);
            asm volatile("s_waitcnt vmcnt(0)" ::: "memory");
        } else {
            XB_SPIN(xb_ld(&bar[XB_XGEN(b.x)]) == gen, bar);
            __builtin_amdgcn_fence(__ATOMIC_ACQUIRE, "agent");
            asm volatile("s_waitcnt vmcnt(0)" ::: "memory");
        }
    }
    __syncthreads();
}

struct Args { const float* in[29]; float* out; unsigned char* ws; int lo, hi; };
enum { I_X = 0, I_MEM, I_RELB, I_F1N, I_F1G, I_F1U, I_F1D, I_MIXN, I_WIN, I_BF, I_POSK, I_POSV, I_CK1, I_CK2, I_CV1, I_CV2, I_UPN, I_UPF, I_WOUT, I_MQN, I_MKVN, I_MWQ, I_MWKV, I_MWO, I_F2N, I_F2G, I_F2U, I_F2D, I_FINN };

__device__ __forceinline__ float wave_sum(float v) {
#pragma unroll
    for (int o = 1; o < 64; o <<= 1) v += __shfl_xor(v, o);
    return v;
}
struct ItemD { const float* wp; const float* gp; bf16_t* wt; int ldsrc, K, k0, dstrow0; float scl; bool zero; };
struct ItemR { f32x4 v[8]; float gk[8]; };
__device__ __forceinline__ void cm_plain(int n, int off, int& sc) { sc = n + off; }
__device__ __forceinline__ void cm_win(int n, int& sc, float& scl) {
    scl = 1.f;
    if (n < 512) { sc = n; scl = QS64; }
    else if (n < 1280) sc = n;
    else if (n < 1792) { sc = 1304 + (n - 1280); scl = QS64; }
    else if (n < 2816) sc = 1816 + (n - 1792);
    else if (n < 4864) sc = 2848 + (n - 2816);
    else if (n < 4888) sc = 1280 + (n - 4864);
    else if (n < 4896) sc = 2840 + (n - 4888);
    else sc = -1; }
constexpr int N_GU = 16 * 176, N_D = 44 * 32, N_WIN = 16 * 160, N_UP = 8 * 32, N_SQ = 16 * 32, N_MKV = 16 * 64, N_C1 = 32 * 8, N_C2 = 4 * 2;
constexpr int CONV_NA = N_GU + N_D + N_WIN + N_MKV + 2 * N_C1 + 2 * N_C2, CONV_NB = N_GU + N_D + 2 * N_UP + 3 * N_SQ;
__device__ __forceinline__ ItemD conv_decode(const Args& a, int it, int lane) {
    unsigned char* ws = a.ws; int r = it; ItemD d; const int c4 = lane & 7, kr = lane >> 3;
    const float* W; int ldsrc, K, kb, dr, off = 0; const float* gain = nullptr; bf16_t* wt; float scl = 1.f; bool win = false;
    const int f = r >= CONV_NA; if (f) r -= CONV_NA;
    if (r < N_GU) { kb = r / 176; const int gi = r % 176; dr = gi * 32; const int tile = dr >> 8, within = dr & 255;
        W = a.in[within < 128 ? (f ? I_F2G : I_F1G) : (f ? I_F2U : I_F1U)]; ldsrc = FF; K = DM; wt = (bf16_t*)(ws + (f ? WS_WGU2 : WS_WGU1)); gain = a.in[f ? I_F2N : I_F1N]; off = tile * 128 + (within & 127) - dr; }
    else if ((r -= N_GU) < N_D) { kb = r / 32; dr = (r % 32) * 32; W = a.in[f ? I_F2D : I_F1D]; ldsrc = DM; K = FF; wt = (bf16_t*)(ws + (f ? WS_WD2 : WS_WD1)); }
    else if (!f) { r -= N_D;
        if (r < N_WIN) { kb = r / 160; dr = (r % 160) * 32; W = a.in[I_WIN]; ldsrc = 4896; K = DM; wt = (bf16_t*)(ws + WS_WIN); gain = a.in[I_MIXN]; win = true; }
        else if ((r -= N_WIN) < N_MKV) { kb = r / 64; dr = (r % 64) * 32; W = a.in[I_MWKV]; ldsrc = 2048; K = DM; wt = (bf16_t*)(ws + WS_WMKV); gain = a.in[I_MKVN]; }
        else if ((r -= N_MKV) < 2 * N_C1) { const int g = r >= N_C1; r -= g * N_C1; kb = r / 8; dr = (r % 8) * 32; W = a.in[g ? I_CV1 : I_CK1]; ldsrc = 256; K = 2048; wt = (bf16_t*)(ws + (g ? WS_CW1V : WS_CW1K)); }
        else { r -= 2 * N_C1; const int g = r >= N_C2; r -= g * N_C2; kb = r / 2; dr = (r % 2) * 32; W = a.in[g ? I_CV2 : I_CK2]; ldsrc = 64; K = 256; wt = (bf16_t*)(ws + (g ? WS_CW2V : WS_CW2K)); }
    } else { r -= N_D;
        if (r < 2 * N_UP) { const int g = r >= N_UP; r -= g * N_UP; kb = r / 32; dr = (r % 32) * 32; W = a.in[g ? I_UPF : I_UPN]; ldsrc = DM; K = 512; wt = (bf16_t*)(ws + (g ? WS_WUPF : WS_WUPN)); }
        else { r -= 2 * N_UP; const int g = r / N_SQ; r -= g * N_SQ; kb = r / 32; dr = (r % 32) * 32; W = a.in[g == 0 ? I_WOUT : (g == 1 ? I_MWQ : I_MWO)]; ldsrc = DM; K = DM;
            wt = (bf16_t*)(ws + (g == 0 ? WS_WOUT : (g == 1 ? WS_WMQ : WS_WMO))); if (g == 1) { W = a.in[I_MWO]; wt = (bf16_t*)(ws + WS_WMO); } }
    }
    int sc; if (win) cm_win(dr + 4 * c4, sc, scl); else cm_plain(dr + 4 * c4, off, sc);
    d.zero = sc < 0; d.wp = W + (size_t)(kb * 64 + kr) * ldsrc + (sc < 0 ? 0 : sc); d.gp = gain ? gain + kb * 64 + kr : nullptr; d.wt = wt; d.ldsrc = ldsrc; d.K = K; d.k0 = kb * 64; d.dstrow0 = dr; d.scl = scl;
    return d;
}
__device__ __forceinline__ void conv_load(const ItemD& d, ItemR& r) {
#pragma unroll
    for (int i = 0; i < 8; ++i) { r.v[i] = d.zero ? (f32x4){0.f, 0.f, 0.f, 0.f} : *(const f32x4*)(d.wp + (size_t)(8 * i) * d.ldsrc); r.gk[i] = d.gp ? d.gp[8 * i] : 1.f; }
}
__device__ __forceinline__ void conv_finish(const ItemD& d, const ItemR& r, LAS float* scr, int lane) {
    const int kr = lane >> 3, c4 = lane & 7;
#pragma unroll
    for (int i = 0; i < 8; ++i) { const int kk = 8 * i + kr; const float s = r.gk[i] * d.scl; LAS float* p = scr + kk * 33 + 4 * c4; p[0] = r.v[i][0] * s; p[1] = r.v[i][1] * s; p[2] = r.v[i][2] * s; p[3] = r.v[i][3] * s; }
    asm volatile("s_waitcnt lgkmcnt(0)" ::: "memory");
    const int c = lane & 7;
#pragma unroll
    for (int j = 0; j < 4; ++j) { const int nn = (lane >> 3) + 8 * j; const LAS float* s = scr + (8 * c) * 33 + nn;
        u32x4 o; o.x = cvtpk(s[0 * 33], s[1 * 33]); o.y = cvtpk(s[2 * 33], s[3 * 33]); o.z = cvtpk(s[4 * 33], s[5 * 33]); o.w = cvtpk(s[6 * 33], s[7 * 33]);
        *(u32x4*)(d.wt + (size_t)(d.dstrow0 + nn) * d.K + d.k0 + 8 * c) = o; }
    asm volatile("s_waitcnt lgkmcnt(0)" ::: "memory");
}
__device__ __forceinline__ void conv_run(const Args& a, int it0, int itend, int stride, LAS float* scr, int lane) {
    if (it0 >= itend) return;
    ItemD d0 = conv_decode(a, it0, lane); ItemR r0; conv_load(d0, r0);
    for (int it = it0 + stride; ; it += stride) {
        const bool more = it < itend;
        ItemD d1; ItemR r1;
        if (more) { d1 = conv_decode(a, it, lane); conv_load(d1, r1); }
        conv_finish(d0, r0, scr, lane);
        if (!more) break;
        d0 = d1; r0 = r1;
    }
}

__device__ __forceinline__ void p0_prologue(const Args& a, LAS unsigned char* lds, int gw, int NGW, int wave, int lane) {
    unsigned char* ws = a.ws;
    LAS float* scr = (LAS float*)(lds + wave * 16384);
    conv_run(a, gw, N_GU, NGW, scr, lane);
    { f32x4* z = (f32x4*)(ws + WS_SSQ); for (int i = gw * 64 + lane; i < 3 * M / 2; i += NGW * 64) z[i] = (f32x4){0.f, 0.f, 0.f, 0.f}; }
    for (int mrow = gw; mrow < M + MROWS; mrow += NGW) {
        const bool ismem = mrow >= M; const int rr = ismem ? mrow - M : mrow;
        const f32x4* xr = (const f32x4*)((ismem ? a.in[I_MEM] : a.in[I_X]) + (size_t)rr * DM) + lane;
        unsigned long long* o8 = (unsigned long long*)((bf16_t*)(ws + (ismem ? WS_MEMB : WS_XB)) + (size_t)rr * DM) + lane;
        float s = 0.f; f32x4 v[4];
#pragma unroll
        for (int j = 0; j < 4; ++j) v[j] = xr[64 * j];
#pragma unroll
        for (int j = 0; j < 4; ++j) { s += (v[j][0] * v[j][0] + v[j][1] * v[j][1]) + (v[j][2] * v[j][2] + v[j][3] * v[j][3]);
            o8[64 * j] = (unsigned long long)cvtpk(v[j][0], v[j][1]) | ((unsigned long long)cvtpk(v[j][2], v[j][3]) << 32); }
        s = wave_sum(s);
        if (lane == 0) ((float*)(ws + (ismem ? WS_SSM : WS_SS)))[rr] = s;
    }
    for (int t = gw; t < 64; t += NGW) { const int kv = t >> 5, kc = (t & 31) * 64; const float* pos = a.in[kv ? I_POSV : I_POSK] + kc; const f32x4* w1 = (const f32x4*)(a.in[kv ? I_CV1 : I_CK1] + (size_t)kc * 256) + lane;
        f32x4 s = {0.f, 0.f, 0.f, 0.f};
#pragma unroll 8
        for (int k = 0; k < 64; ++k) s += w1[(size_t)k * 64] * pos[k];
        *(f32x4*)((float*)(ws + WS_POSCP) + ((t & 31) * 2 + kv) * 256 + 4 * lane) = s; }
}

__device__ __forceinline__ void wqn_rows(const Args& a, int w0, int nw, int lane) {
    for (int d = w0; d < DM; d += nw) { const float s = a.in[I_MQN][d] * QS256; const f32x4* xr = (const f32x4*)(a.in[I_MWQ] + (size_t)d * DM) + lane;
        unsigned long long* o8 = (unsigned long long*)((bf16_t*)(a.ws + WS_WMQ) + (size_t)d * DM) + lane; f32x4 v[4];
#pragma unroll
        for (int j = 0; j < 4; ++j) v[j] = xr[64 * j];
#pragma unroll
        for (int j = 0; j < 4; ++j) o8[64 * j] = (unsigned long long)cvtpk(v[j][0] * s, v[j][1] * s) | ((unsigned long long)cvtpk(v[j][2] * s, v[j][3] * s) << 32); }
}
__device__ __forceinline__ void compress_unit(const Args& a, LAS unsigned char* lds, int uidx) {
    unsigned char* ws = a.ws;
    const int tid = fresh_tid(), lane = tid & 63, r32 = lane & 31, hi = lane >> 5, wid = __builtin_amdgcn_readfirstlane(tid >> 6);
    const int kv = uidx >> 6, b = (uidx >> 3) & 7, g = (uidx >> 2) & 1, chunk = uidx & 3, n0 = chunk * 32;
    const bf16_t* W1 = (const bf16_t*)(ws + (kv ? WS_CW1V : WS_CW1K)); const bf16_t* W2 = (const bf16_t*)(ws + (kv ? WS_CW2V : WS_CW2K));
    const float* poscp = (const float*)(ws + WS_POSCP) + kv * 256;
    const bf16_t* asrc = (const bf16_t*)(ws + WS_KVN) + (size_t)(b * SEQ) * 768 + kv * 128 + g * 64;
    LAS bf16_t* As = (LAS bf16_t*)lds;
    for (int i = tid; i < 528 * 8; i += 512) { const int row = i >> 3, ch = i & 7; const int t = min(16 * n0 + row, SEQ - 1);
        *(LAS u32x4*)(As + row * 64 + ((ch ^ ((row >> 4) & 7)) * 8)) = *(const u32x4*)(asrc + (size_t)t * 768 + ch * 8); }
    __syncthreads();
    const bf16_t* brow = W1 + (size_t)(32 * wid + r32) * 2048 + hi * 8;
    f32x16 acc = f32x16{}, accb = f32x16{};
#pragma unroll 8
    for (int kk = 0; kk < 128; kk += 2) {
        { const int l = kk >> 2, dch = (kk & 3) * 2 + hi, row = 16 * r32 + l;
          const bf16x8 av = *(const LAS bf16x8*)(As + row * 64 + ((dch ^ ((row >> 4) & 7)) * 8)); const bf16x8 bv = *(const bf16x8*)(brow + kk * 16);
          acc = __builtin_amdgcn_mfma_f32_32x32x16_bf16(av, bv, acc, 0, 0, 0); }
        { const int k1 = kk + 1, l = k1 >> 2, dch = (k1 & 3) * 2 + hi, row = 16 * r32 + l;
          const bf16x8 av = *(const LAS bf16x8*)(As + row * 64 + ((dch ^ ((row >> 4) & 7)) * 8)); const bf16x8 bv = *(const bf16x8*)(brow + k1 * 16);
          accb = __builtin_amdgcn_mfma_f32_32x32x16_bf16(av, bv, accb, 0, 0, 0); } }
    acc += accb;
    LAS bf16_t* Hs = (LAS bf16_t*)(lds + 81920);
    float pc = 0.f;
#pragma unroll 8
    for (int c = 0; c < 32; ++c) pc += poscp[c * 512 + 32 * wid + r32];
#pragma unroll
    for (int r = 0; r < 16; ++r) { const float x = acc[r] + pc; const float u = 0.7978845608028654f * (x + 0.044715f * x * x * x);
        const float ge = x * frcp(1.0f + fexp2(-2.0f * LOG2E * u)); Hs[att::crow(r, hi) * 264 + 32 * wid + r32] = (bf16_t)(cvtpk(ge, 0.f) & 0xffffu); }
    __syncthreads();
    if (wid < 2) { f32x16 acc2 = f32x16{};
#pragma unroll
        for (int kk = 0; kk < 16; ++kk) { const bf16x8 av = *(const LAS bf16x8*)(Hs + r32 * 264 + kk * 16 + hi * 8); const bf16x8 bv = *(const bf16x8*)(W2 + (size_t)(32 * wid + r32) * 256 + kk * 16 + hi * 8);
            acc2 = __builtin_amdgcn_mfma_f32_32x32x16_bf16(av, bv, acc2, 0, 0, 0); }
        bf16_t* outp = (bf16_t*)(ws + (kv ? WS_VC : WS_KC)) + (size_t)((b * 2 + g) * 128) * 64;
#pragma unroll
        for (int r = 0; r < 16; ++r) { const int n = n0 + att::crow(r, hi); const float v = n < 127 ? acc2[r] : 0.f; outp[(size_t)n * 64 + 32 * wid + r32] = (bf16_t)(cvtpk(v, 0.f) & 0xffffu); } }
    __syncthreads();
}
__device__ __forceinline__ void kmax_task(const Args& a, LAS unsigned char* lds, int task, int wave, int lane) {
    const int b = task >> 3, h = task & 7; float mx = 0.f;
    const bf16_t* K = (const bf16_t*)(a.ws + WS_KVF) + (size_t)(b * SEQ) * 1024 + h * 64;
#pragma unroll
    for (int rr = 0; rr < 4; ++rr) { const u32x4* p = (const u32x4*)(K + (size_t)(wave * 256 + rr * 64 + lane) * 1024); float ss = 0.f;
#pragma unroll
        for (int c = 0; c < 8; ++c) { const u32x4 v = p[c]; ss += (bflo(v.x) * bflo(v.x) + bfhi(v.x) * bfhi(v.x)) + (bflo(v.y) * bflo(v.y) + bfhi(v.y) * bfhi(v.y)) + (bflo(v.z) * bflo(v.z) + bfhi(v.z) * bfhi(v.z)) + (bflo(v.w) * bflo(v.w) + bfhi(v.w) * bfhi(v.w)); }
        mx = fmaxf(mx, ss); }
#pragma unroll
    for (int o = 1; o < 64; o <<= 1) mx = fmaxf(mx, __shfl_xor(mx, o));
    LAS float* red = (LAS float*)(lds + 120 * 1024);
    if (lane == 0) red[wave] = mx;
    __syncthreads();
    if (wave == 0 && lane == 0) { float m2 = red[0]; for (int i = 1; i < 8; ++i) m2 = fmaxf(m2, red[i]); ((float*)(a.ws + WS_KMAX))[task] = sqrtf(m2) * 1.01f; }
    __syncthreads();
}
__device__ __forceinline__ void cumsum_task(const Args& a, int task, int lane) {
    const int b = task >> 3, h = task & 7; const float bf = a.in[I_BF][h];
    const float* fl = (const float*)(a.ws + WS_F32S) + (size_t)(b * SEQ) * 32 + 24 + h; float* out = (float*)(a.ws + WS_CUM) + (size_t)task * SEQ;
    float v[32];
#pragma unroll
    for (int i = 0; i < 32; ++i) v[i] = fl[(size_t)(64 * i + lane) * 32];
    float carry = 0.f;
#pragma unroll
    for (int i = 0; i < 32; ++i) { const float x = v[i] + bf; float inc = fminf(x, 0.f) - log1pf(expf(-fabsf(x)));
#pragma unroll
        for (int o = 1; o < 64; o <<= 1) { const float t = __shfl_up(inc, o); if (lane >= o) inc += t; }
        inc += carry; out[64 * i + lane] = -inc * LOG2E; carry = __shfl(inc, 63); }
}

__device__ __forceinline__ void init_t5_table(const Args& a, LAS unsigned char* lds) {
    LAS float* T = (LAS float*)(lds + att::L_TBL);
    for (int i = fresh_tid(); i < 1024; i += 512) { const int h = i >> 7, d = i & 127; T[i] = a.in[I_RELB][T5B[d] * 8 + h] * LOG2E; }
}
template <bool DRY> __device__ __forceinline__ void fox_unit(const Args& a, LAS unsigned char* lds, int b, int h, int qb) {
    using namespace att;
    unsigned char* ws = a.ws;
    const int tid = fresh_tid(), lane = tid & 63, r32 = lane & 31, hi = lane >> 5, wid = __builtin_amdgcn_readfirstlane(tid >> 6);
    const int q0 = qb * 256, q0w = q0 + wid * 32, qpos = q0w + r32;
    LAS float* cb = (LAS float*)(lds + L_CB); LAS float* wsf = (LAS float*)(lds + L_WSF) + wid * 64;
    const float* cum = (const float*)(ws + WS_CUM) + (size_t)(b * 8 + h) * SEQ;
    for (int i = tid; i < q0 + 256; i += 512) cb[i] = cum[i];
    bf16_t* Qw = (bf16_t*)(ws + WS_QF) + (size_t)(b * SEQ + q0w) * 512 + h * 64;
    bf16x8 qr[4]; load_q(qr, Qw, 512, r32, hi);
    f32x16 o[2]; o[0] = f32x16{}; o[1] = f32x16{}; float m = 0.f, l = 0.f;
    const int nt = 4 * qb + 4; unsigned tmask = nt >= 32 ? 0xffffffffu : ((1u << nt) - 1u);
    const bf16_t* Kg = (const bf16_t*)(ws + WS_KVF) + (size_t)(b * SEQ) * 1024 + h * 64;
#ifndef NO_FOX_SKIP
    {
        const float cb0 = cum[q0], cbt = cum[64 * (lane < nt ? lane : 0) + 63], kmx = ((const float*)(ws + WS_KMAX))[b * 8 + h];
        float qq = 0.f;
#pragma unroll
        for (int d0 = 0; d0 < 4; ++d0) { const u32x4 v = __builtin_bit_cast(u32x4, qr[d0]);
            qq += (bflo(v.x) * bflo(v.x) + bfhi(v.x) * bfhi(v.x)) + (bflo(v.y) * bflo(v.y) + bfhi(v.y) * bfhi(v.y)) + (bflo(v.z) * bflo(v.z) + bfhi(v.z) * bfhi(v.z)) + (bflo(v.w) * bflo(v.w) + bfhi(v.w) * bfhi(v.w)); }
        qq = halfsum(qq);
#pragma unroll
        for (int o_ = 1; o_ < 32; o_ <<= 1) qq = fmaxf(qq, __shfl_xor(qq, o_));
        LAS float* red = (LAS float*)(lds + L_MISC + 384 + (qb & 1) * 32);
        if (lane == 0) red[wid] = qq;
        __syncthreads();
        float qmax = red[0];
#pragma unroll
        for (int i = 1; i < 8; ++i) qmax = fmaxf(qmax, red[i]);
        const float need = 2.0f * sqrtf(qmax) * 1.01f * kmx + 40.0f;
        const bool skip = (lane < 32) && (lane < nt) && (cb0 - cbt >= need);
        const unsigned long long bal = __ballot(skip);
        tmask &= ~(unsigned)bal;
    }
#endif
#ifndef FOX_ABL
#define FOX_ABL 0
#endif
    if (DRY && (FOX_ABL & 64)) tmask = 1u << (31 - __clz((int)tmask));
    if (DRY) attn_loop2<FOX_ABL>(tmask, Kg, 1024, Kg + 512, 1024, lds, qr, o, m, l, TfFox{cb, qpos, hi, q0w}, q0w + 31);
    else attn_loop2<0>(tmask, Kg, 1024, Kg + 512, 1024, lds, qr, o, m, l, TfFox{cb, qpos, hi, q0w}, q0w + 31);
    l = halfsum(l);
    scale_rows(o, wsf, 1.0f / l, r32, hi);
    store_o<false>(o, lds, DRY ? (bf16_t*)((unsigned char*)a.out + 16 * MiB) + (size_t)(b * SEQ + q0w) * 512 + h * 64 : Qw, 512, nullptr, 0);
}
template <int PARTS> __device__ __forceinline__ void cmpwin_unit(const Args& a, LAS unsigned char* lds, int b, int g, int qb) {
    using namespace att;
    unsigned char* ws = a.ws;
    const int tid = fresh_tid(), lane = tid & 63, r32 = lane & 31, hi = lane >> 5, wid = __builtin_amdgcn_readfirstlane(tid >> 6);
    const int j = wid >> 1, sub = wid & 1, hg = g * 4 + j, q0w = qb * 64 + sub * 32, qpos = q0w + r32; const size_t qrow = (size_t)b * SEQ + qpos;
    const LAS float* tb = (const LAS float*)(lds + L_TBL) + hg * 128;
    LAS float* wsf = (LAS float*)(lds + L_WSF) + wid * 64; LAS float* PS = (LAS float*)(lds + L_PS); LAS float* IMP = (LAS float*)(lds + L_IMP); LAS unsigned* MW = (LAS unsigned*)(lds + L_MISC);
    const float* gates = (const float*)(ws + WS_F32S) + qrow * 32;
    if (tid == 0) MW[0] = 0u;
    bf16x8 qr[4]; load_q(qr, (const bf16_t*)(ws + WS_QN) + (size_t)(b * SEQ + q0w) * 512 + hg * 64, 512, r32, hi);
    const StageGeo sg = stage_geo(tid);
    { const bf16_t* Kc = (const bf16_t*)(ws + WS_KC) + (size_t)((b * 2 + g) * 128) * 64; const bf16_t* Vc = (const bf16_t*)(ws + WS_VC) + (size_t)((b * 2 + g) * 128) * 64;
#pragma unroll
        for (int t = 0; t < 2; ++t) { *(LAS u32x4*)(lds + L_SLOT + t * 16384 + sg.koff) = *(const u32x4*)(Kc + (size_t)(t * 64 + sg.krow) * 64 + sg.kcol);
            *(LAS u32x4*)(lds + L_SLOT + t * 16384 + sg.voff) = *(const u32x4*)(Vc + (size_t)(t * 64 + sg.vrow) * 64 + sg.vcol); } }
    __syncthreads();
    if (PARTS & 1) {
        f32x16 oc[2]; oc[0] = f32x16{}; oc[1] = f32x16{};
        f32x16 a0, a1, b0, b1; qkt(a0, a1, lds + L_SLOT, qr, r32, hi); qkt(b0, b1, lds + L_SLOT + 16384, qr, r32, hi);
        float mx = NEG;
#pragma unroll
        for (int r = 0; r < 16; ++r) { const int d = qpos - 16 * crow(r, hi) - 31;
            a0[r] = d >= 0 ? a0[r] + tb[min(d, 127)] : NEG; a1[r] = d - 512 >= 0 ? a1[r] + tb[min(d - 512, 127)] : NEG;
            b0[r] = d - 1024 >= 0 ? b0[r] + tb[min(d - 1024, 127)] : NEG; b1[r] = d - 1536 >= 0 ? b1[r] + tb[min(d - 1536, 127)] : NEG;
            mx = fmaxf(fmaxf(mx, fmaxf(a0[r], a1[r])), fmaxf(b0[r], b1[r])); }
        { auto rr = __builtin_amdgcn_permlane32_swap(__float_as_uint(mx), __float_as_uint(mx), false, false); mx = fmaxf(__uint_as_float(rr[0]), __uint_as_float(rr[1])); }
        const float mxs = mx == NEG ? 0.f : mx; float s = 0.f;
#pragma unroll
        for (int r = 0; r < 16; ++r) { a0[r] = fexp2(a0[r] - mxs); a1[r] = fexp2(a1[r] - mxs); b0[r] = fexp2(b0[r] - mxs); b1[r] = fexp2(b1[r] - mxs); s += (a0[r] + a1[r]) + (b0[r] + b1[r]); }
        s = halfsum(s); const float inv = s > 0.f ? 1.0f / s : 0.f;
#pragma unroll
        for (int r = 0; r < 16; ++r) { a0[r] *= inv; a1[r] *= inv; b0[r] *= inv; b1[r] *= inv; }
        {
            float own[4][4], x3[4][4], rcv[4][4];
#pragma unroll
            for (int i = 0; i < 4; ++i) {
                own[0][i] = 2.0f * (a0[4 * i] + a0[4 * i + 1] + a0[4 * i + 2]) + a0[4 * i + 3]; x3[0][i] = a0[4 * i + 3];
                own[1][i] = 2.0f * (a1[4 * i] + a1[4 * i + 1] + a1[4 * i + 2]) + a1[4 * i + 3]; x3[1][i] = a1[4 * i + 3];
                own[2][i] = 2.0f * (b0[4 * i] + b0[4 * i + 1] + b0[4 * i + 2]) + b0[4 * i + 3]; x3[2][i] = b0[4 * i + 3];
                own[3][i] = 2.0f * (b1[4 * i] + b1[4 * i + 1] + b1[4 * i + 2]) + b1[4 * i + 3]; x3[3][i] = b1[4 * i + 3]; }
#pragma unroll
            for (int k = 0; k < 4; ++k)
#pragma unroll
                for (int i = 0; i < 4; ++i) { auto rr = __builtin_amdgcn_permlane32_swap(__float_as_uint(x3[k][i]), __float_as_uint(x3[k][i]), false, false); rcv[k][i] = __uint_as_float(hi ? rr[0] : rr[1]); }
            LAS float* imh = PS + j * (64 * 33) + (sub * 32 + r32) * 33 + hi;
#pragma unroll
            for (int k = 0; k < 4; ++k)
#pragma unroll
                for (int i = 0; i < 4; ++i) { const float prev = i > 0 ? rcv[k][i - 1] : (k > 0 ? rcv[k - 1][3] : 0.f);
                    imh[8 * k + 2 * i] = own[k][i] + (hi ? rcv[k][i] : prev); }
        }
        const int vb0 = (int)(unsigned)(size_t)(lds + L_SLOT + 8192) + ((lane >> 4) & 1) * 32 + (lane & 3) * 8 + (4 * hi + ((lane & 15) >> 2)) * 64;
        bf16x8 x0, x1, x2, x3; pack_p(a0, a1, x0, x1, x2, x3); pv(oc, vb0, x0, x1, x2, x3);
        pack_p(b0, b1, x0, x1, x2, x3); pv(oc, vb0 + 16384, x0, x1, x2, x3);
        scale_rows(oc, wsf, sigmoidf_(gates[hg]), r32, hi);
        store_o<false>(oc, lds, (bf16_t*)a.out + (size_t)(b * SEQ + q0w) * 512 + hg * 64, 512, nullptr, 0);
    }
    __syncthreads();
    if (PARTS & 2) {
        const int q = tid >> 3, jb = (tid & 7) * 4; const LAS float* ps = PS + q * 33; LAS float* im = IMP + q * 33;
#pragma unroll
        for (int jj = 0; jj < 4; ++jj) { const int jx = jb + jj;
            const float v = (ps[jx] + ps[64 * 33 + jx]) + (ps[2 * 64 * 33 + jx] + ps[3 * 64 * 33 + jx]);
            const bool valid = jx <= qb, forced = (jx == 0) || (jx == qb) || (jx == qb - 1);
            im[jx] = valid ? v + (forced ? 1e4f : 0.f) : -1e30f; }
        __syncthreads();
        unsigned bits = 0u;
#pragma unroll
        for (int jj = 0; jj < 4; ++jj) { const int jx = jb + jj; const float v = im[jx]; int cnt = 0;
#pragma unroll
            for (int j2 = 0; j2 < 32; ++j2) { const float v2 = im[j2]; cnt += (v2 > v || (v2 == v && j2 < jx)) ? 1 : 0; }
            if (cnt < 16 && jx <= qb) bits |= 1u << jx; }
        bits |= __shfl_xor(bits, 1); bits |= __shfl_xor(bits, 2); bits |= __shfl_xor(bits, 4);
        if ((tid & 7) == 0) { MW[16 + q] = bits; __hip_atomic_fetch_or(MW, bits, __ATOMIC_RELAXED, __HIP_MEMORY_SCOPE_WORKGROUP); }
        __syncthreads();
    }
    if (PARTS & 2) {
    f32x16 o[2]; o[0] = f32x16{}; o[1] = f32x16{}; float m = 0.f, l = 0.f;
    const unsigned mask = MW[16 + sub * 32 + r32];
    const unsigned um = MW[0] & (qb >= 31 ? 0xffffffffu : ((2u << qb) - 1u));
    const bf16_t* Kg = (const bf16_t*)(ws + WS_KVN) + (size_t)(b * SEQ) * 768 + 256 + g * 64;
    attn_loop2(um, Kg, 768, Kg + 128, 768, lds, qr, o, m, l, TfT5{tb, qpos, hi, q0w, 1 << 30, mask, true}, q0w + 31);
    l = halfsum(l);
    scale_rows(o, wsf, sigmoidf_(gates[8 + hg]) / l, r32, hi);
    { bf16_t* ocw = (bf16_t*)a.out + (size_t)(b * SEQ + q0w) * 512 + hg * 64; store_o<true>(o, lds, ocw, 512, ocw, 512); }
    }
    if (PARTS & 4) {
    f32x16 o[2]; o[0] = f32x16{}; o[1] = f32x16{}; float m = -1e30f, l = 0.f;
    const int lo = qb > 8 ? qb - 8 : 0; const unsigned tmask = (qb >= 31 ? 0xffffffffu : ((2u << qb) - 1u)) & ~((1u << lo) - 1u);
    const bf16_t* Kg = (const bf16_t*)(ws + WS_KVN) + (size_t)(b * SEQ) * 768 + 512 + g * 64;
    attn_loop2(tmask, Kg, 768, Kg + 128, 768, lds, qr, o, m, l, TfT5{tb, qpos, hi, q0w, 512, 0u, false}, q0w + 31);
    l = halfsum(l);
    scale_rows(o, wsf, sigmoidf_(gates[16 + hg]) / l, r32, hi);
    { const bf16_t* ocw = (const bf16_t*)a.out + (size_t)(b * SEQ + q0w) * 512 + hg * 64; store_o<true>(o, lds, (bf16_t*)(ws + WS_QN) + (size_t)(b * SEQ + q0w) * 512 + hg * 64, 512, ocw, 512); }
    }
}
template <bool DRY> __device__ __forceinline__ void sel_unit(const Args& a, LAS unsigned char* lds, int b, int g, int qb) {
    using namespace att;
    unsigned char* ws = a.ws;
    const int tid = fresh_tid(), lane = tid & 63, r32 = lane & 31, hi = lane >> 5, wid = __builtin_amdgcn_readfirstlane(tid >> 6);
    const int j = wid >> 1, sub = wid & 1, hg = g * 4 + j, q0w = qb * 64 + sub * 32, qpos = q0w + r32; const size_t qrow = (size_t)b * SEQ + qpos;
    const LAS float* tb = (const LAS float*)(lds + L_TBL) + hg * 128; LAS float* wsf = (LAS float*)(lds + L_WSF) + wid * 64;
    bf16_t* Qw = (bf16_t*)(ws + WS_QN) + (size_t)(b * SEQ + q0w) * 512 + hg * 64;
    bf16x8 qr[4]; load_q(qr, Qw, 512, r32, hi);
    const unsigned mask = ((const unsigned*)(ws + WS_MASK))[(size_t)(b * 2 + g) * SEQ + qpos];
    const unsigned um = ((const unsigned*)(ws + WS_UMASK))[(b * 2 + g) * 32 + qb] & (qb >= 31 ? 0xffffffffu : ((2u << qb) - 1u));
    f32x16 o[2]; o[0] = f32x16{}; o[1] = f32x16{}; float m = -1e30f, l = 0.f;
    const bf16_t* Kg = (const bf16_t*)(ws + WS_KVN) + (size_t)(b * SEQ) * 768 + 256 + g * 64;
    attn_loop2(um, Kg, 768, Kg + 128, 768, lds, qr, o, m, l, TfT5{tb, qpos, hi, q0w, 1 << 30, mask, true}, q0w + 31);
    l = halfsum(l);
    const float g1 = sigmoidf_(((const float*)(ws + WS_F32S))[qrow * 32 + 8 + hg]);
    scale_rows(o, wsf, g1 / l, r32, hi);
    store_o<true>(o, lds, DRY ? (bf16_t*)((unsigned char*)a.out + 16 * MiB) + (size_t)(b * SEQ + q0w) * 512 + hg * 64 : Qw, 512, (const bf16_t*)a.out + (size_t)(b * SEQ + q0w) * 512 + hg * 64, 512);
}
#ifndef PHMASK
#define PHMASK 0xffffffffu
#endif
#define PH(n) (((PHMASK) >> (n)) & 1u)
#ifndef MULTI_ALIGN
#define MULTI_ALIGN true
#endif
#ifndef SINGLE_ALIGN
#define SINGLE_ALIGN true
#endif
#ifndef DUPMASK
#define DUPMASK 0u
#endif
#define DUP(n) (((DUPMASK) >> (n)) & 1u)
#define REP(n) for (int rep_ = 0; rep_ < 1 + (int)DUP(n); ++rep_)
#define STAGE_SSQ(S_, ssptr) do { LAS float* aux_ = (LAS float*)(lds + RING_BYTES); pg8::Unit u_; const int t_ = fresh_tid(); \
        for (int i_ = 0; S_.next(i_, u_); ++i_) if (t_ < 256) aux_[i_ * 256 + t_] = ssq_f((ssptr)[u_.pm * 256 + t_]); \
        __syncthreads(); } while (0)
#define STAGE_SS(S_, ssptr) do { LAS float* aux_ = (LAS float*)(lds + RING_BYTES); pg8::Unit u_; const int t_ = fresh_tid(); \
        for (int i_ = 0; S_.next(i_, u_); ++i_) if (t_ < 256) aux_[i_ * 256 + t_] = (ssptr)[u_.pm * 256 + t_]; \
        __syncthreads(); } while (0)
__global__ void __launch_bounds__(512, 2) hybrid_fwd(Args a) {
    extern __shared__ __attribute__((aligned(16))) unsigned char lds_raw[];
    LAS unsigned char* lds = (LAS unsigned char*)lds_raw;
    cg::grid_group grid = cg::this_grid();
    unsigned char* ws = a.ws;
    const int tid = fresh_tid(), lane = tid & 63, wave = __builtin_amdgcn_readfirstlane(tid >> 6);
    const int G = gridDim.x, bx = blockIdx.x, vcu = (G % 8 == 0) ? (bx % 8) * (G / 8) + bx / 8 : bx;
    const int gw = vcu * 8 + wave, NGW = G * 8;
    float* X = a.out;
    bf16_t* XB = (bf16_t*)(ws + WS_XB);
    float* SS = (float*)(ws + WS_SS); unsigned long long* SSQ = (unsigned long long*)(ws + WS_SSQ);
    { volatile LAS unsigned* st0 = (volatile LAS unsigned*)(lds + LDS_BYTES - 256); if (tid < 32) st0[tid] = 0u; }
    __syncthreads();
    XcdBarrier xbar = xcd_barrier_post((unsigned*)(ws + WS_CTL) + CW_BAR, (volatile LAS unsigned*)(lds + LDS_BYTES - 256 + 32));
#ifdef USE_CG_SYNC
#define GSYNC() grid.sync()
#else
    if (a.lo == 0x7e57) grid.sync();
#ifdef TSTAMP
    int gs_cnt = 0; unsigned long long t_start = __builtin_amdgcn_s_memrealtime(), t_rec = 0;
    unsigned long long t_prev = t_start;
#define GSYNC() do { xcd_barrier(xbar); ++gs_cnt; if (gs_cnt == TSTAMP - 1) t_prev = __builtin_amdgcn_s_memrealtime(); if (gs_cnt == TSTAMP) t_rec = __builtin_amdgcn_s_memrealtime(); } while (0)
#else
#define GSYNC() xcd_barrier(xbar)
#endif
#endif
    const float* fin_src = a.in[I_X];

#if STAGE_LIMIT >= 1
    REP(0) p0_prologue(a, lds, gw, NGW, wave, lane);
    GSYNC();
    { pg8::Gemm g{XB, (const bf16_t*)(ws + WS_WGU1), DM, DM, DM, 0, 0, 0, 0}; pg8::Order S; S.init(64, 22, 1, G, bx);
      STAGE_SS(S, SS); pg8::EpiGU E{(bf16_t*)(ws + WS_H), (const LAS float*)(lds + RING_BYTES)};
#ifdef P1_NULLDUP
      { pg8::EpiNull E0{(float*)(ws + WS_POSC + 4096)}; pg8::gemm_phase<pg8::EpiNull, true>(lds, g, S, E0); }
#endif
      REP(1) pg8::gemm_phase<pg8::EpiGU, MULTI_ALIGN>(lds, g, S, E);
      if (bx >= 128) { LAS float* scr = (LAS float*)(lds + wave * 16384); conv_run(a, N_GU + (bx - 128) * 8 + wave, CONV_NA, 1024, scr, lane); } }
    GSYNC();
    { pg8::Gemm g{(const bf16_t*)(ws + WS_H), (const bf16_t*)(ws + WS_WD1), FF, FF, FF, 0, 0, 0, 0}; pg8::Order S; S.init(64, 4, 1, G, bx);
      if (DUP(2)) { pg8::EpiNull E0{(float*)(ws + WS_POSC + 4096)}; pg8::gemm_phase<pg8::EpiNull, false>(lds, g, S, E0); }
      pg8::EpiResB<false> E{nullptr, XB, SSQ, 0.5f}; pg8::gemm_phase<pg8::EpiResB<false>, false>(lds, g, S, E); }
    GSYNC();
    fin_src = X;
#endif
#if STAGE_LIMIT >= 2
#if PH(3)
    { pg8::Gemm g{XB, (const bf16_t*)(ws + WS_WIN), DM, DM, DM, 0, 0, 0, 0}; pg8::Order S; S.init(64, 20, 1, G, bx);
      pg8::EpiQKV E{(bf16_t*)(ws + WS_QN), (bf16_t*)(ws + WS_KVN), (bf16_t*)(ws + WS_QF), (bf16_t*)(ws + WS_KVF), (bf16_t*)(ws + WS_GAB), (float*)(ws + WS_F32S), (const LAS float*)(lds + RING_BYTES)};
      STAGE_SSQ(S, SSQ);
      REP(3) pg8::gemm_phase<pg8::EpiQKV, MULTI_ALIGN>(lds, g, S, E); }
#endif
    GSYNC();
#if PH(4)
    REP(4) if (bx < 128) { compress_unit(a, lds, bx); }
    else if (bx < 192) {
        { pg8::Gemm g{(const bf16_t*)(ws + WS_MEMB), (const bf16_t*)(ws + WS_WMKV), DM, DM, DM, 0, 0, 0, 0}; pg8::Order S; S.init(8, 8, 1, 64, bx - 128);
            pg8::EpiRowScale E{(bf16_t*)(ws + WS_KVM), 2 * DM, (const float*)(ws + WS_SSM)}; pg8::gemm_phase<pg8::EpiRowScale, false>(lds, g, S, E); }
    } else { if (wave == 0) cumsum_task(a, bx - 192, lane); kmax_task(a, lds, bx - 192, wave, lane); }
    if (bx >= 128) {
        LAS float* scr = (LAS float*)(lds + wave * 16384);
        if (bx < 192) conv_run(a, CONV_NA + (bx - 128) * 8 + wave, CONV_NA + CONV_NB, 1536, scr, lane);
        else { const int s0_ = 512 + ((bx - 192) * 8 + wave) * 2; conv_run(a, CONV_NA + s0_, CONV_NA + CONV_NB, 1536, scr, lane); conv_run(a, CONV_NA + s0_ + 1, CONV_NA + CONV_NB, 1536, scr, lane); }
        wqn_rows(a, (bx - 128) * 8 + wave, 1024, lane); }
#endif
    GSYNC();
#if PH(5)
    init_t5_table(a, lds);
    { const int bh = vcu >> 2, s = vcu & 3; if (DUP(5)) { fox_unit<true>(a, lds, bh >> 3, bh & 7, 7 - s); fox_unit<true>(a, lds, bh >> 3, bh & 7, s); }
      fox_unit<false>(a, lds, bh >> 3, bh & 7, 7 - s); fox_unit<false>(a, lds, bh >> 3, 7 - (bh & 7), s); }
#ifdef DUPPART
    { const int bg = vcu >> 4, s = vcu & 15; cmpwin_unit<DUPPART>(a, lds, bg >> 1, bg & 1, 31 - s); cmpwin_unit<DUPPART>(a, lds, bg >> 1, bg & 1, s); }
#endif
#ifndef NO_CMPWIN
    REP(15) { const int bg = vcu >> 4, s = vcu & 15; cmpwin_unit<7>(a, lds, bg >> 1, bg & 1, 31 - s); cmpwin_unit<7>(a, lds, bg >> 1, bg & 1, s); }
#endif
#endif
    GSYNC();
#if PH(7)
    REP(7) { pg8::PairOrder S; S.base.init(64, 4, 1, G, bx);
      pg8::Gemm g{(const bf16_t*)(ws + WS_QN), (const bf16_t*)(ws + WS_WUPN), 512, 512, 512, 0, (long)(WS_QF - WS_QN) / 2, 0, (long)(WS_WUPF - WS_WUPN) / 2};
      pg8::EpiUp<2> E{(const bf16_t*)(ws + WS_GAB), (bf16_t*)(ws + WS_Y)}; pg8::gemm_phase<pg8::EpiUp<2>, true>(lds, g, S, E); }
#endif
    GSYNC();
#if PH(8)
    { pg8::Gemm g{(const bf16_t*)(ws + WS_Y), (const bf16_t*)(ws + WS_WOUT), DM, DM, DM, 0, 0, 0, 0}; pg8::Order S; S.init(64, 4, 1, G, bx);
      if (DUP(8)) { pg8::EpiNull E0{(float*)(ws + WS_POSC + 4096)}; pg8::gemm_phase<pg8::EpiNull, false>(lds, g, S, E0); }
      pg8::EpiResB<false> E{nullptr, XB, SSQ + M, 1.0f}; pg8::gemm_phase<pg8::EpiResB<false>, false>(lds, g, S, E); }
    if (bx < 128) { pg8::Gemm g{(const bf16_t*)(ws + WS_KVM), (const bf16_t*)(ws + WS_WMQ), 2 * DM, DM, 256, (long)MEMLEN * 2 * DM, 256, 0, 256};
        pg8::OneUnit S{pg8::Unit{0, bx & 3, bx >> 2}}; pg8::EpiBatchBf16 E{(bf16_t*)(ws + WS_MT), DM, (long)DM * DM, (long)256 * DM}; pg8::gemm_phase<pg8::EpiBatchBf16, false>(lds, g, S, E); }
    else { pg8::Gemm g{(const bf16_t*)(ws + WS_WMO), (const bf16_t*)(ws + WS_KVM) + DM, DM, 2 * DM, 256, 0, 256, (long)MEMLEN * 2 * DM, 256};
        pg8::OneUnit S{pg8::Unit{(bx - 128) & 3, 0, (bx - 128) >> 2}}; pg8::EpiBatchBf16 E{(bf16_t*)(ws + WS_NT), DM, (long)DM * DM, 256}; pg8::gemm_phase<pg8::EpiBatchBf16, false>(lds, g, S, E); }
#endif
    GSYNC();
#endif
#if STAGE_LIMIT >= 3
    { pg8::Gemm g{XB, (const bf16_t*)(ws + WS_MT), DM, DM, DM, 0, 0, (long)4 * DM * DM, (long)DM * DM}; pg8::Order S; S.init(64, 4, 1, G, bx, 3);
      pg8::EpiSoftmaxRS E{(bf16_t*)(ws + WS_PM), DM, SSQ + M}; pg8::gemm_phase<pg8::EpiSoftmaxRS, false>(lds, g, S, E); }
    GSYNC();
    { pg8::Gemm g{(const bf16_t*)(ws + WS_PM), (const bf16_t*)(ws + WS_NT), DM, DM, DM, 0, 0, (long)4 * DM * DM, (long)DM * DM}; pg8::Order S; S.init(64, 4, 1, G, bx, 3);
      pg8::EpiResB<false> E{nullptr, XB, SSQ + 2 * M, 1.0f}; pg8::gemm_phase<pg8::EpiResB<false>, false>(lds, g, S, E); }
    GSYNC();
#endif
#if STAGE_LIMIT >= 4
    { pg8::Gemm g{XB, (const bf16_t*)(ws + WS_WGU2), DM, DM, DM, 0, 0, 0, 0}; pg8::Order S; S.init(64, 22, 1, G, bx);
      STAGE_SSQ(S, SSQ + 2 * M); pg8::EpiGU E{(bf16_t*)(ws + WS_H), (const LAS float*)(lds + RING_BYTES)}; REP(13) pg8::gemm_phase<pg8::EpiGU, MULTI_ALIGN>(lds, g, S, E); }
    GSYNC();
    { pg8::Gemm g{(const bf16_t*)(ws + WS_H), (const bf16_t*)(ws + WS_WD2), FF, FF, FF, 0, 0, 0, 0}; pg8::Order S; S.init(64, 4, 1, G, bx);
      pg8::EpiResNorm E{XB, X, 0.5f, a.in[I_FINN], (float*)(ws + WS_XBUF), (unsigned*)(ws + WS_FINCNT)}; pg8::gemm_phase<pg8::EpiResNorm, false>(lds, g, S, E); }
#ifdef TSTAMP
    GSYNC();
    if (t_rec == 0) t_rec = __builtin_amdgcn_s_memrealtime();
    if (bx == 0) { const int n = (int)((t_rec - t_prev) * 400 / 100); for (int i = tid; i < n; i += 512) X[i] += 0.1f; }
#endif
    return;
#endif
#ifdef EXTRA_BARS
    for (int eb = 0; eb < EXTRA_BARS; ++eb) GSYNC();
#endif
    { const float* gn = a.in[I_FINN]; const int tid2 = fresh_tid(), lane = tid2 & 63, gw = vcu * 8 + (tid2 >> 6);
      for (int mrow = gw; mrow < M; mrow += NGW) {
          const f32x4* xr = (const f32x4*)(fin_src + (size_t)mrow * DM) + lane; f32x4* orow = (f32x4*)(X + (size_t)mrow * DM) + lane;
          f32x4 v[4]; float s = 0.f;
#pragma unroll
          for (int j = 0; j < 4; ++j) { v[j] = xr[64 * j]; s += (v[j][0] * v[j][0] + v[j][1] * v[j][1]) + (v[j][2] * v[j][2] + v[j][3] * v[j][3]); }
          const float rs = rstd_of(wave_sum(s));
#pragma unroll
          for (int j = 0; j < 4; ++j) orow[64 * j] = v[j] * rs * ((const f32x4*)gn)[lane + 64 * j];
      } }
}

extern "C" void kernel_launch(void* const* d_in, const int* in_sizes, int n_in, void* d_out, int out_size, void* d_ws, size_t ws_size, hipStream_t stream) {
    static int grid = 0;
    if (grid == 0) {
        if (n_in != 29 || out_size != M * DM || ws_size < WS_END) { fprintf(stderr, "kernel_launch: unexpected shapes (n_in %d out %d ws %zu)\n", n_in, out_size, ws_size); grid = -1; return; }
        int dev = 0, cus = 0, per_cu = 0;
        hipGetDevice(&dev); hipDeviceGetAttribute(&cus, hipDeviceAttributeMultiprocessorCount, dev);
        if (hipFuncSetAttribute((const void*)hybrid_fwd, hipFuncAttributeMaxDynamicSharedMemorySize, LDS_BYTES) != hipSuccess) { fprintf(stderr, "kernel_launch: hipFuncSetAttribute failed\n"); grid = -1; return; }
        if (hipOccupancyMaxActiveBlocksPerMultiprocessor(&per_cu, (const void*)hybrid_fwd, 512, LDS_BYTES) != hipSuccess || per_cu < 1) { fprintf(stderr, "kernel_launch: occupancy query failed (%d)\n", per_cu); per_cu = 1; }
        (void)hipGetLastError();
        grid = cus * (per_cu < 1 ? 1 : 1);
        if (grid != 256) fprintf(stderr, "kernel_launch: grid %d != 256: this kernel's phase maps assume 256 workgroups\n", grid);
    }
    if (grid < 0) return;
    hipMemsetAsync((char*)d_ws + WS_CTL, 0, CTL_ZERO_BYTES, stream);
    Args a{};
    for (int i = 0; i < 29; ++i) a.in[i] = (const float*)d_in[i];
    a.out = (float*)d_out; a.ws = (unsigned char*)d_ws; a.lo = 0; a.hi = 0;
    void* args[] = {&a};
#ifdef PLAIN_LAUNCH
    hipLaunchKernelGGL(hybrid_fwd, dim3(grid), dim3(512), LDS_BYTES, stream, a); hipError_t e = hipPeekAtLastError(); (void)args;
#else
    hipError_t e = hipLaunchCooperativeKernel((const void*)hybrid_fwd, dim3(grid), dim3(512), args, LDS_BYTES, stream);
#endif
    if (e != hipSuccess) fprintf(stderr, "kernel_launch: cooperative launch failed: %s (grid %d)\n", hipGetErrorString(e), grid);
}
```

```cpp
#define ATT_PRE_MASK 7
#define D2_P13 1
#define CONVB_SKIP_D2 1
#define FOX_DYN 1
#define CFAR_OPAQUE 1
#include <hip/hip_runtime.h>
#include <hip/hip_cooperative_groups.h>
#include <cstdio>
#include <cstdint>
namespace cg = cooperative_groups;

#define LAS __attribute__((address_space(3)))
__device__ __forceinline__ void wg_barrier_() { __builtin_amdgcn_fence(__ATOMIC_RELEASE, "workgroup"); __builtin_amdgcn_s_barrier(); __builtin_amdgcn_fence(__ATOMIC_ACQUIRE, "workgroup"); }
__device__ __forceinline__ unsigned atomic_add_u32_(unsigned* p, unsigned v) { return __hip_atomic_fetch_add(p, v, __ATOMIC_RELAXED, __HIP_MEMORY_SCOPE_AGENT); }
#define __syncthreads() wg_barrier_()
#define atomicAdd(p, v) atomic_add_u32_((p), (v))
typedef unsigned short bf16_t;
typedef short bf16x8 __attribute__((ext_vector_type(8)));
typedef short s16x4 __attribute__((ext_vector_type(4)));
typedef float f32x2 __attribute__((ext_vector_type(2)));
typedef float f32x4 __attribute__((ext_vector_type(4)));
typedef float f32x16 __attribute__((ext_vector_type(16)));
typedef unsigned u32x2 __attribute__((ext_vector_type(2)));
typedef unsigned u32x4 __attribute__((ext_vector_type(4)));
typedef __bf16 bf16x2_t __attribute__((ext_vector_type(2)));
#ifndef WT_STORES
#define WT_STORES 1
#endif
#ifndef WT_MULTI
#define WT_MULTI 0
#endif
#ifndef WT_LASTUNIT
#define WT_LASTUNIT 0
#endif
#if WT_MULTI
#define ST16M(base, eidx, val) ST16(base, eidx, val)
#elif WT_LASTUNIT
#define ST16M(base, eidx, val) do { if (u.last) ST16(base, eidx, val); else *(u32x4*)((base) + (eidx)) = (val); } while (0)
#else
#define ST16M(base, eidx, val) (*(u32x4*)((base) + (eidx)) = (val))
#endif
#if WT_STORES
#define ST16(base, eidx, val) __builtin_amdgcn_raw_buffer_store_b128((val), __builtin_amdgcn_make_buffer_rsrc((void*)(base), (short)0, 0x7FFFFFFF, 0x00020000), (unsigned)((eidx) * 2u), 0, 16)
#else
#define ST16(base, eidx, val) (*(u32x4*)((base) + (eidx)) = (val))
#endif

constexpr int NB = 8, SEQ = 2048, DM = 1024, FF = 2816, M = NB * SEQ;
constexpr int MEMLEN = 256, MROWS = NB * MEMLEN;
constexpr float RMS_EPS = 1e-6f;
constexpr float LOG2E = 1.4426950408889634f;
constexpr float QS64 = 0.125f * LOG2E;
constexpr float QS256 = 0.0625f * LOG2E;

__device__ __forceinline__ int fresh_tid() { int t = threadIdx.x; asm volatile("" : "+v"(t)); return t; }
__device__ __forceinline__ unsigned cvtpk(float lo, float hi) { f32x2 v = {lo, hi}; bf16x2_t b = __builtin_convertvector(v, bf16x2_t); return __builtin_bit_cast(unsigned, b); }
__device__ __forceinline__ float bflo(unsigned w) { return __uint_as_float(w << 16); }
__device__ __forceinline__ float bfhi(unsigned w) { return __uint_as_float(w & 0xffff0000u); }
__device__ __forceinline__ u32x4 pack8(f32x4 a, f32x4 b) { u32x4 w; w.x = cvtpk(a[0], a[1]); w.y = cvtpk(a[2], a[3]); w.z = cvtpk(b[0], b[1]); w.w = cvtpk(b[2], b[3]); return w; }
__device__ __forceinline__ float fexp2(float x) { return __builtin_amdgcn_exp2f(x); }
__device__ __forceinline__ float frcp(float x) { return __builtin_amdgcn_rcpf(x); }
__device__ __forceinline__ float sigmoidf_(float x) { return frcp(1.0f + fexp2(-x * LOG2E)); }
#ifndef GATE_SIG
#define GATE_SIG 0
#endif
#if GATE_SIG
__device__ __forceinline__ float sgm2_(float y) { return y; }
#else
__device__ __forceinline__ float sgm2_(float y) { return frcp(1.0f + fexp2(y)); }
#endif
__device__ __forceinline__ float rstd_of(float ss) { return __builtin_amdgcn_rsqf(ss * (1.0f / DM) + RMS_EPS); }
constexpr float SSQ_SCALE = 1048576.0f;
__device__ __forceinline__ float ssq_f(unsigned long long q) { return (float)q * (1.0f / SSQ_SCALE); }

#ifndef WGM_SET
#define WGM_SET 8
#endif
namespace pg8 {
constexpr int BM = 256, BK = 64, HALF = 128, HTB = HALF * BK * 2, STAGE_BYTES = 8 * HTB, NXCD = 8, WGM = WGM_SET;
__host__ __device__ __forceinline__ int lds_byte(int r, int c) { const int st = (r >> 4) * 2 + (c >> 5), rr = r & 15, cc = c & 31, ob = rr * 64 + cc * 2; return st * 1024 + (ob ^ (((ob >> 9) & 1) << 5)); }
__host__ __device__ __forceinline__ void stage_rc(int b, int& R, int& C) { const int st = b / 1024, sb = b % 1024, swz = sb ^ (((sb >> 9) & 1) << 5); R = (st >> 1) * 16 + swz / 64; C = (st & 1) * 32 + (swz % 64) / 2; }
__host__ __device__ __forceinline__ int perm32(int rho) { const int n = rho >> 4, i = rho & 15; return 8 * (i >> 2) + 4 * n + (i & 3); }

struct Unit { int pm, pn, pb, ui, last; };
struct Gemm { const bf16_t* A; const bf16_t* Bt; int lda, ldb, K; long sAb, sAh, sBb, sBh; };

struct Order {
    int nM, nN, nwg, G, c, pbs;
    __device__ __forceinline__ void init(int nM_, int nN_, int nB_, int G_, int c_, int pbs_ = -1) { nM = nM_; nN = nN_; nwg = nM_ * nN_ * nB_; G = G_; c = c_; pbs = pbs_; }
    __device__ __forceinline__ bool next(int i, Unit& u) const {
        if (c < 0) return false;
        const long L = (long)i * G + c; if (L >= nwg) return false;
        int wgid = (int)L; { const int q = nwg / NXCD, r = nwg % NXCD, xcd = wgid % NXCD, off = wgid / NXCD; wgid = (xcd < r ? xcd * (q + 1) : r * (q + 1) + (xcd - r) * q) + off; }
        const int per = nM * nN; u.pb = wgid / per; const int w = wgid % per;
        const int nig = WGM * nN, gid = w / nig, fm = gid * WGM, gsz = (nM - fm) < WGM ? (nM - fm) : WGM;
        u.pm = fm + ((w % nig) % gsz); u.pn = (w % nig) / gsz; if (pbs >= 0) u.pb = u.pm >> pbs; return true;
    }
};

struct PairOrder { Order base; __device__ __forceinline__ bool next(int i, Unit& o) const { if (i >= 2) return false; base.next(0, o); o.pb = i; return true; } };
struct OneUnit { Unit u; __device__ __forceinline__ bool next(int i, Unit& o) const { if (i != 0) return false; o = u; o.ui = 0; return true; } };

typedef f32x4 Acc[2][2][4][2];
template <class T, class = void> struct preload_of { static constexpr bool v = false; };
template <class T> struct preload_of<T, decltype((void)T::PRELOAD)> { static constexpr bool v = T::PRELOAD; };
template <class T, class = void> struct chain_of { static constexpr bool v = false; };
template <class T> struct chain_of<T, decltype((void)T::CHAIN)> { static constexpr bool v = T::CHAIN; };

#ifndef PG8_PEEL
#define PG8_PEEL 0
#endif
struct NoPre { template <class S_> __device__ __forceinline__ void issue(unsigned long long (&)[6], const S_&) const {} template <class S_> __device__ __forceinline__ void apply(const unsigned long long (&)[6], const S_&, LAS unsigned char*) const {} };
struct PreSS { const float* p; int aux_off;
    template <class S_> __device__ __forceinline__ void issue(unsigned long long (&r)[6], const S_& S) const { const int t = fresh_tid(); Unit u;
        _Pragma("unroll") for (int i = 0; i < 6; ++i) { r[i] = 0ull; if (S.next(i, u) && t < 256) r[i] = (unsigned long long)__float_as_uint(p[u.pm * 256 + t]); } }
    template <class S_> __device__ __forceinline__ void apply(const unsigned long long (&r)[6], const S_& S, LAS unsigned char* lds) const { const int t = fresh_tid(); Unit u; LAS float* aux = (LAS float*)(lds + aux_off);
        _Pragma("unroll") for (int i = 0; i < 6; ++i) if (S.next(i, u) && t < 256) aux[i * 256 + t] = __uint_as_float((unsigned)r[i]); } };
struct PreSSQ { const unsigned long long* p; int aux_off;
    template <class S_> __device__ __forceinline__ void issue(unsigned long long (&r)[6], const S_& S) const { const int t = fresh_tid(); Unit u;
        _Pragma("unroll") for (int i = 0; i < 6; ++i) { r[i] = 0ull; if (S.next(i, u) && t < 256) r[i] = p[u.pm * 256 + t]; } }
    template <class S_> __device__ __forceinline__ void apply(const unsigned long long (&r)[6], const S_& S, LAS unsigned char* lds) const { const int t = fresh_tid(); Unit u; LAS float* aux = (LAS float*)(lds + aux_off);
        _Pragma("unroll") for (int i = 0; i < 6; ++i) if (S.next(i, u) && t < 256) aux[i * 256 + t] = ssq_f(r[i]); } };
template <class Epi, bool ALIGN_EPI, class Sched, class Pre = NoPre>
__device__ __forceinline__ void gemm_phase(LAS unsigned char* lds, const Gemm g, const Sched& S, const Epi& E, const Pre pst = Pre{}) {
    const int tid = fresh_tid(), wid = __builtin_amdgcn_readfirstlane(tid >> 6), lane = tid & 63, wr = wid >> 2, wc = wid & 3, fr = lane & 15, fq = lane >> 4;
    const int K = g.K, nt = K / BK;
    unsigned voffA[2], voffB[2];
#pragma unroll
    for (int i = 0; i < 2; ++i) { int R, C; stage_rc(tid * 16 + i * 8192, R, C); const int Rb = (R & ~31) + perm32(R & 31);
        voffA[i] = (unsigned)(R * g.lda + C) * 2u; voffB[i] = (unsigned)(Rb * g.ldb + C) * 2u; }
    const size_t kstep = (size_t)(BK * 2);
    const size_t hstepA = (size_t)HALF * g.lda * 2, hstepB = (size_t)HALF * g.ldb * 2;
    const size_t tstepA = 2 * hstepA, tstepB = 2 * hstepB;
    const unsigned ldsw = (unsigned)wid * 1024u;
    const int aoff = lds_byte(wr * 64 + fr, fq * 8), boff = lds_byte(wc * 32 + fr, fq * 8);
#define PG8_SA(b, h) (((b) * 2 + (h)) * HTB)
#define PG8_SB(b, h) ((4 + (b) * 2 + (h)) * HTB)
#define PG8_STAGE(bufoff, gbase, voff) do { _Pragma("unroll") for (int _i = 0; _i < 2; ++_i) \
        __builtin_amdgcn_global_load_lds((const unsigned*)((const char*)(gbase) + (voff)[_i]), (LAS unsigned*)(lds + (bufoff) + ldsw + _i * 8192), 16, 0, 0); } while (0)
#define PG8_LDA(dst, b, h) do { _Pragma("unroll") for (int m = 0; m < 4; ++m) _Pragma("unroll") for (int k = 0; k < 2; ++k) dst[m][k] = *(const LAS bf16x8*)(lds + PG8_SA(b, h) + aoff + m * 2048 + k * 1024); } while (0)
#define PG8_LDB(dst, b, h) do { _Pragma("unroll") for (int n = 0; n < 2; ++n) _Pragma("unroll") for (int k = 0; k < 2; ++k) dst[n][k] = *(const LAS bf16x8*)(lds + PG8_SB(b, h) + boff + n * 2048 + k * 1024); } while (0)
#define PG8_MMA(ai, bj, At, Bt) do { __builtin_amdgcn_s_setprio(1); _Pragma("unroll") for (int m = 0; m < 4; ++m) _Pragma("unroll") for (int n = 0; n < 2; ++n) _Pragma("unroll") for (int k = 0; k < 2; ++k) \
        acc[ai][bj][m][n] = __builtin_amdgcn_mfma_f32_16x16x32_bf16(Bt[n][k], At[m][k], acc[ai][bj][m][n], 0, 0, 0); __builtin_amdgcn_s_setprio(0); } while (0)
#define PG8_WAIT_V(n) asm volatile("s_waitcnt vmcnt(" #n ")" ::: "memory")
#define PG8_WAIT_L(n) asm volatile("s_waitcnt lgkmcnt(" #n ")" ::: "memory")
#define PG8_BAR __builtin_amdgcn_s_barrier()
#define PG8_SCHED __builtin_amdgcn_sched_barrier(0)
#define PG8_OFFA(u) ((size_t)(((u).pb >> 2) * g.sAb + ((u).pb & 3) * g.sAh) * 2 + (size_t)(u).pm * tstepA)
#define PG8_OFFB(u) ((size_t)(((u).pb >> 2) * g.sBb + ((u).pb & 3) * g.sBh) * 2 + (size_t)(u).pn * tstepB)
    Unit cur, nxt; int ui = 0;
    if (!S.next(0, cur)) return;
    cur.ui = 0;
    Acc acc;
#pragma unroll
    for (int a = 0; a < 2; ++a)
#pragma unroll
        for (int b = 0; b < 2; ++b)
#pragma unroll
            for (int m = 0; m < 4; ++m)
#pragma unroll
                for (int n = 0; n < 2; ++n) acc[a][b][m][n] = (f32x4){0.f, 0.f, 0.f, 0.f};
    unsigned long long pst_[6]; pst.issue(pst_, S);
    u32x4 pre_[2][4][2];
    if constexpr (preload_of<Epi>::v) E.pre_issue(pre_, cur, wr, wc, fr, fq);
    bf16x8 At[4][2], B0[2][2], B1[2][2];
    const char* cA = (const char*)g.A + PG8_OFFA(cur); const char* cB = (const char*)g.Bt + PG8_OFFB(cur);
    {
        PG8_STAGE(PG8_SB(0, 0), cB, voffB); PG8_STAGE(PG8_SB(0, 1), cB + hstepB, voffB); PG8_STAGE(PG8_SA(0, 0), cA, voffA); PG8_STAGE(PG8_SA(0, 1), cA + hstepA, voffA);
        if (wr == 1) PG8_BAR;
        PG8_WAIT_V(2); PG8_BAR;
        PG8_STAGE(PG8_SB(1, 0), cB + kstep, voffB); PG8_STAGE(PG8_SA(1, 0), cA + kstep, voffA); PG8_STAGE(PG8_SB(1, 1), cB + hstepB + kstep, voffB);
        PG8_WAIT_V(6); PG8_BAR;
    }
    pst.apply(pst_, S, lds);
    if constexpr (preload_of<Epi>::v) E.pre_apply(acc, pre_);
    for (;;) {
        const bool has_next = S.next(ui + 1, nxt); nxt.ui = ui + 1;
        const char* nA = has_next ? (const char*)g.A + PG8_OFFA(nxt) : cA; const char* nB = has_next ? (const char*)g.Bt + PG8_OFFB(nxt) : cB;
#if PG8_PEEL
        for (int t = 0; t < nt; t += 2) {
            const bool last = (t == nt - 2); const bool stg = !last || has_next;
            const char* a1 = cA + (size_t)(t + 1) * kstep;
            const char* a2 = last ? nA : cA + (size_t)(t + 2) * kstep; const char* b2 = last ? nB : cB + (size_t)(t + 2) * kstep;
            const char* a3 = a2 + kstep; const char* b3 = b2 + kstep;
            PG8_LDB(B0, 0, 0); PG8_LDB(B1, 0, 1); PG8_SCHED; PG8_LDA(At, 0, 0); PG8_STAGE(PG8_SA(1, 1), a1 + hstepA, voffA);
            PG8_WAIT_V(8); PG8_WAIT_L(0); PG8_BAR; PG8_MMA(0, 0, At, B0); PG8_MMA(0, 1, At, B1); PG8_BAR; PG8_SCHED;
            PG8_LDA(At, 0, 1); if (stg) { PG8_STAGE(PG8_SB(0, 0), b2, voffB); PG8_STAGE(PG8_SB(0, 1), b2 + hstepB, voffB); PG8_STAGE(PG8_SA(0, 0), a2, voffA); }
            if (stg) PG8_WAIT_V(8); else PG8_WAIT_V(2); PG8_WAIT_L(0); PG8_BAR; PG8_MMA(1, 0, At, B0); PG8_MMA(1, 1, At, B1); PG8_BAR; PG8_SCHED;
            PG8_LDB(B0, 1, 0); PG8_LDB(B1, 1, 1); PG8_SCHED; PG8_LDA(At, 1, 0); if (stg) PG8_STAGE(PG8_SA(0, 1), a2 + hstepA, voffA);
            if (stg) PG8_WAIT_V(8); else PG8_WAIT_V(0); PG8_WAIT_L(0); PG8_BAR; PG8_MMA(0, 0, At, B0); PG8_MMA(0, 1, At, B1); PG8_BAR; PG8_SCHED;
            PG8_LDA(At, 1, 1); if (stg) { PG8_STAGE(PG8_SB(1, 0), b3, voffB); PG8_STAGE(PG8_SB(1, 1), b3 + hstepB, voffB); PG8_STAGE(PG8_SA(1, 0), a3, voffA); }
            if (stg) PG8_WAIT_V(8); else PG8_WAIT_V(0); PG8_WAIT_L(0); PG8_BAR; PG8_MMA(1, 0, At, B0); PG8_MMA(1, 1, At, B1); PG8_BAR; PG8_SCHED;
        }
#else
        for (int t = 0; t < nt; t += 2) {
            const bool last = (t == nt - 2);
            const char* a1 = cA + (size_t)(t + 1) * kstep;
            const char* a2 = last ? nA : cA + (size_t)(t + 2) * kstep; const char* b2 = last ? nB : cB + (size_t)(t + 2) * kstep;
            const char* a3 = a2 + kstep; const char* b3 = b2 + kstep;
            PG8_LDB(B0, 0, 0); PG8_LDB(B1, 0, 1); PG8_SCHED; PG8_LDA(At, 0, 0); PG8_STAGE(PG8_SA(1, 1), a1 + hstepA, voffA);
            PG8_WAIT_V(8); PG8_WAIT_L(0); PG8_BAR; PG8_MMA(0, 0, At, B0); PG8_MMA(0, 1, At, B1); PG8_BAR; PG8_SCHED;
            PG8_LDA(At, 0, 1); PG8_STAGE(PG8_SB(0, 0), b2, voffB); PG8_STAGE(PG8_SB(0, 1), b2 + hstepB, voffB); PG8_STAGE(PG8_SA(0, 0), a2, voffA);
            PG8_WAIT_V(8); PG8_WAIT_L(0); PG8_BAR; PG8_MMA(1, 0, At, B0); PG8_MMA(1, 1, At, B1); PG8_BAR; PG8_SCHED;
            PG8_LDB(B0, 1, 0); PG8_LDB(B1, 1, 1); PG8_SCHED; PG8_LDA(At, 1, 0); PG8_STAGE(PG8_SA(0, 1), a2 + hstepA, voffA);
            PG8_WAIT_V(8); PG8_WAIT_L(0); PG8_BAR; PG8_MMA(0, 0, At, B0); PG8_MMA(0, 1, At, B1); PG8_BAR; PG8_SCHED;
            PG8_LDA(At, 1, 1); PG8_STAGE(PG8_SB(1, 0), b3, voffB); PG8_STAGE(PG8_SB(1, 1), b3 + hstepB, voffB); PG8_STAGE(PG8_SA(1, 0), a3, voffA);
            PG8_WAIT_V(8); PG8_WAIT_L(0); PG8_BAR; PG8_MMA(1, 0, At, B0); PG8_MMA(1, 1, At, B1); PG8_BAR; PG8_SCHED;
        }
#endif
        if constexpr (ALIGN_EPI) { if (wr == 0) PG8_BAR; }
        cur.last = has_next ? 0 : 1;
        if constexpr (!Epi::AFTER_DRAIN) { const int l2_ = fresh_tid() & 63; E(acc, cur, wr, wc, l2_ & 15, l2_ >> 4); }
        if (!has_next) break;
        if constexpr (!chain_of<Epi>::v) {
#pragma unroll
        for (int a = 0; a < 2; ++a)
#pragma unroll
            for (int b = 0; b < 2; ++b)
#pragma unroll
                for (int m = 0; m < 4; ++m)
#pragma unroll
                    for (int n = 0; n < 2; ++n) acc[a][b][m][n] = (f32x4){0.f, 0.f, 0.f, 0.f};
        }
        cur = nxt; cA = nA; cB = nB; ++ui;
        if constexpr (ALIGN_EPI) { if (wr == 1) PG8_BAR; }
    }
    PG8_WAIT_V(0);
    if constexpr (!ALIGN_EPI) { if (wr == 0) PG8_BAR; }
    PG8_BAR;
    if constexpr (Epi::AFTER_DRAIN) { const int l2_ = fresh_tid() & 63; E.fused(acc, cur, wr, wc, l2_ & 15, l2_ >> 4, lds, wid, l2_); }
#undef PG8_SA
#undef PG8_SB
#undef PG8_STAGE
#undef PG8_LDA
#undef PG8_LDB
#undef PG8_MMA
#undef PG8_WAIT_V
#undef PG8_WAIT_L
#undef PG8_BAR
#undef PG8_SCHED
#undef PG8_OFFA
#undef PG8_OFFB
}

struct EpiNull { static constexpr bool AFTER_DRAIN = false; float* sink; __device__ __forceinline__ void operator()(const Acc& acc, const Unit& u, int wr, int wc, int fr, int fq) const { f32x4 s = {0.f, 0.f, 0.f, 0.f};
_Pragma("unroll") for (int a = 0; a < 2; ++a) _Pragma("unroll") for (int b = 0; b < 2; ++b) _Pragma("unroll") for (int m = 0; m < 4; ++m) _Pragma("unroll") for (int n = 0; n < 2; ++n) s += acc[a][b][m][n];
 if (s[0] + s[1] + s[2] + s[3] == 1234567.25f) sink[0] = 1.f; } };
#ifndef GU_ALG
#define GU_ALG 1
#endif
struct EpiGU {
    static constexpr bool AFTER_DRAIN = false;
    bf16_t* H; const LAS float* aux;
    __device__ __forceinline__ void operator()(const Acc& acc, const Unit& u, int wr, int wc, int fr, int fq) const {
        const int row0 = u.pm * BM + wr * 64 + fr, col0 = u.pn * 128 + wc * 32 + fq * 8;
        float rsv[2][4];
#pragma unroll
        for (int ai = 0; ai < 2; ++ai)
#pragma unroll
            for (int m = 0; m < 4; ++m) rsv[ai][m] = aux[u.ui * 256 + wr * 64 + fr + ai * HALF + m * 16];
#pragma unroll
        for (int ai = 0; ai < 2; ++ai)
#pragma unroll
            for (int m = 0; m < 4; ++m) {
                const int row = row0 + ai * HALF + m * 16; const float rs = rstd_of(rsv[ai][m]);
                f32x4 h[2];
#if GU_ALG
                const float c1 = -rs * LOG2E, iv = rsv[ai][m] * (1.0f / DM) + RMS_EPS;
#pragma unroll
                for (int n = 0; n < 2; ++n) { const f32x4 ga = acc[ai][0][m][n], ua = acc[ai][1][m][n];
#pragma unroll
                    for (int j = 0; j < 4; ++j) h[n][j] = (ga[j] * ua[j]) * frcp(__builtin_fmaf(fexp2(ga[j] * c1), iv, iv)); }
#else
#pragma unroll
                for (int n = 0; n < 2; ++n) { const f32x4 gg = acc[ai][0][m][n] * rs, uu = acc[ai][1][m][n] * rs;
#pragma unroll
                    for (int j = 0; j < 4; ++j) h[n][j] = gg[j] * sigmoidf_(gg[j]) * uu[j]; }
#endif
                ST16M(H, (size_t)row * FF + col0, pack8(h[0], h[1]));
            }
    }
};
template <bool WRITE_XB, bool WRITE_SS> struct EpiRes {
    static constexpr bool AFTER_DRAIN = false;
    const float* base; float* out; bf16_t* xb; float* ss; float scale;
    __device__ __forceinline__ void operator()(const Acc& acc, const Unit& u, int wr, int wc, int fr, int fq) const {
        const int row0 = u.pm * BM + wr * 64 + fr, col0 = u.pn * BM + wc * 32 + fq * 8;
#pragma unroll
        for (int ai = 0; ai < 2; ++ai)
#pragma unroll
            for (int m2 = 0; m2 < 4; m2 += 2) {
                f32x4 o[2][2][2];
#pragma unroll
                for (int mm = 0; mm < 2; ++mm)
#pragma unroll
                    for (int bj = 0; bj < 2; ++bj) { const size_t p = (size_t)(row0 + ai * HALF + (m2 + mm) * 16) * DM + col0 + bj * HALF; o[mm][bj][0] = *(const f32x4*)(base + p); o[mm][bj][1] = *(const f32x4*)(base + p + 4); }
#pragma unroll
                for (int mm = 0; mm < 2; ++mm) { const int m = m2 + mm, row = row0 + ai * HALF + m * 16; float sq = 0.f;
#pragma unroll
                    for (int bj = 0; bj < 2; ++bj) { const size_t p = (size_t)row * DM + col0 + bj * HALF;
                        const f32x4 n0 = o[mm][bj][0] + acc[ai][bj][m][0] * scale, n1 = o[mm][bj][1] + acc[ai][bj][m][1] * scale;
                        *(f32x4*)(out + p) = n0; *(f32x4*)(out + p + 4) = n1;
                        if (WRITE_XB) ST16(xb, p, pack8(n0, n1));
                        if (WRITE_SS) sq += (n0[0] * n0[0] + n0[1] * n0[1]) + (n0[2] * n0[2] + n0[3] * n0[3]) + (n1[0] * n1[0] + n1[1] * n1[1]) + (n1[2] * n1[2] + n1[3] * n1[3]); }
                    if (WRITE_SS) { sq += __shfl_xor(sq, 16); sq += __shfl_xor(sq, 32); if (fq == 0) unsafeAtomicAdd(ss + row, sq); } }
                asm volatile("" ::: "memory");
            }
    }
};
#ifndef EPIRES_ONEBATCH
#define EPIRES_ONEBATCH 0
#endif
#ifndef RESB_PAIR
#define RESB_PAIR 0
#endif
template <bool BASE_F32, bool WTS = true, bool PRE = false, bool UNIT = false> struct EpiResB {
    static constexpr bool AFTER_DRAIN = false;
    const float* basef; bf16_t* xb; unsigned long long* ss; float scale;
    static constexpr bool PRELOAD = PRE;
    __device__ __forceinline__ void pre_issue(u32x4 (&pre)[2][4][2], const Unit& u, int wr, int wc, int fr, int fq) const {
        const int row0 = u.pm * BM + wr * 64 + fr, col0 = u.pn * BM + wc * 32 + fq * 8;
#pragma unroll
        for (int ai = 0; ai < 2; ++ai)
#pragma unroll
            for (int m = 0; m < 4; ++m)
#pragma unroll
                for (int bj = 0; bj < 2; ++bj) pre[ai][m][bj] = *(const u32x4*)(xb + (size_t)(row0 + ai * HALF + m * 16) * DM + col0 + bj * HALF); }
    __device__ __forceinline__ void pre_apply(Acc& acc, const u32x4 (&pre)[2][4][2]) const {
        const float is = 1.0f / scale;
#pragma unroll
        for (int ai = 0; ai < 2; ++ai)
#pragma unroll
            for (int m = 0; m < 4; ++m)
#pragma unroll
                for (int bj = 0; bj < 2; ++bj) { const u32x4 w = pre[ai][m][bj];
                    const f32x4 r0 = {bflo(w.x), bfhi(w.x), bflo(w.y), bfhi(w.y)}, r1 = {bflo(w.z), bfhi(w.z), bflo(w.w), bfhi(w.w)};
                    acc[ai][bj][m][0] = UNIT ? r0 : r0 * is; acc[ai][bj][m][1] = UNIT ? r1 : r1 * is; } }
    __device__ __forceinline__ void operator()(const Acc& acc, const Unit& u, int wr, int wc, int fr, int fq) const {
        const int row0 = u.pm * BM + wr * 64 + fr, col0 = u.pn * BM + wc * 32 + fq * 8;
        if (PRE) {
#pragma unroll
            for (int ai = 0; ai < 2; ++ai)
#pragma unroll
                for (int m = 0; m < 4; ++m) { const int row = row0 + ai * HALF + m * 16; float sq = 0.f;
#pragma unroll
                    for (int bj = 0; bj < 2; ++bj) { const size_t p = (size_t)row * DM + col0 + bj * HALF;
                        const f32x4 n0 = UNIT ? acc[ai][bj][m][0] : acc[ai][bj][m][0] * scale, n1 = UNIT ? acc[ai][bj][m][1] : acc[ai][bj][m][1] * scale;
                        do { if (WTS) ST16(xb, p, pack8(n0, n1)); else ST16M(xb, p, pack8(n0, n1)); } while (0);
                        sq += (n0[0] * n0[0] + n0[1] * n0[1]) + (n0[2] * n0[2] + n0[3] * n0[3]) + (n1[0] * n1[0] + n1[1] * n1[1]) + (n1[2] * n1[2] + n1[3] * n1[3]); }
                    sq += __shfl_xor(sq, 16); sq += __shfl_xor(sq, 32); if (fq == 0) __hip_atomic_fetch_add(ss + row, (unsigned long long)(sq * SSQ_SCALE + 0.5f), __ATOMIC_RELAXED, __HIP_MEMORY_SCOPE_AGENT); }
            return; }
#if EPIRES_ONEBATCH
        if (!BASE_F32) {
            u32x4 ob[2][4][2];
#pragma unroll
            for (int ai = 0; ai < 2; ++ai)
#pragma unroll
                for (int m = 0; m < 4; ++m)
#pragma unroll
                    for (int bj = 0; bj < 2; ++bj) ob[ai][m][bj] = *(const u32x4*)(xb + (size_t)(row0 + ai * HALF + m * 16) * DM + col0 + bj * HALF);
#pragma unroll
            for (int ai = 0; ai < 2; ++ai)
#pragma unroll
                for (int m = 0; m < 4; ++m) { const int row = row0 + ai * HALF + m * 16; float sq = 0.f;
#pragma unroll
                    for (int bj = 0; bj < 2; ++bj) { const size_t p = (size_t)row * DM + col0 + bj * HALF; const u32x4 w = ob[ai][m][bj];
                        const f32x4 o0 = (f32x4){bflo(w.x), bfhi(w.x), bflo(w.y), bfhi(w.y)}, o1 = (f32x4){bflo(w.z), bfhi(w.z), bflo(w.w), bfhi(w.w)};
                        const f32x4 n0 = o0 + acc[ai][bj][m][0] * scale, n1 = o1 + acc[ai][bj][m][1] * scale;
                        do { if (WTS) ST16(xb, p, pack8(n0, n1)); else ST16M(xb, p, pack8(n0, n1)); } while (0);
                        sq += (n0[0] * n0[0] + n0[1] * n0[1]) + (n0[2] * n0[2] + n0[3] * n0[3]) + (n1[0] * n1[0] + n1[1] * n1[1]) + (n1[2] * n1[2] + n1[3] * n1[3]); }
                    sq += __shfl_xor(sq, 16); sq += __shfl_xor(sq, 32); if (fq == 0) __hip_atomic_fetch_add(ss + row, (unsigned long long)(sq * SSQ_SCALE + 0.5f), __ATOMIC_RELAXED, __HIP_MEMORY_SCOPE_AGENT); }
            return;
        }
#endif
#if RESB_PAIR
#pragma unroll
        for (int am = 0; am < 4; ++am) { const int ai = am >> 1, mb = (am & 1) * 2;
            u32x4 ob[4][2];
#pragma unroll
            for (int m = mb; m < mb + 2; ++m)
#pragma unroll
                for (int bj = 0; bj < 2; ++bj) ob[m][bj] = *(const u32x4*)(xb + (size_t)(row0 + ai * HALF + m * 16) * DM + col0 + bj * HALF);
            f32x4 of[4][2][2];
#pragma unroll
            for (int m = mb; m < mb + 2; ++m) { const int row = row0 + ai * HALF + m * 16; float sq = 0.f;
#else
#pragma unroll
        for (int ai = 0; ai < 2; ++ai) {
            f32x4 of[4][2][2]; u32x4 ob[4][2];
#pragma unroll
            for (int m = 0; m < 4; ++m)
#pragma unroll
                for (int bj = 0; bj < 2; ++bj) { const size_t p = (size_t)(row0 + ai * HALF + m * 16) * DM + col0 + bj * HALF;
                    if (BASE_F32) { of[m][bj][0] = *(const f32x4*)(basef + p); of[m][bj][1] = *(const f32x4*)(basef + p + 4); } else ob[m][bj] = *(const u32x4*)(xb + p); }
#pragma unroll
            for (int m = 0; m < 4; ++m) { const int row = row0 + ai * HALF + m * 16; float sq = 0.f;
#endif
#pragma unroll
                for (int bj = 0; bj < 2; ++bj) { const size_t p = (size_t)row * DM + col0 + bj * HALF; f32x4 o0, o1;
                    if (BASE_F32) { o0 = of[m][bj][0]; o1 = of[m][bj][1]; }
                    else { const u32x4 w = ob[m][bj]; o0 = (f32x4){bflo(w.x), bfhi(w.x), bflo(w.y), bfhi(w.y)}; o1 = (f32x4){bflo(w.z), bfhi(w.z), bflo(w.w), bfhi(w.w)}; }
                    const f32x4 n0 = o0 + acc[ai][bj][m][0] * scale, n1 = o1 + acc[ai][bj][m][1] * scale;
                    do { if (WTS) ST16(xb, p, pack8(n0, n1)); else ST16M(xb, p, pack8(n0, n1)); } while (0);
                    sq += (n0[0] * n0[0] + n0[1] * n0[1]) + (n0[2] * n0[2] + n0[3] * n0[3]) + (n1[0] * n1[0] + n1[1] * n1[1]) + (n1[2] * n1[2] + n1[3] * n1[3]); }
                sq += __shfl_xor(sq, 16); sq += __shfl_xor(sq, 32); if (fq == 0) __hip_atomic_fetch_add(ss + row, (unsigned long long)(sq * SSQ_SCALE + 0.5f), __ATOMIC_RELAXED, __HIP_MEMORY_SCOPE_AGENT); }
            asm volatile("" ::: "memory"); }
    }
};
#ifndef GATE_SIG
#define GATE_SIG 0
#endif
#ifndef GATE_CLAMP
#define GATE_CLAMP 1
#endif
struct EpiQKV {
    static constexpr bool AFTER_DRAIN = false;
    bf16_t *QN, *KVN, *QF, *KVF, *GAB; float* F32S; const LAS float* aux;
    __device__ __forceinline__ void operator()(const Acc& acc, const Unit& u, int wr, int wc, int fr, int fq) const {
        const int row0 = u.pm * BM + wr * 64 + fr, pn = u.pn;
        if (pn == 19) {
            if (wc == 0) {
#pragma unroll
                for (int ai = 0; ai < 2; ++ai)
#pragma unroll
                    for (int m = 0; m < 4; ++m) { const int row = row0 + ai * HALF + m * 16; const float rs = rstd_of(aux[u.ui * 256 + wr * 64 + fr + ai * HALF + m * 16]);
                        *(f32x4*)(F32S + (size_t)row * 32 + fq * 8) = acc[ai][0][m][0] * rs; *(f32x4*)(F32S + (size_t)row * 32 + fq * 8 + 4) = acc[ai][0][m][1] * rs; }
            }
            return;
        }
        bf16_t* dst; int pitch, coff;
        if (pn < 2) { dst = QN; pitch = 512; coff = pn * 256; }
        else if (pn < 5) { dst = KVN; pitch = 768; coff = (pn - 2) * 256; }
        else if (pn < 7) { dst = QF; pitch = 512; coff = (pn - 5) * 256; }
        else if (pn < 11) { dst = KVF; pitch = 1024; coff = (pn - 7) * 256; }
        else { dst = GAB; pitch = 2048; coff = (pn - 11) * 256; }
        coff += wc * 32 + fq * 8;
        const float gsc = pn >= 11 ? -LOG2E : 1.0f;
        float rsv[2][4];
#pragma unroll
        for (int ai = 0; ai < 2; ++ai)
#pragma unroll
            for (int m = 0; m < 4; ++m) rsv[ai][m] = aux[u.ui * 256 + wr * 64 + fr + ai * HALF + m * 16];
#pragma unroll
        for (int ai = 0; ai < 2; ++ai)
#pragma unroll
            for (int m = 0; m < 4; ++m) { const int row = row0 + ai * HALF + m * 16; const float rs = rstd_of(rsv[ai][m]) * gsc;
#pragma unroll
                for (int bj = 0; bj < 2; ++bj) { f32x4 x0 = acc[ai][bj][m][0] * rs, x1 = acc[ai][bj][m][1] * rs;
#if GATE_CLAMP
                    if (pn >= 11) {
#pragma unroll
                        for (int j = 0; j < 4; ++j) { x0[j] = __builtin_amdgcn_fmed3f(x0[j], -64.0f, 64.0f); x1[j] = __builtin_amdgcn_fmed3f(x1[j], -64.0f, 64.0f); } }
#endif
#if GATE_SIG
                    if (pn >= 11) {
#pragma unroll
                        for (int j = 0; j < 4; ++j) { x0[j] = frcp(1.0f + fexp2(x0[j])); x1[j] = frcp(1.0f + fexp2(x1[j])); } }
#endif
                    ST16M(dst, (size_t)row * pitch + coff + bj * HALF, pack8(x0, x1)); } }
    }
};
template <int STEP_> struct EpiUp {
    static constexpr bool AFTER_DRAIN = false;
    const bf16_t* GAB; bf16_t* Y;
    __device__ __forceinline__ void operator()(const Acc& acc, const Unit& u, int wr, int wc, int fr, int fq) const {
        const int STEP = STEP_ == 2 ? u.pb : STEP_;
        const int row0 = u.pm * BM + wr * 64 + fr, col0 = u.pn * BM + wc * 32 + fq * 8;
#pragma unroll
        for (int ai = 0; ai < 2; ++ai) {
            u32x4 gw[4][2], yw[4][2];
#pragma unroll
            for (int m = 0; m < 4; ++m)
#pragma unroll
                for (int bj = 0; bj < 2; ++bj) { const int row = row0 + ai * HALF + m * 16, c = col0 + bj * HALF;
                    gw[m][bj] = *(const u32x4*)(GAB + (size_t)row * 2048 + STEP * 1024 + c); if (STEP == 1) yw[m][bj] = *(const u32x4*)(Y + (size_t)row * DM + c); }
#pragma unroll
            for (int m = 0; m < 4; ++m)
#pragma unroll
                for (int bj = 0; bj < 2; ++bj) { const int row = row0 + ai * HALF + m * 16, c = col0 + bj * HALF; const u32x4 g4 = gw[m][bj];
                    f32x4 v0, v1; const f32x4 a0 = acc[ai][bj][m][0], a1 = acc[ai][bj][m][1];
                    v0[0] = sgm2_(bflo(g4.x)) * a0[0]; v0[1] = sgm2_(bfhi(g4.x)) * a0[1]; v0[2] = sgm2_(bflo(g4.y)) * a0[2]; v0[3] = sgm2_(bfhi(g4.y)) * a0[3];
                    v1[0] = sgm2_(bflo(g4.z)) * a1[0]; v1[1] = sgm2_(bfhi(g4.z)) * a1[1]; v1[2] = sgm2_(bflo(g4.w)) * a1[2]; v1[3] = sgm2_(bfhi(g4.w)) * a1[3];
                    if (STEP == 1) { const u32x4 y = yw[m][bj];
                        v0[0] += bflo(y.x); v0[1] += bfhi(y.x); v0[2] += bflo(y.y); v0[3] += bfhi(y.y); v1[0] += bflo(y.z); v1[1] += bfhi(y.z); v1[2] += bflo(y.w); v1[3] += bfhi(y.w); }
                    ST16M(Y, (size_t)row * DM + c, pack8(v0, v1)); }
            asm volatile("" ::: "memory"); }
    }
};
#ifndef UPC_BIG
#define UPC_BIG 0
#endif
struct EpiUpC {
    static constexpr bool AFTER_DRAIN = false, CHAIN = true;
    const bf16_t* GAB; bf16_t* Y;
    __device__ __forceinline__ void operator()(Acc& acc, const Unit& u, int wr, int wc, int fr, int fq) const {
        const int row0 = u.pm * BM + wr * 64 + fr, col0 = u.pn * BM + wc * 32 + fq * 8;
        if (u.pb == 0) {
#pragma unroll
#if UPC_BIG
            for (int ai = 0; ai < 2; ++ai) { const int mb = 0;
                u32x4 ga[4][2], gb[4][2];
#pragma unroll
                for (int mm = 0; mm < 4; ++mm)
#pragma unroll
                    for (int bj = 0; bj < 2; ++bj) { const size_t p = (size_t)(row0 + ai * HALF + (mb + mm) * 16) * 2048 + col0 + bj * HALF; ga[mm][bj] = *(const u32x4*)(GAB + p); gb[mm][bj] = *(const u32x4*)(GAB + p + 1024); }
#pragma unroll
                for (int mm = 0; mm < 4; ++mm)
#else
            for (int am = 0; am < 4; ++am) { const int ai = am >> 1, mb = (am & 1) * 2;
                u32x4 ga[2][2], gb[2][2];
#pragma unroll
                for (int mm = 0; mm < 2; ++mm)
#pragma unroll
                    for (int bj = 0; bj < 2; ++bj) { const size_t p = (size_t)(row0 + ai * HALF + (mb + mm) * 16) * 2048 + col0 + bj * HALF; ga[mm][bj] = *(const u32x4*)(GAB + p); gb[mm][bj] = *(const u32x4*)(GAB + p + 1024); }
#pragma unroll
                for (int mm = 0; mm < 2; ++mm)
#endif
#pragma unroll
                    for (int bj = 0; bj < 2; ++bj) { const u32x4 a4 = ga[mm][bj], b4 = gb[mm][bj]; f32x4& x0 = acc[ai][bj][mb + mm][0]; f32x4& x1 = acc[ai][bj][mb + mm][1];
#define UPC_R(ya, yb) ((1.0f + fexp2(yb)) * frcp(1.0f + fexp2(ya)))
                        x0[0] *= UPC_R(bflo(a4.x), bflo(b4.x)); x0[1] *= UPC_R(bfhi(a4.x), bfhi(b4.x)); x0[2] *= UPC_R(bflo(a4.y), bflo(b4.y)); x0[3] *= UPC_R(bfhi(a4.y), bfhi(b4.y));
                        x1[0] *= UPC_R(bflo(a4.z), bflo(b4.z)); x1[1] *= UPC_R(bfhi(a4.z), bfhi(b4.z)); x1[2] *= UPC_R(bflo(a4.w), bflo(b4.w)); x1[3] *= UPC_R(bfhi(a4.w), bfhi(b4.w));
#undef UPC_R
                    }
                asm volatile("" ::: "memory"); }
        } else {
#pragma unroll
            for (int ai = 0; ai < 2; ++ai) {
                u32x4 gw[4][2];
#pragma unroll
                for (int m = 0; m < 4; ++m)
#pragma unroll
                    for (int bj = 0; bj < 2; ++bj) gw[m][bj] = *(const u32x4*)(GAB + (size_t)(row0 + ai * HALF + m * 16) * 2048 + 1024 + col0 + bj * HALF);
#pragma unroll
                for (int m = 0; m < 4; ++m)
#pragma unroll
                    for (int bj = 0; bj < 2; ++bj) { const int row = row0 + ai * HALF + m * 16, c = col0 + bj * HALF; const u32x4 g4 = gw[m][bj];
                        f32x4 v0, v1; const f32x4 a0 = acc[ai][bj][m][0], a1 = acc[ai][bj][m][1];
                        v0[0] = sgm2_(bflo(g4.x)) * a0[0]; v0[1] = sgm2_(bfhi(g4.x)) * a0[1]; v0[2] = sgm2_(bflo(g4.y)) * a0[2]; v0[3] = sgm2_(bfhi(g4.y)) * a0[3];
                        v1[0] = sgm2_(bflo(g4.z)) * a1[0]; v1[1] = sgm2_(bfhi(g4.z)) * a1[1]; v1[2] = sgm2_(bflo(g4.w)) * a1[2]; v1[3] = sgm2_(bfhi(g4.w)) * a1[3];
                        ST16(Y, (size_t)row * DM + c, pack8(v0, v1)); }
                asm volatile("" ::: "memory"); }
        }
    }
};
struct EpiRowScale {
    static constexpr bool AFTER_DRAIN = false;
    bf16_t* O; int ldo; const float* ss; const LAS float* aux;
    __device__ __forceinline__ void operator()(const Acc& acc, const Unit& u, int wr, int wc, int fr, int fq) const {
        const int row0 = u.pm * BM + wr * 64 + fr, col0 = u.pn * BM + wc * 32 + fq * 8;
        float rsv[2][4];
#pragma unroll
        for (int ai = 0; ai < 2; ++ai)
#pragma unroll
            for (int m = 0; m < 4; ++m) rsv[ai][m] = aux ? aux[u.ui * 256 + wr * 64 + fr + ai * HALF + m * 16] : ss[row0 + ai * HALF + m * 16];
#pragma unroll
        for (int ai = 0; ai < 2; ++ai)
#pragma unroll
            for (int m = 0; m < 4; ++m) { const int row = row0 + ai * HALF + m * 16; const float rs = rstd_of(rsv[ai][m]);
#pragma unroll
                for (int bj = 0; bj < 2; ++bj) ST16(O, (size_t)row * ldo + col0 + bj * HALF, pack8(acc[ai][bj][m][0] * rs, acc[ai][bj][m][1] * rs)); }
    }
};
struct EpiColScale {
    static constexpr bool AFTER_DRAIN = false;
    bf16_t* O; int ldo; const float* ss;
    __device__ __forceinline__ void operator()(const Acc& acc, const Unit& u, int wr, int wc, int fr, int fq) const {
        const int row0 = u.pm * BM + wr * 64 + fr, col0 = u.pn * BM + wc * 32 + fq * 8;
#pragma unroll
        for (int bj = 0; bj < 2; ++bj) { const int c = col0 + bj * HALF;
            f32x4 s0 = *(const f32x4*)(ss + c), s1 = *(const f32x4*)(ss + c + 4);
#pragma unroll
            for (int j = 0; j < 4; ++j) { s0[j] = rstd_of(s0[j]); s1[j] = rstd_of(s1[j]); }
#pragma unroll
            for (int ai = 0; ai < 2; ++ai)
#pragma unroll
                for (int m = 0; m < 4; ++m) { const int row = row0 + ai * HALF + m * 16;
                    ST16(O, (size_t)row * ldo + c, pack8(acc[ai][bj][m][0] * s0, acc[ai][bj][m][1] * s1)); } }
    }
};
struct EpiBatchBf16 {
    static constexpr bool AFTER_DRAIN = false;
    bf16_t* O; int ldo; long sOb, sOh;
    __device__ __forceinline__ void operator()(const Acc& acc, const Unit& u, int wr, int wc, int fr, int fq) const {
        const int row0 = u.pm * BM + wr * 64 + fr, col0 = u.pn * BM + wc * 32 + fq * 8;
        bf16_t* Ob = O + (size_t)((u.pb >> 2) * sOb + (u.pb & 3) * sOh);
#pragma unroll
        for (int ai = 0; ai < 2; ++ai)
#pragma unroll
            for (int m = 0; m < 4; ++m) { const int row = row0 + ai * HALF + m * 16;
#pragma unroll
                for (int bj = 0; bj < 2; ++bj) ST16(Ob, (size_t)row * ldo + col0 + bj * HALF, pack8(acc[ai][bj][m][0], acc[ai][bj][m][1])); }
    }
};
struct EpiSoftmax {
    static constexpr bool AFTER_DRAIN = true;
    bf16_t* P;
    __device__ __forceinline__ void fused(Acc& acc, const Unit& u, int wr, int wc, int fr, int fq, LAS unsigned char* lds, int wid, int lane) const {
        LAS float* Pm = (LAS float*)lds;
        LAS float* Ps = (LAS float*)(lds + 8192);
#pragma unroll
        for (int ai = 0; ai < 2; ++ai)
#pragma unroll
            for (int m = 0; m < 4; ++m) { float mx = -3.0e38f;
#pragma unroll
                for (int bj = 0; bj < 2; ++bj)
#pragma unroll
                    for (int n = 0; n < 2; ++n) { const f32x4 x = acc[ai][bj][m][n]; mx = fmaxf(mx, fmaxf(fmaxf(x[0], x[1]), fmaxf(x[2], x[3]))); }
                mx = fmaxf(mx, __shfl_xor(mx, 16)); mx = fmaxf(mx, __shfl_xor(mx, 32));
                if (fq == 0) Pm[(ai * HALF + wr * 64 + m * 16 + fr) * 4 + wc] = mx; }
        __syncthreads();
#pragma unroll
        for (int ai = 0; ai < 2; ++ai)
#pragma unroll
            for (int m = 0; m < 4; ++m) { const int r = ai * HALF + wr * 64 + m * 16 + fr; const f32x4 t = *(const LAS f32x4*)(Pm + r * 4);
                const float mx = fmaxf(fmaxf(t[0], t[1]), fmaxf(t[2], t[3])); float s = 0.f;
#pragma unroll
                for (int bj = 0; bj < 2; ++bj)
#pragma unroll
                    for (int n = 0; n < 2; ++n) { f32x4 x = acc[ai][bj][m][n];
#pragma unroll
                        for (int j = 0; j < 4; ++j) { x[j] = fexp2(x[j] - mx); s += x[j]; }
                        acc[ai][bj][m][n] = x; }
                s += __shfl_xor(s, 16); s += __shfl_xor(s, 32);
                if (fq == 0) Ps[r * 4 + wc] = s; }
        __syncthreads();
        bf16_t* Pb = P + (size_t)u.pb * SEQ * 256;
        const int col0 = wc * 32 + fq * 8;
#pragma unroll
        for (int ai = 0; ai < 2; ++ai)
#pragma unroll
            for (int m = 0; m < 4; ++m) { const int r = ai * HALF + wr * 64 + m * 16 + fr; const f32x4 t = *(const LAS f32x4*)(Ps + r * 4);
                const float inv = frcp((t[0] + t[1]) + (t[2] + t[3])); const int row = u.pm * BM + r;
#pragma unroll
                for (int bj = 0; bj < 2; ++bj) ST16(Pb, (size_t)row * 256 + col0 + bj * HALF, pack8(acc[ai][bj][m][0] * inv, acc[ai][bj][m][1] * inv)); }
        __syncthreads();
    }
};
struct EpiSoftmaxRS {
    static constexpr bool AFTER_DRAIN = true;
    bf16_t* P; int ldp; const unsigned long long* ss; const LAS float* aux;
    __device__ __forceinline__ void fused(Acc& acc, const Unit& u, int wr, int wc, int fr, int fq, LAS unsigned char* lds, int wid, int lane) const {
        LAS float* Pm = (LAS float*)lds; LAS float* Ps = (LAS float*)(lds + 8192);
#pragma unroll
        for (int ai = 0; ai < 2; ++ai)
#pragma unroll
            for (int m = 0; m < 4; ++m) { const float rs = rstd_of(aux ? aux[ai * HALF + wr * 64 + m * 16 + fr] : ssq_f(ss[u.pm * BM + ai * HALF + wr * 64 + m * 16 + fr])); float mx = -3.0e38f;
#pragma unroll
                for (int bj = 0; bj < 2; ++bj)
#pragma unroll
                    for (int n = 0; n < 2; ++n) { const f32x4 x = acc[ai][bj][m][n]; mx = fmaxf(mx, fmaxf(fmaxf(x[0], x[1]), fmaxf(x[2], x[3]))); }
                mx = fmaxf(mx, __shfl_xor(mx, 16)); mx = fmaxf(mx, __shfl_xor(mx, 32)); mx *= rs;
                if (fq == 0) Pm[(ai * HALF + wr * 64 + m * 16 + fr) * 4 + wc] = mx; }
        __syncthreads();
#pragma unroll
        for (int ai = 0; ai < 2; ++ai)
#pragma unroll
            for (int m = 0; m < 4; ++m) { const int r = ai * HALF + wr * 64 + m * 16 + fr; const f32x4 t = *(const LAS f32x4*)(Pm + r * 4);
                const float rs = rstd_of(aux ? aux[r] : ssq_f(ss[u.pm * BM + r]));
                const float mx = fmaxf(fmaxf(t[0], t[1]), fmaxf(t[2], t[3])); float s = 0.f;
#pragma unroll
                for (int bj = 0; bj < 2; ++bj)
#pragma unroll
                    for (int n = 0; n < 2; ++n) { f32x4 x = acc[ai][bj][m][n];
#pragma unroll
                        for (int j = 0; j < 4; ++j) { x[j] = fexp2(__builtin_fmaf(x[j], rs, -mx)); s += x[j]; }
                        acc[ai][bj][m][n] = x; }
                s += __shfl_xor(s, 16); s += __shfl_xor(s, 32);
                if (fq == 0) Ps[r * 4 + wc] = s; }
        __syncthreads();
        const int col0 = u.pn * BM + wc * 32 + fq * 8;
#pragma unroll
        for (int ai = 0; ai < 2; ++ai)
#pragma unroll
            for (int m = 0; m < 4; ++m) { const int r = ai * HALF + wr * 64 + m * 16 + fr; const f32x4 t = *(const LAS f32x4*)(Ps + r * 4);
                const float inv = frcp((t[0] + t[1]) + (t[2] + t[3])); const int row = u.pm * BM + r;
#pragma unroll
                for (int bj = 0; bj < 2; ++bj) ST16(P, (size_t)row * ldp + col0 + bj * HALF, pack8(acc[ai][bj][m][0] * inv, acc[ai][bj][m][1] * inv)); }
        __syncthreads();
    }
};
#ifndef NORM_PRE
#define NORM_PRE 0
#endif
struct EpiResNorm {
    static constexpr bool AFTER_DRAIN = true;
    const bf16_t* Xold; float* out; float scale; const float* gn; float* xbuf; unsigned* cnt;
    static constexpr bool PRELOAD = NORM_PRE != 0;
    __device__ __forceinline__ void pre_issue(u32x4 (&pre)[2][4][2], const Unit& u, int wr, int wc, int fr, int fq) const {
        const int row0 = u.pm * BM + wr * 64 + fr, col0 = u.pn * BM + wc * 32 + fq * 8;
#pragma unroll
        for (int ai = 0; ai < 2; ++ai)
#pragma unroll
            for (int m = 0; m < 4; ++m)
#pragma unroll
                for (int bj = 0; bj < 2; ++bj) pre[ai][m][bj] = *(const u32x4*)(Xold + (size_t)(row0 + ai * HALF + m * 16) * DM + col0 + bj * HALF); }
    __device__ __forceinline__ void pre_apply(Acc& acc, const u32x4 (&pre)[2][4][2]) const {
        const float is = 1.0f / scale;
#pragma unroll
        for (int ai = 0; ai < 2; ++ai)
#pragma unroll
            for (int m = 0; m < 4; ++m)
#pragma unroll
                for (int bj = 0; bj < 2; ++bj) { const u32x4 w = pre[ai][m][bj];
                    acc[ai][bj][m][0] = (f32x4){bflo(w.x), bfhi(w.x), bflo(w.y), bfhi(w.y)} * is; acc[ai][bj][m][1] = (f32x4){bflo(w.z), bfhi(w.z), bflo(w.w), bfhi(w.w)} * is; } }
    __device__ __forceinline__ void fused(Acc& acc, const Unit& u, int wr, int wc, int fr, int fq, LAS unsigned char* lds, int wid, int lane) const {
        LAS float* P = (LAS float*)lds;
        LAS float* S = (LAS float*)(lds + 4096);
        const int row0 = u.pm * BM + wr * 64 + fr, col0 = u.pn * BM + wc * 32 + fq * 8;
        f32x4 gg[2][2];
#pragma unroll
        for (int bj = 0; bj < 2; ++bj) { gg[bj][0] = *(const f32x4*)(gn + col0 + bj * HALF); gg[bj][1] = *(const f32x4*)(gn + col0 + bj * HALF + 4); }
#pragma unroll
        for (int ai = 0; ai < 2; ++ai)
#pragma unroll
            for (int m = 0; m < 4; ++m) { const int row = row0 + ai * HALF + m * 16; float sq = 0.f;
#pragma unroll
                for (int bj = 0; bj < 2; ++bj) { const size_t p = (size_t)row * DM + col0 + bj * HALF;
#if NORM_PRE
                    const f32x4 n0 = acc[ai][bj][m][0] * scale, n1 = acc[ai][bj][m][1] * scale; (void)p;
#else
                    const u32x4 w = *(const u32x4*)(Xold + p); const f32x4 o0 = {bflo(w.x), bfhi(w.x), bflo(w.y), bfhi(w.y)}, o1 = {bflo(w.z), bfhi(w.z), bflo(w.w), bfhi(w.w)};
                    const f32x4 n0 = o0 + acc[ai][bj][m][0] * scale, n1 = o1 + acc[ai][bj][m][1] * scale;
#endif
                    acc[ai][bj][m][0] = n0; acc[ai][bj][m][1] = n1;
                    sq += (n0[0] * n0[0] + n0[1] * n0[1]) + (n0[2] * n0[2] + n0[3] * n0[3]) + (n1[0] * n1[0] + n1[1] * n1[1]) + (n1[2] * n1[2] + n1[3] * n1[3]); }
                sq += __shfl_xor(sq, 16); sq += __shfl_xor(sq, 32);
                if (fq == 0) P[(ai * HALF + wr * 64 + m * 16 + fr) * 4 + wc] = sq;
                if (m & 1) asm volatile("" ::: "memory"); }
        __syncthreads();
        const int prow = wid * 32 + (lane & 31);
        if (lane < 32) { const f32x4 t = *(const LAS f32x4*)(P + prow * 4);
            __hip_atomic_store(xbuf + (size_t)(u.pm * BM + prow) * 4 + u.pn, (t[0] + t[1]) + (t[2] + t[3]), __ATOMIC_RELAXED, __HIP_MEMORY_SCOPE_AGENT); }
        asm volatile("s_waitcnt vmcnt(0)" ::: "memory");
        if (lane == 0) __hip_atomic_fetch_add(cnt + 64 * u.pm, 1u, __ATOMIC_RELAXED, __HIP_MEMORY_SCOPE_AGENT);
        if (wid == 0) { unsigned sp = 0;
            while ((unsigned)__builtin_amdgcn_readfirstlane(__hip_atomic_load(cnt + 64 * u.pm, __ATOMIC_RELAXED, __HIP_MEMORY_SCOPE_AGENT)) < 32u) { __builtin_amdgcn_s_sleep(2); if (++sp > (1u << 20)) break; }
            __builtin_amdgcn_fence(__ATOMIC_ACQUIRE, "agent"); }
        asm volatile("s_waitcnt vmcnt(0) lgkmcnt(0)" ::: "memory");
        __syncthreads();
        if (lane < 32) { const float* sl = xbuf + (size_t)(u.pm * BM + prow) * 4; float s = 0.f;
#pragma unroll
            for (int t = 0; t < 4; ++t) s += __hip_atomic_load(sl + t, __ATOMIC_RELAXED, __HIP_MEMORY_SCOPE_AGENT);
            S[prow] = rstd_of(s); }
        __syncthreads();
#pragma unroll
        for (int ai = 0; ai < 2; ++ai)
#pragma unroll
            for (int m = 0; m < 4; ++m) { const int r = ai * HALF + wr * 64 + m * 16 + fr; const float rs = S[r]; const size_t p0 = (size_t)(u.pm * BM + r) * DM + col0;
#pragma unroll
                for (int bj = 0; bj < 2; ++bj) { *(f32x4*)(out + p0 + bj * HALF) = acc[ai][bj][m][0] * rs * gg[bj][0]; *(f32x4*)(out + p0 + bj * HALF + 4) = acc[ai][bj][m][1] * rs * gg[bj][1]; } }
    }
};
}
#ifndef QE_FREE
#define QE_FREE 0
#endif
namespace att {
__device__ __forceinline__ int crow(int r, int hi) { return (r & 3) + 8 * (r >> 2) + 4 * hi; }
#define SBAR() __builtin_amdgcn_sched_barrier(0)
constexpr float NEG = -INFINITY;
constexpr int L_SLOT = 0;
constexpr int L_VR = 24576;
constexpr int L_WSF = 49152;
constexpr int L_OST = L_WSF + 2048;
#ifndef T5_EXT
#define T5_EXT 1
#endif
constexpr int T5_P = T5_EXT ? 96 : 0, T5_W = T5_EXT ? 304 : 128;
constexpr int L_TBL = L_OST + 32768;
constexpr int L_CB = L_TBL + 8 * T5_W * 4;
constexpr int L_PS = L_CB + 8192;
constexpr int L_IMP = L_PS + 4 * 64 * 33 * 4;
constexpr int L_MISC = L_IMP + 64 * 33 * 4;
constexpr int L_TBM = L_MISC + 448;
constexpr int L_CLAIM = L_MISC + 480;
constexpr int L_END = L_MISC + 64 + 256 + 64 + 64 + 32 + 32;
static_assert(L_END <= 147456 - 256, "attention LDS map");

__device__ __forceinline__ void qkt(f32x16& p0, f32x16& p1, const LAS unsigned char* Kslot, const bf16x8 (&qr)[4], int r32, int hi) {
    const LAS unsigned char* kb = Kslot + hi * 1024 + r32 * 16;
    p0 = f32x16{}; p1 = f32x16{};
#pragma unroll
    for (int d0 = 0; d0 < 4; ++d0) {
        const bf16x8 b0 = *(const LAS bf16x8*)(kb + d0 * 2048);
        const bf16x8 b1 = *(const LAS bf16x8*)(kb + d0 * 2048 + 512);
        p0 = __builtin_amdgcn_mfma_f32_32x32x16_bf16(b0, qr[d0], p0, 0, 0, 0);
        p1 = __builtin_amdgcn_mfma_f32_32x32x16_bf16(b1, qr[d0], p1, 0, 0, 0);
    }
}
__device__ __forceinline__ void pv(f32x16 (&o)[2], int vb, bf16x8 pa0, bf16x8 pa1, bf16x8 pa2, bf16x8 pa3) {
#pragma unroll
    for (int d0 = 0; d0 < 2; ++d0) { s16x4 lo[4], hi[4];
#pragma unroll
        for (int ks = 0; ks < 4; ++ks) {
            asm volatile("ds_read_b64_tr_b16 %0,%1 offset:%c2" : "=&v"(lo[ks]) : "v"(vb), "i"(d0 * 4096 + ks * 1024) : "memory");
            asm volatile("ds_read_b64_tr_b16 %0,%1 offset:%c2" : "=&v"(hi[ks]) : "v"(vb), "i"(d0 * 4096 + ks * 1024 + 512) : "memory"); }
        asm volatile("s_waitcnt lgkmcnt(0)" ::: "memory"); SBAR();
#define PK(k) (bf16x8){lo[k][0], lo[k][1], lo[k][2], lo[k][3], hi[k][0], hi[k][1], hi[k][2], hi[k][3]}
        o[d0] = __builtin_amdgcn_mfma_f32_32x32x16_bf16(pa0, PK(0), o[d0], 0, 0, 0);
        o[d0] = __builtin_amdgcn_mfma_f32_32x32x16_bf16(pa1, PK(1), o[d0], 0, 0, 0);
        o[d0] = __builtin_amdgcn_mfma_f32_32x32x16_bf16(pa2, PK(2), o[d0], 0, 0, 0);
        o[d0] = __builtin_amdgcn_mfma_f32_32x32x16_bf16(pa3, PK(3), o[d0], 0, 0, 0);
#undef PK
    }
}
__device__ __forceinline__ float rowmax32(const f32x16& p0, const f32x16& p1) {
    float a = fmaxf(p0[0], p1[0]);
#pragma unroll
    for (int r = 1; r < 16; ++r) a = fmaxf(a, fmaxf(p0[r], p1[r]));
    auto rr = __builtin_amdgcn_permlane32_swap(__float_as_uint(a), __float_as_uint(a), false, false);
    return fmaxf(__uint_as_float(rr[0]), __uint_as_float(rr[1]));
}
__device__ __forceinline__ float halfsum(float v) {
    auto rr = __builtin_amdgcn_permlane32_swap(__float_as_uint(v), __float_as_uint(v), false, false);
    return __uint_as_float(rr[0]) + __uint_as_float(rr[1]);
}
#define PKW(P, B) cvtpk(P[B], P[B + 1])
__device__ __forceinline__ void pack_p(const f32x16& p0, const f32x16& p1, bf16x8& a0, bf16x8& a1, bf16x8& a2, bf16x8& a3) {
    const u32x4 w0 = {PKW(p0, 0), PKW(p0, 2), PKW(p0, 4), PKW(p0, 6)}, w1 = {PKW(p0, 8), PKW(p0, 10), PKW(p0, 12), PKW(p0, 14)};
    const u32x4 w2 = {PKW(p1, 0), PKW(p1, 2), PKW(p1, 4), PKW(p1, 6)}, w3 = {PKW(p1, 8), PKW(p1, 10), PKW(p1, 12), PKW(p1, 14)};
    a0 = __builtin_bit_cast(bf16x8, w0); a1 = __builtin_bit_cast(bf16x8, w1); a2 = __builtin_bit_cast(bf16x8, w2); a3 = __builtin_bit_cast(bf16x8, w3);
}
#undef PKW
__device__ __forceinline__ void scale_rows(f32x16 (&o)[2], LAS float* wsf, float v, int r32, int hi) {
    if (hi == 0) wsf[r32] = v;
    asm volatile("s_waitcnt lgkmcnt(0)" ::: "memory");
#pragma unroll
    for (int i = 0; i < 4; ++i) { const f32x4 f = *(const LAS f32x4*)(wsf + 8 * i + 4 * hi);
#pragma unroll
        for (int j = 0; j < 4; ++j) { o[0][4 * i + j] *= f[j]; o[1][4 * i + j] *= f[j]; } }
    asm volatile("s_waitcnt lgkmcnt(0)" ::: "memory");
}
struct StageGeo { int krow, kcol, koff, vrow, vcol, voff; };
__device__ __forceinline__ StageGeo stage_geo(int tid) {
    StageGeo s; const int w = tid >> 6, ln = tid & 63;
    s.krow = ln; s.kcol = w * 8; s.koff = w * 1024 + ln * 16;
    s.vrow = 16 * (w & 3) + (ln >> 2); s.vcol = (w >> 2) * 32 + (ln & 3) * 8; s.voff = 8192 + w * 1024 + ln * 16;
    return s;
}
template <class Mod>
__device__ __forceinline__ void tile_step(const LAS unsigned char* slot, const bf16x8 (&qr)[4], f32x16 (&o)[2], float& m, float& l, LAS float* wsf, const Mod& mod, int r32, int hi, int vb) {
    f32x16 p0, p1;
    qkt(p0, p1, slot, qr, r32, hi);
    mod(p0, p1);
    const float rm = rowmax32(p0, p1);
    const float mn = fmaxf(m, rm);
    const float alpha = fexp2(m - mn);
    const bool need = __any(mn > m);
    m = mn;
    float s = 0.f;
#pragma unroll
    for (int r = 0; r < 16; ++r) { p0[r] = fexp2(p0[r] - mn); p1[r] = fexp2(p1[r] - mn); s += p0[r] + p1[r]; }
    l = l * alpha + s;
    if (need) scale_rows(o, wsf, alpha, r32, hi);
    bf16x8 a0, a1, a2, a3; pack_p(p0, p1, a0, a1, a2, a3);
    pv(o, vb, a0, a1, a2, a3);
}
template <class ModF>
__device__ __forceinline__ void attn_loop(unsigned tmask, const bf16_t* Kg, int pitchK, const bf16_t* Vg, int pitchV, LAS unsigned char* lds, const bf16x8 (&qr)[4],
                                          f32x16 (&o)[2], float& m, float& l, const ModF& modf, int wave_last_row) {
    const int tid = fresh_tid(), lane = tid & 63, r32 = lane & 31, hi = lane >> 5, wid = tid >> 6;
    const StageGeo sg = stage_geo(tid);
    LAS float* wsf = (LAS float*)(lds + L_WSF) + wid * 64;
    const int vb0 = (int)(unsigned)(size_t)(lds + L_SLOT + 8192) + ((lane >> 4) & 1) * 32 + (lane & 3) * 8 + (4 * hi + ((lane & 15) >> 2)) * 64;
    int kt = 31 - __clz((int)tmask);
    u32x4 kreg = *(const u32x4*)(Kg + (size_t)(kt * 64 + sg.krow) * pitchK + sg.kcol);
    u32x4 vreg = *(const u32x4*)(Vg + (size_t)(kt * 64 + sg.vrow) * pitchV + sg.vcol);
    *(LAS u32x4*)(lds + L_SLOT + sg.koff) = kreg; *(LAS u32x4*)(lds + L_SLOT + sg.voff) = vreg;
    __syncthreads();
    int s = 0;
    for (;;) {
        tmask &= ~(1u << kt);
        const int nk = tmask ? 31 - __clz((int)tmask) : -1;
        if (nk >= 0) { kreg = *(const u32x4*)(Kg + (size_t)(nk * 64 + sg.krow) * pitchK + sg.kcol); vreg = *(const u32x4*)(Vg + (size_t)(nk * 64 + sg.vrow) * pitchV + sg.vcol); }
        if (kt * 64 <= wave_last_row) tile_step(lds + L_SLOT + s * 16384, qr, o, m, l, wsf, modf(kt), r32, hi, vb0 + s * 16384);
        if (nk >= 0) { *(LAS u32x4*)(lds + L_SLOT + (s ^ 1) * 16384 + sg.koff) = kreg; *(LAS u32x4*)(lds + L_SLOT + (s ^ 1) * 16384 + sg.voff) = vreg; }
        __syncthreads();
        if (nk < 0) break;
        kt = nk; s ^= 1;
    }
}
template <bool ADD>
__device__ __forceinline__ void store_o(const f32x16 (&o)[2], LAS unsigned char* lds, bf16_t* dst, int pitch, const bf16_t* addsrc, int addpitch) {
    const int tid = fresh_tid(), lane = tid & 63, r32 = lane & 31, hi = lane >> 5, wid = tid >> 6;
    LAS bf16_t* stg = (LAS bf16_t*)(lds + L_OST) + wid * 2048;
#pragma unroll
    for (int r = 0; r < 16; ++r) { const int orow = crow(r, hi);
#pragma unroll
        for (int d0 = 0; d0 < 2; ++d0) stg[orow * 64 + d0 * 32 + r32] = (bf16_t)(cvtpk(o[d0][r], 0.f) & 0xffffu); }
    asm volatile("s_waitcnt lgkmcnt(0)" ::: "memory");
#pragma unroll
    for (int i = 0; i < 4; ++i) { const int row = i * 8 + (lane >> 3), ch = lane & 7;
        u32x4 v = *(const LAS u32x4*)(stg + row * 64 + ch * 8);
        if (ADD) { const u32x4 a = *(const u32x4*)(addsrc + (size_t)row * addpitch + ch * 8);
            v.x = cvtpk(bflo(v.x) + bflo(a.x), bfhi(v.x) + bfhi(a.x)); v.y = cvtpk(bflo(v.y) + bflo(a.y), bfhi(v.y) + bfhi(a.y));
            v.z = cvtpk(bflo(v.z) + bflo(a.z), bfhi(v.z) + bfhi(a.z)); v.w = cvtpk(bflo(v.w) + bflo(a.w), bfhi(v.w) + bfhi(a.w)); }
        *(u32x4*)(dst + (size_t)row * pitch + ch * 8) = v; }
    asm volatile("s_waitcnt lgkmcnt(0)" ::: "memory");
}
template <bool ACC, bool OUT>
__device__ __forceinline__ void stage_o(const f32x16 (&o)[2], LAS unsigned char* lds, bf16_t* dst, int pitch) {
    const int tid = fresh_tid(), lane = tid & 63, r32 = lane & 31, hi = lane >> 5, wid = tid >> 6;
    LAS bf16_t* stg = (LAS bf16_t*)(lds + L_OST) + wid * 2048;
#pragma unroll
    for (int r = 0; r < 16; ++r) { const int orow = crow(r, hi);
#pragma unroll
        for (int d0 = 0; d0 < 2; ++d0) { LAS bf16_t* p = stg + orow * 64 + d0 * 32 + r32; float v = o[d0][r];
            if (ACC) v += __uint_as_float((unsigned)*p << 16);
            *p = (bf16_t)(cvtpk(v, 0.f) & 0xffffu); } }
    asm volatile("s_waitcnt lgkmcnt(0)" ::: "memory");
    if (OUT) {
#pragma unroll
        for (int i = 0; i < 4; ++i) { const int row = i * 8 + (lane >> 3), ch = lane & 7;
            *(u32x4*)(dst + (size_t)row * pitch + ch * 8) = *(const LAS u32x4*)(stg + row * 64 + ch * 8); }
        asm volatile("s_waitcnt lgkmcnt(0)" ::: "memory"); }
}
__device__ __forceinline__ void load_q(bf16x8 (&qr)[4], const bf16_t* Qw, int pitch, int r32, int hi) {
#pragma unroll
    for (int d0 = 0; d0 < 4; ++d0) qr[d0] = *(const bf16x8*)(Qw + (size_t)r32 * pitch + d0 * 16 + hi * 8);
}

struct ModFox { const LAS float* cb; int kbase, qpos, hi; bool diag;
    __device__ __forceinline__ void operator()(f32x16& p0, f32x16& p1) const {
#pragma unroll
        for (int i = 0; i < 4; ++i) { const f32x4 c0 = *(const LAS f32x4*)(cb + kbase + 8 * i + 4 * hi), c1 = *(const LAS f32x4*)(cb + kbase + 32 + 8 * i + 4 * hi);
#pragma unroll
            for (int j = 0; j < 4; ++j) { p0[4 * i + j] += c0[j]; p1[4 * i + j] += c1[j]; } }
        if (diag) {
#pragma unroll
            for (int r = 0; r < 16; ++r) { const int kv = kbase + crow(r, hi); if (kv > qpos) p0[r] = NEG; if (kv + 32 > qpos) p1[r] = NEG; } }
    } };
struct ModFoxF { const LAS float* cb; int qpos, hi, q0w;
    __device__ __forceinline__ ModFox operator()(int kt) const { return ModFox{cb, kt * 64, qpos, hi, kt * 64 + 63 > q0w}; } };
struct ModT5 { const LAS float* tb; int kbase, qpos, hi, window; bool enabled;
    __device__ __forceinline__ void operator()(f32x16& p0, f32x16& p1) const {
#pragma unroll
        for (int r = 0; r < 16; ++r) { const int d0 = qpos - (kbase + crow(r, hi)), d1 = d0 - 32;
            const float b0 = tb[min(max(d0, 0), 127)], b1 = tb[min(max(d1, 0), 127)];
            p0[r] = (enabled && d0 >= 0 && d0 < window) ? p0[r] + b0 : NEG;
            p1[r] = (enabled && d1 >= 0 && d1 < window) ? p1[r] + b1 : NEG; }
    } };
struct ModWinF { const LAS float* tb; int qpos, hi;
    __device__ __forceinline__ ModT5 operator()(int kt) const { return ModT5{tb, kt * 64, qpos, hi, 512, true}; } };
struct ModSelF { const LAS float* tb; int qpos, hi; unsigned mask;
    __device__ __forceinline__ ModT5 operator()(int kt) const { return ModT5{tb, kt * 64, qpos, hi, 1 << 30, ((mask >> kt) & 1u) != 0u}; } };

typedef short v4i16_t __attribute__((ext_vector_type(4)));
__device__ __forceinline__ s16x4 vtr(const LAS unsigned char* p) { return __builtin_bit_cast(s16x4, __builtin_amdgcn_ds_read_tr16_b64_v4i16((LAS v4i16_t*)p)); }
__device__ __forceinline__ void qkt_c(f32x16& p0, f32x16& p1, const LAS unsigned char* Kslot, const bf16x8 (&qr)[4], const f32x16& c0, const f32x16& c1, int r32, int hi) {
    const LAS unsigned char* kb = Kslot + hi * 1024 + r32 * 16;
    { const bf16x8 b0 = *(const LAS bf16x8*)(kb); const bf16x8 b1 = *(const LAS bf16x8*)(kb + 512);
      p0 = __builtin_amdgcn_mfma_f32_32x32x16_bf16(b0, qr[0], c0, 0, 0, 0); p1 = __builtin_amdgcn_mfma_f32_32x32x16_bf16(b1, qr[0], c1, 0, 0, 0); }
#pragma unroll
    for (int d0 = 1; d0 < 4; ++d0) {
        const bf16x8 b0 = *(const LAS bf16x8*)(kb + d0 * 2048); const bf16x8 b1 = *(const LAS bf16x8*)(kb + d0 * 2048 + 512);
        p0 = __builtin_amdgcn_mfma_f32_32x32x16_bf16(b0, qr[d0], p0, 0, 0, 0); p1 = __builtin_amdgcn_mfma_f32_32x32x16_bf16(b1, qr[d0], p1, 0, 0, 0); }
}
__device__ __forceinline__ void pv2(f32x16 (&o)[2], const LAS unsigned char* vp, bf16x8 pa0, bf16x8 pa1, bf16x8 pa2, bf16x8 pa3) {
    s16x4 lo[2][4], hi[2][4];
#pragma unroll
    for (int ks = 0; ks < 4; ++ks)
#pragma unroll
        for (int d0 = 0; d0 < 2; ++d0) { lo[d0][ks] = vtr(vp + d0 * 4096 + ks * 1024); hi[d0][ks] = vtr(vp + d0 * 4096 + ks * 1024 + 512); }
#define PK(d, k) (bf16x8){lo[d][k][0], lo[d][k][1], lo[d][k][2], lo[d][k][3], hi[d][k][0], hi[d][k][1], hi[d][k][2], hi[d][k][3]}
    o[0] = __builtin_amdgcn_mfma_f32_32x32x16_bf16(pa0, PK(0, 0), o[0], 0, 0, 0); o[1] = __builtin_amdgcn_mfma_f32_32x32x16_bf16(pa0, PK(1, 0), o[1], 0, 0, 0);
    o[0] = __builtin_amdgcn_mfma_f32_32x32x16_bf16(pa1, PK(0, 1), o[0], 0, 0, 0); o[1] = __builtin_amdgcn_mfma_f32_32x32x16_bf16(pa1, PK(1, 1), o[1], 0, 0, 0);
    o[0] = __builtin_amdgcn_mfma_f32_32x32x16_bf16(pa2, PK(0, 2), o[0], 0, 0, 0); o[1] = __builtin_amdgcn_mfma_f32_32x32x16_bf16(pa2, PK(1, 2), o[1], 0, 0, 0);
    o[0] = __builtin_amdgcn_mfma_f32_32x32x16_bf16(pa3, PK(0, 3), o[0], 0, 0, 0); o[1] = __builtin_amdgcn_mfma_f32_32x32x16_bf16(pa3, PK(1, 3), o[1], 0, 0, 0);
#undef PK
}
struct VFrag { s16x4 lo[2][4], hi[2][4]; };
__device__ __forceinline__ void load_vf(VFrag& v, const LAS unsigned char* vp) {
#pragma unroll
    for (int ks = 0; ks < 4; ++ks)
#pragma unroll
        for (int d0 = 0; d0 < 2; ++d0) { v.lo[d0][ks] = vtr(vp + d0 * 4096 + ks * 1024); v.hi[d0][ks] = vtr(vp + d0 * 4096 + ks * 1024 + 512); }
}
__device__ __forceinline__ void pv_mma(f32x16 (&o)[2], const VFrag& v, bf16x8 pa0, bf16x8 pa1, bf16x8 pa2, bf16x8 pa3) {
#define PK(d, k) (bf16x8){v.lo[d][k][0], v.lo[d][k][1], v.lo[d][k][2], v.lo[d][k][3], v.hi[d][k][0], v.hi[d][k][1], v.hi[d][k][2], v.hi[d][k][3]}
    o[0] = __builtin_amdgcn_mfma_f32_32x32x16_bf16(pa0, PK(0, 0), o[0], 0, 0, 0); o[1] = __builtin_amdgcn_mfma_f32_32x32x16_bf16(pa0, PK(1, 0), o[1], 0, 0, 0);
    o[0] = __builtin_amdgcn_mfma_f32_32x32x16_bf16(pa1, PK(0, 1), o[0], 0, 0, 0); o[1] = __builtin_amdgcn_mfma_f32_32x32x16_bf16(pa1, PK(1, 1), o[1], 0, 0, 0);
    o[0] = __builtin_amdgcn_mfma_f32_32x32x16_bf16(pa2, PK(0, 2), o[0], 0, 0, 0); o[1] = __builtin_amdgcn_mfma_f32_32x32x16_bf16(pa2, PK(1, 2), o[1], 0, 0, 0);
    o[0] = __builtin_amdgcn_mfma_f32_32x32x16_bf16(pa3, PK(0, 3), o[0], 0, 0, 0); o[1] = __builtin_amdgcn_mfma_f32_32x32x16_bf16(pa3, PK(1, 3), o[1], 0, 0, 0);
#undef PK
}
__device__ __forceinline__ float rowmax32b(const f32x16& p0, const f32x16& p1) {
    float a = __builtin_fmaxf(__builtin_fmaxf(p0[0], p0[1]), p1[0]), b = __builtin_fmaxf(__builtin_fmaxf(p0[2], p0[3]), p1[1]); a = __builtin_fmaxf(__builtin_fmaxf(a, p1[2]), p1[3]);
#pragma unroll
    for (int r = 4; r < 16; r += 4) { a = __builtin_fmaxf(__builtin_fmaxf(a, p0[r]), p0[r + 1]); b = __builtin_fmaxf(__builtin_fmaxf(b, p0[r + 2]), p0[r + 3]);
        a = __builtin_fmaxf(__builtin_fmaxf(a, p1[r]), p1[r + 1]); b = __builtin_fmaxf(__builtin_fmaxf(b, p1[r + 2]), p1[r + 3]); }
    const float m = __builtin_fmaxf(a, b);
    auto rr = __builtin_amdgcn_permlane32_swap(__float_as_uint(m), __float_as_uint(m), false, false);
    return __builtin_fmaxf(__uint_as_float(rr[0]), __uint_as_float(rr[1]));
}
constexpr float DEFER_THR = 6.0f;
#ifndef ATT_GRP
#define ATT_GRP(w) 0
#endif
template <int ABL, class TF>
__device__ __forceinline__ void sm_pv(f32x16& sc0, f32x16& sc1, f32x16& sn0, f32x16& sn1, bool adjust_next, int kt, int par, bool& first, float& mref, float& l, f32x16 (&o)[2],
                                      LAS float* wsf, const LAS unsigned char* vp0, const TF& tf, int r32, int hi) {
    if (ABL & 16) { o[0][1] += sc0[3] + sc1[5]; return; }
    tf.post(kt, sc0, sc1);
    const float rm = rowmax32b(sc0, sc1);
    if (__any(first || rm > DEFER_THR)) {
        const float delta = first ? (rm == NEG ? 0.f : rm) : __builtin_fmaxf(rm, 0.f);
        mref += delta;
#pragma unroll
        for (int r = 0; r < 16; ++r) { sc0[r] -= delta; sc1[r] -= delta; }
        if (adjust_next) {
#pragma unroll
            for (int r = 0; r < 16; ++r) { sn0[r] -= delta; sn1[r] -= delta; } }
        const float f = fexp2(-delta); l *= f;
        if (!first) scale_rows(o, wsf, f, r32, hi);
        first = false;
    }
    float s = 0.f;
#pragma unroll
    for (int r = 0; r < 16; ++r) { if (!(ABL & 1)) { sc0[r] = fexp2(sc0[r]); sc1[r] = fexp2(sc1[r]); } s += sc0[r] + sc1[r]; }
    l += s;
    bf16x8 a0, a1, a2, a3; pack_p(sc0, sc1, a0, a1, a2, a3);
    if (!(ABL & 2)) pv2(o, vp0 + par * 8192, a0, a1, a2, a3); else { o[0][0] += __builtin_bit_cast(f32x4, a0)[0] + __builtin_bit_cast(f32x4, a3)[3]; }
}
__device__ __forceinline__ void load_kf(bf16x8 (&kf)[8], const LAS unsigned char* Kslot, int r32, int hi) {
    const LAS unsigned char* kb = Kslot + hi * 1024 + r32 * 16;
#pragma unroll
    for (int d0 = 0; d0 < 4; ++d0) { kf[2 * d0] = *(const LAS bf16x8*)(kb + d0 * 2048); kf[2 * d0 + 1] = *(const LAS bf16x8*)(kb + d0 * 2048 + 512); }
}
#if QE_FREE
#define QE_SBAR() do {} while (0)
#else
#define QE_SBAR() SBAR()
#endif
__device__ __forceinline__ void qk_exp(f32x16& n0, f32x16& n1, f32x16& s0, f32x16& s1, const f32x16& c0, const f32x16& c1, const bf16x8 (&kf)[8], const bf16x8 (&qr)[4],
                                       float& l, bf16x8& a0, bf16x8& a1, bf16x8& a2, bf16x8& a3) {
    float sA_ = 0.f, sB_ = 0.f, sC_ = 0.f, sD_ = 0.f; unsigned w[16];
#define QE_GAP(i, X, B) do { X[B] = fexp2(X[B]); X[B + 1] = fexp2(X[B + 1]); X[B + 2] = fexp2(X[B + 2]); X[B + 3] = fexp2(X[B + 3]); \
        sA_ += X[B]; sB_ += X[B + 1]; sC_ += X[B + 2]; sD_ += X[B + 3];     \
        w[2 * (i)] = cvtpk(X[B], X[B + 1]); w[2 * (i) + 1] = cvtpk(X[B + 2], X[B + 3]); QE_SBAR(); } while (0)
    SBAR();
    n0 = __builtin_amdgcn_mfma_f32_32x32x16_bf16(kf[0], qr[0], c0, 0, 0, 0); QE_GAP(0, s0, 0);
    n1 = __builtin_amdgcn_mfma_f32_32x32x16_bf16(kf[1], qr[0], c1, 0, 0, 0); QE_GAP(1, s0, 4);
    n0 = __builtin_amdgcn_mfma_f32_32x32x16_bf16(kf[2], qr[1], n0, 0, 0, 0); QE_GAP(2, s0, 8);
    n1 = __builtin_amdgcn_mfma_f32_32x32x16_bf16(kf[3], qr[1], n1, 0, 0, 0); QE_GAP(3, s0, 12);
    n0 = __builtin_amdgcn_mfma_f32_32x32x16_bf16(kf[4], qr[2], n0, 0, 0, 0); QE_GAP(4, s1, 0);
    n1 = __builtin_amdgcn_mfma_f32_32x32x16_bf16(kf[5], qr[2], n1, 0, 0, 0); QE_GAP(5, s1, 4);
    n0 = __builtin_amdgcn_mfma_f32_32x32x16_bf16(kf[6], qr[3], n0, 0, 0, 0); QE_GAP(6, s1, 8);
    n1 = __builtin_amdgcn_mfma_f32_32x32x16_bf16(kf[7], qr[3], n1, 0, 0, 0); QE_GAP(7, s1, 12);
#undef QE_GAP
    l += (sA_ + sB_) + (sC_ + sD_);
    const u32x4 w0 = {w[0], w[1], w[2], w[3]}, w1 = {w[4], w[5], w[6], w[7]}, w2 = {w[8], w[9], w[10], w[11]}, w3 = {w[12], w[13], w[14], w[15]};
    a0 = __builtin_bit_cast(bf16x8, w0); a1 = __builtin_bit_cast(bf16x8, w1); a2 = __builtin_bit_cast(bf16x8, w2); a3 = __builtin_bit_cast(bf16x8, w3);
}
__device__ __forceinline__ void glds16(const void* gsrc, unsigned lds_dst) { unsigned keep;
    asm volatile("s_mov_b32 %0, m0\n\ts_mov_b32 m0, %2\n\ts_nop 0\n\tglobal_load_lds_dwordx4 %1, off\n\ts_mov_b32 m0, %0" : "=&s"(keep) : "v"(gsrc), "s"(lds_dst) : "memory"); }
#define ATT_WAIT_BAR(N) asm volatile("s_waitcnt vmcnt(" #N ") lgkmcnt(0)\n\ts_barrier" ::: "memory")
#ifndef TAILFIX
#define TAILFIX 0
#endif
#ifndef CFAR_OPAQUE
#define CFAR_OPAQUE 0
#endif
#ifndef YOUNG_PRIO
#define YOUNG_PRIO 0
#endif
#ifndef ENDWAIT
#define ENDWAIT 1
#endif
template <int N>
__device__ __forceinline__ void attn_pre(int t0, int t1, int t2, const bf16_t* Kg, int pitchK, const bf16_t* Vg, int pitchV, LAS unsigned char* lds) {
    const int tid = fresh_tid(), lane = tid & 63, wid = __builtin_amdgcn_readfirstlane(tid >> 6);
    const bf16_t* ksrc = Kg + (size_t)lane * pitchK + wid * 8;
    const bf16_t* vsrc = Vg + (size_t)(16 * (wid & 3) + (lane >> 2)) * pitchV + (wid >> 2) * 32 + (lane & 3) * 8;
    const unsigned ldsb = (unsigned)(size_t)(lds + L_SLOT) + (unsigned)wid * 1024u;
    const int u1 = t1 < 0 ? t0 : t1, u2 = t2 < 0 ? t0 : t2;
    glds16(ksrc + (size_t)t0 * 64 * pitchK, (unsigned)__builtin_amdgcn_readfirstlane(ldsb));
    glds16(vsrc + (size_t)t0 * 64 * pitchV, (unsigned)__builtin_amdgcn_readfirstlane(ldsb + (unsigned)L_VR));
    glds16(ksrc + (size_t)u1 * 64 * pitchK, (unsigned)__builtin_amdgcn_readfirstlane(ldsb + 8192u));
    glds16(vsrc + (size_t)u1 * 64 * pitchV, (unsigned)__builtin_amdgcn_readfirstlane(ldsb + (unsigned)L_VR + 8192u));
    if (N >= 5) glds16(ksrc + (size_t)u2 * 64 * pitchK, (unsigned)__builtin_amdgcn_readfirstlane(ldsb + 16384u));
}
__device__ __forceinline__ void top3(unsigned m, int& t0, int& t1, int& t2) {
    t0 = 31 - __clz((int)m); m &= ~(1u << t0);
    if (m) { t1 = 31 - __clz((int)m); m &= ~(1u << t1); } else t1 = -1;
    t2 = m ? 31 - __clz((int)m) : -1;
}
template <int ABL = 0, int PRE = 0, bool online = false, class TF>
__device__ __forceinline__ void attn_loop2x(unsigned tmask, const bf16_t* Kg, int pitchK, const bf16_t* Vg, int pitchV, LAS unsigned char* lds, const bf16x8 (&qr)[4],
                                           f32x16 (&o)[2], float& mref, float& l, const TF& tf, int wave_last_row, float mref0) {
    const int tid = fresh_tid(), lane = tid & 63, r32 = lane & 31, hi = lane >> 5, wid = __builtin_amdgcn_readfirstlane(tid >> 6), grp = ATT_GRP(wid);
    LAS float* wsf = (LAS float*)(lds + L_WSF) + wid * 64;
    const LAS unsigned char* vp0 = lds + L_SLOT + L_VR + ((lane >> 4) & 1) * 32 + (lane & 3) * 8 + (4 * hi + ((lane & 15) >> 2)) * 64;
    const bf16_t* ksrc = Kg + (size_t)lane * pitchK + wid * 8;
    const bf16_t* vsrc = Vg + (size_t)(16 * (wid & 3) + (lane >> 2)) * pitchV + (wid >> 2) * 32 + (lane & 3) * 8;
    const unsigned ldsb = (unsigned)(size_t)(lds + L_SLOT) + (unsigned)wid * 1024u;
#define DMA_K(t, slot) glds16(ksrc + (size_t)(t) * 64 * pitchK, (unsigned)__builtin_amdgcn_readfirstlane(ldsb + (unsigned)(slot) * 8192u))
#define DMA_V(t, slot) glds16(vsrc + (size_t)(t) * 64 * pitchV, (unsigned)__builtin_amdgcn_readfirstlane(ldsb + (unsigned)L_VR + (unsigned)(slot) * 8192u))
#define NEXT_TILE(dst) do { if (tmask) { dst = 31 - __clz((int)tmask); tmask &= ~(1u << dst); } else dst = -1; } while (0)
    int t0, t1, t2, t3;
    NEXT_TILE(t0); NEXT_TILE(t1); NEXT_TILE(t2);
    const int tz = t0;
    if (PRE < 4) { DMA_K(t0, 0); DMA_V(t0, 0); DMA_K(t1 < 0 ? tz : t1, 1); DMA_V(t1 < 0 ? tz : t1, 1); }
    if (PRE < 5) DMA_K(t2 < 0 ? tz : t2, 2);
    ATT_WAIT_BAR(2);
    f32x16 sa0, sa1, sb0, sb1, cfar;
    bool first = online, seen = !online;
    mref = online ? 0.f : mref0; l = 0.f;
    const float fbias = tf.farbias();
#pragma unroll
    for (int r = 0; r < 16; ++r) cfar[r] = fbias - mref;
#if CFAR_OPAQUE
    if (!online) asm volatile("" : "+v"(cfar));
#endif
    { f32x16 c0, c1; tf.cinit(t0, mref, c0, c1); qkt_c(sa0, sa1, lds + L_SLOT, qr, c0, c1, r32, hi); }
    asm volatile("s_waitcnt lgkmcnt(0)\n\ts_barrier" ::: "memory");
    int s0 = 0, s1 = 1, s2 = 2;
#if YOUNG_PRIO
    if (wid >= 4) __builtin_amdgcn_s_setprio(1);
#endif
#define ATT_STEP(SC0, SC1, SN0, SN1) do { \
        NEXT_TILE(t3); \
        if (TAILFIX) { if (t3 >= 0) DMA_K((ABL & 128) ? tz : t3, s0); if (t2 >= 0) DMA_V((ABL & 128) ? tz : t2, s2); }     \
        else { DMA_K((ABL & 128) || t3 < 0 ? tz : t3, s0); DMA_V((ABL & 128) || t2 < 0 ? tz : t2, s2); } \
        const int t1c = t1 < 0 ? tz : t1; \
        bf16x8 kf[8]; load_kf(kf, lds + L_SLOT + s1 * 8192, r32, hi);          \
        const bool farn = tf.far(t1c); \
        if (TF::HOIST_BIAS && !farn) tf.bias_raw(t1c, SN0, SN1); \
        SBAR(); \
        tf.post(t0, SC0, SC1); \
        if (online) { const float rm = rowmax32b(SC0, SC1); \
          if (__any(first || rm > DEFER_THR || (!seen && rm != NEG))) { \
            const float delta = !seen ? (rm == NEG ? 0.f : rm) : __builtin_fmaxf(rm, 0.f);     \
            seen = seen || (rm != NEG); \
            mref += delta; \
            _Pragma("unroll") for (int r = 0; r < 16; ++r) { SC0[r] -= delta; SC1[r] -= delta; } \
            const float f = fexp2(-delta); l *= f; \
            if (!first) scale_rows(o, wsf, f, r32, hi); \
            _Pragma("unroll") for (int r = 0; r < 16; ++r) cfar[r] = fbias - mref; \
            first = false; } } \
        { bf16x8 a0, a1, a2, a3; \
          if (TF::HOIST_BIAS) { VFrag vf; load_vf(vf, vp0 + s0 * 8192); SBAR();     \
            f32x16 c0, c1; _Pragma("unroll") for (int r = 0; r < 16; ++r) { c0[r] = SN0[r] - mref; c1[r] = SN1[r] - mref; } \
            qk_exp(SN0, SN1, SC0, SC1, c0, c1, kf, qr, l, a0, a1, a2, a3); pv_mma(o, vf, a0, a1, a2, a3); } \
          else { if (farn) { if (TF::FOLD_MASK && tf.use_mask) { f32x16 cm; const bool en_ = tf.rowen(t1c); _Pragma("unroll") for (int r = 0; r < 16; ++r) cm[r] = en_ ? cfar[r] : NEG; \
                                 qk_exp(SN0, SN1, SC0, SC1, cm, cm, kf, qr, l, a0, a1, a2, a3); } \
                               else qk_exp(SN0, SN1, SC0, SC1, cfar, cfar, kf, qr, l, a0, a1, a2, a3); } \
                 else { f32x16 c0, c1; tf.cinit(t1c, mref, c0, c1); qk_exp(SN0, SN1, SC0, SC1, c0, c1, kf, qr, l, a0, a1, a2, a3); } \
                 pv2(o, vp0 + s0 * 8192, a0, a1, a2, a3); } } \
        if (!TAILFIX || t3 >= 0) ATT_WAIT_BAR(2); else if (t2 >= 0) ATT_WAIT_BAR(1); else ATT_WAIT_BAR(0);     \
        t0 = t1; t1 = t2; t2 = t3; { const int s_ = s0; s0 = s1; s1 = s2; s2 = s_; } \
    } while (0)
    for (;;) {
        ATT_STEP(sa0, sa1, sb0, sb1); if (t0 < 0) break;
        ATT_STEP(sb0, sb1, sa0, sa1); if (t0 < 0) break;
    }
#if YOUNG_PRIO
    __builtin_amdgcn_s_setprio(0);
#endif
#if ENDWAIT
    asm volatile("s_waitcnt vmcnt(0)" ::: "memory");
    __syncthreads();
#else
    asm volatile("s_waitcnt lgkmcnt(0)\n\ts_barrier" ::: "memory");
#endif
#undef ATT_STEP
#undef NEXT_TILE
#undef DMA_K
#undef DMA_V
}
template <int ABL = 0, int PRE = 0, class TF>
__device__ __forceinline__ void attn_loop2(unsigned tmask, const bf16_t* Kg, int pitchK, const bf16_t* Vg, int pitchV, LAS unsigned char* lds, const bf16x8 (&qr)[4],
                                           f32x16 (&o)[2], float& mref, float& l, const TF& tf, int wave_last_row, float mref0, bool online) {
#ifdef ONLINE_RUNTIME_ONLY
    attn_loop2x<ABL, PRE, true>(tmask, Kg, pitchK, Vg, pitchV, lds, qr, o, mref, l, tf, wave_last_row, mref0);
#else
    if (online) attn_loop2x<ABL, PRE, true>(tmask, Kg, pitchK, Vg, pitchV, lds, qr, o, mref, l, tf, wave_last_row, mref0);
    else attn_loop2x<ABL, PRE, false>(tmask, Kg, pitchK, Vg, pitchV, lds, qr, o, mref, l, tf, wave_last_row, mref0);
#endif
}
struct TfFox { const LAS float* cb; int qpos, hi, q0w;
    static constexpr bool HOIST_BIAS = true; static constexpr bool FOLD_MASK = false; static constexpr bool use_mask = false;
    __device__ __forceinline__ bool rowen(int) const { return true; }
    __device__ __forceinline__ bool far(int) const { return false; }
    __device__ __forceinline__ float farbias() const { return 0.f; }
    __device__ __forceinline__ void cinit(int kt, float mref, f32x16& c0, f32x16& c1) const {
#pragma unroll
        for (int i = 0; i < 4; ++i) { const f32x4 a = *(const LAS f32x4*)(cb + kt * 64 + 8 * i + 4 * hi), b = *(const LAS f32x4*)(cb + kt * 64 + 32 + 8 * i + 4 * hi);
#pragma unroll
            for (int j = 0; j < 4; ++j) { c0[4 * i + j] = a[j] - mref; c1[4 * i + j] = b[j] - mref; } } }
    __device__ __forceinline__ void bias_raw(int kt, f32x16& c0, f32x16& c1) const {
#pragma unroll
        for (int i = 0; i < 4; ++i) { const f32x4 a = *(const LAS f32x4*)(cb + kt * 64 + 8 * i + 4 * hi), b = *(const LAS f32x4*)(cb + kt * 64 + 32 + 8 * i + 4 * hi);
#pragma unroll
            for (int j = 0; j < 4; ++j) { c0[4 * i + j] = a[j]; c1[4 * i + j] = b[j]; } } }
    __device__ __forceinline__ void post(int kt, f32x16& p0, f32x16& p1) const {
        if (kt * 64 + 63 > q0w) {
#pragma unroll
            for (int r = 0; r < 16; ++r) { const int kv = kt * 64 + crow(r, hi); if (kv > qpos) p0[r] = NEG; if (kv + 32 > qpos) p1[r] = NEG; } } } };
#ifndef SEL_FOLD
#define SEL_FOLD 1
#endif
struct TfT5 { const LAS float* tb; int qpos, hi, q0w, window; unsigned mask; bool use_mask;
    static constexpr bool HOIST_BIAS = false;
    __device__ __forceinline__ bool far(int kt) const { return q0w - (kt * 64 + 63) >= 113; }
    __device__ __forceinline__ float farbias() const { return tb[127]; }
    static constexpr bool FOLD_MASK = SEL_FOLD != 0;
    __device__ __forceinline__ bool rowen(int kt) const { return !use_mask || ((mask >> kt) & 1u) != 0u; }
    __device__ __forceinline__ void cinit(int kt, float mref_, f32x16& c0, f32x16& c1) const {
        const float mref = (FOLD_MASK && !rowen(kt)) ? INFINITY : mref_;
        if (q0w - (kt * 64 + 63) >= 113) { const float c = tb[127] - mref;
#pragma unroll
            for (int r = 0; r < 16; ++r) { c0[r] = c; c1[r] = c; } }
        else {
#pragma unroll
            for (int r = 0; r < 16; ++r) { const int d0 = qpos - kt * 64 - crow(r, hi);
                if (T5_EXT) { c0[r] = tb[d0] - mref; c1[r] = tb[d0 - 32] - mref; }
                else { c0[r] = tb[min(max(d0, 0), 127)] - mref; c1[r] = tb[min(max(d0 - 32, 0), 127)] - mref; } } } }
    __device__ __forceinline__ void bias_raw(int kt, f32x16& c0, f32x16& c1) const {
#pragma unroll
        for (int r = 0; r < 16; ++r) { const int d0 = qpos - kt * 64 - crow(r, hi); c0[r] = tb[min(max(d0, 0), 127)]; c1[r] = tb[min(max(d0 - 32, 0), 127)]; } }
    __device__ __forceinline__ void post(int kt, f32x16& p0, f32x16& p1) const {
        if ((!T5_EXT && q0w - (kt * 64 + 63) < 0) || q0w + 31 - kt * 64 >= window) {
#pragma unroll
            for (int r = 0; r < 16; ++r) { const int d0 = qpos - kt * 64 - crow(r, hi), d1 = d0 - 32; if (d0 < 0 || d0 >= window) p0[r] = NEG; if (d1 < 0 || d1 >= window) p1[r] = NEG; } }
        if (!FOLD_MASK && use_mask) { const bool en = ((mask >> kt) & 1u) != 0u;
            if (!__all(en)) {
#pragma unroll
                for (int r = 0; r < 16; ++r) { p0[r] = en ? p0[r] : NEG; p1[r] = en ? p1[r] : NEG; } } } } };
}
#ifndef STAGE_LIMIT
#define STAGE_LIMIT 4
#endif
constexpr size_t MiB = 1u << 20;
constexpr size_t WS_CTL = 0, CTL_ZERO_BYTES = 64 * 1024;
constexpr size_t WS_SS = 256 * 1024;
constexpr size_t WS_SSQ = 320 * 1024;
constexpr size_t WS_SSM = 720 * 1024;
constexpr size_t WS_F32S = 2 * MiB;
constexpr size_t WS_CUM = 4 * MiB;
constexpr size_t WS_MASK = 4 * MiB + 512 * 1024;
constexpr size_t WS_UMASK = WS_MASK + 128 * 1024;
constexpr size_t WS_KC = 5 * MiB, WS_VC = 5 * MiB + 256 * 1024;
constexpr size_t WS_KMAX = 5 * MiB + 512 * 1024;
constexpr size_t WS_POSCP = 5 * MiB + 768 * 1024;
constexpr size_t WS_POSC = 32 * 1024;
constexpr size_t WS_WGU1 = 8 * MiB, WS_WD1 = 19 * MiB, WS_WIN = 25 * MiB, WS_WUPN = 35 * MiB, WS_WUPF = 36 * MiB, WS_WOUT = 37 * MiB, WS_WMQ = 39 * MiB,
                 WS_WMKV = 41 * MiB, WS_WMO = 45 * MiB, WS_WGU2 = 47 * MiB, WS_WD2 = 58 * MiB, WS_CW1K = 64 * MiB, WS_CW1V = 65 * MiB, WS_CW2K = 66 * MiB, WS_CW2V = 66 * MiB + 256 * 1024;
constexpr size_t WS_KVM = 8 * MiB;
constexpr size_t WS_XB = 68 * MiB;
constexpr size_t WS_QN = 100 * MiB, WS_KVN = 116 * MiB, WS_QF = 140 * MiB, WS_KVF = 156 * MiB, WS_GAB = 188 * MiB;
constexpr size_t WS_H = 100 * MiB;
constexpr size_t WS_Y = WS_KVF;
constexpr size_t WS_MT = 188 * MiB, WS_NT = 204 * MiB, WS_PM = 220 * MiB;
constexpr size_t WS_MEMB = 252 * MiB, WS_END = 256 * MiB;
static_assert(WS_WD2 + (size_t)DM * FF * 2 <= WS_CW1K && WS_GAB + (size_t)M * 2048 * 2 <= WS_MEMB && WS_H + (size_t)M * FF * 2 <= WS_GAB, "ws map");
constexpr int CW_BAR = 4096;
constexpr size_t WS_XBUF = 1 * MiB;
constexpr size_t WS_FOXQ = 60 * 1024;
constexpr size_t WS_FINCNT = 40 * 1024;
constexpr int RING_BYTES = 131072, LDS_BYTES = 147456;

__device__ const unsigned char T5B[128] = {0, 1, 2, 3, 4, 5, 6, 7, 8, 9, 10, 11, 12, 13, 14, 15, 16, 16, 16, 17, 17, 18, 18, 18, 19, 19, 19, 20, 20, 20, 20, 21, 21, 21, 21, 22, 22, 22, 22, 22, 23, 23, 23, 23, 23, 23, 24, 24, 24, 24, 24, 24, 25, 25, 25, 25, 25, 25, 25, 26, 26, 26, 26, 26, 26, 26, 26, 27, 27, 27, 27, 27, 27, 27, 27, 27, 27, 28, 28, 28, 28, 28, 28, 28, 28, 28, 28, 29, 29, 29, 29, 29, 29, 29, 29, 29, 29, 29, 29, 30, 30, 30, 30, 30, 30, 30, 30, 30, 30, 30, 30, 30, 30, 31, 31, 31, 31, 31, 31, 31, 31, 31, 31, 31, 31, 31, 31, 31};


#define XB_TMO      128
#define XB_XCNT(j)  (256  + 64 * (j))
#define XB_XSUB(j)  (1280 + 64 * (j))
#define XB_XGEN(j)  (2304 + 64 * (j))
#define XB_TOP      3328
#define XB_TOPGEN   3392
#define XCD_BAR_WORDS 3456
#define XB_SPIN_CAP (1u << 18)
__device__ __forceinline__ unsigned xb_ld(unsigned* p)              { return __hip_atomic_load(p, __ATOMIC_RELAXED, __HIP_MEMORY_SCOPE_AGENT); }
__device__ __forceinline__ unsigned xb_add(unsigned* p, unsigned v) { return __hip_atomic_fetch_add(p, v, __ATOMIC_RELAXED, __HIP_MEMORY_SCOPE_AGENT); }
__device__ __forceinline__ unsigned xb_xcc_id() { return (unsigned)__builtin_amdgcn_s_getreg((3 << 11) | 20) & 0xFu; }
#define XB_SPIN(cond, bar) do { unsigned _sp = 0; while (cond) { __builtin_amdgcn_s_sleep(1); \
    if ((++_sp & 255u) == 0u) { if (xb_ld(&(bar)[XB_TMO])) break; if (_sp > XB_SPIN_CAP) { atomicAdd(&(bar)[XB_TMO], 1u); break; } } } } while (0)
struct XcdBarrier { unsigned* bar; unsigned x; volatile LAS unsigned* st; };
__device__ __forceinline__ XcdBarrier xcd_barrier_post(unsigned* bar, volatile LAS unsigned* st) {
    XcdBarrier b; b.bar = bar; b.x = xb_xcc_id(); b.st = st;
    if (threadIdx.x == 0) (void)xb_add(&bar[XB_XCNT(b.x)], 1u);
    return b;
}
__device__ __forceinline__ void xcd_barrier_complete(unsigned* bar, unsigned x, unsigned& nloc, unsigned& nx) {
    const unsigned G = gridDim.x * gridDim.y * gridDim.z;
    unsigned sum, cnt, mine, sp = 0u;
    for (;;) {
        sum = 0u; cnt = 0u; mine = 0u;
#pragma unroll
        for (unsigned j = 0; j < 16; ++j) { const unsigned c = xb_ld(&bar[XB_XCNT(j)]); sum += c; cnt += (c > 0u) ? 1u : 0u; mine = (j == x) ? c : mine; }
        if (sum == G) break;
        __builtin_amdgcn_s_sleep(1);
        if ((++sp & 255u) == 0u) { if (xb_ld(&bar[XB_TMO])) break; if (sp > XB_SPIN_CAP) { atomicAdd(&bar[XB_TMO], 1u); break; } }
    }
    nloc = mine > 0u ? mine : 1u; nx = cnt > 0u ? cnt : 1u;
}
__device__ __forceinline__ void xcd_barrier(const XcdBarrier& b) {
    asm volatile("s_waitcnt vmcnt(0)" ::: "memory");
    __syncthreads();
    if (threadIdx.x == 0) {
        unsigned* bar = b.bar;
        __builtin_amdgcn_s_waitcnt(0);
        unsigned nloc = b.st[0], nx = b.st[1];
        if (nloc == 0u) { xcd_barrier_complete(bar, b.x, nloc, nx); b.st[0] = nloc; b.st[1] = nx; }
        const unsigned old = xb_add(&bar[XB_XSUB(b.x)], 1u);
        const unsigned gen = old / nloc;
        if (old + 1u == (gen + 1u) * nloc) {
            __builtin_amdgcn_fence(__ATOMIC_RELEASE, "agent");
            asm volatile("s_waitcnt vmcnt(0)" ::: "memory");
            const unsigned og = xb_add(&bar[XB_TOP], 1u);
            const unsigned tg = og / nx;
            if (og + 1u == (tg + 1u) * nx) xb_add(&bar[XB_TOPGEN], 1u);
            else XB_SPIN(xb_ld(&bar[XB_TOPGEN]) == tg, bar);
            __builtin_amdgcn_fence(__ATOMIC_ACQUIRE, "agent");
            xb_add(&bar[XB_XGEN(b.x)], 1u);
            asm volatile("s_waitcnt vmcnt(0)" ::: "memory");
        } else {
            XB_SPIN(xb_ld(&bar[XB_XGEN(b.x)]) == gen, bar);
            __builtin_amdgcn_fence(__ATOMIC_ACQUIRE, "agent");
            asm volatile("s_waitcnt vmcnt(0)" ::: "memory");
        }
    }
    __syncthreads();
}

struct Args { const float* in[29]; float* out; unsigned char* ws; int lo, hi; };
enum { I_X = 0, I_MEM, I_RELB, I_F1N, I_F1G, I_F1U, I_F1D, I_MIXN, I_WIN, I_BF, I_POSK, I_POSV, I_CK1, I_CK2, I_CV1, I_CV2, I_UPN, I_UPF, I_WOUT, I_MQN, I_MKVN, I_MWQ, I_MWKV, I_MWO, I_F2N, I_F2G, I_F2U, I_F2D, I_FINN };

__device__ __forceinline__ float wave_sum(float v) {
#pragma unroll
    for (int o = 1; o < 64; o <<= 1) v += __shfl_xor(v, o);
    return v;
}
#ifndef CMP_FRAG
#define CMP_FRAG 0
#endif
struct ItemD { const float* wp; const float* gp; bf16_t* wt; int ldsrc, K, k0, dstrow0; float scl; bool zero, frag; };
struct ItemR { f32x4 v[8]; float gk[8]; };
__device__ __forceinline__ void cm_plain(int n, int off, int& sc) { sc = n + off; }
__device__ __forceinline__ void cm_win(int n, int& sc, float& scl) {
    scl = 1.f;
    if (n < 512) { sc = n; scl = QS64; }
    else if (n < 1280) sc = n;
    else if (n < 1792) { sc = 1304 + (n - 1280); scl = QS64; }
    else if (n < 2816) sc = 1816 + (n - 1792);
    else if (n < 4864) sc = 2848 + (n - 2816);
    else if (n < 4888) sc = 1280 + (n - 4864);
    else if (n < 4896) sc = 2840 + (n - 4888);
    else sc = -1; }
constexpr int N_GU = 16 * 176, N_D = 44 * 32, N_WIN = 16 * 160, N_UP = 8 * 32, N_SQ = 16 * 32, N_MKV = 16 * 64, N_C1 = 32 * 8, N_C2 = 4 * 2;
constexpr int CONV_NA = N_GU + N_D + N_WIN + N_MKV + 2 * N_C1 + 2 * N_C2, CONV_NB = N_GU + N_D + 2 * N_UP + 3 * N_SQ;
__device__ __forceinline__ ItemD conv_decode(const Args& a, int it, int lane) {
    unsigned char* ws = a.ws; int r = it; ItemD d; const int c4 = lane & 7, kr = lane >> 3;
    const float* W; int ldsrc, K, kb, dr, off = 0; const float* gain = nullptr; bf16_t* wt; float scl = 1.f; bool win = false, frag = false;
    const int f = r >= CONV_NA; if (f) r -= CONV_NA;
    if (r < N_GU) { kb = r / 176; const int gi = r % 176; dr = gi * 32; const int tile = dr >> 8, within = dr & 255;
        W = a.in[within < 128 ? (f ? I_F2G : I_F1G) : (f ? I_F2U : I_F1U)]; ldsrc = FF; K = DM; wt = (bf16_t*)(ws + (f ? WS_WGU2 : WS_WGU1)); gain = a.in[f ? I_F2N : I_F1N]; off = tile * 128 + (within & 127) - dr; }
    else if ((r -= N_GU) < N_D) { kb = r / 32; dr = (r % 32) * 32; W = a.in[f ? I_F2D : I_F1D]; ldsrc = DM; K = FF; wt = (bf16_t*)(ws + (f ? WS_WD2 : WS_WD1)); }
    else if (!f) { r -= N_D;
        if (r < N_WIN) { kb = r / 160; dr = (r % 160) * 32; W = a.in[I_WIN]; ldsrc = 4896; K = DM; wt = (bf16_t*)(ws + WS_WIN); gain = a.in[I_MIXN]; win = true; }
        else if ((r -= N_WIN) < N_MKV) { kb = r / 64; dr = (r % 64) * 32; W = a.in[I_MWKV]; ldsrc = 2048; K = DM; wt = (bf16_t*)(ws + WS_WMKV); gain = a.in[I_MKVN]; }
        else if ((r -= N_MKV) < 2 * N_C1) { const int g = r >= N_C1; r -= g * N_C1; kb = r / 8; dr = (r % 8) * 32; W = a.in[g ? I_CV1 : I_CK1]; ldsrc = 256; K = 2048; wt = (bf16_t*)(ws + (g ? WS_CW1V : WS_CW1K)); frag = CMP_FRAG != 0; }
        else { r -= 2 * N_C1; const int g = r >= N_C2; r -= g * N_C2; kb = r / 2; dr = (r % 2) * 32; W = a.in[g ? I_CV2 : I_CK2]; ldsrc = 64; K = 256; wt = (bf16_t*)(ws + (g ? WS_CW2V : WS_CW2K)); }
    } else { r -= N_D;
        if (r < 2 * N_UP) { const int g = r >= N_UP; r -= g * N_UP; kb = r / 32; dr = (r % 32) * 32; W = a.in[g ? I_UPF : I_UPN]; ldsrc = DM; K = 512; wt = (bf16_t*)(ws + (g ? WS_WUPF : WS_WUPN)); }
        else { r -= 2 * N_UP; const int g = r / N_SQ; r -= g * N_SQ; kb = r / 32; dr = (r % 32) * 32; W = a.in[g == 0 ? I_WOUT : (g == 1 ? I_MWQ : I_MWO)]; ldsrc = DM; K = DM;
            wt = (bf16_t*)(ws + (g == 0 ? WS_WOUT : (g == 1 ? WS_WMQ : WS_WMO))); if (g == 1) { W = a.in[I_MWO]; wt = (bf16_t*)(ws + WS_WMO); } }
    }
    int sc; if (win) cm_win(dr + 4 * c4, sc, scl); else cm_plain(dr + 4 * c4, off, sc);
    d.zero = sc < 0; d.wp = W + (size_t)(kb * 64 + kr) * ldsrc + (sc < 0 ? 0 : sc); d.gp = gain ? gain + kb * 64 + kr : nullptr; d.wt = wt; d.ldsrc = ldsrc; d.K = K; d.k0 = kb * 64; d.dstrow0 = dr; d.scl = scl; d.frag = frag;
    return d;
}
__device__ __forceinline__ void conv_load(const ItemD& d, ItemR& r) {
#pragma unroll
    for (int i = 0; i < 8; ++i) { r.v[i] = d.zero ? (f32x4){0.f, 0.f, 0.f, 0.f} : __builtin_nontemporal_load((const f32x4*)(d.wp + (size_t)(8 * i) * d.ldsrc)); r.gk[i] = d.gp ? d.gp[8 * i] : 1.f; }
}
__device__ __forceinline__ void conv_finish(const ItemD& d, const ItemR& r, LAS float* scr, int lane) {
    const int kr = lane >> 3, c4 = lane & 7;
#pragma unroll
    for (int i = 0; i < 8; ++i) { const int kk = 8 * i + kr; const float s = r.gk[i] * d.scl; LAS float* p = scr + kk * 33 + 4 * c4; p[0] = r.v[i][0] * s; p[1] = r.v[i][1] * s; p[2] = r.v[i][2] * s; p[3] = r.v[i][3] * s; }
    asm volatile("s_waitcnt lgkmcnt(0)" ::: "memory");
    const int c = lane & 7;
#pragma unroll
    for (int j = 0; j < 4; ++j) { const int nn = (lane >> 3) + 8 * j; const LAS float* s = scr + (8 * c) * 33 + nn;
        u32x4 o; o.x = cvtpk(s[0 * 33], s[1 * 33]); o.y = cvtpk(s[2 * 33], s[3 * 33]); o.z = cvtpk(s[4 * 33], s[5 * 33]); o.w = cvtpk(s[6 * 33], s[7 * 33]);
        bf16_t* dst = d.frag ? d.wt + ((size_t)((d.dstrow0 >> 5) * 128 + (d.k0 >> 4) + (c >> 1)) * 64 + (c & 1) * 32 + nn) * 8 : d.wt + (size_t)(d.dstrow0 + nn) * d.K + d.k0 + 8 * c;
        *(u32x4*)dst = o; }
    asm volatile("s_waitcnt lgkmcnt(0)" ::: "memory");
}
__device__ __forceinline__ void conv_run(const Args& a, int it0, int itend, int stride, LAS float* scr, int lane) {
    if (it0 >= itend) return;
    ItemD d0 = conv_decode(a, it0, lane); ItemR r0; conv_load(d0, r0);
    for (int it = it0 + stride; ; it += stride) {
        const bool more = it < itend;
        ItemD d1; ItemR r1;
        if (more) { d1 = conv_decode(a, it, lane); conv_load(d1, r1); }
        conv_finish(d0, r0, scr, lane);
        if (!more) break;
        d0 = d1; r0 = r1;
    }
}

__device__ __forceinline__ int convb_item(int v) { return CONV_NA + (v < N_GU ? v : v + N_D); }
__device__ __forceinline__ void conv_run_b(const Args& a, int v0, int stride, LAS float* scr, int lane) {
    constexpr int NV = N_GU + 2 * N_UP + 3 * N_SQ;
    if (v0 >= NV) return;
    ItemD d0 = conv_decode(a, convb_item(v0), lane); ItemR r0; conv_load(d0, r0);
    for (int v = v0 + stride; ; v += stride) {
        const bool more = v < NV;
        ItemD d1; ItemR r1;
        if (more) { d1 = conv_decode(a, convb_item(v), lane); conv_load(d1, r1); }
        conv_finish(d0, r0, scr, lane);
        if (!more) break;
        d0 = d1; r0 = r1;
    }
}
#ifndef P0_WT16
#define P0_WT16 0
#endif
__device__ __forceinline__ void p0_prologue(const Args& a, LAS unsigned char* lds, int gw, int NGW, int wave, int lane) {
    unsigned char* ws = a.ws;
    LAS float* scr = (LAS float*)(lds + wave * 16384);
    conv_run(a, gw, N_GU, NGW, scr, lane);
    { f32x4* z = (f32x4*)(ws + WS_SSQ); for (int i = gw * 64 + lane; i < 3 * M / 2; i += NGW * 64) z[i] = (f32x4){0.f, 0.f, 0.f, 0.f}; }
    for (int mrow = gw; mrow < M + MROWS; mrow += NGW) {
        const bool ismem = mrow >= M; const int rr = ismem ? mrow - M : mrow;
#if P0_WT16
        const f32x4* xr = (const f32x4*)((ismem ? a.in[I_MEM] : a.in[I_X]) + (size_t)rr * DM) + 2 * lane;
        bf16_t* ob = (bf16_t*)(ws + (ismem ? WS_MEMB : WS_XB));
        float s = 0.f; f32x4 v[4];
#pragma unroll
        for (int j = 0; j < 2; ++j) { v[2 * j] = __builtin_nontemporal_load(xr + 128 * j); v[2 * j + 1] = __builtin_nontemporal_load(xr + 128 * j + 1); }
#pragma unroll
        for (int j = 0; j < 4; ++j) s += (v[j][0] * v[j][0] + v[j][1] * v[j][1]) + (v[j][2] * v[j][2] + v[j][3] * v[j][3]);
#pragma unroll
#if P0_WT16 == 2
        for (int j = 0; j < 2; ++j) *(u32x4*)(ob + (size_t)rr * DM + 512 * j + 8 * lane) = pack8(v[2 * j], v[2 * j + 1]);
#else
        for (int j = 0; j < 2; ++j) ST16(ob, (size_t)rr * DM + 512 * j + 8 * lane, pack8(v[2 * j], v[2 * j + 1]));
#endif
#else
        const f32x4* xr = (const f32x4*)((ismem ? a.in[I_MEM] : a.in[I_X]) + (size_t)rr * DM) + lane;
        unsigned long long* o8 = (unsigned long long*)((bf16_t*)(ws + (ismem ? WS_MEMB : WS_XB)) + (size_t)rr * DM) + lane;
        float s = 0.f; f32x4 v[4];
#pragma unroll
        for (int j = 0; j < 4; ++j) v[j] = __builtin_nontemporal_load(xr + 64 * j);
#pragma unroll
        for (int j = 0; j < 4; ++j) { s += (v[j][0] * v[j][0] + v[j][1] * v[j][1]) + (v[j][2] * v[j][2] + v[j][3] * v[j][3]);
            o8[64 * j] = (unsigned long long)cvtpk(v[j][0], v[j][1]) | ((unsigned long long)cvtpk(v[j][2], v[j][3]) << 32); }
#endif
        s = wave_sum(s);
        if (lane == 0) ((float*)(ws + (ismem ? WS_SSM : WS_SS)))[rr] = s;
    }
    for (int t = gw; t < 64; t += NGW) { const int kv = t >> 5, kc = (t & 31) * 64; const float* pos = a.in[kv ? I_POSV : I_POSK] + kc; const f32x4* w1 = (const f32x4*)(a.in[kv ? I_CV1 : I_CK1] + (size_t)kc * 256) + lane;
        f32x4 s = {0.f, 0.f, 0.f, 0.f};
#pragma unroll 8
        for (int k = 0; k < 64; ++k) s += w1[(size_t)k * 64] * pos[k];
        *(f32x4*)((float*)(ws + WS_POSCP) + ((t & 31) * 2 + kv) * 256 + 4 * lane) = s; }
}

__device__ __forceinline__ void wqn_rows(const Args& a, int w0, int nw, int lane) {
    for (int d = w0; d < DM; d += nw) { const float s = a.in[I_MQN][d] * QS256; const f32x4* xr = (const f32x4*)(a.in[I_MWQ] + (size_t)d * DM) + lane;
        unsigned long long* o8 = (unsigned long long*)((bf16_t*)(a.ws + WS_WMQ) + (size_t)d * DM) + lane; f32x4 v[4];
#pragma unroll
        for (int j = 0; j < 4; ++j) v[j] = __builtin_nontemporal_load(xr + 64 * j);
#pragma unroll
        for (int j = 0; j < 4; ++j) o8[64 * j] = (unsigned long long)cvtpk(v[j][0] * s, v[j][1] * s) | ((unsigned long long)cvtpk(v[j][2] * s, v[j][3] * s) << 32); }
}
__device__ __forceinline__ void compress_unit(const Args& a, LAS unsigned char* lds, int uidx) {
    unsigned char* ws = a.ws;
    const int tid = fresh_tid(), lane = tid & 63, r32 = lane & 31, hi = lane >> 5, wid = __builtin_amdgcn_readfirstlane(tid >> 6);
    const int kv = uidx >> 6, b = (uidx >> 3) & 7, g = (uidx >> 2) & 1, chunk = uidx & 3, n0 = chunk * 32;
    const bf16_t* W1 = (const bf16_t*)(ws + (kv ? WS_CW1V : WS_CW1K)); const bf16_t* W2 = (const bf16_t*)(ws + (kv ? WS_CW2V : WS_CW2K));
#ifdef CMP_OLD
    const float* poscp = (const float*)(ws + WS_POSCP) + kv * 256;
#else
    const float pc0 = ((const float*)(ws + WS_POSC))[kv * 256 + 32 * wid + r32];
    const int rot = (uidx & 7) * 16;
#endif
    const bf16_t* asrc = (const bf16_t*)(ws + WS_KVN) + (size_t)(b * SEQ) * 768 + kv * 128 + g * 64;
    LAS bf16_t* As = (LAS bf16_t*)lds;
    { u32x4 stg[9];
#pragma unroll
      for (int q = 0; q < 9; ++q) { const int i = tid + q * 512; const int row = min(i >> 3, 527), ch = i & 7; const int t = min(16 * n0 + row, SEQ - 1); stg[q] = *(const u32x4*)(asrc + (size_t)t * 768 + ch * 8); }
#pragma unroll
      for (int q = 0; q < 9; ++q) { const int i = tid + q * 512; const int row = i >> 3, ch = i & 7; if (i < 528 * 8) *(LAS u32x4*)(As + row * 64 + ((ch ^ ((row >> 4) & 7)) * 8)) = stg[q]; } }
    __syncthreads();
    const bf16_t* brow = W1 + (size_t)(32 * wid + r32) * 2048 + hi * 8;
    f32x16 acc = f32x16{}, accb = f32x16{};
#ifdef CMP_OLD2
#pragma unroll 8
    for (int kq = 0; kq < 128; kq += 2) {
#ifdef CMP_OLD
        const int kk = kq;
#else
        const int kk = (kq + rot) & 127;
#endif
        { const int l = kk >> 2, dch = (kk & 3) * 2 + hi, row = 16 * r32 + l;
          const bf16x8 av = *(const LAS bf16x8*)(As + row * 64 + ((dch ^ ((row >> 4) & 7)) * 8)); const bf16x8 bv = *(const bf16x8*)(brow + kk * 16);
          acc = __builtin_amdgcn_mfma_f32_32x32x16_bf16(av, bv, acc, 0, 0, 0); }
        { const int k1 = kk + 1, l = k1 >> 2, dch = (k1 & 3) * 2 + hi, row = 16 * r32 + l;
          const bf16x8 av = *(const LAS bf16x8*)(As + row * 64 + ((dch ^ ((row >> 4) & 7)) * 8)); const bf16x8 bv = *(const bf16x8*)(brow + k1 * 16);
          accb = __builtin_amdgcn_mfma_f32_32x32x16_bf16(av, bv, accb, 0, 0, 0); } }
#else
    {
        bf16x8 bA[16], bB[16];
        const int r0 = uidx & 7;
#if CMP_FRAG
#define CMP_LOAD(bb, g_) do { const bf16_t* p_ = W1 + ((size_t)(wid * 128 + (((g_) + r0) & 7) * 16) * 64 + lane) * 8; _Pragma("unroll") for (int j = 0; j < 16; ++j) bb[j] = *(const bf16x8*)(p_ + j * 512); } while (0)
#else
#define CMP_LOAD(bb, g_) do { const bf16_t* p_ = brow + (((g_) + r0) & 7) * 256; _Pragma("unroll") for (int j = 0; j < 16; ++j) bb[j] = *(const bf16x8*)(p_ + j * 16); } while (0)
#endif
#define CMP_COMP(bb, g_) do { const int k0_ = (((g_) + r0) & 7) * 16; _Pragma("unroll") for (int j = 0; j < 16; ++j) { const int kk = k0_ + j, l = kk >> 2, dch = (kk & 3) * 2 + hi, row = 16 * r32 + l; \
            const bf16x8 av = *(const LAS bf16x8*)(As + row * 64 + ((dch ^ ((row >> 4) & 7)) * 8)); \
            if (j & 1) accb = __builtin_amdgcn_mfma_f32_32x32x16_bf16(av, bb[j], accb, 0, 0, 0); else acc = __builtin_amdgcn_mfma_f32_32x32x16_bf16(av, bb[j], acc, 0, 0, 0); } } while (0)
        CMP_LOAD(bA, 0); __builtin_amdgcn_sched_barrier(0);
#pragma unroll 1
        for (int g = 0; g < 8; g += 2) {
            CMP_LOAD(bB, g + 1); __builtin_amdgcn_sched_barrier(0);
            CMP_COMP(bA, g); __builtin_amdgcn_sched_barrier(0);
            if (g + 2 < 8) { CMP_LOAD(bA, g + 2); } __builtin_amdgcn_sched_barrier(0);
            CMP_COMP(bB, g + 1); __builtin_amdgcn_sched_barrier(0);
        }
#undef CMP_LOAD
#undef CMP_COMP
    }
#endif
    acc += accb;
    LAS bf16_t* Hs = (LAS bf16_t*)(lds + 81920);
#ifdef CMP_W2PRE
    bf16x8 w2f[16];
    if (wid < 2) {
#pragma unroll
        for (int kk = 0; kk < 16; ++kk) w2f[kk] = *(const bf16x8*)(W2 + (size_t)(32 * wid + r32) * 256 + kk * 16 + hi * 8); }
#endif
#ifdef CMP_OLD
    float pc = 0.f;
#pragma unroll 8
    for (int c = 0; c < 32; ++c) pc += poscp[c * 512 + 32 * wid + r32];
#else
    const float pc = pc0;
#endif
#pragma unroll
    for (int r = 0; r < 16; ++r) { const float x = acc[r] + pc; const float u = 0.7978845608028654f * (x + 0.044715f * x * x * x);
        const float ge = x * frcp(1.0f + fexp2(-2.0f * LOG2E * u)); Hs[att::crow(r, hi) * 264 + 32 * wid + r32] = (bf16_t)(cvtpk(ge, 0.f) & 0xffffu); }
    __syncthreads();
    if (wid < 2) { f32x16 acc2 = f32x16{};
#pragma unroll
        for (int kk = 0; kk < 16; ++kk) { const bf16x8 av = *(const LAS bf16x8*)(Hs + r32 * 264 + kk * 16 + hi * 8);
#ifdef CMP_W2PRE
            const bf16x8 bv = w2f[kk];
#else
            const bf16x8 bv = *(const bf16x8*)(W2 + (size_t)(32 * wid + r32) * 256 + kk * 16 + hi * 8);
#endif
            acc2 = __builtin_amdgcn_mfma_f32_32x32x16_bf16(av, bv, acc2, 0, 0, 0); }
        bf16_t* outp = (bf16_t*)(ws + (kv ? WS_VC : WS_KC)) + (size_t)((b * 2 + g) * 128) * 64;
#pragma unroll
        for (int r = 0; r < 16; ++r) { const int n = n0 + att::crow(r, hi); const float v = n < 127 ? acc2[r] : 0.f; outp[(size_t)n * 64 + 32 * wid + r32] = (bf16_t)(cvtpk(v, 0.f) & 0xffffu); } }
    __syncthreads();
}
__device__ __forceinline__ void kmax_task(const Args& a, LAS unsigned char* lds, const bf16_t* K, int pitch, float* outp, int wave, int lane) {
    float mx = 0.f;
#pragma unroll
    for (int rr = 0; rr < 4; ++rr) { const u32x4* p = (const u32x4*)(K + (size_t)(wave * 256 + rr * 64 + lane) * pitch); float ss = 0.f;
#pragma unroll
        for (int c = 0; c < 8; ++c) { const u32x4 v = p[c]; ss += (bflo(v.x) * bflo(v.x) + bfhi(v.x) * bfhi(v.x)) + (bflo(v.y) * bflo(v.y) + bfhi(v.y) * bfhi(v.y)) + (bflo(v.z) * bflo(v.z) + bfhi(v.z) * bfhi(v.z)) + (bflo(v.w) * bflo(v.w) + bfhi(v.w) * bfhi(v.w)); }
        mx = fmaxf(mx, ss); }
#pragma unroll
    for (int o = 1; o < 64; o <<= 1) mx = fmaxf(mx, __shfl_xor(mx, o));
    LAS float* red = (LAS float*)(lds + 120 * 1024);
    if (lane == 0) red[wave] = mx;
    __syncthreads();
    if (wave == 0 && lane == 0) { float m2 = red[0]; for (int i = 1; i < 8; ++i) m2 = fmaxf(m2, red[i]); *outp = sqrtf(m2) * 1.01f; }
    __syncthreads();
}
__device__ __forceinline__ void cumsum_task8(const Args& a, LAS unsigned char* lds, int task, int wave, int lane) {
    const int b = task >> 3, h = task & 7; const float bf = a.in[I_BF][h];
    const float* fl = (const float*)(a.ws + WS_F32S) + (size_t)(b * SEQ + wave * 256) * 32 + 24 + h; float* out = (float*)(a.ws + WS_CUM) + (size_t)task * SEQ + wave * 256;
    float v[4], res[4];
#pragma unroll
    for (int i = 0; i < 4; ++i) v[i] = fl[(size_t)(64 * i + lane) * 32];
    float carry = 0.f;
#pragma unroll
    for (int i = 0; i < 4; ++i) { const float x = v[i] + bf; float inc = fminf(x, 0.f) - log1pf(expf(-fabsf(x)));
#pragma unroll
        for (int o = 1; o < 64; o <<= 1) { const float t = __shfl_up(inc, o); if (lane >= o) inc += t; }
        inc += carry; res[i] = inc; carry = __shfl(inc, 63); }
    LAS float* red = (LAS float*)(lds + 120 * 1024 + 64);
    if (lane == 0) red[wave] = carry;
    __syncthreads();
    float pre = 0.f;
    for (int w = 0; w < wave; ++w) pre += red[w];
#pragma unroll
    for (int i = 0; i < 4; ++i) out[64 * i + lane] = -(res[i] + pre) * LOG2E;
}
__device__ __forceinline__ void cumsum_task(const Args& a, int task, int lane) {
    const int b = task >> 3, h = task & 7; const float bf = a.in[I_BF][h];
    const float* fl = (const float*)(a.ws + WS_F32S) + (size_t)(b * SEQ) * 32 + 24 + h; float* out = (float*)(a.ws + WS_CUM) + (size_t)task * SEQ;
    float v[32];
#pragma unroll
    for (int i = 0; i < 32; ++i) v[i] = fl[(size_t)(64 * i + lane) * 32];
    float carry = 0.f;
#pragma unroll
    for (int i = 0; i < 32; ++i) { const float x = v[i] + bf; float inc = fminf(x, 0.f) - log1pf(expf(-fabsf(x)));
#pragma unroll
        for (int o = 1; o < 64; o <<= 1) { const float t = __shfl_up(inc, o); if (lane >= o) inc += t; }
        inc += carry; out[64 * i + lane] = -inc * LOG2E; carry = __shfl(inc, 63); }
}

__device__ __forceinline__ void init_t5_table(const Args& a, LAS unsigned char* lds) {
    LAS float* T = (LAS float*)(lds + att::L_TBL);
    for (int i = fresh_tid(); i < 8 * att::T5_W; i += 512) { const int h = i / att::T5_W, d = i % att::T5_W - att::T5_P; T[i] = d < 0 ? att::NEG : a.in[I_RELB][T5B[d > 127 ? 127 : d] * 8 + h] * LOG2E; }
    { const int t = fresh_tid(); if (t < 8) { float mx = -3.0e38f; for (int bk = 0; bk < 32; ++bk) mx = fmaxf(mx, a.in[I_RELB][bk * 8 + t] * LOG2E); ((LAS float*)(lds + att::L_TBM))[t] = mx; } }
}
#ifndef ATT_PRE_MASK
#define ATT_PRE_MASK 7
#endif
#define FOX_PRE ((ATT_PRE_MASK & 1) ? 5 : 0)
#define NSA_PRE(P, N) (((P) == 7 && (ATT_PRE_MASK & ((N) == 4 ? 2 : 4))) ? (N) : 0)
template <bool DRY> __device__ __forceinline__ void fox_unit(const Args& a, LAS unsigned char* lds, int b, int h, int qb, int par) {
    using namespace att;
    unsigned char* ws = a.ws;
    const int tid = fresh_tid(), lane = tid & 63, r32 = lane & 31, hi = lane >> 5, wid = __builtin_amdgcn_readfirstlane(tid >> 6);
    const int q0 = qb * 256, q0w = q0 + wid * 32, qpos = q0w + r32;
    LAS float* cb = (LAS float*)(lds + L_CB); LAS float* wsf = (LAS float*)(lds + L_WSF) + wid * 64;
    const float* cum = (const float*)(ws + WS_CUM) + (size_t)(b * 8 + h) * SEQ;
#if (ATT_PRE_MASK & 1)
    if (!DRY) { const bf16_t* Kp = (const bf16_t*)(ws + WS_KVF) + (size_t)(b * SEQ) * 1024 + h * 64;
        attn_pre<5>(4 * qb + 3, 4 * qb + 2, 4 * qb + 1, Kp, 1024, Kp + 512, 1024, lds); }
#endif
    { float cv[4];
#pragma unroll
      for (int q = 0; q < 4; ++q) { const int i = tid + q * 512; cv[q] = cum[i < q0 + 256 ? i : 0]; }
#pragma unroll
      for (int q = 0; q < 4; ++q) { const int i = tid + q * 512; if (i < q0 + 256) cb[i] = cv[q]; } }
    bf16_t* Qw = (bf16_t*)(ws + WS_QF) + (size_t)(b * SEQ + q0w) * 512 + h * 64;
    bf16x8 qr[4]; load_q(qr, Qw, 512, r32, hi);
    f32x16 o[2]; o[0] = f32x16{}; o[1] = f32x16{}; float m = 0.f, l = 0.f;
    const int nt = 4 * qb + 4; unsigned tmask = nt >= 32 ? 0xffffffffu : ((1u << nt) - 1u);
    const bf16_t* Kg = (const bf16_t*)(ws + WS_KVF) + (size_t)(b * SEQ) * 1024 + h * 64;
    const float cb0 = cum[q0], cbt = cum[64 * (lane < nt ? lane : 0) + 63], cbq = cum[qpos], kmx = ((const float*)(ws + WS_KMAX))[b * 8 + h];
    float qq = 0.f;
#pragma unroll
    for (int d0 = 0; d0 < 4; ++d0) { const u32x4 v = __builtin_bit_cast(u32x4, qr[d0]);
        qq += (bflo(v.x) * bflo(v.x) + bfhi(v.x) * bfhi(v.x)) + (bflo(v.y) * bflo(v.y) + bfhi(v.y) * bfhi(v.y)) + (bflo(v.z) * bflo(v.z) + bfhi(v.z) * bfhi(v.z)) + (bflo(v.w) * bflo(v.w) + bfhi(v.w) * bfhi(v.w)); }
    qq = halfsum(qq);
    const float qk_bound = sqrtf(qq) * 1.01f * kmx;
    {
        float qm = qq;
#pragma unroll
        for (int o_ = 1; o_ < 32; o_ <<= 1) qm = fmaxf(qm, __shfl_xor(qm, o_));
        LAS float* red = (LAS float*)(lds + L_MISC + 384 + (par & 1) * 32);
        if (lane == 0) red[wid] = qm;
        __syncthreads();
        float qmax = red[0];
#pragma unroll
        for (int i = 1; i < 8; ++i) qmax = fmaxf(qmax, red[i]);
        const float need = 2.0f * sqrtf(qmax) * 1.01f * kmx + 40.0f;
        const bool skip = (lane < 32) && (lane < nt) && (cb0 - cbt >= need);
        const unsigned long long bal = __ballot(skip);
        tmask &= ~(unsigned)bal;
#ifdef DRY_TILES
        if (DRY) { const unsigned full = nt >= 32 ? 0xffffffffu : ((1u << nt) - 1u); tmask = (DRY_TILES == 0 || DRY_TILES >= nt) ? full : (full & ~((1u << (nt - DRY_TILES)) - 1u)); }
#endif
    }
    const float mref0 = cbq + qk_bound; const bool online = __any(qk_bound > 45.0f);
#ifndef FOX_ABL
#define FOX_ABL 0
#endif
    if (DRY) attn_loop2<FOX_ABL>(tmask, Kg, 1024, Kg + 512, 1024, lds, qr, o, m, l, TfFox{cb, qpos, hi, q0w}, q0w + 31, mref0, online);
    else attn_loop2<0, FOX_PRE>(tmask, Kg, 1024, Kg + 512, 1024, lds, qr, o, m, l, TfFox{cb, qpos, hi, q0w}, q0w + 31, mref0, online);
    l = halfsum(l);
    scale_rows(o, wsf, 1.0f / l, r32, hi);
    store_o<false>(o, lds, DRY ? (bf16_t*)((unsigned char*)a.out + 16 * MiB) + (size_t)(b * SEQ + q0w) * 512 + h * 64 : Qw, 512, nullptr, 0);
}
#ifndef CMP_EARLY
#define CMP_EARLY 0
#endif
#ifndef NSA_LDSACC
#define NSA_LDSACC 1
#endif
#ifndef TOPK_KEY
#define TOPK_KEY 0
#endif
template <int PARTS> __device__ __forceinline__ void cmpwin_unit(const Args& a, LAS unsigned char* lds, int b, int g, int qb) {
    using namespace att;
    unsigned char* ws = a.ws;
    const int tid = fresh_tid(), lane = tid & 63, r32 = lane & 31, hi = lane >> 5, wid = __builtin_amdgcn_readfirstlane(tid >> 6);
    const int j = wid >> 1, sub = wid & 1, hg = g * 4 + j, q0w = qb * 64 + sub * 32, qpos = q0w + r32; const size_t qrow = (size_t)b * SEQ + qpos;
    const LAS float* tb = (const LAS float*)(lds + L_TBL) + hg * T5_W + T5_P;
    LAS float* wsf = (LAS float*)(lds + L_WSF) + wid * 64; LAS float* PS = (LAS float*)(lds + L_PS); LAS float* IMP = (LAS float*)(lds + L_IMP); LAS unsigned* MW = (LAS unsigned*)(lds + L_MISC);
    const float* gates = (const float*)(ws + WS_F32S) + qrow * 32;
    if (tid == 0) MW[0] = 0u;
    bf16x8 qr[4]; load_q(qr, (const bf16_t*)(ws + WS_QN) + (size_t)(b * SEQ + q0w) * 512 + hg * 64, 512, r32, hi);
#if CMP_EARLY
    const StageGeo sg = stage_geo(tid);
    u32x4 kc_[2], vc_[2];
    { const bf16_t* Kc = (const bf16_t*)(ws + WS_KC) + (size_t)((b * 2 + g) * 128) * 64; const bf16_t* Vc = (const bf16_t*)(ws + WS_VC) + (size_t)((b * 2 + g) * 128) * 64;
#pragma unroll
      for (int t = 0; t < 2; ++t) { kc_[t] = *(const u32x4*)(Kc + (size_t)(t * 64 + sg.krow) * 64 + sg.kcol); vc_[t] = *(const u32x4*)(Vc + (size_t)(t * 64 + sg.vrow) * 64 + sg.vcol); } }
    const float gate_c = gates[hg], gate_s = gates[8 + hg], gate_w = gates[16 + hg];
#endif
    const float kmx_s = ((const float*)(ws + WS_KMAX))[64 + (b * 2 + g) * 2], kmx_w = ((const float*)(ws + WS_KMAX))[64 + (b * 2 + g) * 2 + 1];
    float qnrm;
    { float qq = 0.f;
#pragma unroll
      for (int d0 = 0; d0 < 4; ++d0) { const u32x4 v = __builtin_bit_cast(u32x4, qr[d0]);
          qq += (bflo(v.x) * bflo(v.x) + bfhi(v.x) * bfhi(v.x)) + (bflo(v.y) * bflo(v.y) + bfhi(v.y) * bfhi(v.y)) + (bflo(v.z) * bflo(v.z) + bfhi(v.z) * bfhi(v.z)) + (bflo(v.w) * bflo(v.w) + bfhi(v.w) * bfhi(v.w)); }
      qnrm = sqrtf(halfsum(qq)) * 1.01f; }
#if !CMP_EARLY
    const StageGeo sg = stage_geo(tid);
    u32x4 kc_[2], vc_[2];
    { const bf16_t* Kc = (const bf16_t*)(ws + WS_KC) + (size_t)((b * 2 + g) * 128) * 64; const bf16_t* Vc = (const bf16_t*)(ws + WS_VC) + (size_t)((b * 2 + g) * 128) * 64;
#pragma unroll
        for (int t = 0; t < 2; ++t) { kc_[t] = *(const u32x4*)(Kc + (size_t)(t * 64 + sg.krow) * 64 + sg.kcol); vc_[t] = *(const u32x4*)(Vc + (size_t)(t * 64 + sg.vrow) * 64 + sg.vcol); } }
    const float gate_c = gates[hg], gate_s = gates[8 + hg], gate_w = gates[16 + hg];
#endif
    {
#if !ENDWAIT
        asm volatile("s_waitcnt vmcnt(0)\n\ts_barrier" ::: "memory");
#endif
#pragma unroll
        for (int t = 0; t < 2; ++t) { *(LAS u32x4*)(lds + L_SLOT + t * 16384 + sg.koff) = kc_[t]; *(LAS u32x4*)(lds + L_SLOT + t * 16384 + sg.voff) = vc_[t]; } }
    __syncthreads();
    if (PARTS & 1) {
        f32x16 oc[2]; oc[0] = f32x16{}; oc[1] = f32x16{};
        f32x16 a0, a1, b0, b1; qkt(a0, a1, lds + L_SLOT, qr, r32, hi); qkt(b0, b1, lds + L_SLOT + 16384, qr, r32, hi);
        float mx = NEG;
#pragma unroll
        for (int r = 0; r < 16; ++r) { const int d = qpos - 16 * crow(r, hi) - 31;
            a0[r] = d >= 0 ? a0[r] + tb[min(d, 127)] : NEG; a1[r] = d - 512 >= 0 ? a1[r] + tb[min(d - 512, 127)] : NEG;
            b0[r] = d - 1024 >= 0 ? b0[r] + tb[min(d - 1024, 127)] : NEG; b1[r] = d - 1536 >= 0 ? b1[r] + tb[min(d - 1536, 127)] : NEG;
            mx = fmaxf(fmaxf(mx, fmaxf(a0[r], a1[r])), fmaxf(b0[r], b1[r])); }
        { auto rr = __builtin_amdgcn_permlane32_swap(__float_as_uint(mx), __float_as_uint(mx), false, false); mx = fmaxf(__uint_as_float(rr[0]), __uint_as_float(rr[1])); }
        const float mxs = mx == NEG ? 0.f : mx; float s = 0.f;
#pragma unroll
        for (int r = 0; r < 16; ++r) { a0[r] = fexp2(a0[r] - mxs); a1[r] = fexp2(a1[r] - mxs); b0[r] = fexp2(b0[r] - mxs); b1[r] = fexp2(b1[r] - mxs); s += (a0[r] + a1[r]) + (b0[r] + b1[r]); }
        s = halfsum(s); const float inv = s > 0.f ? 1.0f / s : 0.f;
#pragma unroll
        for (int r = 0; r < 16; ++r) { a0[r] *= inv; a1[r] *= inv; b0[r] *= inv; b1[r] *= inv; }
        {
            float own[4][4], x3[4][4], rcv[4][4];
#pragma unroll
            for (int i = 0; i < 4; ++i) {
                own[0][i] = 2.0f * (a0[4 * i] + a0[4 * i + 1] + a0[4 * i + 2]) + a0[4 * i + 3]; x3[0][i] = a0[4 * i + 3];
                own[1][i] = 2.0f * (a1[4 * i] + a1[4 * i + 1] + a1[4 * i + 2]) + a1[4 * i + 3]; x3[1][i] = a1[4 * i + 3];
                own[2][i] = 2.0f * (b0[4 * i] + b0[4 * i + 1] + b0[4 * i + 2]) + b0[4 * i + 3]; x3[2][i] = b0[4 * i + 3];
                own[3][i] = 2.0f * (b1[4 * i] + b1[4 * i + 1] + b1[4 * i + 2]) + b1[4 * i + 3]; x3[3][i] = b1[4 * i + 3]; }
#pragma unroll
            for (int k = 0; k < 4; ++k)
#pragma unroll
                for (int i = 0; i < 4; ++i) { auto rr = __builtin_amdgcn_permlane32_swap(__float_as_uint(x3[k][i]), __float_as_uint(x3[k][i]), false, false); rcv[k][i] = __uint_as_float(hi ? rr[0] : rr[1]); }
            LAS float* imh = PS + j * (64 * 33) + (sub * 32 + r32) * 33 + hi;
#pragma unroll
            for (int k = 0; k < 4; ++k)
#pragma unroll
                for (int i = 0; i < 4; ++i) { const float prev = i > 0 ? rcv[k][i - 1] : (k > 0 ? rcv[k - 1][3] : 0.f);
                    imh[8 * k + 2 * i] = own[k][i] + (hi ? rcv[k][i] : prev); }
        }
        const int vb0 = (int)(unsigned)(size_t)(lds + L_SLOT + 8192) + ((lane >> 4) & 1) * 32 + (lane & 3) * 8 + (4 * hi + ((lane & 15) >> 2)) * 64;
        bf16x8 x0, x1, x2, x3; pack_p(a0, a1, x0, x1, x2, x3); pv(oc, vb0, x0, x1, x2, x3);
        pack_p(b0, b1, x0, x1, x2, x3); pv(oc, vb0 + 16384, x0, x1, x2, x3);
        scale_rows(oc, wsf, sigmoidf_(gate_c), r32, hi);
#if NSA_LDSACC
        if (PARTS == 7) stage_o<false, false>(oc, lds, nullptr, 0); else
#endif
        store_o<false>(oc, lds, (bf16_t*)a.out + (size_t)(b * SEQ + q0w) * 512 + hg * 64, 512, nullptr, 0);
    }
    __syncthreads();
    if (NSA_PRE(PARTS, 4)) { const bf16_t* Kp = (const bf16_t*)(ws + WS_KVN) + (size_t)(b * SEQ) * 768 + 256 + g * 64;
        attn_pre<4>(qb, qb - 1, -1, Kp, 768, Kp + 128, 768, lds); }
    if (PARTS & 2) {
        const int q = tid >> 3, jb = (tid & 7) * 4; const LAS float* ps = PS + q * 33; LAS float* im = IMP + q * 33;
#pragma unroll
        for (int jj = 0; jj < 4; ++jj) { const int jx = jb + jj;
            const float v = (ps[jx] + ps[64 * 33 + jx]) + (ps[2 * 64 * 33 + jx] + ps[3 * 64 * 33 + jx]);
            const bool valid = jx <= qb, forced = (jx == 0) || (jx == qb) || (jx == qb - 1);
#if TOPK_KEY
            ((LAS unsigned*)im)[jx] = valid ? ((__float_as_uint(v + (forced ? 1e4f : 0.f)) & ~31u) | (unsigned)(31 - jx)) : 0u; }
        __syncthreads();
        unsigned bits = 0u;
#pragma unroll
        for (int jj = 0; jj < 4; ++jj) { const int jx = jb + jj; const unsigned kv = ((const LAS unsigned*)im)[jx]; int cnt = 0;
#pragma unroll
            for (int j2 = 0; j2 < 32; ++j2) cnt += (((const LAS unsigned*)im)[j2] > kv) ? 1 : 0;
            if (cnt < 16 && jx <= qb) bits |= 1u << jx; }
#else
            im[jx] = valid ? v + (forced ? 1e4f : 0.f) : -1e30f; }
        __syncthreads();
        unsigned bits = 0u;
#pragma unroll
        for (int jj = 0; jj < 4; ++jj) { const int jx = jb + jj; const float v = im[jx]; int cnt = 0;
#pragma unroll
            for (int j2 = 0; j2 < 32; ++j2) { const float v2 = im[j2]; cnt += (v2 > v || (v2 == v && j2 < jx)) ? 1 : 0; }
            if (cnt < 16 && jx <= qb) bits |= 1u << jx; }
#endif
        bits |= __shfl_xor(bits, 1); bits |= __shfl_xor(bits, 2); bits |= __shfl_xor(bits, 4);
        if ((tid & 7) == 0) { MW[16 + q] = bits; __hip_atomic_fetch_or(MW, bits, __ATOMIC_RELAXED, __HIP_MEMORY_SCOPE_WORKGROUP); }
        __syncthreads();
    }
    if (PARTS & 2) {
    f32x16 o[2]; o[0] = f32x16{}; o[1] = f32x16{}; float m = 0.f, l = 0.f;
    const unsigned mask = MW[16 + sub * 32 + r32];
    const unsigned um = MW[0] & (qb >= 31 ? 0xffffffffu : ((2u << qb) - 1u));
    const bf16_t* Kg = (const bf16_t*)(ws + WS_KVN) + (size_t)(b * SEQ) * 768 + 256 + g * 64;
    { const float bnd = qnrm * kmx_s, tbm = ((const LAS float*)(lds + L_TBM))[hg];
      attn_loop2<0, NSA_PRE(PARTS, 4)>(um, Kg, 768, Kg + 128, 768, lds, qr, o, m, l, TfT5{tb, qpos, hi, q0w, 1 << 30, mask, true}, q0w + 31, bnd + tbm, __any(bnd > 45.0f)); }
    if (NSA_PRE(PARTS, 5)) { const int lo = qb > 8 ? qb - 8 : 0; const unsigned tmw = (qb >= 31 ? 0xffffffffu : ((2u << qb) - 1u)) & ~((1u << lo) - 1u);
        int w0, w1, w2; top3(tmw, w0, w1, w2); const bf16_t* Kp = (const bf16_t*)(ws + WS_KVN) + (size_t)(b * SEQ) * 768 + 512 + g * 64;
        attn_pre<5>(w0, w1, w2, Kp, 768, Kp + 128, 768, lds); }
    l = halfsum(l);
    scale_rows(o, wsf, sigmoidf_(gate_s) / l, r32, hi);
#if NSA_LDSACC
    if (PARTS == 7) stage_o<true, false>(o, lds, nullptr, 0); else
#endif
    { bf16_t* ocw = (bf16_t*)a.out + (size_t)(b * SEQ + q0w) * 512 + hg * 64; store_o<true>(o, lds, ocw, 512, ocw, 512); }
    }
    if (PARTS & 4) {
    f32x16 o[2]; o[0] = f32x16{}; o[1] = f32x16{}; float m = -1e30f, l = 0.f;
    const int lo = qb > 8 ? qb - 8 : 0; const unsigned tmask = (qb >= 31 ? 0xffffffffu : ((2u << qb) - 1u)) & ~((1u << lo) - 1u);
    const bf16_t* Kg = (const bf16_t*)(ws + WS_KVN) + (size_t)(b * SEQ) * 768 + 512 + g * 64;
    { const float bnd = qnrm * kmx_w, tbm = ((const LAS float*)(lds + L_TBM))[hg];
      attn_loop2<0, NSA_PRE(PARTS, 5)>(tmask, Kg, 768, Kg + 128, 768, lds, qr, o, m, l, TfT5{tb, qpos, hi, q0w, 512, 0u, false}, q0w + 31, bnd + tbm, __any(bnd > 45.0f)); }
    l = halfsum(l);
    scale_rows(o, wsf, sigmoidf_(gate_w) / l, r32, hi);
#if NSA_LDSACC
    if (PARTS == 7) stage_o<true, true>(o, lds, (bf16_t*)(ws + WS_QN) + (size_t)(b * SEQ + q0w) * 512 + hg * 64, 512); else
#endif
    { const bf16_t* ocw = (const bf16_t*)a.out + (size_t)(b * SEQ + q0w) * 512 + hg * 64; store_o<true>(o, lds, (bf16_t*)(ws + WS_QN) + (size_t)(b * SEQ + q0w) * 512 + hg * 64, 512, ocw, 512); }
    }
}
template <bool DRY> __device__ __forceinline__ void sel_unit(const Args& a, LAS unsigned char* lds, int b, int g, int qb) {
    using namespace att;
    unsigned char* ws = a.ws;
    const int tid = fresh_tid(), lane = tid & 63, r32 = lane & 31, hi = lane >> 5, wid = __builtin_amdgcn_readfirstlane(tid >> 6);
    const int j = wid >> 1, sub = wid & 1, hg = g * 4 + j, q0w = qb * 64 + sub * 32, qpos = q0w + r32; const size_t qrow = (size_t)b * SEQ + qpos;
    const LAS float* tb = (const LAS float*)(lds + L_TBL) + hg * T5_W + T5_P; LAS float* wsf = (LAS float*)(lds + L_WSF) + wid * 64;
    bf16_t* Qw = (bf16_t*)(ws + WS_QN) + (size_t)(b * SEQ + q0w) * 512 + hg * 64;
    bf16x8 qr[4]; load_q(qr, Qw, 512, r32, hi);
    const unsigned mask = ((const unsigned*)(ws + WS_MASK))[(size_t)(b * 2 + g) * SEQ + qpos];
    const unsigned um = ((const unsigned*)(ws + WS_UMASK))[(b * 2 + g) * 32 + qb] & (qb >= 31 ? 0xffffffffu : ((2u << qb) - 1u));
    f32x16 o[2]; o[0] = f32x16{}; o[1] = f32x16{}; float m = -1e30f, l = 0.f;
    const bf16_t* Kg = (const bf16_t*)(ws + WS_KVN) + (size_t)(b * SEQ) * 768 + 256 + g * 64;
    attn_loop2(um, Kg, 768, Kg + 128, 768, lds, qr, o, m, l, TfT5{tb, qpos, hi, q0w, 1 << 30, mask, true}, q0w + 31, 0.f, true);
    l = halfsum(l);
    const float g1 = sigmoidf_(((const float*)(ws + WS_F32S))[qrow * 32 + 8 + hg]);
    scale_rows(o, wsf, g1 / l, r32, hi);
    store_o<true>(o, lds, DRY ? (bf16_t*)((unsigned char*)a.out + 16 * MiB) + (size_t)(b * SEQ + q0w) * 512 + hg * 64 : Qw, 512, (const bf16_t*)a.out + (size_t)(b * SEQ + q0w) * 512 + hg * 64, 512);
}
#ifndef PHMASK
#define PHMASK 0xffffffffu
#endif
#define PH(n) (((PHMASK) >> (n)) & 1u)
#ifndef PRE_STAGE
#define PRE_STAGE 0
#endif
#ifndef UNIT_SC
#define UNIT_SC false
#endif
#ifndef AUX_STAGE
#define AUX_STAGE 1
#endif
#ifndef RES_PRE2
#define RES_PRE2 true
#endif
#ifndef RES_PRE
#define RES_PRE true
#endif
#ifndef UP_CHAIN
#define UP_CHAIN 1
#endif
#ifndef GU_ALIGN
#define GU_ALIGN true
#endif
#ifndef MULTI_ALIGN
#define MULTI_ALIGN true
#endif
#ifndef SINGLE_ALIGN
#define SINGLE_ALIGN true
#endif
#ifndef DUPMASK
#define DUPMASK 0u
#endif
#define DUP(n) (((DUPMASK) >> (n)) & 1u)
#define REP(n) for (int rep_ = 0; rep_ < 1 + (int)DUP(n); ++rep_)
#define STAGE_SSQ(S_, ssptr) do { LAS float* aux_ = (LAS float*)(lds + RING_BYTES); pg8::Unit u_; const int t_ = fresh_tid(); \
        for (int i_ = 0; S_.next(i_, u_); ++i_) if (t_ < 256) aux_[i_ * 256 + t_] = ssq_f((ssptr)[u_.pm * 256 + t_]); \
        __syncthreads(); } while (0)
#define STAGE_SS(S_, ssptr) do { LAS float* aux_ = (LAS float*)(lds + RING_BYTES); pg8::Unit u_; const int t_ = fresh_tid(); \
        for (int i_ = 0; S_.next(i_, u_); ++i_) if (t_ < 256) aux_[i_ * 256 + t_] = (ssptr)[u_.pm * 256 + t_]; \
        __syncthreads(); } while (0)
#ifndef NO_PK32
#define NO_PK32 1
#endif
#if NO_PK32
#define KATTR __attribute__((target("no-packed-fp32-ops")))
#else
#define KATTR
#endif
__global__ KATTR void __launch_bounds__(512, 2) hybrid_fwd(Args a) {
    extern __shared__ __attribute__((aligned(16))) unsigned char lds_raw[];
    LAS unsigned char* lds = (LAS unsigned char*)lds_raw;
    cg::grid_group grid = cg::this_grid();
    unsigned char* ws = a.ws;
    const int tid = fresh_tid(), lane = tid & 63, wave = __builtin_amdgcn_readfirstlane(tid >> 6);
    const int G = gridDim.x, bx = blockIdx.x, vcu = (G % 8 == 0) ? (bx % 8) * (G / 8) + bx / 8 : bx;
    const int gw = vcu * 8 + wave, NGW = G * 8;
    float* X = a.out;
    bf16_t* XB = (bf16_t*)(ws + WS_XB);
    float* SS = (float*)(ws + WS_SS); unsigned long long* SSQ = (unsigned long long*)(ws + WS_SSQ);
    { volatile LAS unsigned* st0 = (volatile LAS unsigned*)(lds + LDS_BYTES - 256); if (tid < 32) st0[tid] = 0u; }
    __syncthreads();
    XcdBarrier xbar = xcd_barrier_post((unsigned*)(ws + WS_CTL) + CW_BAR, (volatile LAS unsigned*)(lds + LDS_BYTES - 256 + 32));
#ifdef USE_CG_SYNC
#define GSYNC() grid.sync()
#else
    if (a.lo == 0x7e57) grid.sync();
#ifdef TSTAMP
    int gs_cnt = 0; unsigned long long t_start = __builtin_amdgcn_s_memrealtime(), t_rec = 0;
    unsigned long long t_prev = t_start;
#ifdef TSKEW
#define GSYNC() do { ++gs_cnt; if (gs_cnt == TSTAMP && tid == 0) ((unsigned long long*)(ws + WS_XBUF + 512 * 1024))[bx] = __builtin_amdgcn_s_memrealtime(); xcd_barrier(xbar); if (gs_cnt == TSTAMP - 1) t_prev = __builtin_amdgcn_s_memrealtime(); } while (0)
#else
#define GSYNC() do { xcd_barrier(xbar); ++gs_cnt; if (gs_cnt == TSTAMP - 1) t_prev = __builtin_amdgcn_s_memrealtime(); if (gs_cnt == TSTAMP) t_rec = __builtin_amdgcn_s_memrealtime(); } while (0)
#endif
#else
#define GSYNC() xcd_barrier(xbar)
#endif
#endif
    const float* fin_src = a.in[I_X];

#if STAGE_LIMIT >= 1
    REP(0) p0_prologue(a, lds, gw, NGW, wave, lane);
    GSYNC();
    { pg8::Gemm g{XB, (const bf16_t*)(ws + WS_WGU1), DM, DM, DM, 0, 0, 0, 0}; pg8::Order S; S.init(64, 22, 1, G, bx);
#if !PRE_STAGE
      STAGE_SS(S, SS);
#endif
      pg8::EpiGU E{(bf16_t*)(ws + WS_H), (const LAS float*)(lds + RING_BYTES)};
#ifdef P1_NULLDUP
      { pg8::EpiNull E0{(float*)(ws + WS_POSC + 4096)}; pg8::gemm_phase<pg8::EpiNull, true>(lds, g, S, E0); }
#endif
#if PRE_STAGE
      pg8::gemm_phase<pg8::EpiGU, GU_ALIGN, pg8::Order, pg8::PreSS>(lds, g, S, E, pg8::PreSS{SS, RING_BYTES});
#else
      REP(1) pg8::gemm_phase<pg8::EpiGU, GU_ALIGN>(lds, g, S, E);
#endif
      if (bx >= 128) { LAS float* scr = (LAS float*)(lds + wave * 16384); conv_run(a, N_GU + (bx - 128) * 8 + wave, CONV_NA, 1024, scr, lane); }
#ifndef CMP_OLD
      if (bx == 255) { const int t_ = fresh_tid(); const float* pp = (const float*)(ws + WS_POSCP) + t_; float s_ = 0.f;
#pragma unroll 8
          for (int c = 0; c < 32; ++c) s_ += pp[c * 512];
          ((float*)(ws + WS_POSC))[t_] = s_; }
#endif
    }
    GSYNC();
    { pg8::Gemm g{(const bf16_t*)(ws + WS_H), (const bf16_t*)(ws + WS_WD1), FF, FF, FF, 0, 0, 0, 0}; pg8::Order S; S.init(64, 4, 1, G, bx);
      if (DUP(2)) { pg8::EpiNull E0{(float*)(ws + WS_POSC + 4096)}; pg8::gemm_phase<pg8::EpiNull, false>(lds, g, S, E0); }
      pg8::EpiResB<false, true, RES_PRE2> E{nullptr, XB, SSQ, 0.5f}; pg8::gemm_phase<pg8::EpiResB<false, true, RES_PRE2>, false>(lds, g, S, E); }
    GSYNC();
    fin_src = X;
#endif
#if STAGE_LIMIT >= 2
#if PH(3)
    { pg8::Gemm g{XB, (const bf16_t*)(ws + WS_WIN), DM, DM, DM, 0, 0, 0, 0}; pg8::Order S; S.init(64, 20, 1, G, bx);
      pg8::EpiQKV E{(bf16_t*)(ws + WS_QN), (bf16_t*)(ws + WS_KVN), (bf16_t*)(ws + WS_QF), (bf16_t*)(ws + WS_KVF), (bf16_t*)(ws + WS_GAB), (float*)(ws + WS_F32S), (const LAS float*)(lds + RING_BYTES)};
#if !PRE_STAGE
      STAGE_SSQ(S, SSQ);
#endif
#ifdef P3_NULLDUP
      { pg8::EpiNull E0{(float*)(ws + WS_POSC + 4096)}; pg8::gemm_phase<pg8::EpiNull, true>(lds, g, S, E0); }
#endif
#if PRE_STAGE
      pg8::gemm_phase<pg8::EpiQKV, MULTI_ALIGN, pg8::Order, pg8::PreSSQ>(lds, g, S, E, pg8::PreSSQ{SSQ, RING_BYTES}); }
#else
      REP(3) pg8::gemm_phase<pg8::EpiQKV, MULTI_ALIGN>(lds, g, S, E); }
#endif
#endif
    GSYNC();
#if PH(4)
    REP(4) if (bx < 128) { compress_unit(a, lds, bx); }
    else if (bx < 192) {
        { pg8::Gemm g{(const bf16_t*)(ws + WS_MEMB), (const bf16_t*)(ws + WS_WMKV), DM, DM, DM, 0, 0, 0, 0}; pg8::Order S; S.init(8, 8, 1, 64, bx - 128);
#if AUX_STAGE
            pg8::EpiRowScale E{(bf16_t*)(ws + WS_KVM), 2 * DM, (const float*)(ws + WS_SSM), (const LAS float*)(lds + RING_BYTES)}; pg8::gemm_phase<pg8::EpiRowScale, false, pg8::Order, pg8::PreSS>(lds, g, S, E, pg8::PreSS{(const float*)(ws + WS_SSM), RING_BYTES}); }
#else
            pg8::EpiRowScale E{(bf16_t*)(ws + WS_KVM), 2 * DM, (const float*)(ws + WS_SSM), nullptr}; pg8::gemm_phase<pg8::EpiRowScale, false>(lds, g, S, E); }
#endif
#ifdef P4_MOVE
    } else { const int tk = bx - 192; cumsum_task8(a, lds, tk, wave, lane);
        kmax_task(a, lds, (const bf16_t*)(ws + WS_KVF) + (size_t)((tk >> 3) * SEQ) * 1024 + (tk & 7) * 64, 1024, (float*)(ws + WS_KMAX) + tk, wave, lane);
        if (tk < 32) { const int bgi = tk >> 1, br = tk & 1;
            kmax_task(a, lds, (const bf16_t*)(ws + WS_KVN) + (size_t)((bgi >> 1) * SEQ) * 768 + 256 + br * 256 + (bgi & 1) * 64, 768, (float*)(ws + WS_KMAX) + 64 + tk, wave, lane); }
    }
#else
        if (bx < 160) { const int tk = bx - 128, bgi = tk >> 1, br = tk & 1;
            kmax_task(a, lds, (const bf16_t*)(ws + WS_KVN) + (size_t)((bgi >> 1) * SEQ) * 768 + 256 + br * 256 + (bgi & 1) * 64, 768, (float*)(ws + WS_KMAX) + 64 + tk, wave, lane); }
    } else { const int tk = bx - 192; cumsum_task8(a, lds, tk, wave, lane);
        kmax_task(a, lds, (const bf16_t*)(ws + WS_KVF) + (size_t)((tk >> 3) * SEQ) * 1024 + (tk & 7) * 64, 1024, (float*)(ws + WS_KMAX) + tk, wave, lane);
    }
#endif
#ifdef P4_REBAL
    if (bx < 128) { const int t_ = fresh_tid(), wv_ = __builtin_amdgcn_readfirstlane(t_ >> 6), ln_ = t_ & 63; LAS float* scr = (LAS float*)(lds + wv_ * 16384);
        conv_run_b(a, bx * 4 + (wv_ >> 1) + (wv_ & 1) * 1536, 3072, scr, ln_);
        wqn_rows(a, bx * 8 + wv_, 1024, ln_); }
    else if (bx >= 192) { LAS float* scr = (LAS float*)(lds + wave * 16384);
        const int s0_ = 512 + ((bx - 192) * 8 + wave) * 2; conv_run_b(a, s0_, 1536, scr, lane); conv_run_b(a, s0_ + 1, 1536, scr, lane); }
#else
    if (bx >= 128) {
        LAS float* scr = (LAS float*)(lds + wave * 16384);
#ifdef CONVB_SKIP_D2
#ifndef P4DUP
#define P4DUP 0
#endif
        for (int rp_ = 0; rp_ < 1 + ((bx < 192) ? ((P4DUP >> 1) & 1) : ((P4DUP >> 2) & 1)); ++rp_) {
        if (bx < 192) conv_run_b(a, (bx - 128) * 8 + wave, 1536, scr, lane);
        else { const int s0_ = 512 + ((bx - 192) * 8 + wave) * 2; conv_run_b(a, s0_, 1536, scr, lane); conv_run_b(a, s0_ + 1, 1536, scr, lane); }
        }
#else
        if (bx < 192) conv_run(a, CONV_NA + (bx - 128) * 8 + wave, CONV_NA + CONV_NB, 1536, scr, lane);
        else { const int s0_ = 512 + ((bx - 192) * 8 + wave) * 2; conv_run(a, CONV_NA + s0_, CONV_NA + CONV_NB, 1536, scr, lane); conv_run(a, CONV_NA + s0_ + 1, CONV_NA + CONV_NB, 1536, scr, lane); }
#endif
#ifdef P4_MOVE
        if (bx >= 192) wqn_rows(a, (bx - 128) * 8 + wave, 1024, lane); }
    if (bx < 64) { const int t_ = fresh_tid(), wv_ = __builtin_amdgcn_readfirstlane(t_ >> 6), ln_ = t_ & 63; wqn_rows(a, bx * 8 + wv_, 1024, ln_); }
#else
        wqn_rows(a, (bx - 128) * 8 + wave, 1024, lane); }
#endif
#endif
#endif
    GSYNC();
#if PH(5)
    init_t5_table(a, lds);
#ifndef FOX_DYN
    { const int bh = vcu >> 2, s = vcu & 3; if (DUP(5)) { fox_unit<true>(a, lds, bh >> 3, bh & 7, 7 - s, 0); fox_unit<true>(a, lds, bh >> 3, bh & 7, s, 1); }
      fox_unit<false>(a, lds, bh >> 3, bh & 7, 7 - s, 0); fox_unit<false>(a, lds, bh >> 3, 7 - (bh & 7), s, 1); }
#endif
#ifdef DUPPART
    { const int bg = vcu >> 4, s = vcu & 15; cmpwin_unit<DUPPART>(a, lds, bg >> 1, bg & 1, 31 - s); cmpwin_unit<DUPPART>(a, lds, bg >> 1, bg & 1, s); }
#endif
#ifndef NO_CMPWIN
    REP(15) { const int bg = vcu >> 4, s = vcu & 15; cmpwin_unit<7>(a, lds, bg >> 1, bg & 1, 31 - s); cmpwin_unit<7>(a, lds, bg >> 1, bg & 1, s); }
#endif
#ifdef FOX_DYN
    for (int it = 0;; ++it) {
        LAS unsigned* cl = (LAS unsigned*)(lds + att::L_CLAIM) + (it & 1);
        if (fresh_tid() == 0) *cl = atomicAdd((unsigned*)(ws + WS_FOXQ), 1u);
        __syncthreads();
        const int u = __builtin_amdgcn_readfirstlane((int)*cl);
        if (u >= 512) break;
        fox_unit<false>(a, lds, (u & 63) >> 3, u & 7, 7 - (u >> 6), it);
    }
#endif
#endif
    GSYNC();
#if PH(7)
    REP(7) { pg8::PairOrder S; S.base.init(64, 4, 1, G, bx);
      pg8::Gemm g{(const bf16_t*)(ws + WS_QN), (const bf16_t*)(ws + WS_WUPN), 512, 512, 512, 0, (long)(WS_QF - WS_QN) / 2, 0, (long)(WS_WUPF - WS_WUPN) / 2};
#ifdef P7_NULLDUP
      { pg8::EpiNull E0{(float*)(ws + WS_POSC + 4096)}; pg8::gemm_phase<pg8::EpiNull, true>(lds, g, S, E0); }
#endif
#if UP_CHAIN
      pg8::EpiUpC E{(const bf16_t*)(ws + WS_GAB), (bf16_t*)(ws + WS_Y)}; pg8::gemm_phase<pg8::EpiUpC, true>(lds, g, S, E); }
#else
      pg8::EpiUp<2> E{(const bf16_t*)(ws + WS_GAB), (bf16_t*)(ws + WS_Y)}; pg8::gemm_phase<pg8::EpiUp<2>, true>(lds, g, S, E); }
#endif
#endif
    GSYNC();
#if PH(8)
    { pg8::Gemm g{(const bf16_t*)(ws + WS_Y), (const bf16_t*)(ws + WS_WOUT), DM, DM, DM, 0, 0, 0, 0}; pg8::Order S; S.init(64, 4, 1, G, bx);
      if (DUP(8)) { pg8::EpiNull E0{(float*)(ws + WS_POSC + 4096)}; pg8::gemm_phase<pg8::EpiNull, false>(lds, g, S, E0); }
      pg8::EpiResB<false, true, RES_PRE, UNIT_SC> E{nullptr, XB, SSQ + M, 1.0f}; pg8::gemm_phase<pg8::EpiResB<false, true, RES_PRE, UNIT_SC>, false>(lds, g, S, E); }
    if (bx < 128) { pg8::Gemm g{(const bf16_t*)(ws + WS_KVM), (const bf16_t*)(ws + WS_WMQ), 2 * DM, DM, 256, (long)MEMLEN * 2 * DM, 256, 0, 256};
        pg8::OneUnit S{pg8::Unit{0, bx & 3, bx >> 2}}; pg8::EpiBatchBf16 E{(bf16_t*)(ws + WS_MT), DM, (long)DM * DM, (long)256 * DM}; pg8::gemm_phase<pg8::EpiBatchBf16, false>(lds, g, S, E); }
    else { pg8::Gemm g{(const bf16_t*)(ws + WS_WMO), (const bf16_t*)(ws + WS_KVM) + DM, DM, 2 * DM, 256, 0, 256, (long)MEMLEN * 2 * DM, 256};
        pg8::OneUnit S{pg8::Unit{(bx - 128) & 3, 0, (bx - 128) >> 2}}; pg8::EpiBatchBf16 E{(bf16_t*)(ws + WS_NT), DM, (long)DM * DM, 256}; pg8::gemm_phase<pg8::EpiBatchBf16, false>(lds, g, S, E); }
#endif
    GSYNC();
#endif
#if STAGE_LIMIT >= 3
    { pg8::Gemm g{XB, (const bf16_t*)(ws + WS_MT), DM, DM, DM, 0, 0, (long)4 * DM * DM, (long)DM * DM}; pg8::Order S; S.init(64, 4, 1, G, bx, 3);
#if AUX_STAGE
      pg8::EpiSoftmaxRS E{(bf16_t*)(ws + WS_PM), DM, SSQ + M, (const LAS float*)(lds + RING_BYTES)}; pg8::gemm_phase<pg8::EpiSoftmaxRS, false, pg8::Order, pg8::PreSSQ>(lds, g, S, E, pg8::PreSSQ{SSQ + M, RING_BYTES}); }
#else
      pg8::EpiSoftmaxRS E{(bf16_t*)(ws + WS_PM), DM, SSQ + M, nullptr}; pg8::gemm_phase<pg8::EpiSoftmaxRS, false>(lds, g, S, E); }
#endif
    GSYNC();
    { pg8::Gemm g{(const bf16_t*)(ws + WS_PM), (const bf16_t*)(ws + WS_NT), DM, DM, DM, 0, 0, (long)4 * DM * DM, (long)DM * DM}; pg8::Order S; S.init(64, 4, 1, G, bx, 3);
      pg8::EpiResB<false, true, RES_PRE, UNIT_SC> E{nullptr, XB, SSQ + 2 * M, 1.0f}; pg8::gemm_phase<pg8::EpiResB<false, true, RES_PRE, UNIT_SC>, false>(lds, g, S, E); }
    GSYNC();
#endif
#if STAGE_LIMIT >= 4
    { pg8::Gemm g{XB, (const bf16_t*)(ws + WS_WGU2), DM, DM, DM, 0, 0, 0, 0}; pg8::Order S; S.init(64, 22, 1, G, bx);
#if PRE_STAGE
      pg8::EpiGU E{(bf16_t*)(ws + WS_H), (const LAS float*)(lds + RING_BYTES)}; pg8::gemm_phase<pg8::EpiGU, GU_ALIGN, pg8::Order, pg8::PreSSQ>(lds, g, S, E, pg8::PreSSQ{SSQ + 2 * M, RING_BYTES});
#else
      STAGE_SSQ(S, SSQ + 2 * M); pg8::EpiGU E{(bf16_t*)(ws + WS_H), (const LAS float*)(lds + RING_BYTES)}; REP(13) pg8::gemm_phase<pg8::EpiGU, GU_ALIGN>(lds, g, S, E);
#endif
#ifdef D2_P13
      if (bx >= 128) { const int t_ = fresh_tid(), wv_ = __builtin_amdgcn_readfirstlane(t_ >> 6), ln_ = t_ & 63; LAS float* scr = (LAS float*)(lds + wv_ * 16384); conv_run(a, CONV_NA + N_GU + (bx - 128) * 8 + wv_, CONV_NA + N_GU + N_D, 1024, scr, ln_); }
#endif
    }
    GSYNC();
    { pg8::Gemm g{(const bf16_t*)(ws + WS_H), (const bf16_t*)(ws + WS_WD2), FF, FF, FF, 0, 0, 0, 0}; pg8::Order S; S.init(64, 4, 1, G, bx);
      pg8::EpiResNorm E{XB, X, 0.5f, a.in[I_FINN], (float*)(ws + WS_XBUF), (unsigned*)(ws + WS_FINCNT)}; pg8::gemm_phase<pg8::EpiResNorm, false>(lds, g, S, E); }
#ifdef TSTAMP
    GSYNC();
#ifdef TSKEW
#ifndef ROLE_LO
#define ROLE_LO 0
#define ROLE_HI 256
#endif
    { unsigned long long mx = 0; const unsigned long long* ta = (const unsigned long long*)(ws + WS_XBUF + 512 * 1024);
      for (int i = ROLE_LO; i < ROLE_HI; ++i) { const unsigned long long v = __hip_atomic_load(ta + i, __ATOMIC_RELAXED, __HIP_MEMORY_SCOPE_AGENT); mx = v > mx ? v : mx; }
      t_rec = mx; }
#endif
    if (t_rec == 0) t_rec = __builtin_amdgcn_s_memrealtime();
    if (bx == 0) { const int n = (int)((t_rec - t_prev) * 400 / 100); for (int i = tid; i < n; i += 512) X[i] += 0.1f; }
#endif
    return;
#endif
#ifdef EXTRA_BARS
    for (int eb = 0; eb < EXTRA_BARS; ++eb) GSYNC();
#endif
    { const float* gn = a.in[I_FINN]; const int tid2 = fresh_tid(), lane = tid2 & 63, gw = vcu * 8 + (tid2 >> 6);
      for (int mrow = gw; mrow < M; mrow += NGW) {
          const f32x4* xr = (const f32x4*)(fin_src + (size_t)mrow * DM) + lane; f32x4* orow = (f32x4*)(X + (size_t)mrow * DM) + lane;
          f32x4 v[4]; float s = 0.f;
#pragma unroll
          for (int j = 0; j < 4; ++j) { v[j] = xr[64 * j]; s += (v[j][0] * v[j][0] + v[j][1] * v[j][1]) + (v[j][2] * v[j][2] + v[j][3] * v[j][3]); }
          const float rs = rstd_of(wave_sum(s));
#pragma unroll
          for (int j = 0; j < 4; ++j) orow[64 * j] = v[j] * rs * ((const f32x4*)gn)[lane + 64 * j];
      } }
}

extern "C" void kernel_launch(void* const* d_in, const int* in_sizes, int n_in, void* d_out, int out_size, void* d_ws, size_t ws_size, hipStream_t stream) {
    static int grid = 0;
    if (grid == 0) {
        if (n_in != 29 || out_size != M * DM || ws_size < WS_END) { fprintf(stderr, "kernel_launch: unexpected shapes (n_in %d out %d ws %zu)\n", n_in, out_size, ws_size); grid = -1; return; }
        int dev = 0, cus = 0, per_cu = 0;
        hipGetDevice(&dev); hipDeviceGetAttribute(&cus, hipDeviceAttributeMultiprocessorCount, dev);
        if (hipFuncSetAttribute((const void*)hybrid_fwd, hipFuncAttributeMaxDynamicSharedMemorySize, LDS_BYTES) != hipSuccess) { fprintf(stderr, "kernel_launch: hipFuncSetAttribute failed\n"); grid = -1; return; }
        if (hipOccupancyMaxActiveBlocksPerMultiprocessor(&per_cu, (const void*)hybrid_fwd, 512, LDS_BYTES) != hipSuccess || per_cu < 1) { fprintf(stderr, "kernel_launch: occupancy query failed (%d)\n", per_cu); per_cu = 1; }
        (void)hipGetLastError();
        grid = cus * (per_cu < 1 ? 1 : 1);
        if (grid != 256) fprintf(stderr, "kernel_launch: grid %d != 256: this kernel's phase maps assume 256 workgroups\n", grid);
    }
    if (grid < 0) return;
    hipMemsetAsync((char*)d_ws + WS_CTL, 0, CTL_ZERO_BYTES, stream);
#ifdef EXTRA_MEMSET
    for (int i = 0; i < EXTRA_MEMSET; ++i) hipMemsetAsync((char*)d_ws + WS_CTL, 0, CTL_ZERO_BYTES, stream);
#endif
    Args a{};
    for (int i = 0; i < 29; ++i) a.in[i] = (const float*)d_in[i];
    a.out = (float*)d_out; a.ws = (unsigned char*)d_ws; a.lo = 0; a.hi = 0;
    void* args[] = {&a};
#ifdef PLAIN_LAUNCH
    hipLaunchKernelGGL(hybrid_fwd, dim3(grid), dim3(512), LDS_BYTES, stream, a); hipError_t e = hipPeekAtLastError(); (void)args;
#else
    hipError_t e = hipLaunchCooperativeKernel((const void*)hybrid_fwd, dim3(grid), dim3(512), args, LDS_BYTES, stream);
#endif
    if (e != hipSuccess) fprintf(stderr, "kernel_launch: cooperative launch failed: %s (grid %d)\n", hipGetErrorString(e), grid);
}
```
